# Optimizing an MI355X kernel written in HIP

```python
import jax, jax.numpy as jnp
from jax import lax
import numpy as np

D_MODEL = 1024
BATCH = 2
SEQ = 8192
DEPTH = 1

CHUNK = 64
Q_BLOCK = 128
EPS = 1e-6
N_MEM = 256
MLA_HEADS = 8
MLA_Q_RANK = 256
MLA_KV_RANK = 128
MLA_NOPE_DIM = 64
MLA_ROPE_DIM = 32
MLA_V_DIM = 64
MLA_QK_DIM = MLA_NOPE_DIM + MLA_ROPE_DIM
MLA_WIDTH = MLA_HEADS * MLA_V_DIM
ROPE_THETA = 10000.0
CONV_WIDTH = D_MODEL - MLA_WIDTH
CONV_KERNEL = 31
IN_SPLITS = [MLA_Q_RANK, MLA_Q_RANK + MLA_KV_RANK, MLA_Q_RANK + MLA_KV_RANK + MLA_ROPE_DIM]
IN_COLS = MLA_Q_RANK + MLA_KV_RANK + MLA_ROPE_DIM + 2 * CONV_WIDTH
MEM_HEADS = 4
MEM_HEAD_DIM = D_MODEL // MEM_HEADS
PEER_HEADS = 8
PEER_N_KEYS = 128
PEER_N_EXPERTS = PEER_N_KEYS * PEER_N_KEYS
PEER_KEY_DIM = 256
PEER_HALF_DIM = PEER_KEY_DIM // 2
PEER_TOPK = 16
PEER_TOKEN_BLOCK = 128

kernel_name = 'hybrid_mla_conformer_peer_block'


def rms_norm(x, g):
    xf = x.astype(jnp.float32)
    y = xf * lax.rsqrt(jnp.mean(xf * xf, axis=-1, keepdims=True) + EPS)
    return (y * g.astype(jnp.float32)).astype(x.dtype)


def layer_norm(x, g, b):
    xf = x.astype(jnp.float32)
    mu = jnp.mean(xf, axis=-1, keepdims=True)
    xc = xf - mu
    var = jnp.mean(xc * xc, axis=-1, keepdims=True)
    y = xc * lax.rsqrt(var + EPS) * g.astype(jnp.float32) + b.astype(jnp.float32)
    return y.astype(x.dtype)


def rope_tables(seq_len, dim):
    inv = 1.0 / (ROPE_THETA ** (jnp.arange(0, dim, 2, dtype=jnp.float32) / dim))
    ang = jnp.arange(seq_len, dtype=jnp.float32)[:, None] * inv[None, :]
    return jnp.cos(ang), jnp.sin(ang)


def apply_rope(x, cos, sin):
    x1, x2 = jnp.split(x, 2, axis=-1)
    c = cos.astype(x.dtype)
    s = sin.astype(x.dtype)
    return jnp.concatenate([x1 * c - x2 * s, x1 * s + x2 * c], axis=-1)


def chunk_causal_attention(q, k, v):
    B, S, H, Dqk = q.shape
    nb = S // Q_BLOCK
    scale = Dqk ** -0.5
    qb = q.reshape(B, nb, Q_BLOCK, H, Dqk).transpose(1, 0, 2, 3, 4)
    k_chunk = jnp.arange(S) // CHUNK

    def one_block(args):
        blk, q_blk = args
        s = jnp.einsum('bqhd,bkhd->bhqk', q_blk, k).astype(jnp.float32) * scale
        q_chunk = (blk * Q_BLOCK + jnp.arange(Q_BLOCK)) // CHUNK
        allowed = k_chunk[None, :] <= q_chunk[:, None]
        s = jnp.where(allowed, s, -1e30)
        p = jax.nn.softmax(s, axis=-1).astype(v.dtype)
        return jnp.einsum('bhqk,bkhd->bqhd', p, v)

    out = lax.map(one_block, (jnp.arange(nb), qb))
    return out.transpose(1, 0, 2, 3, 4).reshape(B, S, H, v.shape[-1])


def hybrid_mixer(xn, w_in, q_latent_g, w_q_up, kv_latent_g, w_kv_up,
                 conv_w, conv_b, conv_ln_g, conv_ln_b, w_mix_out):
    B, S, _ = xn.shape
    proj = xn @ w_in
    c_q, c_kv, k_r, conv_in = jnp.split(proj, IN_SPLITS, axis=-1)

    q = (rms_norm(c_q, q_latent_g) @ w_q_up).reshape(B, S, MLA_HEADS, MLA_QK_DIM)
    q_nope, q_rope = q[..., :MLA_NOPE_DIM], q[..., MLA_NOPE_DIM:]
    kv = (rms_norm(c_kv, kv_latent_g) @ w_kv_up).reshape(B, S, MLA_HEADS, MLA_NOPE_DIM + MLA_V_DIM)
    k_nope, v = kv[..., :MLA_NOPE_DIM], kv[..., MLA_NOPE_DIM:]
    cos, sin = rope_tables(S, MLA_ROPE_DIM)
    q_rope = apply_rope(q_rope, cos[:, None, :], sin[:, None, :])
    k_rope = apply_rope(k_r, cos, sin)
    q_full = jnp.concatenate([q_nope, q_rope], axis=-1)
    k_full = jnp.concatenate(
        [k_nope, jnp.broadcast_to(k_rope[:, :, None, :], (B, S, MLA_HEADS, MLA_ROPE_DIM))], axis=-1)
    attn = chunk_causal_attention(q_full, k_full, v).reshape(B, S, MLA_WIDTH)

    val, gate = jnp.split(conv_in, 2, axis=-1)
    u = val * jax.nn.sigmoid(gate)
    u = jnp.pad(u, ((0, 0), (CONV_KERNEL - 1, 0), (0, 0)))
    u = lax.conv_general_dilated(u, conv_w.astype(u.dtype), window_strides=(1,), padding='VALID',
                                 dimension_numbers=('NWC', 'WIO', 'NWC'),
                                 feature_group_count=CONV_WIDTH) + conv_b
    u = jax.nn.silu(layer_norm(u, conv_ln_g, conv_ln_b))

    return jnp.concatenate([attn, u], axis=-1) @ w_mix_out


def memory_cross_attention(hn, mem, mem_kv_norm_g, w_mem_q, w_mem_kv, w_mem_out):
    B, S, _ = hn.shape
    M = mem.shape[1]
    q = (hn @ w_mem_q).reshape(B, S, MEM_HEADS, MEM_HEAD_DIM)
    kv = rms_norm(mem, mem_kv_norm_g) @ w_mem_kv
    k, v = jnp.split(kv, 2, axis=-1)
    k = k.reshape(B, M, MEM_HEADS, MEM_HEAD_DIM)
    v = v.reshape(B, M, MEM_HEADS, MEM_HEAD_DIM)
    s = jnp.einsum('bshd,bmhd->bhsm', q, k).astype(jnp.float32) * (MEM_HEAD_DIM ** -0.5)
    p = jax.nn.softmax(s, axis=-1).astype(v.dtype)
    o = jnp.einsum('bhsm,bmhd->bshd', p, v).reshape(B, S, D_MODEL)
    return o @ w_mem_out


def peer_channel_mixer(hn, w_peer_query, peer_sub_keys, peer_u, peer_v):
    B, S, D = hn.shape
    q = (hn @ w_peer_query).reshape(B, S, PEER_HEADS, 2, PEER_HALF_DIM)
    sub_scores = jnp.einsum('bshpd,hpnd->bshpn', q, peer_sub_keys).astype(jnp.float32)
    top_s, top_i = lax.top_k(sub_scores, PEER_TOPK)
    cand_s = top_s[..., 0, :, None] + top_s[..., 1, None, :]
    cand_i = top_i[..., 0, :, None] * PEER_N_KEYS + top_i[..., 1, None, :]
    cand_s = cand_s.reshape(B, S, PEER_HEADS, PEER_TOPK * PEER_TOPK)
    cand_i = cand_i.reshape(B, S, PEER_HEADS, PEER_TOPK * PEER_TOPK)
    best_s, best_pos = lax.top_k(cand_s, PEER_TOPK)
    expert_idx = jnp.take_along_axis(cand_i, best_pos, axis=-1)
    gates = jax.nn.softmax(best_s, axis=-1)

    T = B * S
    nb = T // PEER_TOKEN_BLOCK
    xt = hn.reshape(nb, PEER_TOKEN_BLOCK, D)
    it = expert_idx.reshape(nb, PEER_TOKEN_BLOCK, PEER_HEADS, PEER_TOPK)
    gt = gates.reshape(nb, PEER_TOKEN_BLOCK, PEER_HEADS, PEER_TOPK)

    def one_block(args):
        xb, ib, gb = args
        u = peer_u[ib]
        a = jax.nn.gelu(jnp.einsum('thkd,td->thk', u, xb), approximate=False)
        w = (a.astype(jnp.float32) * gb).astype(xb.dtype)
        v = peer_v[ib]
        return jnp.einsum('thk,thkd->td', w, v)

    return lax.map(one_block, (xt, it, gt)).reshape(B, S, D)


def _normal(key, shape, scale):
    return jax.random.normal(key, shape, dtype=jnp.float32) * scale


def _gain(key, shape):
    return 1.0 + 0.01 * jax.random.normal(key, shape, dtype=jnp.float32)


def setup_inputs(seed: int = 0) -> dict:
    key = jax.random.key(seed)
    ks = jax.random.split(key, 24)
    L = DEPTH
    return {
        'x': _normal(ks[0], (BATCH, SEQ, D_MODEL), 1.0),
        'mem': _normal(ks[1], (BATCH, N_MEM, D_MODEL), 1.0),
        'norm_mix_g': _gain(ks[2], (L, D_MODEL)),
        'w_in': _normal(ks[3], (L, D_MODEL, IN_COLS), D_MODEL ** -0.5),
        'q_latent_g': _gain(ks[4], (L, MLA_Q_RANK)),
        'w_q_up': _normal(ks[5], (L, MLA_Q_RANK, MLA_HEADS * MLA_QK_DIM), MLA_Q_RANK ** -0.5),
        'kv_latent_g': _gain(ks[6], (L, MLA_KV_RANK)),
        'w_kv_up': _normal(ks[7], (L, MLA_KV_RANK, MLA_HEADS * (MLA_NOPE_DIM + MLA_V_DIM)), MLA_KV_RANK ** -0.5),
        'conv_w': _normal(ks[8], (L, CONV_KERNEL, 1, CONV_WIDTH), CONV_KERNEL ** -0.5),
        'conv_b': _normal(ks[9], (L, CONV_WIDTH), 0.01),
        'conv_ln_g': _gain(ks[10], (L, CONV_WIDTH)),
        'conv_ln_b': _normal(ks[11], (L, CONV_WIDTH), 0.01),
        'w_mix_out': _normal(ks[12], (L, D_MODEL, D_MODEL), D_MODEL ** -0.5),
        'norm_mem_g': _gain(ks[13], (L, D_MODEL)),
        'mem_kv_norm_g': _gain(ks[14], (L, D_MODEL)),
        'w_mem_q': _normal(ks[15], (L, D_MODEL, D_MODEL), D_MODEL ** -0.5),
        'w_mem_kv': _normal(ks[16], (L, D_MODEL, 2 * D_MODEL), D_MODEL ** -0.5),
        'w_mem_out': _normal(ks[17], (L, D_MODEL, D_MODEL), D_MODEL ** -0.5),
        'norm_ffn_g': _gain(ks[18], (L, D_MODEL)),
        'w_peer_query': _normal(ks[19], (L, D_MODEL, PEER_HEADS * PEER_KEY_DIM), D_MODEL ** -0.5),
        'peer_sub_keys': _normal(ks[20], (L, PEER_HEADS, 2, PEER_N_KEYS, PEER_HALF_DIM), PEER_HALF_DIM ** -0.5),
        'peer_u': _normal(ks[21], (L, PEER_N_EXPERTS, D_MODEL), D_MODEL ** -0.5),
        'peer_v': _normal(ks[22], (L, PEER_N_EXPERTS, D_MODEL), 0.5),
        'final_norm_g': _gain(ks[23], (D_MODEL,)),
    }


def reference(x, mem, norm_mix_g, w_in, q_latent_g, w_q_up, kv_latent_g, w_kv_up,
              conv_w, conv_b, conv_ln_g, conv_ln_b, w_mix_out,
              norm_mem_g, mem_kv_norm_g, w_mem_q, w_mem_kv, w_mem_out,
              norm_ffn_g, w_peer_query, peer_sub_keys, peer_u, peer_v, final_norm_g):
    h = x
    for l in range(DEPTH):
        h = h + hybrid_mixer(rms_norm(h, norm_mix_g[l]), w_in[l], q_latent_g[l], w_q_up[l],
                             kv_latent_g[l], w_kv_up[l], conv_w[l], conv_b[l],
                             conv_ln_g[l], conv_ln_b[l], w_mix_out[l])
        h = h + memory_cross_attention(rms_norm(h, norm_mem_g[l]), mem, mem_kv_norm_g[l],
                                       w_mem_q[l], w_mem_kv[l], w_mem_out[l])
        h = h + peer_channel_mixer(rms_norm(h, norm_ffn_g[l]), w_peer_query[l],
                                   peer_sub_keys[l], peer_u[l], peer_v[l])
    return rms_norm(h, final_norm_g)
```

```cpp
#include <hip/hip_runtime.h>
#include <cstdio>
#include <cstdint>

typedef unsigned short bf16;
#define DEVI __device__ __forceinline__

constexpr int D = 1024, BATCH = 2, SEQ = 8192, M = BATCH * SEQ;
constexpr int NMEM = 256;
constexpr int MH = 8, QRANK = 256, KVRANK = 128, NOPE = 64, ROPE = 32, VD = 64, QK = NOPE + ROPE;
constexpr int CW = 512, CK = 31;
constexpr int INC = QRANK + KVRANK + ROPE + 2 * CW;
constexpr int INP = 1536;
constexpr int XH = 4, XD = 256;
constexpr int PH = 8, PNK = 128, PHALF = 128, PTOP = 16, PE = PNK * PNK;
constexpr float EPS = 1e-6f;
constexpr float LOG2E = 1.4426950408889634f;
constexpr float PU_SCALE = 64.0f, PV_SCALE = 4.0f;

constexpr size_t MiB = 1u << 20;
constexpr size_t WS_CTL = 0;
constexpr size_t WS_WIN = 1 * MiB;
constexpr size_t WS_WQUP = 4 * MiB;
constexpr size_t WS_WKV = 5 * MiB;
constexpr size_t WS_WMIX = 6 * MiB;
constexpr size_t WS_WMQ = 8 * MiB;
constexpr size_t WS_WMKV = 10 * MiB;
constexpr size_t WS_WMO = 14 * MiB;
constexpr size_t WS_WPQ = 16 * MiB;
constexpr size_t WS_SK = 20 * MiB;
constexpr size_t WS_MEMN = 21 * MiB;
constexpr size_t WS_MEMKV = 22 * MiB;
constexpr size_t WS_PARTQ = 24 * MiB;
constexpr size_t WS_PARTKV = 24 * MiB + 512 * 1024;
constexpr size_t WS_PART1 = 25 * MiB;
constexpr size_t WS_PART2 = 26 * MiB;
constexpr size_t WS_PU = 28 * MiB;
constexpr size_t WS_PV = 60 * MiB;
constexpr size_t WS_R1 = 92 * MiB;
constexpr size_t WS_R2 = 124 * MiB;
constexpr size_t WS_R3 = 156 * MiB;
constexpr size_t WS_KQT = 220 * MiB;
constexpr size_t WS_VOT = 224 * MiB;
constexpr size_t WS_END = 228 * MiB;
constexpr size_t R2_CQ = 0, R2_CKV = 8 * MiB, R2_U = 12 * MiB;
constexpr size_t R2_EIDX = 0, R2_EGATE = 8 * MiB;
constexpr size_t R3_QB = 0, R3_KB = 24 * MiB, R3_VB = 48 * MiB;

DEVI bf16 f2bf(float f) { unsigned u = __builtin_bit_cast(unsigned, f); return (bf16)((u + 0x7fffu + ((u >> 16) & 1u)) >> 16); }
DEVI float bf2f(bf16 b) { return __builtin_bit_cast(float, (unsigned)b << 16); }
DEVI float dotbf(const bf16* a, const bf16* b, int K) {
    float s = 0.f;
    for (int k = 0; k < K; k += 8) {
        uint4 x = *(const uint4*)(a + k), y = *(const uint4*)(b + k);
        const unsigned xs[4] = {x.x, x.y, x.z, x.w}, ys[4] = {y.x, y.y, y.z, y.w};
#pragma unroll
        for (int i = 0; i < 4; ++i) {
            s += __builtin_bit_cast(float, xs[i] << 16) * __builtin_bit_cast(float, ys[i] << 16);
            s += __builtin_bit_cast(float, xs[i] & 0xffff0000u) * __builtin_bit_cast(float, ys[i] & 0xffff0000u);
        }
    }
    return s;
}
DEVI float wave_sum(float v) {
#pragma unroll
    for (int o = 1; o < 64; o <<= 1) v += __shfl_xor(v, o);
    return v;
}
DEVI float wave_max(float v) {
#pragma unroll
    for (int o = 1; o < 64; o <<= 1) v = fmaxf(v, __shfl_xor(v, o));
    return v;
}
DEVI void rope_cs(int pos, int i, float& c, float& s) {
    const float inv = exp2f(-(float)i * (13.287712379549449f / 16.0f));
    const float ang = (float)pos * inv;
    const double a = (double)ang; const double k = rint(a * 0.15915494309189535); const float r = (float)(a - k * 6.283185307179586);
    s = sinf(r); c = cosf(r);
}
DEVI int win_src(int r) {
    if (r < 416) return r;
    if (r < 512) return -1;
    const int t = (r - 512) >> 8, w = (r - 512) & 255, bj = w >> 7, j = w & 127, ch = 128 * t + j;
    return 416 + (bj ? CW : 0) + ch;
}
DEVI int wkv_src(int r) { return r < 512 ? (r >> 6) * 128 + (r & 63) : ((r - 512) >> 6) * 128 + 64 + ((r - 512) & 63); }

namespace pg8 {
#define PG8_LAS __attribute__((address_space(3)))
typedef unsigned short bf16_t;
typedef short bf16x8 __attribute__((ext_vector_type(8)));
typedef float f32x4 __attribute__((ext_vector_type(4)));
typedef unsigned u32x4 __attribute__((ext_vector_type(4)));
constexpr int BM = 256, BK = 64, HALF = 128, HTB = HALF * BK * 2  , STAGE_BYTES = 8 * HTB, NXCD = 8, WGM = 8;

__host__ __device__ __forceinline__ int lds_byte(int r, int c) { const int st = (r >> 4) * 2 + (c >> 5), rr = r & 15, cc = c & 31, ob = rr * 64 + cc * 2; return st * 1024 + (ob ^ (((ob >> 9) & 1) << 5)); }
__host__ __device__ __forceinline__ void stage_rc(int b, int& R, int& C) { const int st = b / 1024, sb = b % 1024, swz = sb ^ (((sb >> 9) & 1) << 5); R = (st >> 1) * 16 + swz / 64; C = (st & 1) * 32 + (swz % 64) / 2; }
__host__ __device__ __forceinline__ int perm32(int rho) { const int n = rho >> 4, i = rho & 15; return 8 * (i >> 2) + 4 * n + (i & 3); }

struct Unit { int pm, pn; };
struct Gemm { const bf16_t* A; const bf16_t* Bt; int M, N, K; int lda, ldb; int mb; size_t bstride; };

struct StaticOrder {
    int nM, nN, nwg, G, c;
    __host__ __device__ void init(int M, int N, int G_, int c_) { nM = M / BM; nN = N / BM; nwg = nM * nN; G = G_; c = c_; }
    __host__ __device__ bool next(int i, Unit& u) const {
        const long L = (long)i * G + c; if (L >= nwg) return false;
        int wgid = (int)L; { const int q = nwg / NXCD, r = nwg % NXCD, xcd = wgid % NXCD, off = wgid / NXCD; wgid = (xcd < r ? xcd * (q + 1) : r * (q + 1) + (xcd - r) * q) + off; }
        const int nig = WGM * nN, gid = wgid / nig, fm = gid * WGM, gsz = (nM - fm) < WGM ? (nM - fm) : WGM;
        u.pm = fm + ((wgid % nig) % gsz); u.pn = (wgid % nig) / gsz; return true;
    }
    __device__ __forceinline__ void a_ready(const Unit&) const {}
    __device__ __forceinline__ void done(const Unit&) const {}
};


typedef float f32x2 __attribute__((ext_vector_type(2)));
typedef unsigned u32x2 __attribute__((ext_vector_type(2)));
__device__ __forceinline__ unsigned cvt_pk_bf16(float lo, float hi) { unsigned r; asm volatile("v_cvt_pk_bf16_f32 %0, %1, %2" : "=v"(r) : "v"(lo), "v"(hi)); return r; }
__device__ __forceinline__ void st_bf4(bf16_t* p, f32x4 v) { u32x2 w; w.x = cvt_pk_bf16(v[0], v[1]); w.y = cvt_pk_bf16(v[2], v[3]); *(u32x2*)p = w; }
__device__ __forceinline__ float sq4(f32x4 v) { return (v[0] * v[0] + v[1] * v[1]) + (v[2] * v[2] + v[3] * v[3]); }
__device__ __forceinline__ float red_fq(float s) { s += __shfl_xor(s, 16); s += __shfl_xor(s, 32); return s; }

struct EpiProj {
    static constexpr bool PERM = false, AFTER_DRAIN = false;
    bf16_t *CQ, *CKV, *KB, *U; float *partq, *partkv; const float* trig;
    __device__ __forceinline__ void operator()(const f32x4 (&acc)[2][2][4][2], const Unit& u, int wr, int wc, int fr, int fq) const {
        const int row0 = u.pm * BM + wr * 64 + fr;
        if (u.pn == 0) {
#pragma unroll
            for (int ai = 0; ai < 2; ++ai)
#pragma unroll
                for (int m = 0; m < 4; ++m) { const int row = row0 + ai * HALF + m * 16; float s = 0.f;
#pragma unroll
                    for (int bj = 0; bj < 2; ++bj)
#pragma unroll
                        for (int n = 0; n < 2; ++n) { const f32x4 v = acc[ai][bj][m][n]; s += sq4(v); st_bf4(CQ + (size_t)row * 256 + bj * HALF + wc * 32 + n * 16 + fq * 4, v); }
                    s = red_fq(s); if (fq == 0) partq[(size_t)row * 4 + wc] = s; }
        } else if (u.pn == 1) {
            f32x4 tc0 = {0.f, 0.f, 0.f, 0.f}, tc1 = tc0, tn0 = tc0, tn1 = tc0;
            if (wc == 0) { const float* tp = trig + ((size_t)(row0 % SEQ) * 16 + fq * 4) * 2; tc0 = *(const f32x4*)tp; tc1 = *(const f32x4*)(tp + 4); }
#pragma unroll
            for (int i8 = 0; i8 < 8; ++i8) { const int ai = i8 >> 2, m = i8 & 3; const int row = row0 + ai * HALF + m * 16; float s = 0.f;
                if (wc == 0 && i8 < 7) { const int rown = row0 + ((i8 + 1) >> 2) * HALF + ((i8 + 1) & 3) * 16; const float* tp = trig + ((size_t)(rown % SEQ) * 16 + fq * 4) * 2; tn0 = *(const f32x4*)tp; tn1 = *(const f32x4*)(tp + 4); }
#pragma unroll
                for (int n = 0; n < 2; ++n) { const f32x4 v = acc[ai][0][m][n]; s += sq4(v); st_bf4(CKV + (size_t)row * 128 + wc * 32 + n * 16 + fq * 4, v); }
                s = red_fq(s); if (fq == 0) partkv[(size_t)row * 4 + wc] = s;
                if (wc == 0) { const f32x4 x1 = acc[ai][1][m][0], x2 = acc[ai][1][m][1]; const f32x4 t0 = tc0, t1 = tc1;
                    f32x4 o1, o2; o1[0] = x1[0] * t0[0] - x2[0] * t0[1]; o2[0] = x1[0] * t0[1] + x2[0] * t0[0]; o1[1] = x1[1] * t0[2] - x2[1] * t0[3]; o2[1] = x1[1] * t0[3] + x2[1] * t0[2];
                    o1[2] = x1[2] * t1[0] - x2[2] * t1[1]; o2[2] = x1[2] * t1[1] + x2[2] * t1[0]; o1[3] = x1[3] * t1[2] - x2[3] * t1[3]; o2[3] = x1[3] * t1[3] + x2[3] * t1[2];
                    u32x2 w1, w2; w1.x = cvt_pk_bf16(o1[0], o1[1]); w1.y = cvt_pk_bf16(o1[2], o1[3]); w2.x = cvt_pk_bf16(o2[0], o2[1]); w2.y = cvt_pk_bf16(o2[2], o2[3]);
#pragma unroll
                    for (int h = 0; h < 8; ++h) { *(u32x2*)(KB + (size_t)row * 768 + h * 96 + 64 + fq * 4) = w1; *(u32x2*)(KB + (size_t)row * 768 + h * 96 + 80 + fq * 4) = w2; } }
                tc0 = tn0; tc1 = tn1; asm volatile("" ::: "memory"); }
        } else {
            const int t = u.pn - 2;
#pragma unroll
            for (int ai = 0; ai < 2; ++ai)
#pragma unroll
                for (int m = 0; m < 4; ++m) { const int row = row0 + ai * HALF + m * 16;
#pragma unroll
                    for (int n = 0; n < 2; ++n) { const f32x4 val = acc[ai][0][m][n], gate = acc[ai][1][m][n]; f32x4 o;
#pragma unroll
                        for (int i = 0; i < 4; ++i) o[i] = val[i] * __builtin_amdgcn_rcpf(1.f + __expf(-gate[i]));
                        st_bf4(U + (size_t)row * 512 + t * 128 + wc * 32 + n * 16 + fq * 4, o); } }
        }
    }
};
struct EpiQ {
    static constexpr bool PERM = false, AFTER_DRAIN = false;
    bf16_t* QB; const float* partq; const float* trig; float c2;
    __device__ __forceinline__ void operator()(const f32x4 (&acc)[2][2][4][2], const Unit& u, int wr, int wc, int fr, int fq) const {
        const int row0 = u.pm * BM + wr * 64 + fr;
        const bool rope = ((u.pn * 8 + wc) % 3 == 2) || ((u.pn * 8 + 4 + wc) % 3 == 2);
        f32x4 ppc = *(const f32x4*)(partq + (size_t)row0 * 4), ppn = ppc;
        f32x4 tc0 = {0.f, 0.f, 0.f, 0.f}, tc1 = tc0, tn0 = tc0, tn1 = tc0;
        if (rope) { const float* tp = trig + ((size_t)(row0 % SEQ) * 16 + fq * 4) * 2; tc0 = *(const f32x4*)tp; tc1 = *(const f32x4*)(tp + 4); }
#pragma unroll
        for (int i8 = 0; i8 < 8; ++i8) { const int ai = i8 >> 2, m = i8 & 3; const int row = row0 + ai * HALF + m * 16;
            if (i8 < 7) { const int rown = row0 + ((i8 + 1) >> 2) * HALF + ((i8 + 1) & 3) * 16; ppn = *(const f32x4*)(partq + (size_t)rown * 4);
                if (rope) { const float* tp = trig + ((size_t)(rown % SEQ) * 16 + fq * 4) * 2; tn0 = *(const f32x4*)tp; tn1 = *(const f32x4*)(tp + 4); } }
            const float rs = rsqrtf(((ppc[0] + ppc[1]) + (ppc[2] + ppc[3])) * (1.f / 256.f) + EPS) * c2;
#pragma unroll
            for (int bj = 0; bj < 2; ++bj) { const int g = u.pn * 8 + bj * 4 + wc; bf16_t* dst = QB + (size_t)row * 768 + g * 32 + fq * 4;
                if (g % 3 != 2) { st_bf4(dst, acc[ai][bj][m][0] * rs); st_bf4(dst + 16, acc[ai][bj][m][1] * rs); }
                else { const f32x4 x1 = acc[ai][bj][m][0] * rs, x2 = acc[ai][bj][m][1] * rs; const f32x4 t0 = tc0, t1 = tc1;
                    f32x4 o1, o2; o1[0] = x1[0] * t0[0] - x2[0] * t0[1]; o2[0] = x1[0] * t0[1] + x2[0] * t0[0]; o1[1] = x1[1] * t0[2] - x2[1] * t0[3]; o2[1] = x1[1] * t0[3] + x2[1] * t0[2];
                    o1[2] = x1[2] * t1[0] - x2[2] * t1[1]; o2[2] = x1[2] * t1[1] + x2[2] * t1[0]; o1[3] = x1[3] * t1[2] - x2[3] * t1[3]; o2[3] = x1[3] * t1[3] + x2[3] * t1[2];
                    st_bf4(dst, o1); st_bf4(dst + 16, o2); } }
            ppc = ppn; tc0 = tn0; tc1 = tn1; asm volatile("" ::: "memory"); }
    }
};
struct EpiKV {
    static constexpr bool PERM = false, AFTER_DRAIN = false;
    bf16_t *KB, *VB; const float* partkv;
    __device__ __forceinline__ void operator()(const f32x4 (&acc)[2][2][4][2], const Unit& u, int wr, int wc, int fr, int fq) const {
        const int row0 = u.pm * BM + wr * 64 + fr;
        f32x4 ppc = *(const f32x4*)(partkv + (size_t)row0 * 4), ppn = ppc;
#pragma unroll
        for (int i8 = 0; i8 < 8; ++i8) { const int ai = i8 >> 2, m = i8 & 3; const int row = row0 + ai * HALF + m * 16;
            if (i8 < 7) { const int rown = row0 + ((i8 + 1) >> 2) * HALF + ((i8 + 1) & 3) * 16; ppn = *(const f32x4*)(partkv + (size_t)rown * 4); }
            const float rs = rsqrtf(((ppc[0] + ppc[1]) + (ppc[2] + ppc[3])) * (1.f / 128.f) + EPS);
#pragma unroll
            for (int bj = 0; bj < 2; ++bj)
#pragma unroll
                for (int n = 0; n < 2; ++n) { const int c = u.pn * BM + bj * HALF + wc * 32 + n * 16 + fq * 4; const f32x4 v = acc[ai][bj][m][n] * rs;
                    if (u.pn < 2) st_bf4(KB + (size_t)row * 768 + (c >> 6) * 96 + (c & 63), v); else st_bf4(VB + (size_t)row * 512 + (c - 512), v); }
            ppc = ppn; asm volatile("" ::: "memory"); }
    }
};
template <bool BF16RES> struct EpiRes {
    static constexpr bool PERM = false, AFTER_DRAIN = false;
    const float* res; const bf16_t* resb; bf16_t* outb; float* part;
    __device__ __forceinline__ f32x4 ldres(size_t off) const {
        if (BF16RES) { const u32x2 rb = *(const u32x2*)(resb + off); f32x4 r; r[0] = __builtin_bit_cast(float, rb.x << 16); r[1] = __builtin_bit_cast(float, rb.x & 0xffff0000u); r[2] = __builtin_bit_cast(float, rb.y << 16); r[3] = __builtin_bit_cast(float, rb.y & 0xffff0000u); return r; }
        return *(const f32x4*)(res + off); }
    __device__ __forceinline__ void operator()(const f32x4 (&acc)[2][2][4][2], const Unit& u, int wr, int wc, int fr, int fq) const {
        const int row0 = u.pm * BM + wr * 64 + fr; const int cb = u.pn * BM + wc * 32 + fq * 4;
        f32x4 rc[4], rn[4];
#pragma unroll
        for (int j = 0; j < 4; ++j) { rc[j] = ldres((size_t)row0 * 1024 + cb + (j >> 1) * HALF + (j & 1) * 16); rn[j] = rc[j]; }
#pragma unroll
        for (int i8 = 0; i8 < 8; ++i8) { const int ai = i8 >> 2, m = i8 & 3; const int row = row0 + ai * HALF + m * 16; float s = 0.f;
            if (i8 < 7) { const int rown = row0 + ((i8 + 1) >> 2) * HALF + ((i8 + 1) & 3) * 16;
#pragma unroll
                for (int j = 0; j < 4; ++j) rn[j] = ldres((size_t)rown * 1024 + cb + (j >> 1) * HALF + (j & 1) * 16); }
#pragma unroll
            for (int bj = 0; bj < 2; ++bj)
#pragma unroll
                for (int n = 0; n < 2; ++n) { const size_t off = (size_t)row * 1024 + cb + bj * HALF + n * 16;
                    const f32x4 v = acc[ai][bj][m][n] + rc[bj * 2 + n]; st_bf4(outb + off, v); s += sq4(v); }
            s = red_fq(s); if (fq == 0) part[(size_t)row * 16 + u.pn * 4 + wc] = s;
#pragma unroll
            for (int j = 0; j < 4; ++j) rc[j] = rn[j];
            asm volatile("" ::: "memory"); }
    }
};
struct EpiScaled {
    static constexpr bool PERM = false, AFTER_DRAIN = false;
    bf16_t* out; int ldc; const float* part; float mul;
    __device__ __forceinline__ void operator()(const f32x4 (&acc)[2][2][4][2], const Unit& u, int wr, int wc, int fr, int fq) const {
        const int row0 = u.pm * BM + wr * 64 + fr;
        float rs8[8];
#pragma unroll
        for (int hb = 0; hb < 2; ++hb) { f32x4 q[4][4];
#pragma unroll
            for (int k = 0; k < 4; ++k) { const int row = row0 + hb * HALF + k * 16; const f32x4* pp = (const f32x4*)(part + (size_t)row * 16);
#pragma unroll
                for (int j = 0; j < 4; ++j) q[k][j] = pp[j]; }
#pragma unroll
            for (int k = 0; k < 4; ++k) { const f32x4 a = q[k][0], b = q[k][1], c = q[k][2], d = q[k][3];
                const float ss = (((a[0] + a[1]) + (a[2] + a[3])) + ((b[0] + b[1]) + (b[2] + b[3]))) + (((c[0] + c[1]) + (c[2] + c[3])) + ((d[0] + d[1]) + (d[2] + d[3])));
                rs8[hb * 4 + k] = rsqrtf(ss * (1.f / 1024.f) + EPS) * mul; } }
#pragma unroll
        for (int i8 = 0; i8 < 8; ++i8) { const int ai = i8 >> 2, m = i8 & 3; const int row = row0 + ai * HALF + m * 16; const float rs = rs8[i8];
#pragma unroll
            for (int bj = 0; bj < 2; ++bj)
#pragma unroll
                for (int n = 0; n < 2; ++n) st_bf4(out + (size_t)row * ldc + u.pn * BM + bj * HALF + wc * 32 + n * 16 + fq * 4, acc[ai][bj][m][n] * rs);
            asm volatile("" ::: "memory"); }
    }
};
struct EpiSoftmaxP {
    static constexpr bool PERM = false, AFTER_DRAIN = false;
    bf16_t* out; int ldc; const float* part; float mul; PG8_LAS float* scr;
    __device__ __forceinline__ float rscale(int row) const { const f32x4* pp = (const f32x4*)(part + (size_t)row * 16); const f32x4 a = pp[0], b = pp[1], c = pp[2], d = pp[3];
        const float ss = (((a[0] + a[1]) + (a[2] + a[3])) + ((b[0] + b[1]) + (b[2] + b[3]))) + (((c[0] + c[1]) + (c[2] + c[3])) + ((d[0] + d[1]) + (d[2] + d[3]))); return rsqrtf(ss * (1.f / 1024.f) + EPS) * mul; }
    __device__ __forceinline__ void operator()(const f32x4 (&acc)[2][2][4][2], const Unit& u, int wr, int wc, int fr, int fq) const {
        PG8_LAS float* P1 = scr; PG8_LAS float* P2 = scr + 1024; float rs8[8];
#define EPS_BAR() do { asm volatile("s_waitcnt lgkmcnt(0)" ::: "memory"); __builtin_amdgcn_s_barrier(); asm volatile("" ::: "memory"); } while (0)
#pragma unroll
        for (int ai = 0; ai < 2; ++ai)
#pragma unroll
            for (int m = 0; m < 4; ++m) { float mx = -3.0e38f;
#pragma unroll
                for (int bj = 0; bj < 2; ++bj)
#pragma unroll
                    for (int n = 0; n < 2; ++n) { const f32x4 v = acc[ai][bj][m][n]; mx = fmaxf(mx, fmaxf(fmaxf(v[0], v[1]), fmaxf(v[2], v[3]))); }
                mx = fmaxf(mx, __shfl_xor(mx, 16)); mx = fmaxf(mx, __shfl_xor(mx, 32));
                if (fq == 0) P1[(ai * HALF + wr * 64 + m * 16 + fr) * 4 + wc] = mx; }
        EPS_BAR();
#pragma unroll
        for (int ai = 0; ai < 2; ++ai)
#pragma unroll
            for (int m = 0; m < 4; ++m) { const int rl = ai * HALF + wr * 64 + m * 16 + fr; const f32x4 q = *(const PG8_LAS f32x4*)(P1 + rl * 4);
                const float mx = fmaxf(fmaxf(q[0], q[1]), fmaxf(q[2], q[3])), rs = rscale(u.pm * BM + rl); float sm = 0.f; rs8[ai * 4 + m] = rs;
#pragma unroll
                for (int bj = 0; bj < 2; ++bj)
#pragma unroll
                    for (int n = 0; n < 2; ++n) { const f32x4 v = acc[ai][bj][m][n];
#pragma unroll
                        for (int i = 0; i < 4; ++i) sm += __builtin_amdgcn_exp2f((v[i] - mx) * rs); }
                sm += __shfl_xor(sm, 16); sm += __shfl_xor(sm, 32);
                if (fq == 0) P2[rl * 4 + wc] = sm; asm volatile("" ::: "memory"); }
        EPS_BAR();
#pragma unroll
        for (int ai = 0; ai < 2; ++ai)
#pragma unroll
            for (int m = 0; m < 4; ++m) { const int rl = ai * HALF + wr * 64 + m * 16 + fr; const f32x4 q = *(const PG8_LAS f32x4*)(P1 + rl * 4), w = *(const PG8_LAS f32x4*)(P2 + rl * 4);
                const float mx = fmaxf(fmaxf(q[0], q[1]), fmaxf(q[2], q[3])), rs = rs8[ai * 4 + m], inv = 1.0f / ((w[0] + w[1]) + (w[2] + w[3]));
#pragma unroll
                for (int bj = 0; bj < 2; ++bj)
#pragma unroll
                    for (int n = 0; n < 2; ++n) { const f32x4 v = acc[ai][bj][m][n]; f32x4 o;
#pragma unroll
                        for (int i = 0; i < 4; ++i) o[i] = __builtin_amdgcn_exp2f((v[i] - mx) * rs) * inv;
                        st_bf4(out + (size_t)(u.pm * BM + rl) * ldc + u.pn * BM + bj * HALF + wc * 32 + n * 16 + fq * 4, o); }
                asm volatile("" ::: "memory"); }
        EPS_BAR();
#undef EPS_BAR
    }
};
struct EpiPlain {
    static constexpr bool PERM = false, AFTER_DRAIN = false;
    bf16_t* out; int ldc;
    __device__ __forceinline__ void operator()(const f32x4 (&acc)[2][2][4][2], const Unit& u, int wr, int wc, int fr, int fq) const {
        const int row0 = u.pm * BM + wr * 64 + fr;
#pragma unroll
        for (int ai = 0; ai < 2; ++ai)
#pragma unroll
            for (int m = 0; m < 4; ++m) { const int row = row0 + ai * HALF + m * 16;
#pragma unroll
                for (int bj = 0; bj < 2; ++bj)
#pragma unroll
                    for (int n = 0; n < 2; ++n) st_bf4(out + (size_t)row * ldc + u.pn * BM + bj * HALF + wc * 32 + n * 16 + fq * 4, acc[ai][bj][m][n]); }
    }
};
template <class Epi, class Sched, bool ALIGN_EPI = false, bool SP2 = false>
__device__ __forceinline__ void gemm_phase(PG8_LAS unsigned char* lds, const Gemm g, const Sched& S, const Epi& E) {
    int tid_ = threadIdx.x; asm volatile("" : "+v"(tid_));
    const int tid = tid_, wid = __builtin_amdgcn_readfirstlane(tid >> 6), lane = tid & 63, wr = wid >> 2, wc = wid & 3, fr = lane & 15, fq = lane >> 4;
    const int K = g.K, nt = K / BK, lda = g.lda ? g.lda : K, ldb = g.ldb ? g.ldb : K;
#define PG8_BOFF(pm_) (g.mb ? (size_t)((pm_) / g.mb) * g.bstride : (size_t)0)
    unsigned voffA[2], voffB[2];
#pragma unroll
    for (int i = 0; i < 2; ++i) { int R, C; stage_rc(tid * 16 + i * 8192, R, C); const int Rb = Epi::PERM ? ((R & ~31) + perm32(R & 31)) : R;
        voffA[i] = (unsigned)(R * lda + C) * 2u; voffB[i] = (unsigned)(Rb * ldb + C) * 2u; }
    const size_t kstep = (size_t)(BK * 2);
    const size_t hstepA = (size_t)HALF * lda * 2, hstepB = (size_t)HALF * ldb * 2;
    const size_t tstepA = 2 * hstepA, tstepB = 2 * hstepB;
    const unsigned ldsw = (unsigned)wid * 1024u;
    const int aoff = lds_byte(wr * 64 + fr, fq * 8), boff = lds_byte(wc * 32 + fr, fq * 8);
#define PG8_SA(b, h) (((b) * 2 + (h)) * HTB)
#define PG8_SB(b, h) ((4 + (b) * 2 + (h)) * HTB)
#define PG8_STAGE(bufoff, gbase, voff) do { _Pragma("unroll") for (int _i = 0; _i < 2; ++_i) \
        __builtin_amdgcn_global_load_lds((const unsigned*)((const char*)(gbase) + (voff)[_i]), (PG8_LAS unsigned*)(lds + (bufoff) + ldsw + _i * 8192), 16, 0, 0); } while (0)
#define PG8_LDA(dst, b, h) do { _Pragma("unroll") for (int m = 0; m < 4; ++m) _Pragma("unroll") for (int k = 0; k < 2; ++k) dst[m][k] = *(const PG8_LAS bf16x8*)(lds + PG8_SA(b, h) + aoff + m * 2048 + k * 1024); } while (0)
#define PG8_LDB(dst, b, h) do { _Pragma("unroll") for (int n = 0; n < 2; ++n) _Pragma("unroll") for (int k = 0; k < 2; ++k) dst[n][k] = *(const PG8_LAS bf16x8*)(lds + PG8_SB(b, h) + boff + n * 2048 + k * 1024); } while (0)
#define PG8_MMA(ai, bj, At, Bt) do { __builtin_amdgcn_s_setprio(1); _Pragma("unroll") for (int m = 0; m < 4; ++m) _Pragma("unroll") for (int n = 0; n < 2; ++n) _Pragma("unroll") for (int k = 0; k < 2; ++k) \
        acc[ai][bj][m][n] = __builtin_amdgcn_mfma_f32_16x16x32_bf16(Bt[n][k], At[m][k], acc[ai][bj][m][n], 0, 0, 0); __builtin_amdgcn_s_setprio(0); } while (0)
#define PG8_WAIT_V(n) asm volatile("s_waitcnt vmcnt(" #n ")" ::: "memory")
#define PG8_WAIT_L(n) asm volatile("s_waitcnt lgkmcnt(" #n ")" ::: "memory")
#define PG8_BAR __builtin_amdgcn_s_barrier()
#define PG8_SCHED __builtin_amdgcn_sched_barrier(0)
    Unit cur, nxt; int ui = 0;
    if (!S.next(0, cur)) return;
    f32x4 acc[2][2][4][2];
#pragma unroll
    for (int a = 0; a < 2; ++a)
#pragma unroll
        for (int b = 0; b < 2; ++b)
#pragma unroll
            for (int m = 0; m < 4; ++m)
#pragma unroll
                for (int n = 0; n < 2; ++n) acc[a][b][m][n] = (f32x4){0.f, 0.f, 0.f, 0.f};
    bf16x8 At[4][2], B0[2][2], B1[2][2];
    const char* cA = (const char*)g.A + (size_t)cur.pm * tstepA; const char* cB = (const char*)g.Bt + (size_t)cur.pn * tstepB + PG8_BOFF(cur.pm);
    S.a_ready(cur);
    if constexpr (SP2) {
        PG8_STAGE(PG8_SB(0, 0), cB, voffB); PG8_STAGE(PG8_SB(0, 1), cB + hstepB, voffB); PG8_STAGE(PG8_SA(0, 0), cA, voffA); PG8_STAGE(PG8_SA(0, 1), cA + hstepA, voffA);
        if (wr == 1) PG8_BAR;
        PG8_WAIT_V(2); PG8_BAR;
        PG8_STAGE(PG8_SB(1, 0), cB + kstep, voffB); PG8_STAGE(PG8_SA(1, 0), cA + kstep, voffA); PG8_STAGE(PG8_SB(1, 1), cB + hstepB + kstep, voffB);
        PG8_WAIT_V(6); PG8_BAR;
    } else {
        PG8_STAGE(PG8_SB(0, 0), cB, voffB); PG8_STAGE(PG8_SA(0, 0), cA, voffA); PG8_STAGE(PG8_SB(0, 1), cB + hstepB, voffB); PG8_STAGE(PG8_SA(0, 1), cA + hstepA, voffA);
        if (wr == 1) PG8_BAR;
        PG8_WAIT_V(4); PG8_BAR;
        PG8_STAGE(PG8_SB(1, 0), cB + kstep, voffB); PG8_STAGE(PG8_SA(1, 0), cA + kstep, voffA); PG8_STAGE(PG8_SB(1, 1), cB + hstepB + kstep, voffB);
        PG8_WAIT_V(6); PG8_BAR;
    }
    for (;;) {
        const bool has_next = S.next(ui + 1, nxt);
        const char* nA = has_next ? (const char*)g.A + (size_t)nxt.pm * tstepA : cA; const char* nB = has_next ? (const char*)g.Bt + (size_t)nxt.pn * tstepB + PG8_BOFF(nxt.pm) : cB;
        for (int t = 0; t < nt; t += 2) {
            const bool last = (t == nt - 2);
            const char* a1 = cA + (size_t)(t + 1) * kstep;
            const char* a2 = last ? nA : cA + (size_t)(t + 2) * kstep; const char* b2 = last ? nB : cB + (size_t)(t + 2) * kstep;
            const char* a3 = a2 + kstep; const char* b3 = b2 + kstep;
            if (last && has_next) S.a_ready(nxt);
            if constexpr (SP2) {
            PG8_LDB(B0, 0, 0); PG8_LDB(B1, 0, 1); PG8_SCHED; PG8_LDA(At, 0, 0); PG8_STAGE(PG8_SA(1, 1), a1 + hstepA, voffA);
            PG8_WAIT_V(8); PG8_WAIT_L(0); PG8_BAR; PG8_MMA(0, 0, At, B0); PG8_MMA(0, 1, At, B1); PG8_BAR; PG8_SCHED;
            PG8_LDA(At, 0, 1); PG8_STAGE(PG8_SB(0, 0), b2, voffB); PG8_STAGE(PG8_SB(0, 1), b2 + hstepB, voffB); PG8_STAGE(PG8_SA(0, 0), a2, voffA);
            PG8_WAIT_V(8); PG8_WAIT_L(0); PG8_BAR; PG8_MMA(1, 0, At, B0); PG8_MMA(1, 1, At, B1); PG8_BAR; PG8_SCHED;
            PG8_LDB(B0, 1, 0); PG8_LDB(B1, 1, 1); PG8_SCHED; PG8_LDA(At, 1, 0); PG8_STAGE(PG8_SA(0, 1), a2 + hstepA, voffA);
            PG8_WAIT_V(8); PG8_WAIT_L(0); PG8_BAR; PG8_MMA(0, 0, At, B0); PG8_MMA(0, 1, At, B1); PG8_BAR; PG8_SCHED;
            PG8_LDA(At, 1, 1); PG8_STAGE(PG8_SB(1, 0), b3, voffB); PG8_STAGE(PG8_SB(1, 1), b3 + hstepB, voffB); PG8_STAGE(PG8_SA(1, 0), a3, voffA);
            PG8_WAIT_V(8); PG8_WAIT_L(0); PG8_BAR; PG8_MMA(1, 0, At, B0); PG8_MMA(1, 1, At, B1); PG8_BAR; PG8_SCHED;
            } else {
            PG8_LDB(B0, 0, 0); PG8_SCHED; PG8_LDA(At, 0, 0); PG8_STAGE(PG8_SA(1, 1), a1 + hstepA, voffA);
            PG8_WAIT_L(8); PG8_BAR; PG8_WAIT_L(0); PG8_MMA(0, 0, At, B0); PG8_BAR; PG8_SCHED;
            PG8_LDB(B1, 0, 1); PG8_STAGE(PG8_SB(0, 0), b2, voffB);
            PG8_BAR; PG8_WAIT_L(0); PG8_MMA(0, 1, At, B1); PG8_BAR;
            PG8_LDA(At, 0, 1); PG8_STAGE(PG8_SA(0, 0), a2, voffA);
            PG8_BAR; PG8_WAIT_L(0); PG8_MMA(1, 0, At, B0); PG8_BAR; PG8_SCHED;
            PG8_STAGE(PG8_SB(0, 1), b2 + hstepB, voffB);
            PG8_WAIT_V(6); PG8_BAR; PG8_MMA(1, 1, At, B1); PG8_BAR;
            PG8_LDB(B0, 1, 0); PG8_SCHED; PG8_LDA(At, 1, 0); PG8_STAGE(PG8_SA(0, 1), a2 + hstepA, voffA);
            PG8_WAIT_L(8); PG8_BAR; PG8_WAIT_L(0); PG8_MMA(0, 0, At, B0); PG8_BAR; PG8_SCHED;
            PG8_LDB(B1, 1, 1); PG8_STAGE(PG8_SB(1, 0), b3, voffB);
            PG8_BAR; PG8_WAIT_L(0); PG8_MMA(0, 1, At, B1); PG8_BAR;
            PG8_LDA(At, 1, 1); PG8_STAGE(PG8_SA(1, 0), a3, voffA);
            PG8_BAR; PG8_WAIT_L(0); PG8_MMA(1, 0, At, B0); PG8_BAR; PG8_SCHED;
            PG8_STAGE(PG8_SB(1, 1), b3 + hstepB, voffB);
            PG8_WAIT_V(6); PG8_BAR; PG8_MMA(1, 1, At, B1); PG8_BAR;
            }
        }
        if constexpr (ALIGN_EPI) { if (wr == 0) PG8_BAR; }
        if constexpr (!Epi::AFTER_DRAIN) { E(acc, cur, wr, wc, fr, fq); S.done(cur); }
        if (!has_next) break;
#pragma unroll
        for (int a = 0; a < 2; ++a)
#pragma unroll
            for (int b = 0; b < 2; ++b)
#pragma unroll
                for (int m = 0; m < 4; ++m)
#pragma unroll
                    for (int n = 0; n < 2; ++n) acc[a][b][m][n] = (f32x4){0.f, 0.f, 0.f, 0.f};
        cur = nxt; cA = nA; cB = nB; ++ui;
        if constexpr (ALIGN_EPI) { if (wr == 1) PG8_BAR; }
    }
    PG8_WAIT_V(0);
    if constexpr (!ALIGN_EPI) { if (wr == 0) PG8_BAR; }
    PG8_BAR;
    if constexpr (Epi::AFTER_DRAIN) { E.fused(acc, cur, wr, wc, fr, fq, lds, wid, lane); S.done(cur); }
#undef PG8_BOFF
#undef PG8_SA
#undef PG8_SB
#undef PG8_STAGE
#undef PG8_LDA
#undef PG8_LDB
#undef PG8_MMA
#undef PG8_WAIT_V
#undef PG8_WAIT_L
#undef PG8_BAR
#undef PG8_SCHED
}
}

#define GAS __attribute__((address_space(1)))
#define LAS __attribute__((address_space(3)))
typedef GAS unsigned gu32;
#define LDS_WAIT() asm volatile("s_waitcnt lgkmcnt(0)" ::: "memory")
#define VM_WAIT() asm volatile("s_waitcnt vmcnt(0)" ::: "memory")
constexpr int NWAVES = 8, NTHR = NWAVES * 64;
constexpr int LDSCTL_OFF = 0, PH_BASE = 512, LDS_BYTES = 147456;
constexpr int CW_BAR = 4096;
constexpr size_t CTL_ZERO_BYTES = 256 * 1024;
constexpr size_t WS_TRIG = 27 * MiB;
#define XB_TMO      128
#define XB_XCNT(j)  (256  + 64 * (j))
#define XB_XSUB(j)  (1280 + 64 * (j))
#define XB_XGEN(j)  (2304 + 64 * (j))
#define XB_TOP      3328
#define XB_TOPGEN   3392
#define XCD_BAR_WORDS 3456
#define XB_SPIN_CAP (1u << 18)

__device__ __forceinline__ unsigned xb_ld(unsigned* p)              { return __hip_atomic_load(p, __ATOMIC_RELAXED, __HIP_MEMORY_SCOPE_AGENT); }
__device__ __forceinline__ unsigned xb_add(unsigned* p, unsigned v) { return __hip_atomic_fetch_add(p, v, __ATOMIC_RELAXED, __HIP_MEMORY_SCOPE_AGENT); }
__device__ __forceinline__ unsigned xb_xcc_id() { return (unsigned)__builtin_amdgcn_s_getreg((3 << 11) | 20) & 0xFu; }
#define XB_SPIN(cond, bar) do { unsigned _sp = 0; while (cond) { __builtin_amdgcn_s_sleep(1); \
    if ((++_sp & 255u) == 0u) { if (xb_ld(&(bar)[XB_TMO])) break; if (_sp > XB_SPIN_CAP) { atomicAdd(&(bar)[XB_TMO], 1u); break; } } } } while (0)

struct XcdBarrier {
    unsigned* bar; unsigned x;
    volatile LAS unsigned* st;
};

__device__ __forceinline__ XcdBarrier xcd_barrier_post(unsigned* bar, volatile LAS unsigned* st) {
    XcdBarrier b; b.bar = bar; b.x = xb_xcc_id(); b.st = st;
    if (threadIdx.x == 0) (void)xb_add(&bar[XB_XCNT(b.x)], 1u);
    return b;
}
__device__ __forceinline__ void xcd_barrier_complete(unsigned* bar, unsigned x, unsigned& nloc, unsigned& nx) {
    const unsigned G = gridDim.x * gridDim.y * gridDim.z;
    unsigned sum, cnt, mine, sp = 0u;
    for (;;) {
        sum = 0u; cnt = 0u; mine = 0u;
#pragma unroll
        for (unsigned j = 0; j < 16; ++j) { const unsigned c = xb_ld(&bar[XB_XCNT(j)]); sum += c; cnt += (c > 0u) ? 1u : 0u; mine = (j == x) ? c : mine; }
        if (sum == G) break;
        __builtin_amdgcn_s_sleep(1);
        if ((++sp & 255u) == 0u) { if (xb_ld(&bar[XB_TMO])) break; if (sp > XB_SPIN_CAP) { atomicAdd(&bar[XB_TMO], 1u); break; } }
    }
    nloc = mine > 0u ? mine : 1u; nx = cnt > 0u ? cnt : 1u;
}

__device__ __forceinline__ void xcd_barrier(const XcdBarrier& b) {
    asm volatile("s_waitcnt vmcnt(0)" ::: "memory");
    __syncthreads();
    if (threadIdx.x == 0) {
        unsigned* bar = b.bar;
        __builtin_amdgcn_s_waitcnt(0);
        unsigned nloc = b.st[0], nx = b.st[1];
        if (nloc == 0u) { xcd_barrier_complete(bar, b.x, nloc, nx); b.st[0] = nloc; b.st[1] = nx; }
        const unsigned old = xb_add(&bar[XB_XSUB(b.x)], 1u);
        const unsigned gen = old / nloc;
        if (old + 1u == (gen + 1u) * nloc) {
            __builtin_amdgcn_fence(__ATOMIC_RELEASE, "agent");
            asm volatile("s_waitcnt vmcnt(0)" ::: "memory");
            const unsigned og = xb_add(&bar[XB_TOP], 1u);
            const unsigned tg = og / nx;
            if (og + 1u == (tg + 1u) * nx) xb_add(&bar[XB_TOPGEN], 1u);
            else XB_SPIN(xb_ld(&bar[XB_TOPGEN]) == tg, bar);
            __builtin_amdgcn_fence(__ATOMIC_ACQUIRE, "agent");
            xb_add(&bar[XB_XGEN(b.x)], 1u);
            asm volatile("s_waitcnt vmcnt(0)" ::: "memory");
        } else {
            XB_SPIN(xb_ld(&bar[XB_XGEN(b.x)]) == gen, bar);
            __builtin_amdgcn_fence(__ATOMIC_ACQUIRE, "agent");
            asm volatile("s_waitcnt vmcnt(0)" ::: "memory");
        }
    }
    __syncthreads();
}

enum { PH_PRO = 0, PH_PROJ, PH_UP, PH_ATTN, PH_MIX, PH_MEMQ, PH_XATTN, PH_MEMO, PH_PQ, PH_TOPK, PH_EXP, PH_N, PHB_CONV = 16, PHB_UPG = 17 };
struct Args { const float* in[24]; float* out; unsigned char* ws; unsigned mask; unsigned li; };

DEVI int src_col(int mode, int r) { return mode == 0 ? r : mode == 1 ? win_src(r) : wkv_src(r); }
template <int MODE, bool HASG> DEVI void p0_transpose_item(const float* W, int K, int N, bf16* WT, int NR, const float* gk, LAS float* scr, int item, int lane) {
    const int nb_ = NR / 32, kb = item / nb_, nb = item % nb_, k0 = 64 * kb, n0 = 32 * nb;
    const int sc = src_col(MODE, n0 + (lane & 31)), scc = sc < 0 ? 0 : sc; const float keep = sc < 0 ? 0.f : 1.f;
    float v[32];
#pragma unroll
    for (int i = 0; i < 32; ++i) { const int kk = 2 * i + (lane >> 5); v[i] = W[(size_t)(k0 + kk) * N + scc]; }
    if (HASG) {
#pragma unroll
        for (int i = 0; i < 32; ++i) { const int kk = 2 * i + (lane >> 5); v[i] *= gk[k0 + kk]; } }
#pragma unroll
    for (int i = 0; i < 32; ++i) { const int kk = 2 * i + (lane >> 5); scr[kk * 33 + (lane & 31)] = MODE == 0 ? v[i] : v[i] * keep; }
    LDS_WAIT(); asm volatile("" ::: "memory");
    const int c = lane & 7;
#pragma unroll
    for (int j = 0; j < 4; ++j) { const int n = (lane >> 3) + 8 * j; const LAS float* s = scr + (8 * c) * 33 + n;
        uint4 o; o.x = pg8::cvt_pk_bf16(s[0 * 33], s[1 * 33]); o.y = pg8::cvt_pk_bf16(s[2 * 33], s[3 * 33]); o.z = pg8::cvt_pk_bf16(s[4 * 33], s[5 * 33]); o.w = pg8::cvt_pk_bf16(s[6 * 33], s[7 * 33]);
        *(uint4*)(WT + (size_t)(n0 + n) * K + k0 + 8 * c) = o; }
    LDS_WAIT(); asm volatile("" ::: "memory");
}
DEVI void rms_row_to_bf16(const float* xrow, const float* g, bf16* orow, int lane) {
    const float4* xr = (const float4*)xrow + lane; const float4* gr = (const float4*)g + lane;
    float4 v[4]; float s = 0.f;
#pragma unroll
    for (int j = 0; j < 4; ++j) { v[j] = xr[64 * j]; s += (v[j].x * v[j].x + v[j].y * v[j].y) + (v[j].z * v[j].z + v[j].w * v[j].w); }
    const float r = rsqrtf(wave_sum(s) * (1.f / D) + EPS);
    uint2* o8 = (uint2*)orow + lane;
#pragma unroll
    for (int j = 0; j < 4; ++j) { const float4 gg = gr[64 * j]; uint2 o; o.x = pg8::cvt_pk_bf16(v[j].x * r * gg.x, v[j].y * r * gg.y); o.y = pg8::cvt_pk_bf16(v[j].z * r * gg.z, v[j].w * r * gg.w); o8[64 * j] = o; }
}
DEVI void rms_rows4_to_bf16(const float* x, const float* g, bf16* out, int m0, int step, int mend, int lane) {
    float4 v[4][4]; float s[4];
#pragma unroll
    for (int r = 0; r < 4; ++r) { const int m = m0 + r * step; const float4* xr = (const float4*)(x + (size_t)(m < mend ? m : m0) * D) + lane;
#pragma unroll
        for (int j = 0; j < 4; ++j) v[r][j] = xr[64 * j]; }
#pragma unroll
    for (int r = 0; r < 4; ++r) { float t = 0.f;
#pragma unroll
        for (int j = 0; j < 4; ++j) t += (v[r][j].x * v[r][j].x + v[r][j].y * v[r][j].y) + (v[r][j].z * v[r][j].z + v[r][j].w * v[r][j].w);
        s[r] = t; }
#pragma unroll
    for (int o = 1; o < 64; o <<= 1) {
#pragma unroll
        for (int r = 0; r < 4; ++r) s[r] += __shfl_xor(s[r], o); }
    const float4* gr = (const float4*)g + lane;
#pragma unroll
    for (int r = 0; r < 4; ++r) { const int m = m0 + r * step; if (m < mend) { const float rs = rsqrtf(s[r] * (1.f / D) + EPS); uint2* o8 = (uint2*)(out + (size_t)m * D) + lane;
#pragma unroll
        for (int j = 0; j < 4; ++j) { const float4 gg = gr[64 * j]; uint2 o; o.x = pg8::cvt_pk_bf16(v[r][j].x * rs * gg.x, v[r][j].y * rs * gg.y); o.y = pg8::cvt_pk_bf16(v[r][j].z * rs * gg.z, v[r][j].w * rs * gg.w); o8[64 * j] = o; } } }
}
DEVI void cvt_stream_fp8(const float* src, unsigned char* dst, size_t n16, const float* g, float mul, size_t gtid, size_t gn) {
    for (size_t i = gtid; i < n16; i += gn) { pg8::u32x4 o;
#pragma unroll
        for (int q = 0; q < 4; ++q) { float4 a = *(const float4*)(src + i * 16 + q * 4); if (g) { const float4 gg = *(const float4*)(g + ((i * 16 + q * 4) & (D - 1))); a.x *= gg.x; a.y *= gg.y; a.z *= gg.z; a.w *= gg.w; }
            int p = __builtin_amdgcn_cvt_pk_fp8_f32(a.x * mul, a.y * mul, 0, false); p = __builtin_amdgcn_cvt_pk_fp8_f32(a.z * mul, a.w * mul, p, true); o[q] = (unsigned)p; }
        *(pg8::u32x4*)(dst + i * 16) = o; }
}
typedef unsigned v6u_t __attribute__((ext_vector_type(6)));
typedef float f32x2_t __attribute__((ext_vector_type(2)));
typedef float v16f_t __attribute__((ext_vector_type(16)));
typedef float v32f_t __attribute__((ext_vector_type(32)));
typedef __bf16 v32bf_t __attribute__((ext_vector_type(32)));
#ifndef FP6_INTERLEAVED
#define FP6_INTERLEAVED 0
#endif
template <bool HASG> DEVI void cvt_rows_fp6(const float* src, unsigned char* dst, const float* g, float mul, size_t gtid, size_t gn) {
    const int grp = (int)(gtid & 31);
    float4 gg[8];
#pragma unroll
    for (int q = 0; q < 8; ++q) { gg[q] = HASG ? *(const float4*)(g + grp * 32 + q * 4) : make_float4(1.f, 1.f, 1.f, 1.f); gg[q].x *= mul; gg[q].y *= mul; gg[q].z *= mul; gg[q].w *= mul; }
    for (size_t i0 = gtid; i0 < (size_t)PE * 32; i0 += 2 * gn) {
        float4 v[2][8];
#pragma unroll
        for (int u = 0; u < 2; ++u) { const size_t i = i0 + u * gn; if (i < (size_t)PE * 32) { const float* sp = src + (i >> 5) * D + (i & 31) * 32;
#pragma unroll
            for (int q = 0; q < 8; ++q) v[u][q] = *(const float4*)(sp + q * 4); } }
#pragma unroll
        for (int u = 0; u < 2; ++u) { const size_t i = i0 + u * gn; if (i < (size_t)PE * 32) { const size_t row = i >> 5;
            v16f_t a, b;
#pragma unroll
            for (int q = 0; q < 8; ++q) { const float4 x = v[u][q]; a[2 * q] = x.x * gg[q].x; b[2 * q] = x.y * gg[q].y; a[2 * q + 1] = x.z * gg[q].z; b[2 * q + 1] = x.w * gg[q].w; }
            const v6u_t p = __builtin_amdgcn_cvt_scalef32_2xpk16_fp6_f32(a, b, 1.0f);
            *(pg8::u32x4*)(dst + row * 768 + grp * 16) = (pg8::u32x4){p[0], p[1], p[2], p[3]};
            *(pg8::u32x2*)(dst + row * 768 + 512 + grp * 8) = (pg8::u32x2){p[4], p[5]}; } }
    }
}
DEVI void cvt_stream(const float* src, bf16* dst, size_t n8, const float* g, size_t gtid, size_t gn) {
    for (size_t i = gtid; i < n8; i += gn) { const float4 a = *(const float4*)(src + i * 8), b = *(const float4*)(src + i * 8 + 4);
        float4 ga = make_float4(1.f, 1.f, 1.f, 1.f), gb = ga; if (g) { ga = *(const float4*)(g + ((i * 8) & (D - 1))); gb = *(const float4*)(g + ((i * 8) & (D - 1)) + 4); }
        uint4 o; o.x = pg8::cvt_pk_bf16(a.x * ga.x, a.y * ga.y); o.y = pg8::cvt_pk_bf16(a.z * ga.z, a.w * ga.w); o.z = pg8::cvt_pk_bf16(b.x * gb.x, b.y * gb.y); o.w = pg8::cvt_pk_bf16(b.z * gb.z, b.w * gb.w);
        *(uint4*)(dst + i * 8) = o; }
}


DEVI void conv_token(int row, const bf16* U, const float* cw, const float* cb, const float* lg, const float* lb, bf16* CONCAT, int lane) {
    const int pos = row % SEQ; float y[8];
    { const float4 b0 = *(const float4*)(cb + lane * 8), b1 = *(const float4*)(cb + lane * 8 + 4); y[0] = b0.x; y[1] = b0.y; y[2] = b0.z; y[3] = b0.w; y[4] = b1.x; y[5] = b1.y; y[6] = b1.z; y[7] = b1.w; }
    const int k0 = pos >= CK - 1 ? 0 : CK - 1 - pos;
    for (int k = k0; k < CK; ++k) {
        const uint4 u = *(const uint4*)(U + (size_t)(row - (CK - 1) + k) * CW + lane * 8);
        const float4 w0 = *(const float4*)(cw + k * CW + lane * 8), w1 = *(const float4*)(cw + k * CW + lane * 8 + 4);
        y[0] += w0.x * __builtin_bit_cast(float, u.x << 16); y[1] += w0.y * __builtin_bit_cast(float, u.x & 0xffff0000u);
        y[2] += w0.z * __builtin_bit_cast(float, u.y << 16); y[3] += w0.w * __builtin_bit_cast(float, u.y & 0xffff0000u);
        y[4] += w1.x * __builtin_bit_cast(float, u.z << 16); y[5] += w1.y * __builtin_bit_cast(float, u.z & 0xffff0000u);
        y[6] += w1.z * __builtin_bit_cast(float, u.w << 16); y[7] += w1.w * __builtin_bit_cast(float, u.w & 0xffff0000u);
    }
    float s = 0.f;
#pragma unroll
    for (int e = 0; e < 8; ++e) s += y[e];
    const float mu = wave_sum(s) * (1.f / CW); float q = 0.f;
#pragma unroll
    for (int e = 0; e < 8; ++e) { y[e] -= mu; q += y[e] * y[e]; }
    const float rstd = rsqrtf(wave_sum(q) * (1.f / CW) + EPS);
    const float4 g0 = *(const float4*)(lg + lane * 8), g1 = *(const float4*)(lg + lane * 8 + 4), c0 = *(const float4*)(lb + lane * 8), c1 = *(const float4*)(lb + lane * 8 + 4);
    const float gg[8] = {g0.x, g0.y, g0.z, g0.w, g1.x, g1.y, g1.z, g1.w}, bb[8] = {c0.x, c0.y, c0.z, c0.w, c1.x, c1.y, c1.z, c1.w};
    float z[8];
#pragma unroll
    for (int e = 0; e < 8; ++e) { const float t = y[e] * rstd * gg[e] + bb[e]; z[e] = t * __builtin_amdgcn_rcpf(1.f + __expf(-t)); }
    uint4 o; o.x = pg8::cvt_pk_bf16(z[0], z[1]); o.y = pg8::cvt_pk_bf16(z[2], z[3]); o.z = pg8::cvt_pk_bf16(z[4], z[5]); o.w = pg8::cvt_pk_bf16(z[6], z[7]);
    *(uint4*)(CONCAT + (size_t)row * D + CW + lane * 8) = o;
}

DEVI void conv_chunk(int c, const bf16* U, const float* cw, const float* cb, const float* lg, const float* lb, bf16* CONCAT, LAS unsigned char* lds) {
    const int ch = threadIdx.x, lane = ch & 63, wv = __builtin_amdgcn_readfirstlane(ch >> 6);
    const int t0 = c * 64, pos0 = t0 % SEQ;
    float w[CK];
#pragma unroll
    for (int k = 0; k < CK; ++k) w[k] = cw[k * CW + ch];
    const float bias = cb[ch];
    float u[64 + CK - 1];
#pragma unroll
    for (int r = 0; r < 64 + CK - 1; ++r) { const int row = t0 - (CK - 1) + r;
        const unsigned raw = *(const unsigned short*)(U + (size_t)(row < 0 ? 0 : row) * CW + ch); u[r] = __builtin_bit_cast(float, raw << 16); }
#pragma unroll
    for (int r = 0; r < CK - 1; ++r) { const float keep = (pos0 - (CK - 1) + r >= 0) ? 1.f : 0.f; u[r] *= keep; }
    LAS float* yl = (LAS float*)lds;
#pragma unroll
    for (int j = 0; j < 64; ++j) { float y = bias;
#pragma unroll
        for (int k = 0; k < CK; ++k) y += w[k] * u[j + k];
        yl[j * CW + ch] = y; }
    __syncthreads();
#pragma unroll 1
    for (int i = 0; i < 8; ++i) { const int j = wv * 8 + i, row = t0 + j;
        const pg8::f32x4 a0 = *(const LAS pg8::f32x4*)(yl + j * CW + lane * 8), a1 = *(const LAS pg8::f32x4*)(yl + j * CW + lane * 8 + 4);
        float y[8] = {a0[0], a0[1], a0[2], a0[3], a1[0], a1[1], a1[2], a1[3]}; float sm = 0.f;
#pragma unroll
        for (int e = 0; e < 8; ++e) sm += y[e];
        const float mu = wave_sum(sm) * (1.f / CW); float q = 0.f;
#pragma unroll
        for (int e = 0; e < 8; ++e) { y[e] -= mu; q += y[e] * y[e]; }
        const float rstd = rsqrtf(wave_sum(q) * (1.f / CW) + EPS);
        const float4 g0 = *(const float4*)(lg + lane * 8), g1 = *(const float4*)(lg + lane * 8 + 4), c0 = *(const float4*)(lb + lane * 8), c1 = *(const float4*)(lb + lane * 8 + 4);
        const float gg[8] = {g0.x, g0.y, g0.z, g0.w, g1.x, g1.y, g1.z, g1.w}, bb[8] = {c0.x, c0.y, c0.z, c0.w, c1.x, c1.y, c1.z, c1.w};
        float z[8];
#pragma unroll
        for (int e = 0; e < 8; ++e) { const float t = y[e] * rstd * gg[e] + bb[e]; z[e] = t * __builtin_amdgcn_rcpf(1.f + __expf(-t)); }
        uint4 o; o.x = pg8::cvt_pk_bf16(z[0], z[1]); o.y = pg8::cvt_pk_bf16(z[2], z[3]); o.z = pg8::cvt_pk_bf16(z[4], z[5]); o.w = pg8::cvt_pk_bf16(z[6], z[7]);
        *(uint4*)(CONCAT + (size_t)row * D + CW + lane * 8) = o; }
    __syncthreads();
}

typedef short bf16x8_t __attribute__((ext_vector_type(8)));
typedef float f32x16_t __attribute__((ext_vector_type(16)));
typedef __bf16 bf16x2_t __attribute__((ext_vector_type(2)));
DEVI unsigned umax_(unsigned a, unsigned b) { return a > b ? a : b; }
DEVI unsigned umin_(unsigned a, unsigned b) { return a < b ? a : b; }
DEVI void ce_desc(unsigned& a, unsigned& b) { const unsigned mx = umax_(a, b), mn = umin_(a, b); a = mx; b = mn; }
DEVI void sort16_desc(unsigned (&v)[16]) {
#pragma unroll
    for (int k = 2; k <= 16; k <<= 1)
#pragma unroll
        for (int j = k >> 1; j > 0; j >>= 1)
#pragma unroll
            for (int i = 0; i < 16; ++i) { const int l = i ^ j; if (l > i) { if ((i & k) == 0) ce_desc(v[i], v[l]); else ce_desc(v[l], v[i]); } }
}
DEVI void merge16_desc(unsigned (&v)[16]) {
#pragma unroll
    for (int j = 8; j > 0; j >>= 1)
#pragma unroll
        for (int i = 0; i < 16; ++i) { const int l = i ^ j; if (l > i) ce_desc(v[i], v[l]); }
}
DEVI void top16_merge(unsigned (&a)[16], const unsigned (&b)[16]) {
#pragma unroll
    for (int i = 0; i < 16; ++i) a[i] = umax_(a[i], b[15 - i]);
    merge16_desc(a);
}
DEVI unsigned f2ord(float f) { const unsigned u = __builtin_bit_cast(unsigned, f); return (u & 0x80000000u) ? ~u : (u | 0x80000000u); }
DEVI float ord2f(unsigned u) { return __builtin_bit_cast(float, (u & 0x80000000u) ? (u & 0x7fffffffu) : ~u); }
DEVI int crow16(int r, int hi) { return (r & 3) + 8 * (r >> 2) + 4 * hi; }

DEVI void subkey_top16(unsigned (&best)[16], const bf16* qrow  , const LAS unsigned char* kl  , int hi) {
    bf16x8_t qf[8];
#pragma unroll
    for (int ks = 0; ks < 8; ++ks) qf[ks] = *(const bf16x8_t*)(qrow + 16 * ks);
    unsigned grp[16];
#pragma unroll
    for (int nt = 0; nt < 4; ++nt) {
        f32x16_t acc = {};
#pragma unroll
        for (int ks = 0; ks < 8; ++ks) { const bf16x8_t kf = *(const LAS bf16x8_t*)(kl + ks * 4096 + nt * 512); acc = __builtin_amdgcn_mfma_f32_32x32x16_bf16(kf, qf[ks], acc, 0, 0, 0); }
#pragma unroll
        for (int r = 0; r < 16; ++r) grp[r] = (f2ord(acc[r]) & 0xffffff80u) | (unsigned)(127 - (32 * nt + crow16(r, hi)));
        sort16_desc(grp);
        if (nt == 0) {
#pragma unroll
            for (int r = 0; r < 16; ++r) best[r] = grp[r];
        } else top16_merge(best, grp);
    }
    unsigned oth[16];
#pragma unroll
    for (int r = 0; r < 16; ++r) oth[r] = (unsigned)__shfl_xor((int)best[r], 32);
    top16_merge(best, oth);
}
DEVI void topk_wave(const bf16* qbase, const LAS unsigned char* keys, LAS unsigned* scr  , int* eidx, float* egate, int lane) {
    const int r32 = lane & 31, hi = lane >> 5;
    unsigned b0[16], b1[16];
    subkey_top16(b0, qbase + 8 * hi, keys + hi * 2048 + r32 * 16, hi);
    subkey_top16(b1, qbase + 128 + 8 * hi, keys + 32768 + hi * 2048 + r32 * 16, hi);
    float s0[16], s1[16];
#pragma unroll
    for (int i = 0; i < 16; ++i) { s0[i] = ord2f(b0[i] & 0xffffff80u); s1[i] = ord2f(b1[i] & 0xffffff80u); }
#pragma unroll
    for (int w = 0; w < 4; ++w) {
        scr[lane * 9 + w] = (127u - (b0[4 * w] & 127u)) | ((127u - (b0[4 * w + 1] & 127u)) << 8) | ((127u - (b0[4 * w + 2] & 127u)) << 16) | ((127u - (b0[4 * w + 3] & 127u)) << 24);
        scr[lane * 9 + 4 + w] = (127u - (b1[4 * w] & 127u)) | ((127u - (b1[4 * w + 1] & 127u)) << 8) | ((127u - (b1[4 * w + 2] & 127u)) << 16) | ((127u - (b1[4 * w + 3] & 127u)) << 24);
    }
    unsigned ca[16], cb2[16];
#define CAND(i, j) ((f2ord(s0[i] + s1[j]) & 0xffffff00u) | (unsigned)(255 - ((i) * 16 + (j))))
    if (hi == 0) {
#pragma unroll
        for (int j = 0; j < 16; ++j) ca[j] = CAND(0, j);
#pragma unroll
        for (int j = 0; j < 8; ++j) cb2[j] = CAND(1, j);
#pragma unroll
        for (int j = 8; j < 16; ++j) cb2[j] = 0u;
    } else {
        ca[0] = CAND(2, 0); ca[1] = CAND(2, 1); ca[2] = CAND(2, 2); ca[3] = CAND(2, 3); ca[4] = CAND(2, 4); ca[5] = CAND(3, 0); ca[6] = CAND(3, 1); ca[7] = CAND(3, 2); ca[8] = CAND(3, 3);
        ca[9] = CAND(4, 0); ca[10] = CAND(4, 1); ca[11] = CAND(4, 2); ca[12] = CAND(5, 0); ca[13] = CAND(5, 1); ca[14] = CAND(6, 0); ca[15] = CAND(6, 1);
        cb2[0] = CAND(7, 0); cb2[1] = CAND(7, 1); cb2[2] = CAND(8, 0); cb2[3] = CAND(9, 0); cb2[4] = CAND(10, 0); cb2[5] = CAND(11, 0); cb2[6] = CAND(12, 0); cb2[7] = CAND(13, 0); cb2[8] = CAND(14, 0); cb2[9] = CAND(15, 0);
#pragma unroll
        for (int j = 10; j < 16; ++j) cb2[j] = 0u;
    }
#undef CAND
    sort16_desc(ca); sort16_desc(cb2); top16_merge(ca, cb2);
    unsigned oth[16];
#pragma unroll
    for (int r = 0; r < 16; ++r) oth[r] = (unsigned)__shfl_xor((int)ca[r], 32);
    top16_merge(ca, oth);
    const float mx = ord2f(ca[0] & 0xffffff00u); float ex[16]; float l = 0.f;
#pragma unroll
    for (int k = 0; k < 16; ++k) { ex[k] = __expf(ord2f(ca[k] & 0xffffff00u) - mx); l += ex[k]; }
    const float rl = 1.f / l;
    LDS_WAIT(); asm volatile("" ::: "memory");
    int ei[8]; float eg[8];
    const unsigned mhi = (unsigned)(-hi);
#pragma unroll
    for (int k = 0; k < 8; ++k) { const unsigned key = ca[k] ^ ((ca[k] ^ ca[8 + k]) & mhi); const unsigned ij = 255u - (key & 255u), i = ij >> 4, j = ij & 15u;
        const unsigned w0 = scr[lane * 9 + (i >> 2)], w1 = scr[lane * 9 + 4 + (j >> 2)];
        ei[k] = (int)(((w0 >> (8 * (i & 3))) & 255u) * PNK + ((w1 >> (8 * (j & 3))) & 255u)); eg[k] = __builtin_bit_cast(float, __builtin_bit_cast(unsigned, ex[k]) ^ ((__builtin_bit_cast(unsigned, ex[k]) ^ __builtin_bit_cast(unsigned, ex[8 + k])) & mhi)) * rl; }
    *(int4*)(eidx + hi * 8) = make_int4(ei[0], ei[1], ei[2], ei[3]); *(int4*)(eidx + hi * 8 + 4) = make_int4(ei[4], ei[5], ei[6], ei[7]);
    *(float4*)(egate + hi * 8) = make_float4(eg[0], eg[1], eg[2], eg[3]); *(float4*)(egate + hi * 8 + 4) = make_float4(eg[4], eg[5], eg[6], eg[7]);
    LDS_WAIT(); asm volatile("" ::: "memory");
}

typedef unsigned char fp8_t;
template <int VAR = 0> DEVI float dot16_fp8(pg8::u32x4 row, pg8::u32x4 ha, pg8::u32x4 hb, float acc) {
    if (VAR == 1) return __builtin_bit_cast(float, (row[0] ^ row[1]) ^ (row[2] ^ row[3]));
#pragma unroll
    for (int i = 0; i < 4; ++i) { const unsigned hlo = i < 2 ? ha[2 * i] : hb[2 * i - 4], hhi = i < 2 ? ha[2 * i + 1] : hb[2 * i - 3];
        acc = __builtin_amdgcn_fdot2_f32_bf16(__builtin_amdgcn_cvt_scalef32_pk_bf16_fp8(row[i], 1.0f, false), __builtin_bit_cast(bf16x2_t, hlo), acc, false);
        acc = __builtin_amdgcn_fdot2_f32_bf16(__builtin_amdgcn_cvt_scalef32_pk_bf16_fp8(row[i], 1.0f, true), __builtin_bit_cast(bf16x2_t, hhi), acc, false); }
    return acc;
}
template <int VAR = 0> DEVI void fma16_fp8(float (&acc)[16], float w, pg8::u32x4 row) {
    if (VAR == 1) { acc[0] += __builtin_bit_cast(float, row[0] ^ row[1]); acc[1] += __builtin_bit_cast(float, row[2] ^ row[3]); return; }
#pragma unroll
    for (int i = 0; i < 4; ++i) { const pg8::f32x2 lo = __builtin_amdgcn_cvt_pk_f32_fp8(row[i], false), hh = __builtin_amdgcn_cvt_pk_f32_fp8(row[i], true);
        acc[4 * i] += w * lo[0]; acc[4 * i + 1] += w * lo[1]; acc[4 * i + 2] += w * hh[0]; acc[4 * i + 3] += w * hh[1]; }
}
DEVI void sort128_asc(unsigned& a, unsigned& b, int lane) {
#pragma unroll
    for (int k = 2; k <= 128; k <<= 1)
#pragma unroll
        for (int j = k >> 1; j > 0; j >>= 1) {
            if (j == 64) { const unsigned lo = umin_(a, b), hi = umax_(a, b); a = lo; b = hi; }
            else {
                const bool upper = (lane & j) != 0;
                const bool asc_a = k == 128 ? true : ((lane & k) == 0), asc_b = k == 128 ? true : (k == 64 ? false : ((lane & k) == 0));
                const unsigned pa_ = (unsigned)__shfl_xor((int)a, j), pb_ = (unsigned)__shfl_xor((int)b, j);
                a = (upper != asc_a) ? umin_(a, pa_) : umax_(a, pa_);
                b = (upper != asc_b) ? umin_(b, pb_) : umax_(b, pb_);
            }
        }
}
constexpr int EXD = 8, EXP_LDS_WAVE = 12800;
struct Row6 { pg8::u32x4 a; pg8::u32x2 b; };
template <int VAR> DEVI void experts_wave(LAS unsigned char* wl_, int t0, int tstep, const bf16* H2B, const float* part2, const unsigned char* PU, const unsigned char* PV, const int* EIDX, const float* EGATE, const float* fg, float* out, int lane) {
    if (t0 >= M) return;
    const int ntok = (M - t0 + tstep - 1) / tstep < 8 ? (M - t0 + tstep - 1) / tstep : 8;
    LAS int* sid = (LAS int*)wl_; LAS float* gsl = (LAS float*)(wl_ + 4096); LAS float* wl = (LAS float*)(wl_ + 8192); LAS float* r2l = (LAS float*)(wl_ + 12288);
    const unsigned g32 = (unsigned)lane & 31u, hsel = (unsigned)lane >> 5, l4 = (unsigned)lane * 4u;
#define LDI(p) (*(const int*)((const char*)(p) + l4))
#define LDF(p) (*(const float*)((const char*)(p) + l4))
#define LDROW(dst, tab, ridx) do { const unsigned char* rp_ = (tab) + (size_t)(unsigned)(ridx) * 768u; (dst).a = *(const pg8::u32x4*)(rp_ + g32 * 16u); (dst).b = *(const pg8::u32x2*)(rp_ + 512u + g32 * 8u); } while (0)
    for (int k = 0; k < ntok; ++k) { const int t = t0 + k * tstep;
        unsigned k0 = ((unsigned)LDI(EIDX + (size_t)t * 128) << 7) | (unsigned)lane, k1 = ((unsigned)LDI(EIDX + (size_t)t * 128 + 64) << 7) | (unsigned)(64 + lane);
        const float ga = LDF(EGATE + (size_t)t * 128), gb = LDF(EGATE + (size_t)t * 128 + 64);
        sort128_asc(k0, k1, lane);
        const unsigned sl0 = k0 & 127u, sl1 = k1 & 127u;
        const float x0 = __shfl(ga, (int)(sl0 & 63u)), y0 = __shfl(gb, (int)(sl0 & 63u)), x1 = __shfl(ga, (int)(sl1 & 63u)), y1 = __shfl(gb, (int)(sl1 & 63u));
        sid[k * 128 + lane] = (int)(k0 >> 7); sid[k * 128 + 64 + lane] = (int)(k1 >> 7);
        gsl[k * 128 + lane] = sl0 < 64u ? x0 : y0; gsl[k * 128 + 64 + lane] = sl1 < 64u ? x1 : y1;
        const float r2 = rsqrtf(wave_sum(lane < 16 ? LDF(part2 + (size_t)t * 16) : 0.f) * (1.f / D) + EPS) * (1.0f / PU_SCALE);
        if (lane == 0) r2l[k] = r2; }
    LDS_WAIT(); asm volatile("" ::: "memory");
    const int nsteps = 8 * ntok;
#define STEP_DESC(q, tab, pos0) do { const int q_ = (q); if (q_ < nsteps) { (tab) = PU; if (ntok == 8) (pos0) = ((q_ >> 4) * 2 + (q_ & 1)) * 128 + 16 * ((q_ >> 1) & 7); else { const int b_ = q_ / ntok; (pos0) = (q_ - b_ * ntok) * 128 + 16 * b_; } } \
        else if (q_ < 2 * nsteps) { const int qq_ = q_ - nsteps; (tab) = PV; (pos0) = (qq_ >> 3) * 128 + 16 * (qq_ & 7); } else { (tab) = PV; (pos0) = 0; } } while (0)
    constexpr int LOOK = 1;
    Row6 buf[8 * LOOK];
#pragma unroll
    for (int i = 0; i < 8; ++i) { const int ri = sid[2 * i + (int)hsel]; LDROW(buf[i], PU, ri); }
    if (LOOK == 2) { const unsigned char* tb_; int p0_; STEP_DESC(1, tb_, p0_);
#pragma unroll
      for (int i = 0; i < 8; ++i) { const int ri = sid[p0_ + 2 * i + (int)hsel]; LDROW(buf[(8 + i) % (8 * LOOK)], tb_, ri); } }
#define TR_STEP(S) _Pragma("unroll") for (int i = 0; i < S; ++i) { const bool up_ = (lane & S) != 0; const float send = up_ ? r[i] : r[i + S], keep = up_ ? r[i + S] : r[i]; r[i] = keep + __shfl_xor(send, S); }
#define U_STEP(q, SB, B_, K_, HV) do { const int q__ = (q); const int ub_ = (B_), uk_ = (K_); \
        const unsigned char* ntab; int npos; STEP_DESC(q__ + LOOK, ntab, npos); npos += (int)hsel; \
        float r[8]; \
        _Pragma("unroll") for (int i2 = 0; i2 < 8; ++i2) { \
            const v6u_t p = {buf[SB + i2].a[0], buf[SB + i2].a[1], buf[SB + i2].a[2], buf[SB + i2].a[3], buf[SB + i2].b[0], buf[SB + i2].b[1]}; \
            float d = 0.f; \
            if (VAR == 1) d = __builtin_bit_cast(float, p[0] ^ p[1] ^ p[2] ^ p[3] ^ p[4] ^ p[5]); \
            else { const v32f_t rv = __builtin_amdgcn_cvt_scalef32_pk32_f32_fp6(p, 1.0f); \
                f32x2_t d2 = {0.f, 0.f}; _Pragma("unroll") for (int j = 0; j < 32; j += 2) { const unsigned hw_ = HV[j >> 3][(j >> 1) & 3]; const f32x2_t r2_ = {rv[j], rv[j + 1]}, h2_ = {__builtin_bit_cast(float, hw_ << 16), __builtin_bit_cast(float, hw_ & 0xffff0000u)}; d2 = __builtin_elementwise_fma(r2_, h2_, d2); } d = d2[0] + d2[1]; } \
            r[i2] = d; \
            const int ri = sid[npos + 2 * i2]; LDROW(buf[SB + i2], ntab, ri); \
            __builtin_amdgcn_sched_barrier(0); } \
        TR_STEP(4) TR_STEP(2) TR_STEP(1) \
        float tot = r[0] + __shfl_xor(r[0], 8); tot += __shfl_xor(tot, 16); \
        const int pos = uk_ * 128 + 16 * ub_ + 2 * (lane & 7) + (int)hsel; \
        const float a = tot * r2l[uk_]; \
        wl[pos] = 0.5f * a * (1.f + erff(a * 0.70710678118654752f)) * gsl[pos] * (1.0f / PV_SCALE); } while (0)
#define LOAD_HV(dst, k_) do { const int t_ = t0 + (k_) * tstep; _Pragma("unroll") for (int qd = 0; qd < 4; ++qd) (dst)[qd] = VAR == 2 ? (pg8::u32x4){0x3f803f80u, 0x3f803f80u, 0x3f803f80u, 0x3f803f80u} : *(const pg8::u32x4*)((const char*)(H2B + (size_t)t_ * D) + g32 * 64u + qd * 16u); } while (0)
    if (ntok == 8) {
#pragma unroll 1
        for (int grp = 0; grp < 4; ++grp) {
            pg8::u32x4 hv0[4], hv1[4];
            LOAD_HV(hv0, 2 * grp); LOAD_HV(hv1, 2 * grp + 1);
#pragma unroll 1
            for (int b = 0; b < 8; ++b) { const int q = grp * 16 + b * 2;
                U_STEP(q, 0, b, 2 * grp, hv0); U_STEP(q + 1, 8 * (LOOK - 1), b, 2 * grp + 1, hv1); }
        }
    } else {
#pragma unroll 1
        for (int q = 0; q < nsteps; q += 2) { pg8::u32x4 hva[4], hvb[4]; const int b0_ = q / ntok, k0_ = q - b0_ * ntok, b1_ = (q + 1) / ntok, k1_ = (q + 1) - b1_ * ntok;
            LOAD_HV(hva, k0_); LOAD_HV(hvb, k1_); U_STEP(q, 0, b0_, k0_, hva); U_STEP(q + 1, 8 * (LOOK - 1), b1_, k1_, hvb); }
    }
#undef LOAD_HV
#undef U_STEP
#undef TR_STEP
    LDS_WAIT(); asm volatile("" ::: "memory");
#define V_STEP(q, SB) do { const int q__ = (q); const int b = (q__ - nsteps) & 7; \
        const unsigned char* ntab; int npos; STEP_DESC(q__ + LOOK, ntab, npos); npos += (int)hsel; \
        const int wpos = k * 128 + b * 16 + (int)hsel; \
        _Pragma("unroll") for (int i2 = 0; i2 < 8; ++i2) { \
            const v6u_t p = {buf[SB + i2].a[0], buf[SB + i2].a[1], buf[SB + i2].a[2], buf[SB + i2].a[3], buf[SB + i2].b[0], buf[SB + i2].b[1]}; \
            const float wv = wl[wpos + 2 * i2]; \
            if (VAR == 1) { acc[0] += __builtin_bit_cast(float, p[0] ^ p[1] ^ p[2]); acc[1] += __builtin_bit_cast(float, p[3] ^ p[4] ^ p[5]); } \
            else { const v32f_t rv = __builtin_amdgcn_cvt_scalef32_pk32_f32_fp6(p, 1.0f); \
                const f32x2_t w2_ = {wv, wv}; _Pragma("unroll") for (int j = 0; j < 32; j += 2) { const f32x2_t r2_ = {rv[j], rv[j + 1]}; f32x2_t a2_ = {acc[j], acc[j + 1]}; a2_ = __builtin_elementwise_fma(r2_, w2_, a2_); acc[j] = a2_[0]; acc[j + 1] = a2_[1]; } } \
            const int ri = sid[npos + 2 * i2]; LDROW(buf[SB + i2], ntab, ri); \
            asm volatile("" : "+v"(acc[0]), "+v"(acc[1]), "+v"(acc[2]), "+v"(acc[3]), "+v"(acc[4]), "+v"(acc[5]), "+v"(acc[6]), "+v"(acc[7]), "+v"(acc[8]), "+v"(acc[9]), "+v"(acc[10]), "+v"(acc[11]), "+v"(acc[12]), "+v"(acc[13]), "+v"(acc[14]), "+v"(acc[15])); \
            asm volatile("" : "+v"(acc[16]), "+v"(acc[17]), "+v"(acc[18]), "+v"(acc[19]), "+v"(acc[20]), "+v"(acc[21]), "+v"(acc[22]), "+v"(acc[23]), "+v"(acc[24]), "+v"(acc[25]), "+v"(acc[26]), "+v"(acc[27]), "+v"(acc[28]), "+v"(acc[29]), "+v"(acc[30]), "+v"(acc[31])); \
            __builtin_amdgcn_sched_barrier(0); } } while (0)
#pragma unroll 1
    for (int k = 0; k < ntok; ++k) {
        const int t = t0 + k * tstep;
        float acc[32];
#pragma unroll
        for (int j = 0; j < 32; ++j) acc[j] = 0.f;
#pragma unroll 1
        for (int bb = 0; bb < 8; bb += 2) { const int q = nsteps + 8 * k + bb; V_STEP(q, 0); V_STEP(q + 1, 8 * (LOOK - 1)); }
        float fin[16];
#pragma unroll
        for (int j = 0; j < 16; ++j) { const float lo = acc[j], hi = acc[16 + j]; const float send = hsel ? lo : hi, keep = hsel ? hi : lo; fin[j] = keep + __shfl_xor(send, 32); }
        const unsigned eoff = (g32 * 32u + hsel * 16u) * 4u;
        float* orow = (float*)((char*)(out + (size_t)t * D) + eoff); float ss = 0.f;
        { const pg8::u32x4 ra = *(const pg8::u32x4*)((const char*)(H2B + (size_t)t * D) + eoff / 2), rb = *(const pg8::u32x4*)((const char*)(H2B + (size_t)t * D) + eoff / 2 + 16);
#pragma unroll
          for (int q = 0; q < 4; ++q) { fin[2 * q] += __builtin_bit_cast(float, ra[q] << 16); fin[2 * q + 1] += __builtin_bit_cast(float, ra[q] & 0xffff0000u); fin[8 + 2 * q] += __builtin_bit_cast(float, rb[q] << 16); fin[8 + 2 * q + 1] += __builtin_bit_cast(float, rb[q] & 0xffff0000u); } }
#pragma unroll
        for (int j = 0; j < 16; ++j) ss += fin[j] * fin[j];
        const float rr = rsqrtf(wave_sum(ss) * (1.f / D) + EPS);
#pragma unroll
        for (int q = 0; q < 4; ++q) { const float4 g = *(const float4*)((const char*)(fg + q * 4) + eoff);
            *(float4*)(orow + q * 4) = make_float4(fin[4 * q] * rr * g.x, fin[4 * q + 1] * rr * g.y, fin[4 * q + 2] * rr * g.z, fin[4 * q + 3] * rr * g.w); }
        __builtin_amdgcn_sched_barrier(0);
    }
#undef V_STEP
#undef STEP_DESC
#undef LDI
#undef LDF
#undef LDROW
}

typedef short v4i16_t __attribute__((ext_vector_type(4)));
typedef int v2i32_t __attribute__((ext_vector_type(2)));
typedef int v4i32_t __attribute__((ext_vector_type(4)));
DEVI bf16x8_t join_tr(v4i16_t lo, v4i16_t hh) { const v2i32_t a = __builtin_bit_cast(v2i32_t, lo), b = __builtin_bit_cast(v2i32_t, hh); const v4i32_t w = {a[0], a[1], b[0], b[1]}; return __builtin_bit_cast(bf16x8_t, w); }
DEVI float max3f(float a, float b, float c) { float r; asm("v_max3_f32 %0, %1, %2, %3" : "=v"(r) : "v"(a), "v"(b), "v"(c)); return r; }
DEVI float max2f(float a, float b) { float r; asm("v_max_f32_e32 %0, %1, %2" : "=v"(r) : "v"(a), "v"(b)); return r; }
DEVI void glds16(const void* gsrc, unsigned lds_dst) { unsigned keep;
    asm volatile("s_mov_b32 %0, m0\n\ts_mov_b32 m0, %2\n\ts_nop 0\n\tglobal_load_lds_dwordx4 %1, off\n\ts_mov_b32 m0, %0" : "=&s"(keep) : "v"(gsrc), "s"(lds_dst) : "memory"); }
#define LDSADDR(p) ((unsigned)__builtin_amdgcn_readfirstlane((int)(unsigned)(uintptr_t)(p)))
#define ATT_BAR(N) asm volatile("s_waitcnt vmcnt(" #N ") lgkmcnt(0)\n\ts_barrier" ::: "memory")
template <int DQK, int DV, int DSPLIT, int NSLOT, int PD, bool CAUSAL, bool STAG, int VAR = 0>
DEVI void attn_unit(LAS unsigned char* S, const bf16* Qu, int qpitch, const bf16* Ku, int kpitch, const bf16* Vu, int vpitch, bf16* Ou, int opitch, int NT, int qcb) {
    constexpr int NCH = DQK / 8, KSLOT = NCH * 1024, NVG = DV / 32, VSLOT = NVG * 4096, NRG = 8 / DSPLIT, DVW = DV / DSPLIT, NOD = DVW / 32, NKS = DQK / 16;
    constexpr int KOFF = 0, VOFF = NSLOT * KSLOT, WSF = VOFF + NSLOT * VSLOT;
    static_assert(NRG * 32 * DVW * 2 * DSPLIT <= NSLOT * KSLOT, "O staging reuses the K ring");
    static_assert(NSLOT >= PD + (STAG ? 2 : 1), "ring depth");
    int tid_ = threadIdx.x; asm volatile("" : "+v"(tid_));
    const int lane = tid_ & 63, wid = __builtin_amdgcn_readfirstlane(tid_ >> 6), r32 = lane & 31, hi = lane >> 5, rg = wid % NRG, dp = wid / NRG;
    const bool late = STAG && wid >= 4;
    LAS float* wsf = (LAS float*)(S + WSF) + wid * 64;
    const int nld = (NCH - wid + 7) / 8 + (NVG * 4 - wid + 7) / 8;
    const bf16* ksrc = Ku + (size_t)lane * kpitch;
    const bf16* vsrc = Vu + (size_t)(lane >> 2) * vpitch + (lane & 3) * 8;
#define ATT_DMA(t, slot) do { \
        _Pragma("unroll") for (int pc_ = 0; pc_ < (NCH + 7) / 8; ++pc_) { const int pc = wid + 8 * pc_; if (pc < NCH) \
            glds16(ksrc + (size_t)(t) * 64 * kpitch + pc * 8, LDSADDR(S + KOFF + (slot) * KSLOT + pc * 1024)); } \
        _Pragma("unroll") for (int pv_ = 0; pv_ < (NVG * 4 + 7) / 8; ++pv_) { const int pv = wid + 8 * pv_; if (pv < NVG * 4) \
            glds16(vsrc + (size_t)((t) * 64 + (pv & 3) * 16) * vpitch + (pv >> 2) * 32, LDSADDR(S + VOFF + (slot) * VSLOT + pv * 1024)); } } while (0)
    bf16x8_t qr[NKS];
#pragma unroll
    for (int ks = 0; ks < NKS; ++ks) qr[ks] = *(const bf16x8_t*)(Qu + (size_t)(32 * rg + r32) * qpitch + ks * 16 + hi * 8);
#pragma unroll
    for (int ks = 0; ks < NKS; ++ks) asm volatile("" : "+v"(qr[ks]));
#pragma unroll
    for (int t = 0; t < PD; ++t) if (t < NT) ATT_DMA(t, t);
    f32x16_t o[NOD];
#pragma unroll
    for (int dd = 0; dd < NOD; ++dd) o[dd] = f32x16_t{};
    float m = 0.f, l = 0.f; f32x16_t negm = f32x16_t{};
    const int tlast = CAUSAL ? qcb + (rg >> 1) : NT - 1;
    const LAS unsigned char* kbase = S + KOFF + hi * 1024 + r32 * 16;
    const LAS unsigned char* vbase = S + VOFF + ((lane >> 4) & 1) * 32 + (lane & 3) * 8 + (4 * hi + ((lane & 15) >> 2)) * 64 + dp * NOD * 4096;
    bf16x8_t pa[4];
#define ATT_QKSM(sl) do { const LAS unsigned char* kp = kbase + (sl) * KSLOT; \
            f32x16_t p0 = negm, p1 = negm; \
            _Pragma("unroll") for (int ks = 0; ks < NKS; ++ks) { const bf16x8_t a0 = *(const LAS bf16x8_t*)(kp + ks * 2048), a1 = *(const LAS bf16x8_t*)(kp + ks * 2048 + 512); \
                if (VAR != 2) { p0 = __builtin_amdgcn_mfma_f32_32x32x16_bf16(a0, qr[ks], p0, 0, 0, 0); p1 = __builtin_amdgcn_mfma_f32_32x32x16_bf16(a1, qr[ks], p1, 0, 0, 0); } else { p0[ks] += __builtin_bit_cast(float, (int)a0[0]); p1[ks] += __builtin_bit_cast(float, (int)a1[0]); } } \
            asm volatile("s_nop 15\n\ts_nop 7" : "+v"(p0), "+v"(p1)); \
            float rm = 0.f; \
            if (VAR != 1) { float a = max3f(p0[0], p0[1], p1[0]), b = max3f(p0[2], p0[3], p1[1]); a = max3f(a, p1[2], p1[3]); \
              _Pragma("unroll") for (int r = 4; r < 16; r += 4) { a = max3f(a, p0[r], p0[r + 1]); b = max3f(b, p0[r + 2], p0[r + 3]); a = max3f(a, p1[r], p1[r + 1]); b = max3f(b, p1[r + 2], p1[r + 3]); } \
              rm = max2f(a, b); rm = max2f(rm, __shfl_xor(rm, 32)); } \
            if (__any(rm > 0.f)) { \
                const float dl = fmaxf(rm, 0.f), alpha = __builtin_amdgcn_exp2f(-dl); m += dl; l *= alpha; \
                _Pragma("unroll") for (int r = 0; r < 16; ++r) { p0[r] -= dl; p1[r] -= dl; negm[r] = -m; } \
                if (hi == 0) wsf[r32] = alpha; \
                LDS_WAIT(); asm volatile("" ::: "memory"); \
                _Pragma("unroll") for (int r = 0; r < 16; ++r) { const float f = wsf[crow16(r, hi)]; \
                    _Pragma("unroll") for (int dd = 0; dd < NOD; ++dd) o[dd][r] *= f; } \
                LDS_WAIT(); asm volatile("" ::: "memory"); \
            } \
            float ls = 0.f; \
            if (VAR != 1) { _Pragma("unroll") for (int r = 0; r < 16; ++r) { p0[r] = __builtin_amdgcn_exp2f(p0[r]); p1[r] = __builtin_amdgcn_exp2f(p1[r]); ls += p0[r] + p1[r]; } } \
            l += ls; \
            _Pragma("unroll") for (int ks = 0; ks < 4; ++ks) { pg8::u32x4 w; \
                if (ks < 2) { w.x = pg8::cvt_pk_bf16(p0[8 * ks], p0[8 * ks + 1]); w.y = pg8::cvt_pk_bf16(p0[8 * ks + 2], p0[8 * ks + 3]); w.z = pg8::cvt_pk_bf16(p0[8 * ks + 4], p0[8 * ks + 5]); w.w = pg8::cvt_pk_bf16(p0[8 * ks + 6], p0[8 * ks + 7]); } \
                else { const int k2 = ks - 2; w.x = pg8::cvt_pk_bf16(p1[8 * k2], p1[8 * k2 + 1]); w.y = pg8::cvt_pk_bf16(p1[8 * k2 + 2], p1[8 * k2 + 3]); w.z = pg8::cvt_pk_bf16(p1[8 * k2 + 4], p1[8 * k2 + 5]); w.w = pg8::cvt_pk_bf16(p1[8 * k2 + 6], p1[8 * k2 + 7]); } \
                pa[ks] = __builtin_bit_cast(bf16x8_t, w); } } while (0)
#define ATT_PV(sl) do { const LAS unsigned char* vp = vbase + (sl) * VSLOT; \
            _Pragma("unroll") for (int dd = 0; dd < NOD; ++dd) \
                _Pragma("unroll") for (int ks = 0; ks < 4; ++ks) { \
                    const v4i16_t lo = __builtin_amdgcn_ds_read_tr16_b64_v4i16((LAS v4i16_t*)(vp + dd * 4096 + ks * 1024)); \
                    const v4i16_t hh = __builtin_amdgcn_ds_read_tr16_b64_v4i16((LAS v4i16_t*)(vp + dd * 4096 + ks * 1024 + 512)); \
                    const bf16x8_t vf = join_tr(lo, hh); \
                    if (VAR != 2) o[dd] = __builtin_amdgcn_mfma_f32_32x32x16_bf16(pa[ks], vf, o[dd], 0, 0, 0); else o[dd][ks] += __builtin_bit_cast(float, (int)vf[0] + (int)pa[ks][0]); } } while (0)
    int slot = 0, slot_prev = NSLOT - 1, slot_issue = PD % NSLOT;
    for (int t = 0; t < NT; ++t) {
        const int ahead = (t + PD - 1 < NT - 1 ? t + PD - 1 : NT - 1) - t;
        const int nwait = ahead * nld;
        if (nwait <= 0) ATT_BAR(0); else if (nwait == 2) ATT_BAR(2); else if (nwait == 3) ATT_BAR(3); else if (nwait == 4) ATT_BAR(4); else if (nwait == 6) ATT_BAR(6); else if (nwait == 8) ATT_BAR(8); else ATT_BAR(0);
        if (t + PD < NT) ATT_DMA(t + PD, slot_issue);
        if (!late) { if (t <= tlast) { ATT_QKSM(slot); ATT_PV(slot); } }
        else { if (t >= 1 && t - 1 <= tlast) ATT_PV(slot_prev); if (t <= tlast) ATT_QKSM(slot); }
        slot_prev = slot; slot = slot + 1 == NSLOT ? 0 : slot + 1; slot_issue = slot_issue + 1 == NSLOT ? 0 : slot_issue + 1;
    }
    if (late && tlast >= NT - 1) ATT_PV(slot_prev);
    l += __shfl_xor(l, 32);
    if (hi == 0) wsf[32 + r32] = l;
    ATT_BAR(0);
    LAS bf16* stg = (LAS bf16*)(S + KOFF) + wid * 32 * DVW;
#pragma unroll
    for (int r = 0; r < 16; ++r) { const int orow = crow16(r, hi); const float rl = __builtin_amdgcn_rcpf(wsf[32 + orow]);
#pragma unroll
        for (int dd = 0; dd < NOD; ++dd) stg[orow * DVW + dd * 32 + r32] = f2bf(o[dd][r] * rl); }
    LDS_WAIT(); asm volatile("" ::: "memory");
#pragma unroll
    for (int i = 0; i < DVW / 16; ++i) { const int idx = i * 64 + lane, row = idx / (DVW / 8), ch = idx % (DVW / 8);
        *(pg8::u32x4*)(Ou + (size_t)(32 * rg + row) * opitch + dp * DVW + ch * 8) = *(const LAS pg8::u32x4*)(stg + row * DVW + ch * 8); }
    ATT_BAR(0);
#undef ATT_DMA
#undef ATT_QKSM
#undef ATT_PV
}

typedef float f32x2_t __attribute__((ext_vector_type(2)));
DEVI unsigned cvtpk(float lo, float hi) { const f32x2_t v = {lo, hi}; const bf16x2_t b = __builtin_convertvector(v, bf16x2_t); return __builtin_bit_cast(unsigned, b); }
DEVI void attn_mla_unit(LAS unsigned char* S, const bf16* Qu, const bf16* Ku, const bf16* Vu, bf16* Ou, int NT, int qcb) {
    constexpr int NCH = 12, KSLOT = NCH * 1024, VSLOT = 8192, NSLOT = 4, NKS = 6, qpitch = 768, kpitch = 768, vpitch = 512, opitch = D;
    constexpr int KOFF = 0, VOFF = NSLOT * KSLOT, WSF = VOFF + NSLOT * VSLOT;
    int tid_ = threadIdx.x; asm volatile("" : "+v"(tid_));
    const int lane = tid_ & 63, wid = __builtin_amdgcn_readfirstlane(tid_ >> 6), r32 = lane & 31, hi = lane >> 5;
    LAS float* wsf = (LAS float*)(S + WSF) + wid * 64;
    const int nld = wid < 4 ? 3 : 2;
    const bf16* ksrc = Ku + (size_t)lane * kpitch;
    const bf16* vsrc = Vu + (size_t)(lane >> 2) * vpitch + (lane & 3) * 8;
#define MLA_DMA(t, slot) do { \
        glds16(ksrc + (size_t)(t) * 64 * kpitch + wid * 8, LDSADDR(S + KOFF + (slot) * KSLOT + wid * 1024)); \
        if (wid < 4) glds16(ksrc + (size_t)(t) * 64 * kpitch + (wid + 8) * 8, LDSADDR(S + KOFF + (slot) * KSLOT + (wid + 8) * 1024)); \
        glds16(vsrc + (size_t)((t) * 64 + (wid & 3) * 16) * vpitch + (wid >> 2) * 32, LDSADDR(S + VOFF + (slot) * VSLOT + wid * 1024)); } while (0)
#define MLA_BAR(nw) do { if ((nw) <= 0) ATT_BAR(0); else if ((nw) == 2) ATT_BAR(2); else if ((nw) == 3) ATT_BAR(3); else if ((nw) == 4) ATT_BAR(4); else ATT_BAR(6); } while (0)
#define SGB(mask, n) __builtin_amdgcn_sched_group_barrier(mask, n, 0)
    bf16x8_t qr[NKS];
#pragma unroll
    for (int ks = 0; ks < NKS; ++ks) qr[ks] = *(const bf16x8_t*)(Qu + (size_t)(32 * wid + r32) * qpitch + ks * 16 + hi * 8);
#pragma unroll
    for (int ks = 0; ks < NKS; ++ks) asm volatile("" : "+v"(qr[ks]));
    MLA_DMA(0, 0); MLA_DMA(1, 1); MLA_DMA(2, 2);
    f32x16_t o0 = f32x16_t{}, o1 = f32x16_t{};
    float m = 0.f, l = 0.f; f32x16_t negm = f32x16_t{};
    const int tlast = qcb + (wid >> 1);
    const LAS unsigned char* kbase = S + KOFF + hi * 1024 + r32 * 16;
    const LAS unsigned char* vbase = S + VOFF + ((lane >> 4) & 1) * 32 + (lane & 3) * 8 + (4 * hi + ((lane & 15) >> 2)) * 64;
    f32x16_t p0, p1;
#define MLA_ROWMAX(rm, q0, q1) do { float a_ = __builtin_fmaxf(__builtin_fmaxf(q0[0], q0[1]), q1[0]), b_ = __builtin_fmaxf(__builtin_fmaxf(q0[2], q0[3]), q1[1]); a_ = __builtin_fmaxf(__builtin_fmaxf(a_, q1[2]), q1[3]); \
        _Pragma("unroll") for (int r = 4; r < 16; r += 4) { a_ = __builtin_fmaxf(__builtin_fmaxf(a_, q0[r]), q0[r + 1]); b_ = __builtin_fmaxf(__builtin_fmaxf(b_, q0[r + 2]), q0[r + 3]); a_ = __builtin_fmaxf(__builtin_fmaxf(a_, q1[r]), q1[r + 1]); b_ = __builtin_fmaxf(__builtin_fmaxf(b_, q1[r + 2]), q1[r + 3]); } \
        rm = __builtin_fmaxf(a_, b_); rm = __builtin_fmaxf(rm, __shfl_xor(rm, 32)); } while (0)
#define MLA_MOVE(rm, q0, q1) do { if (__any(rm > 0.f)) { \
            const float dl = fmaxf(rm, 0.f), alpha = __builtin_amdgcn_exp2f(-dl); m += dl; l *= alpha; \
            _Pragma("unroll") for (int r = 0; r < 16; ++r) { q0[r] -= dl; q1[r] -= dl; negm[r] = -m; } \
            if (hi == 0) wsf[r32] = alpha; \
            LDS_WAIT(); asm volatile("" ::: "memory"); \
            _Pragma("unroll") for (int r = 0; r < 16; ++r) { const float f = wsf[crow16(r, hi)]; o0[r] *= f; o1[r] *= f; } \
            LDS_WAIT(); asm volatile("" ::: "memory"); } } while (0)
    MLA_BAR(2 * nld);
    MLA_DMA(3, 3);
    { const LAS unsigned char* kp = kbase; p0 = negm; p1 = negm;
#pragma unroll
      for (int ks = 0; ks < NKS; ++ks) { const bf16x8_t a0 = *(const LAS bf16x8_t*)(kp + ks * 2048), a1 = *(const LAS bf16x8_t*)(kp + ks * 2048 + 512);
          p0 = __builtin_amdgcn_mfma_f32_32x32x16_bf16(a0, qr[ks], p0, 0, 0, 0); p1 = __builtin_amdgcn_mfma_f32_32x32x16_bf16(a1, qr[ks], p1, 0, 0, 0); }
      float rm; MLA_ROWMAX(rm, p0, p1); MLA_MOVE(rm, p0, p1); }
    int kslot = 1, vslot = 0, islot = 3;
    for (int t = 0; t < NT; ++t) {
        if (t + 1 < NT) { const int young = (t + 2 < NT) ? 1 : 0; MLA_BAR(young * nld); } else ATT_BAR(0);
        if (t >= 1 && t + 3 < NT) MLA_DMA(t + 3, islot);
        if (t < tlast) {
            const LAS unsigned char* kp = kbase + kslot * KSLOT; const LAS unsigned char* vp = vbase + vslot * VSLOT;
            bf16x8_t kf[12];
#pragma unroll
            for (int ks = 0; ks < NKS; ++ks) { kf[2 * ks] = *(const LAS bf16x8_t*)(kp + ks * 2048); kf[2 * ks + 1] = *(const LAS bf16x8_t*)(kp + ks * 2048 + 512); }
            f32x16_t n0 = negm, n1 = negm; float ls = 0.f; pg8::u32x4 pw[4];
#pragma unroll
            for (int ks = 0; ks < NKS; ++ks) { n0 = __builtin_amdgcn_mfma_f32_32x32x16_bf16(kf[2 * ks], qr[ks], n0, 0, 0, 0); n1 = __builtin_amdgcn_mfma_f32_32x32x16_bf16(kf[2 * ks + 1], qr[ks], n1, 0, 0, 0); }
#pragma unroll
            for (int r = 0; r < 16; ++r) { p0[r] = __builtin_amdgcn_exp2f(p0[r]); p1[r] = __builtin_amdgcn_exp2f(p1[r]); }
#pragma unroll
            for (int r = 0; r < 16; r += 2) { ls += (p0[r] + p0[r + 1]) + (p1[r] + p1[r + 1]); }
#pragma unroll
            for (int ks = 0; ks < 2; ++ks) { pw[ks] = (pg8::u32x4){cvtpk(p0[8 * ks], p0[8 * ks + 1]), cvtpk(p0[8 * ks + 2], p0[8 * ks + 3]), cvtpk(p0[8 * ks + 4], p0[8 * ks + 5]), cvtpk(p0[8 * ks + 6], p0[8 * ks + 7])};
                pw[2 + ks] = (pg8::u32x4){cvtpk(p1[8 * ks], p1[8 * ks + 1]), cvtpk(p1[8 * ks + 2], p1[8 * ks + 3]), cvtpk(p1[8 * ks + 4], p1[8 * ks + 5]), cvtpk(p1[8 * ks + 6], p1[8 * ks + 7])}; }
            l += ls;
            SGB(0x100, 4);
#pragma unroll
            for (int i = 0; i < 12; ++i) { SGB(0x008, 1); SGB(0x002, 7); if (i < 8) SGB(0x100, 1); }
            __builtin_amdgcn_sched_barrier(0);
            v4i16_t vlo[8], vhi[8];
#pragma unroll
            for (int i = 0; i < 8; ++i) { vlo[i] = __builtin_amdgcn_ds_read_tr16_b64_v4i16((LAS v4i16_t*)(vp + (i >> 2) * 4096 + (i & 3) * 1024)); vhi[i] = __builtin_amdgcn_ds_read_tr16_b64_v4i16((LAS v4i16_t*)(vp + (i >> 2) * 4096 + (i & 3) * 1024 + 512)); }
#pragma unroll
            for (int i = 0; i < 8; ++i) { const bf16x8_t vf = join_tr(vlo[i], vhi[i]); const bf16x8_t pa_ = __builtin_bit_cast(bf16x8_t, pw[i & 3]);
                if (i < 4) o0 = __builtin_amdgcn_mfma_f32_32x32x16_bf16(pa_, vf, o0, 0, 0, 0); else o1 = __builtin_amdgcn_mfma_f32_32x32x16_bf16(pa_, vf, o1, 0, 0, 0); }
            float rm; MLA_ROWMAX(rm, n0, n1);
            SGB(0x100, 6);
#pragma unroll
            for (int i = 0; i < 8; ++i) { SGB(0x008, 1); SGB(0x002, 3); if (i < 5) SGB(0x100, 2); }
            __builtin_amdgcn_sched_barrier(0);
            MLA_MOVE(rm, n0, n1);
            p0 = n0; p1 = n1;
        } else if (t == tlast) {
            asm volatile("" : "+v"(p0), "+v"(p1));
            const LAS unsigned char* vp = vbase + vslot * VSLOT; float ls = 0.f; pg8::u32x4 pw[4];
#pragma unroll
            for (int r = 0; r < 16; ++r) { p0[r] = __builtin_amdgcn_exp2f(p0[r]); p1[r] = __builtin_amdgcn_exp2f(p1[r]); ls += p0[r] + p1[r]; }
            l += ls;
#pragma unroll
            for (int ks = 0; ks < 2; ++ks) { pw[ks] = (pg8::u32x4){cvtpk(p0[8 * ks], p0[8 * ks + 1]), cvtpk(p0[8 * ks + 2], p0[8 * ks + 3]), cvtpk(p0[8 * ks + 4], p0[8 * ks + 5]), cvtpk(p0[8 * ks + 6], p0[8 * ks + 7])};
                pw[2 + ks] = (pg8::u32x4){cvtpk(p1[8 * ks], p1[8 * ks + 1]), cvtpk(p1[8 * ks + 2], p1[8 * ks + 3]), cvtpk(p1[8 * ks + 4], p1[8 * ks + 5]), cvtpk(p1[8 * ks + 6], p1[8 * ks + 7])}; }
#pragma unroll
            for (int i = 0; i < 8; ++i) { const v4i16_t lo = __builtin_amdgcn_ds_read_tr16_b64_v4i16((LAS v4i16_t*)(vp + (i >> 2) * 4096 + (i & 3) * 1024)), hh = __builtin_amdgcn_ds_read_tr16_b64_v4i16((LAS v4i16_t*)(vp + (i >> 2) * 4096 + (i & 3) * 1024 + 512));
                const bf16x8_t vf = join_tr(lo, hh); const bf16x8_t pa_ = __builtin_bit_cast(bf16x8_t, pw[i & 3]);
                if (i < 4) o0 = __builtin_amdgcn_mfma_f32_32x32x16_bf16(pa_, vf, o0, 0, 0, 0); else o1 = __builtin_amdgcn_mfma_f32_32x32x16_bf16(pa_, vf, o1, 0, 0, 0); }
        }
        kslot = (kslot + 1) & 3; vslot = (vslot + 1) & 3; islot = (islot + 1) & 3;
    }
    l += __shfl_xor(l, 32);
    if (hi == 0) wsf[32 + r32] = l;
    ATT_BAR(0);
    LAS bf16* stg = (LAS bf16*)(S + KOFF) + wid * 32 * 64;
#pragma unroll
    for (int r = 0; r < 16; ++r) { const int orow = crow16(r, hi); const float rl = __builtin_amdgcn_rcpf(wsf[32 + orow]);
        stg[orow * 64 + r32] = f2bf(o0[r] * rl); stg[orow * 64 + 32 + r32] = f2bf(o1[r] * rl); }
    LDS_WAIT(); asm volatile("" ::: "memory");
#pragma unroll
    for (int i = 0; i < 4; ++i) { const int idx = i * 64 + lane, row = idx >> 3, ch = idx & 7;
        *(pg8::u32x4*)(Ou + (size_t)(32 * wid + row) * opitch + ch * 8) = *(const LAS pg8::u32x4*)(stg + row * 64 + ch * 8); }
    ATT_BAR(0);
#undef MLA_DMA
#undef MLA_BAR
#undef MLA_ROWMAX
#undef MLA_MOVE
#undef SGB
}

DEVI bool unit_of(int Mrows, int Ncols, int G, int c, int i, int& pm, int& pn) {
    const int nM = Mrows / 256, nN = Ncols / 256, nwg = nM * nN; const long Lq = (long)i * G + c; if (Lq >= nwg) return false;
    int wgid = (int)Lq; { const int q = nwg / 8, r = nwg % 8, xcd = wgid % 8, off = wgid / 8; wgid = (xcd < r ? xcd * (q + 1) : r * (q + 1) + (xcd - r) * q) + off; }
    const int nig = 8 * nN, gid = wgid / nig, fm = gid * 8, gsz = (nM - fm) < 8 ? (nM - fm) : 8;
    pm = fm + ((wgid % nig) % gsz); pn = (wgid % nig) / gsz; return true;
}
DEVI void own_writes_visible() {
    asm volatile("s_waitcnt vmcnt(0)" ::: "memory"); __syncthreads();
    if (threadIdx.x == 0) { __builtin_amdgcn_fence(__ATOMIC_ACQUIRE, "agent"); asm volatile("s_waitcnt vmcnt(0)" ::: "memory"); }
    __syncthreads();
}

__global__ void __launch_bounds__(NTHR, 2) mega(Args args) {
    extern __shared__ __attribute__((aligned(16))) unsigned char lds[];
    const int tid = threadIdx.x, lane = tid & 63, wave = __builtin_amdgcn_readfirstlane(tid >> 6);
    const int G = gridDim.x, bx = blockIdx.x; const int vcu = (G % 8 == 0) ? (bx % 8) * (G / 8) + bx / 8 : bx;
    LAS unsigned char* L = (LAS unsigned char*)lds + PH_BASE;
    volatile LAS unsigned* MISC = (volatile LAS unsigned*)((LAS unsigned char*)lds + LDSCTL_OFF + 320);
    unsigned char* ws = args.ws; gu32* ctl = (gu32*)(ws + WS_CTL);
    if (tid < PH_BASE / 4) ((LAS unsigned*)(lds))[tid] = 0u;
    __syncthreads();
    XcdBarrier bar = xcd_barrier_post((unsigned*)(ctl + CW_BAR) + args.li * XCD_BAR_WORDS, MISC + 8);
    const unsigned mask = args.mask;
#define IN(k) ((mask >> (k)) & 1u)
#ifndef PROBE_ATTVAR
#define PROBE_ATTVAR 0
#endif
#ifndef PROBE_EXPVAR
#define PROBE_EXPVAR 0
#endif
#ifndef PROBE_REP
#define PROBE_REP 0u
#endif
#define NREP(k) (1 + (int)((PROBE_REP >> (k)) & 1u))
#define SEAM(k) do { if ((mask & ((1u << PH_N) - 1u)) >> ((k) + 1)) xcd_barrier(bar); } while (0)
    const float* x = args.in[0]; float* out = args.out;
    bf16 *Wt_in = (bf16*)(ws + WS_WIN), *Wt_qup = (bf16*)(ws + WS_WQUP), *Wt_kv = (bf16*)(ws + WS_WKV), *Wt_mix = (bf16*)(ws + WS_WMIX), *Wt_mq = (bf16*)(ws + WS_WMQ), *Wt_mkv = (bf16*)(ws + WS_WMKV),
         *Wt_mo = (bf16*)(ws + WS_WMO), *Wt_pq = (bf16*)(ws + WS_WPQ), *SK = (bf16*)(ws + WS_SK), *MEMN = (bf16*)(ws + WS_MEMN), *MEMKV = (bf16*)(ws + WS_MEMKV), *PU = (bf16*)(ws + WS_PU), *PV = (bf16*)(ws + WS_PV);
    float *partq = (float*)(ws + WS_PARTQ), *partkv = (float*)(ws + WS_PARTKV), *part1 = (float*)(ws + WS_PART1), *part2 = (float*)(ws + WS_PART2), *trig = (float*)(ws + WS_TRIG);
    bf16 *XN = (bf16*)(ws + WS_R1), *CONCAT = XN, *QM = XN, *H2B = XN;
    bf16 *CQ = (bf16*)(ws + WS_R2 + R2_CQ), *CKV = (bf16*)(ws + WS_R2 + R2_CKV), *U = (bf16*)(ws + WS_R2 + R2_U), *H1B = (bf16*)(ws + WS_R2), *OM = (bf16*)(ws + WS_R3);
    bf16 *QB = (bf16*)(ws + WS_R3 + R3_QB), *KB = (bf16*)(ws + WS_R3 + R3_KB), *VB = (bf16*)(ws + WS_R3 + R3_VB), *QP = (bf16*)(ws + WS_R3);


    if (IN(PH_PRO)) {
        for (int rep_ = 0; rep_ < NREP(PH_PRO); ++rep_) { if (rep_) xcd_barrier(bar);
        LAS float* scr = (LAS float*)(L + wave * 16384);
        const int gw = vcu * NWAVES + wave, NGW = G * NWAVES;
        constexpr int I_IN = (D / 64) * (INP / 32), I_QUP = (256 / 64) * (768 / 32), I_KV = (128 / 64) * (1024 / 32), I_SQ = (D / 64) * (D / 32), I_W2 = (D / 64) * (2048 / 32);
        constexpr int NITEMS = I_IN + I_QUP + I_KV + 2 * I_SQ + 2 * I_W2;
        for (int rp_ = 0; rp_ < 1 + (int)((PROBE_REP >> 20) & 1u); ++rp_)
        for (int it = gw; it < NITEMS; it += NGW) {
            int r = it;
            if (r < I_IN) { p0_transpose_item<1, false>(args.in[3], D, INC, Wt_in, INP, nullptr, scr, r, lane); continue; } r -= I_IN;
            if (r < I_QUP) { p0_transpose_item<0, true>(args.in[5], 256, 768, Wt_qup, 768, args.in[4], scr, r, lane); continue; } r -= I_QUP;
            if (r < I_KV) { p0_transpose_item<2, true>(args.in[7], 128, 1024, Wt_kv, 1024, args.in[6], scr, r, lane); continue; } r -= I_KV;
            if (r < I_SQ) { p0_transpose_item<0, false>(args.in[12], D, D, Wt_mix, D, nullptr, scr, r, lane); continue; } r -= I_SQ;
            if (r < I_SQ) { p0_transpose_item<0, false>(args.in[17], D, D, Wt_mo, D, nullptr, scr, r, lane); continue; } r -= I_SQ;
            if (r < I_W2) { p0_transpose_item<0, false>(args.in[16], D, 2048, Wt_mkv, 2048, nullptr, scr, r, lane); continue; } r -= I_W2;
            p0_transpose_item<0, true>(args.in[19], D, 2048, Wt_pq, 2048, args.in[18], scr, r, lane);
        }
        for (int rp_ = 0; rp_ < 1 + (int)((PROBE_REP >> 21) & 1u); ++rp_)
        for (int m = gw; m < M; m += 4 * NGW) rms_rows4_to_bf16(x, args.in[2], XN, m, NGW, M, lane);
        for (int m = gw; m < BATCH * NMEM; m += NGW) rms_row_to_bf16(args.in[1] + (size_t)m * D, args.in[14], MEMN + (size_t)m * D, lane);
        const size_t gtid = (size_t)vcu * NTHR + tid, gn = (size_t)G * NTHR;
        cvt_stream(args.in[20], SK, (size_t)PH * 2 * PNK * PHALF / 8, nullptr, gtid, gn);
        for (size_t i = gtid; i < (size_t)D * D / 8; i += gn) {
            const float4 a = *(const float4*)(args.in[15] + i * 8), b = *(const float4*)(args.in[15] + i * 8 + 4); const float gk = args.in[13][(i * 8) >> 10];
            pg8::u32x4 o; o.x = pg8::cvt_pk_bf16(a.x * gk, a.y * gk); o.y = pg8::cvt_pk_bf16(a.z * gk, a.w * gk); o.z = pg8::cvt_pk_bf16(b.x * gk, b.y * gk); o.w = pg8::cvt_pk_bf16(b.z * gk, b.w * gk);
            *(pg8::u32x4*)(Wt_mq + i * 8) = o; }
        for (int rp_ = 0; rp_ < 1 + (int)((PROBE_REP >> 22) & 1u); ++rp_) {
        cvt_rows_fp6<true>(args.in[21], (unsigned char*)PU, args.in[18], PU_SCALE, gtid, gn);
        cvt_rows_fp6<false>(args.in[22], (unsigned char*)PV, nullptr, PV_SCALE, gtid, gn); }
        for (size_t i = gtid; i < (size_t)SEQ * 16; i += gn) { float c, s; rope_cs((int)(i >> 4), (int)(i & 15), c, s); *(float2*)(trig + i * 2) = make_float2(c, s); }
        }
        SEAM(PH_PRO);
    }
    if (IN(PH_PROJ)) {
        for (int rep_ = 0; rep_ < NREP(PH_PROJ); ++rep_) { if (rep_) xcd_barrier(bar);
        { pg8::Gemm g{XN, Wt_in, M, INP, D, 0, 0, 0, 0}; pg8::StaticOrder S; S.init(M, INP, G, bx); pg8::EpiProj E{CQ, CKV, KB, U, partq, partkv, trig};
          pg8::gemm_phase<pg8::EpiProj, pg8::StaticOrder, true, true>(L, g, S, E); }
        { pg8::Gemm g{MEMN, Wt_mkv, BATCH * NMEM, 2048, D, 0, 0, 0, 0}; pg8::StaticOrder S; S.init(BATCH * NMEM, 2048, G, (bx + 128) % G); pg8::EpiPlain E{MEMKV, 2048};
          pg8::gemm_phase<pg8::EpiPlain, pg8::StaticOrder, true, true>(L, g, S, E); }
        }
        SEAM(PH_PROJ);
    }
    if (IN(PH_UP)) {
        for (int rep_ = 0; rep_ < NREP(PH_UP); ++rep_) { if (rep_) xcd_barrier(bar);
        if (IN(PHB_UPG)) {
        { pg8::Gemm g{CQ, Wt_qup, M, 768, 256, 0, 0, 0, 0}; pg8::StaticOrder S; S.init(M, 768, G, bx); pg8::EpiQ E{QB, partq, trig, LOG2E * 0.10206207261596577f};
          pg8::gemm_phase<pg8::EpiQ, pg8::StaticOrder, true, true>(L, g, S, E); }
        { pg8::Gemm g{CKV, Wt_kv, M, 1024, 128, 0, 0, 0, 0}; pg8::StaticOrder S; S.init(M, 1024, G, (bx + 192) % G); pg8::EpiKV E{KB, VB, partkv};
          pg8::gemm_phase<pg8::EpiKV, pg8::StaticOrder, true, true>(L, g, S, E); }
        }
        if (IN(PHB_CONV)) { __syncthreads(); for (int c = vcu; c < M / 64; c += G) conv_chunk(c, U, args.in[8], args.in[9], args.in[10], args.in[11], CONCAT, L); }
        }
        SEAM(PH_UP);
    }
    if (IN(PH_ATTN)) {
        for (int rep_ = 0; rep_ < NREP(PH_ATTN); ++rep_) { if (rep_) xcd_barrier(bar);
        for (int u = vcu; u < 512; u += G) { const int bh = (u & 255) >> 4, sidx = u & 15, qb = u < 256 ? 31 - sidx : sidx, b = bh >> 3, h = bh & 7;
            const size_t r0 = (size_t)b * SEQ;
            if (NREP(PH_ATTN) > 1 && rep_ == 0) attn_unit<96, 64, 1, 4, 3, true, false, PROBE_ATTVAR>(L, QB + (r0 + qb * 256) * 768 + h * 96, 768, KB + r0 * 768 + h * 96, 768, VB + r0 * 512 + h * 64, 512, CONCAT + (r0 + qb * 256) * D + h * 64, D, 4 * qb + 4, 4 * qb);
            else attn_mla_unit(L, QB + (r0 + qb * 256) * 768 + h * 96, KB + r0 * 768 + h * 96, VB + r0 * 512 + h * 64, CONCAT + (r0 + qb * 256) * D + h * 64, 4 * qb + 4, 4 * qb); }
        }
        { bf16* KQT = (bf16*)(ws + WS_KQT); bf16* VOT = (bf16*)(ws + WS_VOT);
#pragma unroll 1
          for (int bh = 0; bh < BATCH * XH; ++bh) { const int b = bh >> 2, h = bh & 3;
            { pg8::Gemm g{MEMKV + (size_t)b * NMEM * 2048 + h * XD, Wt_mq + h * XD, NMEM, D, XD, 2048, D, 0, 0}; pg8::StaticOrder S; S.init(NMEM, D, G, (bx + 8 * bh) % G);
              pg8::EpiPlain E{KQT + (size_t)b * D * D + (size_t)h * XD * D, D}; pg8::gemm_phase<pg8::EpiPlain, pg8::StaticOrder, true, true>(L, g, S, E); }
            { pg8::Gemm g{Wt_mo + h * XD, MEMKV + (size_t)b * NMEM * 2048 + 1024 + h * XD, D, NMEM, XD, D, 2048, 0, 0}; pg8::StaticOrder S; S.init(D, NMEM, G, (bx + 8 * bh + 4) % G);
              pg8::EpiPlain E{VOT + (size_t)b * D * D + h * XD, D}; pg8::gemm_phase<pg8::EpiPlain, pg8::StaticOrder, true, true>(L, g, S, E); } } }
        SEAM(PH_ATTN);
    }
    if (IN(PH_MIX)) {
        for (int rep_ = 0; rep_ < NREP(PH_MIX); ++rep_) { if (rep_) xcd_barrier(bar);
        pg8::Gemm g{CONCAT, Wt_mix, M, D, D, 0, 0, 0, 0}; pg8::StaticOrder S; S.init(M, D, G, bx); pg8::EpiRes<false> E{x, nullptr, H1B, part1};
        pg8::gemm_phase<pg8::EpiRes<false>, pg8::StaticOrder, true, true>(L, g, S, E);
        }
        SEAM(PH_MIX);
    }
    if (IN(PH_MEMQ)) {
        for (int rep_ = 0; rep_ < NREP(PH_MEMQ); ++rep_) { if (rep_) xcd_barrier(bar);
        pg8::Gemm g{H1B, (const bf16*)(ws + WS_KQT), M, D, D, 0, 0, SEQ / 256, (size_t)D * D * 2}; pg8::StaticOrder S; S.init(M, D, G, bx);
        pg8::EpiSoftmaxP E{OM, D, part1, LOG2E / 16.0f, (LAS float*)(L + 131072)};
        pg8::gemm_phase<pg8::EpiSoftmaxP, pg8::StaticOrder, true, true>(L, g, S, E);
        }
        SEAM(PH_MEMQ);
    }
    if (IN(PH_MEMO)) {
        pg8::Gemm g{OM, (const bf16*)(ws + WS_VOT), M, D, D, 0, 0, SEQ / 256, (size_t)D * D * 2};   pg8::StaticOrder S; S.init(M, D, G, bx); pg8::EpiRes<true> E{nullptr, H1B, H2B, part2};
        pg8::gemm_phase<pg8::EpiRes<true>, pg8::StaticOrder, true, true>(L, g, S, E);
        SEAM(PH_MEMO);
    }
    if (IN(PH_PQ)) {
        for (int rep_ = 0; rep_ < NREP(PH_PQ); ++rep_) { if (rep_) xcd_barrier(bar);
        pg8::Gemm g{H2B, Wt_pq, M, 2048, D, 0, 0, 0, 0}; pg8::StaticOrder S; S.init(M, 2048, G, bx); pg8::EpiScaled E{QP, 2048, part2, 1.0f};
        pg8::gemm_phase<pg8::EpiScaled, pg8::StaticOrder, true, true>(L, g, S, E);
        own_writes_visible();
        int* EIDX = (int*)(ws + WS_R2 + R2_EIDX); float* EGATE = (float*)(ws + WS_R2 + R2_EGATE);
        LAS unsigned* scr = (LAS unsigned*)(L + 65536 + wave * 64 * 9 * 4);
        int hl = -1, upm, upn;
        for (int i = 0; unit_of(M, 2048, G, bx, i, upm, upn); ++i) { const int tb = upm, h = upn;
            if (h != hl) {
                __syncthreads();
                for (int pc = tid; pc < 4096; pc += NTHR) { const int p = pc >> 11, n = (pc >> 4) & 127, c = pc & 15;
                    *(LAS pg8::u32x4*)(L + p * 32768 + c * 2048 + n * 16) = *(const pg8::u32x4*)(SK + ((size_t)(h * 2 + p) * 128 + n) * 128 + c * 8); }
                __syncthreads(); hl = h; }
            const int token = tb * 256 + wave * 32 + (lane & 31);
            topk_wave(QP + (size_t)token * 2048 + h * 256, L, scr, EIDX + (size_t)token * 128 + h * 16, EGATE + (size_t)token * 128 + h * 16, lane); }
        __syncthreads();
        }
        SEAM(PH_PQ);
    }
    if (IN(PH_EXP)) {
        const int* EIDX = (const int*)(ws + WS_R2 + R2_EIDX); const float* EGATE = (const float*)(ws + WS_R2 + R2_EGATE);
#ifndef EXP_PREWARM
#define EXP_PREWARM 0
#endif
        if (EXP_PREWARM) {
            const pg8::u32x4* tb = (const pg8::u32x4*)PU; pg8::u32x4 x = {0u, 0u, 0u, 0u};
            for (size_t i = (size_t)vcu * NTHR + tid; i < (size_t)2 * PE * D / 16; i += (size_t)G * NTHR) { const pg8::u32x4 v = __builtin_nontemporal_load(tb + i); x ^= v; }
            if ((x[0] ^ x[1] ^ x[2] ^ x[3]) == 0x9e3779b9u && tid == 999) out[0] = 0.f;
        }
        for (int rep_ = NREP(PH_EXP) - 1; rep_ >= 0; --rep_) { float* dst = rep_ ? (float*)(ws + WS_R3) : out;
            if (rep_) { if (PROBE_EXPVAR != 5 || wave < 4) experts_wave<PROBE_EXPVAR == 5 ? 0 : PROBE_EXPVAR>(L + wave * EXP_LDS_WAVE, vcu * NWAVES + wave, G * NWAVES, H2B, part2, (const unsigned char*)PU, (const unsigned char*)PV, EIDX, EGATE, args.in[23], dst, lane); } else
            experts_wave<0>(L + wave * EXP_LDS_WAVE, vcu * NWAVES + wave, G * NWAVES, H2B, part2, (const unsigned char*)PU, (const unsigned char*)PV, EIDX, EGATE, args.in[23], dst, lane);
            if (rep_) xcd_barrier(bar); }
    }
#undef IN
#undef SEAM
}

#define FAST_MASK ((1u << PH_PRO) | (1u << PH_PROJ) | (1u << PH_UP) | (1u << PHB_UPG) | (1u << PHB_CONV) | (1u << PH_ATTN) | (1u << PH_MIX) | (1u << PH_MEMQ) | (1u << PH_MEMO) | (1u << PH_PQ) | (1u << PH_EXP))
extern "C" void kernel_launch(void* const* d_in, const int* in_sizes, int n_in, void* d_out, int out_size, void* d_ws, size_t ws_size, hipStream_t stream) {
    if (n_in != 24 || out_size != M * D || ws_size < WS_END) { fprintf(stderr, "kernel_launch: unexpected problem (n_in %d out %d ws %zu)\n", n_in, out_size, ws_size); return; }
    static int grid = 0;
    if (grid == 0) {
        int dev = 0, cus = 0, per_cu = 0;
        if (hipGetDevice(&dev) != hipSuccess || hipDeviceGetAttribute(&cus, hipDeviceAttributeMultiprocessorCount, dev) != hipSuccess) { grid = -1; return; }
        if (hipFuncSetAttribute((const void*)mega, hipFuncAttributeMaxDynamicSharedMemorySize, LDS_BYTES) != hipSuccess) { fprintf(stderr, "kernel_launch: hipFuncSetAttribute failed\n"); grid = -1; return; }
        if (hipOccupancyMaxActiveBlocksPerMultiprocessor(&per_cu, (const void*)mega, NTHR, LDS_BYTES) != hipSuccess || per_cu < 1) { fprintf(stderr, "kernel_launch: occupancy query says %d blocks per CU\n", per_cu); grid = -1; (void)hipGetLastError(); return; }
        grid = cus;
    }
    if (grid < 0) return;
    (void)hipMemsetAsync((char*)d_ws + WS_CTL, 0, CTL_ZERO_BYTES, stream);
    Args a{}; for (int i = 0; i < 24; ++i) a.in[i] = (const float*)d_in[i]; a.out = (float*)d_out; a.ws = (unsigned char*)d_ws; a.mask = FAST_MASK; a.li = 0;
    hipLaunchKernelGGL(mega, dim3(grid), dim3(NTHR), LDS_BYTES, stream, a);
}
```

```cpp
#include <hip/hip_runtime.h>
#include <cstdio>
#include <cstdint>

typedef unsigned short bf16;
#define DEVI __device__ __forceinline__

constexpr int D = 1024, BATCH = 2, SEQ = 8192, M = BATCH * SEQ;
constexpr int NMEM = 256;
constexpr int MH = 8, QRANK = 256, KVRANK = 128, NOPE = 64, ROPE = 32, VD = 64, QK = NOPE + ROPE;
constexpr int CW = 512, CK = 31;
constexpr int INC = QRANK + KVRANK + ROPE + 2 * CW;
constexpr int INP = 1536;
constexpr int XH = 4, XD = 256;
constexpr int PH = 8, PNK = 128, PHALF = 128, PTOP = 16, PE = PNK * PNK;
constexpr float EPS = 1e-6f;
constexpr float LOG2E = 1.4426950408889634f;
constexpr float PU_SCALE = 64.0f, PV_SCALE = 4.0f;

constexpr size_t MiB = 1u << 20;
constexpr size_t WS_CTL = 0;
constexpr size_t WS_WIN = 1 * MiB;
constexpr size_t WS_WQUP = 4 * MiB;
constexpr size_t WS_WKV = 5 * MiB;
constexpr size_t WS_WMIX = 6 * MiB;
constexpr size_t WS_WMQ = 8 * MiB;
constexpr size_t WS_WMKV = 10 * MiB;
constexpr size_t WS_WMO = 14 * MiB;
constexpr size_t WS_WPQ = 16 * MiB;
constexpr size_t WS_SK = 20 * MiB;
constexpr size_t WS_MEMN = 21 * MiB;
constexpr size_t WS_MEMKV = 22 * MiB;
constexpr size_t WS_PARTQ = 24 * MiB;
constexpr size_t WS_PARTKV = 24 * MiB + 512 * 1024;
constexpr size_t WS_PART1 = 25 * MiB;
constexpr size_t WS_PART2 = 26 * MiB;
constexpr size_t WS_PU = 28 * MiB;
constexpr size_t WS_PV = 60 * MiB;
constexpr size_t WS_R1 = 92 * MiB;
constexpr size_t WS_R2 = 124 * MiB;
constexpr size_t WS_R3 = 156 * MiB;
constexpr size_t WS_KQT = 220 * MiB;
constexpr size_t WS_VOT = 224 * MiB;
constexpr size_t WS_END = 228 * MiB;
constexpr size_t R2_CQ = 0, R2_CKV = 8 * MiB, R2_U = 12 * MiB;
constexpr size_t R2_EIDX = 0, R2_EGATE = 8 * MiB;
constexpr size_t R3_QB = 0, R3_KB = 24 * MiB, R3_VB = 48 * MiB;

DEVI bf16 f2bf(float f) { unsigned u = __builtin_bit_cast(unsigned, f); return (bf16)((u + 0x7fffu + ((u >> 16) & 1u)) >> 16); }
DEVI float bf2f(bf16 b) { return __builtin_bit_cast(float, (unsigned)b << 16); }
DEVI float dotbf(const bf16* a, const bf16* b, int K) {
    float s = 0.f;
    for (int k = 0; k < K; k += 8) {
        uint4 x = *(const uint4*)(a + k), y = *(const uint4*)(b + k);
        const unsigned xs[4] = {x.x, x.y, x.z, x.w}, ys[4] = {y.x, y.y, y.z, y.w};
#pragma unroll
        for (int i = 0; i < 4; ++i) {
            s += __builtin_bit_cast(float, xs[i] << 16) * __builtin_bit_cast(float, ys[i] << 16);
            s += __builtin_bit_cast(float, xs[i] & 0xffff0000u) * __builtin_bit_cast(float, ys[i] & 0xffff0000u);
        }
    }
    return s;
}
DEVI float wave_sum(float v) {
#pragma unroll
    for (int o = 1; o < 64; o <<= 1) v += __shfl_xor(v, o);
    return v;
}
DEVI float wave_max(float v) {
#pragma unroll
    for (int o = 1; o < 64; o <<= 1) v = fmaxf(v, __shfl_xor(v, o));
    return v;
}
DEVI void rope_cs(int pos, int i, float& c, float& s) {
    const float inv = exp2f(-(float)i * (13.287712379549449f / 16.0f));
    const float ang = (float)pos * inv;
    const double a = (double)ang; const double k = rint(a * 0.15915494309189535); const float r = (float)(a - k * 6.283185307179586);
    s = sinf(r); c = cosf(r);
}
DEVI int win_src(int r) {
    if (r < 416) return r;
    if (r < 512) return -1;
    const int t = (r - 512) >> 8, w = (r - 512) & 255, bj = w >> 7, j = w & 127, ch = 128 * t + j;
    return 416 + (bj ? CW : 0) + ch;
}
DEVI int wkv_src(int r) { return r < 512 ? (r >> 6) * 128 + (r & 63) : ((r - 512) >> 6) * 128 + 64 + ((r - 512) & 63); }

namespace pg8 {
#define PG8_LAS __attribute__((address_space(3)))
typedef unsigned short bf16_t;
typedef short bf16x8 __attribute__((ext_vector_type(8)));
typedef float f32x4 __attribute__((ext_vector_type(4)));
typedef unsigned u32x4 __attribute__((ext_vector_type(4)));
constexpr int BM = 256, BK = 64, HALF = 128, HTB = HALF * BK * 2  , STAGE_BYTES = 8 * HTB, NXCD = 8, WGM = 8;

__host__ __device__ __forceinline__ int lds_byte(int r, int c) { const int st = (r >> 4) * 2 + (c >> 5), rr = r & 15, cc = c & 31, ob = rr * 64 + cc * 2; return st * 1024 + (ob ^ (((ob >> 9) & 1) << 5)); }
__host__ __device__ __forceinline__ void stage_rc(int b, int& R, int& C) { const int st = b / 1024, sb = b % 1024, swz = sb ^ (((sb >> 9) & 1) << 5); R = (st >> 1) * 16 + swz / 64; C = (st & 1) * 32 + (swz % 64) / 2; }
__host__ __device__ __forceinline__ int perm32(int rho) { const int n = rho >> 4, i = rho & 15; return 8 * (i >> 2) + 4 * n + (i & 3); }

struct Unit { int pm, pn; };
struct Gemm { const bf16_t* A; const bf16_t* Bt; int M, N, K; int lda, ldb; int mb; size_t bstride; };

struct StaticOrder {
    int nM, nN, nwg, G, c;
    __host__ __device__ void init(int M, int N, int G_, int c_) { nM = M / BM; nN = N / BM; nwg = nM * nN; G = G_; c = c_; }
    __host__ __device__ bool next(int i, Unit& u) const {
        const long L = (long)i * G + c; if (L >= nwg) return false;
        int wgid = (int)L; { const int q = nwg / NXCD, r = nwg % NXCD, xcd = wgid % NXCD, off = wgid / NXCD; wgid = (xcd < r ? xcd * (q + 1) : r * (q + 1) + (xcd - r) * q) + off; }
        const int nig = WGM * nN, gid = wgid / nig, fm = gid * WGM, gsz = (nM - fm) < WGM ? (nM - fm) : WGM;
        u.pm = fm + ((wgid % nig) % gsz); u.pn = (wgid % nig) / gsz; return true;
    }
    __device__ __forceinline__ void a_ready(const Unit&) const {}
    __device__ __forceinline__ void done(const Unit&) const {}
};


typedef float f32x2 __attribute__((ext_vector_type(2)));
typedef unsigned u32x2 __attribute__((ext_vector_type(2)));
__device__ __forceinline__ unsigned cvt_pk_bf16(float lo, float hi) { unsigned r; asm volatile("v_cvt_pk_bf16_f32 %0, %1, %2" : "=v"(r) : "v"(lo), "v"(hi)); return r; }
__device__ __forceinline__ void st_bf4(bf16_t* p, f32x4 v) { u32x2 w; w.x = cvt_pk_bf16(v[0], v[1]); w.y = cvt_pk_bf16(v[2], v[3]); *(u32x2*)p = w; }
__device__ __forceinline__ float sq4(f32x4 v) { return (v[0] * v[0] + v[1] * v[1]) + (v[2] * v[2] + v[3] * v[3]); }
__device__ __forceinline__ float red_fq(float s) { s += __shfl_xor(s, 16); s += __shfl_xor(s, 32); return s; }

struct EpiProj {
    static constexpr bool PERM = false, AFTER_DRAIN = false;
    bf16_t *CQ, *CKV, *KB, *U; float *partq, *partkv; const float* trig;
    __device__ __forceinline__ void operator()(const f32x4 (&acc)[2][2][4][2], const Unit& u, int wr, int wc, int fr, int fq) const {
        const int row0 = u.pm * BM + wr * 64 + fr;
        if (u.pn == 0) {
#pragma unroll
            for (int ai = 0; ai < 2; ++ai)
#pragma unroll
                for (int m = 0; m < 4; ++m) { const int row = row0 + ai * HALF + m * 16; float s = 0.f;
#pragma unroll
                    for (int bj = 0; bj < 2; ++bj)
#pragma unroll
                        for (int n = 0; n < 2; ++n) { const f32x4 v = acc[ai][bj][m][n]; s += sq4(v); st_bf4(CQ + (size_t)row * 256 + bj * HALF + wc * 32 + n * 16 + fq * 4, v); }
                    s = red_fq(s); if (fq == 0) partq[(size_t)row * 4 + wc] = s; }
        } else if (u.pn == 1) {
            f32x4 tc0 = {0.f, 0.f, 0.f, 0.f}, tc1 = tc0, tn0 = tc0, tn1 = tc0;
            if (wc == 0) { const float* tp = trig + ((size_t)(row0 % SEQ) * 16 + fq * 4) * 2; tc0 = *(const f32x4*)tp; tc1 = *(const f32x4*)(tp + 4); }
#pragma unroll
            for (int i8 = 0; i8 < 8; ++i8) { const int ai = i8 >> 2, m = i8 & 3; const int row = row0 + ai * HALF + m * 16; float s = 0.f;
                if (wc == 0 && i8 < 7) { const int rown = row0 + ((i8 + 1) >> 2) * HALF + ((i8 + 1) & 3) * 16; const float* tp = trig + ((size_t)(rown % SEQ) * 16 + fq * 4) * 2; tn0 = *(const f32x4*)tp; tn1 = *(const f32x4*)(tp + 4); }
#pragma unroll
                for (int n = 0; n < 2; ++n) { const f32x4 v = acc[ai][0][m][n]; s += sq4(v); st_bf4(CKV + (size_t)row * 128 + wc * 32 + n * 16 + fq * 4, v); }
                s = red_fq(s); if (fq == 0) partkv[(size_t)row * 4 + wc] = s;
                if (wc == 0) { const f32x4 x1 = acc[ai][1][m][0], x2 = acc[ai][1][m][1]; const f32x4 t0 = tc0, t1 = tc1;
                    f32x4 o1, o2; o1[0] = x1[0] * t0[0] - x2[0] * t0[1]; o2[0] = x1[0] * t0[1] + x2[0] * t0[0]; o1[1] = x1[1] * t0[2] - x2[1] * t0[3]; o2[1] = x1[1] * t0[3] + x2[1] * t0[2];
                    o1[2] = x1[2] * t1[0] - x2[2] * t1[1]; o2[2] = x1[2] * t1[1] + x2[2] * t1[0]; o1[3] = x1[3] * t1[2] - x2[3] * t1[3]; o2[3] = x1[3] * t1[3] + x2[3] * t1[2];
                    u32x2 w1, w2; w1.x = cvt_pk_bf16(o1[0], o1[1]); w1.y = cvt_pk_bf16(o1[2], o1[3]); w2.x = cvt_pk_bf16(o2[0], o2[1]); w2.y = cvt_pk_bf16(o2[2], o2[3]);
#pragma unroll
                    for (int h = 0; h < 8; ++h) { *(u32x2*)(KB + (size_t)row * 768 + h * 96 + 64 + fq * 4) = w1; *(u32x2*)(KB + (size_t)row * 768 + h * 96 + 80 + fq * 4) = w2; } }
                tc0 = tn0; tc1 = tn1; asm volatile("" ::: "memory"); }
        } else {
            const int t = u.pn - 2;
#pragma unroll
            for (int ai = 0; ai < 2; ++ai)
#pragma unroll
                for (int m = 0; m < 4; ++m) { const int row = row0 + ai * HALF + m * 16;
#pragma unroll
                    for (int n = 0; n < 2; ++n) { const f32x4 val = acc[ai][0][m][n], gate = acc[ai][1][m][n]; f32x4 o;
#pragma unroll
                        for (int i = 0; i < 4; ++i) o[i] = val[i] * __builtin_amdgcn_rcpf(1.f + __expf(-gate[i]));
                        st_bf4(U + (size_t)row * 512 + t * 128 + wc * 32 + n * 16 + fq * 4, o); } }
        }
    }
};
struct EpiQ {
    static constexpr bool PERM = false, AFTER_DRAIN = false;
    bf16_t* QB; const float* partq; const float* trig; float c2;
    __device__ __forceinline__ void operator()(const f32x4 (&acc)[2][2][4][2], const Unit& u, int wr, int wc, int fr, int fq) const {
        const int row0 = u.pm * BM + wr * 64 + fr;
        const bool rope = ((u.pn * 8 + wc) % 3 == 2) || ((u.pn * 8 + 4 + wc) % 3 == 2);
        f32x4 ppc = *(const f32x4*)(partq + (size_t)row0 * 4), ppn = ppc;
        f32x4 tc0 = {0.f, 0.f, 0.f, 0.f}, tc1 = tc0, tn0 = tc0, tn1 = tc0;
        if (rope) { const float* tp = trig + ((size_t)(row0 % SEQ) * 16 + fq * 4) * 2; tc0 = *(const f32x4*)tp; tc1 = *(const f32x4*)(tp + 4); }
#pragma unroll
        for (int i8 = 0; i8 < 8; ++i8) { const int ai = i8 >> 2, m = i8 & 3; const int row = row0 + ai * HALF + m * 16;
            if (i8 < 7) { const int rown = row0 + ((i8 + 1) >> 2) * HALF + ((i8 + 1) & 3) * 16; ppn = *(const f32x4*)(partq + (size_t)rown * 4);
                if (rope) { const float* tp = trig + ((size_t)(rown % SEQ) * 16 + fq * 4) * 2; tn0 = *(const f32x4*)tp; tn1 = *(const f32x4*)(tp + 4); } }
            const float rs = rsqrtf(((ppc[0] + ppc[1]) + (ppc[2] + ppc[3])) * (1.f / 256.f) + EPS) * c2;
#pragma unroll
            for (int bj = 0; bj < 2; ++bj) { const int g = u.pn * 8 + bj * 4 + wc; bf16_t* dst = QB + (size_t)row * 768 + g * 32 + fq * 4;
                if (g % 3 != 2) { st_bf4(dst, acc[ai][bj][m][0] * rs); st_bf4(dst + 16, acc[ai][bj][m][1] * rs); }
                else { const f32x4 x1 = acc[ai][bj][m][0] * rs, x2 = acc[ai][bj][m][1] * rs; const f32x4 t0 = tc0, t1 = tc1;
                    f32x4 o1, o2; o1[0] = x1[0] * t0[0] - x2[0] * t0[1]; o2[0] = x1[0] * t0[1] + x2[0] * t0[0]; o1[1] = x1[1] * t0[2] - x2[1] * t0[3]; o2[1] = x1[1] * t0[3] + x2[1] * t0[2];
                    o1[2] = x1[2] * t1[0] - x2[2] * t1[1]; o2[2] = x1[2] * t1[1] + x2[2] * t1[0]; o1[3] = x1[3] * t1[2] - x2[3] * t1[3]; o2[3] = x1[3] * t1[3] + x2[3] * t1[2];
                    st_bf4(dst, o1); st_bf4(dst + 16, o2); } }
            ppc = ppn; tc0 = tn0; tc1 = tn1; asm volatile("" ::: "memory"); }
    }
};
struct EpiKV {
    static constexpr bool PERM = false, AFTER_DRAIN = false;
    bf16_t *KB, *VB; const float* partkv;
    __device__ __forceinline__ void operator()(const f32x4 (&acc)[2][2][4][2], const Unit& u, int wr, int wc, int fr, int fq) const {
        const int row0 = u.pm * BM + wr * 64 + fr;
        f32x4 ppc = *(const f32x4*)(partkv + (size_t)row0 * 4), ppn = ppc;
#pragma unroll
        for (int i8 = 0; i8 < 8; ++i8) { const int ai = i8 >> 2, m = i8 & 3; const int row = row0 + ai * HALF + m * 16;
            if (i8 < 7) { const int rown = row0 + ((i8 + 1) >> 2) * HALF + ((i8 + 1) & 3) * 16; ppn = *(const f32x4*)(partkv + (size_t)rown * 4); }
            const float rs = rsqrtf(((ppc[0] + ppc[1]) + (ppc[2] + ppc[3])) * (1.f / 128.f) + EPS);
#pragma unroll
            for (int bj = 0; bj < 2; ++bj)
#pragma unroll
                for (int n = 0; n < 2; ++n) { const int c = u.pn * BM + bj * HALF + wc * 32 + n * 16 + fq * 4; const f32x4 v = acc[ai][bj][m][n] * rs;
                    if (u.pn < 2) st_bf4(KB + (size_t)row * 768 + (c >> 6) * 96 + (c & 63), v); else st_bf4(VB + (size_t)row * 512 + (c - 512), v); }
            ppc = ppn; asm volatile("" ::: "memory"); }
    }
};
template <bool BF16RES> struct EpiRes {
    static constexpr bool PERM = false, AFTER_DRAIN = false;
    const float* res; const bf16_t* resb; bf16_t* outb; float* part;
    __device__ __forceinline__ f32x4 ldres(size_t off) const {
        if (BF16RES) { const u32x2 rb = *(const u32x2*)(resb + off); f32x4 r; r[0] = __builtin_bit_cast(float, rb.x << 16); r[1] = __builtin_bit_cast(float, rb.x & 0xffff0000u); r[2] = __builtin_bit_cast(float, rb.y << 16); r[3] = __builtin_bit_cast(float, rb.y & 0xffff0000u); return r; }
        return *(const f32x4*)(res + off); }
    __device__ __forceinline__ void operator()(const f32x4 (&acc)[2][2][4][2], const Unit& u, int wr, int wc, int fr, int fq) const {
        const int row0 = u.pm * BM + wr * 64 + fr; const int cb = u.pn * BM + wc * 32 + fq * 4;
        f32x4 rc[4], rn[4];
#pragma unroll
        for (int j = 0; j < 4; ++j) { rc[j] = ldres((size_t)row0 * 1024 + cb + (j >> 1) * HALF + (j & 1) * 16); rn[j] = rc[j]; }
#pragma unroll
        for (int i8 = 0; i8 < 8; ++i8) { const int ai = i8 >> 2, m = i8 & 3; const int row = row0 + ai * HALF + m * 16; float s = 0.f;
            if (i8 < 7) { const int rown = row0 + ((i8 + 1) >> 2) * HALF + ((i8 + 1) & 3) * 16;
#pragma unroll
                for (int j = 0; j < 4; ++j) rn[j] = ldres((size_t)rown * 1024 + cb + (j >> 1) * HALF + (j & 1) * 16); }
#pragma unroll
            for (int bj = 0; bj < 2; ++bj)
#pragma unroll
                for (int n = 0; n < 2; ++n) { const size_t off = (size_t)row * 1024 + cb + bj * HALF + n * 16;
                    const f32x4 v = acc[ai][bj][m][n] + rc[bj * 2 + n]; st_bf4(outb + off, v); s += sq4(v); }
            s = red_fq(s); if (fq == 0) part[(size_t)row * 16 + u.pn * 4 + wc] = s;
#pragma unroll
            for (int j = 0; j < 4; ++j) rc[j] = rn[j];
            asm volatile("" ::: "memory"); }
    }
};
struct EpiScaled {
    static constexpr bool PERM = false, AFTER_DRAIN = false;
    bf16_t* out; int ldc; const float* part; float mul;
    __device__ __forceinline__ void operator()(const f32x4 (&acc)[2][2][4][2], const Unit& u, int wr, int wc, int fr, int fq) const {
        const int row0 = u.pm * BM + wr * 64 + fr;
        float rs8[8];
#pragma unroll
        for (int hb = 0; hb < 2; ++hb) { f32x4 q[4][4];
#pragma unroll
            for (int k = 0; k < 4; ++k) { const int row = row0 + hb * HALF + k * 16; const f32x4* pp = (const f32x4*)(part + (size_t)row * 16);
#pragma unroll
                for (int j = 0; j < 4; ++j) q[k][j] = pp[j]; }
#pragma unroll
            for (int k = 0; k < 4; ++k) { const f32x4 a = q[k][0], b = q[k][1], c = q[k][2], d = q[k][3];
                const float ss = (((a[0] + a[1]) + (a[2] + a[3])) + ((b[0] + b[1]) + (b[2] + b[3]))) + (((c[0] + c[1]) + (c[2] + c[3])) + ((d[0] + d[1]) + (d[2] + d[3])));
                rs8[hb * 4 + k] = rsqrtf(ss * (1.f / 1024.f) + EPS) * mul; } }
#pragma unroll
        for (int i8 = 0; i8 < 8; ++i8) { const int ai = i8 >> 2, m = i8 & 3; const int row = row0 + ai * HALF + m * 16; const float rs = rs8[i8];
#pragma unroll
            for (int bj = 0; bj < 2; ++bj)
#pragma unroll
                for (int n = 0; n < 2; ++n) st_bf4(out + (size_t)row * ldc + u.pn * BM + bj * HALF + wc * 32 + n * 16 + fq * 4, acc[ai][bj][m][n] * rs);
            asm volatile("" ::: "memory"); }
    }
};
struct EpiSoftmaxP {
    static constexpr bool PERM = false, AFTER_DRAIN = false;
    bf16_t* out; int ldc; const float* part; float mul; PG8_LAS float* scr;
    __device__ __forceinline__ float rscale(int row) const { const f32x4* pp = (const f32x4*)(part + (size_t)row * 16); const f32x4 a = pp[0], b = pp[1], c = pp[2], d = pp[3];
        const float ss = (((a[0] + a[1]) + (a[2] + a[3])) + ((b[0] + b[1]) + (b[2] + b[3]))) + (((c[0] + c[1]) + (c[2] + c[3])) + ((d[0] + d[1]) + (d[2] + d[3]))); return rsqrtf(ss * (1.f / 1024.f) + EPS) * mul; }
    __device__ __forceinline__ void operator()(const f32x4 (&acc)[2][2][4][2], const Unit& u, int wr, int wc, int fr, int fq) const {
        PG8_LAS float* P1 = scr; PG8_LAS float* P2 = scr + 1024; float rs8[8];
#define EPS_BAR() do { asm volatile("s_waitcnt lgkmcnt(0)" ::: "memory"); __builtin_amdgcn_s_barrier(); asm volatile("" ::: "memory"); } while (0)
#pragma unroll
        for (int ai = 0; ai < 2; ++ai)
#pragma unroll
            for (int m = 0; m < 4; ++m) { float mx = -3.0e38f;
#pragma unroll
                for (int bj = 0; bj < 2; ++bj)
#pragma unroll
                    for (int n = 0; n < 2; ++n) { const f32x4 v = acc[ai][bj][m][n]; mx = fmaxf(mx, fmaxf(fmaxf(v[0], v[1]), fmaxf(v[2], v[3]))); }
                mx = fmaxf(mx, __shfl_xor(mx, 16)); mx = fmaxf(mx, __shfl_xor(mx, 32));
                if (fq == 0) P1[(ai * HALF + wr * 64 + m * 16 + fr) * 4 + wc] = mx; }
        EPS_BAR();
#pragma unroll
        for (int ai = 0; ai < 2; ++ai)
#pragma unroll
            for (int m = 0; m < 4; ++m) { const int rl = ai * HALF + wr * 64 + m * 16 + fr; const f32x4 q = *(const PG8_LAS f32x4*)(P1 + rl * 4);
                const float mx = fmaxf(fmaxf(q[0], q[1]), fmaxf(q[2], q[3])), rs = rscale(u.pm * BM + rl); float sm = 0.f; rs8[ai * 4 + m] = rs;
#pragma unroll
                for (int bj = 0; bj < 2; ++bj)
#pragma unroll
                    for (int n = 0; n < 2; ++n) { const f32x4 v = acc[ai][bj][m][n];
#pragma unroll
                        for (int i = 0; i < 4; ++i) sm += __builtin_amdgcn_exp2f((v[i] - mx) * rs); }
                sm += __shfl_xor(sm, 16); sm += __shfl_xor(sm, 32);
                if (fq == 0) P2[rl * 4 + wc] = sm; asm volatile("" ::: "memory"); }
        EPS_BAR();
#pragma unroll
        for (int ai = 0; ai < 2; ++ai)
#pragma unroll
            for (int m = 0; m < 4; ++m) { const int rl = ai * HALF + wr * 64 + m * 16 + fr; const f32x4 q = *(const PG8_LAS f32x4*)(P1 + rl * 4), w = *(const PG8_LAS f32x4*)(P2 + rl * 4);
                const float mx = fmaxf(fmaxf(q[0], q[1]), fmaxf(q[2], q[3])), rs = rs8[ai * 4 + m], inv = 1.0f / ((w[0] + w[1]) + (w[2] + w[3]));
#pragma unroll
                for (int bj = 0; bj < 2; ++bj)
#pragma unroll
                    for (int n = 0; n < 2; ++n) { const f32x4 v = acc[ai][bj][m][n]; f32x4 o;
#pragma unroll
                        for (int i = 0; i < 4; ++i) o[i] = __builtin_amdgcn_exp2f((v[i] - mx) * rs) * inv;
                        st_bf4(out + (size_t)(u.pm * BM + rl) * ldc + u.pn * BM + bj * HALF + wc * 32 + n * 16 + fq * 4, o); }
                asm volatile("" ::: "memory"); }
        EPS_BAR();
#undef EPS_BAR
    }
};
struct EpiPlain {
    static constexpr bool PERM = false, AFTER_DRAIN = false;
    bf16_t* out; int ldc;
    __device__ __forceinline__ void operator()(const f32x4 (&acc)[2][2][4][2], const Unit& u, int wr, int wc, int fr, int fq) const {
        const int row0 = u.pm * BM + wr * 64 + fr;
#pragma unroll
        for (int ai = 0; ai < 2; ++ai)
#pragma unroll
            for (int m = 0; m < 4; ++m) { const int row = row0 + ai * HALF + m * 16;
#pragma unroll
                for (int bj = 0; bj < 2; ++bj)
#pragma unroll
                    for (int n = 0; n < 2; ++n) st_bf4(out + (size_t)row * ldc + u.pn * BM + bj * HALF + wc * 32 + n * 16 + fq * 4, acc[ai][bj][m][n]); }
    }
};
template <class Epi, class Sched, bool ALIGN_EPI = false, bool SP2 = false>
__device__ __forceinline__ void gemm_phase(PG8_LAS unsigned char* lds, const Gemm g, const Sched& S, const Epi& E) {
    int tid_ = threadIdx.x; asm volatile("" : "+v"(tid_));
    const int tid = tid_, wid = __builtin_amdgcn_readfirstlane(tid >> 6), lane = tid & 63, wr = wid >> 2, wc = wid & 3, fr = lane & 15, fq = lane >> 4;
    const int K = g.K, nt = K / BK, lda = g.lda ? g.lda : K, ldb = g.ldb ? g.ldb : K;
#define PG8_BOFF(pm_) (g.mb ? (size_t)((pm_) / g.mb) * g.bstride : (size_t)0)
    unsigned voffA[2], voffB[2];
#pragma unroll
    for (int i = 0; i < 2; ++i) { int R, C; stage_rc(tid * 16 + i * 8192, R, C); const int Rb = Epi::PERM ? ((R & ~31) + perm32(R & 31)) : R;
        voffA[i] = (unsigned)(R * lda + C) * 2u; voffB[i] = (unsigned)(Rb * ldb + C) * 2u; }
    const size_t kstep = (size_t)(BK * 2);
    const size_t hstepA = (size_t)HALF * lda * 2, hstepB = (size_t)HALF * ldb * 2;
    const size_t tstepA = 2 * hstepA, tstepB = 2 * hstepB;
    const unsigned ldsw = (unsigned)wid * 1024u;
    const int aoff = lds_byte(wr * 64 + fr, fq * 8), boff = lds_byte(wc * 32 + fr, fq * 8);
#define PG8_SA(b, h) (((b) * 2 + (h)) * HTB)
#define PG8_SB(b, h) ((4 + (b) * 2 + (h)) * HTB)
#define PG8_STAGE(bufoff, gbase, voff) do { _Pragma("unroll") for (int _i = 0; _i < 2; ++_i) \
        __builtin_amdgcn_global_load_lds((const unsigned*)((const char*)(gbase) + (voff)[_i]), (PG8_LAS unsigned*)(lds + (bufoff) + ldsw + _i * 8192), 16, 0, 0); } while (0)
#define PG8_LDA(dst, b, h) do { _Pragma("unroll") for (int m = 0; m < 4; ++m) _Pragma("unroll") for (int k = 0; k < 2; ++k) dst[m][k] = *(const PG8_LAS bf16x8*)(lds + PG8_SA(b, h) + aoff + m * 2048 + k * 1024); } while (0)
#define PG8_LDB(dst, b, h) do { _Pragma("unroll") for (int n = 0; n < 2; ++n) _Pragma("unroll") for (int k = 0; k < 2; ++k) dst[n][k] = *(const PG8_LAS bf16x8*)(lds + PG8_SB(b, h) + boff + n * 2048 + k * 1024); } while (0)
#define PG8_MMA(ai, bj, At, Bt) do { __builtin_amdgcn_s_setprio(1); _Pragma("unroll") for (int m = 0; m < 4; ++m) _Pragma("unroll") for (int n = 0; n < 2; ++n) _Pragma("unroll") for (int k = 0; k < 2; ++k) \
        acc[ai][bj][m][n] = __builtin_amdgcn_mfma_f32_16x16x32_bf16(Bt[n][k], At[m][k], acc[ai][bj][m][n], 0, 0, 0); __builtin_amdgcn_s_setprio(0); } while (0)
#define PG8_WAIT_V(n) asm volatile("s_waitcnt vmcnt(" #n ")" ::: "memory")
#define PG8_WAIT_L(n) asm volatile("s_waitcnt lgkmcnt(" #n ")" ::: "memory")
#define PG8_BAR __builtin_amdgcn_s_barrier()
#define PG8_SCHED __builtin_amdgcn_sched_barrier(0)
    Unit cur, nxt; int ui = 0;
    if (!S.next(0, cur)) return;
    f32x4 acc[2][2][4][2];
#pragma unroll
    for (int a = 0; a < 2; ++a)
#pragma unroll
        for (int b = 0; b < 2; ++b)
#pragma unroll
            for (int m = 0; m < 4; ++m)
#pragma unroll
                for (int n = 0; n < 2; ++n) acc[a][b][m][n] = (f32x4){0.f, 0.f, 0.f, 0.f};
    bf16x8 At[4][2], B0[2][2], B1[2][2];
    const char* cA = (const char*)g.A + (size_t)cur.pm * tstepA; const char* cB = (const char*)g.Bt + (size_t)cur.pn * tstepB + PG8_BOFF(cur.pm);
    S.a_ready(cur);
    if constexpr (SP2) {
        PG8_STAGE(PG8_SB(0, 0), cB, voffB); PG8_STAGE(PG8_SB(0, 1), cB + hstepB, voffB); PG8_STAGE(PG8_SA(0, 0), cA, voffA); PG8_STAGE(PG8_SA(0, 1), cA + hstepA, voffA);
        if (wr == 1) PG8_BAR;
        PG8_WAIT_V(2); PG8_BAR;
        PG8_STAGE(PG8_SB(1, 0), cB + kstep, voffB); PG8_STAGE(PG8_SA(1, 0), cA + kstep, voffA); PG8_STAGE(PG8_SB(1, 1), cB + hstepB + kstep, voffB);
        PG8_WAIT_V(6); PG8_BAR;
    } else {
        PG8_STAGE(PG8_SB(0, 0), cB, voffB); PG8_STAGE(PG8_SA(0, 0), cA, voffA); PG8_STAGE(PG8_SB(0, 1), cB + hstepB, voffB); PG8_STAGE(PG8_SA(0, 1), cA + hstepA, voffA);
        if (wr == 1) PG8_BAR;
        PG8_WAIT_V(4); PG8_BAR;
        PG8_STAGE(PG8_SB(1, 0), cB + kstep, voffB); PG8_STAGE(PG8_SA(1, 0), cA + kstep, voffA); PG8_STAGE(PG8_SB(1, 1), cB + hstepB + kstep, voffB);
        PG8_WAIT_V(6); PG8_BAR;
    }
    for (;;) {
        const bool has_next = S.next(ui + 1, nxt);
        const char* nA = has_next ? (const char*)g.A + (size_t)nxt.pm * tstepA : cA; const char* nB = has_next ? (const char*)g.Bt + (size_t)nxt.pn * tstepB + PG8_BOFF(nxt.pm) : cB;
        for (int t = 0; t < nt; t += 2) {
            const bool last = (t == nt - 2);
            const char* a1 = cA + (size_t)(t + 1) * kstep;
            const char* a2 = last ? nA : cA + (size_t)(t + 2) * kstep; const char* b2 = last ? nB : cB + (size_t)(t + 2) * kstep;
            const char* a3 = a2 + kstep; const char* b3 = b2 + kstep;
            if (last && has_next) S.a_ready(nxt);
            if constexpr (SP2) {
            PG8_LDB(B0, 0, 0); PG8_LDB(B1, 0, 1); PG8_SCHED; PG8_LDA(At, 0, 0); PG8_STAGE(PG8_SA(1, 1), a1 + hstepA, voffA);
            PG8_WAIT_V(8); PG8_WAIT_L(0); PG8_BAR; PG8_MMA(0, 0, At, B0); PG8_MMA(0, 1, At, B1); PG8_BAR; PG8_SCHED;
            PG8_LDA(At, 0, 1); PG8_STAGE(PG8_SB(0, 0), b2, voffB); PG8_STAGE(PG8_SB(0, 1), b2 + hstepB, voffB); PG8_STAGE(PG8_SA(0, 0), a2, voffA);
            PG8_WAIT_V(8); PG8_WAIT_L(0); PG8_BAR; PG8_MMA(1, 0, At, B0); PG8_MMA(1, 1, At, B1); PG8_BAR; PG8_SCHED;
            PG8_LDB(B0, 1, 0); PG8_LDB(B1, 1, 1); PG8_SCHED; PG8_LDA(At, 1, 0); PG8_STAGE(PG8_SA(0, 1), a2 + hstepA, voffA);
            PG8_WAIT_V(8); PG8_WAIT_L(0); PG8_BAR; PG8_MMA(0, 0, At, B0); PG8_MMA(0, 1, At, B1); PG8_BAR; PG8_SCHED;
            PG8_LDA(At, 1, 1); PG8_STAGE(PG8_SB(1, 0), b3, voffB); PG8_STAGE(PG8_SB(1, 1), b3 + hstepB, voffB); PG8_STAGE(PG8_SA(1, 0), a3, voffA);
            PG8_WAIT_V(8); PG8_WAIT_L(0); PG8_BAR; PG8_MMA(1, 0, At, B0); PG8_MMA(1, 1, At, B1); PG8_BAR; PG8_SCHED;
            } else {
            PG8_LDB(B0, 0, 0); PG8_SCHED; PG8_LDA(At, 0, 0); PG8_STAGE(PG8_SA(1, 1), a1 + hstepA, voffA);
            PG8_WAIT_L(8); PG8_BAR; PG8_WAIT_L(0); PG8_MMA(0, 0, At, B0); PG8_BAR; PG8_SCHED;
            PG8_LDB(B1, 0, 1); PG8_STAGE(PG8_SB(0, 0), b2, voffB);
            PG8_BAR; PG8_WAIT_L(0); PG8_MMA(0, 1, At, B1); PG8_BAR;
            PG8_LDA(At, 0, 1); PG8_STAGE(PG8_SA(0, 0), a2, voffA);
            PG8_BAR; PG8_WAIT_L(0); PG8_MMA(1, 0, At, B0); PG8_BAR; PG8_SCHED;
            PG8_STAGE(PG8_SB(0, 1), b2 + hstepB, voffB);
            PG8_WAIT_V(6); PG8_BAR; PG8_MMA(1, 1, At, B1); PG8_BAR;
            PG8_LDB(B0, 1, 0); PG8_SCHED; PG8_LDA(At, 1, 0); PG8_STAGE(PG8_SA(0, 1), a2 + hstepA, voffA);
            PG8_WAIT_L(8); PG8_BAR; PG8_WAIT_L(0); PG8_MMA(0, 0, At, B0); PG8_BAR; PG8_SCHED;
            PG8_LDB(B1, 1, 1); PG8_STAGE(PG8_SB(1, 0), b3, voffB);
            PG8_BAR; PG8_WAIT_L(0); PG8_MMA(0, 1, At, B1); PG8_BAR;
            PG8_LDA(At, 1, 1); PG8_STAGE(PG8_SA(1, 0), a3, voffA);
            PG8_BAR; PG8_WAIT_L(0); PG8_MMA(1, 0, At, B0); PG8_BAR; PG8_SCHED;
            PG8_STAGE(PG8_SB(1, 1), b3 + hstepB, voffB);
            PG8_WAIT_V(6); PG8_BAR; PG8_MMA(1, 1, At, B1); PG8_BAR;
            }
        }
        if constexpr (ALIGN_EPI) { if (wr == 0) PG8_BAR; }
        if constexpr (!Epi::AFTER_DRAIN) { E(acc, cur, wr, wc, fr, fq); S.done(cur); }
        if (!has_next) break;
#pragma unroll
        for (int a = 0; a < 2; ++a)
#pragma unroll
            for (int b = 0; b < 2; ++b)
#pragma unroll
                for (int m = 0; m < 4; ++m)
#pragma unroll
                    for (int n = 0; n < 2; ++n) acc[a][b][m][n] = (f32x4){0.f, 0.f, 0.f, 0.f};
        cur = nxt; cA = nA; cB = nB; ++ui;
        if constexpr (ALIGN_EPI) { if (wr == 1) PG8_BAR; }
    }
    PG8_WAIT_V(0);
    if constexpr (!ALIGN_EPI) { if (wr == 0) PG8_BAR; }
    PG8_BAR;
    if constexpr (Epi::AFTER_DRAIN) { E.fused(acc, cur, wr, wc, fr, fq, lds, wid, lane); S.done(cur); }
#undef PG8_BOFF
#undef PG8_SA
#undef PG8_SB
#undef PG8_STAGE
#undef PG8_LDA
#undef PG8_LDB
#undef PG8_MMA
#undef PG8_WAIT_V
#undef PG8_WAIT_L
#undef PG8_BAR
#undef PG8_SCHED
}
}

#define GAS __attribute__((address_space(1)))
#define LAS __attribute__((address_space(3)))
typedef GAS unsigned gu32;
#define LDS_WAIT() asm volatile("s_waitcnt lgkmcnt(0)" ::: "memory")
#define VM_WAIT() asm volatile("s_waitcnt vmcnt(0)" ::: "memory")
constexpr int NWAVES = 8, NTHR = NWAVES * 64;
constexpr int LDSCTL_OFF = 0, PH_BASE = 512, LDS_BYTES = 147456;
constexpr int CW_BAR = 4096;
constexpr size_t CTL_ZERO_BYTES = 256 * 1024;
constexpr size_t WS_TRIG = 27 * MiB;
#define XB_TMO      128
#define XB_XCNT(j)  (256  + 64 * (j))
#define XB_XSUB(j)  (1280 + 64 * (j))
#define XB_XGEN(j)  (2304 + 64 * (j))
#define XB_TOP      3328
#define XB_TOPGEN   3392
#define XCD_BAR_WORDS 3456
#define XB_SPIN_CAP (1u << 18)

__device__ __forceinline__ unsigned xb_ld(unsigned* p)              { return __hip_atomic_load(p, __ATOMIC_RELAXED, __HIP_MEMORY_SCOPE_AGENT); }
__device__ __forceinline__ unsigned xb_add(unsigned* p, unsigned v) { return __hip_atomic_fetch_add(p, v, __ATOMIC_RELAXED, __HIP_MEMORY_SCOPE_AGENT); }
__device__ __forceinline__ unsigned xb_xcc_id() { return (unsigned)__builtin_amdgcn_s_getreg((3 << 11) | 20) & 0xFu; }
#define XB_SPIN(cond, bar) do { unsigned _sp = 0; while (cond) { __builtin_amdgcn_s_sleep(1); \
    if ((++_sp & 255u) == 0u) { if (xb_ld(&(bar)[XB_TMO])) break; if (_sp > XB_SPIN_CAP) { atomicAdd(&(bar)[XB_TMO], 1u); break; } } } } while (0)

struct XcdBarrier {
    unsigned* bar; unsigned x;
    volatile LAS unsigned* st;
};

__device__ __forceinline__ XcdBarrier xcd_barrier_post(unsigned* bar, volatile LAS unsigned* st) {
    XcdBarrier b; b.bar = bar; b.x = xb_xcc_id(); b.st = st;
    if (threadIdx.x == 0) (void)xb_add(&bar[XB_XCNT(b.x)], 1u);
    return b;
}
__device__ __forceinline__ void xcd_barrier_complete(unsigned* bar, unsigned x, unsigned& nloc, unsigned& nx) {
    const unsigned G = gridDim.x * gridDim.y * gridDim.z;
    unsigned sum, cnt, mine, sp = 0u;
    for (;;) {
        sum = 0u; cnt = 0u; mine = 0u;
#pragma unroll
        for (unsigned j = 0; j < 16; ++j) { const unsigned c = xb_ld(&bar[XB_XCNT(j)]); sum += c; cnt += (c > 0u) ? 1u : 0u; mine = (j == x) ? c : mine; }
        if (sum == G) break;
        __builtin_amdgcn_s_sleep(1);
        if ((++sp & 255u) == 0u) { if (xb_ld(&bar[XB_TMO])) break; if (sp > XB_SPIN_CAP) { atomicAdd(&bar[XB_TMO], 1u); break; } }
    }
    nloc = mine > 0u ? mine : 1u; nx = cnt > 0u ? cnt : 1u;
}

__device__ __forceinline__ void xcd_barrier(const XcdBarrier& b) {
    asm volatile("s_waitcnt vmcnt(0)" ::: "memory");
    __syncthreads();
    if (threadIdx.x == 0) {
        unsigned* bar = b.bar;
        __builtin_amdgcn_s_waitcnt(0);
        unsigned nloc = b.st[0], nx = b.st[1];
        if (nloc == 0u) { xcd_barrier_complete(bar, b.x, nloc, nx); b.st[0] = nloc; b.st[1] = nx; }
        const unsigned old = xb_add(&bar[XB_XSUB(b.x)], 1u);
        const unsigned gen = old / nloc;
        if (old + 1u == (gen + 1u) * nloc) {
            __builtin_amdgcn_fence(__ATOMIC_RELEASE, "agent");
            asm volatile("s_waitcnt vmcnt(0)" ::: "memory");
            const unsigned og = xb_add(&bar[XB_TOP], 1u);
            const unsigned tg = og / nx;
            if (og + 1u == (tg + 1u) * nx) xb_add(&bar[XB_TOPGEN], 1u);
            else XB_SPIN(xb_ld(&bar[XB_TOPGEN]) == tg, bar);
            __builtin_amdgcn_fence(__ATOMIC_ACQUIRE, "agent");
            xb_add(&bar[XB_XGEN(b.x)], 1u);
            asm volatile("s_waitcnt vmcnt(0)" ::: "memory");
        } else {
            XB_SPIN(xb_ld(&bar[XB_XGEN(b.x)]) == gen, bar);
            __builtin_amdgcn_fence(__ATOMIC_ACQUIRE, "agent");
            asm volatile("s_waitcnt vmcnt(0)" ::: "memory");
        }
    }
    __syncthreads();
}

enum { PH_PRO = 0, PH_PROJ, PH_UP, PH_ATTN, PH_MIX, PH_MEMQ, PH_XATTN, PH_MEMO, PH_PQ, PH_TOPK, PH_EXP, PH_N, PHB_CONV = 16, PHB_UPG = 17 };
struct Args { const float* in[24]; float* out; unsigned char* ws; unsigned mask; unsigned li; };

DEVI int src_col(int mode, int r) { return mode == 0 ? r : mode == 1 ? win_src(r) : wkv_src(r); }
template <int MODE, bool HASG> DEVI void p0_transpose_item(const float* W, int K, int N, bf16* WT, int NR, const float* gk, LAS float* scr, int item, int lane) {
    const int nb_ = NR / 32, kb = item / nb_, nb = item % nb_, k0 = 64 * kb, n0 = 32 * nb;
    const int sc = src_col(MODE, n0 + (lane & 31)), scc = sc < 0 ? 0 : sc; const float keep = sc < 0 ? 0.f : 1.f;
    float v[32];
#pragma unroll
    for (int i = 0; i < 32; ++i) { const int kk = 2 * i + (lane >> 5); v[i] = W[(size_t)(k0 + kk) * N + scc]; }
    if (HASG) {
#pragma unroll
        for (int i = 0; i < 32; ++i) { const int kk = 2 * i + (lane >> 5); v[i] *= gk[k0 + kk]; } }
#pragma unroll
    for (int i = 0; i < 32; ++i) { const int kk = 2 * i + (lane >> 5); scr[kk * 33 + (lane & 31)] = MODE == 0 ? v[i] : v[i] * keep; }
    LDS_WAIT(); asm volatile("" ::: "memory");
    const int c = lane & 7;
#pragma unroll
    for (int j = 0; j < 4; ++j) { const int n = (lane >> 3) + 8 * j; const LAS float* s = scr + (8 * c) * 33 + n;
        uint4 o; o.x = pg8::cvt_pk_bf16(s[0 * 33], s[1 * 33]); o.y = pg8::cvt_pk_bf16(s[2 * 33], s[3 * 33]); o.z = pg8::cvt_pk_bf16(s[4 * 33], s[5 * 33]); o.w = pg8::cvt_pk_bf16(s[6 * 33], s[7 * 33]);
        *(uint4*)(WT + (size_t)(n0 + n) * K + k0 + 8 * c) = o; }
    LDS_WAIT(); asm volatile("" ::: "memory");
}
DEVI void rms_row_to_bf16(const float* xrow, const float* g, bf16* orow, int lane) {
    const float4* xr = (const float4*)xrow + lane; const float4* gr = (const float4*)g + lane;
    float4 v[4]; float s = 0.f;
#pragma unroll
    for (int j = 0; j < 4; ++j) { v[j] = xr[64 * j]; s += (v[j].x * v[j].x + v[j].y * v[j].y) + (v[j].z * v[j].z + v[j].w * v[j].w); }
    const float r = rsqrtf(wave_sum(s) * (1.f / D) + EPS);
    uint2* o8 = (uint2*)orow + lane;
#pragma unroll
    for (int j = 0; j < 4; ++j) { const float4 gg = gr[64 * j]; uint2 o; o.x = pg8::cvt_pk_bf16(v[j].x * r * gg.x, v[j].y * r * gg.y); o.y = pg8::cvt_pk_bf16(v[j].z * r * gg.z, v[j].w * r * gg.w); o8[64 * j] = o; }
}
DEVI void rms_rows4_to_bf16(const float* x, const float* g, bf16* out, int m0, int step, int mend, int lane) {
    float4 v[4][4]; float s[4]; float4 gq[4];
#pragma unroll
    for (int j = 0; j < 4; ++j) gq[j] = ((const float4*)g + lane)[64 * j];
#pragma unroll
    for (int r = 0; r < 4; ++r) { const int m = m0 + r * step; const float4* xr = (const float4*)(x + (size_t)(m < mend ? m : m0) * D) + lane;
#pragma unroll
        for (int j = 0; j < 4; ++j) v[r][j] = xr[64 * j]; }
#pragma unroll
    for (int r = 0; r < 4; ++r) { float t = 0.f;
#pragma unroll
        for (int j = 0; j < 4; ++j) t += (v[r][j].x * v[r][j].x + v[r][j].y * v[r][j].y) + (v[r][j].z * v[r][j].z + v[r][j].w * v[r][j].w);
        s[r] = t; }
#pragma unroll
    for (int o = 1; o < 64; o <<= 1) {
#pragma unroll
        for (int r = 0; r < 4; ++r) s[r] += __shfl_xor(s[r], o); }
#pragma unroll
    for (int r = 0; r < 4; ++r) { const int m = m0 + r * step; if (m < mend) { const float rs = rsqrtf(s[r] * (1.f / D) + EPS); uint2* o8 = (uint2*)(out + (size_t)m * D) + lane;
#pragma unroll
        for (int j = 0; j < 4; ++j) { const float4 gg = gq[j]; uint2 o; o.x = pg8::cvt_pk_bf16(v[r][j].x * rs * gg.x, v[r][j].y * rs * gg.y); o.y = pg8::cvt_pk_bf16(v[r][j].z * rs * gg.z, v[r][j].w * rs * gg.w); o8[64 * j] = o; } } }
}
DEVI void cvt_stream_fp8(const float* src, unsigned char* dst, size_t n16, const float* g, float mul, size_t gtid, size_t gn) {
    for (size_t i = gtid; i < n16; i += gn) { pg8::u32x4 o;
#pragma unroll
        for (int q = 0; q < 4; ++q) { float4 a = *(const float4*)(src + i * 16 + q * 4); if (g) { const float4 gg = *(const float4*)(g + ((i * 16 + q * 4) & (D - 1))); a.x *= gg.x; a.y *= gg.y; a.z *= gg.z; a.w *= gg.w; }
            int p = __builtin_amdgcn_cvt_pk_fp8_f32(a.x * mul, a.y * mul, 0, false); p = __builtin_amdgcn_cvt_pk_fp8_f32(a.z * mul, a.w * mul, p, true); o[q] = (unsigned)p; }
        *(pg8::u32x4*)(dst + i * 16) = o; }
}
typedef unsigned v6u_t __attribute__((ext_vector_type(6)));
typedef float f32x2_t __attribute__((ext_vector_type(2)));
typedef float v16f_t __attribute__((ext_vector_type(16)));
typedef float v32f_t __attribute__((ext_vector_type(32)));
typedef __bf16 v32bf_t __attribute__((ext_vector_type(32)));
#ifndef FP6_INTERLEAVED
#define FP6_INTERLEAVED 0
#endif
template <bool HASG> DEVI void cvt_rows_fp6(const float* src, unsigned char* dst, const float* g, float mul, size_t gtid, size_t gn) {
    const int grp = (int)(gtid & 31);
    float4 gg[8];
#pragma unroll
    for (int q = 0; q < 8; ++q) { gg[q] = HASG ? *(const float4*)(g + grp * 32 + q * 4) : make_float4(1.f, 1.f, 1.f, 1.f); gg[q].x *= mul; gg[q].y *= mul; gg[q].z *= mul; gg[q].w *= mul; }
    for (size_t i0 = gtid; i0 < (size_t)PE * 32; i0 += 2 * gn) {
        float4 v[2][8];
#pragma unroll
        for (int u = 0; u < 2; ++u) { const size_t i = i0 + u * gn; if (i < (size_t)PE * 32) { const float* sp = src + (i >> 5) * D + (i & 31) * 32;
#pragma unroll
            for (int q = 0; q < 8; ++q) v[u][q] = *(const float4*)(sp + q * 4); } }
#pragma unroll
        for (int u = 0; u < 2; ++u) { const size_t i = i0 + u * gn; if (i < (size_t)PE * 32) { const size_t row = i >> 5;
            v16f_t a, b;
#pragma unroll
            for (int q = 0; q < 8; ++q) { const float4 x = v[u][q]; a[2 * q] = x.x * gg[q].x; b[2 * q] = x.y * gg[q].y; a[2 * q + 1] = x.z * gg[q].z; b[2 * q + 1] = x.w * gg[q].w; }
            const v6u_t p = __builtin_amdgcn_cvt_scalef32_2xpk16_fp6_f32(a, b, 1.0f);
            *(pg8::u32x4*)(dst + row * 768 + grp * 16) = (pg8::u32x4){p[0], p[1], p[2], p[3]};
            *(pg8::u32x2*)(dst + row * 768 + 512 + grp * 8) = (pg8::u32x2){p[4], p[5]}; } }
    }
}
DEVI void cvt_stream(const float* src, bf16* dst, size_t n8, const float* g, size_t gtid, size_t gn) {
    for (size_t i = gtid; i < n8; i += gn) { const float4 a = *(const float4*)(src + i * 8), b = *(const float4*)(src + i * 8 + 4);
        float4 ga = make_float4(1.f, 1.f, 1.f, 1.f), gb = ga; if (g) { ga = *(const float4*)(g + ((i * 8) & (D - 1))); gb = *(const float4*)(g + ((i * 8) & (D - 1)) + 4); }
        uint4 o; o.x = pg8::cvt_pk_bf16(a.x * ga.x, a.y * ga.y); o.y = pg8::cvt_pk_bf16(a.z * ga.z, a.w * ga.w); o.z = pg8::cvt_pk_bf16(b.x * gb.x, b.y * gb.y); o.w = pg8::cvt_pk_bf16(b.z * gb.z, b.w * gb.w);
        *(uint4*)(dst + i * 8) = o; }
}


DEVI void conv_token(int row, const bf16* U, const float* cw, const float* cb, const float* lg, const float* lb, bf16* CONCAT, int lane) {
    const int pos = row % SEQ; float y[8];
    { const float4 b0 = *(const float4*)(cb + lane * 8), b1 = *(const float4*)(cb + lane * 8 + 4); y[0] = b0.x; y[1] = b0.y; y[2] = b0.z; y[3] = b0.w; y[4] = b1.x; y[5] = b1.y; y[6] = b1.z; y[7] = b1.w; }
    const int k0 = pos >= CK - 1 ? 0 : CK - 1 - pos;
    for (int k = k0; k < CK; ++k) {
        const uint4 u = *(const uint4*)(U + (size_t)(row - (CK - 1) + k) * CW + lane * 8);
        const float4 w0 = *(const float4*)(cw + k * CW + lane * 8), w1 = *(const float4*)(cw + k * CW + lane * 8 + 4);
        y[0] += w0.x * __builtin_bit_cast(float, u.x << 16); y[1] += w0.y * __builtin_bit_cast(float, u.x & 0xffff0000u);
        y[2] += w0.z * __builtin_bit_cast(float, u.y << 16); y[3] += w0.w * __builtin_bit_cast(float, u.y & 0xffff0000u);
        y[4] += w1.x * __builtin_bit_cast(float, u.z << 16); y[5] += w1.y * __builtin_bit_cast(float, u.z & 0xffff0000u);
        y[6] += w1.z * __builtin_bit_cast(float, u.w << 16); y[7] += w1.w * __builtin_bit_cast(float, u.w & 0xffff0000u);
    }
    float s = 0.f;
#pragma unroll
    for (int e = 0; e < 8; ++e) s += y[e];
    const float mu = wave_sum(s) * (1.f / CW); float q = 0.f;
#pragma unroll
    for (int e = 0; e < 8; ++e) { y[e] -= mu; q += y[e] * y[e]; }
    const float rstd = rsqrtf(wave_sum(q) * (1.f / CW) + EPS);
    const float4 g0 = *(const float4*)(lg + lane * 8), g1 = *(const float4*)(lg + lane * 8 + 4), c0 = *(const float4*)(lb + lane * 8), c1 = *(const float4*)(lb + lane * 8 + 4);
    const float gg[8] = {g0.x, g0.y, g0.z, g0.w, g1.x, g1.y, g1.z, g1.w}, bb[8] = {c0.x, c0.y, c0.z, c0.w, c1.x, c1.y, c1.z, c1.w};
    float z[8];
#pragma unroll
    for (int e = 0; e < 8; ++e) { const float t = y[e] * rstd * gg[e] + bb[e]; z[e] = t * __builtin_amdgcn_rcpf(1.f + __expf(-t)); }
    uint4 o; o.x = pg8::cvt_pk_bf16(z[0], z[1]); o.y = pg8::cvt_pk_bf16(z[2], z[3]); o.z = pg8::cvt_pk_bf16(z[4], z[5]); o.w = pg8::cvt_pk_bf16(z[6], z[7]);
    *(uint4*)(CONCAT + (size_t)row * D + CW + lane * 8) = o;
}

DEVI void conv_chunk(int c, const bf16* U, const float* cw, const float* cb, const float* lg, const float* lb, bf16* CONCAT, LAS unsigned char* lds) {
    const int ch = threadIdx.x, lane = ch & 63, wv = __builtin_amdgcn_readfirstlane(ch >> 6);
    const int t0 = c * 64, pos0 = t0 % SEQ;
    float w[CK];
#pragma unroll
    for (int k = 0; k < CK; ++k) w[k] = cw[k * CW + ch];
    const float bias = cb[ch];
    float u[64 + CK - 1];
#pragma unroll
    for (int r = 0; r < 64 + CK - 1; ++r) { const int row = t0 - (CK - 1) + r;
        const unsigned raw = *(const unsigned short*)(U + (size_t)(row < 0 ? 0 : row) * CW + ch); u[r] = __builtin_bit_cast(float, raw << 16); }
#pragma unroll
    for (int r = 0; r < CK - 1; ++r) { const float keep = (pos0 - (CK - 1) + r >= 0) ? 1.f : 0.f; u[r] *= keep; }
    LAS float* yl = (LAS float*)lds;
#pragma unroll
    for (int j = 0; j < 64; ++j) { float y = bias;
#pragma unroll
        for (int k = 0; k < CK; ++k) y += w[k] * u[j + k];
        yl[j * CW + ch] = y; }
    __syncthreads();
#pragma unroll 1
    for (int i = 0; i < 8; ++i) { const int j = wv * 8 + i, row = t0 + j;
        const pg8::f32x4 a0 = *(const LAS pg8::f32x4*)(yl + j * CW + lane * 8), a1 = *(const LAS pg8::f32x4*)(yl + j * CW + lane * 8 + 4);
        float y[8] = {a0[0], a0[1], a0[2], a0[3], a1[0], a1[1], a1[2], a1[3]}; float sm = 0.f;
#pragma unroll
        for (int e = 0; e < 8; ++e) sm += y[e];
        const float mu = wave_sum(sm) * (1.f / CW); float q = 0.f;
#pragma unroll
        for (int e = 0; e < 8; ++e) { y[e] -= mu; q += y[e] * y[e]; }
        const float rstd = rsqrtf(wave_sum(q) * (1.f / CW) + EPS);
        const float4 g0 = *(const float4*)(lg + lane * 8), g1 = *(const float4*)(lg + lane * 8 + 4), c0 = *(const float4*)(lb + lane * 8), c1 = *(const float4*)(lb + lane * 8 + 4);
        const float gg[8] = {g0.x, g0.y, g0.z, g0.w, g1.x, g1.y, g1.z, g1.w}, bb[8] = {c0.x, c0.y, c0.z, c0.w, c1.x, c1.y, c1.z, c1.w};
        float z[8];
#pragma unroll
        for (int e = 0; e < 8; ++e) { const float t = y[e] * rstd * gg[e] + bb[e]; z[e] = t * __builtin_amdgcn_rcpf(1.f + __expf(-t)); }
        uint4 o; o.x = pg8::cvt_pk_bf16(z[0], z[1]); o.y = pg8::cvt_pk_bf16(z[2], z[3]); o.z = pg8::cvt_pk_bf16(z[4], z[5]); o.w = pg8::cvt_pk_bf16(z[6], z[7]);
        *(uint4*)(CONCAT + (size_t)row * D + CW + lane * 8) = o; }
    __syncthreads();
}

typedef short bf16x8_t __attribute__((ext_vector_type(8)));
typedef float f32x16_t __attribute__((ext_vector_type(16)));
typedef __bf16 bf16x2_t __attribute__((ext_vector_type(2)));
DEVI unsigned umax_(unsigned a, unsigned b) { return a > b ? a : b; }
DEVI unsigned umin_(unsigned a, unsigned b) { return a < b ? a : b; }
DEVI unsigned kmax_(unsigned a, unsigned b) { unsigned r; asm("v_max_f32 %0, %1, %2" : "=v"(r) : "v"(a), "v"(b)); return r; }
DEVI unsigned kmin_(unsigned a, unsigned b) { unsigned r; asm("v_min_f32 %0, %1, %2" : "=v"(r) : "v"(a), "v"(b)); return r; }
DEVI void ce_desc(unsigned& a, unsigned& b) { const unsigned mx = kmax_(a, b), mn = kmin_(a, b); a = mx; b = mn; }
DEVI void sort16_desc(unsigned (&v)[16]) {
#pragma unroll
    for (int k = 2; k <= 16; k <<= 1)
#pragma unroll
        for (int j = k >> 1; j > 0; j >>= 1)
#pragma unroll
            for (int i = 0; i < 16; ++i) { const int l = i ^ j; if (l > i) { if ((i & k) == 0) ce_desc(v[i], v[l]); else ce_desc(v[l], v[i]); } }
}
DEVI void merge16_desc(unsigned (&v)[16]) {
#pragma unroll
    for (int j = 8; j > 0; j >>= 1)
#pragma unroll
        for (int i = 0; i < 16; ++i) { const int l = i ^ j; if (l > i) ce_desc(v[i], v[l]); }
}
DEVI void top16_merge(unsigned (&a)[16], const unsigned (&b)[16]) {
#pragma unroll
    for (int i = 0; i < 16; ++i) a[i] = kmax_(a[i], b[15 - i]);
    merge16_desc(a);
}
DEVI int crow16(int r, int hi) { return (r & 3) + 8 * (r >> 2) + 4 * hi; }

DEVI void subkey_top16(unsigned (&best)[16], const bf16* qrow  , const LAS unsigned char* kl  , int hi) {
    bf16x8_t qf[8];
#pragma unroll
    for (int ks = 0; ks < 8; ++ks) qf[ks] = *(const bf16x8_t*)(qrow + 16 * ks);
    unsigned grp[16];
#pragma unroll
    for (int nt = 0; nt < 4; ++nt) {
        f32x16_t acc = {};
#pragma unroll
        for (int ks = 0; ks < 8; ++ks) { const bf16x8_t kf = *(const LAS bf16x8_t*)(kl + ks * 4096 + nt * 512); acc = __builtin_amdgcn_mfma_f32_32x32x16_bf16(kf, qf[ks], acc, 0, 0, 0); }
#pragma unroll
        for (int r = 0; r < 16; ++r) { const float av = acc[r]; grp[r] = (__builtin_bit_cast(unsigned, av) & 0xffffff80u) | (unsigned)(127 - (32 * nt + crow16(r, hi))); }
        sort16_desc(grp);
        if (nt == 0) {
#pragma unroll
            for (int r = 0; r < 16; ++r) best[r] = grp[r];
        } else top16_merge(best, grp);
    }
    unsigned oth[16];
#pragma unroll
    for (int r = 0; r < 16; ++r) oth[r] = (unsigned)__shfl_xor((int)best[r], 32);
    top16_merge(best, oth);
}
DEVI void topk_wave(const bf16* qbase, const LAS unsigned char* keys, LAS unsigned* scr  , int* eidx, float* egate, int lane) {
    const int r32 = lane & 31, hi = lane >> 5;
    unsigned b0[16], b1[16];
    subkey_top16(b0, qbase + 8 * hi, keys + hi * 2048 + r32 * 16, hi);
    subkey_top16(b1, qbase + 128 + 8 * hi, keys + 32768 + hi * 2048 + r32 * 16, hi);
    float s0[16], s1[16];
#pragma unroll
    for (int i = 0; i < 16; ++i) { s0[i] = __builtin_bit_cast(float, b0[i] & 0xffffff80u); s1[i] = __builtin_bit_cast(float, b1[i] & 0xffffff80u); }
#pragma unroll
    for (int w = 0; w < 4; ++w) {
        scr[lane * 9 + w] = (127u - (b0[4 * w] & 127u)) | ((127u - (b0[4 * w + 1] & 127u)) << 8) | ((127u - (b0[4 * w + 2] & 127u)) << 16) | ((127u - (b0[4 * w + 3] & 127u)) << 24);
        scr[lane * 9 + 4 + w] = (127u - (b1[4 * w] & 127u)) | ((127u - (b1[4 * w + 1] & 127u)) << 8) | ((127u - (b1[4 * w + 2] & 127u)) << 16) | ((127u - (b1[4 * w + 3] & 127u)) << 24);
    }
    unsigned ca[16], cb2[16];
#define CAND(i, j) ((__builtin_bit_cast(unsigned, s0[i] + s1[j]) & 0xffffff00u) | (unsigned)(255 - ((i) * 16 + (j))))
    const unsigned lowest = 0xff800000u;
    if (hi == 0) {
#pragma unroll
        for (int j = 0; j < 16; ++j) ca[j] = CAND(0, j);
#pragma unroll
        for (int j = 0; j < 8; ++j) cb2[j] = CAND(1, j);
#pragma unroll
        for (int j = 8; j < 16; ++j) cb2[j] = lowest;
    } else {
        ca[0] = CAND(2, 0); ca[1] = CAND(2, 1); ca[2] = CAND(2, 2); ca[3] = CAND(2, 3); ca[4] = CAND(2, 4); ca[5] = CAND(3, 0); ca[6] = CAND(3, 1); ca[7] = CAND(3, 2); ca[8] = CAND(3, 3);
        ca[9] = CAND(4, 0); ca[10] = CAND(4, 1); ca[11] = CAND(4, 2); ca[12] = CAND(5, 0); ca[13] = CAND(5, 1); ca[14] = CAND(6, 0); ca[15] = CAND(6, 1);
        cb2[0] = CAND(7, 0); cb2[1] = CAND(7, 1); cb2[2] = CAND(8, 0); cb2[3] = CAND(9, 0); cb2[4] = CAND(10, 0); cb2[5] = CAND(11, 0); cb2[6] = CAND(12, 0); cb2[7] = CAND(13, 0); cb2[8] = CAND(14, 0); cb2[9] = CAND(15, 0);
#pragma unroll
        for (int j = 10; j < 16; ++j) cb2[j] = lowest;
    }
#undef CAND
    sort16_desc(ca); sort16_desc(cb2); top16_merge(ca, cb2);
    unsigned oth[16];
#pragma unroll
    for (int r = 0; r < 16; ++r) oth[r] = (unsigned)__shfl_xor((int)ca[r], 32);
    top16_merge(ca, oth);
    const float mx = __builtin_bit_cast(float, ca[0] & 0xffffff00u); float ex[16]; float l = 0.f;
#pragma unroll
    for (int k = 0; k < 16; ++k) { ex[k] = __expf(__builtin_bit_cast(float, ca[k] & 0xffffff00u) - mx); l += ex[k]; }
    const float rl = 1.f / l;
    LDS_WAIT(); asm volatile("" ::: "memory");
    int ei[8]; float eg[8];
    const unsigned mhi = (unsigned)(-hi);
#pragma unroll
    for (int k = 0; k < 8; ++k) { const unsigned key = ca[k] ^ ((ca[k] ^ ca[8 + k]) & mhi); const unsigned ij = 255u - (key & 255u), i = ij >> 4, j = ij & 15u;
        const unsigned w0 = scr[lane * 9 + (i >> 2)], w1 = scr[lane * 9 + 4 + (j >> 2)];
        ei[k] = (int)(((w0 >> (8 * (i & 3))) & 255u) * PNK + ((w1 >> (8 * (j & 3))) & 255u)); eg[k] = __builtin_bit_cast(float, __builtin_bit_cast(unsigned, ex[k]) ^ ((__builtin_bit_cast(unsigned, ex[k]) ^ __builtin_bit_cast(unsigned, ex[8 + k])) & mhi)) * rl; }
    *(int4*)(eidx + hi * 8) = make_int4(ei[0], ei[1], ei[2], ei[3]); *(int4*)(eidx + hi * 8 + 4) = make_int4(ei[4], ei[5], ei[6], ei[7]);
    *(float4*)(egate + hi * 8) = make_float4(eg[0], eg[1], eg[2], eg[3]); *(float4*)(egate + hi * 8 + 4) = make_float4(eg[4], eg[5], eg[6], eg[7]);
    LDS_WAIT(); asm volatile("" ::: "memory");
}

typedef unsigned char fp8_t;
template <int VAR = 0> DEVI float dot16_fp8(pg8::u32x4 row, pg8::u32x4 ha, pg8::u32x4 hb, float acc) {
    if (VAR == 1) return __builtin_bit_cast(float, (row[0] ^ row[1]) ^ (row[2] ^ row[3]));
#pragma unroll
    for (int i = 0; i < 4; ++i) { const unsigned hlo = i < 2 ? ha[2 * i] : hb[2 * i - 4], hhi = i < 2 ? ha[2 * i + 1] : hb[2 * i - 3];
        acc = __builtin_amdgcn_fdot2_f32_bf16(__builtin_amdgcn_cvt_scalef32_pk_bf16_fp8(row[i], 1.0f, false), __builtin_bit_cast(bf16x2_t, hlo), acc, false);
        acc = __builtin_amdgcn_fdot2_f32_bf16(__builtin_amdgcn_cvt_scalef32_pk_bf16_fp8(row[i], 1.0f, true), __builtin_bit_cast(bf16x2_t, hhi), acc, false); }
    return acc;
}
template <int VAR = 0> DEVI void fma16_fp8(float (&acc)[16], float w, pg8::u32x4 row) {
    if (VAR == 1) { acc[0] += __builtin_bit_cast(float, row[0] ^ row[1]); acc[1] += __builtin_bit_cast(float, row[2] ^ row[3]); return; }
#pragma unroll
    for (int i = 0; i < 4; ++i) { const pg8::f32x2 lo = __builtin_amdgcn_cvt_pk_f32_fp8(row[i], false), hh = __builtin_amdgcn_cvt_pk_f32_fp8(row[i], true);
        acc[4 * i] += w * lo[0]; acc[4 * i + 1] += w * lo[1]; acc[4 * i + 2] += w * hh[0]; acc[4 * i + 3] += w * hh[1]; }
}
DEVI void sort128_asc(unsigned& a, unsigned& b, int lane) {
#pragma unroll
    for (int k = 2; k <= 128; k <<= 1)
#pragma unroll
        for (int j = k >> 1; j > 0; j >>= 1) {
            if (j == 64) { const unsigned lo = umin_(a, b), hi = umax_(a, b); a = lo; b = hi; }
            else {
                const bool upper = (lane & j) != 0;
                const bool asc_a = k == 128 ? true : ((lane & k) == 0), asc_b = k == 128 ? true : (k == 64 ? false : ((lane & k) == 0));
                const unsigned pa_ = (unsigned)__shfl_xor((int)a, j), pb_ = (unsigned)__shfl_xor((int)b, j);
                a = (upper != asc_a) ? umin_(a, pa_) : umax_(a, pa_);
                b = (upper != asc_b) ? umin_(b, pb_) : umax_(b, pb_);
            }
        }
}
constexpr int EXD = 8, EXP_LDS_WAVE = 12800;
struct Row6 { pg8::u32x4 a; pg8::u32x2 b; };
template <int VAR> DEVI void experts_wave(LAS unsigned char* wl_, int t0, int tstep, const bf16* H2B, const float* part2, const unsigned char* PU, const unsigned char* PV, const int* EIDX, const float* EGATE, const float* fg, float* out, int lane) {
    if (t0 >= M) return;
    const int ntok = (M - t0 + tstep - 1) / tstep < 8 ? (M - t0 + tstep - 1) / tstep : 8;
    LAS int* sid = (LAS int*)wl_; LAS float* gsl = (LAS float*)(wl_ + 4096); LAS float* wl = (LAS float*)(wl_ + 8192); LAS float* r2l = (LAS float*)(wl_ + 12288);
    const unsigned g32 = (unsigned)lane & 31u, hsel = (unsigned)lane >> 5, l4 = (unsigned)lane * 4u;
#define LDI(p) (*(const int*)((const char*)(p) + l4))
#define LDF(p) (*(const float*)((const char*)(p) + l4))
#define LDROW(dst, tab, ridx) do { const unsigned char* rp_ = (tab) + (size_t)(unsigned)(ridx) * 768u; (dst).a = *(const pg8::u32x4*)(rp_ + g32 * 16u); (dst).b = *(const pg8::u32x2*)(rp_ + 512u + g32 * 8u); } while (0)
    for (int k = 0; k < ntok; ++k) { const int t = t0 + k * tstep;
        unsigned k0 = ((unsigned)LDI(EIDX + (size_t)t * 128) << 7) | (unsigned)lane, k1 = ((unsigned)LDI(EIDX + (size_t)t * 128 + 64) << 7) | (unsigned)(64 + lane);
        const float ga = LDF(EGATE + (size_t)t * 128), gb = LDF(EGATE + (size_t)t * 128 + 64);
        sort128_asc(k0, k1, lane);
        const unsigned sl0 = k0 & 127u, sl1 = k1 & 127u;
        const float x0 = __shfl(ga, (int)(sl0 & 63u)), y0 = __shfl(gb, (int)(sl0 & 63u)), x1 = __shfl(ga, (int)(sl1 & 63u)), y1 = __shfl(gb, (int)(sl1 & 63u));
        sid[k * 128 + lane] = (int)(k0 >> 7); sid[k * 128 + 64 + lane] = (int)(k1 >> 7);
        gsl[k * 128 + lane] = sl0 < 64u ? x0 : y0; gsl[k * 128 + 64 + lane] = sl1 < 64u ? x1 : y1;
        const float r2 = rsqrtf(wave_sum(lane < 16 ? LDF(part2 + (size_t)t * 16) : 0.f) * (1.f / D) + EPS) * (1.0f / PU_SCALE);
        if (lane == 0) r2l[k] = r2; }
    LDS_WAIT(); asm volatile("" ::: "memory");
    const int nsteps = 8 * ntok;
#define STEP_DESC(q, tab, pos0) do { const int q_ = (q); if (q_ < nsteps) { (tab) = PU; if (ntok == 8) (pos0) = ((q_ >> 4) * 2 + (q_ & 1)) * 128 + 16 * ((q_ >> 1) & 7); else { const int b_ = q_ / ntok; (pos0) = (q_ - b_ * ntok) * 128 + 16 * b_; } } \
        else if (q_ < 2 * nsteps) { const int qq_ = q_ - nsteps; (tab) = PV; (pos0) = (qq_ >> 3) * 128 + 16 * (qq_ & 7); } else { (tab) = PV; (pos0) = 0; } } while (0)
    constexpr int LOOK = 1;
    Row6 buf[8 * LOOK];
#pragma unroll
    for (int i = 0; i < 8; ++i) { const int ri = sid[2 * i + (int)hsel]; LDROW(buf[i], PU, ri); }
    if (LOOK == 2) { const unsigned char* tb_; int p0_; STEP_DESC(1, tb_, p0_);
#pragma unroll
      for (int i = 0; i < 8; ++i) { const int ri = sid[p0_ + 2 * i + (int)hsel]; LDROW(buf[(8 + i) % (8 * LOOK)], tb_, ri); } }
#define TR_STEP(S) _Pragma("unroll") for (int i = 0; i < S; ++i) { const bool up_ = (lane & S) != 0; const float send = up_ ? r[i] : r[i + S], keep = up_ ? r[i + S] : r[i]; r[i] = keep + __shfl_xor(send, S); }
#define U_STEP(q, SB, B_, K_, HV) do { const int q__ = (q); const int ub_ = (B_), uk_ = (K_); \
        const unsigned char* ntab; int npos; STEP_DESC(q__ + LOOK, ntab, npos); npos += (int)hsel; \
        float r[8]; \
        _Pragma("unroll") for (int i2 = 0; i2 < 8; ++i2) { \
            const v6u_t p = {buf[SB + i2].a[0], buf[SB + i2].a[1], buf[SB + i2].a[2], buf[SB + i2].a[3], buf[SB + i2].b[0], buf[SB + i2].b[1]}; \
            float d = 0.f; \
            if (VAR == 1) d = __builtin_bit_cast(float, p[0] ^ p[1] ^ p[2] ^ p[3] ^ p[4] ^ p[5]); \
            else { const v32f_t rv = __builtin_amdgcn_cvt_scalef32_pk32_f32_fp6(p, 1.0f); \
                f32x2_t d2 = {0.f, 0.f}; _Pragma("unroll") for (int j = 0; j < 32; j += 2) { const unsigned hw_ = HV[j >> 3][(j >> 1) & 3]; const f32x2_t r2_ = {rv[j], rv[j + 1]}, h2_ = {__builtin_bit_cast(float, hw_ << 16), __builtin_bit_cast(float, hw_ & 0xffff0000u)}; d2 = __builtin_elementwise_fma(r2_, h2_, d2); } d = d2[0] + d2[1]; } \
            r[i2] = d; \
            const int ri = sid[npos + 2 * i2]; LDROW(buf[SB + i2], ntab, ri); \
            __builtin_amdgcn_sched_barrier(0); } \
        TR_STEP(4) TR_STEP(2) TR_STEP(1) \
        float tot = r[0] + __shfl_xor(r[0], 8); tot += __shfl_xor(tot, 16); \
        const int pos = uk_ * 128 + 16 * ub_ + 2 * (lane & 7) + (int)hsel; \
        const float a = tot * r2l[uk_]; \
        wl[pos] = 0.5f * a * (1.f + erff(a * 0.70710678118654752f)) * gsl[pos] * (1.0f / PV_SCALE); } while (0)
#define LOAD_HV(dst, k_) do { const int t_ = t0 + (k_) * tstep; _Pragma("unroll") for (int qd = 0; qd < 4; ++qd) (dst)[qd] = VAR == 2 ? (pg8::u32x4){0x3f803f80u, 0x3f803f80u, 0x3f803f80u, 0x3f803f80u} : *(const pg8::u32x4*)((const char*)(H2B + (size_t)t_ * D) + g32 * 64u + qd * 16u); } while (0)
    if (ntok == 8) {
#pragma unroll 1
        for (int grp = 0; grp < 4; ++grp) {
            pg8::u32x4 hv0[4], hv1[4];
            LOAD_HV(hv0, 2 * grp); LOAD_HV(hv1, 2 * grp + 1);
#pragma unroll 1
            for (int b = 0; b < 8; ++b) { const int q = grp * 16 + b * 2;
                U_STEP(q, 0, b, 2 * grp, hv0); U_STEP(q + 1, 8 * (LOOK - 1), b, 2 * grp + 1, hv1); }
        }
    } else {
#pragma unroll 1
        for (int q = 0; q < nsteps; q += 2) { pg8::u32x4 hva[4], hvb[4]; const int b0_ = q / ntok, k0_ = q - b0_ * ntok, b1_ = (q + 1) / ntok, k1_ = (q + 1) - b1_ * ntok;
            LOAD_HV(hva, k0_); LOAD_HV(hvb, k1_); U_STEP(q, 0, b0_, k0_, hva); U_STEP(q + 1, 8 * (LOOK - 1), b1_, k1_, hvb); }
    }
#undef LOAD_HV
#undef U_STEP
#undef TR_STEP
    LDS_WAIT(); asm volatile("" ::: "memory");
#define V_STEP(q, SB) do { const int q__ = (q); const int b = (q__ - nsteps) & 7; \
        const unsigned char* ntab; int npos; STEP_DESC(q__ + LOOK, ntab, npos); npos += (int)hsel; \
        const int wpos = k * 128 + b * 16 + (int)hsel; \
        _Pragma("unroll") for (int i2 = 0; i2 < 8; ++i2) { \
            const v6u_t p = {buf[SB + i2].a[0], buf[SB + i2].a[1], buf[SB + i2].a[2], buf[SB + i2].a[3], buf[SB + i2].b[0], buf[SB + i2].b[1]}; \
            const float wv = wl[wpos + 2 * i2]; \
            if (VAR == 1) { acc[0] += __builtin_bit_cast(float, p[0] ^ p[1] ^ p[2]); acc[1] += __builtin_bit_cast(float, p[3] ^ p[4] ^ p[5]); } \
            else { const v32f_t rv = __builtin_amdgcn_cvt_scalef32_pk32_f32_fp6(p, 1.0f); \
                const f32x2_t w2_ = {wv, wv}; _Pragma("unroll") for (int j = 0; j < 32; j += 2) { const f32x2_t r2_ = {rv[j], rv[j + 1]}; f32x2_t a2_ = {acc[j], acc[j + 1]}; a2_ = __builtin_elementwise_fma(r2_, w2_, a2_); acc[j] = a2_[0]; acc[j + 1] = a2_[1]; } } \
            const int ri = sid[npos + 2 * i2]; LDROW(buf[SB + i2], ntab, ri); \
            asm volatile("" : "+v"(acc[0]), "+v"(acc[1]), "+v"(acc[2]), "+v"(acc[3]), "+v"(acc[4]), "+v"(acc[5]), "+v"(acc[6]), "+v"(acc[7]), "+v"(acc[8]), "+v"(acc[9]), "+v"(acc[10]), "+v"(acc[11]), "+v"(acc[12]), "+v"(acc[13]), "+v"(acc[14]), "+v"(acc[15])); \
            asm volatile("" : "+v"(acc[16]), "+v"(acc[17]), "+v"(acc[18]), "+v"(acc[19]), "+v"(acc[20]), "+v"(acc[21]), "+v"(acc[22]), "+v"(acc[23]), "+v"(acc[24]), "+v"(acc[25]), "+v"(acc[26]), "+v"(acc[27]), "+v"(acc[28]), "+v"(acc[29]), "+v"(acc[30]), "+v"(acc[31])); \
            __builtin_amdgcn_sched_barrier(0); } } while (0)
    const unsigned eoff = (g32 * 32u + hsel * 16u) * 4u;
    float4 fgq[4];
#pragma unroll
    for (int q = 0; q < 4; ++q) fgq[q] = *(const float4*)((const char*)(fg + q * 4) + eoff);
#pragma unroll 1
    for (int k = 0; k < ntok; ++k) {
        const int t = t0 + k * tstep;
        const pg8::u32x4 ra = *(const pg8::u32x4*)((const char*)(H2B + (size_t)t * D) + eoff / 2), rb = *(const pg8::u32x4*)((const char*)(H2B + (size_t)t * D) + eoff / 2 + 16);
        __builtin_amdgcn_sched_barrier(0);
        float acc[32];
#pragma unroll
        for (int j = 0; j < 32; ++j) acc[j] = 0.f;
#pragma unroll 1
        for (int bb = 0; bb < 8; bb += 2) { const int q = nsteps + 8 * k + bb; V_STEP(q, 0); V_STEP(q + 1, 8 * (LOOK - 1)); }
        float fin[16];
#pragma unroll
        for (int j = 0; j < 16; ++j) { const float lo = acc[j], hi = acc[16 + j]; const float send = hsel ? lo : hi, keep = hsel ? hi : lo; fin[j] = keep + __shfl_xor(send, 32); }
        float* orow = (float*)((char*)(out + (size_t)t * D) + eoff); float ss = 0.f;
        {
#pragma unroll
          for (int q = 0; q < 4; ++q) { fin[2 * q] += __builtin_bit_cast(float, ra[q] << 16); fin[2 * q + 1] += __builtin_bit_cast(float, ra[q] & 0xffff0000u); fin[8 + 2 * q] += __builtin_bit_cast(float, rb[q] << 16); fin[8 + 2 * q + 1] += __builtin_bit_cast(float, rb[q] & 0xffff0000u); } }
#pragma unroll
        for (int j = 0; j < 16; ++j) ss += fin[j] * fin[j];
        const float rr = rsqrtf(wave_sum(ss) * (1.f / D) + EPS);
#pragma unroll
        for (int q = 0; q < 4; ++q) { const float4 g = fgq[q];
            *(float4*)(orow + q * 4) = make_float4(fin[4 * q] * rr * g.x, fin[4 * q + 1] * rr * g.y, fin[4 * q + 2] * rr * g.z, fin[4 * q + 3] * rr * g.w); }
        __builtin_amdgcn_sched_barrier(0);
    }
#undef V_STEP
#undef STEP_DESC
#undef LDI
#undef LDF
#undef LDROW
}

typedef short v4i16_t __attribute__((ext_vector_type(4)));
typedef int v2i32_t __attribute__((ext_vector_type(2)));
typedef int v4i32_t __attribute__((ext_vector_type(4)));
DEVI bf16x8_t join_tr(v4i16_t lo, v4i16_t hh) { const v2i32_t a = __builtin_bit_cast(v2i32_t, lo), b = __builtin_bit_cast(v2i32_t, hh); const v4i32_t w = {a[0], a[1], b[0], b[1]}; return __builtin_bit_cast(bf16x8_t, w); }
DEVI float max3f(float a, float b, float c) { float r; asm("v_max3_f32 %0, %1, %2, %3" : "=v"(r) : "v"(a), "v"(b), "v"(c)); return r; }
DEVI float max2f(float a, float b) { float r; asm("v_max_f32_e32 %0, %1, %2" : "=v"(r) : "v"(a), "v"(b)); return r; }
DEVI void glds16(const void* gsrc, unsigned lds_dst) { unsigned keep;
    asm volatile("s_mov_b32 %0, m0\n\ts_mov_b32 m0, %2\n\ts_nop 0\n\tglobal_load_lds_dwordx4 %1, off\n\ts_mov_b32 m0, %0" : "=&s"(keep) : "v"(gsrc), "s"(lds_dst) : "memory"); }
#define LDSADDR(p) ((unsigned)__builtin_amdgcn_readfirstlane((int)(unsigned)(uintptr_t)(p)))
#define ATT_BAR(N) asm volatile("s_waitcnt vmcnt(" #N ") lgkmcnt(0)\n\ts_barrier" ::: "memory")
template <int DQK, int DV, int DSPLIT, int NSLOT, int PD, bool CAUSAL, bool STAG, int VAR = 0>
DEVI void attn_unit(LAS unsigned char* S, const bf16* Qu, int qpitch, const bf16* Ku, int kpitch, const bf16* Vu, int vpitch, bf16* Ou, int opitch, int NT, int qcb) {
    constexpr int NCH = DQK / 8, KSLOT = NCH * 1024, NVG = DV / 32, VSLOT = NVG * 4096, NRG = 8 / DSPLIT, DVW = DV / DSPLIT, NOD = DVW / 32, NKS = DQK / 16;
    constexpr int KOFF = 0, VOFF = NSLOT * KSLOT, WSF = VOFF + NSLOT * VSLOT;
    static_assert(NRG * 32 * DVW * 2 * DSPLIT <= NSLOT * KSLOT, "O staging reuses the K ring");
    static_assert(NSLOT >= PD + (STAG ? 2 : 1), "ring depth");
    int tid_ = threadIdx.x; asm volatile("" : "+v"(tid_));
    const int lane = tid_ & 63, wid = __builtin_amdgcn_readfirstlane(tid_ >> 6), r32 = lane & 31, hi = lane >> 5, rg = wid % NRG, dp = wid / NRG;
    const bool late = STAG && wid >= 4;
    LAS float* wsf = (LAS float*)(S + WSF) + wid * 64;
    const int nld = (NCH - wid + 7) / 8 + (NVG * 4 - wid + 7) / 8;
    const bf16* ksrc = Ku + (size_t)lane * kpitch;
    const bf16* vsrc = Vu + (size_t)(lane >> 2) * vpitch + (lane & 3) * 8;
#define ATT_DMA(t, slot) do { \
        _Pragma("unroll") for (int pc_ = 0; pc_ < (NCH + 7) / 8; ++pc_) { const int pc = wid + 8 * pc_; if (pc < NCH) \
            glds16(ksrc + (size_t)(t) * 64 * kpitch + pc * 8, LDSADDR(S + KOFF + (slot) * KSLOT + pc * 1024)); } \
        _Pragma("unroll") for (int pv_ = 0; pv_ < (NVG * 4 + 7) / 8; ++pv_) { const int pv = wid + 8 * pv_; if (pv < NVG * 4) \
            glds16(vsrc + (size_t)((t) * 64 + (pv & 3) * 16) * vpitch + (pv >> 2) * 32, LDSADDR(S + VOFF + (slot) * VSLOT + pv * 1024)); } } while (0)
    bf16x8_t qr[NKS];
#pragma unroll
    for (int ks = 0; ks < NKS; ++ks) qr[ks] = *(const bf16x8_t*)(Qu + (size_t)(32 * rg + r32) * qpitch + ks * 16 + hi * 8);
#pragma unroll
    for (int ks = 0; ks < NKS; ++ks) asm volatile("" : "+v"(qr[ks]));
#pragma unroll
    for (int t = 0; t < PD; ++t) if (t < NT) ATT_DMA(t, t);
    f32x16_t o[NOD];
#pragma unroll
    for (int dd = 0; dd < NOD; ++dd) o[dd] = f32x16_t{};
    float m = 0.f, l = 0.f; f32x16_t negm = f32x16_t{};
    const int tlast = CAUSAL ? qcb + (rg >> 1) : NT - 1;
    const LAS unsigned char* kbase = S + KOFF + hi * 1024 + r32 * 16;
    const LAS unsigned char* vbase = S + VOFF + ((lane >> 4) & 1) * 32 + (lane & 3) * 8 + (4 * hi + ((lane & 15) >> 2)) * 64 + dp * NOD * 4096;
    bf16x8_t pa[4];
#define ATT_QKSM(sl) do { const LAS unsigned char* kp = kbase + (sl) * KSLOT; \
            f32x16_t p0 = negm, p1 = negm; \
            _Pragma("unroll") for (int ks = 0; ks < NKS; ++ks) { const bf16x8_t a0 = *(const LAS bf16x8_t*)(kp + ks * 2048), a1 = *(const LAS bf16x8_t*)(kp + ks * 2048 + 512); \
                if (VAR != 2) { p0 = __builtin_amdgcn_mfma_f32_32x32x16_bf16(a0, qr[ks], p0, 0, 0, 0); p1 = __builtin_amdgcn_mfma_f32_32x32x16_bf16(a1, qr[ks], p1, 0, 0, 0); } else { p0[ks] += __builtin_bit_cast(float, (int)a0[0]); p1[ks] += __builtin_bit_cast(float, (int)a1[0]); } } \
            asm volatile("s_nop 15\n\ts_nop 7" : "+v"(p0), "+v"(p1)); \
            float rm = 0.f; \
            if (VAR != 1) { float a = max3f(p0[0], p0[1], p1[0]), b = max3f(p0[2], p0[3], p1[1]); a = max3f(a, p1[2], p1[3]); \
              _Pragma("unroll") for (int r = 4; r < 16; r += 4) { a = max3f(a, p0[r], p0[r + 1]); b = max3f(b, p0[r + 2], p0[r + 3]); a = max3f(a, p1[r], p1[r + 1]); b = max3f(b, p1[r + 2], p1[r + 3]); } \
              rm = max2f(a, b); rm = max2f(rm, __shfl_xor(rm, 32)); } \
            if (__any(rm > 0.f)) { \
                const float dl = fmaxf(rm, 0.f), alpha = __builtin_amdgcn_exp2f(-dl); m += dl; l *= alpha; \
                _Pragma("unroll") for (int r = 0; r < 16; ++r) { p0[r] -= dl; p1[r] -= dl; negm[r] = -m; } \
                if (hi == 0) wsf[r32] = alpha; \
                LDS_WAIT(); asm volatile("" ::: "memory"); \
                _Pragma("unroll") for (int r = 0; r < 16; ++r) { const float f = wsf[crow16(r, hi)]; \
                    _Pragma("unroll") for (int dd = 0; dd < NOD; ++dd) o[dd][r] *= f; } \
                LDS_WAIT(); asm volatile("" ::: "memory"); \
            } \
            float ls = 0.f; \
            if (VAR != 1) { _Pragma("unroll") for (int r = 0; r < 16; ++r) { p0[r] = __builtin_amdgcn_exp2f(p0[r]); p1[r] = __builtin_amdgcn_exp2f(p1[r]); ls += p0[r] + p1[r]; } } \
            l += ls; \
            _Pragma("unroll") for (int ks = 0; ks < 4; ++ks) { pg8::u32x4 w; \
                if (ks < 2) { w.x = pg8::cvt_pk_bf16(p0[8 * ks], p0[8 * ks + 1]); w.y = pg8::cvt_pk_bf16(p0[8 * ks + 2], p0[8 * ks + 3]); w.z = pg8::cvt_pk_bf16(p0[8 * ks + 4], p0[8 * ks + 5]); w.w = pg8::cvt_pk_bf16(p0[8 * ks + 6], p0[8 * ks + 7]); } \
                else { const int k2 = ks - 2; w.x = pg8::cvt_pk_bf16(p1[8 * k2], p1[8 * k2 + 1]); w.y = pg8::cvt_pk_bf16(p1[8 * k2 + 2], p1[8 * k2 + 3]); w.z = pg8::cvt_pk_bf16(p1[8 * k2 + 4], p1[8 * k2 + 5]); w.w = pg8::cvt_pk_bf16(p1[8 * k2 + 6], p1[8 * k2 + 7]); } \
                pa[ks] = __builtin_bit_cast(bf16x8_t, w); } } while (0)
#define ATT_PV(sl) do { const LAS unsigned char* vp = vbase + (sl) * VSLOT; \
            _Pragma("unroll") for (int dd = 0; dd < NOD; ++dd) \
                _Pragma("unroll") for (int ks = 0; ks < 4; ++ks) { \
                    const v4i16_t lo = __builtin_amdgcn_ds_read_tr16_b64_v4i16((LAS v4i16_t*)(vp + dd * 4096 + ks * 1024)); \
                    const v4i16_t hh = __builtin_amdgcn_ds_read_tr16_b64_v4i16((LAS v4i16_t*)(vp + dd * 4096 + ks * 1024 + 512)); \
                    const bf16x8_t vf = join_tr(lo, hh); \
                    if (VAR != 2) o[dd] = __builtin_amdgcn_mfma_f32_32x32x16_bf16(pa[ks], vf, o[dd], 0, 0, 0); else o[dd][ks] += __builtin_bit_cast(float, (int)vf[0] + (int)pa[ks][0]); } } while (0)
    int slot = 0, slot_prev = NSLOT - 1, slot_issue = PD % NSLOT;
    for (int t = 0; t < NT; ++t) {
        const int ahead = (t + PD - 1 < NT - 1 ? t + PD - 1 : NT - 1) - t;
        const int nwait = ahead * nld;
        if (nwait <= 0) ATT_BAR(0); else if (nwait == 2) ATT_BAR(2); else if (nwait == 3) ATT_BAR(3); else if (nwait == 4) ATT_BAR(4); else if (nwait == 6) ATT_BAR(6); else if (nwait == 8) ATT_BAR(8); else ATT_BAR(0);
        if (t + PD < NT) ATT_DMA(t + PD, slot_issue);
        if (!late) { if (t <= tlast) { ATT_QKSM(slot); ATT_PV(slot); } }
        else { if (t >= 1 && t - 1 <= tlast) ATT_PV(slot_prev); if (t <= tlast) ATT_QKSM(slot); }
        slot_prev = slot; slot = slot + 1 == NSLOT ? 0 : slot + 1; slot_issue = slot_issue + 1 == NSLOT ? 0 : slot_issue + 1;
    }
    if (late && tlast >= NT - 1) ATT_PV(slot_prev);
    l += __shfl_xor(l, 32);
    if (hi == 0) wsf[32 + r32] = l;
    ATT_BAR(0);
    LAS bf16* stg = (LAS bf16*)(S + KOFF) + wid * 32 * DVW;
#pragma unroll
    for (int r = 0; r < 16; ++r) { const int orow = crow16(r, hi); const float rl = __builtin_amdgcn_rcpf(wsf[32 + orow]);
#pragma unroll
        for (int dd = 0; dd < NOD; ++dd) stg[orow * DVW + dd * 32 + r32] = f2bf(o[dd][r] * rl); }
    LDS_WAIT(); asm volatile("" ::: "memory");
#pragma unroll
    for (int i = 0; i < DVW / 16; ++i) { const int idx = i * 64 + lane, row = idx / (DVW / 8), ch = idx % (DVW / 8);
        *(pg8::u32x4*)(Ou + (size_t)(32 * rg + row) * opitch + dp * DVW + ch * 8) = *(const LAS pg8::u32x4*)(stg + row * DVW + ch * 8); }
    ATT_BAR(0);
#undef ATT_DMA
#undef ATT_QKSM
#undef ATT_PV
}

typedef float f32x2_t __attribute__((ext_vector_type(2)));
DEVI unsigned cvtpk(float lo, float hi) { const f32x2_t v = {lo, hi}; const bf16x2_t b = __builtin_convertvector(v, bf16x2_t); return __builtin_bit_cast(unsigned, b); }
DEVI void attn_mla_unit(LAS unsigned char* S, const bf16* Qu, const bf16* Ku, const bf16* Vu, bf16* Ou, int NT, int qcb) {
    constexpr int NCH = 12, KSLOT = NCH * 1024, VSLOT = 8192, NSLOT = 4, NKS = 6, qpitch = 768, kpitch = 768, vpitch = 512, opitch = D;
    constexpr int KOFF = 0, VOFF = NSLOT * KSLOT, WSF = VOFF + NSLOT * VSLOT;
    int tid_ = threadIdx.x; asm volatile("" : "+v"(tid_));
    const int lane = tid_ & 63, wid = __builtin_amdgcn_readfirstlane(tid_ >> 6), r32 = lane & 31, hi = lane >> 5;
    LAS float* wsf = (LAS float*)(S + WSF) + wid * 64;
    const int nld = wid < 4 ? 3 : 2;
    const bf16* ksrc = Ku + (size_t)lane * kpitch;
    const bf16* vsrc = Vu + (size_t)(lane >> 2) * vpitch + (lane & 3) * 8;
#define MLA_DMA(t, slot) do { \
        glds16(ksrc + (size_t)(t) * 64 * kpitch + wid * 8, LDSADDR(S + KOFF + (slot) * KSLOT + wid * 1024)); \
        if (wid < 4) glds16(ksrc + (size_t)(t) * 64 * kpitch + (wid + 8) * 8, LDSADDR(S + KOFF + (slot) * KSLOT + (wid + 8) * 1024)); \
        glds16(vsrc + (size_t)((t) * 64 + (wid & 3) * 16) * vpitch + (wid >> 2) * 32, LDSADDR(S + VOFF + (slot) * VSLOT + wid * 1024)); } while (0)
#define MLA_BAR(nw) do { if ((nw) <= 0) ATT_BAR(0); else if ((nw) == 2) ATT_BAR(2); else if ((nw) == 3) ATT_BAR(3); else if ((nw) == 4) ATT_BAR(4); else ATT_BAR(6); } while (0)
#define SGB(mask, n) __builtin_amdgcn_sched_group_barrier(mask, n, 0)
    bf16x8_t qr[NKS];
#pragma unroll
    for (int ks = 0; ks < NKS; ++ks) qr[ks] = *(const bf16x8_t*)(Qu + (size_t)(32 * wid + r32) * qpitch + ks * 16 + hi * 8);
#pragma unroll
    for (int ks = 0; ks < NKS; ++ks) asm volatile("" : "+v"(qr[ks]));
    MLA_DMA(0, 0); MLA_DMA(1, 1); MLA_DMA(2, 2);
    f32x16_t o0 = f32x16_t{}, o1 = f32x16_t{};
    float m = 0.f, l = 0.f; f32x16_t negm = f32x16_t{};
    const int tlast = qcb + (wid >> 1);
    const LAS unsigned char* kbase = S + KOFF + hi * 1024 + r32 * 16;
    const LAS unsigned char* vbase = S + VOFF + ((lane >> 4) & 1) * 32 + (lane & 3) * 8 + (4 * hi + ((lane & 15) >> 2)) * 64;
    f32x16_t p0, p1;
#define MLA_ROWMAX(rm, q0, q1) do { float a_ = __builtin_fmaxf(__builtin_fmaxf(q0[0], q0[1]), q1[0]), b_ = __builtin_fmaxf(__builtin_fmaxf(q0[2], q0[3]), q1[1]); a_ = __builtin_fmaxf(__builtin_fmaxf(a_, q1[2]), q1[3]); \
        _Pragma("unroll") for (int r = 4; r < 16; r += 4) { a_ = __builtin_fmaxf(__builtin_fmaxf(a_, q0[r]), q0[r + 1]); b_ = __builtin_fmaxf(__builtin_fmaxf(b_, q0[r + 2]), q0[r + 3]); a_ = __builtin_fmaxf(__builtin_fmaxf(a_, q1[r]), q1[r + 1]); b_ = __builtin_fmaxf(__builtin_fmaxf(b_, q1[r + 2]), q1[r + 3]); } \
        rm = __builtin_fmaxf(a_, b_); rm = __builtin_fmaxf(rm, __shfl_xor(rm, 32)); } while (0)
#define MLA_MOVE(rm, q0, q1) do { if (__any(rm > 0.f)) { \
            const float dl = fmaxf(rm, 0.f), alpha = __builtin_amdgcn_exp2f(-dl); m += dl; l *= alpha; \
            _Pragma("unroll") for (int r = 0; r < 16; ++r) { q0[r] -= dl; q1[r] -= dl; negm[r] = -m; } \
            if (hi == 0) wsf[r32] = alpha; \
            LDS_WAIT(); asm volatile("" ::: "memory"); \
            _Pragma("unroll") for (int r = 0; r < 16; ++r) { const float f = wsf[crow16(r, hi)]; o0[r] *= f; o1[r] *= f; } \
            LDS_WAIT(); asm volatile("" ::: "memory"); } } while (0)
    MLA_BAR(2 * nld);
    MLA_DMA(3, 3);
    { const LAS unsigned char* kp = kbase; p0 = negm; p1 = negm;
#pragma unroll
      for (int ks = 0; ks < NKS; ++ks) { const bf16x8_t a0 = *(const LAS bf16x8_t*)(kp + ks * 2048), a1 = *(const LAS bf16x8_t*)(kp + ks * 2048 + 512);
          p0 = __builtin_amdgcn_mfma_f32_32x32x16_bf16(a0, qr[ks], p0, 0, 0, 0); p1 = __builtin_amdgcn_mfma_f32_32x32x16_bf16(a1, qr[ks], p1, 0, 0, 0); }
      float rm; MLA_ROWMAX(rm, p0, p1); MLA_MOVE(rm, p0, p1); }
    int kslot = 1, vslot = 0, islot = 3;
    for (int t = 0; t < NT; ++t) {
        if (t + 1 < NT) { const int young = (t + 2 < NT) ? 1 : 0; MLA_BAR(young * nld); } else ATT_BAR(0);
        if (t >= 1 && t + 3 < NT) MLA_DMA(t + 3, islot);
        if (t < tlast) {
            const LAS unsigned char* kp = kbase + kslot * KSLOT; const LAS unsigned char* vp = vbase + vslot * VSLOT;
            bf16x8_t kf[12];
#pragma unroll
            for (int ks = 0; ks < NKS; ++ks) { kf[2 * ks] = *(const LAS bf16x8_t*)(kp + ks * 2048); kf[2 * ks + 1] = *(const LAS bf16x8_t*)(kp + ks * 2048 + 512); }
            f32x16_t n0 = negm, n1 = negm; float ls = 0.f; pg8::u32x4 pw[4];
#pragma unroll
            for (int ks = 0; ks < NKS; ++ks) { n0 = __builtin_amdgcn_mfma_f32_32x32x16_bf16(kf[2 * ks], qr[ks], n0, 0, 0, 0); n1 = __builtin_amdgcn_mfma_f32_32x32x16_bf16(kf[2 * ks + 1], qr[ks], n1, 0, 0, 0); }
#pragma unroll
            for (int r = 0; r < 16; ++r) { p0[r] = __builtin_amdgcn_exp2f(p0[r]); p1[r] = __builtin_amdgcn_exp2f(p1[r]); }
#pragma unroll
            for (int r = 0; r < 16; r += 2) { ls += (p0[r] + p0[r + 1]) + (p1[r] + p1[r + 1]); }
#pragma unroll
            for (int ks = 0; ks < 2; ++ks) { pw[ks] = (pg8::u32x4){cvtpk(p0[8 * ks], p0[8 * ks + 1]), cvtpk(p0[8 * ks + 2], p0[8 * ks + 3]), cvtpk(p0[8 * ks + 4], p0[8 * ks + 5]), cvtpk(p0[8 * ks + 6], p0[8 * ks + 7])};
                pw[2 + ks] = (pg8::u32x4){cvtpk(p1[8 * ks], p1[8 * ks + 1]), cvtpk(p1[8 * ks + 2], p1[8 * ks + 3]), cvtpk(p1[8 * ks + 4], p1[8 * ks + 5]), cvtpk(p1[8 * ks + 6], p1[8 * ks + 7])}; }
            l += ls;
            SGB(0x100, 4);
#pragma unroll
            for (int i = 0; i < 12; ++i) { SGB(0x008, 1); SGB(0x002, 7); if (i < 8) SGB(0x100, 1); }
            __builtin_amdgcn_sched_barrier(0);
            v4i16_t vlo[8], vhi[8];
#pragma unroll
            for (int i = 0; i < 8; ++i) { vlo[i] = __builtin_amdgcn_ds_read_tr16_b64_v4i16((LAS v4i16_t*)(vp + (i >> 2) * 4096 + (i & 3) * 1024)); vhi[i] = __builtin_amdgcn_ds_read_tr16_b64_v4i16((LAS v4i16_t*)(vp + (i >> 2) * 4096 + (i & 3) * 1024 + 512)); }
#pragma unroll
            for (int i = 0; i < 8; ++i) { const bf16x8_t vf = join_tr(vlo[i], vhi[i]); const bf16x8_t pa_ = __builtin_bit_cast(bf16x8_t, pw[i & 3]);
                if (i < 4) o0 = __builtin_amdgcn_mfma_f32_32x32x16_bf16(pa_, vf, o0, 0, 0, 0); else o1 = __builtin_amdgcn_mfma_f32_32x32x16_bf16(pa_, vf, o1, 0, 0, 0); }
            float rm; MLA_ROWMAX(rm, n0, n1);
            SGB(0x100, 6);
#pragma unroll
            for (int i = 0; i < 8; ++i) { SGB(0x008, 1); SGB(0x002, 3); if (i < 5) SGB(0x100, 2); }
            __builtin_amdgcn_sched_barrier(0);
            MLA_MOVE(rm, n0, n1);
            p0 = n0; p1 = n1;
        } else if (t == tlast) {
            asm volatile("" : "+v"(p0), "+v"(p1));
            const LAS unsigned char* vp = vbase + vslot * VSLOT; float ls = 0.f; pg8::u32x4 pw[4];
#pragma unroll
            for (int r = 0; r < 16; ++r) { p0[r] = __builtin_amdgcn_exp2f(p0[r]); p1[r] = __builtin_amdgcn_exp2f(p1[r]); ls += p0[r] + p1[r]; }
            l += ls;
#pragma unroll
            for (int ks = 0; ks < 2; ++ks) { pw[ks] = (pg8::u32x4){cvtpk(p0[8 * ks], p0[8 * ks + 1]), cvtpk(p0[8 * ks + 2], p0[8 * ks + 3]), cvtpk(p0[8 * ks + 4], p0[8 * ks + 5]), cvtpk(p0[8 * ks + 6], p0[8 * ks + 7])};
                pw[2 + ks] = (pg8::u32x4){cvtpk(p1[8 * ks], p1[8 * ks + 1]), cvtpk(p1[8 * ks + 2], p1[8 * ks + 3]), cvtpk(p1[8 * ks + 4], p1[8 * ks + 5]), cvtpk(p1[8 * ks + 6], p1[8 * ks + 7])}; }
#pragma unroll
            for (int i = 0; i < 8; ++i) { const v4i16_t lo = __builtin_amdgcn_ds_read_tr16_b64_v4i16((LAS v4i16_t*)(vp + (i >> 2) * 4096 + (i & 3) * 1024)), hh = __builtin_amdgcn_ds_read_tr16_b64_v4i16((LAS v4i16_t*)(vp + (i >> 2) * 4096 + (i & 3) * 1024 + 512));
                const bf16x8_t vf = join_tr(lo, hh); const bf16x8_t pa_ = __builtin_bit_cast(bf16x8_t, pw[i & 3]);
                if (i < 4) o0 = __builtin_amdgcn_mfma_f32_32x32x16_bf16(pa_, vf, o0, 0, 0, 0); else o1 = __builtin_amdgcn_mfma_f32_32x32x16_bf16(pa_, vf, o1, 0, 0, 0); }
        }
        kslot = (kslot + 1) & 3; vslot = (vslot + 1) & 3; islot = (islot + 1) & 3;
    }
    l += __shfl_xor(l, 32);
    if (hi == 0) wsf[32 + r32] = l;
    ATT_BAR(0);
    LAS bf16* stg = (LAS bf16*)(S + KOFF) + wid * 32 * 64;
#pragma unroll
    for (int r = 0; r < 16; ++r) { const int orow = crow16(r, hi); const float rl = __builtin_amdgcn_rcpf(wsf[32 + orow]);
        stg[orow * 64 + r32] = f2bf(o0[r] * rl); stg[orow * 64 + 32 + r32] = f2bf(o1[r] * rl); }
    LDS_WAIT(); asm volatile("" ::: "memory");
#pragma unroll
    for (int i = 0; i < 4; ++i) { const int idx = i * 64 + lane, row = idx >> 3, ch = idx & 7;
        *(pg8::u32x4*)(Ou + (size_t)(32 * wid + row) * opitch + ch * 8) = *(const LAS pg8::u32x4*)(stg + row * 64 + ch * 8); }
    ATT_BAR(0);
#undef MLA_DMA
#undef MLA_BAR
#undef MLA_ROWMAX
#undef MLA_MOVE
#undef SGB
}

DEVI bool unit_of(int Mrows, int Ncols, int G, int c, int i, int& pm, int& pn) {
    const int nM = Mrows / 256, nN = Ncols / 256, nwg = nM * nN; const long Lq = (long)i * G + c; if (Lq >= nwg) return false;
    int wgid = (int)Lq; { const int q = nwg / 8, r = nwg % 8, xcd = wgid % 8, off = wgid / 8; wgid = (xcd < r ? xcd * (q + 1) : r * (q + 1) + (xcd - r) * q) + off; }
    const int nig = 8 * nN, gid = wgid / nig, fm = gid * 8, gsz = (nM - fm) < 8 ? (nM - fm) : 8;
    pm = fm + ((wgid % nig) % gsz); pn = (wgid % nig) / gsz; return true;
}
DEVI void own_writes_visible() {
    asm volatile("s_waitcnt vmcnt(0)" ::: "memory"); __syncthreads();
    if (threadIdx.x == 0) { __builtin_amdgcn_fence(__ATOMIC_ACQUIRE, "agent"); asm volatile("s_waitcnt vmcnt(0)" ::: "memory"); }
    __syncthreads();
}

__global__ void __launch_bounds__(NTHR, 2) mega(Args args) {
    extern __shared__ __attribute__((aligned(16))) unsigned char lds[];
    const int tid = threadIdx.x, lane = tid & 63, wave = __builtin_amdgcn_readfirstlane(tid >> 6);
    const int G = gridDim.x, bx = blockIdx.x; const int vcu = (G % 8 == 0) ? (bx % 8) * (G / 8) + bx / 8 : bx;
    LAS unsigned char* L = (LAS unsigned char*)lds + PH_BASE;
    volatile LAS unsigned* MISC = (volatile LAS unsigned*)((LAS unsigned char*)lds + LDSCTL_OFF + 320);
    unsigned char* ws = args.ws; gu32* ctl = (gu32*)(ws + WS_CTL);
    if (tid < PH_BASE / 4) ((LAS unsigned*)(lds))[tid] = 0u;
    __syncthreads();
    XcdBarrier bar = xcd_barrier_post((unsigned*)(ctl + CW_BAR) + args.li * XCD_BAR_WORDS, MISC + 8);
    const unsigned mask = args.mask;
#define IN(k) ((mask >> (k)) & 1u)
#ifndef PROBE_ATTVAR
#define PROBE_ATTVAR 0
#endif
#ifndef PROBE_EXPVAR
#define PROBE_EXPVAR 0
#endif
#ifndef PROBE_REP
#define PROBE_REP 0u
#endif
#define NREP(k) (1 + (int)((PROBE_REP >> (k)) & 1u))
#define SEAM(k) do { if ((mask & ((1u << PH_N) - 1u)) >> ((k) + 1)) xcd_barrier(bar); } while (0)
    const float* x = args.in[0]; float* out = args.out;
    bf16 *Wt_in = (bf16*)(ws + WS_WIN), *Wt_qup = (bf16*)(ws + WS_WQUP), *Wt_kv = (bf16*)(ws + WS_WKV), *Wt_mix = (bf16*)(ws + WS_WMIX), *Wt_mq = (bf16*)(ws + WS_WMQ), *Wt_mkv = (bf16*)(ws + WS_WMKV),
         *Wt_mo = (bf16*)(ws + WS_WMO), *Wt_pq = (bf16*)(ws + WS_WPQ), *SK = (bf16*)(ws + WS_SK), *MEMN = (bf16*)(ws + WS_MEMN), *MEMKV = (bf16*)(ws + WS_MEMKV), *PU = (bf16*)(ws + WS_PU), *PV = (bf16*)(ws + WS_PV);
    float *partq = (float*)(ws + WS_PARTQ), *partkv = (float*)(ws + WS_PARTKV), *part1 = (float*)(ws + WS_PART1), *part2 = (float*)(ws + WS_PART2), *trig = (float*)(ws + WS_TRIG);
    bf16 *XN = (bf16*)(ws + WS_R1), *CONCAT = XN, *QM = XN, *H2B = XN;
    bf16 *CQ = (bf16*)(ws + WS_R2 + R2_CQ), *CKV = (bf16*)(ws + WS_R2 + R2_CKV), *U = (bf16*)(ws + WS_R2 + R2_U), *H1B = (bf16*)(ws + WS_R2), *OM = (bf16*)(ws + WS_R3);
    bf16 *QB = (bf16*)(ws + WS_R3 + R3_QB), *KB = (bf16*)(ws + WS_R3 + R3_KB), *VB = (bf16*)(ws + WS_R3 + R3_VB), *QP = (bf16*)(ws + WS_R3);


    if (IN(PH_PRO)) {
        for (int rep_ = 0; rep_ < NREP(PH_PRO); ++rep_) { if (rep_) xcd_barrier(bar);
        LAS float* scr = (LAS float*)(L + wave * 16384);
        const int gw = vcu * NWAVES + wave, NGW = G * NWAVES;
        constexpr int I_IN = (D / 64) * (INP / 32), I_QUP = (256 / 64) * (768 / 32), I_KV = (128 / 64) * (1024 / 32), I_SQ = (D / 64) * (D / 32), I_W2 = (D / 64) * (2048 / 32);
        constexpr int NITEMS = I_IN + I_QUP + I_KV + 2 * I_SQ + 2 * I_W2;
        for (int rp_ = 0; rp_ < 1 + (int)((PROBE_REP >> 20) & 1u); ++rp_)
        for (int it = gw; it < NITEMS; it += NGW) {
            int r = it;
            if (r < I_IN) { p0_transpose_item<1, false>(args.in[3], D, INC, Wt_in, INP, nullptr, scr, r, lane); continue; } r -= I_IN;
            if (r < I_QUP) { p0_transpose_item<0, true>(args.in[5], 256, 768, Wt_qup, 768, args.in[4], scr, r, lane); continue; } r -= I_QUP;
            if (r < I_KV) { p0_transpose_item<2, true>(args.in[7], 128, 1024, Wt_kv, 1024, args.in[6], scr, r, lane); continue; } r -= I_KV;
            if (r < I_SQ) { p0_transpose_item<0, false>(args.in[12], D, D, Wt_mix, D, nullptr, scr, r, lane); continue; } r -= I_SQ;
            if (r < I_SQ) { p0_transpose_item<0, false>(args.in[17], D, D, Wt_mo, D, nullptr, scr, r, lane); continue; } r -= I_SQ;
            if (r < I_W2) { p0_transpose_item<0, false>(args.in[16], D, 2048, Wt_mkv, 2048, nullptr, scr, r, lane); continue; } r -= I_W2;
            p0_transpose_item<0, true>(args.in[19], D, 2048, Wt_pq, 2048, args.in[18], scr, r, lane);
        }
        for (int rp_ = 0; rp_ < 1 + (int)((PROBE_REP >> 21) & 1u); ++rp_)
        for (int m = gw; m < M; m += 4 * NGW) rms_rows4_to_bf16(x, args.in[2], XN, m, NGW, M, lane);
        for (int m = gw; m < BATCH * NMEM; m += NGW) rms_row_to_bf16(args.in[1] + (size_t)m * D, args.in[14], MEMN + (size_t)m * D, lane);
        const size_t gtid = (size_t)vcu * NTHR + tid, gn = (size_t)G * NTHR;
        cvt_stream(args.in[20], SK, (size_t)PH * 2 * PNK * PHALF / 8, nullptr, gtid, gn);
        for (size_t i = gtid; i < (size_t)D * D / 8; i += gn) {
            const float4 a = *(const float4*)(args.in[15] + i * 8), b = *(const float4*)(args.in[15] + i * 8 + 4); const float gk = args.in[13][(i * 8) >> 10];
            pg8::u32x4 o; o.x = pg8::cvt_pk_bf16(a.x * gk, a.y * gk); o.y = pg8::cvt_pk_bf16(a.z * gk, a.w * gk); o.z = pg8::cvt_pk_bf16(b.x * gk, b.y * gk); o.w = pg8::cvt_pk_bf16(b.z * gk, b.w * gk);
            *(pg8::u32x4*)(Wt_mq + i * 8) = o; }
        for (int rp_ = 0; rp_ < 1 + (int)((PROBE_REP >> 22) & 1u); ++rp_) {
        cvt_rows_fp6<true>(args.in[21], (unsigned char*)PU, args.in[18], PU_SCALE, gtid, gn);
        cvt_rows_fp6<false>(args.in[22], (unsigned char*)PV, nullptr, PV_SCALE, gtid, gn); }
        for (size_t i = gtid; i < (size_t)SEQ * 16; i += gn) { float c, s; rope_cs((int)(i >> 4), (int)(i & 15), c, s); *(float2*)(trig + i * 2) = make_float2(c, s); }
        }
        SEAM(PH_PRO);
    }
    if (IN(PH_PROJ)) {
        for (int rep_ = 0; rep_ < NREP(PH_PROJ); ++rep_) { if (rep_) xcd_barrier(bar);
        { pg8::Gemm g{XN, Wt_in, M, INP, D, 0, 0, 0, 0}; pg8::StaticOrder S; S.init(M, INP, G, bx); pg8::EpiProj E{CQ, CKV, KB, U, partq, partkv, trig};
          pg8::gemm_phase<pg8::EpiProj, pg8::StaticOrder, true, true>(L, g, S, E); }
        { pg8::Gemm g{MEMN, Wt_mkv, BATCH * NMEM, 2048, D, 0, 0, 0, 0}; pg8::StaticOrder S; S.init(BATCH * NMEM, 2048, G, (bx + 128) % G); pg8::EpiPlain E{MEMKV, 2048};
          pg8::gemm_phase<pg8::EpiPlain, pg8::StaticOrder, true, true>(L, g, S, E); }
        }
        SEAM(PH_PROJ);
    }
    if (IN(PH_UP)) {
        for (int rep_ = 0; rep_ < NREP(PH_UP); ++rep_) { if (rep_) xcd_barrier(bar);
        if (IN(PHB_UPG)) {
        { pg8::Gemm g{CQ, Wt_qup, M, 768, 256, 0, 0, 0, 0}; pg8::StaticOrder S; S.init(M, 768, G, bx); pg8::EpiQ E{QB, partq, trig, LOG2E * 0.10206207261596577f};
          pg8::gemm_phase<pg8::EpiQ, pg8::StaticOrder, true, true>(L, g, S, E); }
        { pg8::Gemm g{CKV, Wt_kv, M, 1024, 128, 0, 0, 0, 0}; pg8::StaticOrder S; S.init(M, 1024, G, (bx + 192) % G); pg8::EpiKV E{KB, VB, partkv};
          pg8::gemm_phase<pg8::EpiKV, pg8::StaticOrder, true, true>(L, g, S, E); }
        }
        if (IN(PHB_CONV)) { __syncthreads(); for (int c = vcu; c < M / 64; c += G) conv_chunk(c, U, args.in[8], args.in[9], args.in[10], args.in[11], CONCAT, L); }
        }
        SEAM(PH_UP);
    }
    if (IN(PH_ATTN)) {
        for (int rep_ = 0; rep_ < NREP(PH_ATTN); ++rep_) { if (rep_) xcd_barrier(bar);
        for (int u = vcu; u < 512; u += G) { const int bh = (u & 255) >> 4, sidx = u & 15, qb = u < 256 ? 31 - sidx : sidx, b = bh >> 3, h = bh & 7;
            const size_t r0 = (size_t)b * SEQ;
            if (NREP(PH_ATTN) > 1 && rep_ == 0) attn_unit<96, 64, 1, 4, 3, true, false, PROBE_ATTVAR>(L, QB + (r0 + qb * 256) * 768 + h * 96, 768, KB + r0 * 768 + h * 96, 768, VB + r0 * 512 + h * 64, 512, CONCAT + (r0 + qb * 256) * D + h * 64, D, 4 * qb + 4, 4 * qb);
            else attn_mla_unit(L, QB + (r0 + qb * 256) * 768 + h * 96, KB + r0 * 768 + h * 96, VB + r0 * 512 + h * 64, CONCAT + (r0 + qb * 256) * D + h * 64, 4 * qb + 4, 4 * qb); }
        }
        { bf16* KQT = (bf16*)(ws + WS_KQT); bf16* VOT = (bf16*)(ws + WS_VOT);
#pragma unroll 1
          for (int bh = 0; bh < BATCH * XH; ++bh) { const int b = bh >> 2, h = bh & 3;
            { pg8::Gemm g{MEMKV + (size_t)b * NMEM * 2048 + h * XD, Wt_mq + h * XD, NMEM, D, XD, 2048, D, 0, 0}; pg8::StaticOrder S; S.init(NMEM, D, G, (bx + 8 * bh) % G);
              pg8::EpiPlain E{KQT + (size_t)b * D * D + (size_t)h * XD * D, D}; pg8::gemm_phase<pg8::EpiPlain, pg8::StaticOrder, true, true>(L, g, S, E); }
            { pg8::Gemm g{Wt_mo + h * XD, MEMKV + (size_t)b * NMEM * 2048 + 1024 + h * XD, D, NMEM, XD, D, 2048, 0, 0}; pg8::StaticOrder S; S.init(D, NMEM, G, (bx + 8 * bh + 4) % G);
              pg8::EpiPlain E{VOT + (size_t)b * D * D + h * XD, D}; pg8::gemm_phase<pg8::EpiPlain, pg8::StaticOrder, true, true>(L, g, S, E); } } }
        SEAM(PH_ATTN);
    }
    if (IN(PH_MIX)) {
        for (int rep_ = 0; rep_ < NREP(PH_MIX); ++rep_) { if (rep_) xcd_barrier(bar);
        pg8::Gemm g{CONCAT, Wt_mix, M, D, D, 0, 0, 0, 0}; pg8::StaticOrder S; S.init(M, D, G, bx); pg8::EpiRes<false> E{x, nullptr, H1B, part1};
        pg8::gemm_phase<pg8::EpiRes<false>, pg8::StaticOrder, true, true>(L, g, S, E);
        }
        SEAM(PH_MIX);
    }
    if (IN(PH_MEMQ)) {
        for (int rep_ = 0; rep_ < NREP(PH_MEMQ); ++rep_) { if (rep_) xcd_barrier(bar);
        pg8::Gemm g{H1B, (const bf16*)(ws + WS_KQT), M, D, D, 0, 0, SEQ / 256, (size_t)D * D * 2}; pg8::StaticOrder S; S.init(M, D, G, bx);
        pg8::EpiSoftmaxP E{OM, D, part1, LOG2E / 16.0f, (LAS float*)(L + 131072)};
        pg8::gemm_phase<pg8::EpiSoftmaxP, pg8::StaticOrder, true, true>(L, g, S, E);
        }
        SEAM(PH_MEMQ);
    }
    if (IN(PH_MEMO)) {
        pg8::Gemm g{OM, (const bf16*)(ws + WS_VOT), M, D, D, 0, 0, SEQ / 256, (size_t)D * D * 2};   pg8::StaticOrder S; S.init(M, D, G, bx); pg8::EpiRes<true> E{nullptr, H1B, H2B, part2};
        pg8::gemm_phase<pg8::EpiRes<true>, pg8::StaticOrder, true, true>(L, g, S, E);
        SEAM(PH_MEMO);
    }
    if (IN(PH_PQ)) {
        for (int rep_ = 0; rep_ < NREP(PH_PQ); ++rep_) { if (rep_) xcd_barrier(bar);
        pg8::Gemm g{H2B, Wt_pq, M, 2048, D, 0, 0, 0, 0}; pg8::StaticOrder S; S.init(M, 2048, G, bx); pg8::EpiScaled E{QP, 2048, part2, 1.0f};
        pg8::gemm_phase<pg8::EpiScaled, pg8::StaticOrder, true, true>(L, g, S, E);
        own_writes_visible();
        int* EIDX = (int*)(ws + WS_R2 + R2_EIDX); float* EGATE = (float*)(ws + WS_R2 + R2_EGATE);
        LAS unsigned* scr = (LAS unsigned*)(L + 65536 + wave * 64 * 9 * 4);
        int hl = -1, upm, upn;
        for (int i = 0; unit_of(M, 2048, G, bx, i, upm, upn); ++i) { const int tb = upm, h = upn;
            if (h != hl) {
                __syncthreads();
                for (int pc = tid; pc < 4096; pc += NTHR) { const int p = pc >> 11, n = (pc >> 4) & 127, c = pc & 15;
                    *(LAS pg8::u32x4*)(L + p * 32768 + c * 2048 + n * 16) = *(const pg8::u32x4*)(SK + ((size_t)(h * 2 + p) * 128 + n) * 128 + c * 8); }
                __syncthreads(); hl = h; }
            const int token = tb * 256 + wave * 32 + (lane & 31);
            topk_wave(QP + (size_t)token * 2048 + h * 256, L, scr, EIDX + (size_t)token * 128 + h * 16, EGATE + (size_t)token * 128 + h * 16, lane); }
        __syncthreads();
        }
        SEAM(PH_PQ);
    }
    if (IN(PH_EXP)) {
        const int* EIDX = (const int*)(ws + WS_R2 + R2_EIDX); const float* EGATE = (const float*)(ws + WS_R2 + R2_EGATE);
#ifndef EXP_PREWARM
#define EXP_PREWARM 0
#endif
        if (EXP_PREWARM) {
            const pg8::u32x4* tb = (const pg8::u32x4*)PU; pg8::u32x4 x = {0u, 0u, 0u, 0u};
            for (size_t i = (size_t)vcu * NTHR + tid; i < (size_t)2 * PE * D / 16; i += (size_t)G * NTHR) { const pg8::u32x4 v = __builtin_nontemporal_load(tb + i); x ^= v; }
            if ((x[0] ^ x[1] ^ x[2] ^ x[3]) == 0x9e3779b9u && tid == 999) out[0] = 0.f;
        }
        for (int rep_ = NREP(PH_EXP) - 1; rep_ >= 0; --rep_) { float* dst = rep_ ? (float*)(ws + WS_R3) : out;
            if (rep_) { if (PROBE_EXPVAR != 5 || wave < 4) experts_wave<PROBE_EXPVAR == 5 ? 0 : PROBE_EXPVAR>(L + wave * EXP_LDS_WAVE, vcu * NWAVES + wave, G * NWAVES, H2B, part2, (const unsigned char*)PU, (const unsigned char*)PV, EIDX, EGATE, args.in[23], dst, lane); } else
            experts_wave<0>(L + wave * EXP_LDS_WAVE, vcu * NWAVES + wave, G * NWAVES, H2B, part2, (const unsigned char*)PU, (const unsigned char*)PV, EIDX, EGATE, args.in[23], dst, lane);
            if (rep_) xcd_barrier(bar); }
    }
#undef IN
#undef SEAM
}

#define FAST_MASK ((1u << PH_PRO) | (1u << PH_PROJ) | (1u << PH_UP) | (1u << PHB_UPG) | (1u << PHB_CONV) | (1u << PH_ATTN) | (1u << PH_MIX) | (1u << PH_MEMQ) | (1u << PH_MEMO) | (1u << PH_PQ) | (1u << PH_EXP))
extern "C" void kernel_launch(void* const* d_in, const int* in_sizes, int n_in, void* d_out, int out_size, void* d_ws, size_t ws_size, hipStream_t stream) {
    if (n_in != 24 || out_size != M * D || ws_size < WS_END) { fprintf(stderr, "kernel_launch: unexpected problem (n_in %d out %d ws %zu)\n", n_in, out_size, ws_size); return; }
    static int grid = 0;
    if (grid == 0) {
        int dev = 0, cus = 0, per_cu = 0;
        if (hipGetDevice(&dev) != hipSuccess || hipDeviceGetAttribute(&cus, hipDeviceAttributeMultiprocessorCount, dev) != hipSuccess) { grid = -1; return; }
        if (hipFuncSetAttribute((const void*)mega, hipFuncAttributeMaxDynamicSharedMemorySize, LDS_BYTES) != hipSuccess) { fprintf(stderr, "kernel_launch: hipFuncSetAttribute failed\n"); grid = -1; return; }
        if (hipOccupancyMaxActiveBlocksPerMultiprocessor(&per_cu, (const void*)mega, NTHR, LDS_BYTES) != hipSuccess || per_cu < 1) { fprintf(stderr, "kernel_launch: occupancy query says %d blocks per CU\n", per_cu); grid = -1; (void)hipGetLastError(); return; }
        grid = cus;
    }
    if (grid < 0) return;
    (void)hipMemsetAsync((char*)d_ws + WS_CTL, 0, CTL_ZERO_BYTES, stream);
    Args a{}; for (int i = 0; i < 24; ++i) a.in[i] = (const float*)d_in[i]; a.out = (float*)d_out; a.ws = (unsigned char*)d_ws; a.mask = FAST_MASK; a.li = 0;
    hipLaunchKernelGGL(mega, dim3(grid), dim3(NTHR), LDS_BYTES, stream, a);
}
```

```cpp
#include <hip/hip_runtime.h>
#include <cstdio>
#include <cstdint>

typedef unsigned short bf16;
#define DEVI __device__ __forceinline__

constexpr int D = 1024, BATCH = 2, SEQ = 8192, M = BATCH * SEQ;
constexpr int NMEM = 256;
constexpr int MH = 8, QRANK = 256, KVRANK = 128, NOPE = 64, ROPE = 32, VD = 64, QK = NOPE + ROPE;
constexpr int CW = 512, CK = 31;
constexpr int INC = QRANK + KVRANK + ROPE + 2 * CW;
constexpr int INP = 1536;
constexpr int XH = 4, XD = 256;
constexpr int PH = 8, PNK = 128, PHALF = 128, PTOP = 16, PE = PNK * PNK;
constexpr float EPS = 1e-6f;
constexpr float LOG2E = 1.4426950408889634f;
constexpr float PU_SCALE = 64.0f, PV_SCALE = 4.0f;

constexpr size_t MiB = 1u << 20;
constexpr size_t WS_CTL = 0;
constexpr size_t WS_WIN = 1 * MiB;
constexpr size_t WS_WQUP = 4 * MiB;
constexpr size_t WS_WKV = 5 * MiB;
constexpr size_t WS_WMIX = 6 * MiB;
constexpr size_t WS_WMQ = 8 * MiB;
constexpr size_t WS_WMKV = 10 * MiB;
constexpr size_t WS_WMO = 14 * MiB;
constexpr size_t WS_WPQ = 16 * MiB;
constexpr size_t WS_SK = 20 * MiB;
constexpr size_t WS_MEMN = 21 * MiB;
constexpr size_t WS_MEMKV = 22 * MiB;
constexpr size_t WS_PARTQ = 24 * MiB;
constexpr size_t WS_PARTKV = 24 * MiB + 512 * 1024;
constexpr size_t WS_PART1 = 25 * MiB;
constexpr size_t WS_PART2 = 26 * MiB;
constexpr size_t WS_PU = 28 * MiB;
constexpr size_t WS_PV = 60 * MiB;
constexpr size_t WS_R1 = 92 * MiB;
constexpr size_t WS_R2 = 124 * MiB;
constexpr size_t WS_R3 = 156 * MiB;
constexpr size_t WS_KQT = 220 * MiB;
constexpr size_t WS_VOT = 224 * MiB;
constexpr size_t WS_END = 228 * MiB;
constexpr size_t R2_CQ = 0, R2_CKV = 8 * MiB, R2_U = 12 * MiB;
constexpr size_t R2_EIDX = 0, R2_EGATE = 8 * MiB;
constexpr size_t R3_QB = 0, R3_KB = 24 * MiB, R3_VB = 48 * MiB;

DEVI bf16 f2bf(float f) { unsigned u = __builtin_bit_cast(unsigned, f); return (bf16)((u + 0x7fffu + ((u >> 16) & 1u)) >> 16); }
DEVI float bf2f(bf16 b) { return __builtin_bit_cast(float, (unsigned)b << 16); }
DEVI float dotbf(const bf16* a, const bf16* b, int K) {
    float s = 0.f;
    for (int k = 0; k < K; k += 8) {
        uint4 x = *(const uint4*)(a + k), y = *(const uint4*)(b + k);
        const unsigned xs[4] = {x.x, x.y, x.z, x.w}, ys[4] = {y.x, y.y, y.z, y.w};
#pragma unroll
        for (int i = 0; i < 4; ++i) {
            s += __builtin_bit_cast(float, xs[i] << 16) * __builtin_bit_cast(float, ys[i] << 16);
            s += __builtin_bit_cast(float, xs[i] & 0xffff0000u) * __builtin_bit_cast(float, ys[i] & 0xffff0000u);
        }
    }
    return s;
}
DEVI float wave_sum(float v) {
#pragma unroll
    for (int o = 1; o < 64; o <<= 1) v += __shfl_xor(v, o);
    return v;
}
DEVI float wave_max(float v) {
#pragma unroll
    for (int o = 1; o < 64; o <<= 1) v = fmaxf(v, __shfl_xor(v, o));
    return v;
}
DEVI void rope_cs(int pos, int i, float& c, float& s) {
    const float inv = exp2f(-(float)i * (13.287712379549449f / 16.0f));
    const float ang = (float)pos * inv;
    const double a = (double)ang; const double k = rint(a * 0.15915494309189535); const float r = (float)(a - k * 6.283185307179586);
    s = sinf(r); c = cosf(r);
}
DEVI int win_src(int r) {
    if (r < 416) return r;
    if (r < 512) return -1;
    const int t = (r - 512) >> 8, w = (r - 512) & 255, bj = w >> 7, j = w & 127, ch = 128 * t + j;
    return 416 + (bj ? CW : 0) + ch;
}
DEVI int wkv_src(int r) { return r < 512 ? (r >> 6) * 128 + (r & 63) : ((r - 512) >> 6) * 128 + 64 + ((r - 512) & 63); }

namespace pg8 {
#define PG8_LAS __attribute__((address_space(3)))
typedef unsigned short bf16_t;
typedef short bf16x8 __attribute__((ext_vector_type(8)));
typedef float f32x4 __attribute__((ext_vector_type(4)));
typedef unsigned u32x4 __attribute__((ext_vector_type(4)));
constexpr int BM = 256, BK = 64, HALF = 128, HTB = HALF * BK * 2  , STAGE_BYTES = 8 * HTB, NXCD = 8, WGM = 8;

__host__ __device__ __forceinline__ int lds_byte(int r, int c) { const int st = (r >> 4) * 2 + (c >> 5), rr = r & 15, cc = c & 31, ob = rr * 64 + cc * 2; return st * 1024 + (ob ^ (((ob >> 9) & 1) << 5)); }
__host__ __device__ __forceinline__ void stage_rc(int b, int& R, int& C) { const int st = b / 1024, sb = b % 1024, swz = sb ^ (((sb >> 9) & 1) << 5); R = (st >> 1) * 16 + swz / 64; C = (st & 1) * 32 + (swz % 64) / 2; }
__host__ __device__ __forceinline__ int perm32(int rho) { const int n = rho >> 4, i = rho & 15; return 8 * (i >> 2) + 4 * n + (i & 3); }

struct Unit { int pm, pn; };
struct Gemm { const bf16_t* A; const bf16_t* Bt; int M, N, K; int lda, ldb; int mb; size_t bstride; };

struct StaticOrder {
    int nM, nN, nwg, G, c;
    __host__ __device__ void init(int M, int N, int G_, int c_) { nM = M / BM; nN = N / BM; nwg = nM * nN; G = G_; c = c_; }
    __host__ __device__ bool next(int i, Unit& u) const {
        const long L = (long)i * G + c; if (L >= nwg) return false;
        int wgid = (int)L; { const int q = nwg / NXCD, r = nwg % NXCD, xcd = wgid % NXCD, off = wgid / NXCD; wgid = (xcd < r ? xcd * (q + 1) : r * (q + 1) + (xcd - r) * q) + off; }
        const int nig = WGM * nN, gid = wgid / nig, fm = gid * WGM, gsz = (nM - fm) < WGM ? (nM - fm) : WGM;
        u.pm = fm + ((wgid % nig) % gsz); u.pn = (wgid % nig) / gsz; return true;
    }
    __device__ __forceinline__ void a_ready(const Unit&) const {}
    __device__ __forceinline__ void done(const Unit&) const {}
};


typedef float f32x2 __attribute__((ext_vector_type(2)));
typedef unsigned u32x2 __attribute__((ext_vector_type(2)));
__device__ __forceinline__ unsigned cvt_pk_bf16(float lo, float hi) { unsigned r; asm volatile("v_cvt_pk_bf16_f32 %0, %1, %2" : "=v"(r) : "v"(lo), "v"(hi)); return r; }
__device__ __forceinline__ void st_bf4(bf16_t* p, f32x4 v) { u32x2 w; w.x = cvt_pk_bf16(v[0], v[1]); w.y = cvt_pk_bf16(v[2], v[3]); *(u32x2*)p = w; }
__device__ __forceinline__ float sq4(f32x4 v) { return (v[0] * v[0] + v[1] * v[1]) + (v[2] * v[2] + v[3] * v[3]); }
__device__ __forceinline__ float red_fq(float s) { s += __shfl_xor(s, 16); s += __shfl_xor(s, 32); return s; }

struct EpiProj {
    static constexpr bool PERM = false, AFTER_DRAIN = false;
    bf16_t *CQ, *CKV, *KB, *U; float *partq, *partkv; const float* trig;
    __device__ __forceinline__ void operator()(const f32x4 (&acc)[2][2][4][2], const Unit& u, int wr, int wc, int fr, int fq) const {
        const int row0 = u.pm * BM + wr * 64 + fr;
        if (u.pn == 0) {
#pragma unroll
            for (int ai = 0; ai < 2; ++ai)
#pragma unroll
                for (int m = 0; m < 4; ++m) { const int row = row0 + ai * HALF + m * 16; float s = 0.f;
#pragma unroll
                    for (int bj = 0; bj < 2; ++bj)
#pragma unroll
                        for (int n = 0; n < 2; ++n) { const f32x4 v = acc[ai][bj][m][n]; s += sq4(v); st_bf4(CQ + (size_t)row * 256 + bj * HALF + wc * 32 + n * 16 + fq * 4, v); }
                    s = red_fq(s); if (fq == 0) partq[(size_t)row * 4 + wc] = s; }
        } else if (u.pn == 1) {
            f32x4 tc0 = {0.f, 0.f, 0.f, 0.f}, tc1 = tc0, tn0 = tc0, tn1 = tc0;
            if (wc == 0) { const float* tp = trig + ((size_t)(row0 % SEQ) * 16 + fq * 4) * 2; tc0 = *(const f32x4*)tp; tc1 = *(const f32x4*)(tp + 4); }
#pragma unroll
            for (int i8 = 0; i8 < 8; ++i8) { const int ai = i8 >> 2, m = i8 & 3; const int row = row0 + ai * HALF + m * 16; float s = 0.f;
                if (wc == 0 && i8 < 7) { const int rown = row0 + ((i8 + 1) >> 2) * HALF + ((i8 + 1) & 3) * 16; const float* tp = trig + ((size_t)(rown % SEQ) * 16 + fq * 4) * 2; tn0 = *(const f32x4*)tp; tn1 = *(const f32x4*)(tp + 4); }
#pragma unroll
                for (int n = 0; n < 2; ++n) { const f32x4 v = acc[ai][0][m][n]; s += sq4(v); st_bf4(CKV + (size_t)row * 128 + wc * 32 + n * 16 + fq * 4, v); }
                s = red_fq(s); if (fq == 0) partkv[(size_t)row * 4 + wc] = s;
                if (wc == 0) { const f32x4 x1 = acc[ai][1][m][0], x2 = acc[ai][1][m][1]; const f32x4 t0 = tc0, t1 = tc1;
                    f32x4 o1, o2; o1[0] = x1[0] * t0[0] - x2[0] * t0[1]; o2[0] = x1[0] * t0[1] + x2[0] * t0[0]; o1[1] = x1[1] * t0[2] - x2[1] * t0[3]; o2[1] = x1[1] * t0[3] + x2[1] * t0[2];
                    o1[2] = x1[2] * t1[0] - x2[2] * t1[1]; o2[2] = x1[2] * t1[1] + x2[2] * t1[0]; o1[3] = x1[3] * t1[2] - x2[3] * t1[3]; o2[3] = x1[3] * t1[3] + x2[3] * t1[2];
                    u32x2 w1, w2; w1.x = cvt_pk_bf16(o1[0], o1[1]); w1.y = cvt_pk_bf16(o1[2], o1[3]); w2.x = cvt_pk_bf16(o2[0], o2[1]); w2.y = cvt_pk_bf16(o2[2], o2[3]);
#pragma unroll
                    for (int h = 0; h < 8; ++h) { *(u32x2*)(KB + (size_t)row * 768 + h * 96 + 64 + fq * 4) = w1; *(u32x2*)(KB + (size_t)row * 768 + h * 96 + 80 + fq * 4) = w2; } }
                tc0 = tn0; tc1 = tn1; asm volatile("" ::: "memory"); }
        } else {
            const int t = u.pn - 2;
#pragma unroll
            for (int ai = 0; ai < 2; ++ai)
#pragma unroll
                for (int m = 0; m < 4; ++m) { const int row = row0 + ai * HALF + m * 16;
#pragma unroll
                    for (int n = 0; n < 2; ++n) { const f32x4 val = acc[ai][0][m][n], gate = acc[ai][1][m][n]; f32x4 o;
#pragma unroll
                        for (int i = 0; i < 4; ++i) o[i] = val[i] * __builtin_amdgcn_rcpf(1.f + __expf(-gate[i]));
                        st_bf4(U + (size_t)row * 512 + t * 128 + wc * 32 + n * 16 + fq * 4, o); } }
        }
    }
};
struct EpiQ {
    static constexpr bool PERM = false, AFTER_DRAIN = false;
    bf16_t* QB; const float* partq; const float* trig; float c2;
    __device__ __forceinline__ void operator()(const f32x4 (&acc)[2][2][4][2], const Unit& u, int wr, int wc, int fr, int fq) const {
        const int row0 = u.pm * BM + wr * 64 + fr;
        const bool rope = ((u.pn * 8 + wc) % 3 == 2) || ((u.pn * 8 + 4 + wc) % 3 == 2);
        f32x4 ppc = *(const f32x4*)(partq + (size_t)row0 * 4), ppn = ppc;
        f32x4 tc0 = {0.f, 0.f, 0.f, 0.f}, tc1 = tc0, tn0 = tc0, tn1 = tc0;
        if (rope) { const float* tp = trig + ((size_t)(row0 % SEQ) * 16 + fq * 4) * 2; tc0 = *(const f32x4*)tp; tc1 = *(const f32x4*)(tp + 4); }
#pragma unroll
        for (int i8 = 0; i8 < 8; ++i8) { const int ai = i8 >> 2, m = i8 & 3; const int row = row0 + ai * HALF + m * 16;
            if (i8 < 7) { const int rown = row0 + ((i8 + 1) >> 2) * HALF + ((i8 + 1) & 3) * 16; ppn = *(const f32x4*)(partq + (size_t)rown * 4);
                if (rope) { const float* tp = trig + ((size_t)(rown % SEQ) * 16 + fq * 4) * 2; tn0 = *(const f32x4*)tp; tn1 = *(const f32x4*)(tp + 4); } }
            const float rs = rsqrtf(((ppc[0] + ppc[1]) + (ppc[2] + ppc[3])) * (1.f / 256.f) + EPS) * c2;
#pragma unroll
            for (int bj = 0; bj < 2; ++bj) { const int g = u.pn * 8 + bj * 4 + wc; bf16_t* dst = QB + (size_t)row * 768 + g * 32 + fq * 4;
                if (g % 3 != 2) { st_bf4(dst, acc[ai][bj][m][0] * rs); st_bf4(dst + 16, acc[ai][bj][m][1] * rs); }
                else { const f32x4 x1 = acc[ai][bj][m][0] * rs, x2 = acc[ai][bj][m][1] * rs; const f32x4 t0 = tc0, t1 = tc1;
                    f32x4 o1, o2; o1[0] = x1[0] * t0[0] - x2[0] * t0[1]; o2[0] = x1[0] * t0[1] + x2[0] * t0[0]; o1[1] = x1[1] * t0[2] - x2[1] * t0[3]; o2[1] = x1[1] * t0[3] + x2[1] * t0[2];
                    o1[2] = x1[2] * t1[0] - x2[2] * t1[1]; o2[2] = x1[2] * t1[1] + x2[2] * t1[0]; o1[3] = x1[3] * t1[2] - x2[3] * t1[3]; o2[3] = x1[3] * t1[3] + x2[3] * t1[2];
                    st_bf4(dst, o1); st_bf4(dst + 16, o2); } }
            ppc = ppn; tc0 = tn0; tc1 = tn1; asm volatile("" ::: "memory"); }
    }
};
struct EpiKV {
    static constexpr bool PERM = false, AFTER_DRAIN = false;
    bf16_t *KB, *VB; const float* partkv;
    __device__ __forceinline__ void operator()(const f32x4 (&acc)[2][2][4][2], const Unit& u, int wr, int wc, int fr, int fq) const {
        const int row0 = u.pm * BM + wr * 64 + fr;
        f32x4 ppc = *(const f32x4*)(partkv + (size_t)row0 * 4), ppn = ppc;
#pragma unroll
        for (int i8 = 0; i8 < 8; ++i8) { const int ai = i8 >> 2, m = i8 & 3; const int row = row0 + ai * HALF + m * 16;
            if (i8 < 7) { const int rown = row0 + ((i8 + 1) >> 2) * HALF + ((i8 + 1) & 3) * 16; ppn = *(const f32x4*)(partkv + (size_t)rown * 4); }
            const float rs = rsqrtf(((ppc[0] + ppc[1]) + (ppc[2] + ppc[3])) * (1.f / 128.f) + EPS);
#pragma unroll
            for (int bj = 0; bj < 2; ++bj)
#pragma unroll
                for (int n = 0; n < 2; ++n) { const int c = u.pn * BM + bj * HALF + wc * 32 + n * 16 + fq * 4; const f32x4 v = acc[ai][bj][m][n] * rs;
                    if (u.pn < 2) st_bf4(KB + (size_t)row * 768 + (c >> 6) * 96 + (c & 63), v); else st_bf4(VB + (size_t)row * 512 + (c - 512), v); }
            ppc = ppn; asm volatile("" ::: "memory"); }
    }
};
template <bool BF16RES> struct EpiRes {
    static constexpr bool PERM = false, AFTER_DRAIN = false;
    const float* res; const bf16_t* resb; bf16_t* outb; float* part;
    __device__ __forceinline__ f32x4 ldres(size_t off) const {
        if (BF16RES) { const u32x2 rb = *(const u32x2*)(resb + off); f32x4 r; r[0] = __builtin_bit_cast(float, rb.x << 16); r[1] = __builtin_bit_cast(float, rb.x & 0xffff0000u); r[2] = __builtin_bit_cast(float, rb.y << 16); r[3] = __builtin_bit_cast(float, rb.y & 0xffff0000u); return r; }
        return *(const f32x4*)(res + off); }
    __device__ __forceinline__ void operator()(const f32x4 (&acc)[2][2][4][2], const Unit& u, int wr, int wc, int fr, int fq) const {
        const int row0 = u.pm * BM + wr * 64 + fr; const int cb = u.pn * BM + wc * 32 + fq * 4;
        f32x4 rc[4], rn[4];
#pragma unroll
        for (int j = 0; j < 4; ++j) { rc[j] = ldres((size_t)row0 * 1024 + cb + (j >> 1) * HALF + (j & 1) * 16); rn[j] = rc[j]; }
#pragma unroll
        for (int i8 = 0; i8 < 8; ++i8) { const int ai = i8 >> 2, m = i8 & 3; const int row = row0 + ai * HALF + m * 16; float s = 0.f;
            if (i8 < 7) { const int rown = row0 + ((i8 + 1) >> 2) * HALF + ((i8 + 1) & 3) * 16;
#pragma unroll
                for (int j = 0; j < 4; ++j) rn[j] = ldres((size_t)rown * 1024 + cb + (j >> 1) * HALF + (j & 1) * 16); }
#pragma unroll
            for (int bj = 0; bj < 2; ++bj)
#pragma unroll
                for (int n = 0; n < 2; ++n) { const size_t off = (size_t)row * 1024 + cb + bj * HALF + n * 16;
                    const f32x4 v = acc[ai][bj][m][n] + rc[bj * 2 + n]; st_bf4(outb + off, v); s += sq4(v); }
            s = red_fq(s); if (fq == 0) part[(size_t)row * 16 + u.pn * 4 + wc] = s;
#pragma unroll
            for (int j = 0; j < 4; ++j) rc[j] = rn[j];
            asm volatile("" ::: "memory"); }
    }
};
struct EpiScaled {
    static constexpr bool PERM = false, AFTER_DRAIN = false;
    bf16_t* out; int ldc; const float* part; float mul;
    __device__ __forceinline__ void operator()(const f32x4 (&acc)[2][2][4][2], const Unit& u, int wr, int wc, int fr, int fq) const {
        const int row0 = u.pm * BM + wr * 64 + fr;
        float rs8[8];
#pragma unroll
        for (int hb = 0; hb < 2; ++hb) { f32x4 q[4][4];
#pragma unroll
            for (int k = 0; k < 4; ++k) { const int row = row0 + hb * HALF + k * 16; const f32x4* pp = (const f32x4*)(part + (size_t)row * 16);
#pragma unroll
                for (int j = 0; j < 4; ++j) q[k][j] = pp[j]; }
#pragma unroll
            for (int k = 0; k < 4; ++k) { const f32x4 a = q[k][0], b = q[k][1], c = q[k][2], d = q[k][3];
                const float ss = (((a[0] + a[1]) + (a[2] + a[3])) + ((b[0] + b[1]) + (b[2] + b[3]))) + (((c[0] + c[1]) + (c[2] + c[3])) + ((d[0] + d[1]) + (d[2] + d[3])));
                rs8[hb * 4 + k] = rsqrtf(ss * (1.f / 1024.f) + EPS) * mul; } }
#pragma unroll
        for (int i8 = 0; i8 < 8; ++i8) { const int ai = i8 >> 2, m = i8 & 3; const int row = row0 + ai * HALF + m * 16; const float rs = rs8[i8];
#pragma unroll
            for (int bj = 0; bj < 2; ++bj)
#pragma unroll
                for (int n = 0; n < 2; ++n) st_bf4(out + (size_t)row * ldc + u.pn * BM + bj * HALF + wc * 32 + n * 16 + fq * 4, acc[ai][bj][m][n] * rs);
            asm volatile("" ::: "memory"); }
    }
};
struct EpiSoftmaxP {
    static constexpr bool PERM = false, AFTER_DRAIN = false;
    bf16_t* out; int ldc; const float* part; float mul; PG8_LAS float* scr;
    __device__ __forceinline__ float rscale(int row) const { const f32x4* pp = (const f32x4*)(part + (size_t)row * 16); const f32x4 a = pp[0], b = pp[1], c = pp[2], d = pp[3];
        const float ss = (((a[0] + a[1]) + (a[2] + a[3])) + ((b[0] + b[1]) + (b[2] + b[3]))) + (((c[0] + c[1]) + (c[2] + c[3])) + ((d[0] + d[1]) + (d[2] + d[3]))); return rsqrtf(ss * (1.f / 1024.f) + EPS) * mul; }
    __device__ __forceinline__ void operator()(const f32x4 (&acc)[2][2][4][2], const Unit& u, int wr, int wc, int fr, int fq) const {
        PG8_LAS float* P1 = scr; PG8_LAS float* P2 = scr + 1024; float rs8[8];
#define EPS_BAR() do { asm volatile("s_waitcnt lgkmcnt(0)" ::: "memory"); __builtin_amdgcn_s_barrier(); asm volatile("" ::: "memory"); } while (0)
#pragma unroll
        for (int ai = 0; ai < 2; ++ai)
#pragma unroll
            for (int m = 0; m < 4; ++m) { float mx = -3.0e38f;
#pragma unroll
                for (int bj = 0; bj < 2; ++bj)
#pragma unroll
                    for (int n = 0; n < 2; ++n) { const f32x4 v = acc[ai][bj][m][n]; mx = fmaxf(mx, fmaxf(fmaxf(v[0], v[1]), fmaxf(v[2], v[3]))); }
                mx = fmaxf(mx, __shfl_xor(mx, 16)); mx = fmaxf(mx, __shfl_xor(mx, 32));
                if (fq == 0) P1[(ai * HALF + wr * 64 + m * 16 + fr) * 4 + wc] = mx; }
        EPS_BAR();
#pragma unroll
        for (int ai = 0; ai < 2; ++ai)
#pragma unroll
            for (int m = 0; m < 4; ++m) { const int rl = ai * HALF + wr * 64 + m * 16 + fr; const f32x4 q = *(const PG8_LAS f32x4*)(P1 + rl * 4);
                const float mx = fmaxf(fmaxf(q[0], q[1]), fmaxf(q[2], q[3])), rs = rscale(u.pm * BM + rl); float sm = 0.f; rs8[ai * 4 + m] = rs;
#pragma unroll
                for (int bj = 0; bj < 2; ++bj)
#pragma unroll
                    for (int n = 0; n < 2; ++n) { const f32x4 v = acc[ai][bj][m][n];
#pragma unroll
                        for (int i = 0; i < 4; ++i) sm += __builtin_amdgcn_exp2f((v[i] - mx) * rs); }
                sm += __shfl_xor(sm, 16); sm += __shfl_xor(sm, 32);
                if (fq == 0) P2[rl * 4 + wc] = sm; asm volatile("" ::: "memory"); }
        EPS_BAR();
#pragma unroll
        for (int ai = 0; ai < 2; ++ai)
#pragma unroll
            for (int m = 0; m < 4; ++m) { const int rl = ai * HALF + wr * 64 + m * 16 + fr; const f32x4 q = *(const PG8_LAS f32x4*)(P1 + rl * 4), w = *(const PG8_LAS f32x4*)(P2 + rl * 4);
                const float mx = fmaxf(fmaxf(q[0], q[1]), fmaxf(q[2], q[3])), rs = rs8[ai * 4 + m], inv = 1.0f / ((w[0] + w[1]) + (w[2] + w[3]));
#pragma unroll
                for (int bj = 0; bj < 2; ++bj)
#pragma unroll
                    for (int n = 0; n < 2; ++n) { const f32x4 v = acc[ai][bj][m][n]; f32x4 o;
#pragma unroll
                        for (int i = 0; i < 4; ++i) o[i] = __builtin_amdgcn_exp2f((v[i] - mx) * rs) * inv;
                        st_bf4(out + (size_t)(u.pm * BM + rl) * ldc + u.pn * BM + bj * HALF + wc * 32 + n * 16 + fq * 4, o); }
                asm volatile("" ::: "memory"); }
        EPS_BAR();
#undef EPS_BAR
    }
};
struct EpiPlain {
    static constexpr bool PERM = false, AFTER_DRAIN = false;
    bf16_t* out; int ldc;
    __device__ __forceinline__ void operator()(const f32x4 (&acc)[2][2][4][2], const Unit& u, int wr, int wc, int fr, int fq) const {
        const int row0 = u.pm * BM + wr * 64 + fr;
#pragma unroll
        for (int ai = 0; ai < 2; ++ai)
#pragma unroll
            for (int m = 0; m < 4; ++m) { const int row = row0 + ai * HALF + m * 16;
#pragma unroll
                for (int bj = 0; bj < 2; ++bj)
#pragma unroll
                    for (int n = 0; n < 2; ++n) st_bf4(out + (size_t)row * ldc + u.pn * BM + bj * HALF + wc * 32 + n * 16 + fq * 4, acc[ai][bj][m][n]); }
    }
};
template <class Epi, class Sched, bool ALIGN_EPI = false, bool SP2 = false>
__device__ __forceinline__ void gemm_phase(PG8_LAS unsigned char* lds, const Gemm g, const Sched& S, const Epi& E) {
    int tid_ = threadIdx.x; asm volatile("" : "+v"(tid_));
    const int tid = tid_, wid = __builtin_amdgcn_readfirstlane(tid >> 6), lane = tid & 63, wr = wid >> 2, wc = wid & 3, fr = lane & 15, fq = lane >> 4;
    const int K = g.K, nt = K / BK, lda = g.lda ? g.lda : K, ldb = g.ldb ? g.ldb : K;
#define PG8_BOFF(pm_) (g.mb ? (size_t)((pm_) / g.mb) * g.bstride : (size_t)0)
    unsigned voffA[2], voffB[2];
#pragma unroll
    for (int i = 0; i < 2; ++i) { int R, C; stage_rc(tid * 16 + i * 8192, R, C); const int Rb = Epi::PERM ? ((R & ~31) + perm32(R & 31)) : R;
        voffA[i] = (unsigned)(R * lda + C) * 2u; voffB[i] = (unsigned)(Rb * ldb + C) * 2u; }
    const size_t kstep = (size_t)(BK * 2);
    const size_t hstepA = (size_t)HALF * lda * 2, hstepB = (size_t)HALF * ldb * 2;
    const size_t tstepA = 2 * hstepA, tstepB = 2 * hstepB;
    const unsigned ldsw = (unsigned)wid * 1024u;
    const int aoff = lds_byte(wr * 64 + fr, fq * 8), boff = lds_byte(wc * 32 + fr, fq * 8);
#define PG8_SA(b, h) (((b) * 2 + (h)) * HTB)
#define PG8_SB(b, h) ((4 + (b) * 2 + (h)) * HTB)
#define PG8_STAGE(bufoff, gbase, voff) do { _Pragma("unroll") for (int _i = 0; _i < 2; ++_i) \
        __builtin_amdgcn_global_load_lds((const unsigned*)((const char*)(gbase) + (voff)[_i]), (PG8_LAS unsigned*)(lds + (bufoff) + ldsw + _i * 8192), 16, 0, 0); } while (0)
#define PG8_LDA(dst, b, h) do { _Pragma("unroll") for (int m = 0; m < 4; ++m) _Pragma("unroll") for (int k = 0; k < 2; ++k) dst[m][k] = *(const PG8_LAS bf16x8*)(lds + PG8_SA(b, h) + aoff + m * 2048 + k * 1024); } while (0)
#define PG8_LDB(dst, b, h) do { _Pragma("unroll") for (int n = 0; n < 2; ++n) _Pragma("unroll") for (int k = 0; k < 2; ++k) dst[n][k] = *(const PG8_LAS bf16x8*)(lds + PG8_SB(b, h) + boff + n * 2048 + k * 1024); } while (0)
#define PG8_MMA(ai, bj, At, Bt) do { __builtin_amdgcn_s_setprio(1); _Pragma("unroll") for (int m = 0; m < 4; ++m) _Pragma("unroll") for (int n = 0; n < 2; ++n) _Pragma("unroll") for (int k = 0; k < 2; ++k) \
        acc[ai][bj][m][n] = __builtin_amdgcn_mfma_f32_16x16x32_bf16(Bt[n][k], At[m][k], acc[ai][bj][m][n], 0, 0, 0); __builtin_amdgcn_s_setprio(0); } while (0)
#define PG8_WAIT_V(n) asm volatile("s_waitcnt vmcnt(" #n ")" ::: "memory")
#define PG8_WAIT_L(n) asm volatile("s_waitcnt lgkmcnt(" #n ")" ::: "memory")
#define PG8_BAR __builtin_amdgcn_s_barrier()
#define PG8_SCHED __builtin_amdgcn_sched_barrier(0)
    Unit cur, nxt; int ui = 0;
    if (!S.next(0, cur)) return;
    f32x4 acc[2][2][4][2];
#pragma unroll
    for (int a = 0; a < 2; ++a)
#pragma unroll
        for (int b = 0; b < 2; ++b)
#pragma unroll
            for (int m = 0; m < 4; ++m)
#pragma unroll
                for (int n = 0; n < 2; ++n) acc[a][b][m][n] = (f32x4){0.f, 0.f, 0.f, 0.f};
    bf16x8 At[4][2], B0[2][2], B1[2][2];
    const char* cA = (const char*)g.A + (size_t)cur.pm * tstepA; const char* cB = (const char*)g.Bt + (size_t)cur.pn * tstepB + PG8_BOFF(cur.pm);
    S.a_ready(cur);
    if constexpr (SP2) {
        PG8_STAGE(PG8_SB(0, 0), cB, voffB); PG8_STAGE(PG8_SB(0, 1), cB + hstepB, voffB); PG8_STAGE(PG8_SA(0, 0), cA, voffA); PG8_STAGE(PG8_SA(0, 1), cA + hstepA, voffA);
        if (wr == 1) PG8_BAR;
        PG8_WAIT_V(2); PG8_BAR;
        PG8_STAGE(PG8_SB(1, 0), cB + kstep, voffB); PG8_STAGE(PG8_SA(1, 0), cA + kstep, voffA); PG8_STAGE(PG8_SB(1, 1), cB + hstepB + kstep, voffB);
        PG8_WAIT_V(6); PG8_BAR;
    } else {
        PG8_STAGE(PG8_SB(0, 0), cB, voffB); PG8_STAGE(PG8_SA(0, 0), cA, voffA); PG8_STAGE(PG8_SB(0, 1), cB + hstepB, voffB); PG8_STAGE(PG8_SA(0, 1), cA + hstepA, voffA);
        if (wr == 1) PG8_BAR;
        PG8_WAIT_V(4); PG8_BAR;
        PG8_STAGE(PG8_SB(1, 0), cB + kstep, voffB); PG8_STAGE(PG8_SA(1, 0), cA + kstep, voffA); PG8_STAGE(PG8_SB(1, 1), cB + hstepB + kstep, voffB);
        PG8_WAIT_V(6); PG8_BAR;
    }
    for (;;) {
        const bool has_next = S.next(ui + 1, nxt);
        const char* nA = has_next ? (const char*)g.A + (size_t)nxt.pm * tstepA : cA; const char* nB = has_next ? (const char*)g.Bt + (size_t)nxt.pn * tstepB + PG8_BOFF(nxt.pm) : cB;
        for (int t = 0; t < nt; t += 2) {
            const bool last = (t == nt - 2);
            const char* a1 = cA + (size_t)(t + 1) * kstep;
            const char* a2 = last ? nA : cA + (size_t)(t + 2) * kstep; const char* b2 = last ? nB : cB + (size_t)(t + 2) * kstep;
            const char* a3 = a2 + kstep; const char* b3 = b2 + kstep;
            if (last && has_next) S.a_ready(nxt);
            if constexpr (SP2) {
            PG8_LDB(B0, 0, 0); PG8_LDB(B1, 0, 1); PG8_SCHED; PG8_LDA(At, 0, 0); PG8_STAGE(PG8_SA(1, 1), a1 + hstepA, voffA);
            PG8_WAIT_V(8); PG8_WAIT_L(0); PG8_BAR; PG8_MMA(0, 0, At, B0); PG8_MMA(0, 1, At, B1); PG8_BAR; PG8_SCHED;
            PG8_LDA(At, 0, 1); PG8_STAGE(PG8_SB(0, 0), b2, voffB); PG8_STAGE(PG8_SB(0, 1), b2 + hstepB, voffB); PG8_STAGE(PG8_SA(0, 0), a2, voffA);
            PG8_WAIT_V(8); PG8_WAIT_L(0); PG8_BAR; PG8_MMA(1, 0, At, B0); PG8_MMA(1, 1, At, B1); PG8_BAR; PG8_SCHED;
            PG8_LDB(B0, 1, 0); PG8_LDB(B1, 1, 1); PG8_SCHED; PG8_LDA(At, 1, 0); PG8_STAGE(PG8_SA(0, 1), a2 + hstepA, voffA);
            PG8_WAIT_V(8); PG8_WAIT_L(0); PG8_BAR; PG8_MMA(0, 0, At, B0); PG8_MMA(0, 1, At, B1); PG8_BAR; PG8_SCHED;
            PG8_LDA(At, 1, 1); PG8_STAGE(PG8_SB(1, 0), b3, voffB); PG8_STAGE(PG8_SB(1, 1), b3 + hstepB, voffB); PG8_STAGE(PG8_SA(1, 0), a3, voffA);
            PG8_WAIT_V(8); PG8_WAIT_L(0); PG8_BAR; PG8_MMA(1, 0, At, B0); PG8_MMA(1, 1, At, B1); PG8_BAR; PG8_SCHED;
            } else {
            PG8_LDB(B0, 0, 0); PG8_SCHED; PG8_LDA(At, 0, 0); PG8_STAGE(PG8_SA(1, 1), a1 + hstepA, voffA);
            PG8_WAIT_L(8); PG8_BAR; PG8_WAIT_L(0); PG8_MMA(0, 0, At, B0); PG8_BAR; PG8_SCHED;
            PG8_LDB(B1, 0, 1); PG8_STAGE(PG8_SB(0, 0), b2, voffB);
            PG8_BAR; PG8_WAIT_L(0); PG8_MMA(0, 1, At, B1); PG8_BAR;
            PG8_LDA(At, 0, 1); PG8_STAGE(PG8_SA(0, 0), a2, voffA);
            PG8_BAR; PG8_WAIT_L(0); PG8_MMA(1, 0, At, B0); PG8_BAR; PG8_SCHED;
            PG8_STAGE(PG8_SB(0, 1), b2 + hstepB, voffB);
            PG8_WAIT_V(6); PG8_BAR; PG8_MMA(1, 1, At, B1); PG8_BAR;
            PG8_LDB(B0, 1, 0); PG8_SCHED; PG8_LDA(At, 1, 0); PG8_STAGE(PG8_SA(0, 1), a2 + hstepA, voffA);
            PG8_WAIT_L(8); PG8_BAR; PG8_WAIT_L(0); PG8_MMA(0, 0, At, B0); PG8_BAR; PG8_SCHED;
            PG8_LDB(B1, 1, 1); PG8_STAGE(PG8_SB(1, 0), b3, voffB);
            PG8_BAR; PG8_WAIT_L(0); PG8_MMA(0, 1, At, B1); PG8_BAR;
            PG8_LDA(At, 1, 1); PG8_STAGE(PG8_SA(1, 0), a3, voffA);
            PG8_BAR; PG8_WAIT_L(0); PG8_MMA(1, 0, At, B0); PG8_BAR; PG8_SCHED;
            PG8_STAGE(PG8_SB(1, 1), b3 + hstepB, voffB);
            PG8_WAIT_V(6); PG8_BAR; PG8_MMA(1, 1, At, B1); PG8_BAR;
            }
        }
        if constexpr (ALIGN_EPI) { if (wr == 0) PG8_BAR; }
        if constexpr (!Epi::AFTER_DRAIN) { E(acc, cur, wr, wc, fr, fq); S.done(cur); }
        if (!has_next) break;
#pragma unroll
        for (int a = 0; a < 2; ++a)
#pragma unroll
            for (int b = 0; b < 2; ++b)
#pragma unroll
                for (int m = 0; m < 4; ++m)
#pragma unroll
                    for (int n = 0; n < 2; ++n) acc[a][b][m][n] = (f32x4){0.f, 0.f, 0.f, 0.f};
        cur = nxt; cA = nA; cB = nB; ++ui;
        if constexpr (ALIGN_EPI) { if (wr == 1) PG8_BAR; }
    }
    PG8_WAIT_V(0);
    if constexpr (!ALIGN_EPI) { if (wr == 0) PG8_BAR; }
    PG8_BAR;
    if constexpr (Epi::AFTER_DRAIN) { E.fused(acc, cur, wr, wc, fr, fq, lds, wid, lane); S.done(cur); }
#undef PG8_BOFF
#undef PG8_SA
#undef PG8_SB
#undef PG8_STAGE
#undef PG8_LDA
#undef PG8_LDB
#undef PG8_MMA
#undef PG8_WAIT_V
#undef PG8_WAIT_L
#undef PG8_BAR
#undef PG8_SCHED
}
}

#define GAS __attribute__((address_space(1)))
#define LAS __attribute__((address_space(3)))
typedef GAS unsigned gu32;
#define LDS_WAIT() asm volatile("s_waitcnt lgkmcnt(0)" ::: "memory")
#define VM_WAIT() asm volatile("s_waitcnt vmcnt(0)" ::: "memory")
constexpr int NWAVES = 8, NTHR = NWAVES * 64;
constexpr int LDSCTL_OFF = 0, PH_BASE = 512, LDS_BYTES = 147456;
constexpr int CW_BAR = 4096;
constexpr size_t CTL_ZERO_BYTES = 256 * 1024;
constexpr size_t WS_TRIG = 27 * MiB;
#define XB_TMO      128
#define XB_XCNT(j)  (256  + 64 * (j))
#define XB_XSUB(j)  (1280 + 64 * (j))
#define XB_XGEN(j)  (2304 + 64 * (j))
#define XB_TOP      3328
#define XB_TOPGEN   3392
#define XCD_BAR_WORDS 3456
#define XB_SPIN_CAP (1u << 18)

__device__ __forceinline__ unsigned xb_ld(unsigned* p)              { return __hip_atomic_load(p, __ATOMIC_RELAXED, __HIP_MEMORY_SCOPE_AGENT); }
__device__ __forceinline__ unsigned xb_add(unsigned* p, unsigned v) { return __hip_atomic_fetch_add(p, v, __ATOMIC_RELAXED, __HIP_MEMORY_SCOPE_AGENT); }
__device__ __forceinline__ unsigned xb_xcc_id() { return (unsigned)__builtin_amdgcn_s_getreg((3 << 11) | 20) & 0xFu; }
#define XB_SPIN(cond, bar) do { unsigned _sp = 0; while (cond) { __builtin_amdgcn_s_sleep(1); \
    if ((++_sp & 255u) == 0u) { if (xb_ld(&(bar)[XB_TMO])) break; if (_sp > XB_SPIN_CAP) { atomicAdd(&(bar)[XB_TMO], 1u); break; } } } } while (0)

struct XcdBarrier {
    unsigned* bar; unsigned x;
    volatile LAS unsigned* st;
};

__device__ __forceinline__ XcdBarrier xcd_barrier_post(unsigned* bar, volatile LAS unsigned* st) {
    XcdBarrier b; b.bar = bar; b.x = xb_xcc_id(); b.st = st;
    if (threadIdx.x == 0) (void)xb_add(&bar[XB_XCNT(b.x)], 1u);
    return b;
}
__device__ __forceinline__ void xcd_barrier_complete(unsigned* bar, unsigned x, unsigned& nloc, unsigned& nx) {
    const unsigned G = gridDim.x * gridDim.y * gridDim.z;
    unsigned sum, cnt, mine, sp = 0u;
    for (;;) {
        sum = 0u; cnt = 0u; mine = 0u;
#pragma unroll
        for (unsigned j = 0; j < 16; ++j) { const unsigned c = xb_ld(&bar[XB_XCNT(j)]); sum += c; cnt += (c > 0u) ? 1u : 0u; mine = (j == x) ? c : mine; }
        if (sum == G) break;
        __builtin_amdgcn_s_sleep(1);
        if ((++sp & 255u) == 0u) { if (xb_ld(&bar[XB_TMO])) break; if (sp > XB_SPIN_CAP) { atomicAdd(&bar[XB_TMO], 1u); break; } }
    }
    nloc = mine > 0u ? mine : 1u; nx = cnt > 0u ? cnt : 1u;
}

__device__ __forceinline__ void xcd_barrier(const XcdBarrier& b) {
    asm volatile("s_waitcnt vmcnt(0)" ::: "memory");
    __syncthreads();
    if (threadIdx.x == 0) {
        unsigned* bar = b.bar;
        __builtin_amdgcn_s_waitcnt(0);
        unsigned nloc = b.st[0], nx = b.st[1];
        if (nloc == 0u) { xcd_barrier_complete(bar, b.x, nloc, nx); b.st[0] = nloc; b.st[1] = nx; }
        const unsigned old = xb_add(&bar[XB_XSUB(b.x)], 1u);
        const unsigned gen = old / nloc;
        if (old + 1u == (gen + 1u) * nloc) {
            __builtin_amdgcn_fence(__ATOMIC_RELEASE, "agent");
            asm volatile("s_waitcnt vmcnt(0)" ::: "memory");
            const unsigned og = xb_add(&bar[XB_TOP], 1u);
            const unsigned tg = og / nx;
            if (og + 1u == (tg + 1u) * nx) xb_add(&bar[XB_TOPGEN], 1u);
            else XB_SPIN(xb_ld(&bar[XB_TOPGEN]) == tg, bar);
            __builtin_amdgcn_fence(__ATOMIC_ACQUIRE, "agent");
            xb_add(&bar[XB_XGEN(b.x)], 1u);
            asm volatile("s_waitcnt vmcnt(0)" ::: "memory");
        } else {
            XB_SPIN(xb_ld(&bar[XB_XGEN(b.x)]) == gen, bar);
            __builtin_amdgcn_fence(__ATOMIC_ACQUIRE, "agent");
            asm volatile("s_waitcnt vmcnt(0)" ::: "memory");
        }
    }
    __syncthreads();
}

enum { PH_PRO = 0, PH_PROJ, PH_UP, PH_ATTN, PH_MIX, PH_MEMQ, PH_XATTN, PH_MEMO, PH_PQ, PH_TOPK, PH_EXP, PH_N, PHB_CONV = 16, PHB_UPG = 17 };
struct Args { const float* in[24]; float* out; unsigned char* ws; unsigned mask; unsigned li; };

DEVI int src_col(int mode, int r) { return mode == 0 ? r : mode == 1 ? win_src(r) : wkv_src(r); }
template <int MODE, bool HASG> DEVI void p0_transpose_item(const float* W, int K, int N, bf16* WT, int NR, const float* gk, LAS float* scr, int item, int lane) {
    const int nb_ = NR / 32, kb = item / nb_, nb = item % nb_, k0 = 64 * kb, n0 = 32 * nb;
    const int sc = src_col(MODE, n0 + (lane & 31)), scc = sc < 0 ? 0 : sc; const float keep = sc < 0 ? 0.f : 1.f;
    float v[32];
#pragma unroll
    for (int i = 0; i < 32; ++i) { const int kk = 2 * i + (lane >> 5); v[i] = W[(size_t)(k0 + kk) * N + scc]; }
    if (HASG) {
#pragma unroll
        for (int i = 0; i < 32; ++i) { const int kk = 2 * i + (lane >> 5); v[i] *= gk[k0 + kk]; } }
#pragma unroll
    for (int i = 0; i < 32; ++i) { const int kk = 2 * i + (lane >> 5); scr[kk * 33 + (lane & 31)] = MODE == 0 ? v[i] : v[i] * keep; }
    LDS_WAIT(); asm volatile("" ::: "memory");
    const int c = lane & 7;
#pragma unroll
    for (int j = 0; j < 4; ++j) { const int n = (lane >> 3) + 8 * j; const LAS float* s = scr + (8 * c) * 33 + n;
        uint4 o; o.x = pg8::cvt_pk_bf16(s[0 * 33], s[1 * 33]); o.y = pg8::cvt_pk_bf16(s[2 * 33], s[3 * 33]); o.z = pg8::cvt_pk_bf16(s[4 * 33], s[5 * 33]); o.w = pg8::cvt_pk_bf16(s[6 * 33], s[7 * 33]);
        *(uint4*)(WT + (size_t)(n0 + n) * K + k0 + 8 * c) = o; }
    LDS_WAIT(); asm volatile("" ::: "memory");
}
DEVI void rms_row_to_bf16(const float* xrow, const float* g, bf16* orow, int lane) {
    const float4* xr = (const float4*)xrow + lane; const float4* gr = (const float4*)g + lane;
    float4 v[4]; float s = 0.f;
#pragma unroll
    for (int j = 0; j < 4; ++j) { v[j] = xr[64 * j]; s += (v[j].x * v[j].x + v[j].y * v[j].y) + (v[j].z * v[j].z + v[j].w * v[j].w); }
    const float r = rsqrtf(wave_sum(s) * (1.f / D) + EPS);
    uint2* o8 = (uint2*)orow + lane;
#pragma unroll
    for (int j = 0; j < 4; ++j) { const float4 gg = gr[64 * j]; uint2 o; o.x = pg8::cvt_pk_bf16(v[j].x * r * gg.x, v[j].y * r * gg.y); o.y = pg8::cvt_pk_bf16(v[j].z * r * gg.z, v[j].w * r * gg.w); o8[64 * j] = o; }
}
DEVI void rms_rows4_to_bf16(const float* x, const float* g, bf16* out, int m0, int step, int mend, int lane) {
    float4 v[4][4]; float s[4]; float4 gq[4];
#pragma unroll
    for (int j = 0; j < 4; ++j) gq[j] = ((const float4*)g + lane)[64 * j];
#pragma unroll
    for (int r = 0; r < 4; ++r) { const int m = m0 + r * step; const float4* xr = (const float4*)(x + (size_t)(m < mend ? m : m0) * D) + lane;
#pragma unroll
        for (int j = 0; j < 4; ++j) v[r][j] = xr[64 * j]; }
#pragma unroll
    for (int r = 0; r < 4; ++r) { float t = 0.f;
#pragma unroll
        for (int j = 0; j < 4; ++j) t += (v[r][j].x * v[r][j].x + v[r][j].y * v[r][j].y) + (v[r][j].z * v[r][j].z + v[r][j].w * v[r][j].w);
        s[r] = t; }
#pragma unroll
    for (int o = 1; o < 64; o <<= 1) {
#pragma unroll
        for (int r = 0; r < 4; ++r) s[r] += __shfl_xor(s[r], o); }
#pragma unroll
    for (int r = 0; r < 4; ++r) { const int m = m0 + r * step; if (m < mend) { const float rs = rsqrtf(s[r] * (1.f / D) + EPS); uint2* o8 = (uint2*)(out + (size_t)m * D) + lane;
#pragma unroll
        for (int j = 0; j < 4; ++j) { const float4 gg = gq[j]; uint2 o; o.x = pg8::cvt_pk_bf16(v[r][j].x * rs * gg.x, v[r][j].y * rs * gg.y); o.y = pg8::cvt_pk_bf16(v[r][j].z * rs * gg.z, v[r][j].w * rs * gg.w); o8[64 * j] = o; } } }
}
DEVI void cvt_stream_fp8(const float* src, unsigned char* dst, size_t n16, const float* g, float mul, size_t gtid, size_t gn) {
    for (size_t i = gtid; i < n16; i += gn) { pg8::u32x4 o;
#pragma unroll
        for (int q = 0; q < 4; ++q) { float4 a = *(const float4*)(src + i * 16 + q * 4); if (g) { const float4 gg = *(const float4*)(g + ((i * 16 + q * 4) & (D - 1))); a.x *= gg.x; a.y *= gg.y; a.z *= gg.z; a.w *= gg.w; }
            int p = __builtin_amdgcn_cvt_pk_fp8_f32(a.x * mul, a.y * mul, 0, false); p = __builtin_amdgcn_cvt_pk_fp8_f32(a.z * mul, a.w * mul, p, true); o[q] = (unsigned)p; }
        *(pg8::u32x4*)(dst + i * 16) = o; }
}
typedef unsigned v6u_t __attribute__((ext_vector_type(6)));
typedef float f32x2_t __attribute__((ext_vector_type(2)));
typedef float v16f_t __attribute__((ext_vector_type(16)));
typedef float v32f_t __attribute__((ext_vector_type(32)));
typedef __bf16 v32bf_t __attribute__((ext_vector_type(32)));
#ifndef FP6_INTERLEAVED
#define FP6_INTERLEAVED 0
#endif
template <bool HASG> DEVI void cvt_rows_fp6(const float* src, unsigned char* dst, const float* g, float mul, size_t gtid, size_t gn) {
    const int grp = (int)(gtid & 31);
    float4 gg[8];
#pragma unroll
    for (int q = 0; q < 8; ++q) { gg[q] = HASG ? *(const float4*)(g + grp * 32 + q * 4) : make_float4(1.f, 1.f, 1.f, 1.f); gg[q].x *= mul; gg[q].y *= mul; gg[q].z *= mul; gg[q].w *= mul; }
    for (size_t i0 = gtid; i0 < (size_t)PE * 32; i0 += 2 * gn) {
        float4 v[2][8];
#pragma unroll
        for (int u = 0; u < 2; ++u) { const size_t i = i0 + u * gn; if (i < (size_t)PE * 32) { const float* sp = src + (i >> 5) * D + (i & 31) * 32;
#pragma unroll
            for (int q = 0; q < 8; ++q) v[u][q] = *(const float4*)(sp + q * 4); } }
#pragma unroll
        for (int u = 0; u < 2; ++u) { const size_t i = i0 + u * gn; if (i < (size_t)PE * 32) { const size_t row = i >> 5;
            v16f_t a, b;
#pragma unroll
            for (int q = 0; q < 8; ++q) { const float4 x = v[u][q]; a[2 * q] = x.x * gg[q].x; b[2 * q] = x.y * gg[q].y; a[2 * q + 1] = x.z * gg[q].z; b[2 * q + 1] = x.w * gg[q].w; }
            const v6u_t p = __builtin_amdgcn_cvt_scalef32_2xpk16_fp6_f32(a, b, 1.0f);
            *(pg8::u32x4*)(dst + row * 768 + grp * 16) = (pg8::u32x4){p[0], p[1], p[2], p[3]};
            *(pg8::u32x2*)(dst + row * 768 + 512 + grp * 8) = (pg8::u32x2){p[4], p[5]}; } }
    }
}
DEVI void cvt_stream(const float* src, bf16* dst, size_t n8, const float* g, size_t gtid, size_t gn) {
    for (size_t i = gtid; i < n8; i += gn) { const float4 a = *(const float4*)(src + i * 8), b = *(const float4*)(src + i * 8 + 4);
        float4 ga = make_float4(1.f, 1.f, 1.f, 1.f), gb = ga; if (g) { ga = *(const float4*)(g + ((i * 8) & (D - 1))); gb = *(const float4*)(g + ((i * 8) & (D - 1)) + 4); }
        uint4 o; o.x = pg8::cvt_pk_bf16(a.x * ga.x, a.y * ga.y); o.y = pg8::cvt_pk_bf16(a.z * ga.z, a.w * ga.w); o.z = pg8::cvt_pk_bf16(b.x * gb.x, b.y * gb.y); o.w = pg8::cvt_pk_bf16(b.z * gb.z, b.w * gb.w);
        *(uint4*)(dst + i * 8) = o; }
}


DEVI void conv_token(int row, const bf16* U, const float* cw, const float* cb, const float* lg, const float* lb, bf16* CONCAT, int lane) {
    const int pos = row % SEQ; float y[8];
    { const float4 b0 = *(const float4*)(cb + lane * 8), b1 = *(const float4*)(cb + lane * 8 + 4); y[0] = b0.x; y[1] = b0.y; y[2] = b0.z; y[3] = b0.w; y[4] = b1.x; y[5] = b1.y; y[6] = b1.z; y[7] = b1.w; }
    const int k0 = pos >= CK - 1 ? 0 : CK - 1 - pos;
    for (int k = k0; k < CK; ++k) {
        const uint4 u = *(const uint4*)(U + (size_t)(row - (CK - 1) + k) * CW + lane * 8);
        const float4 w0 = *(const float4*)(cw + k * CW + lane * 8), w1 = *(const float4*)(cw + k * CW + lane * 8 + 4);
        y[0] += w0.x * __builtin_bit_cast(float, u.x << 16); y[1] += w0.y * __builtin_bit_cast(float, u.x & 0xffff0000u);
        y[2] += w0.z * __builtin_bit_cast(float, u.y << 16); y[3] += w0.w * __builtin_bit_cast(float, u.y & 0xffff0000u);
        y[4] += w1.x * __builtin_bit_cast(float, u.z << 16); y[5] += w1.y * __builtin_bit_cast(float, u.z & 0xffff0000u);
        y[6] += w1.z * __builtin_bit_cast(float, u.w << 16); y[7] += w1.w * __builtin_bit_cast(float, u.w & 0xffff0000u);
    }
    float s = 0.f;
#pragma unroll
    for (int e = 0; e < 8; ++e) s += y[e];
    const float mu = wave_sum(s) * (1.f / CW); float q = 0.f;
#pragma unroll
    for (int e = 0; e < 8; ++e) { y[e] -= mu; q += y[e] * y[e]; }
    const float rstd = rsqrtf(wave_sum(q) * (1.f / CW) + EPS);
    const float4 g0 = *(const float4*)(lg + lane * 8), g1 = *(const float4*)(lg + lane * 8 + 4), c0 = *(const float4*)(lb + lane * 8), c1 = *(const float4*)(lb + lane * 8 + 4);
    const float gg[8] = {g0.x, g0.y, g0.z, g0.w, g1.x, g1.y, g1.z, g1.w}, bb[8] = {c0.x, c0.y, c0.z, c0.w, c1.x, c1.y, c1.z, c1.w};
    float z[8];
#pragma unroll
    for (int e = 0; e < 8; ++e) { const float t = y[e] * rstd * gg[e] + bb[e]; z[e] = t * __builtin_amdgcn_rcpf(1.f + __expf(-t)); }
    uint4 o; o.x = pg8::cvt_pk_bf16(z[0], z[1]); o.y = pg8::cvt_pk_bf16(z[2], z[3]); o.z = pg8::cvt_pk_bf16(z[4], z[5]); o.w = pg8::cvt_pk_bf16(z[6], z[7]);
    *(uint4*)(CONCAT + (size_t)row * D + CW + lane * 8) = o;
}

DEVI void conv_chunk(int c, const bf16* U, const float* cw, const float* cb, const float* lg, const float* lb, bf16* CONCAT, LAS unsigned char* lds) {
    const int ch = threadIdx.x, lane = ch & 63, wv = __builtin_amdgcn_readfirstlane(ch >> 6);
    const int t0 = c * 64, pos0 = t0 % SEQ;
    float w[CK];
#pragma unroll
    for (int k = 0; k < CK; ++k) w[k] = cw[k * CW + ch];
    const float bias = cb[ch];
    float u[64 + CK - 1];
#pragma unroll
    for (int r = 0; r < 64 + CK - 1; ++r) { const int row = t0 - (CK - 1) + r;
        const unsigned raw = *(const unsigned short*)(U + (size_t)(row < 0 ? 0 : row) * CW + ch); u[r] = __builtin_bit_cast(float, raw << 16); }
#pragma unroll
    for (int r = 0; r < CK - 1; ++r) { const float keep = (pos0 - (CK - 1) + r >= 0) ? 1.f : 0.f; u[r] *= keep; }
    LAS float* yl = (LAS float*)lds;
#pragma unroll
    for (int j = 0; j < 64; ++j) { float y = bias;
#pragma unroll
        for (int k = 0; k < CK; ++k) y += w[k] * u[j + k];
        yl[j * CW + ch] = y; }
    __syncthreads();
#pragma unroll 1
    for (int i = 0; i < 8; ++i) { const int j = wv * 8 + i, row = t0 + j;
        const pg8::f32x4 a0 = *(const LAS pg8::f32x4*)(yl + j * CW + lane * 8), a1 = *(const LAS pg8::f32x4*)(yl + j * CW + lane * 8 + 4);
        float y[8] = {a0[0], a0[1], a0[2], a0[3], a1[0], a1[1], a1[2], a1[3]}; float sm = 0.f;
#pragma unroll
        for (int e = 0; e < 8; ++e) sm += y[e];
        const float mu = wave_sum(sm) * (1.f / CW); float q = 0.f;
#pragma unroll
        for (int e = 0; e < 8; ++e) { y[e] -= mu; q += y[e] * y[e]; }
        const float rstd = rsqrtf(wave_sum(q) * (1.f / CW) + EPS);
        const float4 g0 = *(const float4*)(lg + lane * 8), g1 = *(const float4*)(lg + lane * 8 + 4), c0 = *(const float4*)(lb + lane * 8), c1 = *(const float4*)(lb + lane * 8 + 4);
        const float gg[8] = {g0.x, g0.y, g0.z, g0.w, g1.x, g1.y, g1.z, g1.w}, bb[8] = {c0.x, c0.y, c0.z, c0.w, c1.x, c1.y, c1.z, c1.w};
        float z[8];
#pragma unroll
        for (int e = 0; e < 8; ++e) { const float t = y[e] * rstd * gg[e] + bb[e]; z[e] = t * __builtin_amdgcn_rcpf(1.f + __expf(-t)); }
        uint4 o; o.x = pg8::cvt_pk_bf16(z[0], z[1]); o.y = pg8::cvt_pk_bf16(z[2], z[3]); o.z = pg8::cvt_pk_bf16(z[4], z[5]); o.w = pg8::cvt_pk_bf16(z[6], z[7]);
        *(uint4*)(CONCAT + (size_t)row * D + CW + lane * 8) = o; }
    __syncthreads();
}

typedef short bf16x8_t __attribute__((ext_vector_type(8)));
typedef float f32x16_t __attribute__((ext_vector_type(16)));
typedef __bf16 bf16x2_t __attribute__((ext_vector_type(2)));
DEVI unsigned umax_(unsigned a, unsigned b) { return a > b ? a : b; }
DEVI unsigned umin_(unsigned a, unsigned b) { return a < b ? a : b; }
DEVI unsigned kmax_(unsigned a, unsigned b) { unsigned r; asm("v_max_f32 %0, %1, %2" : "=v"(r) : "v"(a), "v"(b)); return r; }
DEVI unsigned kmin_(unsigned a, unsigned b) { unsigned r; asm("v_min_f32 %0, %1, %2" : "=v"(r) : "v"(a), "v"(b)); return r; }
DEVI void ce_desc(unsigned& a, unsigned& b) { const unsigned mx = kmax_(a, b), mn = kmin_(a, b); a = mx; b = mn; }
DEVI void sort16_desc(unsigned (&v)[16]) {
    ce_desc(v[0], v[13]); ce_desc(v[1], v[12]); ce_desc(v[2], v[15]); ce_desc(v[3], v[14]); ce_desc(v[4], v[8]); ce_desc(v[5], v[6]); ce_desc(v[7], v[11]); ce_desc(v[9], v[10]);
    ce_desc(v[0], v[5]); ce_desc(v[1], v[7]); ce_desc(v[2], v[9]); ce_desc(v[3], v[4]); ce_desc(v[6], v[13]); ce_desc(v[8], v[14]); ce_desc(v[10], v[15]); ce_desc(v[11], v[12]);
    ce_desc(v[0], v[1]); ce_desc(v[2], v[3]); ce_desc(v[4], v[5]); ce_desc(v[6], v[8]); ce_desc(v[7], v[9]); ce_desc(v[10], v[11]); ce_desc(v[12], v[13]); ce_desc(v[14], v[15]);
    ce_desc(v[0], v[2]); ce_desc(v[1], v[3]); ce_desc(v[4], v[10]); ce_desc(v[5], v[11]); ce_desc(v[6], v[7]); ce_desc(v[8], v[9]); ce_desc(v[12], v[14]); ce_desc(v[13], v[15]);
    ce_desc(v[1], v[2]); ce_desc(v[3], v[12]); ce_desc(v[4], v[6]); ce_desc(v[5], v[7]); ce_desc(v[8], v[10]); ce_desc(v[9], v[11]); ce_desc(v[13], v[14]);
    ce_desc(v[1], v[4]); ce_desc(v[2], v[6]); ce_desc(v[5], v[8]); ce_desc(v[7], v[10]); ce_desc(v[9], v[13]); ce_desc(v[11], v[14]);
    ce_desc(v[2], v[4]); ce_desc(v[3], v[6]); ce_desc(v[9], v[12]); ce_desc(v[11], v[13]);
    ce_desc(v[3], v[5]); ce_desc(v[6], v[8]); ce_desc(v[7], v[9]); ce_desc(v[10], v[12]);
    ce_desc(v[3], v[4]); ce_desc(v[5], v[6]); ce_desc(v[7], v[8]); ce_desc(v[9], v[10]); ce_desc(v[11], v[12]);
    ce_desc(v[6], v[7]); ce_desc(v[8], v[9]);
}
DEVI void merge16_desc(unsigned (&v)[16]) {
#pragma unroll
    for (int j = 8; j > 0; j >>= 1)
#pragma unroll
        for (int i = 0; i < 16; ++i) { const int l = i ^ j; if (l > i) ce_desc(v[i], v[l]); }
}
DEVI void top16_merge(unsigned (&a)[16], const unsigned (&b)[16]) {
#pragma unroll
    for (int i = 0; i < 16; ++i) a[i] = kmax_(a[i], b[15 - i]);
    merge16_desc(a);
}
DEVI int crow16(int r, int hi) { return (r & 3) + 8 * (r >> 2) + 4 * hi; }

DEVI void subkey_top16(unsigned (&best)[16], const bf16* qrow  , const LAS unsigned char* kl  , int hi) {
    bf16x8_t qf[8];
#pragma unroll
    for (int ks = 0; ks < 8; ++ks) qf[ks] = *(const bf16x8_t*)(qrow + 16 * ks);
    unsigned grp[16];
#pragma unroll
    for (int nt = 0; nt < 4; ++nt) {
        f32x16_t acc = {};
#pragma unroll
        for (int ks = 0; ks < 8; ++ks) { const bf16x8_t kf = *(const LAS bf16x8_t*)(kl + ks * 4096 + nt * 512); acc = __builtin_amdgcn_mfma_f32_32x32x16_bf16(kf, qf[ks], acc, 0, 0, 0); }
#pragma unroll
        for (int r = 0; r < 16; ++r) { const float av = acc[r]; grp[r] = (__builtin_bit_cast(unsigned, av) & 0xffffff80u) | (unsigned)(127 - (32 * nt + crow16(r, hi))); }
        sort16_desc(grp);
        if (nt == 0) {
#pragma unroll
            for (int r = 0; r < 16; ++r) best[r] = grp[r];
        } else top16_merge(best, grp);
    }
    unsigned oth[16];
#pragma unroll
    for (int r = 0; r < 16; ++r) oth[r] = (unsigned)__shfl_xor((int)best[r], 32);
    top16_merge(best, oth);
}
DEVI void topk_wave(const bf16* qbase, const LAS unsigned char* keys, LAS unsigned* scr  , int* eidx, float* egate, int lane) {
    const int r32 = lane & 31, hi = lane >> 5;
    unsigned b0[16], b1[16];
    subkey_top16(b0, qbase + 8 * hi, keys + hi * 2048 + r32 * 16, hi);
    subkey_top16(b1, qbase + 128 + 8 * hi, keys + 32768 + hi * 2048 + r32 * 16, hi);
    float s0[16], s1[16];
#pragma unroll
    for (int i = 0; i < 16; ++i) { s0[i] = __builtin_bit_cast(float, b0[i] & 0xffffff80u); s1[i] = __builtin_bit_cast(float, b1[i] & 0xffffff80u); }
#pragma unroll
    for (int w = 0; w < 4; ++w) {
        scr[lane * 9 + w] = (127u - (b0[4 * w] & 127u)) | ((127u - (b0[4 * w + 1] & 127u)) << 8) | ((127u - (b0[4 * w + 2] & 127u)) << 16) | ((127u - (b0[4 * w + 3] & 127u)) << 24);
        scr[lane * 9 + 4 + w] = (127u - (b1[4 * w] & 127u)) | ((127u - (b1[4 * w + 1] & 127u)) << 8) | ((127u - (b1[4 * w + 2] & 127u)) << 16) | ((127u - (b1[4 * w + 3] & 127u)) << 24);
    }
    unsigned ca[16], cb2[16];
#define CAND(i, j) ((__builtin_bit_cast(unsigned, s0[i] + s1[j]) & 0xffffff00u) | (unsigned)(255 - ((i) * 16 + (j))))
    const unsigned lowest = 0xff800000u;
    if (hi == 0) {
#pragma unroll
        for (int j = 0; j < 16; ++j) ca[j] = CAND(0, j);
#pragma unroll
        for (int j = 0; j < 8; ++j) cb2[j] = CAND(1, j);
#pragma unroll
        for (int j = 8; j < 16; ++j) cb2[j] = lowest;
    } else {
        ca[0] = CAND(2, 0); ca[1] = CAND(2, 1); ca[2] = CAND(2, 2); ca[3] = CAND(2, 3); ca[4] = CAND(2, 4); ca[5] = CAND(3, 0); ca[6] = CAND(3, 1); ca[7] = CAND(3, 2); ca[8] = CAND(3, 3);
        ca[9] = CAND(4, 0); ca[10] = CAND(4, 1); ca[11] = CAND(4, 2); ca[12] = CAND(5, 0); ca[13] = CAND(5, 1); ca[14] = CAND(6, 0); ca[15] = CAND(6, 1);
        cb2[0] = CAND(7, 0); cb2[1] = CAND(7, 1); cb2[2] = CAND(8, 0); cb2[3] = CAND(9, 0); cb2[4] = CAND(10, 0); cb2[5] = CAND(11, 0); cb2[6] = CAND(12, 0); cb2[7] = CAND(13, 0); cb2[8] = CAND(14, 0); cb2[9] = CAND(15, 0);
#pragma unroll
        for (int j = 10; j < 16; ++j) cb2[j] = lowest;
    }
#undef CAND
    sort16_desc(ca); sort16_desc(cb2); top16_merge(ca, cb2);
    unsigned oth[16];
#pragma unroll
    for (int r = 0; r < 16; ++r) oth[r] = (unsigned)__shfl_xor((int)ca[r], 32);
    top16_merge(ca, oth);
    const float mx = __builtin_bit_cast(float, ca[0] & 0xffffff00u); float ex[16]; float l = 0.f;
#pragma unroll
    for (int k = 0; k < 16; ++k) { ex[k] = __expf(__builtin_bit_cast(float, ca[k] & 0xffffff00u) - mx); l += ex[k]; }
    const float rl = 1.f / l;
    LDS_WAIT(); asm volatile("" ::: "memory");
    int ei[8]; float eg[8];
    const unsigned mhi = (unsigned)(-hi);
#pragma unroll
    for (int k = 0; k < 8; ++k) { const unsigned key = ca[k] ^ ((ca[k] ^ ca[8 + k]) & mhi); const unsigned ij = 255u - (key & 255u), i = ij >> 4, j = ij & 15u;
        const unsigned w0 = scr[lane * 9 + (i >> 2)], w1 = scr[lane * 9 + 4 + (j >> 2)];
        ei[k] = (int)(((w0 >> (8 * (i & 3))) & 255u) * PNK + ((w1 >> (8 * (j & 3))) & 255u)); eg[k] = __builtin_bit_cast(float, __builtin_bit_cast(unsigned, ex[k]) ^ ((__builtin_bit_cast(unsigned, ex[k]) ^ __builtin_bit_cast(unsigned, ex[8 + k])) & mhi)) * rl; }
    *(int4*)(eidx + hi * 8) = make_int4(ei[0], ei[1], ei[2], ei[3]); *(int4*)(eidx + hi * 8 + 4) = make_int4(ei[4], ei[5], ei[6], ei[7]);
    *(float4*)(egate + hi * 8) = make_float4(eg[0], eg[1], eg[2], eg[3]); *(float4*)(egate + hi * 8 + 4) = make_float4(eg[4], eg[5], eg[6], eg[7]);
    LDS_WAIT(); asm volatile("" ::: "memory");
}

typedef unsigned char fp8_t;
template <int VAR = 0> DEVI float dot16_fp8(pg8::u32x4 row, pg8::u32x4 ha, pg8::u32x4 hb, float acc) {
    if (VAR == 1) return __builtin_bit_cast(float, (row[0] ^ row[1]) ^ (row[2] ^ row[3]));
#pragma unroll
    for (int i = 0; i < 4; ++i) { const unsigned hlo = i < 2 ? ha[2 * i] : hb[2 * i - 4], hhi = i < 2 ? ha[2 * i + 1] : hb[2 * i - 3];
        acc = __builtin_amdgcn_fdot2_f32_bf16(__builtin_amdgcn_cvt_scalef32_pk_bf16_fp8(row[i], 1.0f, false), __builtin_bit_cast(bf16x2_t, hlo), acc, false);
        acc = __builtin_amdgcn_fdot2_f32_bf16(__builtin_amdgcn_cvt_scalef32_pk_bf16_fp8(row[i], 1.0f, true), __builtin_bit_cast(bf16x2_t, hhi), acc, false); }
    return acc;
}
template <int VAR = 0> DEVI void fma16_fp8(float (&acc)[16], float w, pg8::u32x4 row) {
    if (VAR == 1) { acc[0] += __builtin_bit_cast(float, row[0] ^ row[1]); acc[1] += __builtin_bit_cast(float, row[2] ^ row[3]); return; }
#pragma unroll
    for (int i = 0; i < 4; ++i) { const pg8::f32x2 lo = __builtin_amdgcn_cvt_pk_f32_fp8(row[i], false), hh = __builtin_amdgcn_cvt_pk_f32_fp8(row[i], true);
        acc[4 * i] += w * lo[0]; acc[4 * i + 1] += w * lo[1]; acc[4 * i + 2] += w * hh[0]; acc[4 * i + 3] += w * hh[1]; }
}
DEVI void sort128_asc(unsigned& a, unsigned& b, int lane) {
#pragma unroll
    for (int k = 2; k <= 128; k <<= 1)
#pragma unroll
        for (int j = k >> 1; j > 0; j >>= 1) {
            if (j == 64) { const unsigned lo = umin_(a, b), hi = umax_(a, b); a = lo; b = hi; }
            else {
                const bool upper = (lane & j) != 0;
                const bool asc_a = k == 128 ? true : ((lane & k) == 0), asc_b = k == 128 ? true : (k == 64 ? false : ((lane & k) == 0));
                const unsigned pa_ = (unsigned)__shfl_xor((int)a, j), pb_ = (unsigned)__shfl_xor((int)b, j);
                a = (upper != asc_a) ? umin_(a, pa_) : umax_(a, pa_);
                b = (upper != asc_b) ? umin_(b, pb_) : umax_(b, pb_);
            }
        }
}
constexpr int EXD = 8, EXP_LDS_WAVE = 12800;
struct Row6 { pg8::u32x4 a; pg8::u32x2 b; };
template <int VAR> DEVI void experts_wave(LAS unsigned char* wl_, int t0, int tstep, const bf16* H2B, const float* part2, const unsigned char* PU, const unsigned char* PV, const int* EIDX, const float* EGATE, const float* fg, float* out, int lane) {
    if (t0 >= M) return;
    const int ntok = (M - t0 + tstep - 1) / tstep < 8 ? (M - t0 + tstep - 1) / tstep : 8;
    LAS int* sid = (LAS int*)wl_; LAS float* gsl = (LAS float*)(wl_ + 4096); LAS float* wl = (LAS float*)(wl_ + 8192); LAS float* r2l = (LAS float*)(wl_ + 12288);
    const unsigned g32 = (unsigned)lane & 31u, hsel = (unsigned)lane >> 5, l4 = (unsigned)lane * 4u;
#define LDI(p) (*(const int*)((const char*)(p) + l4))
#define LDF(p) (*(const float*)((const char*)(p) + l4))
#define LDROW(dst, tab, ridx) do { const unsigned char* rp_ = (tab) + (size_t)(unsigned)(ridx) * 768u; (dst).a = *(const pg8::u32x4*)(rp_ + g32 * 16u); (dst).b = *(const pg8::u32x2*)(rp_ + 512u + g32 * 8u); } while (0)
    for (int k = 0; k < ntok; ++k) { const int t = t0 + k * tstep;
        unsigned k0 = ((unsigned)LDI(EIDX + (size_t)t * 128) << 7) | (unsigned)lane, k1 = ((unsigned)LDI(EIDX + (size_t)t * 128 + 64) << 7) | (unsigned)(64 + lane);
        const float ga = LDF(EGATE + (size_t)t * 128), gb = LDF(EGATE + (size_t)t * 128 + 64);
        sort128_asc(k0, k1, lane);
        const unsigned sl0 = k0 & 127u, sl1 = k1 & 127u;
        const float x0 = __shfl(ga, (int)(sl0 & 63u)), y0 = __shfl(gb, (int)(sl0 & 63u)), x1 = __shfl(ga, (int)(sl1 & 63u)), y1 = __shfl(gb, (int)(sl1 & 63u));
        sid[k * 128 + lane] = (int)(k0 >> 7); sid[k * 128 + 64 + lane] = (int)(k1 >> 7);
        gsl[k * 128 + lane] = sl0 < 64u ? x0 : y0; gsl[k * 128 + 64 + lane] = sl1 < 64u ? x1 : y1;
        const float r2 = rsqrtf(wave_sum(lane < 16 ? LDF(part2 + (size_t)t * 16) : 0.f) * (1.f / D) + EPS) * (1.0f / PU_SCALE);
        if (lane == 0) r2l[k] = r2; }
    LDS_WAIT(); asm volatile("" ::: "memory");
    const int nsteps = 8 * ntok;
#define STEP_DESC(q, tab, pos0) do { const int q_ = (q); if (q_ < nsteps) { (tab) = PU; if (ntok == 8) (pos0) = ((q_ >> 4) * 2 + (q_ & 1)) * 128 + 16 * ((q_ >> 1) & 7); else { const int b_ = q_ / ntok; (pos0) = (q_ - b_ * ntok) * 128 + 16 * b_; } } \
        else if (q_ < 2 * nsteps) { const int qq_ = q_ - nsteps; (tab) = PV; (pos0) = (qq_ >> 3) * 128 + 16 * (qq_ & 7); } else { (tab) = PV; (pos0) = 0; } } while (0)
    constexpr int LOOK = 1;
    Row6 buf[8 * LOOK];
#pragma unroll
    for (int i = 0; i < 8; ++i) { const int ri = sid[2 * i + (int)hsel]; LDROW(buf[i], PU, ri); }
    if (LOOK == 2) { const unsigned char* tb_; int p0_; STEP_DESC(1, tb_, p0_);
#pragma unroll
      for (int i = 0; i < 8; ++i) { const int ri = sid[p0_ + 2 * i + (int)hsel]; LDROW(buf[(8 + i) % (8 * LOOK)], tb_, ri); } }
#define TR_STEP(S) _Pragma("unroll") for (int i = 0; i < S; ++i) { const bool up_ = (lane & S) != 0; const float send = up_ ? r[i] : r[i + S], keep = up_ ? r[i + S] : r[i]; r[i] = keep + __shfl_xor(send, S); }
#define U_STEP(q, SB, B_, K_, HV) do { const int q__ = (q); const int ub_ = (B_), uk_ = (K_); \
        const unsigned char* ntab; int npos; STEP_DESC(q__ + LOOK, ntab, npos); npos += (int)hsel; \
        float r[8]; \
        _Pragma("unroll") for (int i2 = 0; i2 < 8; ++i2) { \
            const v6u_t p = {buf[SB + i2].a[0], buf[SB + i2].a[1], buf[SB + i2].a[2], buf[SB + i2].a[3], buf[SB + i2].b[0], buf[SB + i2].b[1]}; \
            float d = 0.f; \
            if (VAR == 1) d = __builtin_bit_cast(float, p[0] ^ p[1] ^ p[2] ^ p[3] ^ p[4] ^ p[5]); \
            else { const v32f_t rv = __builtin_amdgcn_cvt_scalef32_pk32_f32_fp6(p, 1.0f); \
                f32x2_t d2 = {0.f, 0.f}; _Pragma("unroll") for (int j = 0; j < 32; j += 2) { const unsigned hw_ = HV[j >> 3][(j >> 1) & 3]; const f32x2_t r2_ = {rv[j], rv[j + 1]}, h2_ = {__builtin_bit_cast(float, hw_ << 16), __builtin_bit_cast(float, hw_ & 0xffff0000u)}; d2 = __builtin_elementwise_fma(r2_, h2_, d2); } d = d2[0] + d2[1]; } \
            r[i2] = d; \
            const int ri = sid[npos + 2 * i2]; LDROW(buf[SB + i2], ntab, ri); \
            __builtin_amdgcn_sched_barrier(0); } \
        TR_STEP(4) TR_STEP(2) TR_STEP(1) \
        float tot = r[0] + __shfl_xor(r[0], 8); tot += __shfl_xor(tot, 16); \
        const int pos = uk_ * 128 + 16 * ub_ + 2 * (lane & 7) + (int)hsel; \
        const float a = tot * r2l[uk_]; \
        wl[pos] = 0.5f * a * (1.f + erff(a * 0.70710678118654752f)) * gsl[pos] * (1.0f / PV_SCALE); } while (0)
#define LOAD_HV(dst, k_) do { const int t_ = t0 + (k_) * tstep; _Pragma("unroll") for (int qd = 0; qd < 4; ++qd) (dst)[qd] = VAR == 2 ? (pg8::u32x4){0x3f803f80u, 0x3f803f80u, 0x3f803f80u, 0x3f803f80u} : *(const pg8::u32x4*)((const char*)(H2B + (size_t)t_ * D) + g32 * 64u + qd * 16u); } while (0)
    if (ntok == 8) {
#pragma unroll 1
        for (int grp = 0; grp < 4; ++grp) {
            pg8::u32x4 hv0[4], hv1[4];
            LOAD_HV(hv0, 2 * grp); LOAD_HV(hv1, 2 * grp + 1);
#pragma unroll 1
            for (int b = 0; b < 8; ++b) { const int q = grp * 16 + b * 2;
                U_STEP(q, 0, b, 2 * grp, hv0); U_STEP(q + 1, 8 * (LOOK - 1), b, 2 * grp + 1, hv1); }
        }
    } else {
#pragma unroll 1
        for (int q = 0; q < nsteps; q += 2) { pg8::u32x4 hva[4], hvb[4]; const int b0_ = q / ntok, k0_ = q - b0_ * ntok, b1_ = (q + 1) / ntok, k1_ = (q + 1) - b1_ * ntok;
            LOAD_HV(hva, k0_); LOAD_HV(hvb, k1_); U_STEP(q, 0, b0_, k0_, hva); U_STEP(q + 1, 8 * (LOOK - 1), b1_, k1_, hvb); }
    }
#undef LOAD_HV
#undef U_STEP
#undef TR_STEP
    LDS_WAIT(); asm volatile("" ::: "memory");
#define V_STEP(q, SB) do { const int q__ = (q); const int b = (q__ - nsteps) & 7; \
        const unsigned char* ntab; int npos; STEP_DESC(q__ + LOOK, ntab, npos); npos += (int)hsel; \
        const int wpos = k * 128 + b * 16 + (int)hsel; \
        _Pragma("unroll") for (int i2 = 0; i2 < 8; ++i2) { \
            const v6u_t p = {buf[SB + i2].a[0], buf[SB + i2].a[1], buf[SB + i2].a[2], buf[SB + i2].a[3], buf[SB + i2].b[0], buf[SB + i2].b[1]}; \
            const float wv = wl[wpos + 2 * i2]; \
            if (VAR == 1) { acc[0] += __builtin_bit_cast(float, p[0] ^ p[1] ^ p[2]); acc[1] += __builtin_bit_cast(float, p[3] ^ p[4] ^ p[5]); } \
            else { const v32f_t rv = __builtin_amdgcn_cvt_scalef32_pk32_f32_fp6(p, 1.0f); \
                const f32x2_t w2_ = {wv, wv}; _Pragma("unroll") for (int j = 0; j < 32; j += 2) { const f32x2_t r2_ = {rv[j], rv[j + 1]}; f32x2_t a2_ = {acc[j], acc[j + 1]}; a2_ = __builtin_elementwise_fma(r2_, w2_, a2_); acc[j] = a2_[0]; acc[j + 1] = a2_[1]; } } \
            const int ri = sid[npos + 2 * i2]; LDROW(buf[SB + i2], ntab, ri); \
            asm volatile("" : "+v"(acc[0]), "+v"(acc[1]), "+v"(acc[2]), "+v"(acc[3]), "+v"(acc[4]), "+v"(acc[5]), "+v"(acc[6]), "+v"(acc[7]), "+v"(acc[8]), "+v"(acc[9]), "+v"(acc[10]), "+v"(acc[11]), "+v"(acc[12]), "+v"(acc[13]), "+v"(acc[14]), "+v"(acc[15])); \
            asm volatile("" : "+v"(acc[16]), "+v"(acc[17]), "+v"(acc[18]), "+v"(acc[19]), "+v"(acc[20]), "+v"(acc[21]), "+v"(acc[22]), "+v"(acc[23]), "+v"(acc[24]), "+v"(acc[25]), "+v"(acc[26]), "+v"(acc[27]), "+v"(acc[28]), "+v"(acc[29]), "+v"(acc[30]), "+v"(acc[31])); \
            __builtin_amdgcn_sched_barrier(0); } } while (0)
    const unsigned eoff = (g32 * 32u + hsel * 16u) * 4u;
    float4 fgq[4];
#pragma unroll
    for (int q = 0; q < 4; ++q) fgq[q] = *(const float4*)((const char*)(fg + q * 4) + eoff);
#pragma unroll 1
    for (int k = 0; k < ntok; ++k) {
        const int t = t0 + k * tstep;
        const pg8::u32x4 ra = *(const pg8::u32x4*)((const char*)(H2B + (size_t)t * D) + eoff / 2), rb = *(const pg8::u32x4*)((const char*)(H2B + (size_t)t * D) + eoff / 2 + 16);
        __builtin_amdgcn_sched_barrier(0);
        float acc[32];
#pragma unroll
        for (int j = 0; j < 32; ++j) acc[j] = 0.f;
#pragma unroll 1
        for (int bb = 0; bb < 8; bb += 2) { const int q = nsteps + 8 * k + bb; V_STEP(q, 0); V_STEP(q + 1, 8 * (LOOK - 1)); }
        float fin[16];
#pragma unroll
        for (int j = 0; j < 16; ++j) { const float lo = acc[j], hi = acc[16 + j]; const float send = hsel ? lo : hi, keep = hsel ? hi : lo; fin[j] = keep + __shfl_xor(send, 32); }
        float* orow = (float*)((char*)(out + (size_t)t * D) + eoff); float ss = 0.f;
        {
#pragma unroll
          for (int q = 0; q < 4; ++q) { fin[2 * q] += __builtin_bit_cast(float, ra[q] << 16); fin[2 * q + 1] += __builtin_bit_cast(float, ra[q] & 0xffff0000u); fin[8 + 2 * q] += __builtin_bit_cast(float, rb[q] << 16); fin[8 + 2 * q + 1] += __builtin_bit_cast(float, rb[q] & 0xffff0000u); } }
#pragma unroll
        for (int j = 0; j < 16; ++j) ss += fin[j] * fin[j];
        const float rr = rsqrtf(wave_sum(ss) * (1.f / D) + EPS);
#pragma unroll
        for (int q = 0; q < 4; ++q) { const float4 g = fgq[q];
            *(float4*)(orow + q * 4) = make_float4(fin[4 * q] * rr * g.x, fin[4 * q + 1] * rr * g.y, fin[4 * q + 2] * rr * g.z, fin[4 * q + 3] * rr * g.w); }
        __builtin_amdgcn_sched_barrier(0);
    }
#undef V_STEP
#undef STEP_DESC
#undef LDI
#undef LDF
#undef LDROW
}

typedef short v4i16_t __attribute__((ext_vector_type(4)));
typedef int v2i32_t __attribute__((ext_vector_type(2)));
typedef int v4i32_t __attribute__((ext_vector_type(4)));
DEVI bf16x8_t join_tr(v4i16_t lo, v4i16_t hh) { const v2i32_t a = __builtin_bit_cast(v2i32_t, lo), b = __builtin_bit_cast(v2i32_t, hh); const v4i32_t w = {a[0], a[1], b[0], b[1]}; return __builtin_bit_cast(bf16x8_t, w); }
DEVI float max3f(float a, float b, float c) { float r; asm("v_max3_f32 %0, %1, %2, %3" : "=v"(r) : "v"(a), "v"(b), "v"(c)); return r; }
DEVI float max2f(float a, float b) { float r; asm("v_max_f32_e32 %0, %1, %2" : "=v"(r) : "v"(a), "v"(b)); return r; }
DEVI void glds16(const void* gsrc, unsigned lds_dst) { unsigned keep;
    asm volatile("s_mov_b32 %0, m0\n\ts_mov_b32 m0, %2\n\ts_nop 0\n\tglobal_load_lds_dwordx4 %1, off\n\ts_mov_b32 m0, %0" : "=&s"(keep) : "v"(gsrc), "s"(lds_dst) : "memory"); }
#define LDSADDR(p) ((unsigned)__builtin_amdgcn_readfirstlane((int)(unsigned)(uintptr_t)(p)))
#define ATT_BAR(N) asm volatile("s_waitcnt vmcnt(" #N ") lgkmcnt(0)\n\ts_barrier" ::: "memory")
template <int DQK, int DV, int DSPLIT, int NSLOT, int PD, bool CAUSAL, bool STAG, int VAR = 0>
DEVI void attn_unit(LAS unsigned char* S, const bf16* Qu, int qpitch, const bf16* Ku, int kpitch, const bf16* Vu, int vpitch, bf16* Ou, int opitch, int NT, int qcb) {
    constexpr int NCH = DQK / 8, KSLOT = NCH * 1024, NVG = DV / 32, VSLOT = NVG * 4096, NRG = 8 / DSPLIT, DVW = DV / DSPLIT, NOD = DVW / 32, NKS = DQK / 16;
    constexpr int KOFF = 0, VOFF = NSLOT * KSLOT, WSF = VOFF + NSLOT * VSLOT;
    static_assert(NRG * 32 * DVW * 2 * DSPLIT <= NSLOT * KSLOT, "O staging reuses the K ring");
    static_assert(NSLOT >= PD + (STAG ? 2 : 1), "ring depth");
    int tid_ = threadIdx.x; asm volatile("" : "+v"(tid_));
    const int lane = tid_ & 63, wid = __builtin_amdgcn_readfirstlane(tid_ >> 6), r32 = lane & 31, hi = lane >> 5, rg = wid % NRG, dp = wid / NRG;
    const bool late = STAG && wid >= 4;
    LAS float* wsf = (LAS float*)(S + WSF) + wid * 64;
    const int nld = (NCH - wid + 7) / 8 + (NVG * 4 - wid + 7) / 8;
    const bf16* ksrc = Ku + (size_t)lane * kpitch;
    const bf16* vsrc = Vu + (size_t)(lane >> 2) * vpitch + (lane & 3) * 8;
#define ATT_DMA(t, slot) do { \
        _Pragma("unroll") for (int pc_ = 0; pc_ < (NCH + 7) / 8; ++pc_) { const int pc = wid + 8 * pc_; if (pc < NCH) \
            glds16(ksrc + (size_t)(t) * 64 * kpitch + pc * 8, LDSADDR(S + KOFF + (slot) * KSLOT + pc * 1024)); } \
        _Pragma("unroll") for (int pv_ = 0; pv_ < (NVG * 4 + 7) / 8; ++pv_) { const int pv = wid + 8 * pv_; if (pv < NVG * 4) \
            glds16(vsrc + (size_t)((t) * 64 + (pv & 3) * 16) * vpitch + (pv >> 2) * 32, LDSADDR(S + VOFF + (slot) * VSLOT + pv * 1024)); } } while (0)
    bf16x8_t qr[NKS];
#pragma unroll
    for (int ks = 0; ks < NKS; ++ks) qr[ks] = *(const bf16x8_t*)(Qu + (size_t)(32 * rg + r32) * qpitch + ks * 16 + hi * 8);
#pragma unroll
    for (int ks = 0; ks < NKS; ++ks) asm volatile("" : "+v"(qr[ks]));
#pragma unroll
    for (int t = 0; t < PD; ++t) if (t < NT) ATT_DMA(t, t);
    f32x16_t o[NOD];
#pragma unroll
    for (int dd = 0; dd < NOD; ++dd) o[dd] = f32x16_t{};
    float m = 0.f, l = 0.f; f32x16_t negm = f32x16_t{};
    const int tlast = CAUSAL ? qcb + (rg >> 1) : NT - 1;
    const LAS unsigned char* kbase = S + KOFF + hi * 1024 + r32 * 16;
    const LAS unsigned char* vbase = S + VOFF + ((lane >> 4) & 1) * 32 + (lane & 3) * 8 + (4 * hi + ((lane & 15) >> 2)) * 64 + dp * NOD * 4096;
    bf16x8_t pa[4];
#define ATT_QKSM(sl) do { const LAS unsigned char* kp = kbase + (sl) * KSLOT; \
            f32x16_t p0 = negm, p1 = negm; \
            _Pragma("unroll") for (int ks = 0; ks < NKS; ++ks) { const bf16x8_t a0 = *(const LAS bf16x8_t*)(kp + ks * 2048), a1 = *(const LAS bf16x8_t*)(kp + ks * 2048 + 512); \
                if (VAR != 2) { p0 = __builtin_amdgcn_mfma_f32_32x32x16_bf16(a0, qr[ks], p0, 0, 0, 0); p1 = __builtin_amdgcn_mfma_f32_32x32x16_bf16(a1, qr[ks], p1, 0, 0, 0); } else { p0[ks] += __builtin_bit_cast(float, (int)a0[0]); p1[ks] += __builtin_bit_cast(float, (int)a1[0]); } } \
            asm volatile("s_nop 15\n\ts_nop 7" : "+v"(p0), "+v"(p1)); \
            float rm = 0.f; \
            if (VAR != 1) { float a = max3f(p0[0], p0[1], p1[0]), b = max3f(p0[2], p0[3], p1[1]); a = max3f(a, p1[2], p1[3]); \
              _Pragma("unroll") for (int r = 4; r < 16; r += 4) { a = max3f(a, p0[r], p0[r + 1]); b = max3f(b, p0[r + 2], p0[r + 3]); a = max3f(a, p1[r], p1[r + 1]); b = max3f(b, p1[r + 2], p1[r + 3]); } \
              rm = max2f(a, b); rm = max2f(rm, __shfl_xor(rm, 32)); } \
            if (__any(rm > 0.f)) { \
                const float dl = fmaxf(rm, 0.f), alpha = __builtin_amdgcn_exp2f(-dl); m += dl; l *= alpha; \
                _Pragma("unroll") for (int r = 0; r < 16; ++r) { p0[r] -= dl; p1[r] -= dl; negm[r] = -m; } \
                if (hi == 0) wsf[r32] = alpha; \
                LDS_WAIT(); asm volatile("" ::: "memory"); \
                _Pragma("unroll") for (int r = 0; r < 16; ++r) { const float f = wsf[crow16(r, hi)]; \
                    _Pragma("unroll") for (int dd = 0; dd < NOD; ++dd) o[dd][r] *= f; } \
                LDS_WAIT(); asm volatile("" ::: "memory"); \
            } \
            float ls = 0.f; \
            if (VAR != 1) { _Pragma("unroll") for (int r = 0; r < 16; ++r) { p0[r] = __builtin_amdgcn_exp2f(p0[r]); p1[r] = __builtin_amdgcn_exp2f(p1[r]); ls += p0[r] + p1[r]; } } \
            l += ls; \
            _Pragma("unroll") for (int ks = 0; ks < 4; ++ks) { pg8::u32x4 w; \
                if (ks < 2) { w.x = pg8::cvt_pk_bf16(p0[8 * ks], p0[8 * ks + 1]); w.y = pg8::cvt_pk_bf16(p0[8 * ks + 2], p0[8 * ks + 3]); w.z = pg8::cvt_pk_bf16(p0[8 * ks + 4], p0[8 * ks + 5]); w.w = pg8::cvt_pk_bf16(p0[8 * ks + 6], p0[8 * ks + 7]); } \
                else { const int k2 = ks - 2; w.x = pg8::cvt_pk_bf16(p1[8 * k2], p1[8 * k2 + 1]); w.y = pg8::cvt_pk_bf16(p1[8 * k2 + 2], p1[8 * k2 + 3]); w.z = pg8::cvt_pk_bf16(p1[8 * k2 + 4], p1[8 * k2 + 5]); w.w = pg8::cvt_pk_bf16(p1[8 * k2 + 6], p1[8 * k2 + 7]); } \
                pa[ks] = __builtin_bit_cast(bf16x8_t, w); } } while (0)
#define ATT_PV(sl) do { const LAS unsigned char* vp = vbase + (sl) * VSLOT; \
            _Pragma("unroll") for (int dd = 0; dd < NOD; ++dd) \
                _Pragma("unroll") for (int ks = 0; ks < 4; ++ks) { \
                    const v4i16_t lo = __builtin_amdgcn_ds_read_tr16_b64_v4i16((LAS v4i16_t*)(vp + dd * 4096 + ks * 1024)); \
                    const v4i16_t hh = __builtin_amdgcn_ds_read_tr16_b64_v4i16((LAS v4i16_t*)(vp + dd * 4096 + ks * 1024 + 512)); \
                    const bf16x8_t vf = join_tr(lo, hh); \
                    if (VAR != 2) o[dd] = __builtin_amdgcn_mfma_f32_32x32x16_bf16(pa[ks], vf, o[dd], 0, 0, 0); else o[dd][ks] += __builtin_bit_cast(float, (int)vf[0] + (int)pa[ks][0]); } } while (0)
    int slot = 0, slot_prev = NSLOT - 1, slot_issue = PD % NSLOT;
    for (int t = 0; t < NT; ++t) {
        const int ahead = (t + PD - 1 < NT - 1 ? t + PD - 1 : NT - 1) - t;
        const int nwait = ahead * nld;
        if (nwait <= 0) ATT_BAR(0); else if (nwait == 2) ATT_BAR(2); else if (nwait == 3) ATT_BAR(3); else if (nwait == 4) ATT_BAR(4); else if (nwait == 6) ATT_BAR(6); else if (nwait == 8) ATT_BAR(8); else ATT_BAR(0);
        if (t + PD < NT) ATT_DMA(t + PD, slot_issue);
        if (!late) { if (t <= tlast) { ATT_QKSM(slot); ATT_PV(slot); } }
        else { if (t >= 1 && t - 1 <= tlast) ATT_PV(slot_prev); if (t <= tlast) ATT_QKSM(slot); }
        slot_prev = slot; slot = slot + 1 == NSLOT ? 0 : slot + 1; slot_issue = slot_issue + 1 == NSLOT ? 0 : slot_issue + 1;
    }
    if (late && tlast >= NT - 1) ATT_PV(slot_prev);
    l += __shfl_xor(l, 32);
    if (hi == 0) wsf[32 + r32] = l;
    ATT_BAR(0);
    LAS bf16* stg = (LAS bf16*)(S + KOFF) + wid * 32 * DVW;
#pragma unroll
    for (int r = 0; r < 16; ++r) { const int orow = crow16(r, hi); const float rl = __builtin_amdgcn_rcpf(wsf[32 + orow]);
#pragma unroll
        for (int dd = 0; dd < NOD; ++dd) stg[orow * DVW + dd * 32 + r32] = f2bf(o[dd][r] * rl); }
    LDS_WAIT(); asm volatile("" ::: "memory");
#pragma unroll
    for (int i = 0; i < DVW / 16; ++i) { const int idx = i * 64 + lane, row = idx / (DVW / 8), ch = idx % (DVW / 8);
        *(pg8::u32x4*)(Ou + (size_t)(32 * rg + row) * opitch + dp * DVW + ch * 8) = *(const LAS pg8::u32x4*)(stg + row * DVW + ch * 8); }
    ATT_BAR(0);
#undef ATT_DMA
#undef ATT_QKSM
#undef ATT_PV
}

typedef float f32x2_t __attribute__((ext_vector_type(2)));
DEVI unsigned cvtpk(float lo, float hi) { const f32x2_t v = {lo, hi}; const bf16x2_t b = __builtin_convertvector(v, bf16x2_t); return __builtin_bit_cast(unsigned, b); }
DEVI void attn_mla_unit(LAS unsigned char* S, const bf16* Qu, const bf16* Ku, const bf16* Vu, bf16* Ou, int NT, int qcb) {
    constexpr int NCH = 12, KSLOT = NCH * 1024, VSLOT = 8192, NSLOT = 4, NKS = 6, qpitch = 768, kpitch = 768, vpitch = 512, opitch = D;
    constexpr int KOFF = 0, VOFF = NSLOT * KSLOT, WSF = VOFF + NSLOT * VSLOT;
    int tid_ = threadIdx.x; asm volatile("" : "+v"(tid_));
    const int lane = tid_ & 63, wid = __builtin_amdgcn_readfirstlane(tid_ >> 6), r32 = lane & 31, hi = lane >> 5;
    LAS float* wsf = (LAS float*)(S + WSF) + wid * 64;
    const int nld = wid < 4 ? 3 : 2;
    const bf16* ksrc = Ku + (size_t)lane * kpitch;
    const bf16* vsrc = Vu + (size_t)(lane >> 2) * vpitch + (lane & 3) * 8;
#define MLA_DMA(t, slot) do { \
        glds16(ksrc + (size_t)(t) * 64 * kpitch + wid * 8, LDSADDR(S + KOFF + (slot) * KSLOT + wid * 1024)); \
        if (wid < 4) glds16(ksrc + (size_t)(t) * 64 * kpitch + (wid + 8) * 8, LDSADDR(S + KOFF + (slot) * KSLOT + (wid + 8) * 1024)); \
        glds16(vsrc + (size_t)((t) * 64 + (wid & 3) * 16) * vpitch + (wid >> 2) * 32, LDSADDR(S + VOFF + (slot) * VSLOT + wid * 1024)); } while (0)
#define MLA_BAR(nw) do { if ((nw) <= 0) ATT_BAR(0); else if ((nw) == 2) ATT_BAR(2); else if ((nw) == 3) ATT_BAR(3); else if ((nw) == 4) ATT_BAR(4); else ATT_BAR(6); } while (0)
#define SGB(mask, n) __builtin_amdgcn_sched_group_barrier(mask, n, 0)
    bf16x8_t qr[NKS];
#pragma unroll
    for (int ks = 0; ks < NKS; ++ks) qr[ks] = *(const bf16x8_t*)(Qu + (size_t)(32 * wid + r32) * qpitch + ks * 16 + hi * 8);
#pragma unroll
    for (int ks = 0; ks < NKS; ++ks) asm volatile("" : "+v"(qr[ks]));
    MLA_DMA(0, 0); MLA_DMA(1, 1); MLA_DMA(2, 2);
    f32x16_t o0 = f32x16_t{}, o1 = f32x16_t{};
    float m = 0.f, l = 0.f; f32x16_t negm = f32x16_t{};
    const int tlast = qcb + (wid >> 1);
    const LAS unsigned char* kbase = S + KOFF + hi * 1024 + r32 * 16;
    const LAS unsigned char* vbase = S + VOFF + ((lane >> 4) & 1) * 32 + (lane & 3) * 8 + (4 * hi + ((lane & 15) >> 2)) * 64;
    f32x16_t p0, p1;
#define MLA_ROWMAX(rm, q0, q1) do { float a_ = __builtin_fmaxf(__builtin_fmaxf(q0[0], q0[1]), q1[0]), b_ = __builtin_fmaxf(__builtin_fmaxf(q0[2], q0[3]), q1[1]); a_ = __builtin_fmaxf(__builtin_fmaxf(a_, q1[2]), q1[3]); \
        _Pragma("unroll") for (int r = 4; r < 16; r += 4) { a_ = __builtin_fmaxf(__builtin_fmaxf(a_, q0[r]), q0[r + 1]); b_ = __builtin_fmaxf(__builtin_fmaxf(b_, q0[r + 2]), q0[r + 3]); a_ = __builtin_fmaxf(__builtin_fmaxf(a_, q1[r]), q1[r + 1]); b_ = __builtin_fmaxf(__builtin_fmaxf(b_, q1[r + 2]), q1[r + 3]); } \
        rm = __builtin_fmaxf(a_, b_); rm = __builtin_fmaxf(rm, __shfl_xor(rm, 32)); } while (0)
#define MLA_MOVE(rm, q0, q1) do { if (__any(rm > 0.f)) { \
            const float dl = fmaxf(rm, 0.f), alpha = __builtin_amdgcn_exp2f(-dl); m += dl; l *= alpha; \
            _Pragma("unroll") for (int r = 0; r < 16; ++r) { q0[r] -= dl; q1[r] -= dl; negm[r] = -m; } \
            if (hi == 0) wsf[r32] = alpha; \
            LDS_WAIT(); asm volatile("" ::: "memory"); \
            _Pragma("unroll") for (int r = 0; r < 16; ++r) { const float f = wsf[crow16(r, hi)]; o0[r] *= f; o1[r] *= f; } \
            LDS_WAIT(); asm volatile("" ::: "memory"); } } while (0)
    MLA_BAR(2 * nld);
    MLA_DMA(3, 3);
    { const LAS unsigned char* kp = kbase; p0 = negm; p1 = negm;
#pragma unroll
      for (int ks = 0; ks < NKS; ++ks) { const bf16x8_t a0 = *(const LAS bf16x8_t*)(kp + ks * 2048), a1 = *(const LAS bf16x8_t*)(kp + ks * 2048 + 512);
          p0 = __builtin_amdgcn_mfma_f32_32x32x16_bf16(a0, qr[ks], p0, 0, 0, 0); p1 = __builtin_amdgcn_mfma_f32_32x32x16_bf16(a1, qr[ks], p1, 0, 0, 0); }
      float rm; MLA_ROWMAX(rm, p0, p1); MLA_MOVE(rm, p0, p1); }
    int kslot = 1, vslot = 0, islot = 3;
    for (int t = 0; t < NT; ++t) {
        if (t + 1 < NT) { const int young = (t + 2 < NT) ? 1 : 0; MLA_BAR(young * nld); } else ATT_BAR(0);
        if (t >= 1 && t + 3 < NT) MLA_DMA(t + 3, islot);
        if (t < tlast) {
            const LAS unsigned char* kp = kbase + kslot * KSLOT; const LAS unsigned char* vp = vbase + vslot * VSLOT;
            bf16x8_t kf[12];
#pragma unroll
            for (int ks = 0; ks < NKS; ++ks) { kf[2 * ks] = *(const LAS bf16x8_t*)(kp + ks * 2048); kf[2 * ks + 1] = *(const LAS bf16x8_t*)(kp + ks * 2048 + 512); }
            f32x16_t n0 = negm, n1 = negm; float ls = 0.f; pg8::u32x4 pw[4];
#pragma unroll
            for (int ks = 0; ks < NKS; ++ks) { n0 = __builtin_amdgcn_mfma_f32_32x32x16_bf16(kf[2 * ks], qr[ks], n0, 0, 0, 0); n1 = __builtin_amdgcn_mfma_f32_32x32x16_bf16(kf[2 * ks + 1], qr[ks], n1, 0, 0, 0); }
#pragma unroll
            for (int r = 0; r < 16; ++r) { p0[r] = __builtin_amdgcn_exp2f(p0[r]); p1[r] = __builtin_amdgcn_exp2f(p1[r]); }
#pragma unroll
            for (int r = 0; r < 16; r += 2) { ls += (p0[r] + p0[r + 1]) + (p1[r] + p1[r + 1]); }
#pragma unroll
            for (int ks = 0; ks < 2; ++ks) { pw[ks] = (pg8::u32x4){cvtpk(p0[8 * ks], p0[8 * ks + 1]), cvtpk(p0[8 * ks + 2], p0[8 * ks + 3]), cvtpk(p0[8 * ks + 4], p0[8 * ks + 5]), cvtpk(p0[8 * ks + 6], p0[8 * ks + 7])};
                pw[2 + ks] = (pg8::u32x4){cvtpk(p1[8 * ks], p1[8 * ks + 1]), cvtpk(p1[8 * ks + 2], p1[8 * ks + 3]), cvtpk(p1[8 * ks + 4], p1[8 * ks + 5]), cvtpk(p1[8 * ks + 6], p1[8 * ks + 7])}; }
            l += ls;
            SGB(0x100, 4);
#pragma unroll
            for (int i = 0; i < 12; ++i) { SGB(0x008, 1); SGB(0x002, 7); if (i < 8) SGB(0x100, 1); }
            __builtin_amdgcn_sched_barrier(0);
            v4i16_t vlo[8], vhi[8];
#pragma unroll
            for (int i = 0; i < 8; ++i) { vlo[i] = __builtin_amdgcn_ds_read_tr16_b64_v4i16((LAS v4i16_t*)(vp + (i >> 2) * 4096 + (i & 3) * 1024)); vhi[i] = __builtin_amdgcn_ds_read_tr16_b64_v4i16((LAS v4i16_t*)(vp + (i >> 2) * 4096 + (i & 3) * 1024 + 512)); }
#pragma unroll
            for (int i = 0; i < 8; ++i) { const bf16x8_t vf = join_tr(vlo[i], vhi[i]); const bf16x8_t pa_ = __builtin_bit_cast(bf16x8_t, pw[i & 3]);
                if (i < 4) o0 = __builtin_amdgcn_mfma_f32_32x32x16_bf16(pa_, vf, o0, 0, 0, 0); else o1 = __builtin_amdgcn_mfma_f32_32x32x16_bf16(pa_, vf, o1, 0, 0, 0); }
            float rm; MLA_ROWMAX(rm, n0, n1);
            SGB(0x100, 6);
#pragma unroll
            for (int i = 0; i < 8; ++i) { SGB(0x008, 1); SGB(0x002, 3); if (i < 5) SGB(0x100, 2); }
            __builtin_amdgcn_sched_barrier(0);
            MLA_MOVE(rm, n0, n1);
            p0 = n0; p1 = n1;
        } else if (t == tlast) {
            asm volatile("" : "+v"(p0), "+v"(p1));
            const LAS unsigned char* vp = vbase + vslot * VSLOT; float ls = 0.f; pg8::u32x4 pw[4];
#pragma unroll
            for (int r = 0; r < 16; ++r) { p0[r] = __builtin_amdgcn_exp2f(p0[r]); p1[r] = __builtin_amdgcn_exp2f(p1[r]); ls += p0[r] + p1[r]; }
            l += ls;
#pragma unroll
            for (int ks = 0; ks < 2; ++ks) { pw[ks] = (pg8::u32x4){cvtpk(p0[8 * ks], p0[8 * ks + 1]), cvtpk(p0[8 * ks + 2], p0[8 * ks + 3]), cvtpk(p0[8 * ks + 4], p0[8 * ks + 5]), cvtpk(p0[8 * ks + 6], p0[8 * ks + 7])};
                pw[2 + ks] = (pg8::u32x4){cvtpk(p1[8 * ks], p1[8 * ks + 1]), cvtpk(p1[8 * ks + 2], p1[8 * ks + 3]), cvtpk(p1[8 * ks + 4], p1[8 * ks + 5]), cvtpk(p1[8 * ks + 6], p1[8 * ks + 7])}; }
#pragma unroll
            for (int i = 0; i < 8; ++i) { const v4i16_t lo = __builtin_amdgcn_ds_read_tr16_b64_v4i16((LAS v4i16_t*)(vp + (i >> 2) * 4096 + (i & 3) * 1024)), hh = __builtin_amdgcn_ds_read_tr16_b64_v4i16((LAS v4i16_t*)(vp + (i >> 2) * 4096 + (i & 3) * 1024 + 512));
                const bf16x8_t vf = join_tr(lo, hh); const bf16x8_t pa_ = __builtin_bit_cast(bf16x8_t, pw[i & 3]);
                if (i < 4) o0 = __builtin_amdgcn_mfma_f32_32x32x16_bf16(pa_, vf, o0, 0, 0, 0); else o1 = __builtin_amdgcn_mfma_f32_32x32x16_bf16(pa_, vf, o1, 0, 0, 0); }
        }
        kslot = (kslot + 1) & 3; vslot = (vslot + 1) & 3; islot = (islot + 1) & 3;
    }
    l += __shfl_xor(l, 32);
    if (hi == 0) wsf[32 + r32] = l;
    ATT_BAR(0);
    LAS bf16* stg = (LAS bf16*)(S + KOFF) + wid * 32 * 64;
#pragma unroll
    for (int r = 0; r < 16; ++r) { const int orow = crow16(r, hi); const float rl = __builtin_amdgcn_rcpf(wsf[32 + orow]);
        stg[orow * 64 + r32] = f2bf(o0[r] * rl); stg[orow * 64 + 32 + r32] = f2bf(o1[r] * rl); }
    LDS_WAIT(); asm volatile("" ::: "memory");
#pragma unroll
    for (int i = 0; i < 4; ++i) { const int idx = i * 64 + lane, row = idx >> 3, ch = idx & 7;
        *(pg8::u32x4*)(Ou + (size_t)(32 * wid + row) * opitch + ch * 8) = *(const LAS pg8::u32x4*)(stg + row * 64 + ch * 8); }
    ATT_BAR(0);
#undef MLA_DMA
#undef MLA_BAR
#undef MLA_ROWMAX
#undef MLA_MOVE
#undef SGB
}

DEVI bool unit_of(int Mrows, int Ncols, int G, int c, int i, int& pm, int& pn) {
    const int nM = Mrows / 256, nN = Ncols / 256, nwg = nM * nN; const long Lq = (long)i * G + c; if (Lq >= nwg) return false;
    int wgid = (int)Lq; { const int q = nwg / 8, r = nwg % 8, xcd = wgid % 8, off = wgid / 8; wgid = (xcd < r ? xcd * (q + 1) : r * (q + 1) + (xcd - r) * q) + off; }
    const int nig = 8 * nN, gid = wgid / nig, fm = gid * 8, gsz = (nM - fm) < 8 ? (nM - fm) : 8;
    pm = fm + ((wgid % nig) % gsz); pn = (wgid % nig) / gsz; return true;
}
DEVI void own_writes_visible() {
    asm volatile("s_waitcnt vmcnt(0)" ::: "memory"); __syncthreads();
    if (threadIdx.x == 0) { __builtin_amdgcn_fence(__ATOMIC_ACQUIRE, "agent"); asm volatile("s_waitcnt vmcnt(0)" ::: "memory"); }
    __syncthreads();
}

__global__ void __launch_bounds__(NTHR, 2) mega(Args args) {
    extern __shared__ __attribute__((aligned(16))) unsigned char lds[];
    const int tid = threadIdx.x, lane = tid & 63, wave = __builtin_amdgcn_readfirstlane(tid >> 6);
    const int G = gridDim.x, bx = blockIdx.x; const int vcu = (G % 8 == 0) ? (bx % 8) * (G / 8) + bx / 8 : bx;
    LAS unsigned char* L = (LAS unsigned char*)lds + PH_BASE;
    volatile LAS unsigned* MISC = (volatile LAS unsigned*)((LAS unsigned char*)lds + LDSCTL_OFF + 320);
    unsigned char* ws = args.ws; gu32* ctl = (gu32*)(ws + WS_CTL);
    if (tid < PH_BASE / 4) ((LAS unsigned*)(lds))[tid] = 0u;
    __syncthreads();
    XcdBarrier bar = xcd_barrier_post((unsigned*)(ctl + CW_BAR) + args.li * XCD_BAR_WORDS, MISC + 8);
    const unsigned mask = args.mask;
#define IN(k) ((mask >> (k)) & 1u)
#ifndef PROBE_ATTVAR
#define PROBE_ATTVAR 0
#endif
#ifndef PROBE_EXPVAR
#define PROBE_EXPVAR 0
#endif
#ifndef PROBE_REP
#define PROBE_REP 0u
#endif
#define NREP(k) (1 + (int)((PROBE_REP >> (k)) & 1u))
#define SEAM(k) do { if ((mask & ((1u << PH_N) - 1u)) >> ((k) + 1)) xcd_barrier(bar); } while (0)
    const float* x = args.in[0]; float* out = args.out;
    bf16 *Wt_in = (bf16*)(ws + WS_WIN), *Wt_qup = (bf16*)(ws + WS_WQUP), *Wt_kv = (bf16*)(ws + WS_WKV), *Wt_mix = (bf16*)(ws + WS_WMIX), *Wt_mq = (bf16*)(ws + WS_WMQ), *Wt_mkv = (bf16*)(ws + WS_WMKV),
         *Wt_mo = (bf16*)(ws + WS_WMO), *Wt_pq = (bf16*)(ws + WS_WPQ), *SK = (bf16*)(ws + WS_SK), *MEMN = (bf16*)(ws + WS_MEMN), *MEMKV = (bf16*)(ws + WS_MEMKV), *PU = (bf16*)(ws + WS_PU), *PV = (bf16*)(ws + WS_PV);
    float *partq = (float*)(ws + WS_PARTQ), *partkv = (float*)(ws + WS_PARTKV), *part1 = (float*)(ws + WS_PART1), *part2 = (float*)(ws + WS_PART2), *trig = (float*)(ws + WS_TRIG);
    bf16 *XN = (bf16*)(ws + WS_R1), *CONCAT = XN, *QM = XN, *H2B = XN;
    bf16 *CQ = (bf16*)(ws + WS_R2 + R2_CQ), *CKV = (bf16*)(ws + WS_R2 + R2_CKV), *U = (bf16*)(ws + WS_R2 + R2_U), *H1B = (bf16*)(ws + WS_R2), *OM = (bf16*)(ws + WS_R3);
    bf16 *QB = (bf16*)(ws + WS_R3 + R3_QB), *KB = (bf16*)(ws + WS_R3 + R3_KB), *VB = (bf16*)(ws + WS_R3 + R3_VB), *QP = (bf16*)(ws + WS_R3);


    if (IN(PH_PRO)) {
        for (int rep_ = 0; rep_ < NREP(PH_PRO); ++rep_) { if (rep_) xcd_barrier(bar);
        LAS float* scr = (LAS float*)(L + wave * 16384);
        const int gw = vcu * NWAVES + wave, NGW = G * NWAVES;
        constexpr int I_IN = (D / 64) * (INP / 32), I_QUP = (256 / 64) * (768 / 32), I_KV = (128 / 64) * (1024 / 32), I_SQ = (D / 64) * (D / 32), I_W2 = (D / 64) * (2048 / 32);
        constexpr int NITEMS = I_IN + I_QUP + I_KV + 2 * I_SQ + 2 * I_W2;
        for (int rp_ = 0; rp_ < 1 + (int)((PROBE_REP >> 20) & 1u); ++rp_)
        for (int it = gw; it < NITEMS; it += NGW) {
            int r = it;
            if (r < I_IN) { p0_transpose_item<1, false>(args.in[3], D, INC, Wt_in, INP, nullptr, scr, r, lane); continue; } r -= I_IN;
            if (r < I_QUP) { p0_transpose_item<0, true>(args.in[5], 256, 768, Wt_qup, 768, args.in[4], scr, r, lane); continue; } r -= I_QUP;
            if (r < I_KV) { p0_transpose_item<2, true>(args.in[7], 128, 1024, Wt_kv, 1024, args.in[6], scr, r, lane); continue; } r -= I_KV;
            if (r < I_SQ) { p0_transpose_item<0, false>(args.in[12], D, D, Wt_mix, D, nullptr, scr, r, lane); continue; } r -= I_SQ;
            if (r < I_SQ) { p0_transpose_item<0, false>(args.in[17], D, D, Wt_mo, D, nullptr, scr, r, lane); continue; } r -= I_SQ;
            if (r < I_W2) { p0_transpose_item<0, false>(args.in[16], D, 2048, Wt_mkv, 2048, nullptr, scr, r, lane); continue; } r -= I_W2;
            p0_transpose_item<0, true>(args.in[19], D, 2048, Wt_pq, 2048, args.in[18], scr, r, lane);
        }
        for (int rp_ = 0; rp_ < 1 + (int)((PROBE_REP >> 21) & 1u); ++rp_)
        for (int m = gw; m < M; m += 4 * NGW) rms_rows4_to_bf16(x, args.in[2], XN, m, NGW, M, lane);
        for (int m = gw; m < BATCH * NMEM; m += NGW) rms_row_to_bf16(args.in[1] + (size_t)m * D, args.in[14], MEMN + (size_t)m * D, lane);
        const size_t gtid = (size_t)vcu * NTHR + tid, gn = (size_t)G * NTHR;
        cvt_stream(args.in[20], SK, (size_t)PH * 2 * PNK * PHALF / 8, nullptr, gtid, gn);
        for (size_t i = gtid; i < (size_t)D * D / 8; i += gn) {
            const float4 a = *(const float4*)(args.in[15] + i * 8), b = *(const float4*)(args.in[15] + i * 8 + 4); const float gk = args.in[13][(i * 8) >> 10];
            pg8::u32x4 o; o.x = pg8::cvt_pk_bf16(a.x * gk, a.y * gk); o.y = pg8::cvt_pk_bf16(a.z * gk, a.w * gk); o.z = pg8::cvt_pk_bf16(b.x * gk, b.y * gk); o.w = pg8::cvt_pk_bf16(b.z * gk, b.w * gk);
            *(pg8::u32x4*)(Wt_mq + i * 8) = o; }
        for (int rp_ = 0; rp_ < 1 + (int)((PROBE_REP >> 22) & 1u); ++rp_) {
        cvt_rows_fp6<true>(args.in[21], (unsigned char*)PU, args.in[18], PU_SCALE, gtid, gn);
        cvt_rows_fp6<false>(args.in[22], (unsigned char*)PV, nullptr, PV_SCALE, gtid, gn); }
        for (size_t i = gtid; i < (size_t)SEQ * 16; i += gn) { float c, s; rope_cs((int)(i >> 4), (int)(i & 15), c, s); *(float2*)(trig + i * 2) = make_float2(c, s); }
        }
        SEAM(PH_PRO);
    }
    if (IN(PH_PROJ)) {
        for (int rep_ = 0; rep_ < NREP(PH_PROJ); ++rep_) { if (rep_) xcd_barrier(bar);
        { pg8::Gemm g{XN, Wt_in, M, INP, D, 0, 0, 0, 0}; pg8::StaticOrder S; S.init(M, INP, G, bx); pg8::EpiProj E{CQ, CKV, KB, U, partq, partkv, trig};
          pg8::gemm_phase<pg8::EpiProj, pg8::StaticOrder, true, true>(L, g, S, E); }
        { pg8::Gemm g{MEMN, Wt_mkv, BATCH * NMEM, 2048, D, 0, 0, 0, 0}; pg8::StaticOrder S; S.init(BATCH * NMEM, 2048, G, (bx + 128) % G); pg8::EpiPlain E{MEMKV, 2048};
          pg8::gemm_phase<pg8::EpiPlain, pg8::StaticOrder, true, true>(L, g, S, E); }
        }
        SEAM(PH_PROJ);
    }
    if (IN(PH_UP)) {
        for (int rep_ = 0; rep_ < NREP(PH_UP); ++rep_) { if (rep_) xcd_barrier(bar);
        if (IN(PHB_UPG)) {
        { pg8::Gemm g{CQ, Wt_qup, M, 768, 256, 0, 0, 0, 0}; pg8::StaticOrder S; S.init(M, 768, G, bx); pg8::EpiQ E{QB, partq, trig, LOG2E * 0.10206207261596577f};
          pg8::gemm_phase<pg8::EpiQ, pg8::StaticOrder, true, true>(L, g, S, E); }
        { pg8::Gemm g{CKV, Wt_kv, M, 1024, 128, 0, 0, 0, 0}; pg8::StaticOrder S; S.init(M, 1024, G, (bx + 192) % G); pg8::EpiKV E{KB, VB, partkv};
          pg8::gemm_phase<pg8::EpiKV, pg8::StaticOrder, true, true>(L, g, S, E); }
        }
        if (IN(PHB_CONV)) { __syncthreads(); for (int c = vcu; c < M / 64; c += G) conv_chunk(c, U, args.in[8], args.in[9], args.in[10], args.in[11], CONCAT, L); }
        }
        SEAM(PH_UP);
    }
    if (IN(PH_ATTN)) {
        for (int rep_ = 0; rep_ < NREP(PH_ATTN); ++rep_) { if (rep_) xcd_barrier(bar);
        for (int u = vcu; u < 512; u += G) { const int bh = (u & 255) >> 4, sidx = u & 15, qb = u < 256 ? 31 - sidx : sidx, b = bh >> 3, h = bh & 7;
            const size_t r0 = (size_t)b * SEQ;
            if (NREP(PH_ATTN) > 1 && rep_ == 0) attn_unit<96, 64, 1, 4, 3, true, false, PROBE_ATTVAR>(L, QB + (r0 + qb * 256) * 768 + h * 96, 768, KB + r0 * 768 + h * 96, 768, VB + r0 * 512 + h * 64, 512, CONCAT + (r0 + qb * 256) * D + h * 64, D, 4 * qb + 4, 4 * qb);
            else attn_mla_unit(L, QB + (r0 + qb * 256) * 768 + h * 96, KB + r0 * 768 + h * 96, VB + r0 * 512 + h * 64, CONCAT + (r0 + qb * 256) * D + h * 64, 4 * qb + 4, 4 * qb); }
        }
        { bf16* KQT = (bf16*)(ws + WS_KQT); bf16* VOT = (bf16*)(ws + WS_VOT);
#pragma unroll 1
          for (int bh = 0; bh < BATCH * XH; ++bh) { const int b = bh >> 2, h = bh & 3;
            { pg8::Gemm g{MEMKV + (size_t)b * NMEM * 2048 + h * XD, Wt_mq + h * XD, NMEM, D, XD, 2048, D, 0, 0}; pg8::StaticOrder S; S.init(NMEM, D, G, (bx + 8 * bh) % G);
              pg8::EpiPlain E{KQT + (size_t)b * D * D + (size_t)h * XD * D, D}; pg8::gemm_phase<pg8::EpiPlain, pg8::StaticOrder, true, true>(L, g, S, E); }
            { pg8::Gemm g{Wt_mo + h * XD, MEMKV + (size_t)b * NMEM * 2048 + 1024 + h * XD, D, NMEM, XD, D, 2048, 0, 0}; pg8::StaticOrder S; S.init(D, NMEM, G, (bx + 8 * bh + 4) % G);
              pg8::EpiPlain E{VOT + (size_t)b * D * D + h * XD, D}; pg8::gemm_phase<pg8::EpiPlain, pg8::StaticOrder, true, true>(L, g, S, E); } } }
        SEAM(PH_ATTN);
    }
    if (IN(PH_MIX)) {
        for (int rep_ = 0; rep_ < NREP(PH_MIX); ++rep_) { if (rep_) xcd_barrier(bar);
        pg8::Gemm g{CONCAT, Wt_mix, M, D, D, 0, 0, 0, 0}; pg8::StaticOrder S; S.init(M, D, G, bx); pg8::EpiRes<false> E{x, nullptr, H1B, part1};
        pg8::gemm_phase<pg8::EpiRes<false>, pg8::StaticOrder, true, true>(L, g, S, E);
        }
        SEAM(PH_MIX);
    }
    if (IN(PH_MEMQ)) {
        for (int rep_ = 0; rep_ < NREP(PH_MEMQ); ++rep_) { if (rep_) xcd_barrier(bar);
        pg8::Gemm g{H1B, (const bf16*)(ws + WS_KQT), M, D, D, 0, 0, SEQ / 256, (size_t)D * D * 2}; pg8::StaticOrder S; S.init(M, D, G, bx);
        pg8::EpiSoftmaxP E{OM, D, part1, LOG2E / 16.0f, (LAS float*)(L + 131072)};
        pg8::gemm_phase<pg8::EpiSoftmaxP, pg8::StaticOrder, true, true>(L, g, S, E);
        }
        SEAM(PH_MEMQ);
    }
    if (IN(PH_MEMO)) {
        pg8::Gemm g{OM, (const bf16*)(ws + WS_VOT), M, D, D, 0, 0, SEQ / 256, (size_t)D * D * 2};   pg8::StaticOrder S; S.init(M, D, G, bx); pg8::EpiRes<true> E{nullptr, H1B, H2B, part2};
        pg8::gemm_phase<pg8::EpiRes<true>, pg8::StaticOrder, true, true>(L, g, S, E);
        SEAM(PH_MEMO);
    }
    if (IN(PH_PQ)) {
        for (int rep_ = 0; rep_ < NREP(PH_PQ); ++rep_) { if (rep_) xcd_barrier(bar);
        pg8::Gemm g{H2B, Wt_pq, M, 2048, D, 0, 0, 0, 0}; pg8::StaticOrder S; S.init(M, 2048, G, bx); pg8::EpiScaled E{QP, 2048, part2, 1.0f};
        pg8::gemm_phase<pg8::EpiScaled, pg8::StaticOrder, true, true>(L, g, S, E);
        own_writes_visible();
        int* EIDX = (int*)(ws + WS_R2 + R2_EIDX); float* EGATE = (float*)(ws + WS_R2 + R2_EGATE);
        LAS unsigned* scr = (LAS unsigned*)(L + 65536 + wave * 64 * 9 * 4);
        int hl = -1, upm, upn;
        for (int i = 0; unit_of(M, 2048, G, bx, i, upm, upn); ++i) { const int tb = upm, h = upn;
            if (h != hl) {
                __syncthreads();
                for (int pc = tid; pc < 4096; pc += NTHR) { const int p = pc >> 11, n = (pc >> 4) & 127, c = pc & 15;
                    *(LAS pg8::u32x4*)(L + p * 32768 + c * 2048 + n * 16) = *(const pg8::u32x4*)(SK + ((size_t)(h * 2 + p) * 128 + n) * 128 + c * 8); }
                __syncthreads(); hl = h; }
            const int token = tb * 256 + wave * 32 + (lane & 31);
            topk_wave(QP + (size_t)token * 2048 + h * 256, L, scr, EIDX + (size_t)token * 128 + h * 16, EGATE + (size_t)token * 128 + h * 16, lane); }
        __syncthreads();
        }
        SEAM(PH_PQ);
    }
    if (IN(PH_EXP)) {
        const int* EIDX = (const int*)(ws + WS_R2 + R2_EIDX); const float* EGATE = (const float*)(ws + WS_R2 + R2_EGATE);
#ifndef EXP_PREWARM
#define EXP_PREWARM 0
#endif
        if (EXP_PREWARM) {
            const pg8::u32x4* tb = (const pg8::u32x4*)PU; pg8::u32x4 x = {0u, 0u, 0u, 0u};
            for (size_t i = (size_t)vcu * NTHR + tid; i < (size_t)2 * PE * D / 16; i += (size_t)G * NTHR) { const pg8::u32x4 v = __builtin_nontemporal_load(tb + i); x ^= v; }
            if ((x[0] ^ x[1] ^ x[2] ^ x[3]) == 0x9e3779b9u && tid == 999) out[0] = 0.f;
        }
        for (int rep_ = NREP(PH_EXP) - 1; rep_ >= 0; --rep_) { float* dst = rep_ ? (float*)(ws + WS_R3) : out;
            if (rep_) { if (PROBE_EXPVAR != 5 || wave < 4) experts_wave<PROBE_EXPVAR == 5 ? 0 : PROBE_EXPVAR>(L + wave * EXP_LDS_WAVE, vcu * NWAVES + wave, G * NWAVES, H2B, part2, (const unsigned char*)PU, (const unsigned char*)PV, EIDX, EGATE, args.in[23], dst, lane); } else
            experts_wave<0>(L + wave * EXP_LDS_WAVE, vcu * NWAVES + wave, G * NWAVES, H2B, part2, (const unsigned char*)PU, (const unsigned char*)PV, EIDX, EGATE, args.in[23], dst, lane);
            if (rep_) xcd_barrier(bar); }
    }
#undef IN
#undef SEAM
}

#define FAST_MASK ((1u << PH_PRO) | (1u << PH_PROJ) | (1u << PH_UP) | (1u << PHB_UPG) | (1u << PHB_CONV) | (1u << PH_ATTN) | (1u << PH_MIX) | (1u << PH_MEMQ) | (1u << PH_MEMO) | (1u << PH_PQ) | (1u << PH_EXP))
extern "C" void kernel_launch(void* const* d_in, const int* in_sizes, int n_in, void* d_out, int out_size, void* d_ws, size_t ws_size, hipStream_t stream) {
    if (n_in != 24 || out_size != M * D || ws_size < WS_END) { fprintf(stderr, "kernel_launch: unexpected problem (n_in %d out %d ws %zu)\n", n_in, out_size, ws_size); return; }
    static int grid = 0;
    if (grid == 0) {
        int dev = 0, cus = 0, per_cu = 0;
        if (hipGetDevice(&dev) != hipSuccess || hipDeviceGetAttribute(&cus, hipDeviceAttributeMultiprocessorCount, dev) != hipSuccess) { grid = -1; return; }
        if (hipFuncSetAttribute((const void*)mega, hipFuncAttributeMaxDynamicSharedMemorySize, LDS_BYTES) != hipSuccess) { fprintf(stderr, "kernel_launch: hipFuncSetAttribute failed\n"); grid = -1; return; }
        if (hipOccupancyMaxActiveBlocksPerMultiprocessor(&per_cu, (const void*)mega, NTHR, LDS_BYTES) != hipSuccess || per_cu < 1) { fprintf(stderr, "kernel_launch: occupancy query says %d blocks per CU\n", per_cu); grid = -1; (void)hipGetLastError(); return; }
        grid = cus;
    }
    if (grid < 0) return;
    (void)hipMemsetAsync((char*)d_ws + WS_CTL, 0, CTL_ZERO_BYTES, stream);
    Args a{}; for (int i = 0; i < 24; ++i) a.in[i] = (const float*)d_in[i]; a.out = (float*)d_out; a.ws = (unsigned char*)d_ws; a.mask = FAST_MASK; a.li = 0;
    hipLaunchKernelGGL(mega, dim3(grid), dim3(NTHR), LDS_BYTES, stream, a);
}
```

```cpp
#include <hip/hip_runtime.h>
#include <cstdio>
#include <cstdint>

typedef unsigned short bf16;
#define DEVI __device__ __forceinline__

constexpr int D = 1024, BATCH = 2, SEQ = 8192, M = BATCH * SEQ;
constexpr int NMEM = 256;
constexpr int MH = 8, QRANK = 256, KVRANK = 128, NOPE = 64, ROPE = 32, VD = 64, QK = NOPE + ROPE;
constexpr int CW = 512, CK = 31;
constexpr int INC = QRANK + KVRANK + ROPE + 2 * CW;
constexpr int INP = 1536;
constexpr int XH = 4, XD = 256;
constexpr int PH = 8, PNK = 128, PHALF = 128, PTOP = 16, PE = PNK * PNK;
constexpr float EPS = 1e-6f;
constexpr float LOG2E = 1.4426950408889634f;
constexpr float PU_SCALE = 64.0f, PV_SCALE = 4.0f;

constexpr size_t MiB = 1u << 20;
constexpr size_t WS_CTL = 0;
constexpr size_t WS_WIN = 1 * MiB;
constexpr size_t WS_WQUP = 4 * MiB;
constexpr size_t WS_WKV = 5 * MiB;
constexpr size_t WS_WMIX = 6 * MiB;
constexpr size_t WS_WMQ = 8 * MiB;
constexpr size_t WS_WMKV = 10 * MiB;
constexpr size_t WS_WMO = 14 * MiB;
constexpr size_t WS_WPQ = 16 * MiB;
constexpr size_t WS_SK = 20 * MiB;
constexpr size_t WS_MEMN = 21 * MiB;
constexpr size_t WS_MEMKV = 22 * MiB;
constexpr size_t WS_PARTQ = 24 * MiB;
constexpr size_t WS_PARTKV = 24 * MiB + 512 * 1024;
constexpr size_t WS_PART1 = 25 * MiB;
constexpr size_t WS_PART2 = 26 * MiB;
constexpr size_t WS_PU = 28 * MiB;
constexpr size_t WS_PV = 60 * MiB;
constexpr size_t WS_R1 = 92 * MiB;
constexpr size_t WS_R2 = 124 * MiB;
constexpr size_t WS_R3 = 156 * MiB;
constexpr size_t WS_KQT = 220 * MiB;
constexpr size_t WS_VOT = 224 * MiB;
constexpr size_t WS_END = 228 * MiB;
constexpr size_t R2_CQ = 0, R2_CKV = 8 * MiB, R2_U = 12 * MiB;
constexpr size_t R2_EIDX = 0, R2_EGATE = 8 * MiB;
constexpr size_t R3_QB = 0, R3_KB = 24 * MiB, R3_VB = 48 * MiB;

DEVI bf16 f2bf(float f) { unsigned u = __builtin_bit_cast(unsigned, f); return (bf16)((u + 0x7fffu + ((u >> 16) & 1u)) >> 16); }
DEVI float bf2f(bf16 b) { return __builtin_bit_cast(float, (unsigned)b << 16); }
DEVI float dotbf(const bf16* a, const bf16* b, int K) {
    float s = 0.f;
    for (int k = 0; k < K; k += 8) {
        uint4 x = *(const uint4*)(a + k), y = *(const uint4*)(b + k);
        const unsigned xs[4] = {x.x, x.y, x.z, x.w}, ys[4] = {y.x, y.y, y.z, y.w};
#pragma unroll
        for (int i = 0; i < 4; ++i) {
            s += __builtin_bit_cast(float, xs[i] << 16) * __builtin_bit_cast(float, ys[i] << 16);
            s += __builtin_bit_cast(float, xs[i] & 0xffff0000u) * __builtin_bit_cast(float, ys[i] & 0xffff0000u);
        }
    }
    return s;
}
DEVI float wave_sum(float v) {
#pragma unroll
    for (int o = 1; o < 64; o <<= 1) v += __shfl_xor(v, o);
    return v;
}
DEVI float wave_max(float v) {
#pragma unroll
    for (int o = 1; o < 64; o <<= 1) v = fmaxf(v, __shfl_xor(v, o));
    return v;
}
DEVI void rope_cs(int pos, int i, float& c, float& s) {
    const float inv = exp2f(-(float)i * (13.287712379549449f / 16.0f));
    const float ang = (float)pos * inv;
    const double a = (double)ang; const double k = rint(a * 0.15915494309189535); const float r = (float)(a - k * 6.283185307179586);
    s = sinf(r); c = cosf(r);
}
DEVI int win_src(int r) {
    if (r < 416) return r;
    if (r < 512) return -1;
    const int t = (r - 512) >> 8, w = (r - 512) & 255, bj = w >> 7, j = w & 127, ch = 128 * t + j;
    return 416 + (bj ? CW : 0) + ch;
}
DEVI int wkv_src(int r) { return r < 512 ? (r >> 6) * 128 + (r & 63) : ((r - 512) >> 6) * 128 + 64 + ((r - 512) & 63); }

namespace pg8 {
#define PG8_LAS __attribute__((address_space(3)))
typedef unsigned short bf16_t;
typedef short bf16x8 __attribute__((ext_vector_type(8)));
typedef float f32x4 __attribute__((ext_vector_type(4)));
typedef unsigned u32x4 __attribute__((ext_vector_type(4)));
constexpr int BM = 256, BK = 64, HALF = 128, HTB = HALF * BK * 2  , STAGE_BYTES = 8 * HTB, NXCD = 8, WGM = 8;

__host__ __device__ __forceinline__ int lds_byte(int r, int c) { const int st = (r >> 4) * 2 + (c >> 5), rr = r & 15, cc = c & 31, ob = rr * 64 + cc * 2; return st * 1024 + (ob ^ (((ob >> 9) & 1) << 5)); }
__host__ __device__ __forceinline__ void stage_rc(int b, int& R, int& C) { const int st = b / 1024, sb = b % 1024, swz = sb ^ (((sb >> 9) & 1) << 5); R = (st >> 1) * 16 + swz / 64; C = (st & 1) * 32 + (swz % 64) / 2; }
__host__ __device__ __forceinline__ int perm32(int rho) { const int n = rho >> 4, i = rho & 15; return 8 * (i >> 2) + 4 * n + (i & 3); }

struct Unit { int pm, pn; };
struct Gemm { const bf16_t* A; const bf16_t* Bt; int M, N, K; int lda, ldb; int mb; size_t bstride; };

struct StaticOrder {
    int nM, nN, nwg, G, c;
    __host__ __device__ void init(int M, int N, int G_, int c_) { nM = M / BM; nN = N / BM; nwg = nM * nN; G = G_; c = c_; }
    __host__ __device__ bool next(int i, Unit& u) const {
        const long L = (long)i * G + c; if (L >= nwg) return false;
        int wgid = (int)L; { const int q = nwg / NXCD, r = nwg % NXCD, xcd = wgid % NXCD, off = wgid / NXCD; wgid = (xcd < r ? xcd * (q + 1) : r * (q + 1) + (xcd - r) * q) + off; }
        const int nig = WGM * nN, gid = wgid / nig, fm = gid * WGM, gsz = (nM - fm) < WGM ? (nM - fm) : WGM;
        u.pm = fm + ((wgid % nig) % gsz); u.pn = (wgid % nig) / gsz; return true;
    }
    __device__ __forceinline__ void a_ready(const Unit&) const {}
    __device__ __forceinline__ void done(const Unit&) const {}
};


typedef float f32x2 __attribute__((ext_vector_type(2)));
typedef unsigned u32x2 __attribute__((ext_vector_type(2)));
__device__ __forceinline__ unsigned cvt_pk_bf16(float lo, float hi) { unsigned r; asm volatile("v_cvt_pk_bf16_f32 %0, %1, %2" : "=v"(r) : "v"(lo), "v"(hi)); return r; }
__device__ __forceinline__ void st_bf4(bf16_t* p, f32x4 v) { u32x2 w; w.x = cvt_pk_bf16(v[0], v[1]); w.y = cvt_pk_bf16(v[2], v[3]); *(u32x2*)p = w; }
__device__ __forceinline__ float sq4(f32x4 v) { return (v[0] * v[0] + v[1] * v[1]) + (v[2] * v[2] + v[3] * v[3]); }
__device__ __forceinline__ float red_fq(float s) { s += __shfl_xor(s, 16); s += __shfl_xor(s, 32); return s; }

struct EpiProj {
    static constexpr bool PERM = false, AFTER_DRAIN = false;
    bf16_t *CQ, *CKV, *KB, *U; float *partq, *partkv; const float* trig;
    __device__ __forceinline__ void operator()(const f32x4 (&acc)[2][2][4][2], const Unit& u, int wr, int wc, int fr, int fq) const {
        const int row0 = u.pm * BM + wr * 64 + fr;
        if (u.pn == 0) {
#pragma unroll
            for (int ai = 0; ai < 2; ++ai)
#pragma unroll
                for (int m = 0; m < 4; ++m) { const int row = row0 + ai * HALF + m * 16; float s = 0.f;
#pragma unroll
                    for (int bj = 0; bj < 2; ++bj)
#pragma unroll
                        for (int n = 0; n < 2; ++n) { const f32x4 v = acc[ai][bj][m][n]; s += sq4(v); st_bf4(CQ + (size_t)row * 256 + bj * HALF + wc * 32 + n * 16 + fq * 4, v); }
                    s = red_fq(s); if (fq == 0) partq[(size_t)row * 4 + wc] = s; }
        } else if (u.pn == 1) {
            f32x4 tc0 = {0.f, 0.f, 0.f, 0.f}, tc1 = tc0, tn0 = tc0, tn1 = tc0;
            if (wc == 0) { const float* tp = trig + ((size_t)(row0 % SEQ) * 16 + fq * 4) * 2; tc0 = *(const f32x4*)tp; tc1 = *(const f32x4*)(tp + 4); }
#pragma unroll
            for (int i8 = 0; i8 < 8; ++i8) { const int ai = i8 >> 2, m = i8 & 3; const int row = row0 + ai * HALF + m * 16; float s = 0.f;
                if (wc == 0 && i8 < 7) { const int rown = row0 + ((i8 + 1) >> 2) * HALF + ((i8 + 1) & 3) * 16; const float* tp = trig + ((size_t)(rown % SEQ) * 16 + fq * 4) * 2; tn0 = *(const f32x4*)tp; tn1 = *(const f32x4*)(tp + 4); }
#pragma unroll
                for (int n = 0; n < 2; ++n) { const f32x4 v = acc[ai][0][m][n]; s += sq4(v); st_bf4(CKV + (size_t)row * 128 + wc * 32 + n * 16 + fq * 4, v); }
                s = red_fq(s); if (fq == 0) partkv[(size_t)row * 4 + wc] = s;
                if (wc == 0) { const f32x4 x1 = acc[ai][1][m][0], x2 = acc[ai][1][m][1]; const f32x4 t0 = tc0, t1 = tc1;
                    f32x4 o1, o2; o1[0] = x1[0] * t0[0] - x2[0] * t0[1]; o2[0] = x1[0] * t0[1] + x2[0] * t0[0]; o1[1] = x1[1] * t0[2] - x2[1] * t0[3]; o2[1] = x1[1] * t0[3] + x2[1] * t0[2];
                    o1[2] = x1[2] * t1[0] - x2[2] * t1[1]; o2[2] = x1[2] * t1[1] + x2[2] * t1[0]; o1[3] = x1[3] * t1[2] - x2[3] * t1[3]; o2[3] = x1[3] * t1[3] + x2[3] * t1[2];
                    u32x2 w1, w2; w1.x = cvt_pk_bf16(o1[0], o1[1]); w1.y = cvt_pk_bf16(o1[2], o1[3]); w2.x = cvt_pk_bf16(o2[0], o2[1]); w2.y = cvt_pk_bf16(o2[2], o2[3]);
#pragma unroll
                    for (int h = 0; h < 8; ++h) { *(u32x2*)(KB + (size_t)row * 768 + h * 96 + 64 + fq * 4) = w1; *(u32x2*)(KB + (size_t)row * 768 + h * 96 + 80 + fq * 4) = w2; } }
                tc0 = tn0; tc1 = tn1; asm volatile("" ::: "memory"); }
        } else {
            const int t = u.pn - 2;
#pragma unroll
            for (int ai = 0; ai < 2; ++ai)
#pragma unroll
                for (int m = 0; m < 4; ++m) { const int row = row0 + ai * HALF + m * 16;
#pragma unroll
                    for (int n = 0; n < 2; ++n) { const f32x4 val = acc[ai][0][m][n], gate = acc[ai][1][m][n]; f32x4 o;
#pragma unroll
                        for (int i = 0; i < 4; ++i) o[i] = val[i] * __builtin_amdgcn_rcpf(1.f + __expf(-gate[i]));
                        st_bf4(U + (size_t)row * 512 + t * 128 + wc * 32 + n * 16 + fq * 4, o); } }
        }
    }
};
struct EpiQ {
    static constexpr bool PERM = false, AFTER_DRAIN = false;
    bf16_t* QB; const float* partq; const float* trig; float c2;
    __device__ __forceinline__ void operator()(const f32x4 (&acc)[2][2][4][2], const Unit& u, int wr, int wc, int fr, int fq) const {
        const int row0 = u.pm * BM + wr * 64 + fr;
        const bool rope = ((u.pn * 8 + wc) % 3 == 2) || ((u.pn * 8 + 4 + wc) % 3 == 2);
        f32x4 ppc = *(const f32x4*)(partq + (size_t)row0 * 4), ppn = ppc;
        f32x4 tc0 = {0.f, 0.f, 0.f, 0.f}, tc1 = tc0, tn0 = tc0, tn1 = tc0;
        if (rope) { const float* tp = trig + ((size_t)(row0 % SEQ) * 16 + fq * 4) * 2; tc0 = *(const f32x4*)tp; tc1 = *(const f32x4*)(tp + 4); }
#pragma unroll
        for (int i8 = 0; i8 < 8; ++i8) { const int ai = i8 >> 2, m = i8 & 3; const int row = row0 + ai * HALF + m * 16;
            if (i8 < 7) { const int rown = row0 + ((i8 + 1) >> 2) * HALF + ((i8 + 1) & 3) * 16; ppn = *(const f32x4*)(partq + (size_t)rown * 4);
                if (rope) { const float* tp = trig + ((size_t)(rown % SEQ) * 16 + fq * 4) * 2; tn0 = *(const f32x4*)tp; tn1 = *(const f32x4*)(tp + 4); } }
            const float rs = rsqrtf(((ppc[0] + ppc[1]) + (ppc[2] + ppc[3])) * (1.f / 256.f) + EPS) * c2;
#pragma unroll
            for (int bj = 0; bj < 2; ++bj) { const int g = u.pn * 8 + bj * 4 + wc; bf16_t* dst = QB + (size_t)row * 768 + g * 32 + fq * 4;
                if (g % 3 != 2) { st_bf4(dst, acc[ai][bj][m][0] * rs); st_bf4(dst + 16, acc[ai][bj][m][1] * rs); }
                else { const f32x4 x1 = acc[ai][bj][m][0] * rs, x2 = acc[ai][bj][m][1] * rs; const f32x4 t0 = tc0, t1 = tc1;
                    f32x4 o1, o2; o1[0] = x1[0] * t0[0] - x2[0] * t0[1]; o2[0] = x1[0] * t0[1] + x2[0] * t0[0]; o1[1] = x1[1] * t0[2] - x2[1] * t0[3]; o2[1] = x1[1] * t0[3] + x2[1] * t0[2];
                    o1[2] = x1[2] * t1[0] - x2[2] * t1[1]; o2[2] = x1[2] * t1[1] + x2[2] * t1[0]; o1[3] = x1[3] * t1[2] - x2[3] * t1[3]; o2[3] = x1[3] * t1[3] + x2[3] * t1[2];
                    st_bf4(dst, o1); st_bf4(dst + 16, o2); } }
            ppc = ppn; tc0 = tn0; tc1 = tn1; asm volatile("" ::: "memory"); }
    }
};
struct EpiKV {
    static constexpr bool PERM = false, AFTER_DRAIN = false;
    bf16_t *KB, *VB; const float* partkv;
    __device__ __forceinline__ void operator()(const f32x4 (&acc)[2][2][4][2], const Unit& u, int wr, int wc, int fr, int fq) const {
        const int row0 = u.pm * BM + wr * 64 + fr;
        f32x4 ppc = *(const f32x4*)(partkv + (size_t)row0 * 4), ppn = ppc;
#pragma unroll
        for (int i8 = 0; i8 < 8; ++i8) { const int ai = i8 >> 2, m = i8 & 3; const int row = row0 + ai * HALF + m * 16;
            if (i8 < 7) { const int rown = row0 + ((i8 + 1) >> 2) * HALF + ((i8 + 1) & 3) * 16; ppn = *(const f32x4*)(partkv + (size_t)rown * 4); }
            const float rs = rsqrtf(((ppc[0] + ppc[1]) + (ppc[2] + ppc[3])) * (1.f / 128.f) + EPS);
#pragma unroll
            for (int bj = 0; bj < 2; ++bj)
#pragma unroll
                for (int n = 0; n < 2; ++n) { const int c = u.pn * BM + bj * HALF + wc * 32 + n * 16 + fq * 4; const f32x4 v = acc[ai][bj][m][n] * rs;
                    if (u.pn < 2) st_bf4(KB + (size_t)row * 768 + (c >> 6) * 96 + (c & 63), v); else st_bf4(VB + (size_t)row * 512 + (c - 512), v); }
            ppc = ppn; asm volatile("" ::: "memory"); }
    }
};
template <bool BF16RES> struct EpiRes {
    static constexpr bool PERM = false, AFTER_DRAIN = false;
    const float* res; const bf16_t* resb; bf16_t* outb; float* part;
    __device__ __forceinline__ f32x4 ldres(size_t off) const {
        if (BF16RES) { const u32x2 rb = *(const u32x2*)(resb + off); f32x4 r; r[0] = __builtin_bit_cast(float, rb.x << 16); r[1] = __builtin_bit_cast(float, rb.x & 0xffff0000u); r[2] = __builtin_bit_cast(float, rb.y << 16); r[3] = __builtin_bit_cast(float, rb.y & 0xffff0000u); return r; }
        return *(const f32x4*)(res + off); }
    __device__ __forceinline__ void operator()(const f32x4 (&acc)[2][2][4][2], const Unit& u, int wr, int wc, int fr, int fq) const {
        const int row0 = u.pm * BM + wr * 64 + fr; const int cb = u.pn * BM + wc * 32 + fq * 4;
        f32x4 rc[4], rn[4];
#pragma unroll
        for (int j = 0; j < 4; ++j) { rc[j] = ldres((size_t)row0 * 1024 + cb + (j >> 1) * HALF + (j & 1) * 16); rn[j] = rc[j]; }
#pragma unroll
        for (int i8 = 0; i8 < 8; ++i8) { const int ai = i8 >> 2, m = i8 & 3; const int row = row0 + ai * HALF + m * 16; float s = 0.f;
            if (i8 < 7) { const int rown = row0 + ((i8 + 1) >> 2) * HALF + ((i8 + 1) & 3) * 16;
#pragma unroll
                for (int j = 0; j < 4; ++j) rn[j] = ldres((size_t)rown * 1024 + cb + (j >> 1) * HALF + (j & 1) * 16); }
#pragma unroll
            for (int bj = 0; bj < 2; ++bj)
#pragma unroll
                for (int n = 0; n < 2; ++n) { const size_t off = (size_t)row * 1024 + cb + bj * HALF + n * 16;
                    const f32x4 v = acc[ai][bj][m][n] + rc[bj * 2 + n]; st_bf4(outb + off, v); s += sq4(v); }
            s = red_fq(s); if (fq == 0) part[(size_t)row * 16 + u.pn * 4 + wc] = s;
#pragma unroll
            for (int j = 0; j < 4; ++j) rc[j] = rn[j];
            asm volatile("" ::: "memory"); }
    }
};
struct EpiScaled {
    static constexpr bool PERM = false, AFTER_DRAIN = false;
    bf16_t* out; int ldc; const float* part; float mul;
    __device__ __forceinline__ void operator()(const f32x4 (&acc)[2][2][4][2], const Unit& u, int wr, int wc, int fr, int fq) const {
        const int row0 = u.pm * BM + wr * 64 + fr;
        float rs8[8];
#pragma unroll
        for (int hb = 0; hb < 2; ++hb) { f32x4 q[4][4];
#pragma unroll
            for (int k = 0; k < 4; ++k) { const int row = row0 + hb * HALF + k * 16; const f32x4* pp = (const f32x4*)(part + (size_t)row * 16);
#pragma unroll
                for (int j = 0; j < 4; ++j) q[k][j] = pp[j]; }
#pragma unroll
            for (int k = 0; k < 4; ++k) { const f32x4 a = q[k][0], b = q[k][1], c = q[k][2], d = q[k][3];
                const float ss = (((a[0] + a[1]) + (a[2] + a[3])) + ((b[0] + b[1]) + (b[2] + b[3]))) + (((c[0] + c[1]) + (c[2] + c[3])) + ((d[0] + d[1]) + (d[2] + d[3])));
                rs8[hb * 4 + k] = rsqrtf(ss * (1.f / 1024.f) + EPS) * mul; } }
#pragma unroll
        for (int i8 = 0; i8 < 8; ++i8) { const int ai = i8 >> 2, m = i8 & 3; const int row = row0 + ai * HALF + m * 16; const float rs = rs8[i8];
#pragma unroll
            for (int bj = 0; bj < 2; ++bj)
#pragma unroll
                for (int n = 0; n < 2; ++n) st_bf4(out + (size_t)row * ldc + u.pn * BM + bj * HALF + wc * 32 + n * 16 + fq * 4, acc[ai][bj][m][n] * rs);
            asm volatile("" ::: "memory"); }
    }
};
struct EpiSoftmaxP {
    static constexpr bool PERM = false, AFTER_DRAIN = false;
    bf16_t* out; int ldc; const float* part; float mul; PG8_LAS float* scr;
    __device__ __forceinline__ float rscale(int row) const { const f32x4* pp = (const f32x4*)(part + (size_t)row * 16); const f32x4 a = pp[0], b = pp[1], c = pp[2], d = pp[3];
        const float ss = (((a[0] + a[1]) + (a[2] + a[3])) + ((b[0] + b[1]) + (b[2] + b[3]))) + (((c[0] + c[1]) + (c[2] + c[3])) + ((d[0] + d[1]) + (d[2] + d[3]))); return rsqrtf(ss * (1.f / 1024.f) + EPS) * mul; }
    __device__ __forceinline__ void operator()(const f32x4 (&acc)[2][2][4][2], const Unit& u, int wr, int wc, int fr, int fq) const {
        PG8_LAS float* P1 = scr; PG8_LAS float* P2 = scr + 1024; float rs8[8];
#define EPS_BAR() do { asm volatile("s_waitcnt lgkmcnt(0)" ::: "memory"); __builtin_amdgcn_s_barrier(); asm volatile("" ::: "memory"); } while (0)
#pragma unroll
        for (int ai = 0; ai < 2; ++ai)
#pragma unroll
            for (int m = 0; m < 4; ++m) { float mx = -3.0e38f;
#pragma unroll
                for (int bj = 0; bj < 2; ++bj)
#pragma unroll
                    for (int n = 0; n < 2; ++n) { const f32x4 v = acc[ai][bj][m][n]; mx = fmaxf(mx, fmaxf(fmaxf(v[0], v[1]), fmaxf(v[2], v[3]))); }
                mx = fmaxf(mx, __shfl_xor(mx, 16)); mx = fmaxf(mx, __shfl_xor(mx, 32));
                if (fq == 0) P1[(ai * HALF + wr * 64 + m * 16 + fr) * 4 + wc] = mx; }
        EPS_BAR();
#pragma unroll
        for (int ai = 0; ai < 2; ++ai)
#pragma unroll
            for (int m = 0; m < 4; ++m) { const int rl = ai * HALF + wr * 64 + m * 16 + fr; const f32x4 q = *(const PG8_LAS f32x4*)(P1 + rl * 4);
                const float mx = fmaxf(fmaxf(q[0], q[1]), fmaxf(q[2], q[3])), rs = rscale(u.pm * BM + rl); float sm = 0.f; rs8[ai * 4 + m] = rs;
#pragma unroll
                for (int bj = 0; bj < 2; ++bj)
#pragma unroll
                    for (int n = 0; n < 2; ++n) { const f32x4 v = acc[ai][bj][m][n];
#pragma unroll
                        for (int i = 0; i < 4; ++i) sm += __builtin_amdgcn_exp2f((v[i] - mx) * rs); }
                sm += __shfl_xor(sm, 16); sm += __shfl_xor(sm, 32);
                if (fq == 0) P2[rl * 4 + wc] = sm; asm volatile("" ::: "memory"); }
        EPS_BAR();
#pragma unroll
        for (int ai = 0; ai < 2; ++ai)
#pragma unroll
            for (int m = 0; m < 4; ++m) { const int rl = ai * HALF + wr * 64 + m * 16 + fr; const f32x4 q = *(const PG8_LAS f32x4*)(P1 + rl * 4), w = *(const PG8_LAS f32x4*)(P2 + rl * 4);
                const float mx = fmaxf(fmaxf(q[0], q[1]), fmaxf(q[2], q[3])), rs = rs8[ai * 4 + m], inv = 1.0f / ((w[0] + w[1]) + (w[2] + w[3]));
#pragma unroll
                for (int bj = 0; bj < 2; ++bj)
#pragma unroll
                    for (int n = 0; n < 2; ++n) { const f32x4 v = acc[ai][bj][m][n]; f32x4 o;
#pragma unroll
                        for (int i = 0; i < 4; ++i) o[i] = __builtin_amdgcn_exp2f((v[i] - mx) * rs) * inv;
                        st_bf4(out + (size_t)(u.pm * BM + rl) * ldc + u.pn * BM + bj * HALF + wc * 32 + n * 16 + fq * 4, o); }
                asm volatile("" ::: "memory"); }
        EPS_BAR();
#undef EPS_BAR
    }
};
struct EpiPlain {
    static constexpr bool PERM = false, AFTER_DRAIN = false;
    bf16_t* out; int ldc;
    __device__ __forceinline__ void operator()(const f32x4 (&acc)[2][2][4][2], const Unit& u, int wr, int wc, int fr, int fq) const {
        const int row0 = u.pm * BM + wr * 64 + fr;
#pragma unroll
        for (int ai = 0; ai < 2; ++ai)
#pragma unroll
            for (int m = 0; m < 4; ++m) { const int row = row0 + ai * HALF + m * 16;
#pragma unroll
                for (int bj = 0; bj < 2; ++bj)
#pragma unroll
                    for (int n = 0; n < 2; ++n) st_bf4(out + (size_t)row * ldc + u.pn * BM + bj * HALF + wc * 32 + n * 16 + fq * 4, acc[ai][bj][m][n]); }
    }
};
template <class Epi, class Sched, bool ALIGN_EPI = false, bool SP2 = false>
__device__ __forceinline__ void gemm_phase(PG8_LAS unsigned char* lds, const Gemm g, const Sched& S, const Epi& E) {
    int tid_ = threadIdx.x; asm volatile("" : "+v"(tid_));
    const int tid = tid_, wid = __builtin_amdgcn_readfirstlane(tid >> 6), lane = tid & 63, wr = wid >> 2, wc = wid & 3, fr = lane & 15, fq = lane >> 4;
    const int K = g.K, nt = K / BK, lda = g.lda ? g.lda : K, ldb = g.ldb ? g.ldb : K;
#define PG8_BOFF(pm_) (g.mb ? (size_t)((pm_) / g.mb) * g.bstride : (size_t)0)
    unsigned voffA[2], voffB[2];
#pragma unroll
    for (int i = 0; i < 2; ++i) { int R, C; stage_rc(tid * 16 + i * 8192, R, C); const int Rb = Epi::PERM ? ((R & ~31) + perm32(R & 31)) : R;
        voffA[i] = (unsigned)(R * lda + C) * 2u; voffB[i] = (unsigned)(Rb * ldb + C) * 2u; }
    const size_t kstep = (size_t)(BK * 2);
    const size_t hstepA = (size_t)HALF * lda * 2, hstepB = (size_t)HALF * ldb * 2;
    const size_t tstepA = 2 * hstepA, tstepB = 2 * hstepB;
    const unsigned ldsw = (unsigned)wid * 1024u;
    const int aoff = lds_byte(wr * 64 + fr, fq * 8), boff = lds_byte(wc * 32 + fr, fq * 8);
#define PG8_SA(b, h) (((b) * 2 + (h)) * HTB)
#define PG8_SB(b, h) ((4 + (b) * 2 + (h)) * HTB)
#define PG8_STAGE(bufoff, gbase, voff) do { _Pragma("unroll") for (int _i = 0; _i < 2; ++_i) \
        __builtin_amdgcn_global_load_lds((const unsigned*)((const char*)(gbase) + (voff)[_i]), (PG8_LAS unsigned*)(lds + (bufoff) + ldsw + _i * 8192), 16, 0, 0); } while (0)
#define PG8_LDA(dst, b, h) do { _Pragma("unroll") for (int m = 0; m < 4; ++m) _Pragma("unroll") for (int k = 0; k < 2; ++k) dst[m][k] = *(const PG8_LAS bf16x8*)(lds + PG8_SA(b, h) + aoff + m * 2048 + k * 1024); } while (0)
#define PG8_LDB(dst, b, h) do { _Pragma("unroll") for (int n = 0; n < 2; ++n) _Pragma("unroll") for (int k = 0; k < 2; ++k) dst[n][k] = *(const PG8_LAS bf16x8*)(lds + PG8_SB(b, h) + boff + n * 2048 + k * 1024); } while (0)
#define PG8_MMA(ai, bj, At, Bt) do { __builtin_amdgcn_s_setprio(1); _Pragma("unroll") for (int m = 0; m < 4; ++m) _Pragma("unroll") for (int n = 0; n < 2; ++n) _Pragma("unroll") for (int k = 0; k < 2; ++k) \
        acc[ai][bj][m][n] = __builtin_amdgcn_mfma_f32_16x16x32_bf16(Bt[n][k], At[m][k], acc[ai][bj][m][n], 0, 0, 0); __builtin_amdgcn_s_setprio(0); } while (0)
#define PG8_WAIT_V(n) asm volatile("s_waitcnt vmcnt(" #n ")" ::: "memory")
#define PG8_WAIT_L(n) asm volatile("s_waitcnt lgkmcnt(" #n ")" ::: "memory")
#define PG8_BAR __builtin_amdgcn_s_barrier()
#define PG8_SCHED __builtin_amdgcn_sched_barrier(0)
    Unit cur, nxt; int ui = 0;
    if (!S.next(0, cur)) return;
    f32x4 acc[2][2][4][2];
#pragma unroll
    for (int a = 0; a < 2; ++a)
#pragma unroll
        for (int b = 0; b < 2; ++b)
#pragma unroll
            for (int m = 0; m < 4; ++m)
#pragma unroll
                for (int n = 0; n < 2; ++n) acc[a][b][m][n] = (f32x4){0.f, 0.f, 0.f, 0.f};
    bf16x8 At[4][2], B0[2][2], B1[2][2];
    const char* cA = (const char*)g.A + (size_t)cur.pm * tstepA; const char* cB = (const char*)g.Bt + (size_t)cur.pn * tstepB + PG8_BOFF(cur.pm);
    S.a_ready(cur);
    if constexpr (SP2) {
        PG8_STAGE(PG8_SB(0, 0), cB, voffB); PG8_STAGE(PG8_SB(0, 1), cB + hstepB, voffB); PG8_STAGE(PG8_SA(0, 0), cA, voffA); PG8_STAGE(PG8_SA(0, 1), cA + hstepA, voffA);
        if (wr == 1) PG8_BAR;
        PG8_WAIT_V(2); PG8_BAR;
        PG8_STAGE(PG8_SB(1, 0), cB + kstep, voffB); PG8_STAGE(PG8_SA(1, 0), cA + kstep, voffA); PG8_STAGE(PG8_SB(1, 1), cB + hstepB + kstep, voffB);
        PG8_WAIT_V(6); PG8_BAR;
    } else {
        PG8_STAGE(PG8_SB(0, 0), cB, voffB); PG8_STAGE(PG8_SA(0, 0), cA, voffA); PG8_STAGE(PG8_SB(0, 1), cB + hstepB, voffB); PG8_STAGE(PG8_SA(0, 1), cA + hstepA, voffA);
        if (wr == 1) PG8_BAR;
        PG8_WAIT_V(4); PG8_BAR;
        PG8_STAGE(PG8_SB(1, 0), cB + kstep, voffB); PG8_STAGE(PG8_SA(1, 0), cA + kstep, voffA); PG8_STAGE(PG8_SB(1, 1), cB + hstepB + kstep, voffB);
        PG8_WAIT_V(6); PG8_BAR;
    }
    for (;;) {
        const bool has_next = S.next(ui + 1, nxt);
        const char* nA = has_next ? (const char*)g.A + (size_t)nxt.pm * tstepA : cA; const char* nB = has_next ? (const char*)g.Bt + (size_t)nxt.pn * tstepB + PG8_BOFF(nxt.pm) : cB;
        for (int t = 0; t < nt; t += 2) {
            const bool last = (t == nt - 2);
            const char* a1 = cA + (size_t)(t + 1) * kstep;
            const char* a2 = last ? nA : cA + (size_t)(t + 2) * kstep; const char* b2 = last ? nB : cB + (size_t)(t + 2) * kstep;
            const char* a3 = a2 + kstep; const char* b3 = b2 + kstep;
            if (last && has_next) S.a_ready(nxt);
            if constexpr (SP2) {
            PG8_LDB(B0, 0, 0); PG8_LDB(B1, 0, 1); PG8_SCHED; PG8_LDA(At, 0, 0); PG8_STAGE(PG8_SA(1, 1), a1 + hstepA, voffA);
            PG8_WAIT_V(8); PG8_WAIT_L(0); PG8_BAR; PG8_MMA(0, 0, At, B0); PG8_MMA(0, 1, At, B1); PG8_BAR; PG8_SCHED;
            PG8_LDA(At, 0, 1); PG8_STAGE(PG8_SB(0, 0), b2, voffB); PG8_STAGE(PG8_SB(0, 1), b2 + hstepB, voffB); PG8_STAGE(PG8_SA(0, 0), a2, voffA);
            PG8_WAIT_V(8); PG8_WAIT_L(0); PG8_BAR; PG8_MMA(1, 0, At, B0); PG8_MMA(1, 1, At, B1); PG8_BAR; PG8_SCHED;
            PG8_LDB(B0, 1, 0); PG8_LDB(B1, 1, 1); PG8_SCHED; PG8_LDA(At, 1, 0); PG8_STAGE(PG8_SA(0, 1), a2 + hstepA, voffA);
            PG8_WAIT_V(8); PG8_WAIT_L(0); PG8_BAR; PG8_MMA(0, 0, At, B0); PG8_MMA(0, 1, At, B1); PG8_BAR; PG8_SCHED;
            PG8_LDA(At, 1, 1); PG8_STAGE(PG8_SB(1, 0), b3, voffB); PG8_STAGE(PG8_SB(1, 1), b3 + hstepB, voffB); PG8_STAGE(PG8_SA(1, 0), a3, voffA);
            PG8_WAIT_V(8); PG8_WAIT_L(0); PG8_BAR; PG8_MMA(1, 0, At, B0); PG8_MMA(1, 1, At, B1); PG8_BAR; PG8_SCHED;
            } else {
            PG8_LDB(B0, 0, 0); PG8_SCHED; PG8_LDA(At, 0, 0); PG8_STAGE(PG8_SA(1, 1), a1 + hstepA, voffA);
            PG8_WAIT_L(8); PG8_BAR; PG8_WAIT_L(0); PG8_MMA(0, 0, At, B0); PG8_BAR; PG8_SCHED;
            PG8_LDB(B1, 0, 1); PG8_STAGE(PG8_SB(0, 0), b2, voffB);
            PG8_BAR; PG8_WAIT_L(0); PG8_MMA(0, 1, At, B1); PG8_BAR;
            PG8_LDA(At, 0, 1); PG8_STAGE(PG8_SA(0, 0), a2, voffA);
            PG8_BAR; PG8_WAIT_L(0); PG8_MMA(1, 0, At, B0); PG8_BAR; PG8_SCHED;
            PG8_STAGE(PG8_SB(0, 1), b2 + hstepB, voffB);
            PG8_WAIT_V(6); PG8_BAR; PG8_MMA(1, 1, At, B1); PG8_BAR;
            PG8_LDB(B0, 1, 0); PG8_SCHED; PG8_LDA(At, 1, 0); PG8_STAGE(PG8_SA(0, 1), a2 + hstepA, voffA);
            PG8_WAIT_L(8); PG8_BAR; PG8_WAIT_L(0); PG8_MMA(0, 0, At, B0); PG8_BAR; PG8_SCHED;
            PG8_LDB(B1, 1, 1); PG8_STAGE(PG8_SB(1, 0), b3, voffB);
            PG8_BAR; PG8_WAIT_L(0); PG8_MMA(0, 1, At, B1); PG8_BAR;
            PG8_LDA(At, 1, 1); PG8_STAGE(PG8_SA(1, 0), a3, voffA);
            PG8_BAR; PG8_WAIT_L(0); PG8_MMA(1, 0, At, B0); PG8_BAR; PG8_SCHED;
            PG8_STAGE(PG8_SB(1, 1), b3 + hstepB, voffB);
            PG8_WAIT_V(6); PG8_BAR; PG8_MMA(1, 1, At, B1); PG8_BAR;
            }
        }
        if constexpr (ALIGN_EPI) { if (wr == 0) PG8_BAR; }
        if constexpr (!Epi::AFTER_DRAIN) { E(acc, cur, wr, wc, fr, fq); S.done(cur); }
        if (!has_next) break;
#pragma unroll
        for (int a = 0; a < 2; ++a)
#pragma unroll
            for (int b = 0; b < 2; ++b)
#pragma unroll
                for (int m = 0; m < 4; ++m)
#pragma unroll
                    for (int n = 0; n < 2; ++n) acc[a][b][m][n] = (f32x4){0.f, 0.f, 0.f, 0.f};
        cur = nxt; cA = nA; cB = nB; ++ui;
        if constexpr (ALIGN_EPI) { if (wr == 1) PG8_BAR; }
    }
    PG8_WAIT_V(0);
    if constexpr (!ALIGN_EPI) { if (wr == 0) PG8_BAR; }
    PG8_BAR;
    if constexpr (Epi::AFTER_DRAIN) { E.fused(acc, cur, wr, wc, fr, fq, lds, wid, lane); S.done(cur); }
#undef PG8_BOFF
#undef PG8_SA
#undef PG8_SB
#undef PG8_STAGE
#undef PG8_LDA
#undef PG8_LDB
#undef PG8_MMA
#undef PG8_WAIT_V
#undef PG8_WAIT_L
#undef PG8_BAR
#undef PG8_SCHED
}
}

#define GAS __attribute__((address_space(1)))
#define LAS __attribute__((address_space(3)))
typedef GAS unsigned gu32;
#define LDS_WAIT() asm volatile("s_waitcnt lgkmcnt(0)" ::: "memory")
#define VM_WAIT() asm volatile("s_waitcnt vmcnt(0)" ::: "memory")
constexpr int NWAVES = 8, NTHR = NWAVES * 64;
constexpr int LDSCTL_OFF = 0, PH_BASE = 512, LDS_BYTES = 147456;
constexpr int CW_BAR = 4096;
constexpr size_t CTL_ZERO_BYTES = 256 * 1024;
constexpr size_t WS_TRIG = 27 * MiB;
#define XB_TMO      128
#define XB_XCNT(j)  (256  + 64 * (j))
#define XB_XSUB(j)  (1280 + 64 * (j))
#define XB_XGEN(j)  (2304 + 64 * (j))
#define XB_TOP      3328
#define XB_TOPGEN   3392
#define XCD_BAR_WORDS 3456
#define XB_SPIN_CAP (1u << 18)

__device__ __forceinline__ unsigned xb_ld(unsigned* p)              { return __hip_atomic_load(p, __ATOMIC_RELAXED, __HIP_MEMORY_SCOPE_AGENT); }
__device__ __forceinline__ unsigned xb_add(unsigned* p, unsigned v) { return __hip_atomic_fetch_add(p, v, __ATOMIC_RELAXED, __HIP_MEMORY_SCOPE_AGENT); }
__device__ __forceinline__ unsigned xb_xcc_id() { return (unsigned)__builtin_amdgcn_s_getreg((3 << 11) | 20) & 0xFu; }
#define XB_SPIN(cond, bar) do { unsigned _sp = 0; while (cond) { __builtin_amdgcn_s_sleep(1); \
    if ((++_sp & 255u) == 0u) { if (xb_ld(&(bar)[XB_TMO])) break; if (_sp > XB_SPIN_CAP) { atomicAdd(&(bar)[XB_TMO], 1u); break; } } } } while (0)

struct XcdBarrier {
    unsigned* bar; unsigned x;
    volatile LAS unsigned* st;
};

__device__ __forceinline__ XcdBarrier xcd_barrier_post(unsigned* bar, volatile LAS unsigned* st) {
    XcdBarrier b; b.bar = bar; b.x = xb_xcc_id(); b.st = st;
    if (threadIdx.x == 0) (void)xb_add(&bar[XB_XCNT(b.x)], 1u);
    return b;
}
__device__ __forceinline__ void xcd_barrier_complete(unsigned* bar, unsigned x, unsigned& nloc, unsigned& nx) {
    const unsigned G = gridDim.x * gridDim.y * gridDim.z;
    unsigned sum, cnt, mine, sp = 0u;
    for (;;) {
        sum = 0u; cnt = 0u; mine = 0u;
#pragma unroll
        for (unsigned j = 0; j < 16; ++j) { const unsigned c = xb_ld(&bar[XB_XCNT(j)]); sum += c; cnt += (c > 0u) ? 1u : 0u; mine = (j == x) ? c : mine; }
        if (sum == G) break;
        __builtin_amdgcn_s_sleep(1);
        if ((++sp & 255u) == 0u) { if (xb_ld(&bar[XB_TMO])) break; if (sp > XB_SPIN_CAP) { atomicAdd(&bar[XB_TMO], 1u); break; } }
    }
    nloc = mine > 0u ? mine : 1u; nx = cnt > 0u ? cnt : 1u;
}

__device__ __forceinline__ void xcd_barrier(const XcdBarrier& b) {
    asm volatile("s_waitcnt vmcnt(0)" ::: "memory");
    __syncthreads();
    if (threadIdx.x == 0) {
        unsigned* bar = b.bar;
        __builtin_amdgcn_s_waitcnt(0);
        unsigned nloc = b.st[0], nx = b.st[1];
        if (nloc == 0u) { xcd_barrier_complete(bar, b.x, nloc, nx); b.st[0] = nloc; b.st[1] = nx; }
        const unsigned old = xb_add(&bar[XB_XSUB(b.x)], 1u);
        const unsigned gen = old / nloc;
        if (old + 1u == (gen + 1u) * nloc) {
            __builtin_amdgcn_fence(__ATOMIC_RELEASE, "agent");
            asm volatile("s_waitcnt vmcnt(0)" ::: "memory");
            const unsigned og = xb_add(&bar[XB_TOP], 1u);
            const unsigned tg = og / nx;
            if (og + 1u == (tg + 1u) * nx) xb_add(&bar[XB_TOPGEN], 1u);
            else XB_SPIN(xb_ld(&bar[XB_TOPGEN]) == tg, bar);
            __builtin_amdgcn_fence(__ATOMIC_ACQUIRE, "agent");
            xb_add(&bar[XB_XGEN(b.x)], 1u);
            asm volatile("s_waitcnt vmcnt(0)" ::: "memory");
        } else {
            XB_SPIN(xb_ld(&bar[XB_XGEN(b.x)]) == gen, bar);
            __builtin_amdgcn_fence(__ATOMIC_ACQUIRE, "agent");
            asm volatile("s_waitcnt vmcnt(0)" ::: "memory");
        }
    }
    __syncthreads();
}

enum { PH_PRO = 0, PH_PROJ, PH_UP, PH_ATTN, PH_MIX, PH_MEMQ, PH_XATTN, PH_MEMO, PH_PQ, PH_TOPK, PH_EXP, PH_N, PHB_CONV = 16, PHB_UPG = 17 };
struct Args { const float* in[24]; float* out; unsigned char* ws; unsigned mask; unsigned li; };

DEVI int src_col(int mode, int r) { return mode == 0 ? r : mode == 1 ? win_src(r) : wkv_src(r); }
template <int MODE, bool HASG> DEVI void p0_transpose_item(const float* W, int K, int N, bf16* WT, int NR, const float* gk, LAS float* scr, int item, int lane) {
    const int nb_ = NR / 32, kb = item / nb_, nb = item % nb_, k0 = 64 * kb, n0 = 32 * nb;
    const int sc = src_col(MODE, n0 + (lane & 31)), scc = sc < 0 ? 0 : sc; const float keep = sc < 0 ? 0.f : 1.f;
    float v[32];
#pragma unroll
    for (int i = 0; i < 32; ++i) { const int kk = 2 * i + (lane >> 5); v[i] = W[(size_t)(k0 + kk) * N + scc]; }
    if (HASG) {
#pragma unroll
        for (int i = 0; i < 32; ++i) { const int kk = 2 * i + (lane >> 5); v[i] *= gk[k0 + kk]; } }
#pragma unroll
    for (int i = 0; i < 32; ++i) { const int kk = 2 * i + (lane >> 5); scr[kk * 33 + (lane & 31)] = MODE == 0 ? v[i] : v[i] * keep; }
    LDS_WAIT(); asm volatile("" ::: "memory");
    const int c = lane & 7;
#pragma unroll
    for (int j = 0; j < 4; ++j) { const int n = (lane >> 3) + 8 * j; const LAS float* s = scr + (8 * c) * 33 + n;
        uint4 o; o.x = pg8::cvt_pk_bf16(s[0 * 33], s[1 * 33]); o.y = pg8::cvt_pk_bf16(s[2 * 33], s[3 * 33]); o.z = pg8::cvt_pk_bf16(s[4 * 33], s[5 * 33]); o.w = pg8::cvt_pk_bf16(s[6 * 33], s[7 * 33]);
        *(uint4*)(WT + (size_t)(n0 + n) * K + k0 + 8 * c) = o; }
    LDS_WAIT(); asm volatile("" ::: "memory");
}
DEVI void rms_row_to_bf16(const float* xrow, const float* g, bf16* orow, int lane) {
    const float4* xr = (const float4*)xrow + lane; const float4* gr = (const float4*)g + lane;
    float4 v[4]; float s = 0.f;
#pragma unroll
    for (int j = 0; j < 4; ++j) { v[j] = xr[64 * j]; s += (v[j].x * v[j].x + v[j].y * v[j].y) + (v[j].z * v[j].z + v[j].w * v[j].w); }
    const float r = rsqrtf(wave_sum(s) * (1.f / D) + EPS);
    uint2* o8 = (uint2*)orow + lane;
#pragma unroll
    for (int j = 0; j < 4; ++j) { const float4 gg = gr[64 * j]; uint2 o; o.x = pg8::cvt_pk_bf16(v[j].x * r * gg.x, v[j].y * r * gg.y); o.y = pg8::cvt_pk_bf16(v[j].z * r * gg.z, v[j].w * r * gg.w); o8[64 * j] = o; }
}
DEVI void rms_rows4_to_bf16(const float* x, const float* g, bf16* out, int m0, int step, int mend, int lane) {
    float4 v[4][4]; float s[4]; float4 gq[4];
#pragma unroll
    for (int j = 0; j < 4; ++j) gq[j] = ((const float4*)g + lane)[64 * j];
#pragma unroll
    for (int r = 0; r < 4; ++r) { const int m = m0 + r * step; const float4* xr = (const float4*)(x + (size_t)(m < mend ? m : m0) * D) + lane;
#pragma unroll
        for (int j = 0; j < 4; ++j) v[r][j] = xr[64 * j]; }
#pragma unroll
    for (int r = 0; r < 4; ++r) { float t = 0.f;
#pragma unroll
        for (int j = 0; j < 4; ++j) t += (v[r][j].x * v[r][j].x + v[r][j].y * v[r][j].y) + (v[r][j].z * v[r][j].z + v[r][j].w * v[r][j].w);
        s[r] = t; }
#pragma unroll
    for (int o = 1; o < 64; o <<= 1) {
#pragma unroll
        for (int r = 0; r < 4; ++r) s[r] += __shfl_xor(s[r], o); }
#pragma unroll
    for (int r = 0; r < 4; ++r) { const int m = m0 + r * step; if (m < mend) { const float rs = rsqrtf(s[r] * (1.f / D) + EPS); uint2* o8 = (uint2*)(out + (size_t)m * D) + lane;
#pragma unroll
        for (int j = 0; j < 4; ++j) { const float4 gg = gq[j]; uint2 o; o.x = pg8::cvt_pk_bf16(v[r][j].x * rs * gg.x, v[r][j].y * rs * gg.y); o.y = pg8::cvt_pk_bf16(v[r][j].z * rs * gg.z, v[r][j].w * rs * gg.w); o8[64 * j] = o; } } }
}
DEVI void cvt_stream_fp8(const float* src, unsigned char* dst, size_t n16, const float* g, float mul, size_t gtid, size_t gn) {
    for (size_t i = gtid; i < n16; i += gn) { pg8::u32x4 o;
#pragma unroll
        for (int q = 0; q < 4; ++q) { float4 a = *(const float4*)(src + i * 16 + q * 4); if (g) { const float4 gg = *(const float4*)(g + ((i * 16 + q * 4) & (D - 1))); a.x *= gg.x; a.y *= gg.y; a.z *= gg.z; a.w *= gg.w; }
            int p = __builtin_amdgcn_cvt_pk_fp8_f32(a.x * mul, a.y * mul, 0, false); p = __builtin_amdgcn_cvt_pk_fp8_f32(a.z * mul, a.w * mul, p, true); o[q] = (unsigned)p; }
        *(pg8::u32x4*)(dst + i * 16) = o; }
}
typedef unsigned v6u_t __attribute__((ext_vector_type(6)));
typedef float f32x2_t __attribute__((ext_vector_type(2)));
typedef float v16f_t __attribute__((ext_vector_type(16)));
typedef float v32f_t __attribute__((ext_vector_type(32)));
typedef __bf16 v32bf_t __attribute__((ext_vector_type(32)));
#ifndef FP6_INTERLEAVED
#define FP6_INTERLEAVED 0
#endif
template <bool HASG> DEVI void cvt_rows_fp6(const float* src, unsigned char* dst, const float* g, float mul, size_t gtid, size_t gn) {
    const int grp = (int)(gtid & 31);
    float4 gg[8];
#pragma unroll
    for (int q = 0; q < 8; ++q) { gg[q] = HASG ? *(const float4*)(g + grp * 32 + q * 4) : make_float4(1.f, 1.f, 1.f, 1.f); gg[q].x *= mul; gg[q].y *= mul; gg[q].z *= mul; gg[q].w *= mul; }
    for (size_t i0 = gtid; i0 < (size_t)PE * 32; i0 += 2 * gn) {
        float4 v[2][8];
#pragma unroll
        for (int u = 0; u < 2; ++u) { const size_t i = i0 + u * gn; if (i < (size_t)PE * 32) { const float* sp = src + (i >> 5) * D + (i & 31) * 32;
#pragma unroll
            for (int q = 0; q < 8; ++q) v[u][q] = *(const float4*)(sp + q * 4); } }
#pragma unroll
        for (int u = 0; u < 2; ++u) { const size_t i = i0 + u * gn; if (i < (size_t)PE * 32) { const size_t row = i >> 5;
            v16f_t a, b;
#pragma unroll
            for (int q = 0; q < 8; ++q) { const float4 x = v[u][q]; a[2 * q] = x.x * gg[q].x; b[2 * q] = x.y * gg[q].y; a[2 * q + 1] = x.z * gg[q].z; b[2 * q + 1] = x.w * gg[q].w; }
            const v6u_t p = __builtin_amdgcn_cvt_scalef32_2xpk16_fp6_f32(a, b, 1.0f);
            *(pg8::u32x4*)(dst + row * 768 + grp * 16) = (pg8::u32x4){p[0], p[1], p[2], p[3]};
            *(pg8::u32x2*)(dst + row * 768 + 512 + grp * 8) = (pg8::u32x2){p[4], p[5]}; } }
    }
}
DEVI void cvt_stream(const float* src, bf16* dst, size_t n8, const float* g, size_t gtid, size_t gn) {
    for (size_t i = gtid; i < n8; i += gn) { const float4 a = *(const float4*)(src + i * 8), b = *(const float4*)(src + i * 8 + 4);
        float4 ga = make_float4(1.f, 1.f, 1.f, 1.f), gb = ga; if (g) { ga = *(const float4*)(g + ((i * 8) & (D - 1))); gb = *(const float4*)(g + ((i * 8) & (D - 1)) + 4); }
        uint4 o; o.x = pg8::cvt_pk_bf16(a.x * ga.x, a.y * ga.y); o.y = pg8::cvt_pk_bf16(a.z * ga.z, a.w * ga.w); o.z = pg8::cvt_pk_bf16(b.x * gb.x, b.y * gb.y); o.w = pg8::cvt_pk_bf16(b.z * gb.z, b.w * gb.w);
        *(uint4*)(dst + i * 8) = o; }
}


DEVI void conv_token(int row, const bf16* U, const float* cw, const float* cb, const float* lg, const float* lb, bf16* CONCAT, int lane) {
    const int pos = row % SEQ; float y[8];
    { const float4 b0 = *(const float4*)(cb + lane * 8), b1 = *(const float4*)(cb + lane * 8 + 4); y[0] = b0.x; y[1] = b0.y; y[2] = b0.z; y[3] = b0.w; y[4] = b1.x; y[5] = b1.y; y[6] = b1.z; y[7] = b1.w; }
    const int k0 = pos >= CK - 1 ? 0 : CK - 1 - pos;
    for (int k = k0; k < CK; ++k) {
        const uint4 u = *(const uint4*)(U + (size_t)(row - (CK - 1) + k) * CW + lane * 8);
        const float4 w0 = *(const float4*)(cw + k * CW + lane * 8), w1 = *(const float4*)(cw + k * CW + lane * 8 + 4);
        y[0] += w0.x * __builtin_bit_cast(float, u.x << 16); y[1] += w0.y * __builtin_bit_cast(float, u.x & 0xffff0000u);
        y[2] += w0.z * __builtin_bit_cast(float, u.y << 16); y[3] += w0.w * __builtin_bit_cast(float, u.y & 0xffff0000u);
        y[4] += w1.x * __builtin_bit_cast(float, u.z << 16); y[5] += w1.y * __builtin_bit_cast(float, u.z & 0xffff0000u);
        y[6] += w1.z * __builtin_bit_cast(float, u.w << 16); y[7] += w1.w * __builtin_bit_cast(float, u.w & 0xffff0000u);
    }
    float s = 0.f;
#pragma unroll
    for (int e = 0; e < 8; ++e) s += y[e];
    const float mu = wave_sum(s) * (1.f / CW); float q = 0.f;
#pragma unroll
    for (int e = 0; e < 8; ++e) { y[e] -= mu; q += y[e] * y[e]; }
    const float rstd = rsqrtf(wave_sum(q) * (1.f / CW) + EPS);
    const float4 g0 = *(const float4*)(lg + lane * 8), g1 = *(const float4*)(lg + lane * 8 + 4), c0 = *(const float4*)(lb + lane * 8), c1 = *(const float4*)(lb + lane * 8 + 4);
    const float gg[8] = {g0.x, g0.y, g0.z, g0.w, g1.x, g1.y, g1.z, g1.w}, bb[8] = {c0.x, c0.y, c0.z, c0.w, c1.x, c1.y, c1.z, c1.w};
    float z[8];
#pragma unroll
    for (int e = 0; e < 8; ++e) { const float t = y[e] * rstd * gg[e] + bb[e]; z[e] = t * __builtin_amdgcn_rcpf(1.f + __expf(-t)); }
    uint4 o; o.x = pg8::cvt_pk_bf16(z[0], z[1]); o.y = pg8::cvt_pk_bf16(z[2], z[3]); o.z = pg8::cvt_pk_bf16(z[4], z[5]); o.w = pg8::cvt_pk_bf16(z[6], z[7]);
    *(uint4*)(CONCAT + (size_t)row * D + CW + lane * 8) = o;
}

DEVI void conv_chunk(int c, const bf16* U, const float* cw, const float* cb, const float* lg, const float* lb, bf16* CONCAT, LAS unsigned char* lds) {
    const int ch = threadIdx.x, lane = ch & 63, wv = __builtin_amdgcn_readfirstlane(ch >> 6);
    const int t0 = c * 64, pos0 = t0 % SEQ;
    float w[CK];
#pragma unroll
    for (int k = 0; k < CK; ++k) w[k] = cw[k * CW + ch];
    const float bias = cb[ch];
    float u[64 + CK - 1];
#pragma unroll
    for (int r = 0; r < 64 + CK - 1; ++r) { const int row = t0 - (CK - 1) + r;
        const unsigned raw = *(const unsigned short*)(U + (size_t)(row < 0 ? 0 : row) * CW + ch); u[r] = __builtin_bit_cast(float, raw << 16); }
#pragma unroll
    for (int r = 0; r < CK - 1; ++r) { const float keep = (pos0 - (CK - 1) + r >= 0) ? 1.f : 0.f; u[r] *= keep; }
    LAS float* yl = (LAS float*)lds;
#pragma unroll
    for (int j = 0; j < 64; ++j) { float y = bias;
#pragma unroll
        for (int k = 0; k < CK; ++k) y += w[k] * u[j + k];
        yl[j * CW + ch] = y; }
    __syncthreads();
#pragma unroll 1
    for (int i = 0; i < 8; ++i) { const int j = wv * 8 + i, row = t0 + j;
        const pg8::f32x4 a0 = *(const LAS pg8::f32x4*)(yl + j * CW + lane * 8), a1 = *(const LAS pg8::f32x4*)(yl + j * CW + lane * 8 + 4);
        float y[8] = {a0[0], a0[1], a0[2], a0[3], a1[0], a1[1], a1[2], a1[3]}; float sm = 0.f;
#pragma unroll
        for (int e = 0; e < 8; ++e) sm += y[e];
        const float mu = wave_sum(sm) * (1.f / CW); float q = 0.f;
#pragma unroll
        for (int e = 0; e < 8; ++e) { y[e] -= mu; q += y[e] * y[e]; }
        const float rstd = rsqrtf(wave_sum(q) * (1.f / CW) + EPS);
        const float4 g0 = *(const float4*)(lg + lane * 8), g1 = *(const float4*)(lg + lane * 8 + 4), c0 = *(const float4*)(lb + lane * 8), c1 = *(const float4*)(lb + lane * 8 + 4);
        const float gg[8] = {g0.x, g0.y, g0.z, g0.w, g1.x, g1.y, g1.z, g1.w}, bb[8] = {c0.x, c0.y, c0.z, c0.w, c1.x, c1.y, c1.z, c1.w};
        float z[8];
#pragma unroll
        for (int e = 0; e < 8; ++e) { const float t = y[e] * rstd * gg[e] + bb[e]; z[e] = t * __builtin_amdgcn_rcpf(1.f + __expf(-t)); }
        uint4 o; o.x = pg8::cvt_pk_bf16(z[0], z[1]); o.y = pg8::cvt_pk_bf16(z[2], z[3]); o.z = pg8::cvt_pk_bf16(z[4], z[5]); o.w = pg8::cvt_pk_bf16(z[6], z[7]);
        *(uint4*)(CONCAT + (size_t)row * D + CW + lane * 8) = o; }
    __syncthreads();
}

typedef short bf16x8_t __attribute__((ext_vector_type(8)));
typedef float f32x16_t __attribute__((ext_vector_type(16)));
typedef __bf16 bf16x2_t __attribute__((ext_vector_type(2)));
DEVI unsigned umax_(unsigned a, unsigned b) { return a > b ? a : b; }
DEVI unsigned umin_(unsigned a, unsigned b) { return a < b ? a : b; }
DEVI unsigned kmax_(unsigned a, unsigned b) { unsigned r; asm("v_max_f32 %0, %1, %2" : "=v"(r) : "v"(a), "v"(b)); return r; }
DEVI unsigned kmin_(unsigned a, unsigned b) { unsigned r; asm("v_min_f32 %0, %1, %2" : "=v"(r) : "v"(a), "v"(b)); return r; }
DEVI void ce_desc(unsigned& a, unsigned& b) { const unsigned mx = kmax_(a, b), mn = kmin_(a, b); a = mx; b = mn; }
DEVI void sort16_desc(unsigned (&v)[16]) {
    ce_desc(v[0], v[13]); ce_desc(v[1], v[12]); ce_desc(v[2], v[15]); ce_desc(v[3], v[14]); ce_desc(v[4], v[8]); ce_desc(v[5], v[6]); ce_desc(v[7], v[11]); ce_desc(v[9], v[10]);
    ce_desc(v[0], v[5]); ce_desc(v[1], v[7]); ce_desc(v[2], v[9]); ce_desc(v[3], v[4]); ce_desc(v[6], v[13]); ce_desc(v[8], v[14]); ce_desc(v[10], v[15]); ce_desc(v[11], v[12]);
    ce_desc(v[0], v[1]); ce_desc(v[2], v[3]); ce_desc(v[4], v[5]); ce_desc(v[6], v[8]); ce_desc(v[7], v[9]); ce_desc(v[10], v[11]); ce_desc(v[12], v[13]); ce_desc(v[14], v[15]);
    ce_desc(v[0], v[2]); ce_desc(v[1], v[3]); ce_desc(v[4], v[10]); ce_desc(v[5], v[11]); ce_desc(v[6], v[7]); ce_desc(v[8], v[9]); ce_desc(v[12], v[14]); ce_desc(v[13], v[15]);
    ce_desc(v[1], v[2]); ce_desc(v[3], v[12]); ce_desc(v[4], v[6]); ce_desc(v[5], v[7]); ce_desc(v[8], v[10]); ce_desc(v[9], v[11]); ce_desc(v[13], v[14]);
    ce_desc(v[1], v[4]); ce_desc(v[2], v[6]); ce_desc(v[5], v[8]); ce_desc(v[7], v[10]); ce_desc(v[9], v[13]); ce_desc(v[11], v[14]);
    ce_desc(v[2], v[4]); ce_desc(v[3], v[6]); ce_desc(v[9], v[12]); ce_desc(v[11], v[13]);
    ce_desc(v[3], v[5]); ce_desc(v[6], v[8]); ce_desc(v[7], v[9]); ce_desc(v[10], v[12]);
    ce_desc(v[3], v[4]); ce_desc(v[5], v[6]); ce_desc(v[7], v[8]); ce_desc(v[9], v[10]); ce_desc(v[11], v[12]);
    ce_desc(v[6], v[7]); ce_desc(v[8], v[9]);
}
DEVI void merge16_desc(unsigned (&v)[16]) {
#pragma unroll
    for (int j = 8; j > 0; j >>= 1)
#pragma unroll
        for (int i = 0; i < 16; ++i) { const int l = i ^ j; if (l > i) ce_desc(v[i], v[l]); }
}
DEVI void top16_merge(unsigned (&a)[16], const unsigned (&b)[16]) {
#pragma unroll
    for (int i = 0; i < 16; ++i) a[i] = kmax_(a[i], b[15 - i]);
    merge16_desc(a);
}
DEVI int crow16(int r, int hi) { return (r & 3) + 8 * (r >> 2) + 4 * hi; }

DEVI void subkey_top16(unsigned (&best)[16], const bf16* qrow  , const LAS unsigned char* kl  , int hi) {
    bf16x8_t qf[8];
#pragma unroll
    for (int ks = 0; ks < 8; ++ks) qf[ks] = *(const bf16x8_t*)(qrow + 16 * ks);
    unsigned grp[16];
#pragma unroll
    for (int nt = 0; nt < 4; ++nt) {
        f32x16_t acc = {};
#pragma unroll
        for (int ks = 0; ks < 8; ++ks) { const bf16x8_t kf = *(const LAS bf16x8_t*)(kl + ks * 4096 + nt * 512); acc = __builtin_amdgcn_mfma_f32_32x32x16_bf16(kf, qf[ks], acc, 0, 0, 0); }
#pragma unroll
        for (int r = 0; r < 16; ++r) { const float av = acc[r]; grp[r] = (__builtin_bit_cast(unsigned, av) & 0xffffff80u) | (unsigned)(127 - (32 * nt + crow16(r, hi))); }
        sort16_desc(grp);
        if (nt == 0) {
#pragma unroll
            for (int r = 0; r < 16; ++r) best[r] = grp[r];
        } else top16_merge(best, grp);
    }
    unsigned oth[16];
#pragma unroll
    for (int r = 0; r < 16; ++r) oth[r] = (unsigned)__shfl_xor((int)best[r], 32);
    top16_merge(best, oth);
}
DEVI void topk_wave(const bf16* qbase, const LAS unsigned char* keys, LAS unsigned* scr  , int* eidx, float* egate, int lane) {
    const int r32 = lane & 31, hi = lane >> 5;
    unsigned b0[16], b1[16];
    subkey_top16(b0, qbase + 8 * hi, keys + hi * 2048 + r32 * 16, hi);
    subkey_top16(b1, qbase + 128 + 8 * hi, keys + 32768 + hi * 2048 + r32 * 16, hi);
    float s0[16], s1[16];
#pragma unroll
    for (int i = 0; i < 16; ++i) { s0[i] = __builtin_bit_cast(float, b0[i] & 0xffffff80u); s1[i] = __builtin_bit_cast(float, b1[i] & 0xffffff80u); }
#pragma unroll
    for (int w = 0; w < 4; ++w) {
        scr[lane * 9 + w] = (127u - (b0[4 * w] & 127u)) | ((127u - (b0[4 * w + 1] & 127u)) << 8) | ((127u - (b0[4 * w + 2] & 127u)) << 16) | ((127u - (b0[4 * w + 3] & 127u)) << 24);
        scr[lane * 9 + 4 + w] = (127u - (b1[4 * w] & 127u)) | ((127u - (b1[4 * w + 1] & 127u)) << 8) | ((127u - (b1[4 * w + 2] & 127u)) << 16) | ((127u - (b1[4 * w + 3] & 127u)) << 24);
    }
    unsigned ca[16], cb2[16];
#define CAND(i, j) ((__builtin_bit_cast(unsigned, s0[i] + s1[j]) & 0xffffff00u) | (unsigned)(255 - ((i) * 16 + (j))))
    const unsigned lowest = 0xff800000u;
    if (hi == 0) {
#pragma unroll
        for (int j = 0; j < 16; ++j) ca[j] = CAND(0, j);
#pragma unroll
        for (int j = 0; j < 8; ++j) cb2[j] = CAND(1, j);
#pragma unroll
        for (int j = 8; j < 16; ++j) cb2[j] = lowest;
    } else {
        ca[0] = CAND(2, 0); ca[1] = CAND(2, 1); ca[2] = CAND(2, 2); ca[3] = CAND(2, 3); ca[4] = CAND(2, 4); ca[5] = CAND(3, 0); ca[6] = CAND(3, 1); ca[7] = CAND(3, 2); ca[8] = CAND(3, 3);
        ca[9] = CAND(4, 0); ca[10] = CAND(4, 1); ca[11] = CAND(4, 2); ca[12] = CAND(5, 0); ca[13] = CAND(5, 1); ca[14] = CAND(6, 0); ca[15] = CAND(6, 1);
        cb2[0] = CAND(7, 0); cb2[1] = CAND(7, 1); cb2[2] = CAND(8, 0); cb2[3] = CAND(9, 0); cb2[4] = CAND(10, 0); cb2[5] = CAND(11, 0); cb2[6] = CAND(12, 0); cb2[7] = CAND(13, 0); cb2[8] = CAND(14, 0); cb2[9] = CAND(15, 0);
#pragma unroll
        for (int j = 10; j < 16; ++j) cb2[j] = lowest;
    }
#undef CAND
    sort16_desc(ca); sort16_desc(cb2); top16_merge(ca, cb2);
    unsigned oth[16];
#pragma unroll
    for (int r = 0; r < 16; ++r) oth[r] = (unsigned)__shfl_xor((int)ca[r], 32);
    top16_merge(ca, oth);
    const float mx = __builtin_bit_cast(float, ca[0] & 0xffffff00u); float ex[16]; float l = 0.f;
#pragma unroll
    for (int k = 0; k < 16; ++k) { ex[k] = __expf(__builtin_bit_cast(float, ca[k] & 0xffffff00u) - mx); l += ex[k]; }
    const float rl = 1.f / l;
    LDS_WAIT(); asm volatile("" ::: "memory");
    int ei[8]; float eg[8];
    const unsigned mhi = (unsigned)(-hi);
#pragma unroll
    for (int k = 0; k < 8; ++k) { const unsigned key = ca[k] ^ ((ca[k] ^ ca[8 + k]) & mhi); const unsigned ij = 255u - (key & 255u), i = ij >> 4, j = ij & 15u;
        const unsigned w0 = scr[lane * 9 + (i >> 2)], w1 = scr[lane * 9 + 4 + (j >> 2)];
        ei[k] = (int)(((w0 >> (8 * (i & 3))) & 255u) * PNK + ((w1 >> (8 * (j & 3))) & 255u)); eg[k] = __builtin_bit_cast(float, __builtin_bit_cast(unsigned, ex[k]) ^ ((__builtin_bit_cast(unsigned, ex[k]) ^ __builtin_bit_cast(unsigned, ex[8 + k])) & mhi)) * rl; }
    *(int4*)(eidx + hi * 8) = make_int4(ei[0], ei[1], ei[2], ei[3]); *(int4*)(eidx + hi * 8 + 4) = make_int4(ei[4], ei[5], ei[6], ei[7]);
    *(float4*)(egate + hi * 8) = make_float4(eg[0], eg[1], eg[2], eg[3]); *(float4*)(egate + hi * 8 + 4) = make_float4(eg[4], eg[5], eg[6], eg[7]);
    LDS_WAIT(); asm volatile("" ::: "memory");
}

typedef unsigned char fp8_t;
template <int VAR = 0> DEVI float dot16_fp8(pg8::u32x4 row, pg8::u32x4 ha, pg8::u32x4 hb, float acc) {
    if (VAR == 1) return __builtin_bit_cast(float, (row[0] ^ row[1]) ^ (row[2] ^ row[3]));
#pragma unroll
    for (int i = 0; i < 4; ++i) { const unsigned hlo = i < 2 ? ha[2 * i] : hb[2 * i - 4], hhi = i < 2 ? ha[2 * i + 1] : hb[2 * i - 3];
        acc = __builtin_amdgcn_fdot2_f32_bf16(__builtin_amdgcn_cvt_scalef32_pk_bf16_fp8(row[i], 1.0f, false), __builtin_bit_cast(bf16x2_t, hlo), acc, false);
        acc = __builtin_amdgcn_fdot2_f32_bf16(__builtin_amdgcn_cvt_scalef32_pk_bf16_fp8(row[i], 1.0f, true), __builtin_bit_cast(bf16x2_t, hhi), acc, false); }
    return acc;
}
template <int VAR = 0> DEVI void fma16_fp8(float (&acc)[16], float w, pg8::u32x4 row) {
    if (VAR == 1) { acc[0] += __builtin_bit_cast(float, row[0] ^ row[1]); acc[1] += __builtin_bit_cast(float, row[2] ^ row[3]); return; }
#pragma unroll
    for (int i = 0; i < 4; ++i) { const pg8::f32x2 lo = __builtin_amdgcn_cvt_pk_f32_fp8(row[i], false), hh = __builtin_amdgcn_cvt_pk_f32_fp8(row[i], true);
        acc[4 * i] += w * lo[0]; acc[4 * i + 1] += w * lo[1]; acc[4 * i + 2] += w * hh[0]; acc[4 * i + 3] += w * hh[1]; }
}
DEVI void sort128_asc(unsigned& a, unsigned& b, int lane) {
#pragma unroll
    for (int k = 2; k <= 128; k <<= 1)
#pragma unroll
        for (int j = k >> 1; j > 0; j >>= 1) {
            if (j == 64) { const unsigned lo = umin_(a, b), hi = umax_(a, b); a = lo; b = hi; }
            else {
                const bool upper = (lane & j) != 0;
                const bool asc_a = k == 128 ? true : ((lane & k) == 0), asc_b = k == 128 ? true : (k == 64 ? false : ((lane & k) == 0));
                const unsigned pa_ = (unsigned)__shfl_xor((int)a, j), pb_ = (unsigned)__shfl_xor((int)b, j);
                a = (upper != asc_a) ? umin_(a, pa_) : umax_(a, pa_);
                b = (upper != asc_b) ? umin_(b, pb_) : umax_(b, pb_);
            }
        }
}
constexpr int EXD = 8, EXP_LDS_WAVE = 12800 + 2048;
typedef int v8i_t __attribute__((ext_vector_type(8)));
typedef float v4f_t __attribute__((ext_vector_type(4)));
struct Row6 { pg8::u32x4 a; pg8::u32x2 b; };
template <int VAR> DEVI void experts_wave(LAS unsigned char* wl_, int t0, int tstep, const bf16* H2B, const float* part2, const unsigned char* PU, const unsigned char* PV, const int* EIDX, const float* EGATE, const float* fg, float* out, int lane) {
    if (t0 >= M) return;
    const int ntok = (M - t0 + tstep - 1) / tstep < 8 ? (M - t0 + tstep - 1) / tstep : 8;
    LAS int* sid = (LAS int*)wl_; LAS float* gsl = (LAS float*)(wl_ + 4096); LAS float* wl = (LAS float*)(wl_ + 8192); LAS float* r2l = (LAS float*)(wl_ + 12288);
    const unsigned g32 = (unsigned)lane & 31u, hsel = (unsigned)lane >> 5, l4 = (unsigned)lane * 4u;
#define LDI(p) (*(const int*)((const char*)(p) + l4))
#define LDF(p) (*(const float*)((const char*)(p) + l4))
#define LDROW(dst, tab, ridx) do { const unsigned char* rp_ = (tab) + (size_t)(unsigned)(ridx) * 768u; (dst).a = *(const pg8::u32x4*)(rp_ + g32 * 16u); (dst).b = *(const pg8::u32x2*)(rp_ + 512u + g32 * 8u); } while (0)
    for (int k = 0; k < ntok; ++k) { const int t = t0 + k * tstep;
        unsigned k0 = ((unsigned)LDI(EIDX + (size_t)t * 128) << 7) | (unsigned)lane, k1 = ((unsigned)LDI(EIDX + (size_t)t * 128 + 64) << 7) | (unsigned)(64 + lane);
        const float ga = LDF(EGATE + (size_t)t * 128), gb = LDF(EGATE + (size_t)t * 128 + 64);
        sort128_asc(k0, k1, lane);
        const unsigned sl0 = k0 & 127u, sl1 = k1 & 127u;
        const float x0 = __shfl(ga, (int)(sl0 & 63u)), y0 = __shfl(gb, (int)(sl0 & 63u)), x1 = __shfl(ga, (int)(sl1 & 63u)), y1 = __shfl(gb, (int)(sl1 & 63u));
        sid[k * 128 + lane] = (int)(k0 >> 7); sid[k * 128 + 64 + lane] = (int)(k1 >> 7);
        gsl[k * 128 + lane] = sl0 < 64u ? x0 : y0; gsl[k * 128 + 64 + lane] = sl1 < 64u ? x1 : y1;
        const float r2 = rsqrtf(wave_sum(lane < 16 ? LDF(part2 + (size_t)t * 16) : 0.f) * (1.f / D) + EPS) * (1.0f / PU_SCALE);
        if (lane == 0) r2l[k] = r2; }
    LDS_WAIT(); asm volatile("" ::: "memory");
    const int nsteps = 8 * ntok;
#define STEP_DESC(q, tab, pos0) do { const int q_ = (q); if (q_ < nsteps) { (tab) = PU; (pos0) = ((q_ >> 5) * 4 + (q_ & 3)) * 128 + 16 * ((q_ >> 2) & 7); } \
        else if (q_ < 2 * nsteps) { const int qq_ = q_ - nsteps; (tab) = PV; (pos0) = (qq_ >> 3) * 128 + 16 * (qq_ & 7); } else { (tab) = PV; (pos0) = 0; } } while (0)
    constexpr int LOOK = 1;
    Row6 buf[8 * LOOK];
    pg8::u32x4 hhi[4], hlo[4];
#define CONVERT_GRP(g_) do { LAS unsigned char* img = wl_ + 12800; const int c16 = lane & 15, q4 = lane >> 4; \
      _Pragma("unroll") for (int k = 0; k < 4; ++k) { const int tt_ = t0 + (4 * (g_) + k) * tstep; \
          const pg8::u32x4 h0 = *(const pg8::u32x4*)((const char*)(H2B + (size_t)tt_ * D) + lane * 32), h1 = *(const pg8::u32x4*)((const char*)(H2B + (size_t)tt_ * D) + lane * 32 + 16); \
          float hf[16]; \
          _Pragma("unroll") for (int j = 0; j < 4; ++j) { hf[2 * j] = __builtin_bit_cast(float, h0[j] << 16); hf[2 * j + 1] = __builtin_bit_cast(float, h0[j] & 0xffff0000u); hf[8 + 2 * j] = __builtin_bit_cast(float, h1[j] << 16); hf[8 + 2 * j + 1] = __builtin_bit_cast(float, h1[j] & 0xffff0000u); } \
          pg8::u32x4 hiw, low; \
          _Pragma("unroll") for (int w = 0; w < 4; ++w) { int p = __builtin_amdgcn_cvt_pk_fp8_f32(hf[4 * w], hf[4 * w + 1], 0, false); p = __builtin_amdgcn_cvt_pk_fp8_f32(hf[4 * w + 2], hf[4 * w + 3], p, true); \
              const pg8::f32x2 b01 = __builtin_amdgcn_cvt_pk_f32_fp8(p, false), b23 = __builtin_amdgcn_cvt_pk_f32_fp8(p, true); \
              int ql = __builtin_amdgcn_cvt_pk_fp8_f32(hf[4 * w] - b01[0], hf[4 * w + 1] - b01[1], 0, false); ql = __builtin_amdgcn_cvt_pk_fp8_f32(hf[4 * w + 2] - b23[0], hf[4 * w + 3] - b23[1], ql, true); \
              hiw[w] = (unsigned)p; low[w] = (unsigned)ql; } \
          *(LAS pg8::u32x4*)(img + lane * 16) = hiw; *(LAS pg8::u32x4*)(img + 1024 + lane * 16) = low; \
          LDS_WAIT(); asm volatile("" ::: "memory"); \
          const int off = 32 * c16 + 512 * (q4 >> 1) + 16 * (q4 & 1); \
          hhi[k] = *(const LAS pg8::u32x4*)(img + off); hlo[k] = *(const LAS pg8::u32x4*)(img + 1024 + off); \
          LDS_WAIT(); asm volatile("" ::: "memory"); } } while (0)
#pragma unroll
    for (int i = 0; i < 8; ++i) { const int ri = sid[2 * i + (int)hsel]; LDROW(buf[i], PU, ri); }
#define TR_STEP(S) _Pragma("unroll") for (int i = 0; i < S; ++i) { const bool up_ = (lane & S) != 0; const float send = up_ ? r[i] : r[i + S], keep = up_ ? r[i + S] : r[i]; r[i] = keep + __shfl_xor(send, S); }
#define U_STEP(q, B_, K_, G_) do { const int q__ = (q); const int ub_ = (B_); constexpr int uk_ = (K_); const int tk_ = 4 * (G_) + uk_; \
        const unsigned char* ntab; int npos; STEP_DESC(q__ + LOOK, ntab, npos); npos += (int)hsel; \
        const v8i_t AAh = {(int)hhi[uk_][0], (int)hhi[uk_][1], (int)hhi[uk_][2], (int)hhi[uk_][3], 0, 0, 0, 0}, AAl = {(int)hlo[uk_][0], (int)hlo[uk_][1], (int)hlo[uk_][2], (int)hlo[uk_][3], 0, 0, 0, 0}; \
        const v8i_t ABh = {0, 0, 0, 0, (int)hhi[uk_][0], (int)hhi[uk_][1], (int)hhi[uk_][2], (int)hhi[uk_][3]}, ABl = {0, 0, 0, 0, (int)hlo[uk_][0], (int)hlo[uk_][1], (int)hlo[uk_][2], (int)hlo[uk_][3]}; \
        const int c16_ = lane & 15; const bool dg_ = (lane >> 4) == (c16_ >> 2); \
        float r[16]; \
        _Pragma("unroll") for (int i2 = 0; i2 < 8; ++i2) { \
            const v8i_t B6 = {(int)buf[i2].a[0], (int)buf[i2].a[1], (int)buf[i2].a[2], (int)buf[i2].a[3], (int)buf[i2].b[0], (int)buf[i2].b[1], 0, 0}; \
            const v4f_t z4 = {0.f, 0.f, 0.f, 0.f}; \
            v4f_t cA = __builtin_amdgcn_mfma_scale_f32_16x16x128_f8f6f4(AAh, B6, z4, 0, 2, 0, 127, 0, 127); cA = __builtin_amdgcn_mfma_scale_f32_16x16x128_f8f6f4(AAl, B6, cA, 0, 2, 0, 127, 0, 127); \
            v4f_t cB = __builtin_amdgcn_mfma_scale_f32_16x16x128_f8f6f4(ABh, B6, z4, 0, 2, 0, 127, 0, 127); cB = __builtin_amdgcn_mfma_scale_f32_16x16x128_f8f6f4(ABl, B6, cB, 0, 2, 0, 127, 0, 127); \
            const int ri = sid[npos + 2 * i2]; LDROW(buf[i2], ntab, ri); \
            const float a01 = (c16_ & 1) ? cA[1] : cA[0], a23 = (c16_ & 1) ? cA[3] : cA[2], b01 = (c16_ & 1) ? cB[1] : cB[0], b23 = (c16_ & 1) ? cB[3] : cB[2]; \
            r[2 * i2] = dg_ ? ((c16_ & 2) ? a23 : a01) : 0.f; r[2 * i2 + 1] = dg_ ? ((c16_ & 2) ? b23 : b01) : 0.f; \
            __builtin_amdgcn_sched_barrier(0); } \
        TR_STEP(8) TR_STEP(4) TR_STEP(2) TR_STEP(1) \
        float tot = r[0] + __shfl_xor(r[0], 16); tot += __shfl_xor(tot, 32); \
        const int pos = tk_ * 128 + 16 * ub_ + c16_; \
        const float a = tot * r2l[tk_]; \
        wl[pos] = 0.5f * a * (1.f + erff(a * 0.70710678118654752f)) * gsl[pos] * (1.0f / PV_SCALE); } while (0)
    if (ntok == 8) {
#pragma unroll 1
        for (int grp = 0; grp < 2; ++grp) {
            CONVERT_GRP(grp);
#pragma unroll 1
            for (int b = 0; b < 8; ++b) { const int q = grp * 32 + b * 4;
                U_STEP(q, b, 0, grp); U_STEP(q + 1, b, 1, grp); U_STEP(q + 2, b, 2, grp); U_STEP(q + 3, b, 3, grp); }
        }
    }
#undef CONVERT_GRP
#undef U_STEP
#undef TR_STEP
    LDS_WAIT(); asm volatile("" ::: "memory");
#define V_STEP(q, SB) do { const int q__ = (q); const int b = (q__ - nsteps) & 7; \
        const unsigned char* ntab; int npos; STEP_DESC(q__ + LOOK, ntab, npos); npos += (int)hsel; \
        const int wpos = k * 128 + b * 16 + (int)hsel; \
        _Pragma("unroll") for (int i2 = 0; i2 < 8; ++i2) { \
            const v6u_t p = {buf[SB + i2].a[0], buf[SB + i2].a[1], buf[SB + i2].a[2], buf[SB + i2].a[3], buf[SB + i2].b[0], buf[SB + i2].b[1]}; \
            const float wv = wl[wpos + 2 * i2]; \
            if (VAR == 1) { acc[0] += __builtin_bit_cast(float, p[0] ^ p[1] ^ p[2]); acc[1] += __builtin_bit_cast(float, p[3] ^ p[4] ^ p[5]); } \
            else { const v32f_t rv = __builtin_amdgcn_cvt_scalef32_pk32_f32_fp6(p, 1.0f); \
                const f32x2_t w2_ = {wv, wv}; _Pragma("unroll") for (int j = 0; j < 32; j += 2) { const f32x2_t r2_ = {rv[j], rv[j + 1]}; f32x2_t a2_ = {acc[j], acc[j + 1]}; a2_ = __builtin_elementwise_fma(r2_, w2_, a2_); acc[j] = a2_[0]; acc[j + 1] = a2_[1]; } } \
            const int ri = sid[npos + 2 * i2]; LDROW(buf[SB + i2], ntab, ri); \
            asm volatile("" : "+v"(acc[0]), "+v"(acc[1]), "+v"(acc[2]), "+v"(acc[3]), "+v"(acc[4]), "+v"(acc[5]), "+v"(acc[6]), "+v"(acc[7]), "+v"(acc[8]), "+v"(acc[9]), "+v"(acc[10]), "+v"(acc[11]), "+v"(acc[12]), "+v"(acc[13]), "+v"(acc[14]), "+v"(acc[15])); \
            asm volatile("" : "+v"(acc[16]), "+v"(acc[17]), "+v"(acc[18]), "+v"(acc[19]), "+v"(acc[20]), "+v"(acc[21]), "+v"(acc[22]), "+v"(acc[23]), "+v"(acc[24]), "+v"(acc[25]), "+v"(acc[26]), "+v"(acc[27]), "+v"(acc[28]), "+v"(acc[29]), "+v"(acc[30]), "+v"(acc[31])); \
            __builtin_amdgcn_sched_barrier(0); } } while (0)
    const unsigned eoff = (g32 * 32u + hsel * 16u) * 4u;
    float4 fgq[4];
#pragma unroll
    for (int q = 0; q < 4; ++q) fgq[q] = *(const float4*)((const char*)(fg + q * 4) + eoff);
#pragma unroll 1
    for (int k = 0; k < ntok; ++k) {
        const int t = t0 + k * tstep;
        const pg8::u32x4 ra = *(const pg8::u32x4*)((const char*)(H2B + (size_t)t * D) + eoff / 2), rb = *(const pg8::u32x4*)((const char*)(H2B + (size_t)t * D) + eoff / 2 + 16);
        __builtin_amdgcn_sched_barrier(0);
        float acc[32];
#pragma unroll
        for (int j = 0; j < 32; ++j) acc[j] = 0.f;
#pragma unroll 1
        for (int bb = 0; bb < 8; bb += 2) { const int q = nsteps + 8 * k + bb; V_STEP(q, 0); V_STEP(q + 1, 8 * (LOOK - 1)); }
        float fin[16];
#pragma unroll
        for (int j = 0; j < 16; ++j) { const float lo = acc[j], hi = acc[16 + j]; const float send = hsel ? lo : hi, keep = hsel ? hi : lo; fin[j] = keep + __shfl_xor(send, 32); }
        float* orow = (float*)((char*)(out + (size_t)t * D) + eoff); float ss = 0.f;
        {
#pragma unroll
          for (int q = 0; q < 4; ++q) { fin[2 * q] += __builtin_bit_cast(float, ra[q] << 16); fin[2 * q + 1] += __builtin_bit_cast(float, ra[q] & 0xffff0000u); fin[8 + 2 * q] += __builtin_bit_cast(float, rb[q] << 16); fin[8 + 2 * q + 1] += __builtin_bit_cast(float, rb[q] & 0xffff0000u); } }
#pragma unroll
        for (int j = 0; j < 16; ++j) ss += fin[j] * fin[j];
        const float rr = rsqrtf(wave_sum(ss) * (1.f / D) + EPS);
#pragma unroll
        for (int q = 0; q < 4; ++q) { const float4 g = fgq[q];
            *(float4*)(orow + q * 4) = make_float4(fin[4 * q] * rr * g.x, fin[4 * q + 1] * rr * g.y, fin[4 * q + 2] * rr * g.z, fin[4 * q + 3] * rr * g.w); }
        __builtin_amdgcn_sched_barrier(0);
    }
#undef V_STEP
#undef STEP_DESC
#undef LDI
#undef LDF
#undef LDROW
}

typedef short v4i16_t __attribute__((ext_vector_type(4)));
typedef int v2i32_t __attribute__((ext_vector_type(2)));
typedef int v4i32_t __attribute__((ext_vector_type(4)));
DEVI bf16x8_t join_tr(v4i16_t lo, v4i16_t hh) { const v2i32_t a = __builtin_bit_cast(v2i32_t, lo), b = __builtin_bit_cast(v2i32_t, hh); const v4i32_t w = {a[0], a[1], b[0], b[1]}; return __builtin_bit_cast(bf16x8_t, w); }
DEVI float max3f(float a, float b, float c) { float r; asm("v_max3_f32 %0, %1, %2, %3" : "=v"(r) : "v"(a), "v"(b), "v"(c)); return r; }
DEVI float max2f(float a, float b) { float r; asm("v_max_f32_e32 %0, %1, %2" : "=v"(r) : "v"(a), "v"(b)); return r; }
DEVI void glds16(const void* gsrc, unsigned lds_dst) { unsigned keep;
    asm volatile("s_mov_b32 %0, m0\n\ts_mov_b32 m0, %2\n\ts_nop 0\n\tglobal_load_lds_dwordx4 %1, off\n\ts_mov_b32 m0, %0" : "=&s"(keep) : "v"(gsrc), "s"(lds_dst) : "memory"); }
#define LDSADDR(p) ((unsigned)__builtin_amdgcn_readfirstlane((int)(unsigned)(uintptr_t)(p)))
#define ATT_BAR(N) asm volatile("s_waitcnt vmcnt(" #N ") lgkmcnt(0)\n\ts_barrier" ::: "memory")
template <int DQK, int DV, int DSPLIT, int NSLOT, int PD, bool CAUSAL, bool STAG, int VAR = 0>
DEVI void attn_unit(LAS unsigned char* S, const bf16* Qu, int qpitch, const bf16* Ku, int kpitch, const bf16* Vu, int vpitch, bf16* Ou, int opitch, int NT, int qcb) {
    constexpr int NCH = DQK / 8, KSLOT = NCH * 1024, NVG = DV / 32, VSLOT = NVG * 4096, NRG = 8 / DSPLIT, DVW = DV / DSPLIT, NOD = DVW / 32, NKS = DQK / 16;
    constexpr int KOFF = 0, VOFF = NSLOT * KSLOT, WSF = VOFF + NSLOT * VSLOT;
    static_assert(NRG * 32 * DVW * 2 * DSPLIT <= NSLOT * KSLOT, "O staging reuses the K ring");
    static_assert(NSLOT >= PD + (STAG ? 2 : 1), "ring depth");
    int tid_ = threadIdx.x; asm volatile("" : "+v"(tid_));
    const int lane = tid_ & 63, wid = __builtin_amdgcn_readfirstlane(tid_ >> 6), r32 = lane & 31, hi = lane >> 5, rg = wid % NRG, dp = wid / NRG;
    const bool late = STAG && wid >= 4;
    LAS float* wsf = (LAS float*)(S + WSF) + wid * 64;
    const int nld = (NCH - wid + 7) / 8 + (NVG * 4 - wid + 7) / 8;
    const bf16* ksrc = Ku + (size_t)lane * kpitch;
    const bf16* vsrc = Vu + (size_t)(lane >> 2) * vpitch + (lane & 3) * 8;
#define ATT_DMA(t, slot) do { \
        _Pragma("unroll") for (int pc_ = 0; pc_ < (NCH + 7) / 8; ++pc_) { const int pc = wid + 8 * pc_; if (pc < NCH) \
            glds16(ksrc + (size_t)(t) * 64 * kpitch + pc * 8, LDSADDR(S + KOFF + (slot) * KSLOT + pc * 1024)); } \
        _Pragma("unroll") for (int pv_ = 0; pv_ < (NVG * 4 + 7) / 8; ++pv_) { const int pv = wid + 8 * pv_; if (pv < NVG * 4) \
            glds16(vsrc + (size_t)((t) * 64 + (pv & 3) * 16) * vpitch + (pv >> 2) * 32, LDSADDR(S + VOFF + (slot) * VSLOT + pv * 1024)); } } while (0)
    bf16x8_t qr[NKS];
#pragma unroll
    for (int ks = 0; ks < NKS; ++ks) qr[ks] = *(const bf16x8_t*)(Qu + (size_t)(32 * rg + r32) * qpitch + ks * 16 + hi * 8);
#pragma unroll
    for (int ks = 0; ks < NKS; ++ks) asm volatile("" : "+v"(qr[ks]));
#pragma unroll
    for (int t = 0; t < PD; ++t) if (t < NT) ATT_DMA(t, t);
    f32x16_t o[NOD];
#pragma unroll
    for (int dd = 0; dd < NOD; ++dd) o[dd] = f32x16_t{};
    float m = 0.f, l = 0.f; f32x16_t negm = f32x16_t{};
    const int tlast = CAUSAL ? qcb + (rg >> 1) : NT - 1;
    const LAS unsigned char* kbase = S + KOFF + hi * 1024 + r32 * 16;
    const LAS unsigned char* vbase = S + VOFF + ((lane >> 4) & 1) * 32 + (lane & 3) * 8 + (4 * hi + ((lane & 15) >> 2)) * 64 + dp * NOD * 4096;
    bf16x8_t pa[4];
#define ATT_QKSM(sl) do { const LAS unsigned char* kp = kbase + (sl) * KSLOT; \
            f32x16_t p0 = negm, p1 = negm; \
            _Pragma("unroll") for (int ks = 0; ks < NKS; ++ks) { const bf16x8_t a0 = *(const LAS bf16x8_t*)(kp + ks * 2048), a1 = *(const LAS bf16x8_t*)(kp + ks * 2048 + 512); \
                if (VAR != 2) { p0 = __builtin_amdgcn_mfma_f32_32x32x16_bf16(a0, qr[ks], p0, 0, 0, 0); p1 = __builtin_amdgcn_mfma_f32_32x32x16_bf16(a1, qr[ks], p1, 0, 0, 0); } else { p0[ks] += __builtin_bit_cast(float, (int)a0[0]); p1[ks] += __builtin_bit_cast(float, (int)a1[0]); } } \
            asm volatile("s_nop 15\n\ts_nop 7" : "+v"(p0), "+v"(p1)); \
            float rm = 0.f; \
            if (VAR != 1) { float a = max3f(p0[0], p0[1], p1[0]), b = max3f(p0[2], p0[3], p1[1]); a = max3f(a, p1[2], p1[3]); \
              _Pragma("unroll") for (int r = 4; r < 16; r += 4) { a = max3f(a, p0[r], p0[r + 1]); b = max3f(b, p0[r + 2], p0[r + 3]); a = max3f(a, p1[r], p1[r + 1]); b = max3f(b, p1[r + 2], p1[r + 3]); } \
              rm = max2f(a, b); rm = max2f(rm, __shfl_xor(rm, 32)); } \
            if (__any(rm > 0.f)) { \
                const float dl = fmaxf(rm, 0.f), alpha = __builtin_amdgcn_exp2f(-dl); m += dl; l *= alpha; \
                _Pragma("unroll") for (int r = 0; r < 16; ++r) { p0[r] -= dl; p1[r] -= dl; negm[r] = -m; } \
                if (hi == 0) wsf[r32] = alpha; \
                LDS_WAIT(); asm volatile("" ::: "memory"); \
                _Pragma("unroll") for (int r = 0; r < 16; ++r) { const float f = wsf[crow16(r, hi)]; \
                    _Pragma("unroll") for (int dd = 0; dd < NOD; ++dd) o[dd][r] *= f; } \
                LDS_WAIT(); asm volatile("" ::: "memory"); \
            } \
            float ls = 0.f; \
            if (VAR != 1) { _Pragma("unroll") for (int r = 0; r < 16; ++r) { p0[r] = __builtin_amdgcn_exp2f(p0[r]); p1[r] = __builtin_amdgcn_exp2f(p1[r]); ls += p0[r] + p1[r]; } } \
            l += ls; \
            _Pragma("unroll") for (int ks = 0; ks < 4; ++ks) { pg8::u32x4 w; \
                if (ks < 2) { w.x = pg8::cvt_pk_bf16(p0[8 * ks], p0[8 * ks + 1]); w.y = pg8::cvt_pk_bf16(p0[8 * ks + 2], p0[8 * ks + 3]); w.z = pg8::cvt_pk_bf16(p0[8 * ks + 4], p0[8 * ks + 5]); w.w = pg8::cvt_pk_bf16(p0[8 * ks + 6], p0[8 * ks + 7]); } \
                else { const int k2 = ks - 2; w.x = pg8::cvt_pk_bf16(p1[8 * k2], p1[8 * k2 + 1]); w.y = pg8::cvt_pk_bf16(p1[8 * k2 + 2], p1[8 * k2 + 3]); w.z = pg8::cvt_pk_bf16(p1[8 * k2 + 4], p1[8 * k2 + 5]); w.w = pg8::cvt_pk_bf16(p1[8 * k2 + 6], p1[8 * k2 + 7]); } \
                pa[ks] = __builtin_bit_cast(bf16x8_t, w); } } while (0)
#define ATT_PV(sl) do { const LAS unsigned char* vp = vbase + (sl) * VSLOT; \
            _Pragma("unroll") for (int dd = 0; dd < NOD; ++dd) \
                _Pragma("unroll") for (int ks = 0; ks < 4; ++ks) { \
                    const v4i16_t lo = __builtin_amdgcn_ds_read_tr16_b64_v4i16((LAS v4i16_t*)(vp + dd * 4096 + ks * 1024)); \
                    const v4i16_t hh = __builtin_amdgcn_ds_read_tr16_b64_v4i16((LAS v4i16_t*)(vp + dd * 4096 + ks * 1024 + 512)); \
                    const bf16x8_t vf = join_tr(lo, hh); \
                    if (VAR != 2) o[dd] = __builtin_amdgcn_mfma_f32_32x32x16_bf16(pa[ks], vf, o[dd], 0, 0, 0); else o[dd][ks] += __builtin_bit_cast(float, (int)vf[0] + (int)pa[ks][0]); } } while (0)
    int slot = 0, slot_prev = NSLOT - 1, slot_issue = PD % NSLOT;
    for (int t = 0; t < NT; ++t) {
        const int ahead = (t + PD - 1 < NT - 1 ? t + PD - 1 : NT - 1) - t;
        const int nwait = ahead * nld;
        if (nwait <= 0) ATT_BAR(0); else if (nwait == 2) ATT_BAR(2); else if (nwait == 3) ATT_BAR(3); else if (nwait == 4) ATT_BAR(4); else if (nwait == 6) ATT_BAR(6); else if (nwait == 8) ATT_BAR(8); else ATT_BAR(0);
        if (t + PD < NT) ATT_DMA(t + PD, slot_issue);
        if (!late) { if (t <= tlast) { ATT_QKSM(slot); ATT_PV(slot); } }
        else { if (t >= 1 && t - 1 <= tlast) ATT_PV(slot_prev); if (t <= tlast) ATT_QKSM(slot); }
        slot_prev = slot; slot = slot + 1 == NSLOT ? 0 : slot + 1; slot_issue = slot_issue + 1 == NSLOT ? 0 : slot_issue + 1;
    }
    if (late && tlast >= NT - 1) ATT_PV(slot_prev);
    l += __shfl_xor(l, 32);
    if (hi == 0) wsf[32 + r32] = l;
    ATT_BAR(0);
    LAS bf16* stg = (LAS bf16*)(S + KOFF) + wid * 32 * DVW;
#pragma unroll
    for (int r = 0; r < 16; ++r) { const int orow = crow16(r, hi); const float rl = __builtin_amdgcn_rcpf(wsf[32 + orow]);
#pragma unroll
        for (int dd = 0; dd < NOD; ++dd) stg[orow * DVW + dd * 32 + r32] = f2bf(o[dd][r] * rl); }
    LDS_WAIT(); asm volatile("" ::: "memory");
#pragma unroll
    for (int i = 0; i < DVW / 16; ++i) { const int idx = i * 64 + lane, row = idx / (DVW / 8), ch = idx % (DVW / 8);
        *(pg8::u32x4*)(Ou + (size_t)(32 * rg + row) * opitch + dp * DVW + ch * 8) = *(const LAS pg8::u32x4*)(stg + row * DVW + ch * 8); }
    ATT_BAR(0);
#undef ATT_DMA
#undef ATT_QKSM
#undef ATT_PV
}

typedef float f32x2_t __attribute__((ext_vector_type(2)));
DEVI unsigned cvtpk(float lo, float hi) { const f32x2_t v = {lo, hi}; const bf16x2_t b = __builtin_convertvector(v, bf16x2_t); return __builtin_bit_cast(unsigned, b); }
DEVI void attn_mla_unit(LAS unsigned char* S, const bf16* Qu, const bf16* Ku, const bf16* Vu, bf16* Ou, int NT, int qcb) {
    constexpr int NCH = 12, KSLOT = NCH * 1024, VSLOT = 8192, NSLOT = 4, NKS = 6, qpitch = 768, kpitch = 768, vpitch = 512, opitch = D;
    constexpr int KOFF = 0, VOFF = NSLOT * KSLOT, WSF = VOFF + NSLOT * VSLOT;
    int tid_ = threadIdx.x; asm volatile("" : "+v"(tid_));
    const int lane = tid_ & 63, wid = __builtin_amdgcn_readfirstlane(tid_ >> 6), r32 = lane & 31, hi = lane >> 5;
    LAS float* wsf = (LAS float*)(S + WSF) + wid * 64;
    const int nld = wid < 4 ? 3 : 2;
    const bf16* ksrc = Ku + (size_t)lane * kpitch;
    const bf16* vsrc = Vu + (size_t)(lane >> 2) * vpitch + (lane & 3) * 8;
#define MLA_DMA(t, slot) do { \
        glds16(ksrc + (size_t)(t) * 64 * kpitch + wid * 8, LDSADDR(S + KOFF + (slot) * KSLOT + wid * 1024)); \
        if (wid < 4) glds16(ksrc + (size_t)(t) * 64 * kpitch + (wid + 8) * 8, LDSADDR(S + KOFF + (slot) * KSLOT + (wid + 8) * 1024)); \
        glds16(vsrc + (size_t)((t) * 64 + (wid & 3) * 16) * vpitch + (wid >> 2) * 32, LDSADDR(S + VOFF + (slot) * VSLOT + wid * 1024)); } while (0)
#define MLA_BAR(nw) do { if ((nw) <= 0) ATT_BAR(0); else if ((nw) == 2) ATT_BAR(2); else if ((nw) == 3) ATT_BAR(3); else if ((nw) == 4) ATT_BAR(4); else ATT_BAR(6); } while (0)
#define SGB(mask, n) __builtin_amdgcn_sched_group_barrier(mask, n, 0)
    bf16x8_t qr[NKS];
#pragma unroll
    for (int ks = 0; ks < NKS; ++ks) qr[ks] = *(const bf16x8_t*)(Qu + (size_t)(32 * wid + r32) * qpitch + ks * 16 + hi * 8);
#pragma unroll
    for (int ks = 0; ks < NKS; ++ks) asm volatile("" : "+v"(qr[ks]));
    MLA_DMA(0, 0); MLA_DMA(1, 1); MLA_DMA(2, 2);
    f32x16_t o0 = f32x16_t{}, o1 = f32x16_t{};
    float m = 0.f, l = 0.f; f32x16_t negm = f32x16_t{};
    const int tlast = qcb + (wid >> 1);
    const LAS unsigned char* kbase = S + KOFF + hi * 1024 + r32 * 16;
    const LAS unsigned char* vbase = S + VOFF + ((lane >> 4) & 1) * 32 + (lane & 3) * 8 + (4 * hi + ((lane & 15) >> 2)) * 64;
    f32x16_t p0, p1;
#define MLA_ROWMAX(rm, q0, q1) do { float a_ = __builtin_fmaxf(__builtin_fmaxf(q0[0], q0[1]), q1[0]), b_ = __builtin_fmaxf(__builtin_fmaxf(q0[2], q0[3]), q1[1]); a_ = __builtin_fmaxf(__builtin_fmaxf(a_, q1[2]), q1[3]); \
        _Pragma("unroll") for (int r = 4; r < 16; r += 4) { a_ = __builtin_fmaxf(__builtin_fmaxf(a_, q0[r]), q0[r + 1]); b_ = __builtin_fmaxf(__builtin_fmaxf(b_, q0[r + 2]), q0[r + 3]); a_ = __builtin_fmaxf(__builtin_fmaxf(a_, q1[r]), q1[r + 1]); b_ = __builtin_fmaxf(__builtin_fmaxf(b_, q1[r + 2]), q1[r + 3]); } \
        rm = __builtin_fmaxf(a_, b_); rm = __builtin_fmaxf(rm, __shfl_xor(rm, 32)); } while (0)
#define MLA_MOVE(rm, q0, q1) do { if (__any(rm > 0.f)) { \
            const float dl = fmaxf(rm, 0.f), alpha = __builtin_amdgcn_exp2f(-dl); m += dl; l *= alpha; \
            _Pragma("unroll") for (int r = 0; r < 16; ++r) { q0[r] -= dl; q1[r] -= dl; negm[r] = -m; } \
            if (hi == 0) wsf[r32] = alpha; \
            LDS_WAIT(); asm volatile("" ::: "memory"); \
            _Pragma("unroll") for (int r = 0; r < 16; ++r) { const float f = wsf[crow16(r, hi)]; o0[r] *= f; o1[r] *= f; } \
            LDS_WAIT(); asm volatile("" ::: "memory"); } } while (0)
    MLA_BAR(2 * nld);
    MLA_DMA(3, 3);
    { const LAS unsigned char* kp = kbase; p0 = negm; p1 = negm;
#pragma unroll
      for (int ks = 0; ks < NKS; ++ks) { const bf16x8_t a0 = *(const LAS bf16x8_t*)(kp + ks * 2048), a1 = *(const LAS bf16x8_t*)(kp + ks * 2048 + 512);
          p0 = __builtin_amdgcn_mfma_f32_32x32x16_bf16(a0, qr[ks], p0, 0, 0, 0); p1 = __builtin_amdgcn_mfma_f32_32x32x16_bf16(a1, qr[ks], p1, 0, 0, 0); }
      float rm; MLA_ROWMAX(rm, p0, p1); MLA_MOVE(rm, p0, p1); }
    int kslot = 1, vslot = 0, islot = 3;
    for (int t = 0; t < NT; ++t) {
        if (t + 1 < NT) { const int young = (t + 2 < NT) ? 1 : 0; MLA_BAR(young * nld); } else ATT_BAR(0);
        if (t >= 1 && t + 3 < NT) MLA_DMA(t + 3, islot);
        if (t < tlast) {
            const LAS unsigned char* kp = kbase + kslot * KSLOT; const LAS unsigned char* vp = vbase + vslot * VSLOT;
            bf16x8_t kf[12];
#pragma unroll
            for (int ks = 0; ks < NKS; ++ks) { kf[2 * ks] = *(const LAS bf16x8_t*)(kp + ks * 2048); kf[2 * ks + 1] = *(const LAS bf16x8_t*)(kp + ks * 2048 + 512); }
            f32x16_t n0 = negm, n1 = negm; float ls = 0.f; pg8::u32x4 pw[4];
#pragma unroll
            for (int ks = 0; ks < NKS; ++ks) { n0 = __builtin_amdgcn_mfma_f32_32x32x16_bf16(kf[2 * ks], qr[ks], n0, 0, 0, 0); n1 = __builtin_amdgcn_mfma_f32_32x32x16_bf16(kf[2 * ks + 1], qr[ks], n1, 0, 0, 0); }
#pragma unroll
            for (int r = 0; r < 16; ++r) { p0[r] = __builtin_amdgcn_exp2f(p0[r]); p1[r] = __builtin_amdgcn_exp2f(p1[r]); }
#pragma unroll
            for (int r = 0; r < 16; r += 2) { ls += (p0[r] + p0[r + 1]) + (p1[r] + p1[r + 1]); }
#pragma unroll
            for (int ks = 0; ks < 2; ++ks) { pw[ks] = (pg8::u32x4){cvtpk(p0[8 * ks], p0[8 * ks + 1]), cvtpk(p0[8 * ks + 2], p0[8 * ks + 3]), cvtpk(p0[8 * ks + 4], p0[8 * ks + 5]), cvtpk(p0[8 * ks + 6], p0[8 * ks + 7])};
                pw[2 + ks] = (pg8::u32x4){cvtpk(p1[8 * ks], p1[8 * ks + 1]), cvtpk(p1[8 * ks + 2], p1[8 * ks + 3]), cvtpk(p1[8 * ks + 4], p1[8 * ks + 5]), cvtpk(p1[8 * ks + 6], p1[8 * ks + 7])}; }
            l += ls;
            SGB(0x100, 4);
#pragma unroll
            for (int i = 0; i < 12; ++i) { SGB(0x008, 1); SGB(0x002, 7); if (i < 8) SGB(0x100, 1); }
            __builtin_amdgcn_sched_barrier(0);
            v4i16_t vlo[8], vhi[8];
#pragma unroll
            for (int i = 0; i < 8; ++i) { vlo[i] = __builtin_amdgcn_ds_read_tr16_b64_v4i16((LAS v4i16_t*)(vp + (i >> 2) * 4096 + (i & 3) * 1024)); vhi[i] = __builtin_amdgcn_ds_read_tr16_b64_v4i16((LAS v4i16_t*)(vp + (i >> 2) * 4096 + (i & 3) * 1024 + 512)); }
#pragma unroll
            for (int i = 0; i < 8; ++i) { const bf16x8_t vf = join_tr(vlo[i], vhi[i]); const bf16x8_t pa_ = __builtin_bit_cast(bf16x8_t, pw[i & 3]);
                if (i < 4) o0 = __builtin_amdgcn_mfma_f32_32x32x16_bf16(pa_, vf, o0, 0, 0, 0); else o1 = __builtin_amdgcn_mfma_f32_32x32x16_bf16(pa_, vf, o1, 0, 0, 0); }
            float rm; MLA_ROWMAX(rm, n0, n1);
            SGB(0x100, 6);
#pragma unroll
            for (int i = 0; i < 8; ++i) { SGB(0x008, 1); SGB(0x002, 3); if (i < 5) SGB(0x100, 2); }
            __builtin_amdgcn_sched_barrier(0);
            MLA_MOVE(rm, n0, n1);
            p0 = n0; p1 = n1;
        } else if (t == tlast) {
            asm volatile("" : "+v"(p0), "+v"(p1));
            const LAS unsigned char* vp = vbase + vslot * VSLOT; float ls = 0.f; pg8::u32x4 pw[4];
#pragma unroll
            for (int r = 0; r < 16; ++r) { p0[r] = __builtin_amdgcn_exp2f(p0[r]); p1[r] = __builtin_amdgcn_exp2f(p1[r]); ls += p0[r] + p1[r]; }
            l += ls;
#pragma unroll
            for (int ks = 0; ks < 2; ++ks) { pw[ks] = (pg8::u32x4){cvtpk(p0[8 * ks], p0[8 * ks + 1]), cvtpk(p0[8 * ks + 2], p0[8 * ks + 3]), cvtpk(p0[8 * ks + 4], p0[8 * ks + 5]), cvtpk(p0[8 * ks + 6], p0[8 * ks + 7])};
                pw[2 + ks] = (pg8::u32x4){cvtpk(p1[8 * ks], p1[8 * ks + 1]), cvtpk(p1[8 * ks + 2], p1[8 * ks + 3]), cvtpk(p1[8 * ks + 4], p1[8 * ks + 5]), cvtpk(p1[8 * ks + 6], p1[8 * ks + 7])}; }
#pragma unroll
            for (int i = 0; i < 8; ++i) { const v4i16_t lo = __builtin_amdgcn_ds_read_tr16_b64_v4i16((LAS v4i16_t*)(vp + (i >> 2) * 4096 + (i & 3) * 1024)), hh = __builtin_amdgcn_ds_read_tr16_b64_v4i16((LAS v4i16_t*)(vp + (i >> 2) * 4096 + (i & 3) * 1024 + 512));
                const bf16x8_t vf = join_tr(lo, hh); const bf16x8_t pa_ = __builtin_bit_cast(bf16x8_t, pw[i & 3]);
                if (i < 4) o0 = __builtin_amdgcn_mfma_f32_32x32x16_bf16(pa_, vf, o0, 0, 0, 0); else o1 = __builtin_amdgcn_mfma_f32_32x32x16_bf16(pa_, vf, o1, 0, 0, 0); }
        }
        kslot = (kslot + 1) & 3; vslot = (vslot + 1) & 3; islot = (islot + 1) & 3;
    }
    l += __shfl_xor(l, 32);
    if (hi == 0) wsf[32 + r32] = l;
    ATT_BAR(0);
    LAS bf16* stg = (LAS bf16*)(S + KOFF) + wid * 32 * 64;
#pragma unroll
    for (int r = 0; r < 16; ++r) { const int orow = crow16(r, hi); const float rl = __builtin_amdgcn_rcpf(wsf[32 + orow]);
        stg[orow * 64 + r32] = f2bf(o0[r] * rl); stg[orow * 64 + 32 + r32] = f2bf(o1[r] * rl); }
    LDS_WAIT(); asm volatile("" ::: "memory");
#pragma unroll
    for (int i = 0; i < 4; ++i) { const int idx = i * 64 + lane, row = idx >> 3, ch = idx & 7;
        *(pg8::u32x4*)(Ou + (size_t)(32 * wid + row) * opitch + ch * 8) = *(const LAS pg8::u32x4*)(stg + row * 64 + ch * 8); }
    ATT_BAR(0);
#undef MLA_DMA
#undef MLA_BAR
#undef MLA_ROWMAX
#undef MLA_MOVE
#undef SGB
}

DEVI bool unit_of(int Mrows, int Ncols, int G, int c, int i, int& pm, int& pn) {
    const int nM = Mrows / 256, nN = Ncols / 256, nwg = nM * nN; const long Lq = (long)i * G + c; if (Lq >= nwg) return false;
    int wgid = (int)Lq; { const int q = nwg / 8, r = nwg % 8, xcd = wgid % 8, off = wgid / 8; wgid = (xcd < r ? xcd * (q + 1) : r * (q + 1) + (xcd - r) * q) + off; }
    const int nig = 8 * nN, gid = wgid / nig, fm = gid * 8, gsz = (nM - fm) < 8 ? (nM - fm) : 8;
    pm = fm + ((wgid % nig) % gsz); pn = (wgid % nig) / gsz; return true;
}
DEVI void own_writes_visible() {
    asm volatile("s_waitcnt vmcnt(0)" ::: "memory"); __syncthreads();
    if (threadIdx.x == 0) { __builtin_amdgcn_fence(__ATOMIC_ACQUIRE, "agent"); asm volatile("s_waitcnt vmcnt(0)" ::: "memory"); }
    __syncthreads();
}

__global__ void __launch_bounds__(NTHR, 2) mega(Args args) {
    extern __shared__ __attribute__((aligned(16))) unsigned char lds[];
    const int tid = threadIdx.x, lane = tid & 63, wave = __builtin_amdgcn_readfirstlane(tid >> 6);
    const int G = gridDim.x, bx = blockIdx.x; const int vcu = (G % 8 == 0) ? (bx % 8) * (G / 8) + bx / 8 : bx;
    LAS unsigned char* L = (LAS unsigned char*)lds + PH_BASE;
    volatile LAS unsigned* MISC = (volatile LAS unsigned*)((LAS unsigned char*)lds + LDSCTL_OFF + 320);
    unsigned char* ws = args.ws; gu32* ctl = (gu32*)(ws + WS_CTL);
    if (tid < PH_BASE / 4) ((LAS unsigned*)(lds))[tid] = 0u;
    __syncthreads();
    XcdBarrier bar = xcd_barrier_post((unsigned*)(ctl + CW_BAR) + args.li * XCD_BAR_WORDS, MISC + 8);
    const unsigned mask = args.mask;
#define IN(k) ((mask >> (k)) & 1u)
#ifndef PROBE_ATTVAR
#define PROBE_ATTVAR 0
#endif
#ifndef PROBE_EXPVAR
#define PROBE_EXPVAR 0
#endif
#ifndef PROBE_REP
#define PROBE_REP 0u
#endif
#define NREP(k) (1 + (int)((PROBE_REP >> (k)) & 1u))
#define SEAM(k) do { if ((mask & ((1u << PH_N) - 1u)) >> ((k) + 1)) xcd_barrier(bar); } while (0)
    const float* x = args.in[0]; float* out = args.out;
    bf16 *Wt_in = (bf16*)(ws + WS_WIN), *Wt_qup = (bf16*)(ws + WS_WQUP), *Wt_kv = (bf16*)(ws + WS_WKV), *Wt_mix = (bf16*)(ws + WS_WMIX), *Wt_mq = (bf16*)(ws + WS_WMQ), *Wt_mkv = (bf16*)(ws + WS_WMKV),
         *Wt_mo = (bf16*)(ws + WS_WMO), *Wt_pq = (bf16*)(ws + WS_WPQ), *SK = (bf16*)(ws + WS_SK), *MEMN = (bf16*)(ws + WS_MEMN), *MEMKV = (bf16*)(ws + WS_MEMKV), *PU = (bf16*)(ws + WS_PU), *PV = (bf16*)(ws + WS_PV);
    float *partq = (float*)(ws + WS_PARTQ), *partkv = (float*)(ws + WS_PARTKV), *part1 = (float*)(ws + WS_PART1), *part2 = (float*)(ws + WS_PART2), *trig = (float*)(ws + WS_TRIG);
    bf16 *XN = (bf16*)(ws + WS_R1), *CONCAT = XN, *QM = XN, *H2B = XN;
    bf16 *CQ = (bf16*)(ws + WS_R2 + R2_CQ), *CKV = (bf16*)(ws + WS_R2 + R2_CKV), *U = (bf16*)(ws + WS_R2 + R2_U), *H1B = (bf16*)(ws + WS_R2), *OM = (bf16*)(ws + WS_R3);
    bf16 *QB = (bf16*)(ws + WS_R3 + R3_QB), *KB = (bf16*)(ws + WS_R3 + R3_KB), *VB = (bf16*)(ws + WS_R3 + R3_VB), *QP = (bf16*)(ws + WS_R3);


    if (IN(PH_PRO)) {
        for (int rep_ = 0; rep_ < NREP(PH_PRO); ++rep_) { if (rep_) xcd_barrier(bar);
        LAS float* scr = (LAS float*)(L + wave * 16384);
        const int gw = vcu * NWAVES + wave, NGW = G * NWAVES;
        constexpr int I_IN = (D / 64) * (INP / 32), I_QUP = (256 / 64) * (768 / 32), I_KV = (128 / 64) * (1024 / 32), I_SQ = (D / 64) * (D / 32), I_W2 = (D / 64) * (2048 / 32);
        constexpr int NITEMS = I_IN + I_QUP + I_KV + 2 * I_SQ + 2 * I_W2;
        for (int rp_ = 0; rp_ < 1 + (int)((PROBE_REP >> 20) & 1u); ++rp_)
        for (int it = gw; it < NITEMS; it += NGW) {
            int r = it;
            if (r < I_IN) { p0_transpose_item<1, false>(args.in[3], D, INC, Wt_in, INP, nullptr, scr, r, lane); continue; } r -= I_IN;
            if (r < I_QUP) { p0_transpose_item<0, true>(args.in[5], 256, 768, Wt_qup, 768, args.in[4], scr, r, lane); continue; } r -= I_QUP;
            if (r < I_KV) { p0_transpose_item<2, true>(args.in[7], 128, 1024, Wt_kv, 1024, args.in[6], scr, r, lane); continue; } r -= I_KV;
            if (r < I_SQ) { p0_transpose_item<0, false>(args.in[12], D, D, Wt_mix, D, nullptr, scr, r, lane); continue; } r -= I_SQ;
            if (r < I_SQ) { p0_transpose_item<0, false>(args.in[17], D, D, Wt_mo, D, nullptr, scr, r, lane); continue; } r -= I_SQ;
            if (r < I_W2) { p0_transpose_item<0, false>(args.in[16], D, 2048, Wt_mkv, 2048, nullptr, scr, r, lane); continue; } r -= I_W2;
            p0_transpose_item<0, true>(args.in[19], D, 2048, Wt_pq, 2048, args.in[18], scr, r, lane);
        }
        for (int rp_ = 0; rp_ < 1 + (int)((PROBE_REP >> 21) & 1u); ++rp_)
        for (int m = gw; m < M; m += 4 * NGW) rms_rows4_to_bf16(x, args.in[2], XN, m, NGW, M, lane);
        for (int m = gw; m < BATCH * NMEM; m += NGW) rms_row_to_bf16(args.in[1] + (size_t)m * D, args.in[14], MEMN + (size_t)m * D, lane);
        const size_t gtid = (size_t)vcu * NTHR + tid, gn = (size_t)G * NTHR;
        cvt_stream(args.in[20], SK, (size_t)PH * 2 * PNK * PHALF / 8, nullptr, gtid, gn);
        for (size_t i = gtid; i < (size_t)D * D / 8; i += gn) {
            const float4 a = *(const float4*)(args.in[15] + i * 8), b = *(const float4*)(args.in[15] + i * 8 + 4); const float gk = args.in[13][(i * 8) >> 10];
            pg8::u32x4 o; o.x = pg8::cvt_pk_bf16(a.x * gk, a.y * gk); o.y = pg8::cvt_pk_bf16(a.z * gk, a.w * gk); o.z = pg8::cvt_pk_bf16(b.x * gk, b.y * gk); o.w = pg8::cvt_pk_bf16(b.z * gk, b.w * gk);
            *(pg8::u32x4*)(Wt_mq + i * 8) = o; }
        for (int rp_ = 0; rp_ < 1 + (int)((PROBE_REP >> 22) & 1u); ++rp_) {
        cvt_rows_fp6<true>(args.in[21], (unsigned char*)PU, args.in[18], PU_SCALE, gtid, gn);
        cvt_rows_fp6<false>(args.in[22], (unsigned char*)PV, nullptr, PV_SCALE, gtid, gn); }
        for (size_t i = gtid; i < (size_t)SEQ * 16; i += gn) { float c, s; rope_cs((int)(i >> 4), (int)(i & 15), c, s); *(float2*)(trig + i * 2) = make_float2(c, s); }
        }
        SEAM(PH_PRO);
    }
    if (IN(PH_PROJ)) {
        for (int rep_ = 0; rep_ < NREP(PH_PROJ); ++rep_) { if (rep_) xcd_barrier(bar);
        { pg8::Gemm g{XN, Wt_in, M, INP, D, 0, 0, 0, 0}; pg8::StaticOrder S; S.init(M, INP, G, bx); pg8::EpiProj E{CQ, CKV, KB, U, partq, partkv, trig};
          pg8::gemm_phase<pg8::EpiProj, pg8::StaticOrder, true, true>(L, g, S, E); }
        { pg8::Gemm g{MEMN, Wt_mkv, BATCH * NMEM, 2048, D, 0, 0, 0, 0}; pg8::StaticOrder S; S.init(BATCH * NMEM, 2048, G, (bx + 128) % G); pg8::EpiPlain E{MEMKV, 2048};
          pg8::gemm_phase<pg8::EpiPlain, pg8::StaticOrder, true, true>(L, g, S, E); }
        }
        SEAM(PH_PROJ);
    }
    if (IN(PH_UP)) {
        for (int rep_ = 0; rep_ < NREP(PH_UP); ++rep_) { if (rep_) xcd_barrier(bar);
        if (IN(PHB_UPG)) {
        { pg8::Gemm g{CQ, Wt_qup, M, 768, 256, 0, 0, 0, 0}; pg8::StaticOrder S; S.init(M, 768, G, bx); pg8::EpiQ E{QB, partq, trig, LOG2E * 0.10206207261596577f};
          pg8::gemm_phase<pg8::EpiQ, pg8::StaticOrder, true, true>(L, g, S, E); }
        { pg8::Gemm g{CKV, Wt_kv, M, 1024, 128, 0, 0, 0, 0}; pg8::StaticOrder S; S.init(M, 1024, G, (bx + 192) % G); pg8::EpiKV E{KB, VB, partkv};
          pg8::gemm_phase<pg8::EpiKV, pg8::StaticOrder, true, true>(L, g, S, E); }
        }
        if (IN(PHB_CONV)) { __syncthreads(); for (int c = vcu; c < M / 64; c += G) conv_chunk(c, U, args.in[8], args.in[9], args.in[10], args.in[11], CONCAT, L); }
        }
        SEAM(PH_UP);
    }
    if (IN(PH_ATTN)) {
        for (int rep_ = 0; rep_ < NREP(PH_ATTN); ++rep_) { if (rep_) xcd_barrier(bar);
        for (int u = vcu; u < 512; u += G) { const int bh = (u & 255) >> 4, sidx = u & 15, qb = u < 256 ? 31 - sidx : sidx, b = bh >> 3, h = bh & 7;
            const size_t r0 = (size_t)b * SEQ;
            if (NREP(PH_ATTN) > 1 && rep_ == 0) attn_unit<96, 64, 1, 4, 3, true, false, PROBE_ATTVAR>(L, QB + (r0 + qb * 256) * 768 + h * 96, 768, KB + r0 * 768 + h * 96, 768, VB + r0 * 512 + h * 64, 512, CONCAT + (r0 + qb * 256) * D + h * 64, D, 4 * qb + 4, 4 * qb);
            else attn_mla_unit(L, QB + (r0 + qb * 256) * 768 + h * 96, KB + r0 * 768 + h * 96, VB + r0 * 512 + h * 64, CONCAT + (r0 + qb * 256) * D + h * 64, 4 * qb + 4, 4 * qb); }
        }
        { bf16* KQT = (bf16*)(ws + WS_KQT); bf16* VOT = (bf16*)(ws + WS_VOT);
#pragma unroll 1
          for (int bh = 0; bh < BATCH * XH; ++bh) { const int b = bh >> 2, h = bh & 3;
            { pg8::Gemm g{MEMKV + (size_t)b * NMEM * 2048 + h * XD, Wt_mq + h * XD, NMEM, D, XD, 2048, D, 0, 0}; pg8::StaticOrder S; S.init(NMEM, D, G, (bx + 8 * bh) % G);
              pg8::EpiPlain E{KQT + (size_t)b * D * D + (size_t)h * XD * D, D}; pg8::gemm_phase<pg8::EpiPlain, pg8::StaticOrder, true, true>(L, g, S, E); }
            { pg8::Gemm g{Wt_mo + h * XD, MEMKV + (size_t)b * NMEM * 2048 + 1024 + h * XD, D, NMEM, XD, D, 2048, 0, 0}; pg8::StaticOrder S; S.init(D, NMEM, G, (bx + 8 * bh + 4) % G);
              pg8::EpiPlain E{VOT + (size_t)b * D * D + h * XD, D}; pg8::gemm_phase<pg8::EpiPlain, pg8::StaticOrder, true, true>(L, g, S, E); } } }
        SEAM(PH_ATTN);
    }
    if (IN(PH_MIX)) {
        for (int rep_ = 0; rep_ < NREP(PH_MIX); ++rep_) { if (rep_) xcd_barrier(bar);
        pg8::Gemm g{CONCAT, Wt_mix, M, D, D, 0, 0, 0, 0}; pg8::StaticOrder S; S.init(M, D, G, bx); pg8::EpiRes<false> E{x, nullptr, H1B, part1};
        pg8::gemm_phase<pg8::EpiRes<false>, pg8::StaticOrder, true, true>(L, g, S, E);
        }
        SEAM(PH_MIX);
    }
    if (IN(PH_MEMQ)) {
        for (int rep_ = 0; rep_ < NREP(PH_MEMQ); ++rep_) { if (rep_) xcd_barrier(bar);
        pg8::Gemm g{H1B, (const bf16*)(ws + WS_KQT), M, D, D, 0, 0, SEQ / 256, (size_t)D * D * 2}; pg8::StaticOrder S; S.init(M, D, G, bx);
        pg8::EpiSoftmaxP E{OM, D, part1, LOG2E / 16.0f, (LAS float*)(L + 131072)};
        pg8::gemm_phase<pg8::EpiSoftmaxP, pg8::StaticOrder, true, true>(L, g, S, E);
        }
        SEAM(PH_MEMQ);
    }
    if (IN(PH_MEMO)) {
        pg8::Gemm g{OM, (const bf16*)(ws + WS_VOT), M, D, D, 0, 0, SEQ / 256, (size_t)D * D * 2};   pg8::StaticOrder S; S.init(M, D, G, bx); pg8::EpiRes<true> E{nullptr, H1B, H2B, part2};
        pg8::gemm_phase<pg8::EpiRes<true>, pg8::StaticOrder, true, true>(L, g, S, E);
        SEAM(PH_MEMO);
    }
    if (IN(PH_PQ)) {
        for (int rep_ = 0; rep_ < NREP(PH_PQ); ++rep_) { if (rep_) xcd_barrier(bar);
        pg8::Gemm g{H2B, Wt_pq, M, 2048, D, 0, 0, 0, 0}; pg8::StaticOrder S; S.init(M, 2048, G, bx); pg8::EpiScaled E{QP, 2048, part2, 1.0f};
        pg8::gemm_phase<pg8::EpiScaled, pg8::StaticOrder, true, true>(L, g, S, E);
        own_writes_visible();
        int* EIDX = (int*)(ws + WS_R2 + R2_EIDX); float* EGATE = (float*)(ws + WS_R2 + R2_EGATE);
        LAS unsigned* scr = (LAS unsigned*)(L + 65536 + wave * 64 * 9 * 4);
        int hl = -1, upm, upn;
        for (int i = 0; unit_of(M, 2048, G, bx, i, upm, upn); ++i) { const int tb = upm, h = upn;
            if (h != hl) {
                __syncthreads();
                for (int pc = tid; pc < 4096; pc += NTHR) { const int p = pc >> 11, n = (pc >> 4) & 127, c = pc & 15;
                    *(LAS pg8::u32x4*)(L + p * 32768 + c * 2048 + n * 16) = *(const pg8::u32x4*)(SK + ((size_t)(h * 2 + p) * 128 + n) * 128 + c * 8); }
                __syncthreads(); hl = h; }
            const int token = tb * 256 + wave * 32 + (lane & 31);
            topk_wave(QP + (size_t)token * 2048 + h * 256, L, scr, EIDX + (size_t)token * 128 + h * 16, EGATE + (size_t)token * 128 + h * 16, lane); }
        __syncthreads();
        }
        SEAM(PH_PQ);
    }
    if (IN(PH_EXP)) {
        const int* EIDX = (const int*)(ws + WS_R2 + R2_EIDX); const float* EGATE = (const float*)(ws + WS_R2 + R2_EGATE);
#ifndef EXP_PREWARM
#define EXP_PREWARM 0
#endif
        if (EXP_PREWARM) {
            const pg8::u32x4* tb = (const pg8::u32x4*)PU; pg8::u32x4 x = {0u, 0u, 0u, 0u};
            for (size_t i = (size_t)vcu * NTHR + tid; i < (size_t)2 * PE * D / 16; i += (size_t)G * NTHR) { const pg8::u32x4 v = __builtin_nontemporal_load(tb + i); x ^= v; }
            if ((x[0] ^ x[1] ^ x[2] ^ x[3]) == 0x9e3779b9u && tid == 999) out[0] = 0.f;
        }
        for (int rep_ = NREP(PH_EXP) - 1; rep_ >= 0; --rep_) { float* dst = rep_ ? (float*)(ws + WS_R3) : out;
            if (rep_) { if (PROBE_EXPVAR != 5 || wave < 4) experts_wave<PROBE_EXPVAR == 5 ? 0 : PROBE_EXPVAR>(L + wave * EXP_LDS_WAVE, vcu * NWAVES + wave, G * NWAVES, H2B, part2, (const unsigned char*)PU, (const unsigned char*)PV, EIDX, EGATE, args.in[23], dst, lane); } else
            experts_wave<0>(L + wave * EXP_LDS_WAVE, vcu * NWAVES + wave, G * NWAVES, H2B, part2, (const unsigned char*)PU, (const unsigned char*)PV, EIDX, EGATE, args.in[23], dst, lane);
            if (rep_) xcd_barrier(bar); }
    }
#undef IN
#undef SEAM
}

#define FAST_MASK ((1u << PH_PRO) | (1u << PH_PROJ) | (1u << PH_UP) | (1u << PHB_UPG) | (1u << PHB_CONV) | (1u << PH_ATTN) | (1u << PH_MIX) | (1u << PH_MEMQ) | (1u << PH_MEMO) | (1u << PH_PQ) | (1u << PH_EXP))
extern "C" void kernel_launch(void* const* d_in, const int* in_sizes, int n_in, void* d_out, int out_size, void* d_ws, size_t ws_size, hipStream_t stream) {
    if (n_in != 24 || out_size != M * D || ws_size < WS_END) { fprintf(stderr, "kernel_launch: unexpected problem (n_in %d out %d ws %zu)\n", n_in, out_size, ws_size); return; }
    static int grid = 0;
    if (grid == 0) {
        int dev = 0, cus = 0, per_cu = 0;
        if (hipGetDevice(&dev) != hipSuccess || hipDeviceGetAttribute(&cus, hipDeviceAttributeMultiprocessorCount, dev) != hipSuccess) { grid = -1; return; }
        if (hipFuncSetAttribute((const void*)mega, hipFuncAttributeMaxDynamicSharedMemorySize, LDS_BYTES) != hipSuccess) { fprintf(stderr, "kernel_launch: hipFuncSetAttribute failed\n"); grid = -1; return; }
        if (hipOccupancyMaxActiveBlocksPerMultiprocessor(&per_cu, (const void*)mega, NTHR, LDS_BYTES) != hipSuccess || per_cu < 1) { fprintf(stderr, "kernel_launch: occupancy query says %d blocks per CU\n", per_cu); grid = -1; (void)hipGetLastError(); return; }
        grid = cus;
    }
    if (grid < 0) return;
    (void)hipMemsetAsync((char*)d_ws + WS_CTL, 0, CTL_ZERO_BYTES, stream);
    Args a{}; for (int i = 0; i < 24; ++i) a.in[i] = (const float*)d_in[i]; a.out = (float*)d_out; a.ws = (unsigned char*)d_ws; a.mask = FAST_MASK; a.li = 0;
    hipLaunchKernelGGL(mega, dim3(grid), dim3(NTHR), LDS_BYTES, stream, a);
}
```

```cpp
#include <hip/hip_runtime.h>
#include <cstdio>
#include <cstdint>

typedef unsigned short bf16;
#define DEVI __device__ __forceinline__

constexpr int D = 1024, BATCH = 2, SEQ = 8192, M = BATCH * SEQ;
constexpr int NMEM = 256;
constexpr int MH = 8, QRANK = 256, KVRANK = 128, NOPE = 64, ROPE = 32, VD = 64, QK = NOPE + ROPE;
constexpr int CW = 512, CK = 31;
constexpr int INC = QRANK + KVRANK + ROPE + 2 * CW;
constexpr int INP = 1536;
constexpr int XH = 4, XD = 256;
constexpr int PH = 8, PNK = 128, PHALF = 128, PTOP = 16, PE = PNK * PNK;
constexpr float EPS = 1e-6f;
constexpr float LOG2E = 1.4426950408889634f;
constexpr float PU_SCALE = 64.0f, PV_SCALE = 4.0f;

constexpr size_t MiB = 1u << 20;
constexpr size_t WS_CTL = 0;
constexpr size_t WS_WIN = 1 * MiB;
constexpr size_t WS_WQUP = 4 * MiB;
constexpr size_t WS_WKV = 5 * MiB;
constexpr size_t WS_WMIX = 6 * MiB;
constexpr size_t WS_WMQ = 8 * MiB;
constexpr size_t WS_WMKV = 10 * MiB;
constexpr size_t WS_WMO = 14 * MiB;
constexpr size_t WS_WPQ = 16 * MiB;
constexpr size_t WS_SK = 20 * MiB;
constexpr size_t WS_MEMN = 21 * MiB;
constexpr size_t WS_MEMKV = 22 * MiB;
constexpr size_t WS_PARTQ = 24 * MiB;
constexpr size_t WS_PARTKV = 24 * MiB + 512 * 1024;
constexpr size_t WS_PART1 = 25 * MiB;
constexpr size_t WS_PART2 = 26 * MiB;
constexpr size_t WS_PU = 28 * MiB;
constexpr size_t WS_PV = 60 * MiB;
constexpr size_t WS_R1 = 92 * MiB;
constexpr size_t WS_R2 = 124 * MiB;
constexpr size_t WS_R3 = 156 * MiB;
constexpr size_t WS_KQT = 220 * MiB;
constexpr size_t WS_VOT = 224 * MiB;
constexpr size_t WS_END = 228 * MiB;
constexpr size_t R2_CQ = 0, R2_CKV = 8 * MiB, R2_U = 12 * MiB;
constexpr size_t R2_EIDX = 0, R2_EGATE = 8 * MiB;
constexpr size_t R3_QB = 0, R3_KB = 24 * MiB, R3_VB = 48 * MiB;

DEVI bf16 f2bf(float f) { unsigned u = __builtin_bit_cast(unsigned, f); return (bf16)((u + 0x7fffu + ((u >> 16) & 1u)) >> 16); }
DEVI float bf2f(bf16 b) { return __builtin_bit_cast(float, (unsigned)b << 16); }
DEVI float dotbf(const bf16* a, const bf16* b, int K) {
    float s = 0.f;
    for (int k = 0; k < K; k += 8) {
        uint4 x = *(const uint4*)(a + k), y = *(const uint4*)(b + k);
        const unsigned xs[4] = {x.x, x.y, x.z, x.w}, ys[4] = {y.x, y.y, y.z, y.w};
#pragma unroll
        for (int i = 0; i < 4; ++i) {
            s += __builtin_bit_cast(float, xs[i] << 16) * __builtin_bit_cast(float, ys[i] << 16);
            s += __builtin_bit_cast(float, xs[i] & 0xffff0000u) * __builtin_bit_cast(float, ys[i] & 0xffff0000u);
        }
    }
    return s;
}
DEVI float wave_sum(float v) {
#pragma unroll
    for (int o = 1; o < 64; o <<= 1) v += __shfl_xor(v, o);
    return v;
}
DEVI float wave_max(float v) {
#pragma unroll
    for (int o = 1; o < 64; o <<= 1) v = fmaxf(v, __shfl_xor(v, o));
    return v;
}
DEVI void rope_cs(int pos, int i, float& c, float& s) {
    const float inv = exp2f(-(float)i * (13.287712379549449f / 16.0f));
    const float ang = (float)pos * inv;
    const double a = (double)ang; const double k = rint(a * 0.15915494309189535); const float r = (float)(a - k * 6.283185307179586);
    s = sinf(r); c = cosf(r);
}
DEVI int win_src(int r) {
    if (r < 416) return r;
    if (r < 512) return -1;
    const int t = (r - 512) >> 8, w = (r - 512) & 255, bj = w >> 7, j = w & 127, ch = 128 * t + j;
    return 416 + (bj ? CW : 0) + ch;
}
DEVI int wkv_src(int r) { return r < 512 ? (r >> 6) * 128 + (r & 63) : ((r - 512) >> 6) * 128 + 64 + ((r - 512) & 63); }

namespace pg8 {
#define PG8_LAS __attribute__((address_space(3)))
typedef unsigned short bf16_t;
typedef short bf16x8 __attribute__((ext_vector_type(8)));
typedef float f32x4 __attribute__((ext_vector_type(4)));
typedef unsigned u32x4 __attribute__((ext_vector_type(4)));
constexpr int BM = 256, BK = 64, HALF = 128, HTB = HALF * BK * 2  , STAGE_BYTES = 8 * HTB, NXCD = 8, WGM = 8;

__host__ __device__ __forceinline__ int lds_byte(int r, int c) { const int st = (r >> 4) * 2 + (c >> 5), rr = r & 15, cc = c & 31, ob = rr * 64 + cc * 2; return st * 1024 + (ob ^ (((ob >> 9) & 1) << 5)); }
__host__ __device__ __forceinline__ void stage_rc(int b, int& R, int& C) { const int st = b / 1024, sb = b % 1024, swz = sb ^ (((sb >> 9) & 1) << 5); R = (st >> 1) * 16 + swz / 64; C = (st & 1) * 32 + (swz % 64) / 2; }
__host__ __device__ __forceinline__ int perm32(int rho) { const int n = rho >> 4, i = rho & 15; return 8 * (i >> 2) + 4 * n + (i & 3); }

struct Unit { int pm, pn; };
struct Gemm { const bf16_t* A; const bf16_t* Bt; int M, N, K; int lda, ldb; int mb; size_t bstride; };

struct StaticOrder {
    int nM, nN, nwg, G, c;
    __host__ __device__ void init(int M, int N, int G_, int c_) { nM = M / BM; nN = N / BM; nwg = nM * nN; G = G_; c = c_; }
    __host__ __device__ bool next(int i, Unit& u) const {
        const long L = (long)i * G + c; if (L >= nwg) return false;
        int wgid = (int)L; { const int q = nwg / NXCD, r = nwg % NXCD, xcd = wgid % NXCD, off = wgid / NXCD; wgid = (xcd < r ? xcd * (q + 1) : r * (q + 1) + (xcd - r) * q) + off; }
        const int nig = WGM * nN, gid = wgid / nig, fm = gid * WGM, gsz = (nM - fm) < WGM ? (nM - fm) : WGM;
        u.pm = fm + ((wgid % nig) % gsz); u.pn = (wgid % nig) / gsz; return true;
    }
    __device__ __forceinline__ void a_ready(const Unit&) const {}
    __device__ __forceinline__ void done(const Unit&) const {}
};


typedef float f32x2 __attribute__((ext_vector_type(2)));
typedef unsigned u32x2 __attribute__((ext_vector_type(2)));
__device__ __forceinline__ unsigned cvt_pk_bf16(float lo, float hi) { unsigned r; asm volatile("v_cvt_pk_bf16_f32 %0, %1, %2" : "=v"(r) : "v"(lo), "v"(hi)); return r; }
__device__ __forceinline__ void st_bf4(bf16_t* p, f32x4 v) { u32x2 w; w.x = cvt_pk_bf16(v[0], v[1]); w.y = cvt_pk_bf16(v[2], v[3]); *(u32x2*)p = w; }
__device__ __forceinline__ float sq4(f32x4 v) { return (v[0] * v[0] + v[1] * v[1]) + (v[2] * v[2] + v[3] * v[3]); }
__device__ __forceinline__ float red_fq(float s) { s += __shfl_xor(s, 16); s += __shfl_xor(s, 32); return s; }

struct EpiProj {
    static constexpr bool PERM = false, AFTER_DRAIN = false;
    bf16_t *CQ, *CKV, *KB, *U; float *partq, *partkv; const float* trig;
    __device__ __forceinline__ void operator()(const f32x4 (&acc)[2][2][4][2], const Unit& u, int wr, int wc, int fr, int fq) const {
        const int row0 = u.pm * BM + wr * 64 + fr;
        if (u.pn == 0) {
#pragma unroll
            for (int ai = 0; ai < 2; ++ai)
#pragma unroll
                for (int m = 0; m < 4; ++m) { const int row = row0 + ai * HALF + m * 16; float s = 0.f;
#pragma unroll
                    for (int bj = 0; bj < 2; ++bj)
#pragma unroll
                        for (int n = 0; n < 2; ++n) { const f32x4 v = acc[ai][bj][m][n]; s += sq4(v); st_bf4(CQ + (size_t)row * 256 + bj * HALF + wc * 32 + n * 16 + fq * 4, v); }
                    s = red_fq(s); if (fq == 0) partq[(size_t)row * 4 + wc] = s; }
        } else if (u.pn == 1) {
            f32x4 tc0 = {0.f, 0.f, 0.f, 0.f}, tc1 = tc0, tn0 = tc0, tn1 = tc0;
            if (wc == 0) { const float* tp = trig + ((size_t)(row0 % SEQ) * 16 + fq * 4) * 2; tc0 = *(const f32x4*)tp; tc1 = *(const f32x4*)(tp + 4); }
#pragma unroll
            for (int i8 = 0; i8 < 8; ++i8) { const int ai = i8 >> 2, m = i8 & 3; const int row = row0 + ai * HALF + m * 16; float s = 0.f;
                if (wc == 0 && i8 < 7) { const int rown = row0 + ((i8 + 1) >> 2) * HALF + ((i8 + 1) & 3) * 16; const float* tp = trig + ((size_t)(rown % SEQ) * 16 + fq * 4) * 2; tn0 = *(const f32x4*)tp; tn1 = *(const f32x4*)(tp + 4); }
#pragma unroll
                for (int n = 0; n < 2; ++n) { const f32x4 v = acc[ai][0][m][n]; s += sq4(v); st_bf4(CKV + (size_t)row * 128 + wc * 32 + n * 16 + fq * 4, v); }
                s = red_fq(s); if (fq == 0) partkv[(size_t)row * 4 + wc] = s;
                if (wc == 0) { const f32x4 x1 = acc[ai][1][m][0], x2 = acc[ai][1][m][1]; const f32x4 t0 = tc0, t1 = tc1;
                    f32x4 o1, o2; o1[0] = x1[0] * t0[0] - x2[0] * t0[1]; o2[0] = x1[0] * t0[1] + x2[0] * t0[0]; o1[1] = x1[1] * t0[2] - x2[1] * t0[3]; o2[1] = x1[1] * t0[3] + x2[1] * t0[2];
                    o1[2] = x1[2] * t1[0] - x2[2] * t1[1]; o2[2] = x1[2] * t1[1] + x2[2] * t1[0]; o1[3] = x1[3] * t1[2] - x2[3] * t1[3]; o2[3] = x1[3] * t1[3] + x2[3] * t1[2];
                    u32x2 w1, w2; w1.x = cvt_pk_bf16(o1[0], o1[1]); w1.y = cvt_pk_bf16(o1[2], o1[3]); w2.x = cvt_pk_bf16(o2[0], o2[1]); w2.y = cvt_pk_bf16(o2[2], o2[3]);
#pragma unroll
                    for (int h = 0; h < 8; ++h) { *(u32x2*)(KB + (size_t)row * 768 + h * 96 + 64 + fq * 4) = w1; *(u32x2*)(KB + (size_t)row * 768 + h * 96 + 80 + fq * 4) = w2; } }
                tc0 = tn0; tc1 = tn1; asm volatile("" ::: "memory"); }
        } else {
            const int t = u.pn - 2;
#pragma unroll
            for (int ai = 0; ai < 2; ++ai)
#pragma unroll
                for (int m = 0; m < 4; ++m) { const int row = row0 + ai * HALF + m * 16;
#pragma unroll
                    for (int n = 0; n < 2; ++n) { const f32x4 val = acc[ai][0][m][n], gate = acc[ai][1][m][n]; f32x4 o;
#pragma unroll
                        for (int i = 0; i < 4; ++i) o[i] = val[i] * __builtin_amdgcn_rcpf(1.f + __expf(-gate[i]));
                        st_bf4(U + (size_t)row * 512 + t * 128 + wc * 32 + n * 16 + fq * 4, o); } }
        }
    }
};
struct EpiQ {
    static constexpr bool PERM = false, AFTER_DRAIN = false;
    bf16_t* QB; const float* partq; const float* trig; float c2;
    __device__ __forceinline__ void operator()(const f32x4 (&acc)[2][2][4][2], const Unit& u, int wr, int wc, int fr, int fq) const {
        const int row0 = u.pm * BM + wr * 64 + fr;
        const bool rope = ((u.pn * 8 + wc) % 3 == 2) || ((u.pn * 8 + 4 + wc) % 3 == 2);
        f32x4 ppc = *(const f32x4*)(partq + (size_t)row0 * 4), ppn = ppc;
        f32x4 tc0 = {0.f, 0.f, 0.f, 0.f}, tc1 = tc0, tn0 = tc0, tn1 = tc0;
        if (rope) { const float* tp = trig + ((size_t)(row0 % SEQ) * 16 + fq * 4) * 2; tc0 = *(const f32x4*)tp; tc1 = *(const f32x4*)(tp + 4); }
#pragma unroll
        for (int i8 = 0; i8 < 8; ++i8) { const int ai = i8 >> 2, m = i8 & 3; const int row = row0 + ai * HALF + m * 16;
            if (i8 < 7) { const int rown = row0 + ((i8 + 1) >> 2) * HALF + ((i8 + 1) & 3) * 16; ppn = *(const f32x4*)(partq + (size_t)rown * 4);
                if (rope) { const float* tp = trig + ((size_t)(rown % SEQ) * 16 + fq * 4) * 2; tn0 = *(const f32x4*)tp; tn1 = *(const f32x4*)(tp + 4); } }
            const float rs = rsqrtf(((ppc[0] + ppc[1]) + (ppc[2] + ppc[3])) * (1.f / 256.f) + EPS) * c2;
#pragma unroll
            for (int bj = 0; bj < 2; ++bj) { const int g = u.pn * 8 + bj * 4 + wc; bf16_t* dst = QB + (size_t)row * 768 + g * 32 + fq * 4;
                if (g % 3 != 2) { st_bf4(dst, acc[ai][bj][m][0] * rs); st_bf4(dst + 16, acc[ai][bj][m][1] * rs); }
                else { const f32x4 x1 = acc[ai][bj][m][0] * rs, x2 = acc[ai][bj][m][1] * rs; const f32x4 t0 = tc0, t1 = tc1;
                    f32x4 o1, o2; o1[0] = x1[0] * t0[0] - x2[0] * t0[1]; o2[0] = x1[0] * t0[1] + x2[0] * t0[0]; o1[1] = x1[1] * t0[2] - x2[1] * t0[3]; o2[1] = x1[1] * t0[3] + x2[1] * t0[2];
                    o1[2] = x1[2] * t1[0] - x2[2] * t1[1]; o2[2] = x1[2] * t1[1] + x2[2] * t1[0]; o1[3] = x1[3] * t1[2] - x2[3] * t1[3]; o2[3] = x1[3] * t1[3] + x2[3] * t1[2];
                    st_bf4(dst, o1); st_bf4(dst + 16, o2); } }
            ppc = ppn; tc0 = tn0; tc1 = tn1; asm volatile("" ::: "memory"); }
    }
};
struct EpiKV {
    static constexpr bool PERM = false, AFTER_DRAIN = false;
    bf16_t *KB, *VB; const float* partkv;
    __device__ __forceinline__ void operator()(const f32x4 (&acc)[2][2][4][2], const Unit& u, int wr, int wc, int fr, int fq) const {
        const int row0 = u.pm * BM + wr * 64 + fr;
        f32x4 ppc = *(const f32x4*)(partkv + (size_t)row0 * 4), ppn = ppc;
#pragma unroll
        for (int i8 = 0; i8 < 8; ++i8) { const int ai = i8 >> 2, m = i8 & 3; const int row = row0 + ai * HALF + m * 16;
            if (i8 < 7) { const int rown = row0 + ((i8 + 1) >> 2) * HALF + ((i8 + 1) & 3) * 16; ppn = *(const f32x4*)(partkv + (size_t)rown * 4); }
            const float rs = rsqrtf(((ppc[0] + ppc[1]) + (ppc[2] + ppc[3])) * (1.f / 128.f) + EPS);
#pragma unroll
            for (int bj = 0; bj < 2; ++bj)
#pragma unroll
                for (int n = 0; n < 2; ++n) { const int c = u.pn * BM + bj * HALF + wc * 32 + n * 16 + fq * 4; const f32x4 v = acc[ai][bj][m][n] * rs;
                    if (u.pn < 2) st_bf4(KB + (size_t)row * 768 + (c >> 6) * 96 + (c & 63), v); else st_bf4(VB + (size_t)row * 512 + (c - 512), v); }
            ppc = ppn; asm volatile("" ::: "memory"); }
    }
};
template <bool BF16RES> struct EpiRes {
    static constexpr bool PERM = false, AFTER_DRAIN = false;
    const float* res; const bf16_t* resb; bf16_t* outb; float* part;
    __device__ __forceinline__ f32x4 ldres(size_t off) const {
        if (BF16RES) { const u32x2 rb = *(const u32x2*)(resb + off); f32x4 r; r[0] = __builtin_bit_cast(float, rb.x << 16); r[1] = __builtin_bit_cast(float, rb.x & 0xffff0000u); r[2] = __builtin_bit_cast(float, rb.y << 16); r[3] = __builtin_bit_cast(float, rb.y & 0xffff0000u); return r; }
        return *(const f32x4*)(res + off); }
    __device__ __forceinline__ void operator()(const f32x4 (&acc)[2][2][4][2], const Unit& u, int wr, int wc, int fr, int fq) const {
        const int row0 = u.pm * BM + wr * 64 + fr; const int cb = u.pn * BM + wc * 32 + fq * 4;
        f32x4 rc[4], rn[4];
#pragma unroll
        for (int j = 0; j < 4; ++j) { rc[j] = ldres((size_t)row0 * 1024 + cb + (j >> 1) * HALF + (j & 1) * 16); rn[j] = rc[j]; }
#pragma unroll
        for (int i8 = 0; i8 < 8; ++i8) { const int ai = i8 >> 2, m = i8 & 3; const int row = row0 + ai * HALF + m * 16; float s = 0.f;
            if (i8 < 7) { const int rown = row0 + ((i8 + 1) >> 2) * HALF + ((i8 + 1) & 3) * 16;
#pragma unroll
                for (int j = 0; j < 4; ++j) rn[j] = ldres((size_t)rown * 1024 + cb + (j >> 1) * HALF + (j & 1) * 16); }
#pragma unroll
            for (int bj = 0; bj < 2; ++bj)
#pragma unroll
                for (int n = 0; n < 2; ++n) { const size_t off = (size_t)row * 1024 + cb + bj * HALF + n * 16;
                    const f32x4 v = acc[ai][bj][m][n] + rc[bj * 2 + n]; st_bf4(outb + off, v); s += sq4(v); }
            s = red_fq(s); if (fq == 0) part[(size_t)row * 16 + u.pn * 4 + wc] = s;
#pragma unroll
            for (int j = 0; j < 4; ++j) rc[j] = rn[j];
            asm volatile("" ::: "memory"); }
    }
};
struct EpiScaled {
    static constexpr bool PERM = false, AFTER_DRAIN = false;
    bf16_t* out; int ldc; const float* part; float mul;
    __device__ __forceinline__ void operator()(const f32x4 (&acc)[2][2][4][2], const Unit& u, int wr, int wc, int fr, int fq) const {
        const int row0 = u.pm * BM + wr * 64 + fr;
        float rs8[8];
#pragma unroll
        for (int hb = 0; hb < 2; ++hb) { f32x4 q[4][4];
#pragma unroll
            for (int k = 0; k < 4; ++k) { const int row = row0 + hb * HALF + k * 16; const f32x4* pp = (const f32x4*)(part + (size_t)row * 16);
#pragma unroll
                for (int j = 0; j < 4; ++j) q[k][j] = pp[j]; }
#pragma unroll
            for (int k = 0; k < 4; ++k) { const f32x4 a = q[k][0], b = q[k][1], c = q[k][2], d = q[k][3];
                const float ss = (((a[0] + a[1]) + (a[2] + a[3])) + ((b[0] + b[1]) + (b[2] + b[3]))) + (((c[0] + c[1]) + (c[2] + c[3])) + ((d[0] + d[1]) + (d[2] + d[3])));
                rs8[hb * 4 + k] = rsqrtf(ss * (1.f / 1024.f) + EPS) * mul; } }
#pragma unroll
        for (int i8 = 0; i8 < 8; ++i8) { const int ai = i8 >> 2, m = i8 & 3; const int row = row0 + ai * HALF + m * 16; const float rs = rs8[i8];
#pragma unroll
            for (int bj = 0; bj < 2; ++bj)
#pragma unroll
                for (int n = 0; n < 2; ++n) st_bf4(out + (size_t)row * ldc + u.pn * BM + bj * HALF + wc * 32 + n * 16 + fq * 4, acc[ai][bj][m][n] * rs);
            asm volatile("" ::: "memory"); }
    }
};
struct EpiSoftmaxP {
    static constexpr bool PERM = false, AFTER_DRAIN = false;
    bf16_t* out; int ldc; const float* part; float mul; PG8_LAS float* scr;
    __device__ __forceinline__ float rscale(int row) const { const f32x4* pp = (const f32x4*)(part + (size_t)row * 16); const f32x4 a = pp[0], b = pp[1], c = pp[2], d = pp[3];
        const float ss = (((a[0] + a[1]) + (a[2] + a[3])) + ((b[0] + b[1]) + (b[2] + b[3]))) + (((c[0] + c[1]) + (c[2] + c[3])) + ((d[0] + d[1]) + (d[2] + d[3]))); return rsqrtf(ss * (1.f / 1024.f) + EPS) * mul; }
    __device__ __forceinline__ void operator()(const f32x4 (&acc)[2][2][4][2], const Unit& u, int wr, int wc, int fr, int fq) const {
        PG8_LAS float* P1 = scr; PG8_LAS float* P2 = scr + 1024; float rs8[8];
#define EPS_BAR() do { asm volatile("s_waitcnt lgkmcnt(0)" ::: "memory"); __builtin_amdgcn_s_barrier(); asm volatile("" ::: "memory"); } while (0)
#pragma unroll
        for (int ai = 0; ai < 2; ++ai)
#pragma unroll
            for (int m = 0; m < 4; ++m) { float mx = -3.0e38f;
#pragma unroll
                for (int bj = 0; bj < 2; ++bj)
#pragma unroll
                    for (int n = 0; n < 2; ++n) { const f32x4 v = acc[ai][bj][m][n]; mx = fmaxf(mx, fmaxf(fmaxf(v[0], v[1]), fmaxf(v[2], v[3]))); }
                mx = fmaxf(mx, __shfl_xor(mx, 16)); mx = fmaxf(mx, __shfl_xor(mx, 32));
                if (fq == 0) P1[(ai * HALF + wr * 64 + m * 16 + fr) * 4 + wc] = mx; }
        EPS_BAR();
#pragma unroll
        for (int ai = 0; ai < 2; ++ai)
#pragma unroll
            for (int m = 0; m < 4; ++m) { const int rl = ai * HALF + wr * 64 + m * 16 + fr; const f32x4 q = *(const PG8_LAS f32x4*)(P1 + rl * 4);
                const float mx = fmaxf(fmaxf(q[0], q[1]), fmaxf(q[2], q[3])), rs = rscale(u.pm * BM + rl); float sm = 0.f; rs8[ai * 4 + m] = rs;
#pragma unroll
                for (int bj = 0; bj < 2; ++bj)
#pragma unroll
                    for (int n = 0; n < 2; ++n) { const f32x4 v = acc[ai][bj][m][n];
#pragma unroll
                        for (int i = 0; i < 4; ++i) sm += __builtin_amdgcn_exp2f((v[i] - mx) * rs); }
                sm += __shfl_xor(sm, 16); sm += __shfl_xor(sm, 32);
                if (fq == 0) P2[rl * 4 + wc] = sm; asm volatile("" ::: "memory"); }
        EPS_BAR();
#pragma unroll
        for (int ai = 0; ai < 2; ++ai)
#pragma unroll
            for (int m = 0; m < 4; ++m) { const int rl = ai * HALF + wr * 64 + m * 16 + fr; const f32x4 q = *(const PG8_LAS f32x4*)(P1 + rl * 4), w = *(const PG8_LAS f32x4*)(P2 + rl * 4);
                const float mx = fmaxf(fmaxf(q[0], q[1]), fmaxf(q[2], q[3])), rs = rs8[ai * 4 + m], inv = 1.0f / ((w[0] + w[1]) + (w[2] + w[3]));
#pragma unroll
                for (int bj = 0; bj < 2; ++bj)
#pragma unroll
                    for (int n = 0; n < 2; ++n) { const f32x4 v = acc[ai][bj][m][n]; f32x4 o;
#pragma unroll
                        for (int i = 0; i < 4; ++i) o[i] = __builtin_amdgcn_exp2f((v[i] - mx) * rs) * inv;
                        st_bf4(out + (size_t)(u.pm * BM + rl) * ldc + u.pn * BM + bj * HALF + wc * 32 + n * 16 + fq * 4, o); }
                asm volatile("" ::: "memory"); }
        EPS_BAR();
#undef EPS_BAR
    }
};
struct EpiPlain {
    static constexpr bool PERM = false, AFTER_DRAIN = false;
    bf16_t* out; int ldc;
    __device__ __forceinline__ void operator()(const f32x4 (&acc)[2][2][4][2], const Unit& u, int wr, int wc, int fr, int fq) const {
        const int row0 = u.pm * BM + wr * 64 + fr;
#pragma unroll
        for (int ai = 0; ai < 2; ++ai)
#pragma unroll
            for (int m = 0; m < 4; ++m) { const int row = row0 + ai * HALF + m * 16;
#pragma unroll
                for (int bj = 0; bj < 2; ++bj)
#pragma unroll
                    for (int n = 0; n < 2; ++n) st_bf4(out + (size_t)row * ldc + u.pn * BM + bj * HALF + wc * 32 + n * 16 + fq * 4, acc[ai][bj][m][n]); }
    }
};
template <class Epi, class Sched, bool ALIGN_EPI = false, bool SP2 = false>
__device__ __forceinline__ void gemm_phase(PG8_LAS unsigned char* lds, const Gemm g, const Sched& S, const Epi& E) {
    int tid_ = threadIdx.x; asm volatile("" : "+v"(tid_));
    const int tid = tid_, wid = __builtin_amdgcn_readfirstlane(tid >> 6), lane = tid & 63, wr = wid >> 2, wc = wid & 3, fr = lane & 15, fq = lane >> 4;
    const int K = g.K, nt = K / BK, lda = g.lda ? g.lda : K, ldb = g.ldb ? g.ldb : K;
#define PG8_BOFF(pm_) (g.mb ? (size_t)((pm_) / g.mb) * g.bstride : (size_t)0)
    unsigned voffA[2], voffB[2];
#pragma unroll
    for (int i = 0; i < 2; ++i) { int R, C; stage_rc(tid * 16 + i * 8192, R, C); const int Rb = Epi::PERM ? ((R & ~31) + perm32(R & 31)) : R;
        voffA[i] = (unsigned)(R * lda + C) * 2u; voffB[i] = (unsigned)(Rb * ldb + C) * 2u; }
    const size_t kstep = (size_t)(BK * 2);
    const size_t hstepA = (size_t)HALF * lda * 2, hstepB = (size_t)HALF * ldb * 2;
    const size_t tstepA = 2 * hstepA, tstepB = 2 * hstepB;
    const unsigned ldsw = (unsigned)wid * 1024u;
    const int aoff = lds_byte(wr * 64 + fr, fq * 8), boff = lds_byte(wc * 32 + fr, fq * 8);
#define PG8_SA(b, h) (((b) * 2 + (h)) * HTB)
#define PG8_SB(b, h) ((4 + (b) * 2 + (h)) * HTB)
#define PG8_STAGE(bufoff, gbase, voff) do { _Pragma("unroll") for (int _i = 0; _i < 2; ++_i) \
        __builtin_amdgcn_global_load_lds((const unsigned*)((const char*)(gbase) + (voff)[_i]), (PG8_LAS unsigned*)(lds + (bufoff) + ldsw + _i * 8192), 16, 0, 0); } while (0)
#define PG8_LDA(dst, b, h) do { _Pragma("unroll") for (int m = 0; m < 4; ++m) _Pragma("unroll") for (int k = 0; k < 2; ++k) dst[m][k] = *(const PG8_LAS bf16x8*)(lds + PG8_SA(b, h) + aoff + m * 2048 + k * 1024); } while (0)
#define PG8_LDB(dst, b, h) do { _Pragma("unroll") for (int n = 0; n < 2; ++n) _Pragma("unroll") for (int k = 0; k < 2; ++k) dst[n][k] = *(const PG8_LAS bf16x8*)(lds + PG8_SB(b, h) + boff + n * 2048 + k * 1024); } while (0)
#define PG8_MMA(ai, bj, At, Bt) do { __builtin_amdgcn_s_setprio(1); _Pragma("unroll") for (int m = 0; m < 4; ++m) _Pragma("unroll") for (int n = 0; n < 2; ++n) _Pragma("unroll") for (int k = 0; k < 2; ++k) \
        acc[ai][bj][m][n] = __builtin_amdgcn_mfma_f32_16x16x32_bf16(Bt[n][k], At[m][k], acc[ai][bj][m][n], 0, 0, 0); __builtin_amdgcn_s_setprio(0); } while (0)
#define PG8_WAIT_V(n) asm volatile("s_waitcnt vmcnt(" #n ")" ::: "memory")
#define PG8_WAIT_L(n) asm volatile("s_waitcnt lgkmcnt(" #n ")" ::: "memory")
#define PG8_BAR __builtin_amdgcn_s_barrier()
#define PG8_SCHED __builtin_amdgcn_sched_barrier(0)
    Unit cur, nxt; int ui = 0;
    if (!S.next(0, cur)) return;
    f32x4 acc[2][2][4][2];
#pragma unroll
    for (int a = 0; a < 2; ++a)
#pragma unroll
        for (int b = 0; b < 2; ++b)
#pragma unroll
            for (int m = 0; m < 4; ++m)
#pragma unroll
                for (int n = 0; n < 2; ++n) acc[a][b][m][n] = (f32x4){0.f, 0.f, 0.f, 0.f};
    bf16x8 At[4][2], B0[2][2], B1[2][2];
    const char* cA = (const char*)g.A + (size_t)cur.pm * tstepA; const char* cB = (const char*)g.Bt + (size_t)cur.pn * tstepB + PG8_BOFF(cur.pm);
    S.a_ready(cur);
    if constexpr (SP2) {
        PG8_STAGE(PG8_SB(0, 0), cB, voffB); PG8_STAGE(PG8_SB(0, 1), cB + hstepB, voffB); PG8_STAGE(PG8_SA(0, 0), cA, voffA); PG8_STAGE(PG8_SA(0, 1), cA + hstepA, voffA);
        if (wr == 1) PG8_BAR;
        PG8_WAIT_V(2); PG8_BAR;
        PG8_STAGE(PG8_SB(1, 0), cB + kstep, voffB); PG8_STAGE(PG8_SA(1, 0), cA + kstep, voffA); PG8_STAGE(PG8_SB(1, 1), cB + hstepB + kstep, voffB);
        PG8_WAIT_V(6); PG8_BAR;
    } else {
        PG8_STAGE(PG8_SB(0, 0), cB, voffB); PG8_STAGE(PG8_SA(0, 0), cA, voffA); PG8_STAGE(PG8_SB(0, 1), cB + hstepB, voffB); PG8_STAGE(PG8_SA(0, 1), cA + hstepA, voffA);
        if (wr == 1) PG8_BAR;
        PG8_WAIT_V(4); PG8_BAR;
        PG8_STAGE(PG8_SB(1, 0), cB + kstep, voffB); PG8_STAGE(PG8_SA(1, 0), cA + kstep, voffA); PG8_STAGE(PG8_SB(1, 1), cB + hstepB + kstep, voffB);
        PG8_WAIT_V(6); PG8_BAR;
    }
    for (;;) {
        const bool has_next = S.next(ui + 1, nxt);
        const char* nA = has_next ? (const char*)g.A + (size_t)nxt.pm * tstepA : cA; const char* nB = has_next ? (const char*)g.Bt + (size_t)nxt.pn * tstepB + PG8_BOFF(nxt.pm) : cB;
        for (int t = 0; t < nt; t += 2) {
            const bool last = (t == nt - 2);
            const char* a1 = cA + (size_t)(t + 1) * kstep;
            const char* a2 = last ? nA : cA + (size_t)(t + 2) * kstep; const char* b2 = last ? nB : cB + (size_t)(t + 2) * kstep;
            const char* a3 = a2 + kstep; const char* b3 = b2 + kstep;
            if (last && has_next) S.a_ready(nxt);
            if constexpr (SP2) {
            PG8_LDB(B0, 0, 0); PG8_LDB(B1, 0, 1); PG8_SCHED; PG8_LDA(At, 0, 0); PG8_STAGE(PG8_SA(1, 1), a1 + hstepA, voffA);
            PG8_WAIT_V(8); PG8_WAIT_L(0); PG8_BAR; PG8_MMA(0, 0, At, B0); PG8_MMA(0, 1, At, B1); PG8_BAR; PG8_SCHED;
            PG8_LDA(At, 0, 1); PG8_STAGE(PG8_SB(0, 0), b2, voffB); PG8_STAGE(PG8_SB(0, 1), b2 + hstepB, voffB); PG8_STAGE(PG8_SA(0, 0), a2, voffA);
            PG8_WAIT_V(8); PG8_WAIT_L(0); PG8_BAR; PG8_MMA(1, 0, At, B0); PG8_MMA(1, 1, At, B1); PG8_BAR; PG8_SCHED;
            PG8_LDB(B0, 1, 0); PG8_LDB(B1, 1, 1); PG8_SCHED; PG8_LDA(At, 1, 0); PG8_STAGE(PG8_SA(0, 1), a2 + hstepA, voffA);
            PG8_WAIT_V(8); PG8_WAIT_L(0); PG8_BAR; PG8_MMA(0, 0, At, B0); PG8_MMA(0, 1, At, B1); PG8_BAR; PG8_SCHED;
            PG8_LDA(At, 1, 1); PG8_STAGE(PG8_SB(1, 0), b3, voffB); PG8_STAGE(PG8_SB(1, 1), b3 + hstepB, voffB); PG8_STAGE(PG8_SA(1, 0), a3, voffA);
            PG8_WAIT_V(8); PG8_WAIT_L(0); PG8_BAR; PG8_MMA(1, 0, At, B0); PG8_MMA(1, 1, At, B1); PG8_BAR; PG8_SCHED;
            } else {
            PG8_LDB(B0, 0, 0); PG8_SCHED; PG8_LDA(At, 0, 0); PG8_STAGE(PG8_SA(1, 1), a1 + hstepA, voffA);
            PG8_WAIT_L(8); PG8_BAR; PG8_WAIT_L(0); PG8_MMA(0, 0, At, B0); PG8_BAR; PG8_SCHED;
            PG8_LDB(B1, 0, 1); PG8_STAGE(PG8_SB(0, 0), b2, voffB);
            PG8_BAR; PG8_WAIT_L(0); PG8_MMA(0, 1, At, B1); PG8_BAR;
            PG8_LDA(At, 0, 1); PG8_STAGE(PG8_SA(0, 0), a2, voffA);
            PG8_BAR; PG8_WAIT_L(0); PG8_MMA(1, 0, At, B0); PG8_BAR; PG8_SCHED;
            PG8_STAGE(PG8_SB(0, 1), b2 + hstepB, voffB);
            PG8_WAIT_V(6); PG8_BAR; PG8_MMA(1, 1, At, B1); PG8_BAR;
            PG8_LDB(B0, 1, 0); PG8_SCHED; PG8_LDA(At, 1, 0); PG8_STAGE(PG8_SA(0, 1), a2 + hstepA, voffA);
            PG8_WAIT_L(8); PG8_BAR; PG8_WAIT_L(0); PG8_MMA(0, 0, At, B0); PG8_BAR; PG8_SCHED;
            PG8_LDB(B1, 1, 1); PG8_STAGE(PG8_SB(1, 0), b3, voffB);
            PG8_BAR; PG8_WAIT_L(0); PG8_MMA(0, 1, At, B1); PG8_BAR;
            PG8_LDA(At, 1, 1); PG8_STAGE(PG8_SA(1, 0), a3, voffA);
            PG8_BAR; PG8_WAIT_L(0); PG8_MMA(1, 0, At, B0); PG8_BAR; PG8_SCHED;
            PG8_STAGE(PG8_SB(1, 1), b3 + hstepB, voffB);
            PG8_WAIT_V(6); PG8_BAR; PG8_MMA(1, 1, At, B1); PG8_BAR;
            }
        }
        if constexpr (ALIGN_EPI) { if (wr == 0) PG8_BAR; }
        if constexpr (!Epi::AFTER_DRAIN) { E(acc, cur, wr, wc, fr, fq); S.done(cur); }
        if (!has_next) break;
#pragma unroll
        for (int a = 0; a < 2; ++a)
#pragma unroll
            for (int b = 0; b < 2; ++b)
#pragma unroll
                for (int m = 0; m < 4; ++m)
#pragma unroll
                    for (int n = 0; n < 2; ++n) acc[a][b][m][n] = (f32x4){0.f, 0.f, 0.f, 0.f};
        cur = nxt; cA = nA; cB = nB; ++ui;
        if constexpr (ALIGN_EPI) { if (wr == 1) PG8_BAR; }
    }
    PG8_WAIT_V(0);
    if constexpr (!ALIGN_EPI) { if (wr == 0) PG8_BAR; }
    PG8_BAR;
    if constexpr (Epi::AFTER_DRAIN) { E.fused(acc, cur, wr, wc, fr, fq, lds, wid, lane); S.done(cur); }
#undef PG8_BOFF
#undef PG8_SA
#undef PG8_SB
#undef PG8_STAGE
#undef PG8_LDA
#undef PG8_LDB
#undef PG8_MMA
#undef PG8_WAIT_V
#undef PG8_WAIT_L
#undef PG8_BAR
#undef PG8_SCHED
}
}

#define GAS __attribute__((address_space(1)))
#define LAS __attribute__((address_space(3)))
typedef GAS unsigned gu32;
#define LDS_WAIT() asm volatile("s_waitcnt lgkmcnt(0)" ::: "memory")
#define VM_WAIT() asm volatile("s_waitcnt vmcnt(0)" ::: "memory")
constexpr int NWAVES = 8, NTHR = NWAVES * 64;
constexpr int LDSCTL_OFF = 0, PH_BASE = 512, LDS_BYTES = 147456;
constexpr int CW_BAR = 4096;
constexpr size_t CTL_ZERO_BYTES = 256 * 1024;
constexpr size_t WS_TRIG = 27 * MiB;
#define XB_TMO      128
#define XB_XCNT(j)  (256  + 64 * (j))
#define XB_XSUB(j)  (1280 + 64 * (j))
#define XB_XGEN(j)  (2304 + 64 * (j))
#define XB_TOP      3328
#define XB_TOPGEN   3392
#define XCD_BAR_WORDS 3456
#define XB_SPIN_CAP (1u << 18)

__device__ __forceinline__ unsigned xb_ld(unsigned* p)              { return __hip_atomic_load(p, __ATOMIC_RELAXED, __HIP_MEMORY_SCOPE_AGENT); }
__device__ __forceinline__ unsigned xb_add(unsigned* p, unsigned v) { return __hip_atomic_fetch_add(p, v, __ATOMIC_RELAXED, __HIP_MEMORY_SCOPE_AGENT); }
__device__ __forceinline__ unsigned xb_xcc_id() { return (unsigned)__builtin_amdgcn_s_getreg((3 << 11) | 20) & 0xFu; }
#define XB_SPIN(cond, bar) do { unsigned _sp = 0; while (cond) { __builtin_amdgcn_s_sleep(1); \
    if ((++_sp & 255u) == 0u) { if (xb_ld(&(bar)[XB_TMO])) break; if (_sp > XB_SPIN_CAP) { atomicAdd(&(bar)[XB_TMO], 1u); break; } } } } while (0)

struct XcdBarrier {
    unsigned* bar; unsigned x;
    volatile LAS unsigned* st;
};

__device__ __forceinline__ XcdBarrier xcd_barrier_post(unsigned* bar, volatile LAS unsigned* st) {
    XcdBarrier b; b.bar = bar; b.x = xb_xcc_id(); b.st = st;
    if (threadIdx.x == 0) (void)xb_add(&bar[XB_XCNT(b.x)], 1u);
    return b;
}
__device__ __forceinline__ void xcd_barrier_complete(unsigned* bar, unsigned x, unsigned& nloc, unsigned& nx) {
    const unsigned G = gridDim.x * gridDim.y * gridDim.z;
    unsigned sum, cnt, mine, sp = 0u;
    for (;;) {
        sum = 0u; cnt = 0u; mine = 0u;
#pragma unroll
        for (unsigned j = 0; j < 16; ++j) { const unsigned c = xb_ld(&bar[XB_XCNT(j)]); sum += c; cnt += (c > 0u) ? 1u : 0u; mine = (j == x) ? c : mine; }
        if (sum == G) break;
        __builtin_amdgcn_s_sleep(1);
        if ((++sp & 255u) == 0u) { if (xb_ld(&bar[XB_TMO])) break; if (sp > XB_SPIN_CAP) { atomicAdd(&bar[XB_TMO], 1u); break; } }
    }
    nloc = mine > 0u ? mine : 1u; nx = cnt > 0u ? cnt : 1u;
}

__device__ __forceinline__ void xcd_barrier(const XcdBarrier& b) {
    asm volatile("s_waitcnt vmcnt(0)" ::: "memory");
    __syncthreads();
    if (threadIdx.x == 0) {
        unsigned* bar = b.bar;
        __builtin_amdgcn_s_waitcnt(0);
        unsigned nloc = b.st[0], nx = b.st[1];
        if (nloc == 0u) { xcd_barrier_complete(bar, b.x, nloc, nx); b.st[0] = nloc; b.st[1] = nx; }
        const unsigned old = xb_add(&bar[XB_XSUB(b.x)], 1u);
        const unsigned gen = old / nloc;
        if (old + 1u == (gen + 1u) * nloc) {
            __builtin_amdgcn_fence(__ATOMIC_RELEASE, "agent");
            asm volatile("s_waitcnt vmcnt(0)" ::: "memory");
            const unsigned og = xb_add(&bar[XB_TOP], 1u);
            const unsigned tg = og / nx;
            if (og + 1u == (tg + 1u) * nx) xb_add(&bar[XB_TOPGEN], 1u);
            else XB_SPIN(xb_ld(&bar[XB_TOPGEN]) == tg, bar);
            __builtin_amdgcn_fence(__ATOMIC_ACQUIRE, "agent");
            xb_add(&bar[XB_XGEN(b.x)], 1u);
            asm volatile("s_waitcnt vmcnt(0)" ::: "memory");
        } else {
            XB_SPIN(xb_ld(&bar[XB_XGEN(b.x)]) == gen, bar);
            __builtin_amdgcn_fence(__ATOMIC_ACQUIRE, "agent");
            asm volatile("s_waitcnt vmcnt(0)" ::: "memory");
        }
    }
    __syncthreads();
}

enum { PH_PRO = 0, PH_PROJ, PH_UP, PH_ATTN, PH_MIX, PH_MEMQ, PH_XATTN, PH_MEMO, PH_PQ, PH_TOPK, PH_EXP, PH_N, PHB_CONV = 16, PHB_UPG = 17 };
struct Args { const float* in[24]; float* out; unsigned char* ws; unsigned mask; unsigned li; };

DEVI int src_col(int mode, int r) { return mode == 0 ? r : mode == 1 ? win_src(r) : wkv_src(r); }
template <int MODE, bool HASG> DEVI void p0_transpose_item(const float* W, int K, int N, bf16* WT, int NR, const float* gk, LAS float* scr, int item, int lane) {
    const int nb_ = NR / 32, kb = item / nb_, nb = item % nb_, k0 = 64 * kb, n0 = 32 * nb;
    const int sc = src_col(MODE, n0 + (lane & 31)), scc = sc < 0 ? 0 : sc; const float keep = sc < 0 ? 0.f : 1.f;
    float v[32];
#pragma unroll
    for (int i = 0; i < 32; ++i) { const int kk = 2 * i + (lane >> 5); v[i] = W[(size_t)(k0 + kk) * N + scc]; }
    if (HASG) {
#pragma unroll
        for (int i = 0; i < 32; ++i) { const int kk = 2 * i + (lane >> 5); v[i] *= gk[k0 + kk]; } }
#pragma unroll
    for (int i = 0; i < 32; ++i) { const int kk = 2 * i + (lane >> 5); scr[kk * 33 + (lane & 31)] = MODE == 0 ? v[i] : v[i] * keep; }
    LDS_WAIT(); asm volatile("" ::: "memory");
    const int c = lane & 7;
#pragma unroll
    for (int j = 0; j < 4; ++j) { const int n = (lane >> 3) + 8 * j; const LAS float* s = scr + (8 * c) * 33 + n;
        uint4 o; o.x = pg8::cvt_pk_bf16(s[0 * 33], s[1 * 33]); o.y = pg8::cvt_pk_bf16(s[2 * 33], s[3 * 33]); o.z = pg8::cvt_pk_bf16(s[4 * 33], s[5 * 33]); o.w = pg8::cvt_pk_bf16(s[6 * 33], s[7 * 33]);
        *(uint4*)(WT + (size_t)(n0 + n) * K + k0 + 8 * c) = o; }
    LDS_WAIT(); asm volatile("" ::: "memory");
}
DEVI void rms_row_to_bf16(const float* xrow, const float* g, bf16* orow, int lane) {
    const float4* xr = (const float4*)xrow + lane; const float4* gr = (const float4*)g + lane;
    float4 v[4]; float s = 0.f;
#pragma unroll
    for (int j = 0; j < 4; ++j) { v[j] = xr[64 * j]; s += (v[j].x * v[j].x + v[j].y * v[j].y) + (v[j].z * v[j].z + v[j].w * v[j].w); }
    const float r = rsqrtf(wave_sum(s) * (1.f / D) + EPS);
    uint2* o8 = (uint2*)orow + lane;
#pragma unroll
    for (int j = 0; j < 4; ++j) { const float4 gg = gr[64 * j]; uint2 o; o.x = pg8::cvt_pk_bf16(v[j].x * r * gg.x, v[j].y * r * gg.y); o.y = pg8::cvt_pk_bf16(v[j].z * r * gg.z, v[j].w * r * gg.w); o8[64 * j] = o; }
}
DEVI void rms_rows4_to_bf16(const float* x, const float* g, bf16* out, int m0, int step, int mend, int lane) {
    float4 v[4][4]; float s[4]; float4 gq[4];
#pragma unroll
    for (int j = 0; j < 4; ++j) gq[j] = ((const float4*)g + lane)[64 * j];
#pragma unroll
    for (int r = 0; r < 4; ++r) { const int m = m0 + r * step; const float4* xr = (const float4*)(x + (size_t)(m < mend ? m : m0) * D) + lane;
#pragma unroll
        for (int j = 0; j < 4; ++j) v[r][j] = xr[64 * j]; }
#pragma unroll
    for (int r = 0; r < 4; ++r) { float t = 0.f;
#pragma unroll
        for (int j = 0; j < 4; ++j) t += (v[r][j].x * v[r][j].x + v[r][j].y * v[r][j].y) + (v[r][j].z * v[r][j].z + v[r][j].w * v[r][j].w);
        s[r] = t; }
#pragma unroll
    for (int o = 1; o < 64; o <<= 1) {
#pragma unroll
        for (int r = 0; r < 4; ++r) s[r] += __shfl_xor(s[r], o); }
#pragma unroll
    for (int r = 0; r < 4; ++r) { const int m = m0 + r * step; if (m < mend) { const float rs = rsqrtf(s[r] * (1.f / D) + EPS); uint2* o8 = (uint2*)(out + (size_t)m * D) + lane;
#pragma unroll
        for (int j = 0; j < 4; ++j) { const float4 gg = gq[j]; uint2 o; o.x = pg8::cvt_pk_bf16(v[r][j].x * rs * gg.x, v[r][j].y * rs * gg.y); o.y = pg8::cvt_pk_bf16(v[r][j].z * rs * gg.z, v[r][j].w * rs * gg.w); o8[64 * j] = o; } } }
}
DEVI void cvt_stream_fp8(const float* src, unsigned char* dst, size_t n16, const float* g, float mul, size_t gtid, size_t gn) {
    for (size_t i = gtid; i < n16; i += gn) { pg8::u32x4 o;
#pragma unroll
        for (int q = 0; q < 4; ++q) { float4 a = *(const float4*)(src + i * 16 + q * 4); if (g) { const float4 gg = *(const float4*)(g + ((i * 16 + q * 4) & (D - 1))); a.x *= gg.x; a.y *= gg.y; a.z *= gg.z; a.w *= gg.w; }
            int p = __builtin_amdgcn_cvt_pk_fp8_f32(a.x * mul, a.y * mul, 0, false); p = __builtin_amdgcn_cvt_pk_fp8_f32(a.z * mul, a.w * mul, p, true); o[q] = (unsigned)p; }
        *(pg8::u32x4*)(dst + i * 16) = o; }
}
typedef unsigned v6u_t __attribute__((ext_vector_type(6)));
typedef float f32x2_t __attribute__((ext_vector_type(2)));
typedef float v16f_t __attribute__((ext_vector_type(16)));
typedef float v32f_t __attribute__((ext_vector_type(32)));
typedef __bf16 v32bf_t __attribute__((ext_vector_type(32)));
#ifndef FP6_INTERLEAVED
#define FP6_INTERLEAVED 0
#endif
template <bool HASG> DEVI void cvt_rows_fp6(const float* src, unsigned char* dst, const float* g, float mul, size_t gtid, size_t gn) {
    const int grp = (int)(gtid & 31);
    float4 gg[8];
#pragma unroll
    for (int q = 0; q < 8; ++q) { gg[q] = HASG ? *(const float4*)(g + grp * 32 + q * 4) : make_float4(1.f, 1.f, 1.f, 1.f); gg[q].x *= mul; gg[q].y *= mul; gg[q].z *= mul; gg[q].w *= mul; }
    for (size_t i0 = gtid; i0 < (size_t)PE * 32; i0 += 2 * gn) {
        float4 v[2][8];
#pragma unroll
        for (int u = 0; u < 2; ++u) { const size_t i = i0 + u * gn; if (i < (size_t)PE * 32) { const float* sp = src + (i >> 5) * D + (i & 31) * 32;
#pragma unroll
            for (int q = 0; q < 8; ++q) v[u][q] = *(const float4*)(sp + q * 4); } }
#pragma unroll
        for (int u = 0; u < 2; ++u) { const size_t i = i0 + u * gn; if (i < (size_t)PE * 32) { const size_t row = i >> 5;
            v16f_t a, b;
#pragma unroll
            for (int q = 0; q < 8; ++q) { const float4 x = v[u][q]; a[2 * q] = x.x * gg[q].x; b[2 * q] = x.y * gg[q].y; a[2 * q + 1] = x.z * gg[q].z; b[2 * q + 1] = x.w * gg[q].w; }
            const v6u_t p = __builtin_amdgcn_cvt_scalef32_2xpk16_fp6_f32(a, b, 1.0f);
            *(pg8::u32x4*)(dst + row * 768 + grp * 16) = (pg8::u32x4){p[0], p[1], p[2], p[3]};
            *(pg8::u32x2*)(dst + row * 768 + 512 + grp * 8) = (pg8::u32x2){p[4], p[5]}; } }
    }
}
DEVI void cvt_stream(const float* src, bf16* dst, size_t n8, const float* g, size_t gtid, size_t gn) {
    for (size_t i = gtid; i < n8; i += gn) { const float4 a = *(const float4*)(src + i * 8), b = *(const float4*)(src + i * 8 + 4);
        float4 ga = make_float4(1.f, 1.f, 1.f, 1.f), gb = ga; if (g) { ga = *(const float4*)(g + ((i * 8) & (D - 1))); gb = *(const float4*)(g + ((i * 8) & (D - 1)) + 4); }
        uint4 o; o.x = pg8::cvt_pk_bf16(a.x * ga.x, a.y * ga.y); o.y = pg8::cvt_pk_bf16(a.z * ga.z, a.w * ga.w); o.z = pg8::cvt_pk_bf16(b.x * gb.x, b.y * gb.y); o.w = pg8::cvt_pk_bf16(b.z * gb.z, b.w * gb.w);
        *(uint4*)(dst + i * 8) = o; }
}


DEVI void conv_token(int row, const bf16* U, const float* cw, const float* cb, const float* lg, const float* lb, bf16* CONCAT, int lane) {
    const int pos = row % SEQ; float y[8];
    { const float4 b0 = *(const float4*)(cb + lane * 8), b1 = *(const float4*)(cb + lane * 8 + 4); y[0] = b0.x; y[1] = b0.y; y[2] = b0.z; y[3] = b0.w; y[4] = b1.x; y[5] = b1.y; y[6] = b1.z; y[7] = b1.w; }
    const int k0 = pos >= CK - 1 ? 0 : CK - 1 - pos;
    for (int k = k0; k < CK; ++k) {
        const uint4 u = *(const uint4*)(U + (size_t)(row - (CK - 1) + k) * CW + lane * 8);
        const float4 w0 = *(const float4*)(cw + k * CW + lane * 8), w1 = *(const float4*)(cw + k * CW + lane * 8 + 4);
        y[0] += w0.x * __builtin_bit_cast(float, u.x << 16); y[1] += w0.y * __builtin_bit_cast(float, u.x & 0xffff0000u);
        y[2] += w0.z * __builtin_bit_cast(float, u.y << 16); y[3] += w0.w * __builtin_bit_cast(float, u.y & 0xffff0000u);
        y[4] += w1.x * __builtin_bit_cast(float, u.z << 16); y[5] += w1.y * __builtin_bit_cast(float, u.z & 0xffff0000u);
        y[6] += w1.z * __builtin_bit_cast(float, u.w << 16); y[7] += w1.w * __builtin_bit_cast(float, u.w & 0xffff0000u);
    }
    float s = 0.f;
#pragma unroll
    for (int e = 0; e < 8; ++e) s += y[e];
    const float mu = wave_sum(s) * (1.f / CW); float q = 0.f;
#pragma unroll
    for (int e = 0; e < 8; ++e) { y[e] -= mu; q += y[e] * y[e]; }
    const float rstd = rsqrtf(wave_sum(q) * (1.f / CW) + EPS);
    const float4 g0 = *(const float4*)(lg + lane * 8), g1 = *(const float4*)(lg + lane * 8 + 4), c0 = *(const float4*)(lb + lane * 8), c1 = *(const float4*)(lb + lane * 8 + 4);
    const float gg[8] = {g0.x, g0.y, g0.z, g0.w, g1.x, g1.y, g1.z, g1.w}, bb[8] = {c0.x, c0.y, c0.z, c0.w, c1.x, c1.y, c1.z, c1.w};
    float z[8];
#pragma unroll
    for (int e = 0; e < 8; ++e) { const float t = y[e] * rstd * gg[e] + bb[e]; z[e] = t * __builtin_amdgcn_rcpf(1.f + __expf(-t)); }
    uint4 o; o.x = pg8::cvt_pk_bf16(z[0], z[1]); o.y = pg8::cvt_pk_bf16(z[2], z[3]); o.z = pg8::cvt_pk_bf16(z[4], z[5]); o.w = pg8::cvt_pk_bf16(z[6], z[7]);
    *(uint4*)(CONCAT + (size_t)row * D + CW + lane * 8) = o;
}

DEVI void conv_chunk(int c, const bf16* U, const float* cw, const float* cb, const float* lg, const float* lb, bf16* CONCAT, LAS unsigned char* lds) {
    const int ch = threadIdx.x, lane = ch & 63, wv = __builtin_amdgcn_readfirstlane(ch >> 6);
    const int t0 = c * 64, pos0 = t0 % SEQ;
    float w[CK];
#pragma unroll
    for (int k = 0; k < CK; ++k) w[k] = cw[k * CW + ch];
    const float bias = cb[ch];
    float u[64 + CK - 1];
#pragma unroll
    for (int r = 0; r < 64 + CK - 1; ++r) { const int row = t0 - (CK - 1) + r;
        const unsigned raw = *(const unsigned short*)(U + (size_t)(row < 0 ? 0 : row) * CW + ch); u[r] = __builtin_bit_cast(float, raw << 16); }
#pragma unroll
    for (int r = 0; r < CK - 1; ++r) { const float keep = (pos0 - (CK - 1) + r >= 0) ? 1.f : 0.f; u[r] *= keep; }
    LAS float* yl = (LAS float*)lds;
#pragma unroll
    for (int j = 0; j < 64; ++j) { float y = bias;
#pragma unroll
        for (int k = 0; k < CK; ++k) y += w[k] * u[j + k];
        yl[j * CW + ch] = y; }
    __syncthreads();
#pragma unroll 1
    for (int i = 0; i < 8; ++i) { const int j = wv * 8 + i, row = t0 + j;
        const pg8::f32x4 a0 = *(const LAS pg8::f32x4*)(yl + j * CW + lane * 8), a1 = *(const LAS pg8::f32x4*)(yl + j * CW + lane * 8 + 4);
        float y[8] = {a0[0], a0[1], a0[2], a0[3], a1[0], a1[1], a1[2], a1[3]}; float sm = 0.f;
#pragma unroll
        for (int e = 0; e < 8; ++e) sm += y[e];
        const float mu = wave_sum(sm) * (1.f / CW); float q = 0.f;
#pragma unroll
        for (int e = 0; e < 8; ++e) { y[e] -= mu; q += y[e] * y[e]; }
        const float rstd = rsqrtf(wave_sum(q) * (1.f / CW) + EPS);
        const float4 g0 = *(const float4*)(lg + lane * 8), g1 = *(const float4*)(lg + lane * 8 + 4), c0 = *(const float4*)(lb + lane * 8), c1 = *(const float4*)(lb + lane * 8 + 4);
        const float gg[8] = {g0.x, g0.y, g0.z, g0.w, g1.x, g1.y, g1.z, g1.w}, bb[8] = {c0.x, c0.y, c0.z, c0.w, c1.x, c1.y, c1.z, c1.w};
        float z[8];
#pragma unroll
        for (int e = 0; e < 8; ++e) { const float t = y[e] * rstd * gg[e] + bb[e]; z[e] = t * __builtin_amdgcn_rcpf(1.f + __expf(-t)); }
        uint4 o; o.x = pg8::cvt_pk_bf16(z[0], z[1]); o.y = pg8::cvt_pk_bf16(z[2], z[3]); o.z = pg8::cvt_pk_bf16(z[4], z[5]); o.w = pg8::cvt_pk_bf16(z[6], z[7]);
        *(uint4*)(CONCAT + (size_t)row * D + CW + lane * 8) = o; }
    __syncthreads();
}

typedef short bf16x8_t __attribute__((ext_vector_type(8)));
typedef float f32x16_t __attribute__((ext_vector_type(16)));
typedef __bf16 bf16x2_t __attribute__((ext_vector_type(2)));
DEVI unsigned umax_(unsigned a, unsigned b) { return a > b ? a : b; }
DEVI unsigned umin_(unsigned a, unsigned b) { return a < b ? a : b; }
DEVI unsigned kmax_(unsigned a, unsigned b) { unsigned r; asm("v_max_f32 %0, %1, %2" : "=v"(r) : "v"(a), "v"(b)); return r; }
DEVI unsigned kmin_(unsigned a, unsigned b) { unsigned r; asm("v_min_f32 %0, %1, %2" : "=v"(r) : "v"(a), "v"(b)); return r; }
DEVI void ce_desc(unsigned& a, unsigned& b) { const unsigned mx = kmax_(a, b), mn = kmin_(a, b); a = mx; b = mn; }
DEVI void sort16_desc(unsigned (&v)[16]) {
    ce_desc(v[0], v[13]); ce_desc(v[1], v[12]); ce_desc(v[2], v[15]); ce_desc(v[3], v[14]); ce_desc(v[4], v[8]); ce_desc(v[5], v[6]); ce_desc(v[7], v[11]); ce_desc(v[9], v[10]);
    ce_desc(v[0], v[5]); ce_desc(v[1], v[7]); ce_desc(v[2], v[9]); ce_desc(v[3], v[4]); ce_desc(v[6], v[13]); ce_desc(v[8], v[14]); ce_desc(v[10], v[15]); ce_desc(v[11], v[12]);
    ce_desc(v[0], v[1]); ce_desc(v[2], v[3]); ce_desc(v[4], v[5]); ce_desc(v[6], v[8]); ce_desc(v[7], v[9]); ce_desc(v[10], v[11]); ce_desc(v[12], v[13]); ce_desc(v[14], v[15]);
    ce_desc(v[0], v[2]); ce_desc(v[1], v[3]); ce_desc(v[4], v[10]); ce_desc(v[5], v[11]); ce_desc(v[6], v[7]); ce_desc(v[8], v[9]); ce_desc(v[12], v[14]); ce_desc(v[13], v[15]);
    ce_desc(v[1], v[2]); ce_desc(v[3], v[12]); ce_desc(v[4], v[6]); ce_desc(v[5], v[7]); ce_desc(v[8], v[10]); ce_desc(v[9], v[11]); ce_desc(v[13], v[14]);
    ce_desc(v[1], v[4]); ce_desc(v[2], v[6]); ce_desc(v[5], v[8]); ce_desc(v[7], v[10]); ce_desc(v[9], v[13]); ce_desc(v[11], v[14]);
    ce_desc(v[2], v[4]); ce_desc(v[3], v[6]); ce_desc(v[9], v[12]); ce_desc(v[11], v[13]);
    ce_desc(v[3], v[5]); ce_desc(v[6], v[8]); ce_desc(v[7], v[9]); ce_desc(v[10], v[12]);
    ce_desc(v[3], v[4]); ce_desc(v[5], v[6]); ce_desc(v[7], v[8]); ce_desc(v[9], v[10]); ce_desc(v[11], v[12]);
    ce_desc(v[6], v[7]); ce_desc(v[8], v[9]);
}
DEVI void merge16_desc(unsigned (&v)[16]) {
#pragma unroll
    for (int j = 8; j > 0; j >>= 1)
#pragma unroll
        for (int i = 0; i < 16; ++i) { const int l = i ^ j; if (l > i) ce_desc(v[i], v[l]); }
}
DEVI void top16_merge(unsigned (&a)[16], const unsigned (&b)[16]) {
#pragma unroll
    for (int i = 0; i < 16; ++i) a[i] = kmax_(a[i], b[15 - i]);
    merge16_desc(a);
}
DEVI int crow16(int r, int hi) { return (r & 3) + 8 * (r >> 2) + 4 * hi; }

DEVI void subkey_top16(unsigned (&best)[16], const bf16* qrow  , const LAS unsigned char* kl  , int hi) {
    bf16x8_t qf[8];
#pragma unroll
    for (int ks = 0; ks < 8; ++ks) qf[ks] = *(const bf16x8_t*)(qrow + 16 * ks);
    unsigned grp[16];
#pragma unroll
    for (int nt = 0; nt < 4; ++nt) {
        f32x16_t acc = {};
#pragma unroll
        for (int ks = 0; ks < 8; ++ks) { const bf16x8_t kf = *(const LAS bf16x8_t*)(kl + ks * 4096 + nt * 512); acc = __builtin_amdgcn_mfma_f32_32x32x16_bf16(kf, qf[ks], acc, 0, 0, 0); }
#pragma unroll
        for (int r = 0; r < 16; ++r) { const float av = acc[r]; grp[r] = (__builtin_bit_cast(unsigned, av) & 0xffffff80u) | (unsigned)(127 - (32 * nt + crow16(r, hi))); }
        sort16_desc(grp);
        if (nt == 0) {
#pragma unroll
            for (int r = 0; r < 16; ++r) best[r] = grp[r];
        } else top16_merge(best, grp);
    }
    unsigned oth[16];
#pragma unroll
    for (int r = 0; r < 16; ++r) oth[r] = (unsigned)__shfl_xor((int)best[r], 32);
    top16_merge(best, oth);
}
DEVI void topk_wave(const bf16* qbase, const LAS unsigned char* keys, LAS unsigned* scr  , int* eidx, float* egate, int lane) {
    const int r32 = lane & 31, hi = lane >> 5;
    unsigned b0[16], b1[16];
    subkey_top16(b0, qbase + 8 * hi, keys + hi * 2048 + r32 * 16, hi);
    subkey_top16(b1, qbase + 128 + 8 * hi, keys + 32768 + hi * 2048 + r32 * 16, hi);
    float s0[16], s1[16];
#pragma unroll
    for (int i = 0; i < 16; ++i) { s0[i] = __builtin_bit_cast(float, b0[i] & 0xffffff80u); s1[i] = __builtin_bit_cast(float, b1[i] & 0xffffff80u); }
#pragma unroll
    for (int w = 0; w < 4; ++w) {
        scr[lane * 9 + w] = (127u - (b0[4 * w] & 127u)) | ((127u - (b0[4 * w + 1] & 127u)) << 8) | ((127u - (b0[4 * w + 2] & 127u)) << 16) | ((127u - (b0[4 * w + 3] & 127u)) << 24);
        scr[lane * 9 + 4 + w] = (127u - (b1[4 * w] & 127u)) | ((127u - (b1[4 * w + 1] & 127u)) << 8) | ((127u - (b1[4 * w + 2] & 127u)) << 16) | ((127u - (b1[4 * w + 3] & 127u)) << 24);
    }
    unsigned ca[16], cb2[16];
#define CAND(i, j) ((__builtin_bit_cast(unsigned, s0[i] + s1[j]) & 0xffffff00u) | (unsigned)(255 - ((i) * 16 + (j))))
    const unsigned lowest = 0xff800000u;
    if (hi == 0) {
#pragma unroll
        for (int j = 0; j < 16; ++j) ca[j] = CAND(0, j);
#pragma unroll
        for (int j = 0; j < 8; ++j) cb2[j] = CAND(1, j);
#pragma unroll
        for (int j = 8; j < 16; ++j) cb2[j] = lowest;
    } else {
        ca[0] = CAND(2, 0); ca[1] = CAND(2, 1); ca[2] = CAND(2, 2); ca[3] = CAND(2, 3); ca[4] = CAND(2, 4); ca[5] = CAND(3, 0); ca[6] = CAND(3, 1); ca[7] = CAND(3, 2); ca[8] = CAND(3, 3);
        ca[9] = CAND(4, 0); ca[10] = CAND(4, 1); ca[11] = CAND(4, 2); ca[12] = CAND(5, 0); ca[13] = CAND(5, 1); ca[14] = CAND(6, 0); ca[15] = CAND(6, 1);
        cb2[0] = CAND(7, 0); cb2[1] = CAND(7, 1); cb2[2] = CAND(8, 0); cb2[3] = CAND(9, 0); cb2[4] = CAND(10, 0); cb2[5] = CAND(11, 0); cb2[6] = CAND(12, 0); cb2[7] = CAND(13, 0); cb2[8] = CAND(14, 0); cb2[9] = CAND(15, 0);
#pragma unroll
        for (int j = 10; j < 16; ++j) cb2[j] = lowest;
    }
#undef CAND
    sort16_desc(ca); sort16_desc(cb2); top16_merge(ca, cb2);
    unsigned oth[16];
#pragma unroll
    for (int r = 0; r < 16; ++r) oth[r] = (unsigned)__shfl_xor((int)ca[r], 32);
    top16_merge(ca, oth);
    const float mx = __builtin_bit_cast(float, ca[0] & 0xffffff00u); float ex[16]; float l = 0.f;
#pragma unroll
    for (int k = 0; k < 16; ++k) { ex[k] = __expf(__builtin_bit_cast(float, ca[k] & 0xffffff00u) - mx); l += ex[k]; }
    const float rl = 1.f / l;
    LDS_WAIT(); asm volatile("" ::: "memory");
    int ei[8]; float eg[8];
    const unsigned mhi = (unsigned)(-hi);
#pragma unroll
    for (int k = 0; k < 8; ++k) { const unsigned key = ca[k] ^ ((ca[k] ^ ca[8 + k]) & mhi); const unsigned ij = 255u - (key & 255u), i = ij >> 4, j = ij & 15u;
        const unsigned w0 = scr[lane * 9 + (i >> 2)], w1 = scr[lane * 9 + 4 + (j >> 2)];
        ei[k] = (int)(((w0 >> (8 * (i & 3))) & 255u) * PNK + ((w1 >> (8 * (j & 3))) & 255u)); eg[k] = __builtin_bit_cast(float, __builtin_bit_cast(unsigned, ex[k]) ^ ((__builtin_bit_cast(unsigned, ex[k]) ^ __builtin_bit_cast(unsigned, ex[8 + k])) & mhi)) * rl; }
    *(int4*)(eidx + hi * 8) = make_int4(ei[0], ei[1], ei[2], ei[3]); *(int4*)(eidx + hi * 8 + 4) = make_int4(ei[4], ei[5], ei[6], ei[7]);
    *(float4*)(egate + hi * 8) = make_float4(eg[0], eg[1], eg[2], eg[3]); *(float4*)(egate + hi * 8 + 4) = make_float4(eg[4], eg[5], eg[6], eg[7]);
    LDS_WAIT(); asm volatile("" ::: "memory");
}

typedef unsigned char fp8_t;
template <int VAR = 0> DEVI float dot16_fp8(pg8::u32x4 row, pg8::u32x4 ha, pg8::u32x4 hb, float acc) {
    if (VAR == 1) return __builtin_bit_cast(float, (row[0] ^ row[1]) ^ (row[2] ^ row[3]));
#pragma unroll
    for (int i = 0; i < 4; ++i) { const unsigned hlo = i < 2 ? ha[2 * i] : hb[2 * i - 4], hhi = i < 2 ? ha[2 * i + 1] : hb[2 * i - 3];
        acc = __builtin_amdgcn_fdot2_f32_bf16(__builtin_amdgcn_cvt_scalef32_pk_bf16_fp8(row[i], 1.0f, false), __builtin_bit_cast(bf16x2_t, hlo), acc, false);
        acc = __builtin_amdgcn_fdot2_f32_bf16(__builtin_amdgcn_cvt_scalef32_pk_bf16_fp8(row[i], 1.0f, true), __builtin_bit_cast(bf16x2_t, hhi), acc, false); }
    return acc;
}
template <int VAR = 0> DEVI void fma16_fp8(float (&acc)[16], float w, pg8::u32x4 row) {
    if (VAR == 1) { acc[0] += __builtin_bit_cast(float, row[0] ^ row[1]); acc[1] += __builtin_bit_cast(float, row[2] ^ row[3]); return; }
#pragma unroll
    for (int i = 0; i < 4; ++i) { const pg8::f32x2 lo = __builtin_amdgcn_cvt_pk_f32_fp8(row[i], false), hh = __builtin_amdgcn_cvt_pk_f32_fp8(row[i], true);
        acc[4 * i] += w * lo[0]; acc[4 * i + 1] += w * lo[1]; acc[4 * i + 2] += w * hh[0]; acc[4 * i + 3] += w * hh[1]; }
}
DEVI void sort128_asc(unsigned& a, unsigned& b, int lane) {
#pragma unroll
    for (int k = 2; k <= 128; k <<= 1)
#pragma unroll
        for (int j = k >> 1; j > 0; j >>= 1) {
            if (j == 64) { const unsigned lo = umin_(a, b), hi = umax_(a, b); a = lo; b = hi; }
            else {
                const bool upper = (lane & j) != 0;
                const bool asc_a = k == 128 ? true : ((lane & k) == 0), asc_b = k == 128 ? true : (k == 64 ? false : ((lane & k) == 0));
                const unsigned pa_ = (unsigned)__shfl_xor((int)a, j), pb_ = (unsigned)__shfl_xor((int)b, j);
                a = (upper != asc_a) ? umin_(a, pa_) : umax_(a, pa_);
                b = (upper != asc_b) ? umin_(b, pb_) : umax_(b, pb_);
            }
        }
}
constexpr int EXD = 8, EXP_LDS_WAVE = 12800 + 2048;
typedef int v8i_t __attribute__((ext_vector_type(8)));
typedef float v4f_t __attribute__((ext_vector_type(4)));
struct Row6 { pg8::u32x4 a; pg8::u32x2 b; };
template <int VAR> DEVI void experts_wave(LAS unsigned char* wl_, int t0, int tstep, const bf16* H2B, const float* part2, const unsigned char* PU, const unsigned char* PV, const int* EIDX, const float* EGATE, const float* fg, float* out, int lane) {
    if (t0 >= M) return;
    const int ntok = (M - t0 + tstep - 1) / tstep < 8 ? (M - t0 + tstep - 1) / tstep : 8;
    LAS int* sid = (LAS int*)wl_; LAS float* gsl = (LAS float*)(wl_ + 4096); LAS float* wl = (LAS float*)(wl_ + 8192); LAS float* r2l = (LAS float*)(wl_ + 12288);
    const unsigned g32 = (unsigned)lane & 31u, hsel = (unsigned)lane >> 5, l4 = (unsigned)lane * 4u;
#define LDI(p) (*(const int*)((const char*)(p) + l4))
#define LDF(p) (*(const float*)((const char*)(p) + l4))
#define LDROW(dst, tab, ridx) do { const unsigned char* rp_ = (tab) + (size_t)(unsigned)(ridx) * 768u; (dst).a = *(const pg8::u32x4*)(rp_ + g32 * 16u); (dst).b = *(const pg8::u32x2*)(rp_ + 512u + g32 * 8u); } while (0)
    for (int k = 0; k < ntok; ++k) { const int t = t0 + k * tstep;
        unsigned k0 = ((unsigned)LDI(EIDX + (size_t)t * 128) << 7) | (unsigned)lane, k1 = ((unsigned)LDI(EIDX + (size_t)t * 128 + 64) << 7) | (unsigned)(64 + lane);
        const float ga = LDF(EGATE + (size_t)t * 128), gb = LDF(EGATE + (size_t)t * 128 + 64);
        sort128_asc(k0, k1, lane);
        const unsigned sl0 = k0 & 127u, sl1 = k1 & 127u;
        const float x0 = __shfl(ga, (int)(sl0 & 63u)), y0 = __shfl(gb, (int)(sl0 & 63u)), x1 = __shfl(ga, (int)(sl1 & 63u)), y1 = __shfl(gb, (int)(sl1 & 63u));
        sid[k * 128 + lane] = (int)(k0 >> 7); sid[k * 128 + 64 + lane] = (int)(k1 >> 7);
        gsl[k * 128 + lane] = sl0 < 64u ? x0 : y0; gsl[k * 128 + 64 + lane] = sl1 < 64u ? x1 : y1;
        const float r2 = rsqrtf(wave_sum(lane < 16 ? LDF(part2 + (size_t)t * 16) : 0.f) * (1.f / D) + EPS) * (1.0f / PU_SCALE);
        if (lane == 0) r2l[k] = r2; }
    LDS_WAIT(); asm volatile("" ::: "memory");
    const int nsteps = 8 * ntok;
#define STEP_DESC(q, tab, pos0) do { const int q_ = (q); if (q_ < nsteps) { (tab) = PU; (pos0) = ((q_ >> 5) * 4 + (q_ & 3)) * 128 + 16 * ((q_ >> 2) & 7); } \
        else if (q_ < 2 * nsteps) { const int qq_ = q_ - nsteps; (tab) = PV; (pos0) = ((qq_ >> 4) * 2 + (qq_ & 1)) * 128 + 16 * ((qq_ >> 1) & 7); } else { (tab) = PV; (pos0) = 0; } } while (0)
    constexpr int LOOK = 1;
    Row6 buf[8 * LOOK];
    pg8::u32x4 hhi[4], hlo[4];
#define CONVERT_GRP(g_) do { LAS unsigned char* img = wl_ + 12800; const int c16 = lane & 15, q4 = lane >> 4; \
      _Pragma("unroll") for (int k = 0; k < 4; ++k) { const int tt_ = t0 + (4 * (g_) + k) * tstep; \
          const pg8::u32x4 h0 = *(const pg8::u32x4*)((const char*)(H2B + (size_t)tt_ * D) + lane * 32), h1 = *(const pg8::u32x4*)((const char*)(H2B + (size_t)tt_ * D) + lane * 32 + 16); \
          float hf[16]; \
          _Pragma("unroll") for (int j = 0; j < 4; ++j) { hf[2 * j] = __builtin_bit_cast(float, h0[j] << 16); hf[2 * j + 1] = __builtin_bit_cast(float, h0[j] & 0xffff0000u); hf[8 + 2 * j] = __builtin_bit_cast(float, h1[j] << 16); hf[8 + 2 * j + 1] = __builtin_bit_cast(float, h1[j] & 0xffff0000u); } \
          pg8::u32x4 hiw, low; \
          _Pragma("unroll") for (int w = 0; w < 4; ++w) { int p = __builtin_amdgcn_cvt_pk_fp8_f32(hf[4 * w], hf[4 * w + 1], 0, false); p = __builtin_amdgcn_cvt_pk_fp8_f32(hf[4 * w + 2], hf[4 * w + 3], p, true); \
              const pg8::f32x2 b01 = __builtin_amdgcn_cvt_pk_f32_fp8(p, false), b23 = __builtin_amdgcn_cvt_pk_f32_fp8(p, true); \
              int ql = __builtin_amdgcn_cvt_pk_fp8_f32(hf[4 * w] - b01[0], hf[4 * w + 1] - b01[1], 0, false); ql = __builtin_amdgcn_cvt_pk_fp8_f32(hf[4 * w + 2] - b23[0], hf[4 * w + 3] - b23[1], ql, true); \
              hiw[w] = (unsigned)p; low[w] = (unsigned)ql; } \
          *(LAS pg8::u32x4*)(img + lane * 16) = hiw; *(LAS pg8::u32x4*)(img + 1024 + lane * 16) = low; \
          LDS_WAIT(); asm volatile("" ::: "memory"); \
          const int off = 32 * c16 + 512 * (q4 >> 1) + 16 * (q4 & 1); \
          hhi[k] = *(const LAS pg8::u32x4*)(img + off); hlo[k] = *(const LAS pg8::u32x4*)(img + 1024 + off); \
          LDS_WAIT(); asm volatile("" ::: "memory"); } } while (0)
#pragma unroll
    for (int i = 0; i < 8; ++i) { const int ri = sid[2 * i + (int)hsel]; LDROW(buf[i], PU, ri); }
#define TR_STEP(S) _Pragma("unroll") for (int i = 0; i < S; ++i) { const bool up_ = (lane & S) != 0; const float send = up_ ? r[i] : r[i + S], keep = up_ ? r[i + S] : r[i]; r[i] = keep + __shfl_xor(send, S); }
#define U_STEP(q, B_, K_, G_) do { const int q__ = (q); const int ub_ = (B_); constexpr int uk_ = (K_); const int tk_ = 4 * (G_) + uk_; \
        const unsigned char* ntab; int npos; STEP_DESC(q__ + LOOK, ntab, npos); npos += (int)hsel; \
        const v8i_t AAh = {(int)hhi[uk_][0], (int)hhi[uk_][1], (int)hhi[uk_][2], (int)hhi[uk_][3], 0, 0, 0, 0}, AAl = {(int)hlo[uk_][0], (int)hlo[uk_][1], (int)hlo[uk_][2], (int)hlo[uk_][3], 0, 0, 0, 0}; \
        const v8i_t ABh = {0, 0, 0, 0, (int)hhi[uk_][0], (int)hhi[uk_][1], (int)hhi[uk_][2], (int)hhi[uk_][3]}, ABl = {0, 0, 0, 0, (int)hlo[uk_][0], (int)hlo[uk_][1], (int)hlo[uk_][2], (int)hlo[uk_][3]}; \
        const int c16_ = lane & 15; const bool dg_ = (lane >> 4) == (c16_ >> 2); \
        float r[16]; \
        _Pragma("unroll") for (int i2 = 0; i2 < 8; ++i2) { \
            const v8i_t B6 = {(int)buf[i2].a[0], (int)buf[i2].a[1], (int)buf[i2].a[2], (int)buf[i2].a[3], (int)buf[i2].b[0], (int)buf[i2].b[1], 0, 0}; \
            const v4f_t z4 = {0.f, 0.f, 0.f, 0.f}; \
            v4f_t cA = __builtin_amdgcn_mfma_scale_f32_16x16x128_f8f6f4(AAh, B6, z4, 0, 2, 0, 127, 0, 127); cA = __builtin_amdgcn_mfma_scale_f32_16x16x128_f8f6f4(AAl, B6, cA, 0, 2, 0, 127, 0, 127); \
            v4f_t cB = __builtin_amdgcn_mfma_scale_f32_16x16x128_f8f6f4(ABh, B6, z4, 0, 2, 0, 127, 0, 127); cB = __builtin_amdgcn_mfma_scale_f32_16x16x128_f8f6f4(ABl, B6, cB, 0, 2, 0, 127, 0, 127); \
            const int ri = sid[npos + 2 * i2]; LDROW(buf[i2], ntab, ri); \
            const float a01 = (c16_ & 1) ? cA[1] : cA[0], a23 = (c16_ & 1) ? cA[3] : cA[2], b01 = (c16_ & 1) ? cB[1] : cB[0], b23 = (c16_ & 1) ? cB[3] : cB[2]; \
            r[2 * i2] = dg_ ? ((c16_ & 2) ? a23 : a01) : 0.f; r[2 * i2 + 1] = dg_ ? ((c16_ & 2) ? b23 : b01) : 0.f; \
            __builtin_amdgcn_sched_barrier(0); } \
        TR_STEP(8) TR_STEP(4) TR_STEP(2) TR_STEP(1) \
        float tot = r[0] + __shfl_xor(r[0], 16); tot += __shfl_xor(tot, 32); \
        const int pos = tk_ * 128 + 16 * ub_ + c16_; \
        const float a = tot * r2l[tk_]; \
        wl[pos] = 0.5f * a * (1.f + erff(a * 0.70710678118654752f)) * gsl[pos] * (1.0f / PV_SCALE); } while (0)
    if (ntok == 8) {
#pragma unroll 1
        for (int grp = 0; grp < 2; ++grp) {
            CONVERT_GRP(grp);
#pragma unroll 1
            for (int b = 0; b < 8; ++b) { const int q = grp * 32 + b * 4;
                U_STEP(q, b, 0, grp); U_STEP(q + 1, b, 1, grp); U_STEP(q + 2, b, 2, grp); U_STEP(q + 3, b, 3, grp); }
        }
    }
#undef CONVERT_GRP
#undef U_STEP
#undef TR_STEP
    LDS_WAIT(); asm volatile("" ::: "memory");
#define V_STEP(q, ACC, KT) do { const int q__ = (q); const int b = ((q__ - nsteps) >> 1) & 7; \
        const unsigned char* ntab; int npos; STEP_DESC(q__ + LOOK, ntab, npos); npos += (int)hsel; \
        const int wpos = (KT) * 128 + b * 16 + (int)hsel; \
        _Pragma("unroll") for (int i2 = 0; i2 < 8; ++i2) { \
            const v6u_t p = {buf[i2].a[0], buf[i2].a[1], buf[i2].a[2], buf[i2].a[3], buf[i2].b[0], buf[i2].b[1]}; \
            const float wv = wl[wpos + 2 * i2]; \
            { const v32f_t rv = __builtin_amdgcn_cvt_scalef32_pk32_f32_fp6(p, 1.0f); \
                const f32x2_t w2_ = {wv, wv}; _Pragma("unroll") for (int j = 0; j < 32; j += 2) { const f32x2_t r2_ = {rv[j], rv[j + 1]}; f32x2_t a2_ = {ACC[j], ACC[j + 1]}; a2_ = __builtin_elementwise_fma(r2_, w2_, a2_); ACC[j] = a2_[0]; ACC[j + 1] = a2_[1]; } } \
            const int ri = sid[npos + 2 * i2]; LDROW(buf[i2], ntab, ri); \
            asm volatile("" : "+v"(ACC[0]), "+v"(ACC[1]), "+v"(ACC[2]), "+v"(ACC[3]), "+v"(ACC[4]), "+v"(ACC[5]), "+v"(ACC[6]), "+v"(ACC[7]), "+v"(ACC[8]), "+v"(ACC[9]), "+v"(ACC[10]), "+v"(ACC[11]), "+v"(ACC[12]), "+v"(ACC[13]), "+v"(ACC[14]), "+v"(ACC[15])); \
            asm volatile("" : "+v"(ACC[16]), "+v"(ACC[17]), "+v"(ACC[18]), "+v"(ACC[19]), "+v"(ACC[20]), "+v"(ACC[21]), "+v"(ACC[22]), "+v"(ACC[23]), "+v"(ACC[24]), "+v"(ACC[25]), "+v"(ACC[26]), "+v"(ACC[27]), "+v"(ACC[28]), "+v"(ACC[29]), "+v"(ACC[30]), "+v"(ACC[31])); \
            __builtin_amdgcn_sched_barrier(0); } } while (0)
#define V_FINISH(ACC, KT, RA, RB) do { const int t = t0 + (KT) * tstep; \
        float fin[16]; \
        _Pragma("unroll") for (int j = 0; j < 16; ++j) { const float lo = ACC[j], hi = ACC[16 + j]; const float send = hsel ? lo : hi, keep = hsel ? hi : lo; fin[j] = keep + __shfl_xor(send, 32); } \
        float* orow = (float*)((char*)(out + (size_t)t * D) + eoff); float ss = 0.f; \
        _Pragma("unroll") for (int q = 0; q < 4; ++q) { fin[2 * q] += __builtin_bit_cast(float, RA[q] << 16); fin[2 * q + 1] += __builtin_bit_cast(float, RA[q] & 0xffff0000u); fin[8 + 2 * q] += __builtin_bit_cast(float, RB[q] << 16); fin[8 + 2 * q + 1] += __builtin_bit_cast(float, RB[q] & 0xffff0000u); } \
        _Pragma("unroll") for (int j = 0; j < 16; ++j) ss += fin[j] * fin[j]; \
        const float rr = rsqrtf(wave_sum(ss) * (1.f / D) + EPS); \
        _Pragma("unroll") for (int q = 0; q < 4; ++q) { const float4 g = fgq[q]; \
            *(float4*)(orow + q * 4) = make_float4(fin[4 * q] * rr * g.x, fin[4 * q + 1] * rr * g.y, fin[4 * q + 2] * rr * g.z, fin[4 * q + 3] * rr * g.w); } } while (0)
    const unsigned eoff = (g32 * 32u + hsel * 16u) * 4u;
    float4 fgq[4];
#pragma unroll
    for (int q = 0; q < 4; ++q) fgq[q] = *(const float4*)((const char*)(fg + q * 4) + eoff);
#pragma unroll 1
    for (int kp = 0; kp < ntok / 2; ++kp) { const int k0_ = 2 * kp, k1_ = 2 * kp + 1;
        const char* h0p = (const char*)(H2B + (size_t)(t0 + k0_ * tstep) * D) + eoff / 2; const char* h1p = (const char*)(H2B + (size_t)(t0 + k1_ * tstep) * D) + eoff / 2;
        const pg8::u32x4 ra0 = *(const pg8::u32x4*)h0p, rb0 = *(const pg8::u32x4*)(h0p + 16), ra1 = *(const pg8::u32x4*)h1p, rb1 = *(const pg8::u32x4*)(h1p + 16);
        __builtin_amdgcn_sched_barrier(0);
        float acc0[32], acc1[32];
#pragma unroll
        for (int j = 0; j < 32; ++j) { acc0[j] = 0.f; acc1[j] = 0.f; }
#pragma unroll 1
        for (int bb = 0; bb < 8; ++bb) { const int q = nsteps + 16 * kp + 2 * bb; V_STEP(q, acc0, k0_); V_STEP(q + 1, acc1, k1_); }
        V_FINISH(acc0, k0_, ra0, rb0);
        V_FINISH(acc1, k1_, ra1, rb1);
        __builtin_amdgcn_sched_barrier(0);
    }
#undef V_FINISH
#undef V_STEP
#undef STEP_DESC
#undef LDI
#undef LDF
#undef LDROW
}

typedef short v4i16_t __attribute__((ext_vector_type(4)));
typedef int v2i32_t __attribute__((ext_vector_type(2)));
typedef int v4i32_t __attribute__((ext_vector_type(4)));
DEVI bf16x8_t join_tr(v4i16_t lo, v4i16_t hh) { const v2i32_t a = __builtin_bit_cast(v2i32_t, lo), b = __builtin_bit_cast(v2i32_t, hh); const v4i32_t w = {a[0], a[1], b[0], b[1]}; return __builtin_bit_cast(bf16x8_t, w); }
DEVI float max3f(float a, float b, float c) { float r; asm("v_max3_f32 %0, %1, %2, %3" : "=v"(r) : "v"(a), "v"(b), "v"(c)); return r; }
DEVI float max2f(float a, float b) { float r; asm("v_max_f32_e32 %0, %1, %2" : "=v"(r) : "v"(a), "v"(b)); return r; }
DEVI void glds16(const void* gsrc, unsigned lds_dst) { unsigned keep;
    asm volatile("s_mov_b32 %0, m0\n\ts_mov_b32 m0, %2\n\ts_nop 0\n\tglobal_load_lds_dwordx4 %1, off\n\ts_mov_b32 m0, %0" : "=&s"(keep) : "v"(gsrc), "s"(lds_dst) : "memory"); }
#define LDSADDR(p) ((unsigned)__builtin_amdgcn_readfirstlane((int)(unsigned)(uintptr_t)(p)))
#define ATT_BAR(N) asm volatile("s_waitcnt vmcnt(" #N ") lgkmcnt(0)\n\ts_barrier" ::: "memory")
template <int DQK, int DV, int DSPLIT, int NSLOT, int PD, bool CAUSAL, bool STAG, int VAR = 0>
DEVI void attn_unit(LAS unsigned char* S, const bf16* Qu, int qpitch, const bf16* Ku, int kpitch, const bf16* Vu, int vpitch, bf16* Ou, int opitch, int NT, int qcb) {
    constexpr int NCH = DQK / 8, KSLOT = NCH * 1024, NVG = DV / 32, VSLOT = NVG * 4096, NRG = 8 / DSPLIT, DVW = DV / DSPLIT, NOD = DVW / 32, NKS = DQK / 16;
    constexpr int KOFF = 0, VOFF = NSLOT * KSLOT, WSF = VOFF + NSLOT * VSLOT;
    static_assert(NRG * 32 * DVW * 2 * DSPLIT <= NSLOT * KSLOT, "O staging reuses the K ring");
    static_assert(NSLOT >= PD + (STAG ? 2 : 1), "ring depth");
    int tid_ = threadIdx.x; asm volatile("" : "+v"(tid_));
    const int lane = tid_ & 63, wid = __builtin_amdgcn_readfirstlane(tid_ >> 6), r32 = lane & 31, hi = lane >> 5, rg = wid % NRG, dp = wid / NRG;
    const bool late = STAG && wid >= 4;
    LAS float* wsf = (LAS float*)(S + WSF) + wid * 64;
    const int nld = (NCH - wid + 7) / 8 + (NVG * 4 - wid + 7) / 8;
    const bf16* ksrc = Ku + (size_t)lane * kpitch;
    const bf16* vsrc = Vu + (size_t)(lane >> 2) * vpitch + (lane & 3) * 8;
#define ATT_DMA(t, slot) do { \
        _Pragma("unroll") for (int pc_ = 0; pc_ < (NCH + 7) / 8; ++pc_) { const int pc = wid + 8 * pc_; if (pc < NCH) \
            glds16(ksrc + (size_t)(t) * 64 * kpitch + pc * 8, LDSADDR(S + KOFF + (slot) * KSLOT + pc * 1024)); } \
        _Pragma("unroll") for (int pv_ = 0; pv_ < (NVG * 4 + 7) / 8; ++pv_) { const int pv = wid + 8 * pv_; if (pv < NVG * 4) \
            glds16(vsrc + (size_t)((t) * 64 + (pv & 3) * 16) * vpitch + (pv >> 2) * 32, LDSADDR(S + VOFF + (slot) * VSLOT + pv * 1024)); } } while (0)
    bf16x8_t qr[NKS];
#pragma unroll
    for (int ks = 0; ks < NKS; ++ks) qr[ks] = *(const bf16x8_t*)(Qu + (size_t)(32 * rg + r32) * qpitch + ks * 16 + hi * 8);
#pragma unroll
    for (int ks = 0; ks < NKS; ++ks) asm volatile("" : "+v"(qr[ks]));
#pragma unroll
    for (int t = 0; t < PD; ++t) if (t < NT) ATT_DMA(t, t);
    f32x16_t o[NOD];
#pragma unroll
    for (int dd = 0; dd < NOD; ++dd) o[dd] = f32x16_t{};
    float m = 0.f, l = 0.f; f32x16_t negm = f32x16_t{};
    const int tlast = CAUSAL ? qcb + (rg >> 1) : NT - 1;
    const LAS unsigned char* kbase = S + KOFF + hi * 1024 + r32 * 16;
    const LAS unsigned char* vbase = S + VOFF + ((lane >> 4) & 1) * 32 + (lane & 3) * 8 + (4 * hi + ((lane & 15) >> 2)) * 64 + dp * NOD * 4096;
    bf16x8_t pa[4];
#define ATT_QKSM(sl) do { const LAS unsigned char* kp = kbase + (sl) * KSLOT; \
            f32x16_t p0 = negm, p1 = negm; \
            _Pragma("unroll") for (int ks = 0; ks < NKS; ++ks) { const bf16x8_t a0 = *(const LAS bf16x8_t*)(kp + ks * 2048), a1 = *(const LAS bf16x8_t*)(kp + ks * 2048 + 512); \
                if (VAR != 2) { p0 = __builtin_amdgcn_mfma_f32_32x32x16_bf16(a0, qr[ks], p0, 0, 0, 0); p1 = __builtin_amdgcn_mfma_f32_32x32x16_bf16(a1, qr[ks], p1, 0, 0, 0); } else { p0[ks] += __builtin_bit_cast(float, (int)a0[0]); p1[ks] += __builtin_bit_cast(float, (int)a1[0]); } } \
            asm volatile("s_nop 15\n\ts_nop 7" : "+v"(p0), "+v"(p1)); \
            float rm = 0.f; \
            if (VAR != 1) { float a = max3f(p0[0], p0[1], p1[0]), b = max3f(p0[2], p0[3], p1[1]); a = max3f(a, p1[2], p1[3]); \
              _Pragma("unroll") for (int r = 4; r < 16; r += 4) { a = max3f(a, p0[r], p0[r + 1]); b = max3f(b, p0[r + 2], p0[r + 3]); a = max3f(a, p1[r], p1[r + 1]); b = max3f(b, p1[r + 2], p1[r + 3]); } \
              rm = max2f(a, b); rm = max2f(rm, __shfl_xor(rm, 32)); } \
            if (__any(rm > 0.f)) { \
                const float dl = fmaxf(rm, 0.f), alpha = __builtin_amdgcn_exp2f(-dl); m += dl; l *= alpha; \
                _Pragma("unroll") for (int r = 0; r < 16; ++r) { p0[r] -= dl; p1[r] -= dl; negm[r] = -m; } \
                if (hi == 0) wsf[r32] = alpha; \
                LDS_WAIT(); asm volatile("" ::: "memory"); \
                _Pragma("unroll") for (int r = 0; r < 16; ++r) { const float f = wsf[crow16(r, hi)]; \
                    _Pragma("unroll") for (int dd = 0; dd < NOD; ++dd) o[dd][r] *= f; } \
                LDS_WAIT(); asm volatile("" ::: "memory"); \
            } \
            float ls = 0.f; \
            if (VAR != 1) { _Pragma("unroll") for (int r = 0; r < 16; ++r) { p0[r] = __builtin_amdgcn_exp2f(p0[r]); p1[r] = __builtin_amdgcn_exp2f(p1[r]); ls += p0[r] + p1[r]; } } \
            l += ls; \
            _Pragma("unroll") for (int ks = 0; ks < 4; ++ks) { pg8::u32x4 w; \
                if (ks < 2) { w.x = pg8::cvt_pk_bf16(p0[8 * ks], p0[8 * ks + 1]); w.y = pg8::cvt_pk_bf16(p0[8 * ks + 2], p0[8 * ks + 3]); w.z = pg8::cvt_pk_bf16(p0[8 * ks + 4], p0[8 * ks + 5]); w.w = pg8::cvt_pk_bf16(p0[8 * ks + 6], p0[8 * ks + 7]); } \
                else { const int k2 = ks - 2; w.x = pg8::cvt_pk_bf16(p1[8 * k2], p1[8 * k2 + 1]); w.y = pg8::cvt_pk_bf16(p1[8 * k2 + 2], p1[8 * k2 + 3]); w.z = pg8::cvt_pk_bf16(p1[8 * k2 + 4], p1[8 * k2 + 5]); w.w = pg8::cvt_pk_bf16(p1[8 * k2 + 6], p1[8 * k2 + 7]); } \
                pa[ks] = __builtin_bit_cast(bf16x8_t, w); } } while (0)
#define ATT_PV(sl) do { const LAS unsigned char* vp = vbase + (sl) * VSLOT; \
            _Pragma("unroll") for (int dd = 0; dd < NOD; ++dd) \
                _Pragma("unroll") for (int ks = 0; ks < 4; ++ks) { \
                    const v4i16_t lo = __builtin_amdgcn_ds_read_tr16_b64_v4i16((LAS v4i16_t*)(vp + dd * 4096 + ks * 1024)); \
                    const v4i16_t hh = __builtin_amdgcn_ds_read_tr16_b64_v4i16((LAS v4i16_t*)(vp + dd * 4096 + ks * 1024 + 512)); \
                    const bf16x8_t vf = join_tr(lo, hh); \
                    if (VAR != 2) o[dd] = __builtin_amdgcn_mfma_f32_32x32x16_bf16(pa[ks], vf, o[dd], 0, 0, 0); else o[dd][ks] += __builtin_bit_cast(float, (int)vf[0] + (int)pa[ks][0]); } } while (0)
    int slot = 0, slot_prev = NSLOT - 1, slot_issue = PD % NSLOT;
    for (int t = 0; t < NT; ++t) {
        const int ahead = (t + PD - 1 < NT - 1 ? t + PD - 1 : NT - 1) - t;
        const int nwait = ahead * nld;
        if (nwait <= 0) ATT_BAR(0); else if (nwait == 2) ATT_BAR(2); else if (nwait == 3) ATT_BAR(3); else if (nwait == 4) ATT_BAR(4); else if (nwait == 6) ATT_BAR(6); else if (nwait == 8) ATT_BAR(8); else ATT_BAR(0);
        if (t + PD < NT) ATT_DMA(t + PD, slot_issue);
        if (!late) { if (t <= tlast) { ATT_QKSM(slot); ATT_PV(slot); } }
        else { if (t >= 1 && t - 1 <= tlast) ATT_PV(slot_prev); if (t <= tlast) ATT_QKSM(slot); }
        slot_prev = slot; slot = slot + 1 == NSLOT ? 0 : slot + 1; slot_issue = slot_issue + 1 == NSLOT ? 0 : slot_issue + 1;
    }
    if (late && tlast >= NT - 1) ATT_PV(slot_prev);
    l += __shfl_xor(l, 32);
    if (hi == 0) wsf[32 + r32] = l;
    ATT_BAR(0);
    LAS bf16* stg = (LAS bf16*)(S + KOFF) + wid * 32 * DVW;
#pragma unroll
    for (int r = 0; r < 16; ++r) { const int orow = crow16(r, hi); const float rl = __builtin_amdgcn_rcpf(wsf[32 + orow]);
#pragma unroll
        for (int dd = 0; dd < NOD; ++dd) stg[orow * DVW + dd * 32 + r32] = f2bf(o[dd][r] * rl); }
    LDS_WAIT(); asm volatile("" ::: "memory");
#pragma unroll
    for (int i = 0; i < DVW / 16; ++i) { const int idx = i * 64 + lane, row = idx / (DVW / 8), ch = idx % (DVW / 8);
        *(pg8::u32x4*)(Ou + (size_t)(32 * rg + row) * opitch + dp * DVW + ch * 8) = *(const LAS pg8::u32x4*)(stg + row * DVW + ch * 8); }
    ATT_BAR(0);
#undef ATT_DMA
#undef ATT_QKSM
#undef ATT_PV
}

typedef float f32x2_t __attribute__((ext_vector_type(2)));
DEVI unsigned cvtpk(float lo, float hi) { const f32x2_t v = {lo, hi}; const bf16x2_t b = __builtin_convertvector(v, bf16x2_t); return __builtin_bit_cast(unsigned, b); }
DEVI void attn_mla_unit(LAS unsigned char* S, const bf16* Qu, const bf16* Ku, const bf16* Vu, bf16* Ou, int NT, int qcb) {
    constexpr int NCH = 12, KSLOT = NCH * 1024, VSLOT = 8192, NSLOT = 4, NKS = 6, qpitch = 768, kpitch = 768, vpitch = 512, opitch = D;
    constexpr int KOFF = 0, VOFF = NSLOT * KSLOT, WSF = VOFF + NSLOT * VSLOT;
    int tid_ = threadIdx.x; asm volatile("" : "+v"(tid_));
    const int lane = tid_ & 63, wid = __builtin_amdgcn_readfirstlane(tid_ >> 6), r32 = lane & 31, hi = lane >> 5;
    LAS float* wsf = (LAS float*)(S + WSF) + wid * 64;
    const int nld = wid < 4 ? 3 : 2;
    const bf16* ksrc = Ku + (size_t)lane * kpitch;
    const bf16* vsrc = Vu + (size_t)(lane >> 2) * vpitch + (lane & 3) * 8;
#define MLA_DMA(t, slot) do { \
        glds16(ksrc + (size_t)(t) * 64 * kpitch + wid * 8, LDSADDR(S + KOFF + (slot) * KSLOT + wid * 1024)); \
        if (wid < 4) glds16(ksrc + (size_t)(t) * 64 * kpitch + (wid + 8) * 8, LDSADDR(S + KOFF + (slot) * KSLOT + (wid + 8) * 1024)); \
        glds16(vsrc + (size_t)((t) * 64 + (wid & 3) * 16) * vpitch + (wid >> 2) * 32, LDSADDR(S + VOFF + (slot) * VSLOT + wid * 1024)); } while (0)
#define MLA_BAR(nw) do { if ((nw) <= 0) ATT_BAR(0); else if ((nw) == 2) ATT_BAR(2); else if ((nw) == 3) ATT_BAR(3); else if ((nw) == 4) ATT_BAR(4); else ATT_BAR(6); } while (0)
#define SGB(mask, n) __builtin_amdgcn_sched_group_barrier(mask, n, 0)
    bf16x8_t qr[NKS];
#pragma unroll
    for (int ks = 0; ks < NKS; ++ks) qr[ks] = *(const bf16x8_t*)(Qu + (size_t)(32 * wid + r32) * qpitch + ks * 16 + hi * 8);
#pragma unroll
    for (int ks = 0; ks < NKS; ++ks) asm volatile("" : "+v"(qr[ks]));
    MLA_DMA(0, 0); MLA_DMA(1, 1); MLA_DMA(2, 2);
    f32x16_t o0 = f32x16_t{}, o1 = f32x16_t{};
    float m = 0.f, l = 0.f; f32x16_t negm = f32x16_t{};
    const int tlast = qcb + (wid >> 1);
    const LAS unsigned char* kbase = S + KOFF + hi * 1024 + r32 * 16;
    const LAS unsigned char* vbase = S + VOFF + ((lane >> 4) & 1) * 32 + (lane & 3) * 8 + (4 * hi + ((lane & 15) >> 2)) * 64;
    f32x16_t p0, p1;
#define MLA_ROWMAX(rm, q0, q1) do { float a_ = __builtin_fmaxf(__builtin_fmaxf(q0[0], q0[1]), q1[0]), b_ = __builtin_fmaxf(__builtin_fmaxf(q0[2], q0[3]), q1[1]); a_ = __builtin_fmaxf(__builtin_fmaxf(a_, q1[2]), q1[3]); \
        _Pragma("unroll") for (int r = 4; r < 16; r += 4) { a_ = __builtin_fmaxf(__builtin_fmaxf(a_, q0[r]), q0[r + 1]); b_ = __builtin_fmaxf(__builtin_fmaxf(b_, q0[r + 2]), q0[r + 3]); a_ = __builtin_fmaxf(__builtin_fmaxf(a_, q1[r]), q1[r + 1]); b_ = __builtin_fmaxf(__builtin_fmaxf(b_, q1[r + 2]), q1[r + 3]); } \
        rm = __builtin_fmaxf(a_, b_); rm = __builtin_fmaxf(rm, __shfl_xor(rm, 32)); } while (0)
#define MLA_MOVE(rm, q0, q1) do { if (__any(rm > 0.f)) { \
            const float dl = fmaxf(rm, 0.f), alpha = __builtin_amdgcn_exp2f(-dl); m += dl; l *= alpha; \
            _Pragma("unroll") for (int r = 0; r < 16; ++r) { q0[r] -= dl; q1[r] -= dl; negm[r] = -m; } \
            if (hi == 0) wsf[r32] = alpha; \
            LDS_WAIT(); asm volatile("" ::: "memory"); \
            _Pragma("unroll") for (int r = 0; r < 16; ++r) { const float f = wsf[crow16(r, hi)]; o0[r] *= f; o1[r] *= f; } \
            LDS_WAIT(); asm volatile("" ::: "memory"); } } while (0)
    MLA_BAR(2 * nld);
    MLA_DMA(3, 3);
    { const LAS unsigned char* kp = kbase; p0 = negm; p1 = negm;
#pragma unroll
      for (int ks = 0; ks < NKS; ++ks) { const bf16x8_t a0 = *(const LAS bf16x8_t*)(kp + ks * 2048), a1 = *(const LAS bf16x8_t*)(kp + ks * 2048 + 512);
          p0 = __builtin_amdgcn_mfma_f32_32x32x16_bf16(a0, qr[ks], p0, 0, 0, 0); p1 = __builtin_amdgcn_mfma_f32_32x32x16_bf16(a1, qr[ks], p1, 0, 0, 0); }
      float rm; MLA_ROWMAX(rm, p0, p1); MLA_MOVE(rm, p0, p1); }
    int kslot = 1, vslot = 0, islot = 3;
    for (int t = 0; t < NT; ++t) {
        if (t + 1 < NT) { const int young = (t + 2 < NT) ? 1 : 0; MLA_BAR(young * nld); } else ATT_BAR(0);
        if (t >= 1 && t + 3 < NT) MLA_DMA(t + 3, islot);
        if (t < tlast) {
            const LAS unsigned char* kp = kbase + kslot * KSLOT; const LAS unsigned char* vp = vbase + vslot * VSLOT;
            bf16x8_t kf[12];
#pragma unroll
            for (int ks = 0; ks < NKS; ++ks) { kf[2 * ks] = *(const LAS bf16x8_t*)(kp + ks * 2048); kf[2 * ks + 1] = *(const LAS bf16x8_t*)(kp + ks * 2048 + 512); }
            f32x16_t n0 = negm, n1 = negm; float ls = 0.f; pg8::u32x4 pw[4];
#pragma unroll
            for (int ks = 0; ks < NKS; ++ks) { n0 = __builtin_amdgcn_mfma_f32_32x32x16_bf16(kf[2 * ks], qr[ks], n0, 0, 0, 0); n1 = __builtin_amdgcn_mfma_f32_32x32x16_bf16(kf[2 * ks + 1], qr[ks], n1, 0, 0, 0); }
#pragma unroll
            for (int r = 0; r < 16; ++r) { p0[r] = __builtin_amdgcn_exp2f(p0[r]); p1[r] = __builtin_amdgcn_exp2f(p1[r]); }
#pragma unroll
            for (int r = 0; r < 16; r += 2) { ls += (p0[r] + p0[r + 1]) + (p1[r] + p1[r + 1]); }
#pragma unroll
            for (int ks = 0; ks < 2; ++ks) { pw[ks] = (pg8::u32x4){cvtpk(p0[8 * ks], p0[8 * ks + 1]), cvtpk(p0[8 * ks + 2], p0[8 * ks + 3]), cvtpk(p0[8 * ks + 4], p0[8 * ks + 5]), cvtpk(p0[8 * ks + 6], p0[8 * ks + 7])};
                pw[2 + ks] = (pg8::u32x4){cvtpk(p1[8 * ks], p1[8 * ks + 1]), cvtpk(p1[8 * ks + 2], p1[8 * ks + 3]), cvtpk(p1[8 * ks + 4], p1[8 * ks + 5]), cvtpk(p1[8 * ks + 6], p1[8 * ks + 7])}; }
            l += ls;
            SGB(0x100, 4);
#pragma unroll
            for (int i = 0; i < 12; ++i) { SGB(0x008, 1); SGB(0x002, 7); if (i < 8) SGB(0x100, 1); }
            __builtin_amdgcn_sched_barrier(0);
            v4i16_t vlo[8], vhi[8];
#pragma unroll
            for (int i = 0; i < 8; ++i) { vlo[i] = __builtin_amdgcn_ds_read_tr16_b64_v4i16((LAS v4i16_t*)(vp + (i >> 2) * 4096 + (i & 3) * 1024)); vhi[i] = __builtin_amdgcn_ds_read_tr16_b64_v4i16((LAS v4i16_t*)(vp + (i >> 2) * 4096 + (i & 3) * 1024 + 512)); }
#pragma unroll
            for (int i = 0; i < 8; ++i) { const bf16x8_t vf = join_tr(vlo[i], vhi[i]); const bf16x8_t pa_ = __builtin_bit_cast(bf16x8_t, pw[i & 3]);
                if (i < 4) o0 = __builtin_amdgcn_mfma_f32_32x32x16_bf16(pa_, vf, o0, 0, 0, 0); else o1 = __builtin_amdgcn_mfma_f32_32x32x16_bf16(pa_, vf, o1, 0, 0, 0); }
            float rm; MLA_ROWMAX(rm, n0, n1);
            SGB(0x100, 6);
#pragma unroll
            for (int i = 0; i < 8; ++i) { SGB(0x008, 1); SGB(0x002, 3); if (i < 5) SGB(0x100, 2); }
            __builtin_amdgcn_sched_barrier(0);
            MLA_MOVE(rm, n0, n1);
            p0 = n0; p1 = n1;
        } else if (t == tlast) {
            asm volatile("" : "+v"(p0), "+v"(p1));
            const LAS unsigned char* vp = vbase + vslot * VSLOT; float ls = 0.f; pg8::u32x4 pw[4];
#pragma unroll
            for (int r = 0; r < 16; ++r) { p0[r] = __builtin_amdgcn_exp2f(p0[r]); p1[r] = __builtin_amdgcn_exp2f(p1[r]); ls += p0[r] + p1[r]; }
            l += ls;
#pragma unroll
            for (int ks = 0; ks < 2; ++ks) { pw[ks] = (pg8::u32x4){cvtpk(p0[8 * ks], p0[8 * ks + 1]), cvtpk(p0[8 * ks + 2], p0[8 * ks + 3]), cvtpk(p0[8 * ks + 4], p0[8 * ks + 5]), cvtpk(p0[8 * ks + 6], p0[8 * ks + 7])};
                pw[2 + ks] = (pg8::u32x4){cvtpk(p1[8 * ks], p1[8 * ks + 1]), cvtpk(p1[8 * ks + 2], p1[8 * ks + 3]), cvtpk(p1[8 * ks + 4], p1[8 * ks + 5]), cvtpk(p1[8 * ks + 6], p1[8 * ks + 7])}; }
#pragma unroll
            for (int i = 0; i < 8; ++i) { const v4i16_t lo = __builtin_amdgcn_ds_read_tr16_b64_v4i16((LAS v4i16_t*)(vp + (i >> 2) * 4096 + (i & 3) * 1024)), hh = __builtin_amdgcn_ds_read_tr16_b64_v4i16((LAS v4i16_t*)(vp + (i >> 2) * 4096 + (i & 3) * 1024 + 512));
                const bf16x8_t vf = join_tr(lo, hh); const bf16x8_t pa_ = __builtin_bit_cast(bf16x8_t, pw[i & 3]);
                if (i < 4) o0 = __builtin_amdgcn_mfma_f32_32x32x16_bf16(pa_, vf, o0, 0, 0, 0); else o1 = __builtin_amdgcn_mfma_f32_32x32x16_bf16(pa_, vf, o1, 0, 0, 0); }
        }
        kslot = (kslot + 1) & 3; vslot = (vslot + 1) & 3; islot = (islot + 1) & 3;
    }
    l += __shfl_xor(l, 32);
    if (hi == 0) wsf[32 + r32] = l;
    ATT_BAR(0);
    LAS bf16* stg = (LAS bf16*)(S + KOFF) + wid * 32 * 64;
#pragma unroll
    for (int r = 0; r < 16; ++r) { const int orow = crow16(r, hi); const float rl = __builtin_amdgcn_rcpf(wsf[32 + orow]);
        stg[orow * 64 + r32] = f2bf(o0[r] * rl); stg[orow * 64 + 32 + r32] = f2bf(o1[r] * rl); }
    LDS_WAIT(); asm volatile("" ::: "memory");
#pragma unroll
    for (int i = 0; i < 4; ++i) { const int idx = i * 64 + lane, row = idx >> 3, ch = idx & 7;
        *(pg8::u32x4*)(Ou + (size_t)(32 * wid + row) * opitch + ch * 8) = *(const LAS pg8::u32x4*)(stg + row * 64 + ch * 8); }
    ATT_BAR(0);
#undef MLA_DMA
#undef MLA_BAR
#undef MLA_ROWMAX
#undef MLA_MOVE
#undef SGB
}

DEVI bool unit_of(int Mrows, int Ncols, int G, int c, int i, int& pm, int& pn) {
    const int nM = Mrows / 256, nN = Ncols / 256, nwg = nM * nN; const long Lq = (long)i * G + c; if (Lq >= nwg) return false;
    int wgid = (int)Lq; { const int q = nwg / 8, r = nwg % 8, xcd = wgid % 8, off = wgid / 8; wgid = (xcd < r ? xcd * (q + 1) : r * (q + 1) + (xcd - r) * q) + off; }
    const int nig = 8 * nN, gid = wgid / nig, fm = gid * 8, gsz = (nM - fm) < 8 ? (nM - fm) : 8;
    pm = fm + ((wgid % nig) % gsz); pn = (wgid % nig) / gsz; return true;
}
DEVI void own_writes_visible() {
    asm volatile("s_waitcnt vmcnt(0)" ::: "memory"); __syncthreads();
    if (threadIdx.x == 0) { __builtin_amdgcn_fence(__ATOMIC_ACQUIRE, "agent"); asm volatile("s_waitcnt vmcnt(0)" ::: "memory"); }
    __syncthreads();
}

__global__ void __launch_bounds__(NTHR, 2) mega(Args args) {
    extern __shared__ __attribute__((aligned(16))) unsigned char lds[];
    const int tid = threadIdx.x, lane = tid & 63, wave = __builtin_amdgcn_readfirstlane(tid >> 6);
    const int G = gridDim.x, bx = blockIdx.x; const int vcu = (G % 8 == 0) ? (bx % 8) * (G / 8) + bx / 8 : bx;
    LAS unsigned char* L = (LAS unsigned char*)lds + PH_BASE;
    volatile LAS unsigned* MISC = (volatile LAS unsigned*)((LAS unsigned char*)lds + LDSCTL_OFF + 320);
    unsigned char* ws = args.ws; gu32* ctl = (gu32*)(ws + WS_CTL);
    if (tid < PH_BASE / 4) ((LAS unsigned*)(lds))[tid] = 0u;
    __syncthreads();
    XcdBarrier bar = xcd_barrier_post((unsigned*)(ctl + CW_BAR) + args.li * XCD_BAR_WORDS, MISC + 8);
    const unsigned mask = args.mask;
#define IN(k) ((mask >> (k)) & 1u)
#ifndef PROBE_ATTVAR
#define PROBE_ATTVAR 0
#endif
#ifndef PROBE_EXPVAR
#define PROBE_EXPVAR 0
#endif
#ifndef PROBE_REP
#define PROBE_REP 0u
#endif
#define NREP(k) (1 + (int)((PROBE_REP >> (k)) & 1u))
#define SEAM(k) do { if ((mask & ((1u << PH_N) - 1u)) >> ((k) + 1)) xcd_barrier(bar); } while (0)
    const float* x = args.in[0]; float* out = args.out;
    bf16 *Wt_in = (bf16*)(ws + WS_WIN), *Wt_qup = (bf16*)(ws + WS_WQUP), *Wt_kv = (bf16*)(ws + WS_WKV), *Wt_mix = (bf16*)(ws + WS_WMIX), *Wt_mq = (bf16*)(ws + WS_WMQ), *Wt_mkv = (bf16*)(ws + WS_WMKV),
         *Wt_mo = (bf16*)(ws + WS_WMO), *Wt_pq = (bf16*)(ws + WS_WPQ), *SK = (bf16*)(ws + WS_SK), *MEMN = (bf16*)(ws + WS_MEMN), *MEMKV = (bf16*)(ws + WS_MEMKV), *PU = (bf16*)(ws + WS_PU), *PV = (bf16*)(ws + WS_PV);
    float *partq = (float*)(ws + WS_PARTQ), *partkv = (float*)(ws + WS_PARTKV), *part1 = (float*)(ws + WS_PART1), *part2 = (float*)(ws + WS_PART2), *trig = (float*)(ws + WS_TRIG);
    bf16 *XN = (bf16*)(ws + WS_R1), *CONCAT = XN, *QM = XN, *H2B = XN;
    bf16 *CQ = (bf16*)(ws + WS_R2 + R2_CQ), *CKV = (bf16*)(ws + WS_R2 + R2_CKV), *U = (bf16*)(ws + WS_R2 + R2_U), *H1B = (bf16*)(ws + WS_R2), *OM = (bf16*)(ws + WS_R3);
    bf16 *QB = (bf16*)(ws + WS_R3 + R3_QB), *KB = (bf16*)(ws + WS_R3 + R3_KB), *VB = (bf16*)(ws + WS_R3 + R3_VB), *QP = (bf16*)(ws + WS_R3);


    if (IN(PH_PRO)) {
        for (int rep_ = 0; rep_ < NREP(PH_PRO); ++rep_) { if (rep_) xcd_barrier(bar);
        LAS float* scr = (LAS float*)(L + wave * 16384);
        const int gw = vcu * NWAVES + wave, NGW = G * NWAVES;
        constexpr int I_IN = (D / 64) * (INP / 32), I_QUP = (256 / 64) * (768 / 32), I_KV = (128 / 64) * (1024 / 32), I_SQ = (D / 64) * (D / 32), I_W2 = (D / 64) * (2048 / 32);
        constexpr int NITEMS = I_IN + I_QUP + I_KV + 2 * I_SQ + 2 * I_W2;
        for (int rp_ = 0; rp_ < 1 + (int)((PROBE_REP >> 20) & 1u); ++rp_)
        for (int it = gw; it < NITEMS; it += NGW) {
            int r = it;
            if (r < I_IN) { p0_transpose_item<1, false>(args.in[3], D, INC, Wt_in, INP, nullptr, scr, r, lane); continue; } r -= I_IN;
            if (r < I_QUP) { p0_transpose_item<0, true>(args.in[5], 256, 768, Wt_qup, 768, args.in[4], scr, r, lane); continue; } r -= I_QUP;
            if (r < I_KV) { p0_transpose_item<2, true>(args.in[7], 128, 1024, Wt_kv, 1024, args.in[6], scr, r, lane); continue; } r -= I_KV;
            if (r < I_SQ) { p0_transpose_item<0, false>(args.in[12], D, D, Wt_mix, D, nullptr, scr, r, lane); continue; } r -= I_SQ;
            if (r < I_SQ) { p0_transpose_item<0, false>(args.in[17], D, D, Wt_mo, D, nullptr, scr, r, lane); continue; } r -= I_SQ;
            if (r < I_W2) { p0_transpose_item<0, false>(args.in[16], D, 2048, Wt_mkv, 2048, nullptr, scr, r, lane); continue; } r -= I_W2;
            p0_transpose_item<0, true>(args.in[19], D, 2048, Wt_pq, 2048, args.in[18], scr, r, lane);
        }
        for (int rp_ = 0; rp_ < 1 + (int)((PROBE_REP >> 21) & 1u); ++rp_)
        for (int m = gw; m < M; m += 4 * NGW) rms_rows4_to_bf16(x, args.in[2], XN, m, NGW, M, lane);
        for (int m = gw; m < BATCH * NMEM; m += NGW) rms_row_to_bf16(args.in[1] + (size_t)m * D, args.in[14], MEMN + (size_t)m * D, lane);
        const size_t gtid = (size_t)vcu * NTHR + tid, gn = (size_t)G * NTHR;
        cvt_stream(args.in[20], SK, (size_t)PH * 2 * PNK * PHALF / 8, nullptr, gtid, gn);
        for (size_t i = gtid; i < (size_t)D * D / 8; i += gn) {
            const float4 a = *(const float4*)(args.in[15] + i * 8), b = *(const float4*)(args.in[15] + i * 8 + 4); const float gk = args.in[13][(i * 8) >> 10];
            pg8::u32x4 o; o.x = pg8::cvt_pk_bf16(a.x * gk, a.y * gk); o.y = pg8::cvt_pk_bf16(a.z * gk, a.w * gk); o.z = pg8::cvt_pk_bf16(b.x * gk, b.y * gk); o.w = pg8::cvt_pk_bf16(b.z * gk, b.w * gk);
            *(pg8::u32x4*)(Wt_mq + i * 8) = o; }
        for (int rp_ = 0; rp_ < 1 + (int)((PROBE_REP >> 22) & 1u); ++rp_) {
        cvt_rows_fp6<true>(args.in[21], (unsigned char*)PU, args.in[18], PU_SCALE, gtid, gn);
        cvt_rows_fp6<false>(args.in[22], (unsigned char*)PV, nullptr, PV_SCALE, gtid, gn); }
        for (size_t i = gtid; i < (size_t)SEQ * 16; i += gn) { float c, s; rope_cs((int)(i >> 4), (int)(i & 15), c, s); *(float2*)(trig + i * 2) = make_float2(c, s); }
        }
        SEAM(PH_PRO);
    }
    if (IN(PH_PROJ)) {
        for (int rep_ = 0; rep_ < NREP(PH_PROJ); ++rep_) { if (rep_) xcd_barrier(bar);
        { pg8::Gemm g{XN, Wt_in, M, INP, D, 0, 0, 0, 0}; pg8::StaticOrder S; S.init(M, INP, G, bx); pg8::EpiProj E{CQ, CKV, KB, U, partq, partkv, trig};
          pg8::gemm_phase<pg8::EpiProj, pg8::StaticOrder, true, true>(L, g, S, E); }
        { pg8::Gemm g{MEMN, Wt_mkv, BATCH * NMEM, 2048, D, 0, 0, 0, 0}; pg8::StaticOrder S; S.init(BATCH * NMEM, 2048, G, (bx + 128) % G); pg8::EpiPlain E{MEMKV, 2048};
          pg8::gemm_phase<pg8::EpiPlain, pg8::StaticOrder, true, true>(L, g, S, E); }
        }
        SEAM(PH_PROJ);
    }
    if (IN(PH_UP)) {
        for (int rep_ = 0; rep_ < NREP(PH_UP); ++rep_) { if (rep_) xcd_barrier(bar);
        if (IN(PHB_UPG)) {
        { pg8::Gemm g{CQ, Wt_qup, M, 768, 256, 0, 0, 0, 0}; pg8::StaticOrder S; S.init(M, 768, G, bx); pg8::EpiQ E{QB, partq, trig, LOG2E * 0.10206207261596577f};
          pg8::gemm_phase<pg8::EpiQ, pg8::StaticOrder, true, true>(L, g, S, E); }
        { pg8::Gemm g{CKV, Wt_kv, M, 1024, 128, 0, 0, 0, 0}; pg8::StaticOrder S; S.init(M, 1024, G, (bx + 192) % G); pg8::EpiKV E{KB, VB, partkv};
          pg8::gemm_phase<pg8::EpiKV, pg8::StaticOrder, true, true>(L, g, S, E); }
        }
        if (IN(PHB_CONV)) { __syncthreads(); for (int c = vcu; c < M / 64; c += G) conv_chunk(c, U, args.in[8], args.in[9], args.in[10], args.in[11], CONCAT, L); }
        }
        SEAM(PH_UP);
    }
    if (IN(PH_ATTN)) {
        for (int rep_ = 0; rep_ < NREP(PH_ATTN); ++rep_) { if (rep_) xcd_barrier(bar);
        for (int u = vcu; u < 512; u += G) { const int bh = (u & 255) >> 4, sidx = u & 15, qb = u < 256 ? 31 - sidx : sidx, b = bh >> 3, h = bh & 7;
            const size_t r0 = (size_t)b * SEQ;
            if (NREP(PH_ATTN) > 1 && rep_ == 0) attn_unit<96, 64, 1, 4, 3, true, false, PROBE_ATTVAR>(L, QB + (r0 + qb * 256) * 768 + h * 96, 768, KB + r0 * 768 + h * 96, 768, VB + r0 * 512 + h * 64, 512, CONCAT + (r0 + qb * 256) * D + h * 64, D, 4 * qb + 4, 4 * qb);
            else attn_mla_unit(L, QB + (r0 + qb * 256) * 768 + h * 96, KB + r0 * 768 + h * 96, VB + r0 * 512 + h * 64, CONCAT + (r0 + qb * 256) * D + h * 64, 4 * qb + 4, 4 * qb); }
        }
        { bf16* KQT = (bf16*)(ws + WS_KQT); bf16* VOT = (bf16*)(ws + WS_VOT);
#pragma unroll 1
          for (int bh = 0; bh < BATCH * XH; ++bh) { const int b = bh >> 2, h = bh & 3;
            { pg8::Gemm g{MEMKV + (size_t)b * NMEM * 2048 + h * XD, Wt_mq + h * XD, NMEM, D, XD, 2048, D, 0, 0}; pg8::StaticOrder S; S.init(NMEM, D, G, (bx + 8 * bh) % G);
              pg8::EpiPlain E{KQT + (size_t)b * D * D + (size_t)h * XD * D, D}; pg8::gemm_phase<pg8::EpiPlain, pg8::StaticOrder, true, true>(L, g, S, E); }
            { pg8::Gemm g{Wt_mo + h * XD, MEMKV + (size_t)b * NMEM * 2048 + 1024 + h * XD, D, NMEM, XD, D, 2048, 0, 0}; pg8::StaticOrder S; S.init(D, NMEM, G, (bx + 8 * bh + 4) % G);
              pg8::EpiPlain E{VOT + (size_t)b * D * D + h * XD, D}; pg8::gemm_phase<pg8::EpiPlain, pg8::StaticOrder, true, true>(L, g, S, E); } } }
        SEAM(PH_ATTN);
    }
    if (IN(PH_MIX)) {
        for (int rep_ = 0; rep_ < NREP(PH_MIX); ++rep_) { if (rep_) xcd_barrier(bar);
        pg8::Gemm g{CONCAT, Wt_mix, M, D, D, 0, 0, 0, 0}; pg8::StaticOrder S; S.init(M, D, G, bx); pg8::EpiRes<false> E{x, nullptr, H1B, part1};
        pg8::gemm_phase<pg8::EpiRes<false>, pg8::StaticOrder, true, true>(L, g, S, E);
        }
        SEAM(PH_MIX);
    }
    if (IN(PH_MEMQ)) {
        for (int rep_ = 0; rep_ < NREP(PH_MEMQ); ++rep_) { if (rep_) xcd_barrier(bar);
        pg8::Gemm g{H1B, (const bf16*)(ws + WS_KQT), M, D, D, 0, 0, SEQ / 256, (size_t)D * D * 2}; pg8::StaticOrder S; S.init(M, D, G, bx);
        pg8::EpiSoftmaxP E{OM, D, part1, LOG2E / 16.0f, (LAS float*)(L + 131072)};
        pg8::gemm_phase<pg8::EpiSoftmaxP, pg8::StaticOrder, true, true>(L, g, S, E);
        }
        SEAM(PH_MEMQ);
    }
    if (IN(PH_MEMO)) {
        pg8::Gemm g{OM, (const bf16*)(ws + WS_VOT), M, D, D, 0, 0, SEQ / 256, (size_t)D * D * 2};   pg8::StaticOrder S; S.init(M, D, G, bx); pg8::EpiRes<true> E{nullptr, H1B, H2B, part2};
        pg8::gemm_phase<pg8::EpiRes<true>, pg8::StaticOrder, true, true>(L, g, S, E);
        SEAM(PH_MEMO);
    }
    if (IN(PH_PQ)) {
        for (int rep_ = 0; rep_ < NREP(PH_PQ); ++rep_) { if (rep_) xcd_barrier(bar);
        pg8::Gemm g{H2B, Wt_pq, M, 2048, D, 0, 0, 0, 0}; pg8::StaticOrder S; S.init(M, 2048, G, bx); pg8::EpiScaled E{QP, 2048, part2, 1.0f};
        pg8::gemm_phase<pg8::EpiScaled, pg8::StaticOrder, true, true>(L, g, S, E);
        own_writes_visible();
        int* EIDX = (int*)(ws + WS_R2 + R2_EIDX); float* EGATE = (float*)(ws + WS_R2 + R2_EGATE);
        LAS unsigned* scr = (LAS unsigned*)(L + 65536 + wave * 64 * 9 * 4);
        int hl = -1, upm, upn;
        for (int i = 0; unit_of(M, 2048, G, bx, i, upm, upn); ++i) { const int tb = upm, h = upn;
            if (h != hl) {
                __syncthreads();
                for (int pc = tid; pc < 4096; pc += NTHR) { const int p = pc >> 11, n = (pc >> 4) & 127, c = pc & 15;
                    *(LAS pg8::u32x4*)(L + p * 32768 + c * 2048 + n * 16) = *(const pg8::u32x4*)(SK + ((size_t)(h * 2 + p) * 128 + n) * 128 + c * 8); }
                __syncthreads(); hl = h; }
            const int token = tb * 256 + wave * 32 + (lane & 31);
            topk_wave(QP + (size_t)token * 2048 + h * 256, L, scr, EIDX + (size_t)token * 128 + h * 16, EGATE + (size_t)token * 128 + h * 16, lane); }
        __syncthreads();
        }
        SEAM(PH_PQ);
    }
    if (IN(PH_EXP)) {
        const int* EIDX = (const int*)(ws + WS_R2 + R2_EIDX); const float* EGATE = (const float*)(ws + WS_R2 + R2_EGATE);
#ifndef EXP_PREWARM
#define EXP_PREWARM 0
#endif
        if (EXP_PREWARM) {
            const pg8::u32x4* tb = (const pg8::u32x4*)PU; pg8::u32x4 x = {0u, 0u, 0u, 0u};
            for (size_t i = (size_t)vcu * NTHR + tid; i < (size_t)2 * PE * D / 16; i += (size_t)G * NTHR) { const pg8::u32x4 v = __builtin_nontemporal_load(tb + i); x ^= v; }
            if ((x[0] ^ x[1] ^ x[2] ^ x[3]) == 0x9e3779b9u && tid == 999) out[0] = 0.f;
        }
        for (int rep_ = NREP(PH_EXP) - 1; rep_ >= 0; --rep_) { float* dst = rep_ ? (float*)(ws + WS_R3) : out;
            if (rep_) { if (PROBE_EXPVAR != 5 || wave < 4) experts_wave<PROBE_EXPVAR == 5 ? 0 : PROBE_EXPVAR>(L + wave * EXP_LDS_WAVE, vcu * NWAVES + wave, G * NWAVES, H2B, part2, (const unsigned char*)PU, (const unsigned char*)PV, EIDX, EGATE, args.in[23], dst, lane); } else
            experts_wave<0>(L + wave * EXP_LDS_WAVE, vcu * NWAVES + wave, G * NWAVES, H2B, part2, (const unsigned char*)PU, (const unsigned char*)PV, EIDX, EGATE, args.in[23], dst, lane);
            if (rep_) xcd_barrier(bar); }
    }
#undef IN
#undef SEAM
}

#define FAST_MASK ((1u << PH_PRO) | (1u << PH_PROJ) | (1u << PH_UP) | (1u << PHB_UPG) | (1u << PHB_CONV) | (1u << PH_ATTN) | (1u << PH_MIX) | (1u << PH_MEMQ) | (1u << PH_MEMO) | (1u << PH_PQ) | (1u << PH_EXP))
extern "C" void kernel_launch(void* const* d_in, const int* in_sizes, int n_in, void* d_out, int out_size, void* d_ws, size_t ws_size, hipStream_t stream) {
    if (n_in != 24 || out_size != M * D || ws_size < WS_END) { fprintf(stderr, "kernel_launch: unexpected problem (n_in %d out %d ws %zu)\n", n_in, out_size, ws_size); return; }
    static int grid = 0;
    if (grid == 0) {
        int dev = 0, cus = 0, per_cu = 0;
        if (hipGetDevice(&dev) != hipSuccess || hipDeviceGetAttribute(&cus, hipDeviceAttributeMultiprocessorCount, dev) != hipSuccess) { grid = -1; return; }
        if (hipFuncSetAttribute((const void*)mega, hipFuncAttributeMaxDynamicSharedMemorySize, LDS_BYTES) != hipSuccess) { fprintf(stderr, "kernel_launch: hipFuncSetAttribute failed\n"); grid = -1; return; }
        if (hipOccupancyMaxActiveBlocksPerMultiprocessor(&per_cu, (const void*)mega, NTHR, LDS_BYTES) != hipSuccess || per_cu < 1) { fprintf(stderr, "kernel_launch: occupancy query says %d blocks per CU\n", per_cu); grid = -1; (void)hipGetLastError(); return; }
        grid = cus;
    }
    if (grid < 0) return;
    (void)hipMemsetAsync((char*)d_ws + WS_CTL, 0, CTL_ZERO_BYTES, stream);
    Args a{}; for (int i = 0; i < 24; ++i) a.in[i] = (const float*)d_in[i]; a.out = (float*)d_out; a.ws = (unsigned char*)d_ws; a.mask = FAST_MASK; a.li = 0;
    hipLaunchKernelGGL(mega, dim3(grid), dim3(NTHR), LDS_BYTES, stream, a);
}
```

```cpp
#include <hip/hip_runtime.h>
#include <cstdio>
#include <cstdint>

typedef unsigned short bf16;
#define DEVI __device__ __forceinline__

constexpr int D = 1024, BATCH = 2, SEQ = 8192, M = BATCH * SEQ;
constexpr int NMEM = 256;
constexpr int MH = 8, QRANK = 256, KVRANK = 128, NOPE = 64, ROPE = 32, VD = 64, QK = NOPE + ROPE;
constexpr int CW = 512, CK = 31;
constexpr int INC = QRANK + KVRANK + ROPE + 2 * CW;
constexpr int INP = 1536;
constexpr int XH = 4, XD = 256;
constexpr int PH = 8, PNK = 128, PHALF = 128, PTOP = 16, PE = PNK * PNK;
constexpr float EPS = 1e-6f;
constexpr float LOG2E = 1.4426950408889634f;
constexpr float PU_SCALE = 64.0f, PV_SCALE = 4.0f;

constexpr size_t MiB = 1u << 20;
constexpr size_t WS_CTL = 0;
constexpr size_t WS_WIN = 1 * MiB;
constexpr size_t WS_WQUP = 4 * MiB;
constexpr size_t WS_WKV = 5 * MiB;
constexpr size_t WS_WMIX = 6 * MiB;
constexpr size_t WS_WMQ = 8 * MiB;
constexpr size_t WS_WMKV = 10 * MiB;
constexpr size_t WS_WMO = 14 * MiB;
constexpr size_t WS_WPQ = 16 * MiB;
constexpr size_t WS_SK = 20 * MiB;
constexpr size_t WS_MEMN = 21 * MiB;
constexpr size_t WS_MEMKV = 22 * MiB;
constexpr size_t WS_PARTQ = 24 * MiB;
constexpr size_t WS_PARTKV = 24 * MiB + 512 * 1024;
constexpr size_t WS_PART1 = 25 * MiB;
constexpr size_t WS_PART2 = 26 * MiB;
constexpr size_t WS_PU = 28 * MiB;
constexpr size_t WS_PV = 60 * MiB;
constexpr size_t WS_R1 = 92 * MiB;
constexpr size_t WS_R2 = 124 * MiB;
constexpr size_t WS_R3 = 156 * MiB;
constexpr size_t WS_KQT = 220 * MiB;
constexpr size_t WS_VOT = 224 * MiB;
constexpr size_t WS_END = 228 * MiB;
constexpr size_t R2_CQ = 0, R2_CKV = 8 * MiB, R2_U = 12 * MiB;
constexpr size_t R2_EIDX = 0, R2_EGATE = 8 * MiB;
constexpr size_t R3_QB = 0, R3_KB = 24 * MiB, R3_VB = 48 * MiB;

DEVI bf16 f2bf(float f) { unsigned u = __builtin_bit_cast(unsigned, f); return (bf16)((u + 0x7fffu + ((u >> 16) & 1u)) >> 16); }
DEVI float bf2f(bf16 b) { return __builtin_bit_cast(float, (unsigned)b << 16); }
DEVI float dotbf(const bf16* a, const bf16* b, int K) {
    float s = 0.f;
    for (int k = 0; k < K; k += 8) {
        uint4 x = *(const uint4*)(a + k), y = *(const uint4*)(b + k);
        const unsigned xs[4] = {x.x, x.y, x.z, x.w}, ys[4] = {y.x, y.y, y.z, y.w};
#pragma unroll
        for (int i = 0; i < 4; ++i) {
            s += __builtin_bit_cast(float, xs[i] << 16) * __builtin_bit_cast(float, ys[i] << 16);
            s += __builtin_bit_cast(float, xs[i] & 0xffff0000u) * __builtin_bit_cast(float, ys[i] & 0xffff0000u);
        }
    }
    return s;
}
DEVI float wave_sum(float v) {
#pragma unroll
    for (int o = 1; o < 64; o <<= 1) v += __shfl_xor(v, o);
    return v;
}
DEVI float wave_max(float v) {
#pragma unroll
    for (int o = 1; o < 64; o <<= 1) v = fmaxf(v, __shfl_xor(v, o));
    return v;
}
DEVI void rope_cs(int pos, int i, float& c, float& s) {
    const float inv = exp2f(-(float)i * (13.287712379549449f / 16.0f));
    const float ang = (float)pos * inv;
    const double a = (double)ang; const double k = rint(a * 0.15915494309189535); const float r = (float)(a - k * 6.283185307179586);
    s = sinf(r); c = cosf(r);
}
DEVI int win_src(int r) {
    if (r < 416) return r;
    if (r < 512) return -1;
    const int t = (r - 512) >> 8, w = (r - 512) & 255, bj = w >> 7, j = w & 127, ch = 128 * t + j;
    return 416 + (bj ? CW : 0) + ch;
}
DEVI int wkv_src(int r) { return r < 512 ? (r >> 6) * 128 + (r & 63) : ((r - 512) >> 6) * 128 + 64 + ((r - 512) & 63); }

namespace pg8 {
#define PG8_LAS __attribute__((address_space(3)))
typedef unsigned short bf16_t;
typedef short bf16x8 __attribute__((ext_vector_type(8)));
typedef float f32x4 __attribute__((ext_vector_type(4)));
typedef unsigned u32x4 __attribute__((ext_vector_type(4)));
constexpr int BM = 256, BK = 64, HALF = 128, HTB = HALF * BK * 2  , STAGE_BYTES = 8 * HTB, NXCD = 8, WGM = 8;

__host__ __device__ __forceinline__ int lds_byte(int r, int c) { const int st = (r >> 4) * 2 + (c >> 5), rr = r & 15, cc = c & 31, ob = rr * 64 + cc * 2; return st * 1024 + (ob ^ (((ob >> 9) & 1) << 5)); }
__host__ __device__ __forceinline__ void stage_rc(int b, int& R, int& C) { const int st = b / 1024, sb = b % 1024, swz = sb ^ (((sb >> 9) & 1) << 5); R = (st >> 1) * 16 + swz / 64; C = (st & 1) * 32 + (swz % 64) / 2; }
__host__ __device__ __forceinline__ int perm32(int rho) { const int n = rho >> 4, i = rho & 15; return 8 * (i >> 2) + 4 * n + (i & 3); }

struct Unit { int pm, pn; };
struct Gemm { const bf16_t* A; const bf16_t* Bt; int M, N, K; int lda, ldb; int mb; size_t bstride; };

struct StaticOrder {
    int nM, nN, nwg, G, c;
    __host__ __device__ void init(int M, int N, int G_, int c_) { nM = M / BM; nN = N / BM; nwg = nM * nN; G = G_; c = c_; }
    __host__ __device__ bool next(int i, Unit& u) const {
        const long L = (long)i * G + c; if (L >= nwg) return false;
        int wgid = (int)L; { const int q = nwg / NXCD, r = nwg % NXCD, xcd = wgid % NXCD, off = wgid / NXCD; wgid = (xcd < r ? xcd * (q + 1) : r * (q + 1) + (xcd - r) * q) + off; }
        const int nig = WGM * nN, gid = wgid / nig, fm = gid * WGM, gsz = (nM - fm) < WGM ? (nM - fm) : WGM;
        u.pm = fm + ((wgid % nig) % gsz); u.pn = (wgid % nig) / gsz; return true;
    }
    __device__ __forceinline__ void a_ready(const Unit&) const {}
    __device__ __forceinline__ void done(const Unit&) const {}
};


typedef float f32x2 __attribute__((ext_vector_type(2)));
typedef unsigned u32x2 __attribute__((ext_vector_type(2)));
__device__ __forceinline__ unsigned cvt_pk_bf16(float lo, float hi) { unsigned r; asm volatile("v_cvt_pk_bf16_f32 %0, %1, %2" : "=v"(r) : "v"(lo), "v"(hi)); return r; }
__device__ __forceinline__ void st_bf4(bf16_t* p, f32x4 v) { u32x2 w; w.x = cvt_pk_bf16(v[0], v[1]); w.y = cvt_pk_bf16(v[2], v[3]); *(u32x2*)p = w; }
__device__ __forceinline__ float sq4(f32x4 v) { return (v[0] * v[0] + v[1] * v[1]) + (v[2] * v[2] + v[3] * v[3]); }
__device__ __forceinline__ float red_fq(float s) { s += __shfl_xor(s, 16); s += __shfl_xor(s, 32); return s; }

struct EpiProj {
    static constexpr bool PERM = false, AFTER_DRAIN = false;
    bf16_t *CQ, *CKV, *KB, *U; float *partq, *partkv; const float* trig;
    __device__ __forceinline__ void operator()(const f32x4 (&acc)[2][2][4][2], const Unit& u, int wr, int wc, int fr, int fq) const {
        const int row0 = u.pm * BM + wr * 64 + fr;
        if (u.pn == 0) {
#pragma unroll
            for (int ai = 0; ai < 2; ++ai)
#pragma unroll
                for (int m = 0; m < 4; ++m) { const int row = row0 + ai * HALF + m * 16; float s = 0.f;
#pragma unroll
                    for (int bj = 0; bj < 2; ++bj)
#pragma unroll
                        for (int n = 0; n < 2; ++n) { const f32x4 v = acc[ai][bj][m][n]; s += sq4(v); st_bf4(CQ + (size_t)row * 256 + bj * HALF + wc * 32 + n * 16 + fq * 4, v); }
                    s = red_fq(s); if (fq == 0) partq[(size_t)row * 4 + wc] = s; }
        } else if (u.pn == 1) {
            f32x4 tc0 = {0.f, 0.f, 0.f, 0.f}, tc1 = tc0, tn0 = tc0, tn1 = tc0;
            if (wc == 0) { const float* tp = trig + ((size_t)(row0 % SEQ) * 16 + fq * 4) * 2; tc0 = *(const f32x4*)tp; tc1 = *(const f32x4*)(tp + 4); }
#pragma unroll
            for (int i8 = 0; i8 < 8; ++i8) { const int ai = i8 >> 2, m = i8 & 3; const int row = row0 + ai * HALF + m * 16; float s = 0.f;
                if (wc == 0 && i8 < 7) { const int rown = row0 + ((i8 + 1) >> 2) * HALF + ((i8 + 1) & 3) * 16; const float* tp = trig + ((size_t)(rown % SEQ) * 16 + fq * 4) * 2; tn0 = *(const f32x4*)tp; tn1 = *(const f32x4*)(tp + 4); }
#pragma unroll
                for (int n = 0; n < 2; ++n) { const f32x4 v = acc[ai][0][m][n]; s += sq4(v); st_bf4(CKV + (size_t)row * 128 + wc * 32 + n * 16 + fq * 4, v); }
                s = red_fq(s); if (fq == 0) partkv[(size_t)row * 4 + wc] = s;
                if (wc == 0) { const f32x4 x1 = acc[ai][1][m][0], x2 = acc[ai][1][m][1]; const f32x4 t0 = tc0, t1 = tc1;
                    f32x4 o1, o2; o1[0] = x1[0] * t0[0] - x2[0] * t0[1]; o2[0] = x1[0] * t0[1] + x2[0] * t0[0]; o1[1] = x1[1] * t0[2] - x2[1] * t0[3]; o2[1] = x1[1] * t0[3] + x2[1] * t0[2];
                    o1[2] = x1[2] * t1[0] - x2[2] * t1[1]; o2[2] = x1[2] * t1[1] + x2[2] * t1[0]; o1[3] = x1[3] * t1[2] - x2[3] * t1[3]; o2[3] = x1[3] * t1[3] + x2[3] * t1[2];
                    u32x2 w1, w2; w1.x = cvt_pk_bf16(o1[0], o1[1]); w1.y = cvt_pk_bf16(o1[2], o1[3]); w2.x = cvt_pk_bf16(o2[0], o2[1]); w2.y = cvt_pk_bf16(o2[2], o2[3]);
#pragma unroll
                    for (int h = 0; h < 8; ++h) { *(u32x2*)(KB + (size_t)row * 768 + h * 96 + 64 + fq * 4) = w1; *(u32x2*)(KB + (size_t)row * 768 + h * 96 + 80 + fq * 4) = w2; } }
                tc0 = tn0; tc1 = tn1; asm volatile("" ::: "memory"); }
        } else {
            const int t = u.pn - 2;
#pragma unroll
            for (int ai = 0; ai < 2; ++ai)
#pragma unroll
                for (int m = 0; m < 4; ++m) { const int row = row0 + ai * HALF + m * 16;
#pragma unroll
                    for (int n = 0; n < 2; ++n) { const f32x4 val = acc[ai][0][m][n], gate = acc[ai][1][m][n]; f32x4 o;
#pragma unroll
                        for (int i = 0; i < 4; ++i) o[i] = val[i] * __builtin_amdgcn_rcpf(1.f + __expf(-gate[i]));
                        st_bf4(U + (size_t)row * 512 + t * 128 + wc * 32 + n * 16 + fq * 4, o); } }
        }
    }
};
struct EpiQ {
    static constexpr bool PERM = false, AFTER_DRAIN = false;
    bf16_t* QB; const float* partq; const float* trig; float c2;
    __device__ __forceinline__ void operator()(const f32x4 (&acc)[2][2][4][2], const Unit& u, int wr, int wc, int fr, int fq) const {
        const int row0 = u.pm * BM + wr * 64 + fr;
        const bool rope = ((u.pn * 8 + wc) % 3 == 2) || ((u.pn * 8 + 4 + wc) % 3 == 2);
        f32x4 ppc = *(const f32x4*)(partq + (size_t)row0 * 4), ppn = ppc;
        f32x4 tc0 = {0.f, 0.f, 0.f, 0.f}, tc1 = tc0, tn0 = tc0, tn1 = tc0;
        if (rope) { const float* tp = trig + ((size_t)(row0 % SEQ) * 16 + fq * 4) * 2; tc0 = *(const f32x4*)tp; tc1 = *(const f32x4*)(tp + 4); }
#pragma unroll
        for (int i8 = 0; i8 < 8; ++i8) { const int ai = i8 >> 2, m = i8 & 3; const int row = row0 + ai * HALF + m * 16;
            if (i8 < 7) { const int rown = row0 + ((i8 + 1) >> 2) * HALF + ((i8 + 1) & 3) * 16; ppn = *(const f32x4*)(partq + (size_t)rown * 4);
                if (rope) { const float* tp = trig + ((size_t)(rown % SEQ) * 16 + fq * 4) * 2; tn0 = *(const f32x4*)tp; tn1 = *(const f32x4*)(tp + 4); } }
            const float rs = rsqrtf(((ppc[0] + ppc[1]) + (ppc[2] + ppc[3])) * (1.f / 256.f) + EPS) * c2;
#pragma unroll
            for (int bj = 0; bj < 2; ++bj) { const int g = u.pn * 8 + bj * 4 + wc; bf16_t* dst = QB + (size_t)row * 768 + g * 32 + fq * 4;
                if (g % 3 != 2) { st_bf4(dst, acc[ai][bj][m][0] * rs); st_bf4(dst + 16, acc[ai][bj][m][1] * rs); }
                else { const f32x4 x1 = acc[ai][bj][m][0] * rs, x2 = acc[ai][bj][m][1] * rs; const f32x4 t0 = tc0, t1 = tc1;
                    f32x4 o1, o2; o1[0] = x1[0] * t0[0] - x2[0] * t0[1]; o2[0] = x1[0] * t0[1] + x2[0] * t0[0]; o1[1] = x1[1] * t0[2] - x2[1] * t0[3]; o2[1] = x1[1] * t0[3] + x2[1] * t0[2];
                    o1[2] = x1[2] * t1[0] - x2[2] * t1[1]; o2[2] = x1[2] * t1[1] + x2[2] * t1[0]; o1[3] = x1[3] * t1[2] - x2[3] * t1[3]; o2[3] = x1[3] * t1[3] + x2[3] * t1[2];
                    st_bf4(dst, o1); st_bf4(dst + 16, o2); } }
            ppc = ppn; tc0 = tn0; tc1 = tn1; asm volatile("" ::: "memory"); }
    }
};
struct EpiKV {
    static constexpr bool PERM = false, AFTER_DRAIN = false;
    bf16_t *KB, *VB; const float* partkv;
    __device__ __forceinline__ void operator()(const f32x4 (&acc)[2][2][4][2], const Unit& u, int wr, int wc, int fr, int fq) const {
        const int row0 = u.pm * BM + wr * 64 + fr;
        f32x4 ppc = *(const f32x4*)(partkv + (size_t)row0 * 4), ppn = ppc;
#pragma unroll
        for (int i8 = 0; i8 < 8; ++i8) { const int ai = i8 >> 2, m = i8 & 3; const int row = row0 + ai * HALF + m * 16;
            if (i8 < 7) { const int rown = row0 + ((i8 + 1) >> 2) * HALF + ((i8 + 1) & 3) * 16; ppn = *(const f32x4*)(partkv + (size_t)rown * 4); }
            const float rs = rsqrtf(((ppc[0] + ppc[1]) + (ppc[2] + ppc[3])) * (1.f / 128.f) + EPS);
#pragma unroll
            for (int bj = 0; bj < 2; ++bj)
#pragma unroll
                for (int n = 0; n < 2; ++n) { const int c = u.pn * BM + bj * HALF + wc * 32 + n * 16 + fq * 4; const f32x4 v = acc[ai][bj][m][n] * rs;
                    if (u.pn < 2) st_bf4(KB + (size_t)row * 768 + (c >> 6) * 96 + (c & 63), v); else st_bf4(VB + (size_t)row * 512 + (c - 512), v); }
            ppc = ppn; asm volatile("" ::: "memory"); }
    }
};
template <bool BF16RES> struct EpiRes {
    static constexpr bool PERM = false, AFTER_DRAIN = false;
    const float* res; const bf16_t* resb; bf16_t* outb; float* part;
    __device__ __forceinline__ f32x4 ldres(size_t off) const {
        if (BF16RES) { const u32x2 rb = *(const u32x2*)(resb + off); f32x4 r; r[0] = __builtin_bit_cast(float, rb.x << 16); r[1] = __builtin_bit_cast(float, rb.x & 0xffff0000u); r[2] = __builtin_bit_cast(float, rb.y << 16); r[3] = __builtin_bit_cast(float, rb.y & 0xffff0000u); return r; }
        return *(const f32x4*)(res + off); }
    __device__ __forceinline__ void operator()(const f32x4 (&acc)[2][2][4][2], const Unit& u, int wr, int wc, int fr, int fq) const {
        const int row0 = u.pm * BM + wr * 64 + fr; const int cb = u.pn * BM + wc * 32 + fq * 4;
        f32x4 rc[4], rn[4];
#pragma unroll
        for (int j = 0; j < 4; ++j) { rc[j] = ldres((size_t)row0 * 1024 + cb + (j >> 1) * HALF + (j & 1) * 16); rn[j] = rc[j]; }
#pragma unroll
        for (int i8 = 0; i8 < 8; ++i8) { const int ai = i8 >> 2, m = i8 & 3; const int row = row0 + ai * HALF + m * 16; float s = 0.f;
            if (i8 < 7) { const int rown = row0 + ((i8 + 1) >> 2) * HALF + ((i8 + 1) & 3) * 16;
#pragma unroll
                for (int j = 0; j < 4; ++j) rn[j] = ldres((size_t)rown * 1024 + cb + (j >> 1) * HALF + (j & 1) * 16); }
#pragma unroll
            for (int bj = 0; bj < 2; ++bj)
#pragma unroll
                for (int n = 0; n < 2; ++n) { const size_t off = (size_t)row * 1024 + cb + bj * HALF + n * 16;
                    const f32x4 v = acc[ai][bj][m][n] + rc[bj * 2 + n]; st_bf4(outb + off, v); s += sq4(v); }
            s = red_fq(s); if (fq == 0) part[(size_t)row * 16 + u.pn * 4 + wc] = s;
#pragma unroll
            for (int j = 0; j < 4; ++j) rc[j] = rn[j];
            asm volatile("" ::: "memory"); }
    }
};
struct EpiScaled {
    static constexpr bool PERM = false, AFTER_DRAIN = false;
    bf16_t* out; int ldc; const float* part; float mul;
    __device__ __forceinline__ void operator()(const f32x4 (&acc)[2][2][4][2], const Unit& u, int wr, int wc, int fr, int fq) const {
        const int row0 = u.pm * BM + wr * 64 + fr;
        float rs8[8];
#pragma unroll
        for (int hb = 0; hb < 2; ++hb) { f32x4 q[4][4];
#pragma unroll
            for (int k = 0; k < 4; ++k) { const int row = row0 + hb * HALF + k * 16; const f32x4* pp = (const f32x4*)(part + (size_t)row * 16);
#pragma unroll
                for (int j = 0; j < 4; ++j) q[k][j] = pp[j]; }
#pragma unroll
            for (int k = 0; k < 4; ++k) { const f32x4 a = q[k][0], b = q[k][1], c = q[k][2], d = q[k][3];
                const float ss = (((a[0] + a[1]) + (a[2] + a[3])) + ((b[0] + b[1]) + (b[2] + b[3]))) + (((c[0] + c[1]) + (c[2] + c[3])) + ((d[0] + d[1]) + (d[2] + d[3])));
                rs8[hb * 4 + k] = rsqrtf(ss * (1.f / 1024.f) + EPS) * mul; } }
#pragma unroll
        for (int i8 = 0; i8 < 8; ++i8) { const int ai = i8 >> 2, m = i8 & 3; const int row = row0 + ai * HALF + m * 16; const float rs = rs8[i8];
#pragma unroll
            for (int bj = 0; bj < 2; ++bj)
#pragma unroll
                for (int n = 0; n < 2; ++n) st_bf4(out + (size_t)row * ldc + u.pn * BM + bj * HALF + wc * 32 + n * 16 + fq * 4, acc[ai][bj][m][n] * rs);
            asm volatile("" ::: "memory"); }
    }
};
struct EpiSoftmaxP {
    static constexpr bool PERM = false, AFTER_DRAIN = false;
    bf16_t* out; int ldc; const float* part; float mul; PG8_LAS float* scr;
    __device__ __forceinline__ float rscale(int row) const { const f32x4* pp = (const f32x4*)(part + (size_t)row * 16); const f32x4 a = pp[0], b = pp[1], c = pp[2], d = pp[3];
        const float ss = (((a[0] + a[1]) + (a[2] + a[3])) + ((b[0] + b[1]) + (b[2] + b[3]))) + (((c[0] + c[1]) + (c[2] + c[3])) + ((d[0] + d[1]) + (d[2] + d[3]))); return rsqrtf(ss * (1.f / 1024.f) + EPS) * mul; }
    __device__ __forceinline__ void operator()(const f32x4 (&acc)[2][2][4][2], const Unit& u, int wr, int wc, int fr, int fq) const {
        PG8_LAS float* P1 = scr; PG8_LAS float* P2 = scr + 1024; float rs8[8];
#define EPS_BAR() do { asm volatile("s_waitcnt lgkmcnt(0)" ::: "memory"); __builtin_amdgcn_s_barrier(); asm volatile("" ::: "memory"); } while (0)
#pragma unroll
        for (int ai = 0; ai < 2; ++ai)
#pragma unroll
            for (int m = 0; m < 4; ++m) { float mx = -3.0e38f;
#pragma unroll
                for (int bj = 0; bj < 2; ++bj)
#pragma unroll
                    for (int n = 0; n < 2; ++n) { const f32x4 v = acc[ai][bj][m][n]; mx = fmaxf(mx, fmaxf(fmaxf(v[0], v[1]), fmaxf(v[2], v[3]))); }
                mx = fmaxf(mx, __shfl_xor(mx, 16)); mx = fmaxf(mx, __shfl_xor(mx, 32));
                if (fq == 0) P1[(ai * HALF + wr * 64 + m * 16 + fr) * 4 + wc] = mx; }
        EPS_BAR();
#pragma unroll
        for (int ai = 0; ai < 2; ++ai)
#pragma unroll
            for (int m = 0; m < 4; ++m) { const int rl = ai * HALF + wr * 64 + m * 16 + fr; const f32x4 q = *(const PG8_LAS f32x4*)(P1 + rl * 4);
                const float mx = fmaxf(fmaxf(q[0], q[1]), fmaxf(q[2], q[3])), rs = rscale(u.pm * BM + rl); float sm = 0.f; rs8[ai * 4 + m] = rs;
#pragma unroll
                for (int bj = 0; bj < 2; ++bj)
#pragma unroll
                    for (int n = 0; n < 2; ++n) { const f32x4 v = acc[ai][bj][m][n];
#pragma unroll
                        for (int i = 0; i < 4; ++i) sm += __builtin_amdgcn_exp2f((v[i] - mx) * rs); }
                sm += __shfl_xor(sm, 16); sm += __shfl_xor(sm, 32);
                if (fq == 0) P2[rl * 4 + wc] = sm; asm volatile("" ::: "memory"); }
        EPS_BAR();
#pragma unroll
        for (int ai = 0; ai < 2; ++ai)
#pragma unroll
            for (int m = 0; m < 4; ++m) { const int rl = ai * HALF + wr * 64 + m * 16 + fr; const f32x4 q = *(const PG8_LAS f32x4*)(P1 + rl * 4), w = *(const PG8_LAS f32x4*)(P2 + rl * 4);
                const float mx = fmaxf(fmaxf(q[0], q[1]), fmaxf(q[2], q[3])), rs = rs8[ai * 4 + m], inv = 1.0f / ((w[0] + w[1]) + (w[2] + w[3]));
#pragma unroll
                for (int bj = 0; bj < 2; ++bj)
#pragma unroll
                    for (int n = 0; n < 2; ++n) { const f32x4 v = acc[ai][bj][m][n]; f32x4 o;
#pragma unroll
                        for (int i = 0; i < 4; ++i) o[i] = __builtin_amdgcn_exp2f((v[i] - mx) * rs) * inv;
                        st_bf4(out + (size_t)(u.pm * BM + rl) * ldc + u.pn * BM + bj * HALF + wc * 32 + n * 16 + fq * 4, o); }
                asm volatile("" ::: "memory"); }
        EPS_BAR();
#undef EPS_BAR
    }
};
struct EpiPlain {
    static constexpr bool PERM = false, AFTER_DRAIN = false;
    bf16_t* out; int ldc;
    __device__ __forceinline__ void operator()(const f32x4 (&acc)[2][2][4][2], const Unit& u, int wr, int wc, int fr, int fq) const {
        const int row0 = u.pm * BM + wr * 64 + fr;
#pragma unroll
        for (int ai = 0; ai < 2; ++ai)
#pragma unroll
            for (int m = 0; m < 4; ++m) { const int row = row0 + ai * HALF + m * 16;
#pragma unroll
                for (int bj = 0; bj < 2; ++bj)
#pragma unroll
                    for (int n = 0; n < 2; ++n) st_bf4(out + (size_t)row * ldc + u.pn * BM + bj * HALF + wc * 32 + n * 16 + fq * 4, acc[ai][bj][m][n]); }
    }
};
template <class Epi, class Sched, bool ALIGN_EPI = false, bool SP2 = false>
__device__ __forceinline__ void gemm_phase(PG8_LAS unsigned char* lds, const Gemm g, const Sched& S, const Epi& E) {
    int tid_ = threadIdx.x; asm volatile("" : "+v"(tid_));
    const int tid = tid_, wid = __builtin_amdgcn_readfirstlane(tid >> 6), lane = tid & 63, wr = wid >> 2, wc = wid & 3, fr = lane & 15, fq = lane >> 4;
    const int K = g.K, nt = K / BK, lda = g.lda ? g.lda : K, ldb = g.ldb ? g.ldb : K;
#define PG8_BOFF(pm_) (g.mb ? (size_t)((pm_) / g.mb) * g.bstride : (size_t)0)
    unsigned voffA[2], voffB[2];
#pragma unroll
    for (int i = 0; i < 2; ++i) { int R, C; stage_rc(tid * 16 + i * 8192, R, C); const int Rb = Epi::PERM ? ((R & ~31) + perm32(R & 31)) : R;
        voffA[i] = (unsigned)(R * lda + C) * 2u; voffB[i] = (unsigned)(Rb * ldb + C) * 2u; }
    const size_t kstep = (size_t)(BK * 2);
    const size_t hstepA = (size_t)HALF * lda * 2, hstepB = (size_t)HALF * ldb * 2;
    const size_t tstepA = 2 * hstepA, tstepB = 2 * hstepB;
    const unsigned ldsw = (unsigned)wid * 1024u;
    const int aoff = lds_byte(wr * 64 + fr, fq * 8), boff = lds_byte(wc * 32 + fr, fq * 8);
#define PG8_SA(b, h) (((b) * 2 + (h)) * HTB)
#define PG8_SB(b, h) ((4 + (b) * 2 + (h)) * HTB)
#define PG8_STAGE(bufoff, gbase, voff) do { _Pragma("unroll") for (int _i = 0; _i < 2; ++_i) \
        __builtin_amdgcn_global_load_lds((const unsigned*)((const char*)(gbase) + (voff)[_i]), (PG8_LAS unsigned*)(lds + (bufoff) + ldsw + _i * 8192), 16, 0, 0); } while (0)
#define PG8_LDA(dst, b, h) do { _Pragma("unroll") for (int m = 0; m < 4; ++m) _Pragma("unroll") for (int k = 0; k < 2; ++k) dst[m][k] = *(const PG8_LAS bf16x8*)(lds + PG8_SA(b, h) + aoff + m * 2048 + k * 1024); } while (0)
#define PG8_LDB(dst, b, h) do { _Pragma("unroll") for (int n = 0; n < 2; ++n) _Pragma("unroll") for (int k = 0; k < 2; ++k) dst[n][k] = *(const PG8_LAS bf16x8*)(lds + PG8_SB(b, h) + boff + n * 2048 + k * 1024); } while (0)
#define PG8_MMA(ai, bj, At, Bt) do { __builtin_amdgcn_s_setprio(1); _Pragma("unroll") for (int m = 0; m < 4; ++m) _Pragma("unroll") for (int n = 0; n < 2; ++n) _Pragma("unroll") for (int k = 0; k < 2; ++k) \
        acc[ai][bj][m][n] = __builtin_amdgcn_mfma_f32_16x16x32_bf16(Bt[n][k], At[m][k], acc[ai][bj][m][n], 0, 0, 0); __builtin_amdgcn_s_setprio(0); } while (0)
#define PG8_WAIT_V(n) asm volatile("s_waitcnt vmcnt(" #n ")" ::: "memory")
#define PG8_WAIT_L(n) asm volatile("s_waitcnt lgkmcnt(" #n ")" ::: "memory")
#define PG8_BAR __builtin_amdgcn_s_barrier()
#define PG8_SCHED __builtin_amdgcn_sched_barrier(0)
    Unit cur, nxt; int ui = 0;
    if (!S.next(0, cur)) return;
    f32x4 acc[2][2][4][2];
#pragma unroll
    for (int a = 0; a < 2; ++a)
#pragma unroll
        for (int b = 0; b < 2; ++b)
#pragma unroll
            for (int m = 0; m < 4; ++m)
#pragma unroll
                for (int n = 0; n < 2; ++n) acc[a][b][m][n] = (f32x4){0.f, 0.f, 0.f, 0.f};
    bf16x8 At[4][2], B0[2][2], B1[2][2];
    const char* cA = (const char*)g.A + (size_t)cur.pm * tstepA; const char* cB = (const char*)g.Bt + (size_t)cur.pn * tstepB + PG8_BOFF(cur.pm);
    S.a_ready(cur);
    if constexpr (SP2) {
        PG8_STAGE(PG8_SB(0, 0), cB, voffB); PG8_STAGE(PG8_SB(0, 1), cB + hstepB, voffB); PG8_STAGE(PG8_SA(0, 0), cA, voffA); PG8_STAGE(PG8_SA(0, 1), cA + hstepA, voffA);
        if (wr == 1) PG8_BAR;
        PG8_WAIT_V(2); PG8_BAR;
        PG8_STAGE(PG8_SB(1, 0), cB + kstep, voffB); PG8_STAGE(PG8_SA(1, 0), cA + kstep, voffA); PG8_STAGE(PG8_SB(1, 1), cB + hstepB + kstep, voffB);
        PG8_WAIT_V(6); PG8_BAR;
    } else {
        PG8_STAGE(PG8_SB(0, 0), cB, voffB); PG8_STAGE(PG8_SA(0, 0), cA, voffA); PG8_STAGE(PG8_SB(0, 1), cB + hstepB, voffB); PG8_STAGE(PG8_SA(0, 1), cA + hstepA, voffA);
        if (wr == 1) PG8_BAR;
        PG8_WAIT_V(4); PG8_BAR;
        PG8_STAGE(PG8_SB(1, 0), cB + kstep, voffB); PG8_STAGE(PG8_SA(1, 0), cA + kstep, voffA); PG8_STAGE(PG8_SB(1, 1), cB + hstepB + kstep, voffB);
        PG8_WAIT_V(6); PG8_BAR;
    }
    for (;;) {
        const bool has_next = S.next(ui + 1, nxt);
        const char* nA = has_next ? (const char*)g.A + (size_t)nxt.pm * tstepA : cA; const char* nB = has_next ? (const char*)g.Bt + (size_t)nxt.pn * tstepB + PG8_BOFF(nxt.pm) : cB;
        for (int t = 0; t < nt; t += 2) {
            const bool last = (t == nt - 2);
            const char* a1 = cA + (size_t)(t + 1) * kstep;
            const char* a2 = last ? nA : cA + (size_t)(t + 2) * kstep; const char* b2 = last ? nB : cB + (size_t)(t + 2) * kstep;
            const char* a3 = a2 + kstep; const char* b3 = b2 + kstep;
            if (last && has_next) S.a_ready(nxt);
            if constexpr (SP2) {
            PG8_LDB(B0, 0, 0); PG8_LDB(B1, 0, 1); PG8_SCHED; PG8_LDA(At, 0, 0); PG8_STAGE(PG8_SA(1, 1), a1 + hstepA, voffA);
            PG8_WAIT_V(8); PG8_WAIT_L(0); PG8_BAR; PG8_MMA(0, 0, At, B0); PG8_MMA(0, 1, At, B1); PG8_BAR; PG8_SCHED;
            PG8_LDA(At, 0, 1); PG8_STAGE(PG8_SB(0, 0), b2, voffB); PG8_STAGE(PG8_SB(0, 1), b2 + hstepB, voffB); PG8_STAGE(PG8_SA(0, 0), a2, voffA);
            PG8_WAIT_V(8); PG8_WAIT_L(0); PG8_BAR; PG8_MMA(1, 0, At, B0); PG8_MMA(1, 1, At, B1); PG8_BAR; PG8_SCHED;
            PG8_LDB(B0, 1, 0); PG8_LDB(B1, 1, 1); PG8_SCHED; PG8_LDA(At, 1, 0); PG8_STAGE(PG8_SA(0, 1), a2 + hstepA, voffA);
            PG8_WAIT_V(8); PG8_WAIT_L(0); PG8_BAR; PG8_MMA(0, 0, At, B0); PG8_MMA(0, 1, At, B1); PG8_BAR; PG8_SCHED;
            PG8_LDA(At, 1, 1); PG8_STAGE(PG8_SB(1, 0), b3, voffB); PG8_STAGE(PG8_SB(1, 1), b3 + hstepB, voffB); PG8_STAGE(PG8_SA(1, 0), a3, voffA);
            PG8_WAIT_V(8); PG8_WAIT_L(0); PG8_BAR; PG8_MMA(1, 0, At, B0); PG8_MMA(1, 1, At, B1); PG8_BAR; PG8_SCHED;
            } else {
            PG8_LDB(B0, 0, 0); PG8_SCHED; PG8_LDA(At, 0, 0); PG8_STAGE(PG8_SA(1, 1), a1 + hstepA, voffA);
            PG8_WAIT_L(8); PG8_BAR; PG8_WAIT_L(0); PG8_MMA(0, 0, At, B0); PG8_BAR; PG8_SCHED;
            PG8_LDB(B1, 0, 1); PG8_STAGE(PG8_SB(0, 0), b2, voffB);
            PG8_BAR; PG8_WAIT_L(0); PG8_MMA(0, 1, At, B1); PG8_BAR;
            PG8_LDA(At, 0, 1); PG8_STAGE(PG8_SA(0, 0), a2, voffA);
            PG8_BAR; PG8_WAIT_L(0); PG8_MMA(1, 0, At, B0); PG8_BAR; PG8_SCHED;
            PG8_STAGE(PG8_SB(0, 1), b2 + hstepB, voffB);
            PG8_WAIT_V(6); PG8_BAR; PG8_MMA(1, 1, At, B1); PG8_BAR;
            PG8_LDB(B0, 1, 0); PG8_SCHED; PG8_LDA(At, 1, 0); PG8_STAGE(PG8_SA(0, 1), a2 + hstepA, voffA);
            PG8_WAIT_L(8); PG8_BAR; PG8_WAIT_L(0); PG8_MMA(0, 0, At, B0); PG8_BAR; PG8_SCHED;
            PG8_LDB(B1, 1, 1); PG8_STAGE(PG8_SB(1, 0), b3, voffB);
            PG8_BAR; PG8_WAIT_L(0); PG8_MMA(0, 1, At, B1); PG8_BAR;
            PG8_LDA(At, 1, 1); PG8_STAGE(PG8_SA(1, 0), a3, voffA);
            PG8_BAR; PG8_WAIT_L(0); PG8_MMA(1, 0, At, B0); PG8_BAR; PG8_SCHED;
            PG8_STAGE(PG8_SB(1, 1), b3 + hstepB, voffB);
            PG8_WAIT_V(6); PG8_BAR; PG8_MMA(1, 1, At, B1); PG8_BAR;
            }
        }
        if constexpr (ALIGN_EPI) { if (wr == 0) PG8_BAR; }
        if constexpr (!Epi::AFTER_DRAIN) { E(acc, cur, wr, wc, fr, fq); S.done(cur); }
        if (!has_next) break;
#pragma unroll
        for (int a = 0; a < 2; ++a)
#pragma unroll
            for (int b = 0; b < 2; ++b)
#pragma unroll
                for (int m = 0; m < 4; ++m)
#pragma unroll
                    for (int n = 0; n < 2; ++n) acc[a][b][m][n] = (f32x4){0.f, 0.f, 0.f, 0.f};
        cur = nxt; cA = nA; cB = nB; ++ui;
        if constexpr (ALIGN_EPI) { if (wr == 1) PG8_BAR; }
    }
    PG8_WAIT_V(0);
    if constexpr (!ALIGN_EPI) { if (wr == 0) PG8_BAR; }
    PG8_BAR;
    if constexpr (Epi::AFTER_DRAIN) { E.fused(acc, cur, wr, wc, fr, fq, lds, wid, lane); S.done(cur); }
#undef PG8_BOFF
#undef PG8_SA
#undef PG8_SB
#undef PG8_STAGE
#undef PG8_LDA
#undef PG8_LDB
#undef PG8_MMA
#undef PG8_WAIT_V
#undef PG8_WAIT_L
#undef PG8_BAR
#undef PG8_SCHED
}
}

#define GAS __attribute__((address_space(1)))
#define LAS __attribute__((address_space(3)))
typedef GAS unsigned gu32;
#define LDS_WAIT() asm volatile("s_waitcnt lgkmcnt(0)" ::: "memory")
#define VM_WAIT() asm volatile("s_waitcnt vmcnt(0)" ::: "memory")
constexpr int NWAVES = 8, NTHR = NWAVES * 64;
constexpr int LDSCTL_OFF = 0, PH_BASE = 512, LDS_BYTES = 147456;
constexpr int CW_BAR = 4096;
constexpr size_t CTL_ZERO_BYTES = 256 * 1024;
constexpr size_t WS_TRIG = 27 * MiB;
#define XB_TMO      128
#define XB_XCNT(j)  (256  + 64 * (j))
#define XB_XSUB(j)  (1280 + 64 * (j))
#define XB_XGEN(j)  (2304 + 64 * (j))
#define XB_TOP      3328
#define XB_TOPGEN   3392
#define XCD_BAR_WORDS 3456
#define XB_SPIN_CAP (1u << 18)

__device__ __forceinline__ unsigned xb_ld(unsigned* p)              { return __hip_atomic_load(p, __ATOMIC_RELAXED, __HIP_MEMORY_SCOPE_AGENT); }
__device__ __forceinline__ unsigned xb_add(unsigned* p, unsigned v) { return __hip_atomic_fetch_add(p, v, __ATOMIC_RELAXED, __HIP_MEMORY_SCOPE_AGENT); }
__device__ __forceinline__ unsigned xb_xcc_id() { return (unsigned)__builtin_amdgcn_s_getreg((3 << 11) | 20) & 0xFu; }
#define XB_SPIN(cond, bar) do { unsigned _sp = 0; while (cond) { __builtin_amdgcn_s_sleep(1); \
    if ((++_sp & 255u) == 0u) { if (xb_ld(&(bar)[XB_TMO])) break; if (_sp > XB_SPIN_CAP) { atomicAdd(&(bar)[XB_TMO], 1u); break; } } } } while (0)

struct XcdBarrier {
    unsigned* bar; unsigned x;
    volatile LAS unsigned* st;
};

__device__ __forceinline__ XcdBarrier xcd_barrier_post(unsigned* bar, volatile LAS unsigned* st) {
    XcdBarrier b; b.bar = bar; b.x = xb_xcc_id(); b.st = st;
    if (threadIdx.x == 0) (void)xb_add(&bar[XB_XCNT(b.x)], 1u);
    return b;
}
__device__ __forceinline__ void xcd_barrier_complete(unsigned* bar, unsigned x, unsigned& nloc, unsigned& nx) {
    const unsigned G = gridDim.x * gridDim.y * gridDim.z;
    unsigned sum, cnt, mine, sp = 0u;
    for (;;) {
        sum = 0u; cnt = 0u; mine = 0u;
#pragma unroll
        for (unsigned j = 0; j < 16; ++j) { const unsigned c = xb_ld(&bar[XB_XCNT(j)]); sum += c; cnt += (c > 0u) ? 1u : 0u; mine = (j == x) ? c : mine; }
        if (sum == G) break;
        __builtin_amdgcn_s_sleep(1);
        if ((++sp & 255u) == 0u) { if (xb_ld(&bar[XB_TMO])) break; if (sp > XB_SPIN_CAP) { atomicAdd(&bar[XB_TMO], 1u); break; } }
    }
    nloc = mine > 0u ? mine : 1u; nx = cnt > 0u ? cnt : 1u;
}

__device__ __forceinline__ void xcd_barrier(const XcdBarrier& b) {
    asm volatile("s_waitcnt vmcnt(0)" ::: "memory");
    __syncthreads();
    if (threadIdx.x == 0) {
        unsigned* bar = b.bar;
        __builtin_amdgcn_s_waitcnt(0);
        unsigned nloc = b.st[0], nx = b.st[1];
        if (nloc == 0u) { xcd_barrier_complete(bar, b.x, nloc, nx); b.st[0] = nloc; b.st[1] = nx; }
        const unsigned old = xb_add(&bar[XB_XSUB(b.x)], 1u);
        const unsigned gen = old / nloc;
        if (old + 1u == (gen + 1u) * nloc) {
            __builtin_amdgcn_fence(__ATOMIC_RELEASE, "agent");
            asm volatile("s_waitcnt vmcnt(0)" ::: "memory");
            const unsigned og = xb_add(&bar[XB_TOP], 1u);
            const unsigned tg = og / nx;
            if (og + 1u == (tg + 1u) * nx) xb_add(&bar[XB_TOPGEN], 1u);
            else XB_SPIN(xb_ld(&bar[XB_TOPGEN]) == tg, bar);
            __builtin_amdgcn_fence(__ATOMIC_ACQUIRE, "agent");
            xb_add(&bar[XB_XGEN(b.x)], 1u);
            asm volatile("s_waitcnt vmcnt(0)" ::: "memory");
        } else {
            XB_SPIN(xb_ld(&bar[XB_XGEN(b.x)]) == gen, bar);
            __builtin_amdgcn_fence(__ATOMIC_ACQUIRE, "agent");
            asm volatile("s_waitcnt vmcnt(0)" ::: "memory");
        }
    }
    __syncthreads();
}

enum { PH_PRO = 0, PH_PROJ, PH_UP, PH_ATTN, PH_MIX, PH_MEMQ, PH_XATTN, PH_MEMO, PH_PQ, PH_TOPK, PH_EXP, PH_N, PHB_CONV = 16, PHB_UPG = 17 };
struct Args { const float* in[24]; float* out; unsigned char* ws; unsigned mask; unsigned li; };

DEVI int src_col(int mode, int r) { return mode == 0 ? r : mode == 1 ? win_src(r) : wkv_src(r); }
template <int MODE, bool HASG> DEVI void p0_transpose_item(const float* W, int K, int N, bf16* WT, int NR, const float* gk, LAS float* scr, int item, int lane) {
    const int nb_ = NR / 32, kb = item / nb_, nb = item % nb_, k0 = 64 * kb, n0 = 32 * nb;
    const int sc = src_col(MODE, n0 + (lane & 31)), scc = sc < 0 ? 0 : sc; const float keep = sc < 0 ? 0.f : 1.f;
    float v[32];
#pragma unroll
    for (int i = 0; i < 32; ++i) { const int kk = 2 * i + (lane >> 5); v[i] = W[(size_t)(k0 + kk) * N + scc]; }
    if (HASG) {
#pragma unroll
        for (int i = 0; i < 32; ++i) { const int kk = 2 * i + (lane >> 5); v[i] *= gk[k0 + kk]; } }
#pragma unroll
    for (int i = 0; i < 32; ++i) { const int kk = 2 * i + (lane >> 5); scr[kk * 33 + (lane & 31)] = MODE == 0 ? v[i] : v[i] * keep; }
    LDS_WAIT(); asm volatile("" ::: "memory");
    const int c = lane & 7;
#pragma unroll
    for (int j = 0; j < 4; ++j) { const int n = (lane >> 3) + 8 * j; const LAS float* s = scr + (8 * c) * 33 + n;
        uint4 o; o.x = pg8::cvt_pk_bf16(s[0 * 33], s[1 * 33]); o.y = pg8::cvt_pk_bf16(s[2 * 33], s[3 * 33]); o.z = pg8::cvt_pk_bf16(s[4 * 33], s[5 * 33]); o.w = pg8::cvt_pk_bf16(s[6 * 33], s[7 * 33]);
        *(uint4*)(WT + (size_t)(n0 + n) * K + k0 + 8 * c) = o; }
    LDS_WAIT(); asm volatile("" ::: "memory");
}
DEVI void rms_row_to_bf16(const float* xrow, const float* g, bf16* orow, int lane) {
    const float4* xr = (const float4*)xrow + lane; const float4* gr = (const float4*)g + lane;
    float4 v[4]; float s = 0.f;
#pragma unroll
    for (int j = 0; j < 4; ++j) { v[j] = xr[64 * j]; s += (v[j].x * v[j].x + v[j].y * v[j].y) + (v[j].z * v[j].z + v[j].w * v[j].w); }
    const float r = rsqrtf(wave_sum(s) * (1.f / D) + EPS);
    uint2* o8 = (uint2*)orow + lane;
#pragma unroll
    for (int j = 0; j < 4; ++j) { const float4 gg = gr[64 * j]; uint2 o; o.x = pg8::cvt_pk_bf16(v[j].x * r * gg.x, v[j].y * r * gg.y); o.y = pg8::cvt_pk_bf16(v[j].z * r * gg.z, v[j].w * r * gg.w); o8[64 * j] = o; }
}
DEVI void rms_rows4_to_bf16(const float* x, const float* g, bf16* out, int m0, int step, int mend, int lane) {
    float4 v[4][4]; float s[4]; float4 gq[4];
#pragma unroll
    for (int j = 0; j < 4; ++j) gq[j] = ((const float4*)g + lane)[64 * j];
#pragma unroll
    for (int r = 0; r < 4; ++r) { const int m = m0 + r * step; const float4* xr = (const float4*)(x + (size_t)(m < mend ? m : m0) * D) + lane;
#pragma unroll
        for (int j = 0; j < 4; ++j) v[r][j] = xr[64 * j]; }
#pragma unroll
    for (int r = 0; r < 4; ++r) { float t = 0.f;
#pragma unroll
        for (int j = 0; j < 4; ++j) t += (v[r][j].x * v[r][j].x + v[r][j].y * v[r][j].y) + (v[r][j].z * v[r][j].z + v[r][j].w * v[r][j].w);
        s[r] = t; }
#pragma unroll
    for (int o = 1; o < 64; o <<= 1) {
#pragma unroll
        for (int r = 0; r < 4; ++r) s[r] += __shfl_xor(s[r], o); }
#pragma unroll
    for (int r = 0; r < 4; ++r) { const int m = m0 + r * step; if (m < mend) { const float rs = rsqrtf(s[r] * (1.f / D) + EPS); uint2* o8 = (uint2*)(out + (size_t)m * D) + lane;
#pragma unroll
        for (int j = 0; j < 4; ++j) { const float4 gg = gq[j]; uint2 o; o.x = pg8::cvt_pk_bf16(v[r][j].x * rs * gg.x, v[r][j].y * rs * gg.y); o.y = pg8::cvt_pk_bf16(v[r][j].z * rs * gg.z, v[r][j].w * rs * gg.w); o8[64 * j] = o; } } }
}
DEVI void cvt_stream_fp8(const float* src, unsigned char* dst, size_t n16, const float* g, float mul, size_t gtid, size_t gn) {
    for (size_t i = gtid; i < n16; i += gn) { pg8::u32x4 o;
#pragma unroll
        for (int q = 0; q < 4; ++q) { float4 a = *(const float4*)(src + i * 16 + q * 4); if (g) { const float4 gg = *(const float4*)(g + ((i * 16 + q * 4) & (D - 1))); a.x *= gg.x; a.y *= gg.y; a.z *= gg.z; a.w *= gg.w; }
            int p = __builtin_amdgcn_cvt_pk_fp8_f32(a.x * mul, a.y * mul, 0, false); p = __builtin_amdgcn_cvt_pk_fp8_f32(a.z * mul, a.w * mul, p, true); o[q] = (unsigned)p; }
        *(pg8::u32x4*)(dst + i * 16) = o; }
}
typedef unsigned v6u_t __attribute__((ext_vector_type(6)));
typedef float f32x2_t __attribute__((ext_vector_type(2)));
typedef float v16f_t __attribute__((ext_vector_type(16)));
typedef float v32f_t __attribute__((ext_vector_type(32)));
typedef __bf16 v32bf_t __attribute__((ext_vector_type(32)));
#ifndef FP6_INTERLEAVED
#define FP6_INTERLEAVED 0
#endif
template <bool HASG> DEVI void cvt_rows_fp6(const float* src, unsigned char* dst, const float* g, float mul, size_t gtid, size_t gn) {
    const int grp = (int)(gtid & 31);
    float4 gg[8];
#pragma unroll
    for (int q = 0; q < 8; ++q) { gg[q] = HASG ? *(const float4*)(g + grp * 32 + q * 4) : make_float4(1.f, 1.f, 1.f, 1.f); gg[q].x *= mul; gg[q].y *= mul; gg[q].z *= mul; gg[q].w *= mul; }
    for (size_t i0 = gtid; i0 < (size_t)PE * 32; i0 += 2 * gn) {
        float4 v[2][8];
#pragma unroll
        for (int u = 0; u < 2; ++u) { const size_t i = i0 + u * gn; if (i < (size_t)PE * 32) { const float* sp = src + (i >> 5) * D + (i & 31) * 32;
#pragma unroll
            for (int q = 0; q < 8; ++q) v[u][q] = *(const float4*)(sp + q * 4); } }
#pragma unroll
        for (int u = 0; u < 2; ++u) { const size_t i = i0 + u * gn; if (i < (size_t)PE * 32) { const size_t row = i >> 5;
            v16f_t a, b;
#pragma unroll
            for (int q = 0; q < 8; ++q) { const float4 x = v[u][q]; a[2 * q] = x.x * gg[q].x; b[2 * q] = x.y * gg[q].y; a[2 * q + 1] = x.z * gg[q].z; b[2 * q + 1] = x.w * gg[q].w; }
            const v6u_t p = __builtin_amdgcn_cvt_scalef32_2xpk16_fp6_f32(a, b, 1.0f);
            *(pg8::u32x4*)(dst + row * 768 + grp * 16) = (pg8::u32x4){p[0], p[1], p[2], p[3]};
            *(pg8::u32x2*)(dst + row * 768 + 512 + grp * 8) = (pg8::u32x2){p[4], p[5]}; } }
    }
}
DEVI void cvt_stream(const float* src, bf16* dst, size_t n8, const float* g, size_t gtid, size_t gn) {
    for (size_t i = gtid; i < n8; i += gn) { const float4 a = *(const float4*)(src + i * 8), b = *(const float4*)(src + i * 8 + 4);
        float4 ga = make_float4(1.f, 1.f, 1.f, 1.f), gb = ga; if (g) { ga = *(const float4*)(g + ((i * 8) & (D - 1))); gb = *(const float4*)(g + ((i * 8) & (D - 1)) + 4); }
        uint4 o; o.x = pg8::cvt_pk_bf16(a.x * ga.x, a.y * ga.y); o.y = pg8::cvt_pk_bf16(a.z * ga.z, a.w * ga.w); o.z = pg8::cvt_pk_bf16(b.x * gb.x, b.y * gb.y); o.w = pg8::cvt_pk_bf16(b.z * gb.z, b.w * gb.w);
        *(uint4*)(dst + i * 8) = o; }
}


DEVI void conv_token(int row, const bf16* U, const float* cw, const float* cb, const float* lg, const float* lb, bf16* CONCAT, int lane) {
    const int pos = row % SEQ; float y[8];
    { const float4 b0 = *(const float4*)(cb + lane * 8), b1 = *(const float4*)(cb + lane * 8 + 4); y[0] = b0.x; y[1] = b0.y; y[2] = b0.z; y[3] = b0.w; y[4] = b1.x; y[5] = b1.y; y[6] = b1.z; y[7] = b1.w; }
    const int k0 = pos >= CK - 1 ? 0 : CK - 1 - pos;
    for (int k = k0; k < CK; ++k) {
        const uint4 u = *(const uint4*)(U + (size_t)(row - (CK - 1) + k) * CW + lane * 8);
        const float4 w0 = *(const float4*)(cw + k * CW + lane * 8), w1 = *(const float4*)(cw + k * CW + lane * 8 + 4);
        y[0] += w0.x * __builtin_bit_cast(float, u.x << 16); y[1] += w0.y * __builtin_bit_cast(float, u.x & 0xffff0000u);
        y[2] += w0.z * __builtin_bit_cast(float, u.y << 16); y[3] += w0.w * __builtin_bit_cast(float, u.y & 0xffff0000u);
        y[4] += w1.x * __builtin_bit_cast(float, u.z << 16); y[5] += w1.y * __builtin_bit_cast(float, u.z & 0xffff0000u);
        y[6] += w1.z * __builtin_bit_cast(float, u.w << 16); y[7] += w1.w * __builtin_bit_cast(float, u.w & 0xffff0000u);
    }
    float s = 0.f;
#pragma unroll
    for (int e = 0; e < 8; ++e) s += y[e];
    const float mu = wave_sum(s) * (1.f / CW); float q = 0.f;
#pragma unroll
    for (int e = 0; e < 8; ++e) { y[e] -= mu; q += y[e] * y[e]; }
    const float rstd = rsqrtf(wave_sum(q) * (1.f / CW) + EPS);
    const float4 g0 = *(const float4*)(lg + lane * 8), g1 = *(const float4*)(lg + lane * 8 + 4), c0 = *(const float4*)(lb + lane * 8), c1 = *(const float4*)(lb + lane * 8 + 4);
    const float gg[8] = {g0.x, g0.y, g0.z, g0.w, g1.x, g1.y, g1.z, g1.w}, bb[8] = {c0.x, c0.y, c0.z, c0.w, c1.x, c1.y, c1.z, c1.w};
    float z[8];
#pragma unroll
    for (int e = 0; e < 8; ++e) { const float t = y[e] * rstd * gg[e] + bb[e]; z[e] = t * __builtin_amdgcn_rcpf(1.f + __expf(-t)); }
    uint4 o; o.x = pg8::cvt_pk_bf16(z[0], z[1]); o.y = pg8::cvt_pk_bf16(z[2], z[3]); o.z = pg8::cvt_pk_bf16(z[4], z[5]); o.w = pg8::cvt_pk_bf16(z[6], z[7]);
    *(uint4*)(CONCAT + (size_t)row * D + CW + lane * 8) = o;
}

DEVI void conv_chunk(int c, const bf16* U, const float* cw, const float* cb, const float* lg, const float* lb, bf16* CONCAT, LAS unsigned char* lds) {
    const int ch = threadIdx.x, lane = ch & 63, wv = __builtin_amdgcn_readfirstlane(ch >> 6);
    const int t0 = c * 64, pos0 = t0 % SEQ;
    float w[CK];
#pragma unroll
    for (int k = 0; k < CK; ++k) w[k] = cw[k * CW + ch];
    const float bias = cb[ch];
    float u[64 + CK - 1];
#pragma unroll
    for (int r = 0; r < 64 + CK - 1; ++r) { const int row = t0 - (CK - 1) + r;
        const unsigned raw = *(const unsigned short*)(U + (size_t)(row < 0 ? 0 : row) * CW + ch); u[r] = __builtin_bit_cast(float, raw << 16); }
#pragma unroll
    for (int r = 0; r < CK - 1; ++r) { const float keep = (pos0 - (CK - 1) + r >= 0) ? 1.f : 0.f; u[r] *= keep; }
    LAS float* yl = (LAS float*)lds;
#pragma unroll
    for (int j = 0; j < 64; ++j) { float y = bias;
#pragma unroll
        for (int k = 0; k < CK; ++k) y += w[k] * u[j + k];
        yl[j * CW + ch] = y; }
    __syncthreads();
#pragma unroll 1
    for (int i = 0; i < 8; ++i) { const int j = wv * 8 + i, row = t0 + j;
        const pg8::f32x4 a0 = *(const LAS pg8::f32x4*)(yl + j * CW + lane * 8), a1 = *(const LAS pg8::f32x4*)(yl + j * CW + lane * 8 + 4);
        float y[8] = {a0[0], a0[1], a0[2], a0[3], a1[0], a1[1], a1[2], a1[3]}; float sm = 0.f;
#pragma unroll
        for (int e = 0; e < 8; ++e) sm += y[e];
        const float mu = wave_sum(sm) * (1.f / CW); float q = 0.f;
#pragma unroll
        for (int e = 0; e < 8; ++e) { y[e] -= mu; q += y[e] * y[e]; }
        const float rstd = rsqrtf(wave_sum(q) * (1.f / CW) + EPS);
        const float4 g0 = *(const float4*)(lg + lane * 8), g1 = *(const float4*)(lg + lane * 8 + 4), c0 = *(const float4*)(lb + lane * 8), c1 = *(const float4*)(lb + lane * 8 + 4);
        const float gg[8] = {g0.x, g0.y, g0.z, g0.w, g1.x, g1.y, g1.z, g1.w}, bb[8] = {c0.x, c0.y, c0.z, c0.w, c1.x, c1.y, c1.z, c1.w};
        float z[8];
#pragma unroll
        for (int e = 0; e < 8; ++e) { const float t = y[e] * rstd * gg[e] + bb[e]; z[e] = t * __builtin_amdgcn_rcpf(1.f + __expf(-t)); }
        uint4 o; o.x = pg8::cvt_pk_bf16(z[0], z[1]); o.y = pg8::cvt_pk_bf16(z[2], z[3]); o.z = pg8::cvt_pk_bf16(z[4], z[5]); o.w = pg8::cvt_pk_bf16(z[6], z[7]);
        *(uint4*)(CONCAT + (size_t)row * D + CW + lane * 8) = o; }
    __syncthreads();
}

typedef short bf16x8_t __attribute__((ext_vector_type(8)));
typedef float f32x16_t __attribute__((ext_vector_type(16)));
typedef __bf16 bf16x2_t __attribute__((ext_vector_type(2)));
DEVI unsigned umax_(unsigned a, unsigned b) { return a > b ? a : b; }
DEVI unsigned umin_(unsigned a, unsigned b) { return a < b ? a : b; }
DEVI unsigned kmax_(unsigned a, unsigned b) { unsigned r; asm("v_max_f32 %0, %1, %2" : "=v"(r) : "v"(a), "v"(b)); return r; }
DEVI unsigned kmin_(unsigned a, unsigned b) { unsigned r; asm("v_min_f32 %0, %1, %2" : "=v"(r) : "v"(a), "v"(b)); return r; }
DEVI void ce_desc(unsigned& a, unsigned& b) { const unsigned mx = kmax_(a, b), mn = kmin_(a, b); a = mx; b = mn; }
DEVI void sort16_desc(unsigned (&v)[16]) {
    ce_desc(v[0], v[13]); ce_desc(v[1], v[12]); ce_desc(v[2], v[15]); ce_desc(v[3], v[14]); ce_desc(v[4], v[8]); ce_desc(v[5], v[6]); ce_desc(v[7], v[11]); ce_desc(v[9], v[10]);
    ce_desc(v[0], v[5]); ce_desc(v[1], v[7]); ce_desc(v[2], v[9]); ce_desc(v[3], v[4]); ce_desc(v[6], v[13]); ce_desc(v[8], v[14]); ce_desc(v[10], v[15]); ce_desc(v[11], v[12]);
    ce_desc(v[0], v[1]); ce_desc(v[2], v[3]); ce_desc(v[4], v[5]); ce_desc(v[6], v[8]); ce_desc(v[7], v[9]); ce_desc(v[10], v[11]); ce_desc(v[12], v[13]); ce_desc(v[14], v[15]);
    ce_desc(v[0], v[2]); ce_desc(v[1], v[3]); ce_desc(v[4], v[10]); ce_desc(v[5], v[11]); ce_desc(v[6], v[7]); ce_desc(v[8], v[9]); ce_desc(v[12], v[14]); ce_desc(v[13], v[15]);
    ce_desc(v[1], v[2]); ce_desc(v[3], v[12]); ce_desc(v[4], v[6]); ce_desc(v[5], v[7]); ce_desc(v[8], v[10]); ce_desc(v[9], v[11]); ce_desc(v[13], v[14]);
    ce_desc(v[1], v[4]); ce_desc(v[2], v[6]); ce_desc(v[5], v[8]); ce_desc(v[7], v[10]); ce_desc(v[9], v[13]); ce_desc(v[11], v[14]);
    ce_desc(v[2], v[4]); ce_desc(v[3], v[6]); ce_desc(v[9], v[12]); ce_desc(v[11], v[13]);
    ce_desc(v[3], v[5]); ce_desc(v[6], v[8]); ce_desc(v[7], v[9]); ce_desc(v[10], v[12]);
    ce_desc(v[3], v[4]); ce_desc(v[5], v[6]); ce_desc(v[7], v[8]); ce_desc(v[9], v[10]); ce_desc(v[11], v[12]);
    ce_desc(v[6], v[7]); ce_desc(v[8], v[9]);
}
DEVI void merge16_desc(unsigned (&v)[16]) {
#pragma unroll
    for (int j = 8; j > 0; j >>= 1)
#pragma unroll
        for (int i = 0; i < 16; ++i) { const int l = i ^ j; if (l > i) ce_desc(v[i], v[l]); }
}
DEVI void top16_merge(unsigned (&a)[16], const unsigned (&b)[16]) {
#pragma unroll
    for (int i = 0; i < 16; ++i) a[i] = kmax_(a[i], b[15 - i]);
    merge16_desc(a);
}
DEVI int crow16(int r, int hi) { return (r & 3) + 8 * (r >> 2) + 4 * hi; }

DEVI void subkey_top16(unsigned (&best)[16], const bf16* qrow  , const LAS unsigned char* kl  , int hi) {
    bf16x8_t qf[8];
#pragma unroll
    for (int ks = 0; ks < 8; ++ks) qf[ks] = *(const bf16x8_t*)(qrow + 16 * ks);
    unsigned grp[16];
#pragma unroll
    for (int nt = 0; nt < 4; ++nt) {
        f32x16_t acc = {};
#pragma unroll
        for (int ks = 0; ks < 8; ++ks) { const bf16x8_t kf = *(const LAS bf16x8_t*)(kl + ks * 4096 + nt * 512); acc = __builtin_amdgcn_mfma_f32_32x32x16_bf16(kf, qf[ks], acc, 0, 0, 0); }
#pragma unroll
        for (int r = 0; r < 16; ++r) { const float av = acc[r]; grp[r] = (__builtin_bit_cast(unsigned, av) & 0xffffff80u) | (unsigned)(127 - (32 * nt + crow16(r, hi))); }
        sort16_desc(grp);
        if (nt == 0) {
#pragma unroll
            for (int r = 0; r < 16; ++r) best[r] = grp[r];
        } else top16_merge(best, grp);
    }
    unsigned oth[16];
#pragma unroll
    for (int r = 0; r < 16; ++r) oth[r] = (unsigned)__shfl_xor((int)best[r], 32);
    top16_merge(best, oth);
}
DEVI void topk_wave(const bf16* qbase, const LAS unsigned char* keys, LAS unsigned* scr  , int* eidx, float* egate, int lane) {
    const int r32 = lane & 31, hi = lane >> 5;
    unsigned b0[16], b1[16];
    subkey_top16(b0, qbase + 8 * hi, keys + hi * 2048 + r32 * 16, hi);
    subkey_top16(b1, qbase + 128 + 8 * hi, keys + 32768 + hi * 2048 + r32 * 16, hi);
    float s0[16], s1[16];
#pragma unroll
    for (int i = 0; i < 16; ++i) { s0[i] = __builtin_bit_cast(float, b0[i] & 0xffffff80u); s1[i] = __builtin_bit_cast(float, b1[i] & 0xffffff80u); }
#pragma unroll
    for (int w = 0; w < 4; ++w) {
        scr[lane * 9 + w] = (127u - (b0[4 * w] & 127u)) | ((127u - (b0[4 * w + 1] & 127u)) << 8) | ((127u - (b0[4 * w + 2] & 127u)) << 16) | ((127u - (b0[4 * w + 3] & 127u)) << 24);
        scr[lane * 9 + 4 + w] = (127u - (b1[4 * w] & 127u)) | ((127u - (b1[4 * w + 1] & 127u)) << 8) | ((127u - (b1[4 * w + 2] & 127u)) << 16) | ((127u - (b1[4 * w + 3] & 127u)) << 24);
    }
    unsigned ca[16], cb2[16];
#define CAND(i, j) ((__builtin_bit_cast(unsigned, s0[i] + s1[j]) & 0xffffff00u) | (unsigned)(255 - ((i) * 16 + (j))))
    const unsigned lowest = 0xff800000u;
    if (hi == 0) {
#pragma unroll
        for (int j = 0; j < 16; ++j) ca[j] = CAND(0, j);
#pragma unroll
        for (int j = 0; j < 8; ++j) cb2[j] = CAND(1, j);
#pragma unroll
        for (int j = 8; j < 16; ++j) cb2[j] = lowest;
    } else {
        ca[0] = CAND(2, 0); ca[1] = CAND(2, 1); ca[2] = CAND(2, 2); ca[3] = CAND(2, 3); ca[4] = CAND(2, 4); ca[5] = CAND(3, 0); ca[6] = CAND(3, 1); ca[7] = CAND(3, 2); ca[8] = CAND(3, 3);
        ca[9] = CAND(4, 0); ca[10] = CAND(4, 1); ca[11] = CAND(4, 2); ca[12] = CAND(5, 0); ca[13] = CAND(5, 1); ca[14] = CAND(6, 0); ca[15] = CAND(6, 1);
        cb2[0] = CAND(7, 0); cb2[1] = CAND(7, 1); cb2[2] = CAND(8, 0); cb2[3] = CAND(9, 0); cb2[4] = CAND(10, 0); cb2[5] = CAND(11, 0); cb2[6] = CAND(12, 0); cb2[7] = CAND(13, 0); cb2[8] = CAND(14, 0); cb2[9] = CAND(15, 0);
#pragma unroll
        for (int j = 10; j < 16; ++j) cb2[j] = lowest;
    }
#undef CAND
    sort16_desc(ca); sort16_desc(cb2); top16_merge(ca, cb2);
    unsigned oth[16];
#pragma unroll
    for (int r = 0; r < 16; ++r) oth[r] = (unsigned)__shfl_xor((int)ca[r], 32);
    top16_merge(ca, oth);
    const float mx = __builtin_bit_cast(float, ca[0] & 0xffffff00u); float ex[16]; float l = 0.f;
#pragma unroll
    for (int k = 0; k < 16; ++k) { ex[k] = __expf(__builtin_bit_cast(float, ca[k] & 0xffffff00u) - mx); l += ex[k]; }
    const float rl = 1.f / l;
    LDS_WAIT(); asm volatile("" ::: "memory");
    int ei[8]; float eg[8];
    const unsigned mhi = (unsigned)(-hi);
#pragma unroll
    for (int k = 0; k < 8; ++k) { const unsigned key = ca[k] ^ ((ca[k] ^ ca[8 + k]) & mhi); const unsigned ij = 255u - (key & 255u), i = ij >> 4, j = ij & 15u;
        const unsigned w0 = scr[lane * 9 + (i >> 2)], w1 = scr[lane * 9 + 4 + (j >> 2)];
        ei[k] = (int)(((w0 >> (8 * (i & 3))) & 255u) * PNK + ((w1 >> (8 * (j & 3))) & 255u)); eg[k] = __builtin_bit_cast(float, __builtin_bit_cast(unsigned, ex[k]) ^ ((__builtin_bit_cast(unsigned, ex[k]) ^ __builtin_bit_cast(unsigned, ex[8 + k])) & mhi)) * rl; }
    *(int4*)(eidx + hi * 8) = make_int4(ei[0], ei[1], ei[2], ei[3]); *(int4*)(eidx + hi * 8 + 4) = make_int4(ei[4], ei[5], ei[6], ei[7]);
    *(float4*)(egate + hi * 8) = make_float4(eg[0], eg[1], eg[2], eg[3]); *(float4*)(egate + hi * 8 + 4) = make_float4(eg[4], eg[5], eg[6], eg[7]);
    LDS_WAIT(); asm volatile("" ::: "memory");
}

typedef unsigned char fp8_t;
template <int VAR = 0> DEVI float dot16_fp8(pg8::u32x4 row, pg8::u32x4 ha, pg8::u32x4 hb, float acc) {
    if (VAR == 1) return __builtin_bit_cast(float, (row[0] ^ row[1]) ^ (row[2] ^ row[3]));
#pragma unroll
    for (int i = 0; i < 4; ++i) { const unsigned hlo = i < 2 ? ha[2 * i] : hb[2 * i - 4], hhi = i < 2 ? ha[2 * i + 1] : hb[2 * i - 3];
        acc = __builtin_amdgcn_fdot2_f32_bf16(__builtin_amdgcn_cvt_scalef32_pk_bf16_fp8(row[i], 1.0f, false), __builtin_bit_cast(bf16x2_t, hlo), acc, false);
        acc = __builtin_amdgcn_fdot2_f32_bf16(__builtin_amdgcn_cvt_scalef32_pk_bf16_fp8(row[i], 1.0f, true), __builtin_bit_cast(bf16x2_t, hhi), acc, false); }
    return acc;
}
template <int VAR = 0> DEVI void fma16_fp8(float (&acc)[16], float w, pg8::u32x4 row) {
    if (VAR == 1) { acc[0] += __builtin_bit_cast(float, row[0] ^ row[1]); acc[1] += __builtin_bit_cast(float, row[2] ^ row[3]); return; }
#pragma unroll
    for (int i = 0; i < 4; ++i) { const pg8::f32x2 lo = __builtin_amdgcn_cvt_pk_f32_fp8(row[i], false), hh = __builtin_amdgcn_cvt_pk_f32_fp8(row[i], true);
        acc[4 * i] += w * lo[0]; acc[4 * i + 1] += w * lo[1]; acc[4 * i + 2] += w * hh[0]; acc[4 * i + 3] += w * hh[1]; }
}
DEVI void sort128_asc(unsigned& a, unsigned& b, int lane) {
#pragma unroll
    for (int k = 2; k <= 128; k <<= 1)
#pragma unroll
        for (int j = k >> 1; j > 0; j >>= 1) {
            if (j == 64) { const unsigned lo = umin_(a, b), hi = umax_(a, b); a = lo; b = hi; }
            else {
                const bool upper = (lane & j) != 0;
                const bool asc_a = k == 128 ? true : ((lane & k) == 0), asc_b = k == 128 ? true : (k == 64 ? false : ((lane & k) == 0));
                const unsigned pa_ = (unsigned)__shfl_xor((int)a, j), pb_ = (unsigned)__shfl_xor((int)b, j);
                a = (upper != asc_a) ? umin_(a, pa_) : umax_(a, pa_);
                b = (upper != asc_b) ? umin_(b, pb_) : umax_(b, pb_);
            }
        }
}
constexpr int EXD = 8, EXP_LDS_WAVE = 12800 + 1024;
typedef int v8i_t __attribute__((ext_vector_type(8)));
typedef float v4f_t __attribute__((ext_vector_type(4)));
struct Row6 { pg8::u32x4 a; pg8::u32x2 b; };
template <int VAR> DEVI void experts_wave(LAS unsigned char* wl_, int t0, int tstep, const bf16* H2B, const float* part2, const unsigned char* PU, const unsigned char* PV, const int* EIDX, const float* EGATE, const float* fg, float* out, int lane) {
    if (t0 >= M) return;
    const int ntok = (M - t0 + tstep - 1) / tstep < 8 ? (M - t0 + tstep - 1) / tstep : 8;
    LAS int* sid = (LAS int*)wl_; LAS float* gsl = (LAS float*)(wl_ + 4096); LAS float* wl = (LAS float*)(wl_ + 8192); LAS float* r2l = (LAS float*)(wl_ + 12288);
    const unsigned g32 = (unsigned)lane & 31u, hsel = (unsigned)lane >> 5, l4 = (unsigned)lane * 4u;
#define LDI(p) (*(const int*)((const char*)(p) + l4))
#define LDF(p) (*(const float*)((const char*)(p) + l4))
#define LDROW(dst, tab, ridx) do { const unsigned char* rp_ = (tab) + (size_t)(unsigned)(ridx) * 768u; (dst).a = *(const pg8::u32x4*)(rp_ + g32 * 16u); (dst).b = *(const pg8::u32x2*)(rp_ + 512u + g32 * 8u); } while (0)
    for (int k = 0; k < ntok; ++k) { const int t = t0 + k * tstep;
        unsigned k0 = ((unsigned)LDI(EIDX + (size_t)t * 128) << 7) | (unsigned)lane, k1 = ((unsigned)LDI(EIDX + (size_t)t * 128 + 64) << 7) | (unsigned)(64 + lane);
        const float ga = LDF(EGATE + (size_t)t * 128), gb = LDF(EGATE + (size_t)t * 128 + 64);
        sort128_asc(k0, k1, lane);
        const unsigned sl0 = k0 & 127u, sl1 = k1 & 127u;
        const float x0 = __shfl(ga, (int)(sl0 & 63u)), y0 = __shfl(gb, (int)(sl0 & 63u)), x1 = __shfl(ga, (int)(sl1 & 63u)), y1 = __shfl(gb, (int)(sl1 & 63u));
        sid[k * 128 + lane] = (int)(k0 >> 7); sid[k * 128 + 64 + lane] = (int)(k1 >> 7);
        gsl[k * 128 + lane] = sl0 < 64u ? x0 : y0; gsl[k * 128 + 64 + lane] = sl1 < 64u ? x1 : y1;
        const float r2 = rsqrtf(wave_sum(lane < 16 ? LDF(part2 + (size_t)t * 16) : 0.f) * (1.f / D) + EPS) * (1.0f / PU_SCALE);
        if (lane == 0) r2l[k] = r2; }
    LDS_WAIT(); asm volatile("" ::: "memory");
    const int nsteps = 8 * ntok;
#define STEP_DESC(q, tab, pos0) do { const int q_ = (q); if (q_ < nsteps) { (tab) = PU; (pos0) = ((q_ >> 5) * 4 + (q_ & 3)) * 128 + 16 * ((q_ >> 2) & 7); } \
        else if (q_ < 2 * nsteps) { const int qq_ = q_ - nsteps; (tab) = PV; (pos0) = ((qq_ >> 4) * 2 + (qq_ & 1)) * 128 + 16 * ((qq_ >> 1) & 7); } else { (tab) = PV; (pos0) = 0; } } while (0)
    constexpr int LOOK = 1;
    Row6 buf[8 * LOOK];
    pg8::u32x4 hhi[4];
#define CONVERT_GRP(g_) do { LAS unsigned char* img = wl_ + 12800; const int c16 = lane & 15, q4 = lane >> 4; \
      _Pragma("unroll") for (int k = 0; k < 4; ++k) { const int tt_ = t0 + (4 * (g_) + k) * tstep; \
          const pg8::u32x4 h0 = *(const pg8::u32x4*)((const char*)(H2B + (size_t)tt_ * D) + lane * 32), h1 = *(const pg8::u32x4*)((const char*)(H2B + (size_t)tt_ * D) + lane * 32 + 16); \
          float hf[16]; \
          _Pragma("unroll") for (int j = 0; j < 4; ++j) { hf[2 * j] = __builtin_bit_cast(float, h0[j] << 16); hf[2 * j + 1] = __builtin_bit_cast(float, h0[j] & 0xffff0000u); hf[8 + 2 * j] = __builtin_bit_cast(float, h1[j] << 16); hf[8 + 2 * j + 1] = __builtin_bit_cast(float, h1[j] & 0xffff0000u); } \
          pg8::u32x4 hiw; \
          _Pragma("unroll") for (int w = 0; w < 4; ++w) { int p = __builtin_amdgcn_cvt_pk_fp8_f32(hf[4 * w], hf[4 * w + 1], 0, false); p = __builtin_amdgcn_cvt_pk_fp8_f32(hf[4 * w + 2], hf[4 * w + 3], p, true); \
              hiw[w] = (unsigned)p; } \
          *(LAS pg8::u32x4*)(img + lane * 16) = hiw; \
          LDS_WAIT(); asm volatile("" ::: "memory"); \
          const int off = 32 * c16 + 512 * (q4 >> 1) + 16 * (q4 & 1); \
          hhi[k] = *(const LAS pg8::u32x4*)(img + off); \
          LDS_WAIT(); asm volatile("" ::: "memory"); } } while (0)
#pragma unroll
    for (int i = 0; i < 8; ++i) { const int ri = sid[2 * i + (int)hsel]; LDROW(buf[i], PU, ri); }
#define TR_STEP(S) _Pragma("unroll") for (int i = 0; i < S; ++i) { const bool up_ = (lane & S) != 0; const float send = up_ ? r[i] : r[i + S], keep = up_ ? r[i + S] : r[i]; r[i] = keep + __shfl_xor(send, S); }
#define U_STEP(q, B_, K_, G_) do { const int q__ = (q); const int ub_ = (B_); constexpr int uk_ = (K_); const int tk_ = 4 * (G_) + uk_; \
        const unsigned char* ntab; int npos; STEP_DESC(q__ + LOOK, ntab, npos); npos += (int)hsel; \
        const v8i_t AAh = {(int)hhi[uk_][0], (int)hhi[uk_][1], (int)hhi[uk_][2], (int)hhi[uk_][3], 0, 0, 0, 0}; \
        const v8i_t ABh = {0, 0, 0, 0, (int)hhi[uk_][0], (int)hhi[uk_][1], (int)hhi[uk_][2], (int)hhi[uk_][3]}; \
        const int c16_ = lane & 15; const bool dg_ = (lane >> 4) == (c16_ >> 2); \
        float r[16]; \
        _Pragma("unroll") for (int i2 = 0; i2 < 8; ++i2) { \
            const v8i_t B6 = {(int)buf[i2].a[0], (int)buf[i2].a[1], (int)buf[i2].a[2], (int)buf[i2].a[3], (int)buf[i2].b[0], (int)buf[i2].b[1], 0, 0}; \
            const v4f_t z4 = {0.f, 0.f, 0.f, 0.f}; \
            v4f_t cA = __builtin_amdgcn_mfma_scale_f32_16x16x128_f8f6f4(AAh, B6, z4, 0, 2, 0, 127, 0, 127); \
            v4f_t cB = __builtin_amdgcn_mfma_scale_f32_16x16x128_f8f6f4(ABh, B6, z4, 0, 2, 0, 127, 0, 127); \
            const int ri = sid[npos + 2 * i2]; LDROW(buf[i2], ntab, ri); \
            const float a01 = (c16_ & 1) ? cA[1] : cA[0], a23 = (c16_ & 1) ? cA[3] : cA[2], b01 = (c16_ & 1) ? cB[1] : cB[0], b23 = (c16_ & 1) ? cB[3] : cB[2]; \
            r[2 * i2] = dg_ ? ((c16_ & 2) ? a23 : a01) : 0.f; r[2 * i2 + 1] = dg_ ? ((c16_ & 2) ? b23 : b01) : 0.f; \
            __builtin_amdgcn_sched_barrier(0); } \
        TR_STEP(8) TR_STEP(4) TR_STEP(2) TR_STEP(1) \
        float tot = r[0] + __shfl_xor(r[0], 16); tot += __shfl_xor(tot, 32); \
        const int pos = tk_ * 128 + 16 * ub_ + c16_; \
        const float a = tot * r2l[tk_]; \
        wl[pos] = 0.5f * a * (1.f + erff(a * 0.70710678118654752f)) * gsl[pos] * (1.0f / PV_SCALE); } while (0)
    if (ntok == 8) {
#pragma unroll 1
        for (int grp = 0; grp < 2; ++grp) {
            CONVERT_GRP(grp);
#pragma unroll 1
            for (int b = 0; b < 8; ++b) { const int q = grp * 32 + b * 4;
                U_STEP(q, b, 0, grp); U_STEP(q + 1, b, 1, grp); U_STEP(q + 2, b, 2, grp); U_STEP(q + 3, b, 3, grp); }
        }
    }
#undef CONVERT_GRP
#undef U_STEP
#undef TR_STEP
    LDS_WAIT(); asm volatile("" ::: "memory");
#define V_STEP(q, ACC, KT) do { const int q__ = (q); const int b = ((q__ - nsteps) >> 1) & 7; \
        const unsigned char* ntab; int npos; STEP_DESC(q__ + LOOK, ntab, npos); npos += (int)hsel; \
        const int wpos = (KT) * 128 + b * 16 + (int)hsel; \
        _Pragma("unroll") for (int i2 = 0; i2 < 8; ++i2) { \
            const v6u_t p = {buf[i2].a[0], buf[i2].a[1], buf[i2].a[2], buf[i2].a[3], buf[i2].b[0], buf[i2].b[1]}; \
            const float wv = wl[wpos + 2 * i2]; \
            { const v32f_t rv = __builtin_amdgcn_cvt_scalef32_pk32_f32_fp6(p, 1.0f); \
                const f32x2_t w2_ = {wv, wv}; _Pragma("unroll") for (int j = 0; j < 32; j += 2) { const f32x2_t r2_ = {rv[j], rv[j + 1]}; f32x2_t a2_ = {ACC[j], ACC[j + 1]}; a2_ = __builtin_elementwise_fma(r2_, w2_, a2_); ACC[j] = a2_[0]; ACC[j + 1] = a2_[1]; } } \
            const int ri = sid[npos + 2 * i2]; LDROW(buf[i2], ntab, ri); \
            asm volatile("" : "+v"(ACC[0]), "+v"(ACC[1]), "+v"(ACC[2]), "+v"(ACC[3]), "+v"(ACC[4]), "+v"(ACC[5]), "+v"(ACC[6]), "+v"(ACC[7]), "+v"(ACC[8]), "+v"(ACC[9]), "+v"(ACC[10]), "+v"(ACC[11]), "+v"(ACC[12]), "+v"(ACC[13]), "+v"(ACC[14]), "+v"(ACC[15])); \
            asm volatile("" : "+v"(ACC[16]), "+v"(ACC[17]), "+v"(ACC[18]), "+v"(ACC[19]), "+v"(ACC[20]), "+v"(ACC[21]), "+v"(ACC[22]), "+v"(ACC[23]), "+v"(ACC[24]), "+v"(ACC[25]), "+v"(ACC[26]), "+v"(ACC[27]), "+v"(ACC[28]), "+v"(ACC[29]), "+v"(ACC[30]), "+v"(ACC[31])); \
            __builtin_amdgcn_sched_barrier(0); } } while (0)
#define V_FINISH(ACC, KT, RA, RB) do { const int t = t0 + (KT) * tstep; \
        float fin[16]; \
        _Pragma("unroll") for (int j = 0; j < 16; ++j) { const float lo = ACC[j], hi = ACC[16 + j]; const float send = hsel ? lo : hi, keep = hsel ? hi : lo; fin[j] = keep + __shfl_xor(send, 32); } \
        float* orow = (float*)((char*)(out + (size_t)t * D) + eoff); float ss = 0.f; \
        _Pragma("unroll") for (int q = 0; q < 4; ++q) { fin[2 * q] += __builtin_bit_cast(float, RA[q] << 16); fin[2 * q + 1] += __builtin_bit_cast(float, RA[q] & 0xffff0000u); fin[8 + 2 * q] += __builtin_bit_cast(float, RB[q] << 16); fin[8 + 2 * q + 1] += __builtin_bit_cast(float, RB[q] & 0xffff0000u); } \
        _Pragma("unroll") for (int j = 0; j < 16; ++j) ss += fin[j] * fin[j]; \
        const float rr = rsqrtf(wave_sum(ss) * (1.f / D) + EPS); \
        _Pragma("unroll") for (int q = 0; q < 4; ++q) { const float4 g = fgq[q]; \
            *(float4*)(orow + q * 4) = make_float4(fin[4 * q] * rr * g.x, fin[4 * q + 1] * rr * g.y, fin[4 * q + 2] * rr * g.z, fin[4 * q + 3] * rr * g.w); } } while (0)
    const unsigned eoff = (g32 * 32u + hsel * 16u) * 4u;
    float4 fgq[4];
#pragma unroll
    for (int q = 0; q < 4; ++q) fgq[q] = *(const float4*)((const char*)(fg + q * 4) + eoff);
#pragma unroll 1
    for (int kp = 0; kp < ntok / 2; ++kp) { const int k0_ = 2 * kp, k1_ = 2 * kp + 1;
        const char* h0p = (const char*)(H2B + (size_t)(t0 + k0_ * tstep) * D) + eoff / 2; const char* h1p = (const char*)(H2B + (size_t)(t0 + k1_ * tstep) * D) + eoff / 2;
        const pg8::u32x4 ra0 = *(const pg8::u32x4*)h0p, rb0 = *(const pg8::u32x4*)(h0p + 16), ra1 = *(const pg8::u32x4*)h1p, rb1 = *(const pg8::u32x4*)(h1p + 16);
        __builtin_amdgcn_sched_barrier(0);
        float acc0[32], acc1[32];
#pragma unroll
        for (int j = 0; j < 32; ++j) { acc0[j] = 0.f; acc1[j] = 0.f; }
#pragma unroll 1
        for (int bb = 0; bb < 8; ++bb) { const int q = nsteps + 16 * kp + 2 * bb; V_STEP(q, acc0, k0_); V_STEP(q + 1, acc1, k1_); }
        V_FINISH(acc0, k0_, ra0, rb0);
        V_FINISH(acc1, k1_, ra1, rb1);
        __builtin_amdgcn_sched_barrier(0);
    }
#undef V_FINISH
#undef V_STEP
#undef STEP_DESC
#undef LDI
#undef LDF
#undef LDROW
}

typedef short v4i16_t __attribute__((ext_vector_type(4)));
typedef int v2i32_t __attribute__((ext_vector_type(2)));
typedef int v4i32_t __attribute__((ext_vector_type(4)));
DEVI bf16x8_t join_tr(v4i16_t lo, v4i16_t hh) { const v2i32_t a = __builtin_bit_cast(v2i32_t, lo), b = __builtin_bit_cast(v2i32_t, hh); const v4i32_t w = {a[0], a[1], b[0], b[1]}; return __builtin_bit_cast(bf16x8_t, w); }
DEVI float max3f(float a, float b, float c) { float r; asm("v_max3_f32 %0, %1, %2, %3" : "=v"(r) : "v"(a), "v"(b), "v"(c)); return r; }
DEVI float max2f(float a, float b) { float r; asm("v_max_f32_e32 %0, %1, %2" : "=v"(r) : "v"(a), "v"(b)); return r; }
DEVI void glds16(const void* gsrc, unsigned lds_dst) { unsigned keep;
    asm volatile("s_mov_b32 %0, m0\n\ts_mov_b32 m0, %2\n\ts_nop 0\n\tglobal_load_lds_dwordx4 %1, off\n\ts_mov_b32 m0, %0" : "=&s"(keep) : "v"(gsrc), "s"(lds_dst) : "memory"); }
#define LDSADDR(p) ((unsigned)__builtin_amdgcn_readfirstlane((int)(unsigned)(uintptr_t)(p)))
#define ATT_BAR(N) asm volatile("s_waitcnt vmcnt(" #N ") lgkmcnt(0)\n\ts_barrier" ::: "memory")
template <int DQK, int DV, int DSPLIT, int NSLOT, int PD, bool CAUSAL, bool STAG, int VAR = 0>
DEVI void attn_unit(LAS unsigned char* S, const bf16* Qu, int qpitch, const bf16* Ku, int kpitch, const bf16* Vu, int vpitch, bf16* Ou, int opitch, int NT, int qcb) {
    constexpr int NCH = DQK / 8, KSLOT = NCH * 1024, NVG = DV / 32, VSLOT = NVG * 4096, NRG = 8 / DSPLIT, DVW = DV / DSPLIT, NOD = DVW / 32, NKS = DQK / 16;
    constexpr int KOFF = 0, VOFF = NSLOT * KSLOT, WSF = VOFF + NSLOT * VSLOT;
    static_assert(NRG * 32 * DVW * 2 * DSPLIT <= NSLOT * KSLOT, "O staging reuses the K ring");
    static_assert(NSLOT >= PD + (STAG ? 2 : 1), "ring depth");
    int tid_ = threadIdx.x; asm volatile("" : "+v"(tid_));
    const int lane = tid_ & 63, wid = __builtin_amdgcn_readfirstlane(tid_ >> 6), r32 = lane & 31, hi = lane >> 5, rg = wid % NRG, dp = wid / NRG;
    const bool late = STAG && wid >= 4;
    LAS float* wsf = (LAS float*)(S + WSF) + wid * 64;
    const int nld = (NCH - wid + 7) / 8 + (NVG * 4 - wid + 7) / 8;
    const bf16* ksrc = Ku + (size_t)lane * kpitch;
    const bf16* vsrc = Vu + (size_t)(lane >> 2) * vpitch + (lane & 3) * 8;
#define ATT_DMA(t, slot) do { \
        _Pragma("unroll") for (int pc_ = 0; pc_ < (NCH + 7) / 8; ++pc_) { const int pc = wid + 8 * pc_; if (pc < NCH) \
            glds16(ksrc + (size_t)(t) * 64 * kpitch + pc * 8, LDSADDR(S + KOFF + (slot) * KSLOT + pc * 1024)); } \
        _Pragma("unroll") for (int pv_ = 0; pv_ < (NVG * 4 + 7) / 8; ++pv_) { const int pv = wid + 8 * pv_; if (pv < NVG * 4) \
            glds16(vsrc + (size_t)((t) * 64 + (pv & 3) * 16) * vpitch + (pv >> 2) * 32, LDSADDR(S + VOFF + (slot) * VSLOT + pv * 1024)); } } while (0)
    bf16x8_t qr[NKS];
#pragma unroll
    for (int ks = 0; ks < NKS; ++ks) qr[ks] = *(const bf16x8_t*)(Qu + (size_t)(32 * rg + r32) * qpitch + ks * 16 + hi * 8);
#pragma unroll
    for (int ks = 0; ks < NKS; ++ks) asm volatile("" : "+v"(qr[ks]));
#pragma unroll
    for (int t = 0; t < PD; ++t) if (t < NT) ATT_DMA(t, t);
    f32x16_t o[NOD];
#pragma unroll
    for (int dd = 0; dd < NOD; ++dd) o[dd] = f32x16_t{};
    float m = 0.f, l = 0.f; f32x16_t negm = f32x16_t{};
    const int tlast = CAUSAL ? qcb + (rg >> 1) : NT - 1;
    const LAS unsigned char* kbase = S + KOFF + hi * 1024 + r32 * 16;
    const LAS unsigned char* vbase = S + VOFF + ((lane >> 4) & 1) * 32 + (lane & 3) * 8 + (4 * hi + ((lane & 15) >> 2)) * 64 + dp * NOD * 4096;
    bf16x8_t pa[4];
#define ATT_QKSM(sl) do { const LAS unsigned char* kp = kbase + (sl) * KSLOT; \
            f32x16_t p0 = negm, p1 = negm; \
            _Pragma("unroll") for (int ks = 0; ks < NKS; ++ks) { const bf16x8_t a0 = *(const LAS bf16x8_t*)(kp + ks * 2048), a1 = *(const LAS bf16x8_t*)(kp + ks * 2048 + 512); \
                if (VAR != 2) { p0 = __builtin_amdgcn_mfma_f32_32x32x16_bf16(a0, qr[ks], p0, 0, 0, 0); p1 = __builtin_amdgcn_mfma_f32_32x32x16_bf16(a1, qr[ks], p1, 0, 0, 0); } else { p0[ks] += __builtin_bit_cast(float, (int)a0[0]); p1[ks] += __builtin_bit_cast(float, (int)a1[0]); } } \
            asm volatile("s_nop 15\n\ts_nop 7" : "+v"(p0), "+v"(p1)); \
            float rm = 0.f; \
            if (VAR != 1) { float a = max3f(p0[0], p0[1], p1[0]), b = max3f(p0[2], p0[3], p1[1]); a = max3f(a, p1[2], p1[3]); \
              _Pragma("unroll") for (int r = 4; r < 16; r += 4) { a = max3f(a, p0[r], p0[r + 1]); b = max3f(b, p0[r + 2], p0[r + 3]); a = max3f(a, p1[r], p1[r + 1]); b = max3f(b, p1[r + 2], p1[r + 3]); } \
              rm = max2f(a, b); rm = max2f(rm, __shfl_xor(rm, 32)); } \
            if (__any(rm > 0.f)) { \
                const float dl = fmaxf(rm, 0.f), alpha = __builtin_amdgcn_exp2f(-dl); m += dl; l *= alpha; \
                _Pragma("unroll") for (int r = 0; r < 16; ++r) { p0[r] -= dl; p1[r] -= dl; negm[r] = -m; } \
                if (hi == 0) wsf[r32] = alpha; \
                LDS_WAIT(); asm volatile("" ::: "memory"); \
                _Pragma("unroll") for (int r = 0; r < 16; ++r) { const float f = wsf[crow16(r, hi)]; \
                    _Pragma("unroll") for (int dd = 0; dd < NOD; ++dd) o[dd][r] *= f; } \
                LDS_WAIT(); asm volatile("" ::: "memory"); \
            } \
            float ls = 0.f; \
            if (VAR != 1) { _Pragma("unroll") for (int r = 0; r < 16; ++r) { p0[r] = __builtin_amdgcn_exp2f(p0[r]); p1[r] = __builtin_amdgcn_exp2f(p1[r]); ls += p0[r] + p1[r]; } } \
            l += ls; \
            _Pragma("unroll") for (int ks = 0; ks < 4; ++ks) { pg8::u32x4 w; \
                if (ks < 2) { w.x = pg8::cvt_pk_bf16(p0[8 * ks], p0[8 * ks + 1]); w.y = pg8::cvt_pk_bf16(p0[8 * ks + 2], p0[8 * ks + 3]); w.z = pg8::cvt_pk_bf16(p0[8 * ks + 4], p0[8 * ks + 5]); w.w = pg8::cvt_pk_bf16(p0[8 * ks + 6], p0[8 * ks + 7]); } \
                else { const int k2 = ks - 2; w.x = pg8::cvt_pk_bf16(p1[8 * k2], p1[8 * k2 + 1]); w.y = pg8::cvt_pk_bf16(p1[8 * k2 + 2], p1[8 * k2 + 3]); w.z = pg8::cvt_pk_bf16(p1[8 * k2 + 4], p1[8 * k2 + 5]); w.w = pg8::cvt_pk_bf16(p1[8 * k2 + 6], p1[8 * k2 + 7]); } \
                pa[ks] = __builtin_bit_cast(bf16x8_t, w); } } while (0)
#define ATT_PV(sl) do { const LAS unsigned char* vp = vbase + (sl) * VSLOT; \
            _Pragma("unroll") for (int dd = 0; dd < NOD; ++dd) \
                _Pragma("unroll") for (int ks = 0; ks < 4; ++ks) { \
                    const v4i16_t lo = __builtin_amdgcn_ds_read_tr16_b64_v4i16((LAS v4i16_t*)(vp + dd * 4096 + ks * 1024)); \
                    const v4i16_t hh = __builtin_amdgcn_ds_read_tr16_b64_v4i16((LAS v4i16_t*)(vp + dd * 4096 + ks * 1024 + 512)); \
                    const bf16x8_t vf = join_tr(lo, hh); \
                    if (VAR != 2) o[dd] = __builtin_amdgcn_mfma_f32_32x32x16_bf16(pa[ks], vf, o[dd], 0, 0, 0); else o[dd][ks] += __builtin_bit_cast(float, (int)vf[0] + (int)pa[ks][0]); } } while (0)
    int slot = 0, slot_prev = NSLOT - 1, slot_issue = PD % NSLOT;
    for (int t = 0; t < NT; ++t) {
        const int ahead = (t + PD - 1 < NT - 1 ? t + PD - 1 : NT - 1) - t;
        const int nwait = ahead * nld;
        if (nwait <= 0) ATT_BAR(0); else if (nwait == 2) ATT_BAR(2); else if (nwait == 3) ATT_BAR(3); else if (nwait == 4) ATT_BAR(4); else if (nwait == 6) ATT_BAR(6); else if (nwait == 8) ATT_BAR(8); else ATT_BAR(0);
        if (t + PD < NT) ATT_DMA(t + PD, slot_issue);
        if (!late) { if (t <= tlast) { ATT_QKSM(slot); ATT_PV(slot); } }
        else { if (t >= 1 && t - 1 <= tlast) ATT_PV(slot_prev); if (t <= tlast) ATT_QKSM(slot); }
        slot_prev = slot; slot = slot + 1 == NSLOT ? 0 : slot + 1; slot_issue = slot_issue + 1 == NSLOT ? 0 : slot_issue + 1;
    }
    if (late && tlast >= NT - 1) ATT_PV(slot_prev);
    l += __shfl_xor(l, 32);
    if (hi == 0) wsf[32 + r32] = l;
    ATT_BAR(0);
    LAS bf16* stg = (LAS bf16*)(S + KOFF) + wid * 32 * DVW;
#pragma unroll
    for (int r = 0; r < 16; ++r) { const int orow = crow16(r, hi); const float rl = __builtin_amdgcn_rcpf(wsf[32 + orow]);
#pragma unroll
        for (int dd = 0; dd < NOD; ++dd) stg[orow * DVW + dd * 32 + r32] = f2bf(o[dd][r] * rl); }
    LDS_WAIT(); asm volatile("" ::: "memory");
#pragma unroll
    for (int i = 0; i < DVW / 16; ++i) { const int idx = i * 64 + lane, row = idx / (DVW / 8), ch = idx % (DVW / 8);
        *(pg8::u32x4*)(Ou + (size_t)(32 * rg + row) * opitch + dp * DVW + ch * 8) = *(const LAS pg8::u32x4*)(stg + row * DVW + ch * 8); }
    ATT_BAR(0);
#undef ATT_DMA
#undef ATT_QKSM
#undef ATT_PV
}

typedef float f32x2_t __attribute__((ext_vector_type(2)));
DEVI unsigned cvtpk(float lo, float hi) { const f32x2_t v = {lo, hi}; const bf16x2_t b = __builtin_convertvector(v, bf16x2_t); return __builtin_bit_cast(unsigned, b); }
DEVI void attn_mla_unit(LAS unsigned char* S, const bf16* Qu, const bf16* Ku, const bf16* Vu, bf16* Ou, int NT, int qcb) {
    constexpr int NCH = 12, KSLOT = NCH * 1024, VSLOT = 8192, NSLOT = 4, NKS = 6, qpitch = 768, kpitch = 768, vpitch = 512, opitch = D;
    constexpr int KOFF = 0, VOFF = NSLOT * KSLOT, WSF = VOFF + NSLOT * VSLOT;
    int tid_ = threadIdx.x; asm volatile("" : "+v"(tid_));
    const int lane = tid_ & 63, wid = __builtin_amdgcn_readfirstlane(tid_ >> 6), r32 = lane & 31, hi = lane >> 5;
    LAS float* wsf = (LAS float*)(S + WSF) + wid * 64;
    const int nld = wid < 4 ? 3 : 2;
    const bf16* ksrc = Ku + (size_t)lane * kpitch;
    const bf16* vsrc = Vu + (size_t)(lane >> 2) * vpitch + (lane & 3) * 8;
#define MLA_DMA(t, slot) do { \
        glds16(ksrc + (size_t)(t) * 64 * kpitch + wid * 8, LDSADDR(S + KOFF + (slot) * KSLOT + wid * 1024)); \
        if (wid < 4) glds16(ksrc + (size_t)(t) * 64 * kpitch + (wid + 8) * 8, LDSADDR(S + KOFF + (slot) * KSLOT + (wid + 8) * 1024)); \
        glds16(vsrc + (size_t)((t) * 64 + (wid & 3) * 16) * vpitch + (wid >> 2) * 32, LDSADDR(S + VOFF + (slot) * VSLOT + wid * 1024)); } while (0)
#define MLA_BAR(nw) do { if ((nw) <= 0) ATT_BAR(0); else if ((nw) == 2) ATT_BAR(2); else if ((nw) == 3) ATT_BAR(3); else if ((nw) == 4) ATT_BAR(4); else ATT_BAR(6); } while (0)
#define SGB(mask, n) __builtin_amdgcn_sched_group_barrier(mask, n, 0)
    bf16x8_t qr[NKS];
#pragma unroll
    for (int ks = 0; ks < NKS; ++ks) qr[ks] = *(const bf16x8_t*)(Qu + (size_t)(32 * wid + r32) * qpitch + ks * 16 + hi * 8);
#pragma unroll
    for (int ks = 0; ks < NKS; ++ks) asm volatile("" : "+v"(qr[ks]));
    MLA_DMA(0, 0); MLA_DMA(1, 1); MLA_DMA(2, 2);
    f32x16_t o0 = f32x16_t{}, o1 = f32x16_t{};
    float m = 0.f, l = 0.f; f32x16_t negm = f32x16_t{};
    const int tlast = qcb + (wid >> 1);
    const LAS unsigned char* kbase = S + KOFF + hi * 1024 + r32 * 16;
    const LAS unsigned char* vbase = S + VOFF + ((lane >> 4) & 1) * 32 + (lane & 3) * 8 + (4 * hi + ((lane & 15) >> 2)) * 64;
    f32x16_t p0, p1;
#define MLA_ROWMAX(rm, q0, q1) do { float a_ = __builtin_fmaxf(__builtin_fmaxf(q0[0], q0[1]), q1[0]), b_ = __builtin_fmaxf(__builtin_fmaxf(q0[2], q0[3]), q1[1]); a_ = __builtin_fmaxf(__builtin_fmaxf(a_, q1[2]), q1[3]); \
        _Pragma("unroll") for (int r = 4; r < 16; r += 4) { a_ = __builtin_fmaxf(__builtin_fmaxf(a_, q0[r]), q0[r + 1]); b_ = __builtin_fmaxf(__builtin_fmaxf(b_, q0[r + 2]), q0[r + 3]); a_ = __builtin_fmaxf(__builtin_fmaxf(a_, q1[r]), q1[r + 1]); b_ = __builtin_fmaxf(__builtin_fmaxf(b_, q1[r + 2]), q1[r + 3]); } \
        rm = __builtin_fmaxf(a_, b_); rm = __builtin_fmaxf(rm, __shfl_xor(rm, 32)); } while (0)
#define MLA_MOVE(rm, q0, q1) do { if (__any(rm > 0.f)) { \
            const float dl = fmaxf(rm, 0.f), alpha = __builtin_amdgcn_exp2f(-dl); m += dl; l *= alpha; \
            _Pragma("unroll") for (int r = 0; r < 16; ++r) { q0[r] -= dl; q1[r] -= dl; negm[r] = -m; } \
            if (hi == 0) wsf[r32] = alpha; \
            LDS_WAIT(); asm volatile("" ::: "memory"); \
            _Pragma("unroll") for (int r = 0; r < 16; ++r) { const float f = wsf[crow16(r, hi)]; o0[r] *= f; o1[r] *= f; } \
            LDS_WAIT(); asm volatile("" ::: "memory"); } } while (0)
    MLA_BAR(2 * nld);
    MLA_DMA(3, 3);
    { const LAS unsigned char* kp = kbase; p0 = negm; p1 = negm;
#pragma unroll
      for (int ks = 0; ks < NKS; ++ks) { const bf16x8_t a0 = *(const LAS bf16x8_t*)(kp + ks * 2048), a1 = *(const LAS bf16x8_t*)(kp + ks * 2048 + 512);
          p0 = __builtin_amdgcn_mfma_f32_32x32x16_bf16(a0, qr[ks], p0, 0, 0, 0); p1 = __builtin_amdgcn_mfma_f32_32x32x16_bf16(a1, qr[ks], p1, 0, 0, 0); }
      float rm; MLA_ROWMAX(rm, p0, p1); MLA_MOVE(rm, p0, p1); }
    int kslot = 1, vslot = 0, islot = 3;
    for (int t = 0; t < NT; ++t) {
        if (t + 1 < NT) { const int young = (t + 2 < NT) ? 1 : 0; MLA_BAR(young * nld); } else ATT_BAR(0);
        if (t >= 1 && t + 3 < NT) MLA_DMA(t + 3, islot);
        if (t < tlast) {
            const LAS unsigned char* kp = kbase + kslot * KSLOT; const LAS unsigned char* vp = vbase + vslot * VSLOT;
            bf16x8_t kf[12];
#pragma unroll
            for (int ks = 0; ks < NKS; ++ks) { kf[2 * ks] = *(const LAS bf16x8_t*)(kp + ks * 2048); kf[2 * ks + 1] = *(const LAS bf16x8_t*)(kp + ks * 2048 + 512); }
            f32x16_t n0 = negm, n1 = negm; float ls = 0.f; pg8::u32x4 pw[4];
#pragma unroll
            for (int ks = 0; ks < NKS; ++ks) { n0 = __builtin_amdgcn_mfma_f32_32x32x16_bf16(kf[2 * ks], qr[ks], n0, 0, 0, 0); n1 = __builtin_amdgcn_mfma_f32_32x32x16_bf16(kf[2 * ks + 1], qr[ks], n1, 0, 0, 0); }
#pragma unroll
            for (int r = 0; r < 16; ++r) { p0[r] = __builtin_amdgcn_exp2f(p0[r]); p1[r] = __builtin_amdgcn_exp2f(p1[r]); }
#pragma unroll
            for (int r = 0; r < 16; r += 2) { ls += (p0[r] + p0[r + 1]) + (p1[r] + p1[r + 1]); }
#pragma unroll
            for (int ks = 0; ks < 2; ++ks) { pw[ks] = (pg8::u32x4){cvtpk(p0[8 * ks], p0[8 * ks + 1]), cvtpk(p0[8 * ks + 2], p0[8 * ks + 3]), cvtpk(p0[8 * ks + 4], p0[8 * ks + 5]), cvtpk(p0[8 * ks + 6], p0[8 * ks + 7])};
                pw[2 + ks] = (pg8::u32x4){cvtpk(p1[8 * ks], p1[8 * ks + 1]), cvtpk(p1[8 * ks + 2], p1[8 * ks + 3]), cvtpk(p1[8 * ks + 4], p1[8 * ks + 5]), cvtpk(p1[8 * ks + 6], p1[8 * ks + 7])}; }
            l += ls;
            SGB(0x100, 4);
#pragma unroll
            for (int i = 0; i < 12; ++i) { SGB(0x008, 1); SGB(0x002, 7); if (i < 8) SGB(0x100, 1); }
            __builtin_amdgcn_sched_barrier(0);
            v4i16_t vlo[8], vhi[8];
#pragma unroll
            for (int i = 0; i < 8; ++i) { vlo[i] = __builtin_amdgcn_ds_read_tr16_b64_v4i16((LAS v4i16_t*)(vp + (i >> 2) * 4096 + (i & 3) * 1024)); vhi[i] = __builtin_amdgcn_ds_read_tr16_b64_v4i16((LAS v4i16_t*)(vp + (i >> 2) * 4096 + (i & 3) * 1024 + 512)); }
#pragma unroll
            for (int i = 0; i < 8; ++i) { const bf16x8_t vf = join_tr(vlo[i], vhi[i]); const bf16x8_t pa_ = __builtin_bit_cast(bf16x8_t, pw[i & 3]);
                if (i < 4) o0 = __builtin_amdgcn_mfma_f32_32x32x16_bf16(pa_, vf, o0, 0, 0, 0); else o1 = __builtin_amdgcn_mfma_f32_32x32x16_bf16(pa_, vf, o1, 0, 0, 0); }
            float rm; MLA_ROWMAX(rm, n0, n1);
            SGB(0x100, 6);
#pragma unroll
            for (int i = 0; i < 8; ++i) { SGB(0x008, 1); SGB(0x002, 3); if (i < 5) SGB(0x100, 2); }
            __builtin_amdgcn_sched_barrier(0);
            MLA_MOVE(rm, n0, n1);
            p0 = n0; p1 = n1;
        } else if (t == tlast) {
            asm volatile("" : "+v"(p0), "+v"(p1));
            const LAS unsigned char* vp = vbase + vslot * VSLOT; float ls = 0.f; pg8::u32x4 pw[4];
#pragma unroll
            for (int r = 0; r < 16; ++r) { p0[r] = __builtin_amdgcn_exp2f(p0[r]); p1[r] = __builtin_amdgcn_exp2f(p1[r]); ls += p0[r] + p1[r]; }
            l += ls;
#pragma unroll
            for (int ks = 0; ks < 2; ++ks) { pw[ks] = (pg8::u32x4){cvtpk(p0[8 * ks], p0[8 * ks + 1]), cvtpk(p0[8 * ks + 2], p0[8 * ks + 3]), cvtpk(p0[8 * ks + 4], p0[8 * ks + 5]), cvtpk(p0[8 * ks + 6], p0[8 * ks + 7])};
                pw[2 + ks] = (pg8::u32x4){cvtpk(p1[8 * ks], p1[8 * ks + 1]), cvtpk(p1[8 * ks + 2], p1[8 * ks + 3]), cvtpk(p1[8 * ks + 4], p1[8 * ks + 5]), cvtpk(p1[8 * ks + 6], p1[8 * ks + 7])}; }
#pragma unroll
            for (int i = 0; i < 8; ++i) { const v4i16_t lo = __builtin_amdgcn_ds_read_tr16_b64_v4i16((LAS v4i16_t*)(vp + (i >> 2) * 4096 + (i & 3) * 1024)), hh = __builtin_amdgcn_ds_read_tr16_b64_v4i16((LAS v4i16_t*)(vp + (i >> 2) * 4096 + (i & 3) * 1024 + 512));
                const bf16x8_t vf = join_tr(lo, hh); const bf16x8_t pa_ = __builtin_bit_cast(bf16x8_t, pw[i & 3]);
                if (i < 4) o0 = __builtin_amdgcn_mfma_f32_32x32x16_bf16(pa_, vf, o0, 0, 0, 0); else o1 = __builtin_amdgcn_mfma_f32_32x32x16_bf16(pa_, vf, o1, 0, 0, 0); }
        }
        kslot = (kslot + 1) & 3; vslot = (vslot + 1) & 3; islot = (islot + 1) & 3;
    }
    l += __shfl_xor(l, 32);
    if (hi == 0) wsf[32 + r32] = l;
    ATT_BAR(0);
    LAS bf16* stg = (LAS bf16*)(S + KOFF) + wid * 32 * 64;
#pragma unroll
    for (int r = 0; r < 16; ++r) { const int orow = crow16(r, hi); const float rl = __builtin_amdgcn_rcpf(wsf[32 + orow]);
        stg[orow * 64 + r32] = f2bf(o0[r] * rl); stg[orow * 64 + 32 + r32] = f2bf(o1[r] * rl); }
    LDS_WAIT(); asm volatile("" ::: "memory");
#pragma unroll
    for (int i = 0; i < 4; ++i) { const int idx = i * 64 + lane, row = idx >> 3, ch = idx & 7;
        *(pg8::u32x4*)(Ou + (size_t)(32 * wid + row) * opitch + ch * 8) = *(const LAS pg8::u32x4*)(stg + row * 64 + ch * 8); }
    ATT_BAR(0);
#undef MLA_DMA
#undef MLA_BAR
#undef MLA_ROWMAX
#undef MLA_MOVE
#undef SGB
}

DEVI bool unit_of(int Mrows, int Ncols, int G, int c, int i, int& pm, int& pn) {
    const int nM = Mrows / 256, nN = Ncols / 256, nwg = nM * nN; const long Lq = (long)i * G + c; if (Lq >= nwg) return false;
    int wgid = (int)Lq; { const int q = nwg / 8, r = nwg % 8, xcd = wgid % 8, off = wgid / 8; wgid = (xcd < r ? xcd * (q + 1) : r * (q + 1) + (xcd - r) * q) + off; }
    const int nig = 8 * nN, gid = wgid / nig, fm = gid * 8, gsz = (nM - fm) < 8 ? (nM - fm) : 8;
    pm = fm + ((wgid % nig) % gsz); pn = (wgid % nig) / gsz; return true;
}
DEVI void own_writes_visible() {
    asm volatile("s_waitcnt vmcnt(0)" ::: "memory"); __syncthreads();
    if (threadIdx.x == 0) { __builtin_amdgcn_fence(__ATOMIC_ACQUIRE, "agent"); asm volatile("s_waitcnt vmcnt(0)" ::: "memory"); }
    __syncthreads();
}

__global__ void __launch_bounds__(NTHR, 2) mega(Args args) {
    extern __shared__ __attribute__((aligned(16))) unsigned char lds[];
    const int tid = threadIdx.x, lane = tid & 63, wave = __builtin_amdgcn_readfirstlane(tid >> 6);
    const int G = gridDim.x, bx = blockIdx.x; const int vcu = (G % 8 == 0) ? (bx % 8) * (G / 8) + bx / 8 : bx;
    LAS unsigned char* L = (LAS unsigned char*)lds + PH_BASE;
    volatile LAS unsigned* MISC = (volatile LAS unsigned*)((LAS unsigned char*)lds + LDSCTL_OFF + 320);
    unsigned char* ws = args.ws; gu32* ctl = (gu32*)(ws + WS_CTL);
    if (tid < PH_BASE / 4) ((LAS unsigned*)(lds))[tid] = 0u;
    __syncthreads();
    XcdBarrier bar = xcd_barrier_post((unsigned*)(ctl + CW_BAR) + args.li * XCD_BAR_WORDS, MISC + 8);
    const unsigned mask = args.mask;
#define IN(k) ((mask >> (k)) & 1u)
#ifndef PROBE_ATTVAR
#define PROBE_ATTVAR 0
#endif
#ifndef PROBE_EXPVAR
#define PROBE_EXPVAR 0
#endif
#ifndef PROBE_REP
#define PROBE_REP 0u
#endif
#define NREP(k) (1 + (int)((PROBE_REP >> (k)) & 1u))
#define SEAM(k) do { if ((mask & ((1u << PH_N) - 1u)) >> ((k) + 1)) xcd_barrier(bar); } while (0)
    const float* x = args.in[0]; float* out = args.out;
    bf16 *Wt_in = (bf16*)(ws + WS_WIN), *Wt_qup = (bf16*)(ws + WS_WQUP), *Wt_kv = (bf16*)(ws + WS_WKV), *Wt_mix = (bf16*)(ws + WS_WMIX), *Wt_mq = (bf16*)(ws + WS_WMQ), *Wt_mkv = (bf16*)(ws + WS_WMKV),
         *Wt_mo = (bf16*)(ws + WS_WMO), *Wt_pq = (bf16*)(ws + WS_WPQ), *SK = (bf16*)(ws + WS_SK), *MEMN = (bf16*)(ws + WS_MEMN), *MEMKV = (bf16*)(ws + WS_MEMKV), *PU = (bf16*)(ws + WS_PU), *PV = (bf16*)(ws + WS_PV);
    float *partq = (float*)(ws + WS_PARTQ), *partkv = (float*)(ws + WS_PARTKV), *part1 = (float*)(ws + WS_PART1), *part2 = (float*)(ws + WS_PART2), *trig = (float*)(ws + WS_TRIG);
    bf16 *XN = (bf16*)(ws + WS_R1), *CONCAT = XN, *QM = XN, *H2B = XN;
    bf16 *CQ = (bf16*)(ws + WS_R2 + R2_CQ), *CKV = (bf16*)(ws + WS_R2 + R2_CKV), *U = (bf16*)(ws + WS_R2 + R2_U), *H1B = (bf16*)(ws + WS_R2), *OM = (bf16*)(ws + WS_R3);
    bf16 *QB = (bf16*)(ws + WS_R3 + R3_QB), *KB = (bf16*)(ws + WS_R3 + R3_KB), *VB = (bf16*)(ws + WS_R3 + R3_VB), *QP = (bf16*)(ws + WS_R3);


    if (IN(PH_PRO)) {
        for (int rep_ = 0; rep_ < NREP(PH_PRO); ++rep_) { if (rep_) xcd_barrier(bar);
        LAS float* scr = (LAS float*)(L + wave * 16384);
        const int gw = vcu * NWAVES + wave, NGW = G * NWAVES;
        constexpr int I_IN = (D / 64) * (INP / 32), I_QUP = (256 / 64) * (768 / 32), I_KV = (128 / 64) * (1024 / 32), I_SQ = (D / 64) * (D / 32), I_W2 = (D / 64) * (2048 / 32);
        constexpr int NITEMS = I_IN + I_QUP + I_KV + 2 * I_SQ + 2 * I_W2;
        for (int rp_ = 0; rp_ < 1 + (int)((PROBE_REP >> 20) & 1u); ++rp_)
        for (int it = gw; it < NITEMS; it += NGW) {
            int r = it;
            if (r < I_IN) { p0_transpose_item<1, false>(args.in[3], D, INC, Wt_in, INP, nullptr, scr, r, lane); continue; } r -= I_IN;
            if (r < I_QUP) { p0_transpose_item<0, true>(args.in[5], 256, 768, Wt_qup, 768, args.in[4], scr, r, lane); continue; } r -= I_QUP;
            if (r < I_KV) { p0_transpose_item<2, true>(args.in[7], 128, 1024, Wt_kv, 1024, args.in[6], scr, r, lane); continue; } r -= I_KV;
            if (r < I_SQ) { p0_transpose_item<0, false>(args.in[12], D, D, Wt_mix, D, nullptr, scr, r, lane); continue; } r -= I_SQ;
            if (r < I_SQ) { p0_transpose_item<0, false>(args.in[17], D, D, Wt_mo, D, nullptr, scr, r, lane); continue; } r -= I_SQ;
            if (r < I_W2) { p0_transpose_item<0, false>(args.in[16], D, 2048, Wt_mkv, 2048, nullptr, scr, r, lane); continue; } r -= I_W2;
            p0_transpose_item<0, true>(args.in[19], D, 2048, Wt_pq, 2048, args.in[18], scr, r, lane);
        }
        for (int rp_ = 0; rp_ < 1 + (int)((PROBE_REP >> 21) & 1u); ++rp_)
        for (int m = gw; m < M; m += 4 * NGW) rms_rows4_to_bf16(x, args.in[2], XN, m, NGW, M, lane);
        for (int m = gw; m < BATCH * NMEM; m += NGW) rms_row_to_bf16(args.in[1] + (size_t)m * D, args.in[14], MEMN + (size_t)m * D, lane);
        const size_t gtid = (size_t)vcu * NTHR + tid, gn = (size_t)G * NTHR;
        cvt_stream(args.in[20], SK, (size_t)PH * 2 * PNK * PHALF / 8, nullptr, gtid, gn);
        for (size_t i = gtid; i < (size_t)D * D / 8; i += gn) {
            const float4 a = *(const float4*)(args.in[15] + i * 8), b = *(const float4*)(args.in[15] + i * 8 + 4); const float gk = args.in[13][(i * 8) >> 10];
            pg8::u32x4 o; o.x = pg8::cvt_pk_bf16(a.x * gk, a.y * gk); o.y = pg8::cvt_pk_bf16(a.z * gk, a.w * gk); o.z = pg8::cvt_pk_bf16(b.x * gk, b.y * gk); o.w = pg8::cvt_pk_bf16(b.z * gk, b.w * gk);
            *(pg8::u32x4*)(Wt_mq + i * 8) = o; }
        for (int rp_ = 0; rp_ < 1 + (int)((PROBE_REP >> 22) & 1u); ++rp_) {
        cvt_rows_fp6<true>(args.in[21], (unsigned char*)PU, args.in[18], PU_SCALE, gtid, gn);
        cvt_rows_fp6<false>(args.in[22], (unsigned char*)PV, nullptr, PV_SCALE, gtid, gn); }
        for (size_t i = gtid; i < (size_t)SEQ * 16; i += gn) { float c, s; rope_cs((int)(i >> 4), (int)(i & 15), c, s); *(float2*)(trig + i * 2) = make_float2(c, s); }
        }
        SEAM(PH_PRO);
    }
    if (IN(PH_PROJ)) {
        for (int rep_ = 0; rep_ < NREP(PH_PROJ); ++rep_) { if (rep_) xcd_barrier(bar);
        { pg8::Gemm g{XN, Wt_in, M, INP, D, 0, 0, 0, 0}; pg8::StaticOrder S; S.init(M, INP, G, bx); pg8::EpiProj E{CQ, CKV, KB, U, partq, partkv, trig};
          pg8::gemm_phase<pg8::EpiProj, pg8::StaticOrder, true, true>(L, g, S, E); }
        { pg8::Gemm g{MEMN, Wt_mkv, BATCH * NMEM, 2048, D, 0, 0, 0, 0}; pg8::StaticOrder S; S.init(BATCH * NMEM, 2048, G, (bx + 128) % G); pg8::EpiPlain E{MEMKV, 2048};
          pg8::gemm_phase<pg8::EpiPlain, pg8::StaticOrder, true, true>(L, g, S, E); }
        }
        SEAM(PH_PROJ);
    }
    if (IN(PH_UP)) {
        for (int rep_ = 0; rep_ < NREP(PH_UP); ++rep_) { if (rep_) xcd_barrier(bar);
        if (IN(PHB_UPG)) {
        { pg8::Gemm g{CQ, Wt_qup, M, 768, 256, 0, 0, 0, 0}; pg8::StaticOrder S; S.init(M, 768, G, bx); pg8::EpiQ E{QB, partq, trig, LOG2E * 0.10206207261596577f};
          pg8::gemm_phase<pg8::EpiQ, pg8::StaticOrder, true, true>(L, g, S, E); }
        { pg8::Gemm g{CKV, Wt_kv, M, 1024, 128, 0, 0, 0, 0}; pg8::StaticOrder S; S.init(M, 1024, G, (bx + 192) % G); pg8::EpiKV E{KB, VB, partkv};
          pg8::gemm_phase<pg8::EpiKV, pg8::StaticOrder, true, true>(L, g, S, E); }
        }
        if (IN(PHB_CONV)) { __syncthreads(); for (int c = vcu; c < M / 64; c += G) conv_chunk(c, U, args.in[8], args.in[9], args.in[10], args.in[11], CONCAT, L); }
        }
        SEAM(PH_UP);
    }
    if (IN(PH_ATTN)) {
        for (int rep_ = 0; rep_ < NREP(PH_ATTN); ++rep_) { if (rep_) xcd_barrier(bar);
        for (int u = vcu; u < 512; u += G) { const int bh = (u & 255) >> 4, sidx = u & 15, qb = u < 256 ? 31 - sidx : sidx, b = bh >> 3, h = bh & 7;
            const size_t r0 = (size_t)b * SEQ;
            if (NREP(PH_ATTN) > 1 && rep_ == 0) attn_unit<96, 64, 1, 4, 3, true, false, PROBE_ATTVAR>(L, QB + (r0 + qb * 256) * 768 + h * 96, 768, KB + r0 * 768 + h * 96, 768, VB + r0 * 512 + h * 64, 512, CONCAT + (r0 + qb * 256) * D + h * 64, D, 4 * qb + 4, 4 * qb);
            else attn_mla_unit(L, QB + (r0 + qb * 256) * 768 + h * 96, KB + r0 * 768 + h * 96, VB + r0 * 512 + h * 64, CONCAT + (r0 + qb * 256) * D + h * 64, 4 * qb + 4, 4 * qb); }
        }
        { bf16* KQT = (bf16*)(ws + WS_KQT); bf16* VOT = (bf16*)(ws + WS_VOT);
#pragma unroll 1
          for (int bh = 0; bh < BATCH * XH; ++bh) { const int b = bh >> 2, h = bh & 3;
            { pg8::Gemm g{MEMKV + (size_t)b * NMEM * 2048 + h * XD, Wt_mq + h * XD, NMEM, D, XD, 2048, D, 0, 0}; pg8::StaticOrder S; S.init(NMEM, D, G, (bx + 8 * bh) % G);
              pg8::EpiPlain E{KQT + (size_t)b * D * D + (size_t)h * XD * D, D}; pg8::gemm_phase<pg8::EpiPlain, pg8::StaticOrder, true, true>(L, g, S, E); }
            { pg8::Gemm g{Wt_mo + h * XD, MEMKV + (size_t)b * NMEM * 2048 + 1024 + h * XD, D, NMEM, XD, D, 2048, 0, 0}; pg8::StaticOrder S; S.init(D, NMEM, G, (bx + 8 * bh + 4) % G);
              pg8::EpiPlain E{VOT + (size_t)b * D * D + h * XD, D}; pg8::gemm_phase<pg8::EpiPlain, pg8::StaticOrder, true, true>(L, g, S, E); } } }
        SEAM(PH_ATTN);
    }
    if (IN(PH_MIX)) {
        for (int rep_ = 0; rep_ < NREP(PH_MIX); ++rep_) { if (rep_) xcd_barrier(bar);
        pg8::Gemm g{CONCAT, Wt_mix, M, D, D, 0, 0, 0, 0}; pg8::StaticOrder S; S.init(M, D, G, bx); pg8::EpiRes<false> E{x, nullptr, H1B, part1};
        pg8::gemm_phase<pg8::EpiRes<false>, pg8::StaticOrder, true, true>(L, g, S, E);
        }
        SEAM(PH_MIX);
    }
    if (IN(PH_MEMQ)) {
        for (int rep_ = 0; rep_ < NREP(PH_MEMQ); ++rep_) { if (rep_) xcd_barrier(bar);
        pg8::Gemm g{H1B, (const bf16*)(ws + WS_KQT), M, D, D, 0, 0, SEQ / 256, (size_t)D * D * 2}; pg8::StaticOrder S; S.init(M, D, G, bx);
        pg8::EpiSoftmaxP E{OM, D, part1, LOG2E / 16.0f, (LAS float*)(L + 131072)};
        pg8::gemm_phase<pg8::EpiSoftmaxP, pg8::StaticOrder, true, true>(L, g, S, E);
        }
        SEAM(PH_MEMQ);
    }
    if (IN(PH_MEMO)) {
        pg8::Gemm g{OM, (const bf16*)(ws + WS_VOT), M, D, D, 0, 0, SEQ / 256, (size_t)D * D * 2};   pg8::StaticOrder S; S.init(M, D, G, bx); pg8::EpiRes<true> E{nullptr, H1B, H2B, part2};
        pg8::gemm_phase<pg8::EpiRes<true>, pg8::StaticOrder, true, true>(L, g, S, E);
        SEAM(PH_MEMO);
    }
    if (IN(PH_PQ)) {
        for (int rep_ = 0; rep_ < NREP(PH_PQ); ++rep_) { if (rep_) xcd_barrier(bar);
        pg8::Gemm g{H2B, Wt_pq, M, 2048, D, 0, 0, 0, 0}; pg8::StaticOrder S; S.init(M, 2048, G, bx); pg8::EpiScaled E{QP, 2048, part2, 1.0f};
        pg8::gemm_phase<pg8::EpiScaled, pg8::StaticOrder, true, true>(L, g, S, E);
        own_writes_visible();
        int* EIDX = (int*)(ws + WS_R2 + R2_EIDX); float* EGATE = (float*)(ws + WS_R2 + R2_EGATE);
        LAS unsigned* scr = (LAS unsigned*)(L + 65536 + wave * 64 * 9 * 4);
        int hl = -1, upm, upn;
        for (int i = 0; unit_of(M, 2048, G, bx, i, upm, upn); ++i) { const int tb = upm, h = upn;
            if (h != hl) {
                __syncthreads();
                for (int pc = tid; pc < 4096; pc += NTHR) { const int p = pc >> 11, n = (pc >> 4) & 127, c = pc & 15;
                    *(LAS pg8::u32x4*)(L + p * 32768 + c * 2048 + n * 16) = *(const pg8::u32x4*)(SK + ((size_t)(h * 2 + p) * 128 + n) * 128 + c * 8); }
                __syncthreads(); hl = h; }
            const int token = tb * 256 + wave * 32 + (lane & 31);
            topk_wave(QP + (size_t)token * 2048 + h * 256, L, scr, EIDX + (size_t)token * 128 + h * 16, EGATE + (size_t)token * 128 + h * 16, lane); }
        __syncthreads();
        }
        SEAM(PH_PQ);
    }
    if (IN(PH_EXP)) {
        const int* EIDX = (const int*)(ws + WS_R2 + R2_EIDX); const float* EGATE = (const float*)(ws + WS_R2 + R2_EGATE);
#ifndef EXP_PREWARM
#define EXP_PREWARM 0
#endif
        if (EXP_PREWARM) {
            const pg8::u32x4* tb = (const pg8::u32x4*)PU; pg8::u32x4 x = {0u, 0u, 0u, 0u};
            for (size_t i = (size_t)vcu * NTHR + tid; i < (size_t)2 * PE * D / 16; i += (size_t)G * NTHR) { const pg8::u32x4 v = __builtin_nontemporal_load(tb + i); x ^= v; }
            if ((x[0] ^ x[1] ^ x[2] ^ x[3]) == 0x9e3779b9u && tid == 999) out[0] = 0.f;
        }
        for (int rep_ = NREP(PH_EXP) - 1; rep_ >= 0; --rep_) { float* dst = rep_ ? (float*)(ws + WS_R3) : out;
            if (rep_) { if (PROBE_EXPVAR != 5 || wave < 4) experts_wave<PROBE_EXPVAR == 5 ? 0 : PROBE_EXPVAR>(L + wave * EXP_LDS_WAVE, vcu * NWAVES + wave, G * NWAVES, H2B, part2, (const unsigned char*)PU, (const unsigned char*)PV, EIDX, EGATE, args.in[23], dst, lane); } else
            experts_wave<0>(L + wave * EXP_LDS_WAVE, vcu * NWAVES + wave, G * NWAVES, H2B, part2, (const unsigned char*)PU, (const unsigned char*)PV, EIDX, EGATE, args.in[23], dst, lane);
            if (rep_) xcd_barrier(bar); }
    }
#undef IN
#undef SEAM
}

#define FAST_MASK ((1u << PH_PRO) | (1u << PH_PROJ) | (1u << PH_UP) | (1u << PHB_UPG) | (1u << PHB_CONV) | (1u << PH_ATTN) | (1u << PH_MIX) | (1u << PH_MEMQ) | (1u << PH_MEMO) | (1u << PH_PQ) | (1u << PH_EXP))
extern "C" void kernel_launch(void* const* d_in, const int* in_sizes, int n_in, void* d_out, int out_size, void* d_ws, size_t ws_size, hipStream_t stream) {
    if (n_in != 24 || out_size != M * D || ws_size < WS_END) { fprintf(stderr, "kernel_launch: unexpected problem (n_in %d out %d ws %zu)\n", n_in, out_size, ws_size); return; }
    static int grid = 0;
    if (grid == 0) {
        int dev = 0, cus = 0, per_cu = 0;
        if (hipGetDevice(&dev) != hipSuccess || hipDeviceGetAttribute(&cus, hipDeviceAttributeMultiprocessorCount, dev) != hipSuccess) { grid = -1; return; }
        if (hipFuncSetAttribute((const void*)mega, hipFuncAttributeMaxDynamicSharedMemorySize, LDS_BYTES) != hipSuccess) { fprintf(stderr, "kernel_launch: hipFuncSetAttribute failed\n"); grid = -1; return; }
        if (hipOccupancyMaxActiveBlocksPerMultiprocessor(&per_cu, (const void*)mega, NTHR, LDS_BYTES) != hipSuccess || per_cu < 1) { fprintf(stderr, "kernel_launch: occupancy query says %d blocks per CU\n", per_cu); grid = -1; (void)hipGetLastError(); return; }
        grid = cus;
    }
    if (grid < 0) return;
    (void)hipMemsetAsync((char*)d_ws + WS_CTL, 0, CTL_ZERO_BYTES, stream);
    Args a{}; for (int i = 0; i < 24; ++i) a.in[i] = (const float*)d_in[i]; a.out = (float*)d_out; a.ws = (unsigned char*)d_ws; a.mask = FAST_MASK; a.li = 0;
    hipLaunchKernelGGL(mega, dim3(grid), dim3(NTHR), LDS_BYTES, stream, a);
}
```

```cpp
#include <hip/hip_runtime.h>
#include <cstdio>
#include <cstdint>

typedef unsigned short bf16;
#define DEVI __device__ __forceinline__

constexpr int D = 1024, BATCH = 2, SEQ = 8192, M = BATCH * SEQ;
constexpr int NMEM = 256;
constexpr int MH = 8, QRANK = 256, KVRANK = 128, NOPE = 64, ROPE = 32, VD = 64, QK = NOPE + ROPE;
constexpr int CW = 512, CK = 31;
constexpr int INC = QRANK + KVRANK + ROPE + 2 * CW;
constexpr int INP = 1536;
constexpr int XH = 4, XD = 256;
constexpr int PH = 8, PNK = 128, PHALF = 128, PTOP = 16, PE = PNK * PNK;
constexpr float EPS = 1e-6f;
constexpr float LOG2E = 1.4426950408889634f;
constexpr float PU_SCALE = 64.0f, PV_SCALE = 4.0f;

constexpr size_t MiB = 1u << 20;
constexpr size_t WS_CTL = 0;
constexpr size_t WS_WIN = 1 * MiB;
constexpr size_t WS_WQUP = 4 * MiB;
constexpr size_t WS_WKV = 5 * MiB;
constexpr size_t WS_WMIX = 6 * MiB;
constexpr size_t WS_WMQ = 8 * MiB;
constexpr size_t WS_WMKV = 10 * MiB;
constexpr size_t WS_WMO = 14 * MiB;
constexpr size_t WS_WPQ = 16 * MiB;
constexpr size_t WS_SK = 20 * MiB;
constexpr size_t WS_MEMN = 21 * MiB;
constexpr size_t WS_MEMKV = 22 * MiB;
constexpr size_t WS_PARTQ = 24 * MiB;
constexpr size_t WS_PARTKV = 24 * MiB + 512 * 1024;
constexpr size_t WS_PART1 = 25 * MiB;
constexpr size_t WS_PART2 = 26 * MiB;
constexpr size_t WS_PU = 28 * MiB;
constexpr size_t WS_PV = 60 * MiB;
constexpr size_t WS_R1 = 92 * MiB;
constexpr size_t WS_R2 = 124 * MiB;
constexpr size_t WS_R3 = 156 * MiB;
constexpr size_t WS_KQT = 220 * MiB;
constexpr size_t WS_VOT = 224 * MiB;
constexpr size_t WS_END = 228 * MiB;
constexpr size_t R2_CQ = 0, R2_CKV = 8 * MiB, R2_U = 12 * MiB;
constexpr size_t R2_EIDX = 0, R2_EGATE = 8 * MiB;
constexpr size_t R3_QB = 0, R3_KB = 24 * MiB, R3_VB = 48 * MiB;

DEVI bf16 f2bf(float f) { unsigned u = __builtin_bit_cast(unsigned, f); return (bf16)((u + 0x7fffu + ((u >> 16) & 1u)) >> 16); }
DEVI float bf2f(bf16 b) { return __builtin_bit_cast(float, (unsigned)b << 16); }
DEVI float dotbf(const bf16* a, const bf16* b, int K) {
    float s = 0.f;
    for (int k = 0; k < K; k += 8) {
        uint4 x = *(const uint4*)(a + k), y = *(const uint4*)(b + k);
        const unsigned xs[4] = {x.x, x.y, x.z, x.w}, ys[4] = {y.x, y.y, y.z, y.w};
#pragma unroll
        for (int i = 0; i < 4; ++i) {
            s += __builtin_bit_cast(float, xs[i] << 16) * __builtin_bit_cast(float, ys[i] << 16);
            s += __builtin_bit_cast(float, xs[i] & 0xffff0000u) * __builtin_bit_cast(float, ys[i] & 0xffff0000u);
        }
    }
    return s;
}
DEVI float wave_sum(float v) {
#pragma unroll
    for (int o = 1; o < 64; o <<= 1) v += __shfl_xor(v, o);
    return v;
}
DEVI float wave_max(float v) {
#pragma unroll
    for (int o = 1; o < 64; o <<= 1) v = fmaxf(v, __shfl_xor(v, o));
    return v;
}
DEVI void rope_cs(int pos, int i, float& c, float& s) {
    const float inv = exp2f(-(float)i * (13.287712379549449f / 16.0f));
    const float ang = (float)pos * inv;
    const double a = (double)ang; const double k = rint(a * 0.15915494309189535); const float r = (float)(a - k * 6.283185307179586);
    s = sinf(r); c = cosf(r);
}
DEVI int win_src(int r) {
    if (r < 416) return r;
    if (r < 512) return -1;
    const int t = (r - 512) >> 8, w = (r - 512) & 255, bj = w >> 7, j = w & 127, ch = 128 * t + j;
    return 416 + (bj ? CW : 0) + ch;
}
DEVI int wkv_src(int r) { return r < 512 ? (r >> 6) * 128 + (r & 63) : ((r - 512) >> 6) * 128 + 64 + ((r - 512) & 63); }

namespace pg8 {
#define PG8_LAS __attribute__((address_space(3)))
typedef unsigned short bf16_t;
typedef short bf16x8 __attribute__((ext_vector_type(8)));
typedef float f32x4 __attribute__((ext_vector_type(4)));
typedef unsigned u32x4 __attribute__((ext_vector_type(4)));
constexpr int BM = 256, BK = 64, HALF = 128, HTB = HALF * BK * 2  , STAGE_BYTES = 8 * HTB, NXCD = 8, WGM = 8;

__host__ __device__ __forceinline__ int lds_byte(int r, int c) { const int st = (r >> 4) * 2 + (c >> 5), rr = r & 15, cc = c & 31, ob = rr * 64 + cc * 2; return st * 1024 + (ob ^ (((ob >> 9) & 1) << 5)); }
__host__ __device__ __forceinline__ void stage_rc(int b, int& R, int& C) { const int st = b / 1024, sb = b % 1024, swz = sb ^ (((sb >> 9) & 1) << 5); R = (st >> 1) * 16 + swz / 64; C = (st & 1) * 32 + (swz % 64) / 2; }
__host__ __device__ __forceinline__ int perm32(int rho) { const int n = rho >> 4, i = rho & 15; return 8 * (i >> 2) + 4 * n + (i & 3); }

struct Unit { int pm, pn; };
struct Gemm { const bf16_t* A; const bf16_t* Bt; int M, N, K; int lda, ldb; int mb; size_t bstride; };

struct StaticOrder {
    int nM, nN, nwg, G, c;
    __host__ __device__ void init(int M, int N, int G_, int c_) { nM = M / BM; nN = N / BM; nwg = nM * nN; G = G_; c = c_; }
    __host__ __device__ bool next(int i, Unit& u) const {
        const long L = (long)i * G + c; if (L >= nwg) return false;
        int wgid = (int)L; { const int q = nwg / NXCD, r = nwg % NXCD, xcd = wgid % NXCD, off = wgid / NXCD; wgid = (xcd < r ? xcd * (q + 1) : r * (q + 1) + (xcd - r) * q) + off; }
        const int nig = WGM * nN, gid = wgid / nig, fm = gid * WGM, gsz = (nM - fm) < WGM ? (nM - fm) : WGM;
        u.pm = fm + ((wgid % nig) % gsz); u.pn = (wgid % nig) / gsz; return true;
    }
    __device__ __forceinline__ void a_ready(const Unit&) const {}
    __device__ __forceinline__ void done(const Unit&) const {}
};


typedef float f32x2 __attribute__((ext_vector_type(2)));
typedef unsigned u32x2 __attribute__((ext_vector_type(2)));
__device__ __forceinline__ unsigned cvt_pk_bf16(float lo, float hi) { unsigned r; asm volatile("v_cvt_pk_bf16_f32 %0, %1, %2" : "=v"(r) : "v"(lo), "v"(hi)); return r; }
__device__ __forceinline__ void st_bf4(bf16_t* p, f32x4 v) { u32x2 w; w.x = cvt_pk_bf16(v[0], v[1]); w.y = cvt_pk_bf16(v[2], v[3]); *(u32x2*)p = w; }
__device__ __forceinline__ float sq4(f32x4 v) { return (v[0] * v[0] + v[1] * v[1]) + (v[2] * v[2] + v[3] * v[3]); }
__device__ __forceinline__ float red_fq(float s) { s += __shfl_xor(s, 16); s += __shfl_xor(s, 32); return s; }

struct EpiProj {
    static constexpr bool PERM = false, AFTER_DRAIN = false;
    bf16_t *CQ, *CKV, *KB, *U; float *partq, *partkv; const float* trig;
    __device__ __forceinline__ void operator()(const f32x4 (&acc)[2][2][4][2], const Unit& u, int wr, int wc, int fr, int fq) const {
        const int row0 = u.pm * BM + wr * 64 + fr;
        if (u.pn == 0) {
#pragma unroll
            for (int ai = 0; ai < 2; ++ai)
#pragma unroll
                for (int m = 0; m < 4; ++m) { const int row = row0 + ai * HALF + m * 16; float s = 0.f;
#pragma unroll
                    for (int bj = 0; bj < 2; ++bj)
#pragma unroll
                        for (int n = 0; n < 2; ++n) { const f32x4 v = acc[ai][bj][m][n]; s += sq4(v); st_bf4(CQ + (size_t)row * 256 + bj * HALF + wc * 32 + n * 16 + fq * 4, v); }
                    s = red_fq(s); if (fq == 0) partq[(size_t)row * 4 + wc] = s; }
        } else if (u.pn == 1) {
            f32x4 tc0 = {0.f, 0.f, 0.f, 0.f}, tc1 = tc0, tn0 = tc0, tn1 = tc0;
            if (wc == 0) { const float* tp = trig + ((size_t)(row0 % SEQ) * 16 + fq * 4) * 2; tc0 = *(const f32x4*)tp; tc1 = *(const f32x4*)(tp + 4); }
#pragma unroll
            for (int i8 = 0; i8 < 8; ++i8) { const int ai = i8 >> 2, m = i8 & 3; const int row = row0 + ai * HALF + m * 16; float s = 0.f;
                if (wc == 0 && i8 < 7) { const int rown = row0 + ((i8 + 1) >> 2) * HALF + ((i8 + 1) & 3) * 16; const float* tp = trig + ((size_t)(rown % SEQ) * 16 + fq * 4) * 2; tn0 = *(const f32x4*)tp; tn1 = *(const f32x4*)(tp + 4); }
#pragma unroll
                for (int n = 0; n < 2; ++n) { const f32x4 v = acc[ai][0][m][n]; s += sq4(v); st_bf4(CKV + (size_t)row * 128 + wc * 32 + n * 16 + fq * 4, v); }
                s = red_fq(s); if (fq == 0) partkv[(size_t)row * 4 + wc] = s;
                if (wc == 0) { const f32x4 x1 = acc[ai][1][m][0], x2 = acc[ai][1][m][1]; const f32x4 t0 = tc0, t1 = tc1;
                    f32x4 o1, o2; o1[0] = x1[0] * t0[0] - x2[0] * t0[1]; o2[0] = x1[0] * t0[1] + x2[0] * t0[0]; o1[1] = x1[1] * t0[2] - x2[1] * t0[3]; o2[1] = x1[1] * t0[3] + x2[1] * t0[2];
                    o1[2] = x1[2] * t1[0] - x2[2] * t1[1]; o2[2] = x1[2] * t1[1] + x2[2] * t1[0]; o1[3] = x1[3] * t1[2] - x2[3] * t1[3]; o2[3] = x1[3] * t1[3] + x2[3] * t1[2];
                    u32x2 w1, w2; w1.x = cvt_pk_bf16(o1[0], o1[1]); w1.y = cvt_pk_bf16(o1[2], o1[3]); w2.x = cvt_pk_bf16(o2[0], o2[1]); w2.y = cvt_pk_bf16(o2[2], o2[3]);
#pragma unroll
                    for (int h = 0; h < 8; ++h) { *(u32x2*)(KB + (size_t)row * 768 + h * 96 + 64 + fq * 4) = w1; *(u32x2*)(KB + (size_t)row * 768 + h * 96 + 80 + fq * 4) = w2; } }
                tc0 = tn0; tc1 = tn1; asm volatile("" ::: "memory"); }
        } else {
            const int t = u.pn - 2;
#pragma unroll
            for (int ai = 0; ai < 2; ++ai)
#pragma unroll
                for (int m = 0; m < 4; ++m) { const int row = row0 + ai * HALF + m * 16;
#pragma unroll
                    for (int n = 0; n < 2; ++n) { const f32x4 val = acc[ai][0][m][n], gate = acc[ai][1][m][n]; f32x4 o;
#pragma unroll
                        for (int i = 0; i < 4; ++i) o[i] = val[i] * __builtin_amdgcn_rcpf(1.f + __expf(-gate[i]));
                        st_bf4(U + (size_t)row * 512 + t * 128 + wc * 32 + n * 16 + fq * 4, o); } }
        }
    }
};
struct EpiQ {
    static constexpr bool PERM = false, AFTER_DRAIN = false;
    bf16_t* QB; const float* partq; const float* trig; float c2;
    __device__ __forceinline__ void operator()(const f32x4 (&acc)[2][2][4][2], const Unit& u, int wr, int wc, int fr, int fq) const {
        const int row0 = u.pm * BM + wr * 64 + fr;
        const bool rope = ((u.pn * 8 + wc) % 3 == 2) || ((u.pn * 8 + 4 + wc) % 3 == 2);
        f32x4 ppc = *(const f32x4*)(partq + (size_t)row0 * 4), ppn = ppc;
        f32x4 tc0 = {0.f, 0.f, 0.f, 0.f}, tc1 = tc0, tn0 = tc0, tn1 = tc0;
        if (rope) { const float* tp = trig + ((size_t)(row0 % SEQ) * 16 + fq * 4) * 2; tc0 = *(const f32x4*)tp; tc1 = *(const f32x4*)(tp + 4); }
#pragma unroll
        for (int i8 = 0; i8 < 8; ++i8) { const int ai = i8 >> 2, m = i8 & 3; const int row = row0 + ai * HALF + m * 16;
            if (i8 < 7) { const int rown = row0 + ((i8 + 1) >> 2) * HALF + ((i8 + 1) & 3) * 16; ppn = *(const f32x4*)(partq + (size_t)rown * 4);
                if (rope) { const float* tp = trig + ((size_t)(rown % SEQ) * 16 + fq * 4) * 2; tn0 = *(const f32x4*)tp; tn1 = *(const f32x4*)(tp + 4); } }
            const float rs = rsqrtf(((ppc[0] + ppc[1]) + (ppc[2] + ppc[3])) * (1.f / 256.f) + EPS) * c2;
#pragma unroll
            for (int bj = 0; bj < 2; ++bj) { const int g = u.pn * 8 + bj * 4 + wc; bf16_t* dst = QB + (size_t)row * 768 + g * 32 + fq * 4;
                if (g % 3 != 2) { st_bf4(dst, acc[ai][bj][m][0] * rs); st_bf4(dst + 16, acc[ai][bj][m][1] * rs); }
                else { const f32x4 x1 = acc[ai][bj][m][0] * rs, x2 = acc[ai][bj][m][1] * rs; const f32x4 t0 = tc0, t1 = tc1;
                    f32x4 o1, o2; o1[0] = x1[0] * t0[0] - x2[0] * t0[1]; o2[0] = x1[0] * t0[1] + x2[0] * t0[0]; o1[1] = x1[1] * t0[2] - x2[1] * t0[3]; o2[1] = x1[1] * t0[3] + x2[1] * t0[2];
                    o1[2] = x1[2] * t1[0] - x2[2] * t1[1]; o2[2] = x1[2] * t1[1] + x2[2] * t1[0]; o1[3] = x1[3] * t1[2] - x2[3] * t1[3]; o2[3] = x1[3] * t1[3] + x2[3] * t1[2];
                    st_bf4(dst, o1); st_bf4(dst + 16, o2); } }
            ppc = ppn; tc0 = tn0; tc1 = tn1; asm volatile("" ::: "memory"); }
    }
};
struct EpiKV {
    static constexpr bool PERM = false, AFTER_DRAIN = false;
    bf16_t *KB, *VB; const float* partkv;
    __device__ __forceinline__ void operator()(const f32x4 (&acc)[2][2][4][2], const Unit& u, int wr, int wc, int fr, int fq) const {
        const int row0 = u.pm * BM + wr * 64 + fr;
        f32x4 ppc = *(const f32x4*)(partkv + (size_t)row0 * 4), ppn = ppc;
#pragma unroll
        for (int i8 = 0; i8 < 8; ++i8) { const int ai = i8 >> 2, m = i8 & 3; const int row = row0 + ai * HALF + m * 16;
            if (i8 < 7) { const int rown = row0 + ((i8 + 1) >> 2) * HALF + ((i8 + 1) & 3) * 16; ppn = *(const f32x4*)(partkv + (size_t)rown * 4); }
            const float rs = rsqrtf(((ppc[0] + ppc[1]) + (ppc[2] + ppc[3])) * (1.f / 128.f) + EPS);
#pragma unroll
            for (int bj = 0; bj < 2; ++bj)
#pragma unroll
                for (int n = 0; n < 2; ++n) { const int c = u.pn * BM + bj * HALF + wc * 32 + n * 16 + fq * 4; const f32x4 v = acc[ai][bj][m][n] * rs;
                    if (u.pn < 2) st_bf4(KB + (size_t)row * 768 + (c >> 6) * 96 + (c & 63), v); else st_bf4(VB + (size_t)row * 512 + (c - 512), v); }
            ppc = ppn; asm volatile("" ::: "memory"); }
    }
};
template <bool BF16RES> struct EpiRes {
    static constexpr bool PERM = false, AFTER_DRAIN = false;
    const float* res; const bf16_t* resb; bf16_t* outb; float* part;
    __device__ __forceinline__ f32x4 ldres(size_t off) const {
        if (BF16RES) { const u32x2 rb = *(const u32x2*)(resb + off); f32x4 r; r[0] = __builtin_bit_cast(float, rb.x << 16); r[1] = __builtin_bit_cast(float, rb.x & 0xffff0000u); r[2] = __builtin_bit_cast(float, rb.y << 16); r[3] = __builtin_bit_cast(float, rb.y & 0xffff0000u); return r; }
        return *(const f32x4*)(res + off); }
    __device__ __forceinline__ void operator()(const f32x4 (&acc)[2][2][4][2], const Unit& u, int wr, int wc, int fr, int fq) const {
        const int row0 = u.pm * BM + wr * 64 + fr; const int cb = u.pn * BM + wc * 32 + fq * 4;
        f32x4 rc[4], rn[4];
#pragma unroll
        for (int j = 0; j < 4; ++j) { rc[j] = ldres((size_t)row0 * 1024 + cb + (j >> 1) * HALF + (j & 1) * 16); rn[j] = rc[j]; }
#pragma unroll
        for (int i8 = 0; i8 < 8; ++i8) { const int ai = i8 >> 2, m = i8 & 3; const int row = row0 + ai * HALF + m * 16; float s = 0.f;
            if (i8 < 7) { const int rown = row0 + ((i8 + 1) >> 2) * HALF + ((i8 + 1) & 3) * 16;
#pragma unroll
                for (int j = 0; j < 4; ++j) rn[j] = ldres((size_t)rown * 1024 + cb + (j >> 1) * HALF + (j & 1) * 16); }
#pragma unroll
            for (int bj = 0; bj < 2; ++bj)
#pragma unroll
                for (int n = 0; n < 2; ++n) { const size_t off = (size_t)row * 1024 + cb + bj * HALF + n * 16;
                    const f32x4 v = acc[ai][bj][m][n] + rc[bj * 2 + n]; st_bf4(outb + off, v); s += sq4(v); }
            s = red_fq(s); if (fq == 0) part[(size_t)row * 16 + u.pn * 4 + wc] = s;
#pragma unroll
            for (int j = 0; j < 4; ++j) rc[j] = rn[j];
            asm volatile("" ::: "memory"); }
    }
};
struct EpiScaled {
    static constexpr bool PERM = false, AFTER_DRAIN = false;
    bf16_t* out; int ldc; const float* part; float mul;
    __device__ __forceinline__ void operator()(const f32x4 (&acc)[2][2][4][2], const Unit& u, int wr, int wc, int fr, int fq) const {
        const int row0 = u.pm * BM + wr * 64 + fr;
        float rs8[8];
#pragma unroll
        for (int hb = 0; hb < 2; ++hb) { f32x4 q[4][4];
#pragma unroll
            for (int k = 0; k < 4; ++k) { const int row = row0 + hb * HALF + k * 16; const f32x4* pp = (const f32x4*)(part + (size_t)row * 16);
#pragma unroll
                for (int j = 0; j < 4; ++j) q[k][j] = pp[j]; }
#pragma unroll
            for (int k = 0; k < 4; ++k) { const f32x4 a = q[k][0], b = q[k][1], c = q[k][2], d = q[k][3];
                const float ss = (((a[0] + a[1]) + (a[2] + a[3])) + ((b[0] + b[1]) + (b[2] + b[3]))) + (((c[0] + c[1]) + (c[2] + c[3])) + ((d[0] + d[1]) + (d[2] + d[3])));
                rs8[hb * 4 + k] = rsqrtf(ss * (1.f / 1024.f) + EPS) * mul; } }
#pragma unroll
        for (int i8 = 0; i8 < 8; ++i8) { const int ai = i8 >> 2, m = i8 & 3; const int row = row0 + ai * HALF + m * 16; const float rs = rs8[i8];
#pragma unroll
            for (int bj = 0; bj < 2; ++bj)
#pragma unroll
                for (int n = 0; n < 2; ++n) st_bf4(out + (size_t)row * ldc + u.pn * BM + bj * HALF + wc * 32 + n * 16 + fq * 4, acc[ai][bj][m][n] * rs);
            asm volatile("" ::: "memory"); }
    }
};
struct EpiSoftmaxP {
    static constexpr bool PERM = false, AFTER_DRAIN = false;
    bf16_t* out; int ldc; const float* part; float mul; PG8_LAS float* scr;
    __device__ __forceinline__ float rscale(int row) const { const f32x4* pp = (const f32x4*)(part + (size_t)row * 16); const f32x4 a = pp[0], b = pp[1], c = pp[2], d = pp[3];
        const float ss = (((a[0] + a[1]) + (a[2] + a[3])) + ((b[0] + b[1]) + (b[2] + b[3]))) + (((c[0] + c[1]) + (c[2] + c[3])) + ((d[0] + d[1]) + (d[2] + d[3]))); return rsqrtf(ss * (1.f / 1024.f) + EPS) * mul; }
    __device__ __forceinline__ void operator()(const f32x4 (&acc)[2][2][4][2], const Unit& u, int wr, int wc, int fr, int fq) const {
        PG8_LAS float* P1 = scr; PG8_LAS float* P2 = scr + 1024; float rs8[8];
#define EPS_BAR() do { asm volatile("s_waitcnt lgkmcnt(0)" ::: "memory"); __builtin_amdgcn_s_barrier(); asm volatile("" ::: "memory"); } while (0)
#pragma unroll
        for (int ai = 0; ai < 2; ++ai)
#pragma unroll
            for (int m = 0; m < 4; ++m) { float mx = -3.0e38f;
#pragma unroll
                for (int bj = 0; bj < 2; ++bj)
#pragma unroll
                    for (int n = 0; n < 2; ++n) { const f32x4 v = acc[ai][bj][m][n]; mx = fmaxf(mx, fmaxf(fmaxf(v[0], v[1]), fmaxf(v[2], v[3]))); }
                mx = fmaxf(mx, __shfl_xor(mx, 16)); mx = fmaxf(mx, __shfl_xor(mx, 32));
                if (fq == 0) P1[(ai * HALF + wr * 64 + m * 16 + fr) * 4 + wc] = mx; }
        EPS_BAR();
#pragma unroll
        for (int ai = 0; ai < 2; ++ai)
#pragma unroll
            for (int m = 0; m < 4; ++m) { const int rl = ai * HALF + wr * 64 + m * 16 + fr; const f32x4 q = *(const PG8_LAS f32x4*)(P1 + rl * 4);
                const float mx = fmaxf(fmaxf(q[0], q[1]), fmaxf(q[2], q[3])), rs = rscale(u.pm * BM + rl); float sm = 0.f; rs8[ai * 4 + m] = rs;
#pragma unroll
                for (int bj = 0; bj < 2; ++bj)
#pragma unroll
                    for (int n = 0; n < 2; ++n) { const f32x4 v = acc[ai][bj][m][n];
#pragma unroll
                        for (int i = 0; i < 4; ++i) sm += __builtin_amdgcn_exp2f((v[i] - mx) * rs); }
                sm += __shfl_xor(sm, 16); sm += __shfl_xor(sm, 32);
                if (fq == 0) P2[rl * 4 + wc] = sm; asm volatile("" ::: "memory"); }
        EPS_BAR();
#pragma unroll
        for (int ai = 0; ai < 2; ++ai)
#pragma unroll
            for (int m = 0; m < 4; ++m) { const int rl = ai * HALF + wr * 64 + m * 16 + fr; const f32x4 q = *(const PG8_LAS f32x4*)(P1 + rl * 4), w = *(const PG8_LAS f32x4*)(P2 + rl * 4);
                const float mx = fmaxf(fmaxf(q[0], q[1]), fmaxf(q[2], q[3])), rs = rs8[ai * 4 + m], inv = 1.0f / ((w[0] + w[1]) + (w[2] + w[3]));
#pragma unroll
                for (int bj = 0; bj < 2; ++bj)
#pragma unroll
                    for (int n = 0; n < 2; ++n) { const f32x4 v = acc[ai][bj][m][n]; f32x4 o;
#pragma unroll
                        for (int i = 0; i < 4; ++i) o[i] = __builtin_amdgcn_exp2f((v[i] - mx) * rs) * inv;
                        st_bf4(out + (size_t)(u.pm * BM + rl) * ldc + u.pn * BM + bj * HALF + wc * 32 + n * 16 + fq * 4, o); }
                asm volatile("" ::: "memory"); }
        EPS_BAR();
#undef EPS_BAR
    }
};
struct EpiPlain {
    static constexpr bool PERM = false, AFTER_DRAIN = false;
    bf16_t* out; int ldc;
    __device__ __forceinline__ void operator()(const f32x4 (&acc)[2][2][4][2], const Unit& u, int wr, int wc, int fr, int fq) const {
        const int row0 = u.pm * BM + wr * 64 + fr;
#pragma unroll
        for (int ai = 0; ai < 2; ++ai)
#pragma unroll
            for (int m = 0; m < 4; ++m) { const int row = row0 + ai * HALF + m * 16;
#pragma unroll
                for (int bj = 0; bj < 2; ++bj)
#pragma unroll
                    for (int n = 0; n < 2; ++n) st_bf4(out + (size_t)row * ldc + u.pn * BM + bj * HALF + wc * 32 + n * 16 + fq * 4, acc[ai][bj][m][n]); }
    }
};
template <class Epi, class Sched, bool ALIGN_EPI = false, bool SP2 = false>
__device__ __forceinline__ void gemm_phase(PG8_LAS unsigned char* lds, const Gemm g, const Sched& S, const Epi& E) {
    int tid_ = threadIdx.x; asm volatile("" : "+v"(tid_));
    const int tid = tid_, wid = __builtin_amdgcn_readfirstlane(tid >> 6), lane = tid & 63, wr = wid >> 2, wc = wid & 3, fr = lane & 15, fq = lane >> 4;
    const int K = g.K, nt = K / BK, lda = g.lda ? g.lda : K, ldb = g.ldb ? g.ldb : K;
#define PG8_BOFF(pm_) (g.mb ? (size_t)((pm_) / g.mb) * g.bstride : (size_t)0)
    unsigned voffA[2], voffB[2];
#pragma unroll
    for (int i = 0; i < 2; ++i) { int R, C; stage_rc(tid * 16 + i * 8192, R, C); const int Rb = Epi::PERM ? ((R & ~31) + perm32(R & 31)) : R;
        voffA[i] = (unsigned)(R * lda + C) * 2u; voffB[i] = (unsigned)(Rb * ldb + C) * 2u; }
    const size_t kstep = (size_t)(BK * 2);
    const size_t hstepA = (size_t)HALF * lda * 2, hstepB = (size_t)HALF * ldb * 2;
    const size_t tstepA = 2 * hstepA, tstepB = 2 * hstepB;
    const unsigned ldsw = (unsigned)wid * 1024u;
    const int aoff = lds_byte(wr * 64 + fr, fq * 8), boff = lds_byte(wc * 32 + fr, fq * 8);
#define PG8_SA(b, h) (((b) * 2 + (h)) * HTB)
#define PG8_SB(b, h) ((4 + (b) * 2 + (h)) * HTB)
#define PG8_STAGE(bufoff, gbase, voff) do { _Pragma("unroll") for (int _i = 0; _i < 2; ++_i) \
        __builtin_amdgcn_global_load_lds((const unsigned*)((const char*)(gbase) + (voff)[_i]), (PG8_LAS unsigned*)(lds + (bufoff) + ldsw + _i * 8192), 16, 0, 0); } while (0)
#define PG8_LDA(dst, b, h) do { _Pragma("unroll") for (int m = 0; m < 4; ++m) _Pragma("unroll") for (int k = 0; k < 2; ++k) dst[m][k] = *(const PG8_LAS bf16x8*)(lds + PG8_SA(b, h) + aoff + m * 2048 + k * 1024); } while (0)
#define PG8_LDB(dst, b, h) do { _Pragma("unroll") for (int n = 0; n < 2; ++n) _Pragma("unroll") for (int k = 0; k < 2; ++k) dst[n][k] = *(const PG8_LAS bf16x8*)(lds + PG8_SB(b, h) + boff + n * 2048 + k * 1024); } while (0)
#define PG8_MMA(ai, bj, At, Bt) do { __builtin_amdgcn_s_setprio(1); _Pragma("unroll") for (int m = 0; m < 4; ++m) _Pragma("unroll") for (int n = 0; n < 2; ++n) _Pragma("unroll") for (int k = 0; k < 2; ++k) \
        acc[ai][bj][m][n] = __builtin_amdgcn_mfma_f32_16x16x32_bf16(Bt[n][k], At[m][k], acc[ai][bj][m][n], 0, 0, 0); __builtin_amdgcn_s_setprio(0); } while (0)
#define PG8_WAIT_V(n) asm volatile("s_waitcnt vmcnt(" #n ")" ::: "memory")
#define PG8_WAIT_L(n) asm volatile("s_waitcnt lgkmcnt(" #n ")" ::: "memory")
#define PG8_BAR __builtin_amdgcn_s_barrier()
#define PG8_SCHED __builtin_amdgcn_sched_barrier(0)
    Unit cur, nxt; int ui = 0;
    if (!S.next(0, cur)) return;
    f32x4 acc[2][2][4][2];
#pragma unroll
    for (int a = 0; a < 2; ++a)
#pragma unroll
        for (int b = 0; b < 2; ++b)
#pragma unroll
            for (int m = 0; m < 4; ++m)
#pragma unroll
                for (int n = 0; n < 2; ++n) acc[a][b][m][n] = (f32x4){0.f, 0.f, 0.f, 0.f};
    bf16x8 At[4][2], B0[2][2], B1[2][2];
    const char* cA = (const char*)g.A + (size_t)cur.pm * tstepA; const char* cB = (const char*)g.Bt + (size_t)cur.pn * tstepB + PG8_BOFF(cur.pm);
    S.a_ready(cur);
    if constexpr (SP2) {
        PG8_STAGE(PG8_SB(0, 0), cB, voffB); PG8_STAGE(PG8_SB(0, 1), cB + hstepB, voffB); PG8_STAGE(PG8_SA(0, 0), cA, voffA); PG8_STAGE(PG8_SA(0, 1), cA + hstepA, voffA);
        if (wr == 1) PG8_BAR;
        PG8_WAIT_V(2); PG8_BAR;
        PG8_STAGE(PG8_SB(1, 0), cB + kstep, voffB); PG8_STAGE(PG8_SA(1, 0), cA + kstep, voffA); PG8_STAGE(PG8_SB(1, 1), cB + hstepB + kstep, voffB);
        PG8_WAIT_V(6); PG8_BAR;
    } else {
        PG8_STAGE(PG8_SB(0, 0), cB, voffB); PG8_STAGE(PG8_SA(0, 0), cA, voffA); PG8_STAGE(PG8_SB(0, 1), cB + hstepB, voffB); PG8_STAGE(PG8_SA(0, 1), cA + hstepA, voffA);
        if (wr == 1) PG8_BAR;
        PG8_WAIT_V(4); PG8_BAR;
        PG8_STAGE(PG8_SB(1, 0), cB + kstep, voffB); PG8_STAGE(PG8_SA(1, 0), cA + kstep, voffA); PG8_STAGE(PG8_SB(1, 1), cB + hstepB + kstep, voffB);
        PG8_WAIT_V(6); PG8_BAR;
    }
    for (;;) {
        const bool has_next = S.next(ui + 1, nxt);
        const char* nA = has_next ? (const char*)g.A + (size_t)nxt.pm * tstepA : cA; const char* nB = has_next ? (const char*)g.Bt + (size_t)nxt.pn * tstepB + PG8_BOFF(nxt.pm) : cB;
        for (int t = 0; t < nt; t += 2) {
            const bool last = (t == nt - 2);
            const char* a1 = cA + (size_t)(t + 1) * kstep;
            const char* a2 = last ? nA : cA + (size_t)(t + 2) * kstep; const char* b2 = last ? nB : cB + (size_t)(t + 2) * kstep;
            const char* a3 = a2 + kstep; const char* b3 = b2 + kstep;
            if (last && has_next) S.a_ready(nxt);
            if constexpr (SP2) {
            PG8_LDB(B0, 0, 0); PG8_LDB(B1, 0, 1); PG8_SCHED; PG8_LDA(At, 0, 0); PG8_STAGE(PG8_SA(1, 1), a1 + hstepA, voffA);
            PG8_WAIT_V(8); PG8_WAIT_L(0); PG8_BAR; PG8_MMA(0, 0, At, B0); PG8_MMA(0, 1, At, B1); PG8_BAR; PG8_SCHED;
            PG8_LDA(At, 0, 1); PG8_STAGE(PG8_SB(0, 0), b2, voffB); PG8_STAGE(PG8_SB(0, 1), b2 + hstepB, voffB); PG8_STAGE(PG8_SA(0, 0), a2, voffA);
            PG8_WAIT_V(8); PG8_WAIT_L(0); PG8_BAR; PG8_MMA(1, 0, At, B0); PG8_MMA(1, 1, At, B1); PG8_BAR; PG8_SCHED;
            PG8_LDB(B0, 1, 0); PG8_LDB(B1, 1, 1); PG8_SCHED; PG8_LDA(At, 1, 0); PG8_STAGE(PG8_SA(0, 1), a2 + hstepA, voffA);
            PG8_WAIT_V(8); PG8_WAIT_L(0); PG8_BAR; PG8_MMA(0, 0, At, B0); PG8_MMA(0, 1, At, B1); PG8_BAR; PG8_SCHED;
            PG8_LDA(At, 1, 1); PG8_STAGE(PG8_SB(1, 0), b3, voffB); PG8_STAGE(PG8_SB(1, 1), b3 + hstepB, voffB); PG8_STAGE(PG8_SA(1, 0), a3, voffA);
            PG8_WAIT_V(8); PG8_WAIT_L(0); PG8_BAR; PG8_MMA(1, 0, At, B0); PG8_MMA(1, 1, At, B1); PG8_BAR; PG8_SCHED;
            } else {
            PG8_LDB(B0, 0, 0); PG8_SCHED; PG8_LDA(At, 0, 0); PG8_STAGE(PG8_SA(1, 1), a1 + hstepA, voffA);
            PG8_WAIT_L(8); PG8_BAR; PG8_WAIT_L(0); PG8_MMA(0, 0, At, B0); PG8_BAR; PG8_SCHED;
            PG8_LDB(B1, 0, 1); PG8_STAGE(PG8_SB(0, 0), b2, voffB);
            PG8_BAR; PG8_WAIT_L(0); PG8_MMA(0, 1, At, B1); PG8_BAR;
            PG8_LDA(At, 0, 1); PG8_STAGE(PG8_SA(0, 0), a2, voffA);
            PG8_BAR; PG8_WAIT_L(0); PG8_MMA(1, 0, At, B0); PG8_BAR; PG8_SCHED;
            PG8_STAGE(PG8_SB(0, 1), b2 + hstepB, voffB);
            PG8_WAIT_V(6); PG8_BAR; PG8_MMA(1, 1, At, B1); PG8_BAR;
            PG8_LDB(B0, 1, 0); PG8_SCHED; PG8_LDA(At, 1, 0); PG8_STAGE(PG8_SA(0, 1), a2 + hstepA, voffA);
            PG8_WAIT_L(8); PG8_BAR; PG8_WAIT_L(0); PG8_MMA(0, 0, At, B0); PG8_BAR; PG8_SCHED;
            PG8_LDB(B1, 1, 1); PG8_STAGE(PG8_SB(1, 0), b3, voffB);
            PG8_BAR; PG8_WAIT_L(0); PG8_MMA(0, 1, At, B1); PG8_BAR;
            PG8_LDA(At, 1, 1); PG8_STAGE(PG8_SA(1, 0), a3, voffA);
            PG8_BAR; PG8_WAIT_L(0); PG8_MMA(1, 0, At, B0); PG8_BAR; PG8_SCHED;
            PG8_STAGE(PG8_SB(1, 1), b3 + hstepB, voffB);
            PG8_WAIT_V(6); PG8_BAR; PG8_MMA(1, 1, At, B1); PG8_BAR;
            }
        }
        if constexpr (ALIGN_EPI) { if (wr == 0) PG8_BAR; }
        if constexpr (!Epi::AFTER_DRAIN) { E(acc, cur, wr, wc, fr, fq); S.done(cur); }
        if (!has_next) break;
#pragma unroll
        for (int a = 0; a < 2; ++a)
#pragma unroll
            for (int b = 0; b < 2; ++b)
#pragma unroll
                for (int m = 0; m < 4; ++m)
#pragma unroll
                    for (int n = 0; n < 2; ++n) acc[a][b][m][n] = (f32x4){0.f, 0.f, 0.f, 0.f};
        cur = nxt; cA = nA; cB = nB; ++ui;
        if constexpr (ALIGN_EPI) { if (wr == 1) PG8_BAR; }
    }
    PG8_WAIT_V(0);
    if constexpr (!ALIGN_EPI) { if (wr == 0) PG8_BAR; }
    PG8_BAR;
    if constexpr (Epi::AFTER_DRAIN) { E.fused(acc, cur, wr, wc, fr, fq, lds, wid, lane); S.done(cur); }
#undef PG8_BOFF
#undef PG8_SA
#undef PG8_SB
#undef PG8_STAGE
#undef PG8_LDA
#undef PG8_LDB
#undef PG8_MMA
#undef PG8_WAIT_V
#undef PG8_WAIT_L
#undef PG8_BAR
#undef PG8_SCHED
}
}

#define GAS __attribute__((address_space(1)))
#define LAS __attribute__((address_space(3)))
typedef GAS unsigned gu32;
#define LDS_WAIT() asm volatile("s_waitcnt lgkmcnt(0)" ::: "memory")
#define VM_WAIT() asm volatile("s_waitcnt vmcnt(0)" ::: "memory")
constexpr int NWAVES = 8, NTHR = NWAVES * 64;
constexpr int LDSCTL_OFF = 0, PH_BASE = 512, LDS_BYTES = 147456;
constexpr int CW_BAR = 4096;
constexpr size_t CTL_ZERO_BYTES = 256 * 1024;
constexpr size_t WS_TRIG = 27 * MiB;
#define XB_TMO      128
#define XB_XCNT(j)  (256  + 64 * (j))
#define XB_XSUB(j)  (1280 + 64 * (j))
#define XB_XGEN(j)  (2304 + 64 * (j))
#define XB_TOP      3328
#define XB_TOPGEN   3392
#define XCD_BAR_WORDS 3456
#define XB_SPIN_CAP (1u << 18)

__device__ __forceinline__ unsigned xb_ld(unsigned* p)              { return __hip_atomic_load(p, __ATOMIC_RELAXED, __HIP_MEMORY_SCOPE_AGENT); }
__device__ __forceinline__ unsigned xb_add(unsigned* p, unsigned v) { return __hip_atomic_fetch_add(p, v, __ATOMIC_RELAXED, __HIP_MEMORY_SCOPE_AGENT); }
__device__ __forceinline__ unsigned xb_xcc_id() { return (unsigned)__builtin_amdgcn_s_getreg((3 << 11) | 20) & 0xFu; }
#define XB_SPIN(cond, bar) do { unsigned _sp = 0; while (cond) { __builtin_amdgcn_s_sleep(1); \
    if ((++_sp & 255u) == 0u) { if (xb_ld(&(bar)[XB_TMO])) break; if (_sp > XB_SPIN_CAP) { atomicAdd(&(bar)[XB_TMO], 1u); break; } } } } while (0)

struct XcdBarrier {
    unsigned* bar; unsigned x;
    volatile LAS unsigned* st;
};

__device__ __forceinline__ XcdBarrier xcd_barrier_post(unsigned* bar, volatile LAS unsigned* st) {
    XcdBarrier b; b.bar = bar; b.x = xb_xcc_id(); b.st = st;
    if (threadIdx.x == 0) (void)xb_add(&bar[XB_XCNT(b.x)], 1u);
    return b;
}
__device__ __forceinline__ void xcd_barrier_complete(unsigned* bar, unsigned x, unsigned& nloc, unsigned& nx) {
    const unsigned G = gridDim.x * gridDim.y * gridDim.z;
    unsigned sum, cnt, mine, sp = 0u;
    for (;;) {
        sum = 0u; cnt = 0u; mine = 0u;
#pragma unroll
        for (unsigned j = 0; j < 16; ++j) { const unsigned c = xb_ld(&bar[XB_XCNT(j)]); sum += c; cnt += (c > 0u) ? 1u : 0u; mine = (j == x) ? c : mine; }
        if (sum == G) break;
        __builtin_amdgcn_s_sleep(1);
        if ((++sp & 255u) == 0u) { if (xb_ld(&bar[XB_TMO])) break; if (sp > XB_SPIN_CAP) { atomicAdd(&bar[XB_TMO], 1u); break; } }
    }
    nloc = mine > 0u ? mine : 1u; nx = cnt > 0u ? cnt : 1u;
}

__device__ __forceinline__ void xcd_barrier(const XcdBarrier& b) {
    asm volatile("s_waitcnt vmcnt(0)" ::: "memory");
    __syncthreads();
    if (threadIdx.x == 0) {
        unsigned* bar = b.bar;
        __builtin_amdgcn_s_waitcnt(0);
        unsigned nloc = b.st[0], nx = b.st[1];
        if (nloc == 0u) { xcd_barrier_complete(bar, b.x, nloc, nx); b.st[0] = nloc; b.st[1] = nx; }
        const unsigned old = xb_add(&bar[XB_XSUB(b.x)], 1u);
        const unsigned gen = old / nloc;
        if (old + 1u == (gen + 1u) * nloc) {
            __builtin_amdgcn_fence(__ATOMIC_RELEASE, "agent");
            asm volatile("s_waitcnt vmcnt(0)" ::: "memory");
            const unsigned og = xb_add(&bar[XB_TOP], 1u);
            const unsigned tg = og / nx;
            if (og + 1u == (tg + 1u) * nx) xb_add(&bar[XB_TOPGEN], 1u);
            else XB_SPIN(xb_ld(&bar[XB_TOPGEN]) == tg, bar);
            __builtin_amdgcn_fence(__ATOMIC_ACQUIRE, "agent");
            xb_add(&bar[XB_XGEN(b.x)], 1u);
            asm volatile("s_waitcnt vmcnt(0)" ::: "memory");
        } else {
            XB_SPIN(xb_ld(&bar[XB_XGEN(b.x)]) == gen, bar);
            __builtin_amdgcn_fence(__ATOMIC_ACQUIRE, "agent");
            asm volatile("s_waitcnt vmcnt(0)" ::: "memory");
        }
    }
    __syncthreads();
}

enum { PH_PRO = 0, PH_PROJ, PH_UP, PH_ATTN, PH_MIX, PH_MEMQ, PH_XATTN, PH_MEMO, PH_PQ, PH_TOPK, PH_EXP, PH_N, PHB_CONV = 16, PHB_UPG = 17 };
struct Args { const float* in[24]; float* out; unsigned char* ws; unsigned mask; unsigned li; };

DEVI int src_col(int mode, int r) { return mode == 0 ? r : mode == 1 ? win_src(r) : wkv_src(r); }
template <int MODE, bool HASG> DEVI void p0_transpose_item(const float* W, int K, int N, bf16* WT, int NR, const float* gk, LAS float* scr, int item, int lane) {
    const int nb_ = NR / 32, kb = item / nb_, nb = item % nb_, k0 = 64 * kb, n0 = 32 * nb;
    const int sc = src_col(MODE, n0 + (lane & 31)), scc = sc < 0 ? 0 : sc; const float keep = sc < 0 ? 0.f : 1.f;
    float v[32];
#pragma unroll
    for (int i = 0; i < 32; ++i) { const int kk = 2 * i + (lane >> 5); v[i] = W[(size_t)(k0 + kk) * N + scc]; }
    if (HASG) {
#pragma unroll
        for (int i = 0; i < 32; ++i) { const int kk = 2 * i + (lane >> 5); v[i] *= gk[k0 + kk]; } }
#pragma unroll
    for (int i = 0; i < 32; ++i) { const int kk = 2 * i + (lane >> 5); scr[kk * 33 + (lane & 31)] = MODE == 0 ? v[i] : v[i] * keep; }
    LDS_WAIT(); asm volatile("" ::: "memory");
    const int c = lane & 7;
#pragma unroll
    for (int j = 0; j < 4; ++j) { const int n = (lane >> 3) + 8 * j; const LAS float* s = scr + (8 * c) * 33 + n;
        uint4 o; o.x = pg8::cvt_pk_bf16(s[0 * 33], s[1 * 33]); o.y = pg8::cvt_pk_bf16(s[2 * 33], s[3 * 33]); o.z = pg8::cvt_pk_bf16(s[4 * 33], s[5 * 33]); o.w = pg8::cvt_pk_bf16(s[6 * 33], s[7 * 33]);
        *(uint4*)(WT + (size_t)(n0 + n) * K + k0 + 8 * c) = o; }
    LDS_WAIT(); asm volatile("" ::: "memory");
}
DEVI void rms_row_to_bf16(const float* xrow, const float* g, bf16* orow, int lane) {
    const float4* xr = (const float4*)xrow + lane; const float4* gr = (const float4*)g + lane;
    float4 v[4]; float s = 0.f;
#pragma unroll
    for (int j = 0; j < 4; ++j) { v[j] = xr[64 * j]; s += (v[j].x * v[j].x + v[j].y * v[j].y) + (v[j].z * v[j].z + v[j].w * v[j].w); }
    const float r = rsqrtf(wave_sum(s) * (1.f / D) + EPS);
    uint2* o8 = (uint2*)orow + lane;
#pragma unroll
    for (int j = 0; j < 4; ++j) { const float4 gg = gr[64 * j]; uint2 o; o.x = pg8::cvt_pk_bf16(v[j].x * r * gg.x, v[j].y * r * gg.y); o.y = pg8::cvt_pk_bf16(v[j].z * r * gg.z, v[j].w * r * gg.w); o8[64 * j] = o; }
}
DEVI void rms_rows4_to_bf16(const float* x, const float* g, bf16* out, int m0, int step, int mend, int lane) {
    float4 v[4][4]; float s[4]; float4 gq[4];
#pragma unroll
    for (int j = 0; j < 4; ++j) gq[j] = ((const float4*)g + lane)[64 * j];
#pragma unroll
    for (int r = 0; r < 4; ++r) { const int m = m0 + r * step; const float4* xr = (const float4*)(x + (size_t)(m < mend ? m : m0) * D) + lane;
#pragma unroll
        for (int j = 0; j < 4; ++j) v[r][j] = xr[64 * j]; }
#pragma unroll
    for (int r = 0; r < 4; ++r) { float t = 0.f;
#pragma unroll
        for (int j = 0; j < 4; ++j) t += (v[r][j].x * v[r][j].x + v[r][j].y * v[r][j].y) + (v[r][j].z * v[r][j].z + v[r][j].w * v[r][j].w);
        s[r] = t; }
#pragma unroll
    for (int o = 1; o < 64; o <<= 1) {
#pragma unroll
        for (int r = 0; r < 4; ++r) s[r] += __shfl_xor(s[r], o); }
#pragma unroll
    for (int r = 0; r < 4; ++r) { const int m = m0 + r * step; if (m < mend) { const float rs = rsqrtf(s[r] * (1.f / D) + EPS); uint2* o8 = (uint2*)(out + (size_t)m * D) + lane;
#pragma unroll
        for (int j = 0; j < 4; ++j) { const float4 gg = gq[j]; uint2 o; o.x = pg8::cvt_pk_bf16(v[r][j].x * rs * gg.x, v[r][j].y * rs * gg.y); o.y = pg8::cvt_pk_bf16(v[r][j].z * rs * gg.z, v[r][j].w * rs * gg.w); o8[64 * j] = o; } } }
}
DEVI void cvt_stream_fp8(const float* src, unsigned char* dst, size_t n16, const float* g, float mul, size_t gtid, size_t gn) {
    for (size_t i = gtid; i < n16; i += gn) { pg8::u32x4 o;
#pragma unroll
        for (int q = 0; q < 4; ++q) { float4 a = *(const float4*)(src + i * 16 + q * 4); if (g) { const float4 gg = *(const float4*)(g + ((i * 16 + q * 4) & (D - 1))); a.x *= gg.x; a.y *= gg.y; a.z *= gg.z; a.w *= gg.w; }
            int p = __builtin_amdgcn_cvt_pk_fp8_f32(a.x * mul, a.y * mul, 0, false); p = __builtin_amdgcn_cvt_pk_fp8_f32(a.z * mul, a.w * mul, p, true); o[q] = (unsigned)p; }
        *(pg8::u32x4*)(dst + i * 16) = o; }
}
typedef unsigned v6u_t __attribute__((ext_vector_type(6)));
typedef float f32x2_t __attribute__((ext_vector_type(2)));
typedef float v16f_t __attribute__((ext_vector_type(16)));
typedef float v32f_t __attribute__((ext_vector_type(32)));
typedef __bf16 v32bf_t __attribute__((ext_vector_type(32)));
#ifndef FP6_INTERLEAVED
#define FP6_INTERLEAVED 0
#endif
template <bool HASG> DEVI void cvt_rows_fp6(const float* src, unsigned char* dst, const float* g, float mul, size_t gtid, size_t gn) {
    const int grp = (int)(gtid & 31);
    float4 gg[8];
#pragma unroll
    for (int q = 0; q < 8; ++q) { gg[q] = HASG ? *(const float4*)(g + grp * 32 + q * 4) : make_float4(1.f, 1.f, 1.f, 1.f); gg[q].x *= mul; gg[q].y *= mul; gg[q].z *= mul; gg[q].w *= mul; }
    for (size_t i0 = gtid; i0 < (size_t)PE * 32; i0 += 2 * gn) {
        float4 v[2][8];
#pragma unroll
        for (int u = 0; u < 2; ++u) { const size_t i = i0 + u * gn; if (i < (size_t)PE * 32) { const float* sp = src + (i >> 5) * D + (i & 31) * 32;
#pragma unroll
            for (int q = 0; q < 8; ++q) v[u][q] = *(const float4*)(sp + q * 4); } }
#pragma unroll
        for (int u = 0; u < 2; ++u) { const size_t i = i0 + u * gn; if (i < (size_t)PE * 32) { const size_t row = i >> 5;
            v16f_t a, b;
#pragma unroll
            for (int q = 0; q < 8; ++q) { const float4 x = v[u][q]; a[2 * q] = x.x * gg[q].x; b[2 * q] = x.y * gg[q].y; a[2 * q + 1] = x.z * gg[q].z; b[2 * q + 1] = x.w * gg[q].w; }
            const v6u_t p = __builtin_amdgcn_cvt_scalef32_2xpk16_fp6_f32(a, b, 1.0f);
            *(pg8::u32x4*)(dst + row * 768 + grp * 16) = (pg8::u32x4){p[0], p[1], p[2], p[3]};
            *(pg8::u32x2*)(dst + row * 768 + 512 + grp * 8) = (pg8::u32x2){p[4], p[5]}; } }
    }
}
DEVI void cvt_stream(const float* src, bf16* dst, size_t n8, const float* g, size_t gtid, size_t gn) {
    for (size_t i = gtid; i < n8; i += gn) { const float4 a = *(const float4*)(src + i * 8), b = *(const float4*)(src + i * 8 + 4);
        float4 ga = make_float4(1.f, 1.f, 1.f, 1.f), gb = ga; if (g) { ga = *(const float4*)(g + ((i * 8) & (D - 1))); gb = *(const float4*)(g + ((i * 8) & (D - 1)) + 4); }
        uint4 o; o.x = pg8::cvt_pk_bf16(a.x * ga.x, a.y * ga.y); o.y = pg8::cvt_pk_bf16(a.z * ga.z, a.w * ga.w); o.z = pg8::cvt_pk_bf16(b.x * gb.x, b.y * gb.y); o.w = pg8::cvt_pk_bf16(b.z * gb.z, b.w * gb.w);
        *(uint4*)(dst + i * 8) = o; }
}


DEVI void conv_token(int row, const bf16* U, const float* cw, const float* cb, const float* lg, const float* lb, bf16* CONCAT, int lane) {
    const int pos = row % SEQ; float y[8];
    { const float4 b0 = *(const float4*)(cb + lane * 8), b1 = *(const float4*)(cb + lane * 8 + 4); y[0] = b0.x; y[1] = b0.y; y[2] = b0.z; y[3] = b0.w; y[4] = b1.x; y[5] = b1.y; y[6] = b1.z; y[7] = b1.w; }
    const int k0 = pos >= CK - 1 ? 0 : CK - 1 - pos;
    for (int k = k0; k < CK; ++k) {
        const uint4 u = *(const uint4*)(U + (size_t)(row - (CK - 1) + k) * CW + lane * 8);
        const float4 w0 = *(const float4*)(cw + k * CW + lane * 8), w1 = *(const float4*)(cw + k * CW + lane * 8 + 4);
        y[0] += w0.x * __builtin_bit_cast(float, u.x << 16); y[1] += w0.y * __builtin_bit_cast(float, u.x & 0xffff0000u);
        y[2] += w0.z * __builtin_bit_cast(float, u.y << 16); y[3] += w0.w * __builtin_bit_cast(float, u.y & 0xffff0000u);
        y[4] += w1.x * __builtin_bit_cast(float, u.z << 16); y[5] += w1.y * __builtin_bit_cast(float, u.z & 0xffff0000u);
        y[6] += w1.z * __builtin_bit_cast(float, u.w << 16); y[7] += w1.w * __builtin_bit_cast(float, u.w & 0xffff0000u);
    }
    float s = 0.f;
#pragma unroll
    for (int e = 0; e < 8; ++e) s += y[e];
    const float mu = wave_sum(s) * (1.f / CW); float q = 0.f;
#pragma unroll
    for (int e = 0; e < 8; ++e) { y[e] -= mu; q += y[e] * y[e]; }
    const float rstd = rsqrtf(wave_sum(q) * (1.f / CW) + EPS);
    const float4 g0 = *(const float4*)(lg + lane * 8), g1 = *(const float4*)(lg + lane * 8 + 4), c0 = *(const float4*)(lb + lane * 8), c1 = *(const float4*)(lb + lane * 8 + 4);
    const float gg[8] = {g0.x, g0.y, g0.z, g0.w, g1.x, g1.y, g1.z, g1.w}, bb[8] = {c0.x, c0.y, c0.z, c0.w, c1.x, c1.y, c1.z, c1.w};
    float z[8];
#pragma unroll
    for (int e = 0; e < 8; ++e) { const float t = y[e] * rstd * gg[e] + bb[e]; z[e] = t * __builtin_amdgcn_rcpf(1.f + __expf(-t)); }
    uint4 o; o.x = pg8::cvt_pk_bf16(z[0], z[1]); o.y = pg8::cvt_pk_bf16(z[2], z[3]); o.z = pg8::cvt_pk_bf16(z[4], z[5]); o.w = pg8::cvt_pk_bf16(z[6], z[7]);
    *(uint4*)(CONCAT + (size_t)row * D + CW + lane * 8) = o;
}

DEVI void conv_chunk(int c, const bf16* U, const float* cw, const float* cb, const float* lg, const float* lb, bf16* CONCAT, LAS unsigned char* lds) {
    const int ch = threadIdx.x, lane = ch & 63, wv = __builtin_amdgcn_readfirstlane(ch >> 6);
    const int t0 = c * 64, pos0 = t0 % SEQ;
    float w[CK];
#pragma unroll
    for (int k = 0; k < CK; ++k) w[k] = cw[k * CW + ch];
    const float bias = cb[ch];
    float u[64 + CK - 1];
#pragma unroll
    for (int r = 0; r < 64 + CK - 1; ++r) { const int row = t0 - (CK - 1) + r;
        const unsigned raw = *(const unsigned short*)(U + (size_t)(row < 0 ? 0 : row) * CW + ch); u[r] = __builtin_bit_cast(float, raw << 16); }
#pragma unroll
    for (int r = 0; r < CK - 1; ++r) { const float keep = (pos0 - (CK - 1) + r >= 0) ? 1.f : 0.f; u[r] *= keep; }
    LAS float* yl = (LAS float*)lds;
#pragma unroll
    for (int j = 0; j < 64; ++j) { float y = bias;
#pragma unroll
        for (int k = 0; k < CK; ++k) y += w[k] * u[j + k];
        yl[j * CW + ch] = y; }
    __syncthreads();
#pragma unroll 1
    for (int i = 0; i < 8; ++i) { const int j = wv * 8 + i, row = t0 + j;
        const pg8::f32x4 a0 = *(const LAS pg8::f32x4*)(yl + j * CW + lane * 8), a1 = *(const LAS pg8::f32x4*)(yl + j * CW + lane * 8 + 4);
        float y[8] = {a0[0], a0[1], a0[2], a0[3], a1[0], a1[1], a1[2], a1[3]}; float sm = 0.f;
#pragma unroll
        for (int e = 0; e < 8; ++e) sm += y[e];
        const float mu = wave_sum(sm) * (1.f / CW); float q = 0.f;
#pragma unroll
        for (int e = 0; e < 8; ++e) { y[e] -= mu; q += y[e] * y[e]; }
        const float rstd = rsqrtf(wave_sum(q) * (1.f / CW) + EPS);
        const float4 g0 = *(const float4*)(lg + lane * 8), g1 = *(const float4*)(lg + lane * 8 + 4), c0 = *(const float4*)(lb + lane * 8), c1 = *(const float4*)(lb + lane * 8 + 4);
        const float gg[8] = {g0.x, g0.y, g0.z, g0.w, g1.x, g1.y, g1.z, g1.w}, bb[8] = {c0.x, c0.y, c0.z, c0.w, c1.x, c1.y, c1.z, c1.w};
        float z[8];
#pragma unroll
        for (int e = 0; e < 8; ++e) { const float t = y[e] * rstd * gg[e] + bb[e]; z[e] = t * __builtin_amdgcn_rcpf(1.f + __expf(-t)); }
        uint4 o; o.x = pg8::cvt_pk_bf16(z[0], z[1]); o.y = pg8::cvt_pk_bf16(z[2], z[3]); o.z = pg8::cvt_pk_bf16(z[4], z[5]); o.w = pg8::cvt_pk_bf16(z[6], z[7]);
        *(uint4*)(CONCAT + (size_t)row * D + CW + lane * 8) = o; }
    __syncthreads();
}

typedef short bf16x8_t __attribute__((ext_vector_type(8)));
typedef float f32x16_t __attribute__((ext_vector_type(16)));
typedef __bf16 bf16x2_t __attribute__((ext_vector_type(2)));
DEVI unsigned umax_(unsigned a, unsigned b) { return a > b ? a : b; }
DEVI unsigned umin_(unsigned a, unsigned b) { return a < b ? a : b; }
DEVI unsigned kmax_(unsigned a, unsigned b) { unsigned r; asm("v_max_f32 %0, %1, %2" : "=v"(r) : "v"(a), "v"(b)); return r; }
DEVI unsigned kmin_(unsigned a, unsigned b) { unsigned r; asm("v_min_f32 %0, %1, %2" : "=v"(r) : "v"(a), "v"(b)); return r; }
DEVI void ce_desc(unsigned& a, unsigned& b) { const unsigned mx = kmax_(a, b), mn = kmin_(a, b); a = mx; b = mn; }
DEVI void sort16_desc(unsigned (&v)[16]) {
    ce_desc(v[0], v[13]); ce_desc(v[1], v[12]); ce_desc(v[2], v[15]); ce_desc(v[3], v[14]); ce_desc(v[4], v[8]); ce_desc(v[5], v[6]); ce_desc(v[7], v[11]); ce_desc(v[9], v[10]);
    ce_desc(v[0], v[5]); ce_desc(v[1], v[7]); ce_desc(v[2], v[9]); ce_desc(v[3], v[4]); ce_desc(v[6], v[13]); ce_desc(v[8], v[14]); ce_desc(v[10], v[15]); ce_desc(v[11], v[12]);
    ce_desc(v[0], v[1]); ce_desc(v[2], v[3]); ce_desc(v[4], v[5]); ce_desc(v[6], v[8]); ce_desc(v[7], v[9]); ce_desc(v[10], v[11]); ce_desc(v[12], v[13]); ce_desc(v[14], v[15]);
    ce_desc(v[0], v[2]); ce_desc(v[1], v[3]); ce_desc(v[4], v[10]); ce_desc(v[5], v[11]); ce_desc(v[6], v[7]); ce_desc(v[8], v[9]); ce_desc(v[12], v[14]); ce_desc(v[13], v[15]);
    ce_desc(v[1], v[2]); ce_desc(v[3], v[12]); ce_desc(v[4], v[6]); ce_desc(v[5], v[7]); ce_desc(v[8], v[10]); ce_desc(v[9], v[11]); ce_desc(v[13], v[14]);
    ce_desc(v[1], v[4]); ce_desc(v[2], v[6]); ce_desc(v[5], v[8]); ce_desc(v[7], v[10]); ce_desc(v[9], v[13]); ce_desc(v[11], v[14]);
    ce_desc(v[2], v[4]); ce_desc(v[3], v[6]); ce_desc(v[9], v[12]); ce_desc(v[11], v[13]);
    ce_desc(v[3], v[5]); ce_desc(v[6], v[8]); ce_desc(v[7], v[9]); ce_desc(v[10], v[12]);
    ce_desc(v[3], v[4]); ce_desc(v[5], v[6]); ce_desc(v[7], v[8]); ce_desc(v[9], v[10]); ce_desc(v[11], v[12]);
    ce_desc(v[6], v[7]); ce_desc(v[8], v[9]);
}
DEVI void merge16_desc(unsigned (&v)[16]) {
#pragma unroll
    for (int j = 8; j > 0; j >>= 1)
#pragma unroll
        for (int i = 0; i < 16; ++i) { const int l = i ^ j; if (l > i) ce_desc(v[i], v[l]); }
}
DEVI void top16_merge(unsigned (&a)[16], const unsigned (&b)[16]) {
#pragma unroll
    for (int i = 0; i < 16; ++i) a[i] = kmax_(a[i], b[15 - i]);
    merge16_desc(a);
}
DEVI int crow16(int r, int hi) { return (r & 3) + 8 * (r >> 2) + 4 * hi; }

DEVI void subkey_top16(unsigned (&best)[16], const bf16* qrow  , const LAS unsigned char* kl  , int hi) {
    bf16x8_t qf[8];
#pragma unroll
    for (int ks = 0; ks < 8; ++ks) qf[ks] = *(const bf16x8_t*)(qrow + 16 * ks);
    unsigned grp[16];
#pragma unroll
    for (int nt = 0; nt < 4; ++nt) {
        f32x16_t acc = {};
#pragma unroll
        for (int ks = 0; ks < 8; ++ks) { const bf16x8_t kf = *(const LAS bf16x8_t*)(kl + ks * 4096 + nt * 512); acc = __builtin_amdgcn_mfma_f32_32x32x16_bf16(kf, qf[ks], acc, 0, 0, 0); }
#pragma unroll
        for (int r = 0; r < 16; ++r) { const float av = acc[r]; grp[r] = (__builtin_bit_cast(unsigned, av) & 0xffffff80u) | (unsigned)(127 - (32 * nt + crow16(r, hi))); }
        sort16_desc(grp);
        if (nt == 0) {
#pragma unroll
            for (int r = 0; r < 16; ++r) best[r] = grp[r];
        } else top16_merge(best, grp);
    }
    unsigned oth[16];
#pragma unroll
    for (int r = 0; r < 16; ++r) oth[r] = (unsigned)__shfl_xor((int)best[r], 32);
    top16_merge(best, oth);
}
DEVI void topk_wave(const bf16* qbase, const LAS unsigned char* keys, LAS unsigned* scr  , int* eidx, float* egate, int lane) {
    const int r32 = lane & 31, hi = lane >> 5;
    unsigned b0[16], b1[16];
    subkey_top16(b0, qbase + 8 * hi, keys + hi * 2048 + r32 * 16, hi);
    subkey_top16(b1, qbase + 128 + 8 * hi, keys + 32768 + hi * 2048 + r32 * 16, hi);
    float s0[16], s1[16];
#pragma unroll
    for (int i = 0; i < 16; ++i) { s0[i] = __builtin_bit_cast(float, b0[i] & 0xffffff80u); s1[i] = __builtin_bit_cast(float, b1[i] & 0xffffff80u); }
#pragma unroll
    for (int w = 0; w < 4; ++w) {
        scr[lane * 9 + w] = (127u - (b0[4 * w] & 127u)) | ((127u - (b0[4 * w + 1] & 127u)) << 8) | ((127u - (b0[4 * w + 2] & 127u)) << 16) | ((127u - (b0[4 * w + 3] & 127u)) << 24);
        scr[lane * 9 + 4 + w] = (127u - (b1[4 * w] & 127u)) | ((127u - (b1[4 * w + 1] & 127u)) << 8) | ((127u - (b1[4 * w + 2] & 127u)) << 16) | ((127u - (b1[4 * w + 3] & 127u)) << 24);
    }
    unsigned ca[16], cb2[16];
#define CAND(i, j) ((__builtin_bit_cast(unsigned, s0[i] + s1[j]) & 0xffffff00u) | (unsigned)(255 - ((i) * 16 + (j))))
    const unsigned lowest = 0xff800000u;
    if (hi == 0) {
#pragma unroll
        for (int j = 0; j < 16; ++j) ca[j] = CAND(0, j);
#pragma unroll
        for (int j = 0; j < 8; ++j) cb2[j] = CAND(1, j);
#pragma unroll
        for (int j = 8; j < 16; ++j) cb2[j] = lowest;
    } else {
        ca[0] = CAND(2, 0); ca[1] = CAND(2, 1); ca[2] = CAND(2, 2); ca[3] = CAND(2, 3); ca[4] = CAND(2, 4); ca[5] = CAND(3, 0); ca[6] = CAND(3, 1); ca[7] = CAND(3, 2); ca[8] = CAND(3, 3);
        ca[9] = CAND(4, 0); ca[10] = CAND(4, 1); ca[11] = CAND(4, 2); ca[12] = CAND(5, 0); ca[13] = CAND(5, 1); ca[14] = CAND(6, 0); ca[15] = CAND(6, 1);
        cb2[0] = CAND(7, 0); cb2[1] = CAND(7, 1); cb2[2] = CAND(8, 0); cb2[3] = CAND(9, 0); cb2[4] = CAND(10, 0); cb2[5] = CAND(11, 0); cb2[6] = CAND(12, 0); cb2[7] = CAND(13, 0); cb2[8] = CAND(14, 0); cb2[9] = CAND(15, 0);
#pragma unroll
        for (int j = 10; j < 16; ++j) cb2[j] = lowest;
    }
#undef CAND
    sort16_desc(ca); sort16_desc(cb2); top16_merge(ca, cb2);
    unsigned oth[16];
#pragma unroll
    for (int r = 0; r < 16; ++r) oth[r] = (unsigned)__shfl_xor((int)ca[r], 32);
    top16_merge(ca, oth);
    const float mx = __builtin_bit_cast(float, ca[0] & 0xffffff00u); float ex[16]; float l = 0.f;
#pragma unroll
    for (int k = 0; k < 16; ++k) { ex[k] = __expf(__builtin_bit_cast(float, ca[k] & 0xffffff00u) - mx); l += ex[k]; }
    const float rl = 1.f / l;
    LDS_WAIT(); asm volatile("" ::: "memory");
    int ei[8]; float eg[8];
    const unsigned mhi = (unsigned)(-hi);
#pragma unroll
    for (int k = 0; k < 8; ++k) { const unsigned key = ca[k] ^ ((ca[k] ^ ca[8 + k]) & mhi); const unsigned ij = 255u - (key & 255u), i = ij >> 4, j = ij & 15u;
        const unsigned w0 = scr[lane * 9 + (i >> 2)], w1 = scr[lane * 9 + 4 + (j >> 2)];
        ei[k] = (int)(((w0 >> (8 * (i & 3))) & 255u) * PNK + ((w1 >> (8 * (j & 3))) & 255u)); eg[k] = __builtin_bit_cast(float, __builtin_bit_cast(unsigned, ex[k]) ^ ((__builtin_bit_cast(unsigned, ex[k]) ^ __builtin_bit_cast(unsigned, ex[8 + k])) & mhi)) * rl; }
    *(int4*)(eidx + hi * 8) = make_int4(ei[0], ei[1], ei[2], ei[3]); *(int4*)(eidx + hi * 8 + 4) = make_int4(ei[4], ei[5], ei[6], ei[7]);
    *(float4*)(egate + hi * 8) = make_float4(eg[0], eg[1], eg[2], eg[3]); *(float4*)(egate + hi * 8 + 4) = make_float4(eg[4], eg[5], eg[6], eg[7]);
    LDS_WAIT(); asm volatile("" ::: "memory");
}

typedef unsigned char fp8_t;
template <int VAR = 0> DEVI float dot16_fp8(pg8::u32x4 row, pg8::u32x4 ha, pg8::u32x4 hb, float acc) {
    if (VAR == 1) return __builtin_bit_cast(float, (row[0] ^ row[1]) ^ (row[2] ^ row[3]));
#pragma unroll
    for (int i = 0; i < 4; ++i) { const unsigned hlo = i < 2 ? ha[2 * i] : hb[2 * i - 4], hhi = i < 2 ? ha[2 * i + 1] : hb[2 * i - 3];
        acc = __builtin_amdgcn_fdot2_f32_bf16(__builtin_amdgcn_cvt_scalef32_pk_bf16_fp8(row[i], 1.0f, false), __builtin_bit_cast(bf16x2_t, hlo), acc, false);
        acc = __builtin_amdgcn_fdot2_f32_bf16(__builtin_amdgcn_cvt_scalef32_pk_bf16_fp8(row[i], 1.0f, true), __builtin_bit_cast(bf16x2_t, hhi), acc, false); }
    return acc;
}
template <int VAR = 0> DEVI void fma16_fp8(float (&acc)[16], float w, pg8::u32x4 row) {
    if (VAR == 1) { acc[0] += __builtin_bit_cast(float, row[0] ^ row[1]); acc[1] += __builtin_bit_cast(float, row[2] ^ row[3]); return; }
#pragma unroll
    for (int i = 0; i < 4; ++i) { const pg8::f32x2 lo = __builtin_amdgcn_cvt_pk_f32_fp8(row[i], false), hh = __builtin_amdgcn_cvt_pk_f32_fp8(row[i], true);
        acc[4 * i] += w * lo[0]; acc[4 * i + 1] += w * lo[1]; acc[4 * i + 2] += w * hh[0]; acc[4 * i + 3] += w * hh[1]; }
}
DEVI void sort128_asc(unsigned& a, unsigned& b, int lane) {
#pragma unroll
    for (int k = 2; k <= 128; k <<= 1)
#pragma unroll
        for (int j = k >> 1; j > 0; j >>= 1) {
            if (j == 64) { const unsigned lo = umin_(a, b), hi = umax_(a, b); a = lo; b = hi; }
            else {
                const bool upper = (lane & j) != 0;
                const bool asc_a = k == 128 ? true : ((lane & k) == 0), asc_b = k == 128 ? true : (k == 64 ? false : ((lane & k) == 0));
                const unsigned pa_ = (unsigned)__shfl_xor((int)a, j), pb_ = (unsigned)__shfl_xor((int)b, j);
                a = (upper != asc_a) ? umin_(a, pa_) : umax_(a, pa_);
                b = (upper != asc_b) ? umin_(b, pb_) : umax_(b, pb_);
            }
        }
}
constexpr int EXD = 8, EXP_LDS_WAVE = 12800 + 1024;
typedef int v8i_t __attribute__((ext_vector_type(8)));
typedef float v4f_t __attribute__((ext_vector_type(4)));
struct Row6 { pg8::u32x4 a; pg8::u32x2 b; };
template <int VAR> DEVI void experts_wave(LAS unsigned char* wl_, int t0, int tstep, const bf16* H2B, const float* part2, const unsigned char* PU, const unsigned char* PV, const int* EIDX, const float* EGATE, const float* fg, float* out, int lane) {
    if (t0 >= M) return;
    const int ntok = (M - t0 + tstep - 1) / tstep < 8 ? (M - t0 + tstep - 1) / tstep : 8;
    LAS int* sid = (LAS int*)wl_; LAS float* gsl = (LAS float*)(wl_ + 4096); LAS float* wl = (LAS float*)(wl_ + 8192); LAS float* r2l = (LAS float*)(wl_ + 12288);
    const unsigned g32 = (unsigned)lane & 31u, hsel = (unsigned)lane >> 5, l4 = (unsigned)lane * 4u;
#define LDI(p) (*(const int*)((const char*)(p) + l4))
#define LDF(p) (*(const float*)((const char*)(p) + l4))
#define LDROW(dst, tab, ridx) do { const unsigned char* rp_ = (tab) + (size_t)(unsigned)(ridx) * 768u; (dst).a = *(const pg8::u32x4*)(rp_ + g32 * 16u); (dst).b = *(const pg8::u32x2*)(rp_ + 512u + g32 * 8u); } while (0)
    for (int k = 0; k < ntok; ++k) { const int t = t0 + k * tstep;
        unsigned k0 = ((unsigned)LDI(EIDX + (size_t)t * 128) << 7) | (unsigned)lane, k1 = ((unsigned)LDI(EIDX + (size_t)t * 128 + 64) << 7) | (unsigned)(64 + lane);
        const float ga = LDF(EGATE + (size_t)t * 128), gb = LDF(EGATE + (size_t)t * 128 + 64);
        sort128_asc(k0, k1, lane);
        const unsigned sl0 = k0 & 127u, sl1 = k1 & 127u;
        const float x0 = __shfl(ga, (int)(sl0 & 63u)), y0 = __shfl(gb, (int)(sl0 & 63u)), x1 = __shfl(ga, (int)(sl1 & 63u)), y1 = __shfl(gb, (int)(sl1 & 63u));
        sid[k * 128 + lane] = (int)(k0 >> 7); sid[k * 128 + 64 + lane] = (int)(k1 >> 7);
        gsl[k * 128 + lane] = sl0 < 64u ? x0 : y0; gsl[k * 128 + 64 + lane] = sl1 < 64u ? x1 : y1;
        const float r2 = rsqrtf(wave_sum(lane < 16 ? LDF(part2 + (size_t)t * 16) : 0.f) * (1.f / D) + EPS) * (1.0f / PU_SCALE);
        if (lane == 0) r2l[k] = r2; }
    LDS_WAIT(); asm volatile("" ::: "memory");
    const int nsteps = 8 * ntok;
#define STEP_DESC(q, tab, pos0) do { const int q_ = (q); if (q_ < nsteps) { (tab) = PU; (pos0) = ((q_ >> 5) * 4 + (q_ & 3)) * 128 + 16 * ((q_ >> 2) & 7); } \
        else if (q_ < 2 * nsteps) { const int qq_ = q_ - nsteps; (tab) = PV; (pos0) = ((qq_ >> 4) * 2 + (qq_ & 1)) * 128 + 16 * ((qq_ >> 1) & 7); } else { (tab) = PV; (pos0) = 0; } } while (0)
    constexpr int LOOK = 1;
    Row6 buf[8 * LOOK];
    pg8::u32x4 hhi[4];
#define CONVERT_GRP(g_) do { LAS unsigned char* img = wl_ + 12800; const int c16 = lane & 15, q4 = lane >> 4; \
      _Pragma("unroll") for (int k = 0; k < 4; ++k) { const int tt_ = t0 + (4 * (g_) + k) * tstep; \
          const pg8::u32x4 h0 = *(const pg8::u32x4*)((const char*)(H2B + (size_t)tt_ * D) + lane * 32), h1 = *(const pg8::u32x4*)((const char*)(H2B + (size_t)tt_ * D) + lane * 32 + 16); \
          float hf[16]; \
          _Pragma("unroll") for (int j = 0; j < 4; ++j) { hf[2 * j] = __builtin_bit_cast(float, h0[j] << 16); hf[2 * j + 1] = __builtin_bit_cast(float, h0[j] & 0xffff0000u); hf[8 + 2 * j] = __builtin_bit_cast(float, h1[j] << 16); hf[8 + 2 * j + 1] = __builtin_bit_cast(float, h1[j] & 0xffff0000u); } \
          pg8::u32x4 hiw; \
          _Pragma("unroll") for (int w = 0; w < 4; ++w) { int p = __builtin_amdgcn_cvt_pk_fp8_f32(hf[4 * w], hf[4 * w + 1], 0, false); p = __builtin_amdgcn_cvt_pk_fp8_f32(hf[4 * w + 2], hf[4 * w + 3], p, true); \
              hiw[w] = (unsigned)p; } \
          *(LAS pg8::u32x4*)(img + lane * 16) = hiw; \
          LDS_WAIT(); asm volatile("" ::: "memory"); \
          const int off = 32 * c16 + 512 * (q4 >> 1) + 16 * (q4 & 1); \
          hhi[k] = *(const LAS pg8::u32x4*)(img + off); \
          LDS_WAIT(); asm volatile("" ::: "memory"); } } while (0)
#pragma unroll
    for (int i = 0; i < 8; ++i) { const int ri = sid[2 * i + (int)hsel]; LDROW(buf[i], PU, ri); }
#define TR_STEP(S) _Pragma("unroll") for (int i = 0; i < S; ++i) { const bool up_ = (lane & S) != 0; const float send = up_ ? r[i] : r[i + S], keep = up_ ? r[i + S] : r[i]; r[i] = keep + __shfl_xor(send, S); }
#define U_STEP(q, B_, K_, G_) do { const int q__ = (q); const int ub_ = (B_); constexpr int uk_ = (K_); const int tk_ = 4 * (G_) + uk_; \
        const unsigned char* ntab; int npos; STEP_DESC(q__ + LOOK, ntab, npos); npos += (int)hsel; \
        const v8i_t AAh = {(int)hhi[uk_][0], (int)hhi[uk_][1], (int)hhi[uk_][2], (int)hhi[uk_][3], 0, 0, 0, 0}; \
        const v8i_t ABh = {0, 0, 0, 0, (int)hhi[uk_][0], (int)hhi[uk_][1], (int)hhi[uk_][2], (int)hhi[uk_][3]}; \
        const int c16_ = lane & 15; const bool dg_ = (lane >> 4) == (c16_ >> 2); \
        float r[16]; \
        _Pragma("unroll") for (int i2 = 0; i2 < 8; ++i2) { \
            const v8i_t B6 = {(int)buf[i2].a[0], (int)buf[i2].a[1], (int)buf[i2].a[2], (int)buf[i2].a[3], (int)buf[i2].b[0], (int)buf[i2].b[1], 0, 0}; \
            const v4f_t z4 = {0.f, 0.f, 0.f, 0.f}; \
            v4f_t cA = __builtin_amdgcn_mfma_scale_f32_16x16x128_f8f6f4(AAh, B6, z4, 0, 2, 0, 127, 0, 127); \
            v4f_t cB = __builtin_amdgcn_mfma_scale_f32_16x16x128_f8f6f4(ABh, B6, z4, 0, 2, 0, 127, 0, 127); \
            const int ri = sid[npos + 2 * i2]; LDROW(buf[i2], ntab, ri); \
            const float a01 = (c16_ & 1) ? cA[1] : cA[0], a23 = (c16_ & 1) ? cA[3] : cA[2], b01 = (c16_ & 1) ? cB[1] : cB[0], b23 = (c16_ & 1) ? cB[3] : cB[2]; \
            r[2 * i2] = dg_ ? ((c16_ & 2) ? a23 : a01) : 0.f; r[2 * i2 + 1] = dg_ ? ((c16_ & 2) ? b23 : b01) : 0.f; \
            __builtin_amdgcn_sched_barrier(0); } \
        TR_STEP(8) TR_STEP(4) TR_STEP(2) TR_STEP(1) \
        float tot = r[0] + __shfl_xor(r[0], 16); tot += __shfl_xor(tot, 32); \
        const int pos = tk_ * 128 + 16 * ub_ + c16_; \
        const float a = tot * r2l[tk_]; \
        wl[pos] = 0.5f * a * (1.f + erff(a * 0.70710678118654752f)) * gsl[pos] * (1.0f / PV_SCALE); } while (0)
    if (ntok == 8) {
#pragma unroll 1
        for (int grp = 0; grp < 2; ++grp) {
            CONVERT_GRP(grp);
#pragma unroll 1
            for (int b = 0; b < 8; ++b) { const int q = grp * 32 + b * 4;
                U_STEP(q, b, 0, grp); U_STEP(q + 1, b, 1, grp); U_STEP(q + 2, b, 2, grp); U_STEP(q + 3, b, 3, grp); }
        }
    }
#undef CONVERT_GRP
#undef U_STEP
#undef TR_STEP
    LDS_WAIT(); asm volatile("" ::: "memory");
#define V_STEP(q, ACC, KT) do { const int q__ = (q); const int b = ((q__ - nsteps) >> 1) & 7; \
        const unsigned char* ntab; int npos; STEP_DESC(q__ + LOOK, ntab, npos); npos += (int)hsel; \
        const int wpos = (KT) * 128 + b * 16 + (int)hsel; \
        _Pragma("unroll") for (int i2 = 0; i2 < 8; ++i2) { \
            const v6u_t p = {buf[i2].a[0], buf[i2].a[1], buf[i2].a[2], buf[i2].a[3], buf[i2].b[0], buf[i2].b[1]}; \
            const float wv = wl[wpos + 2 * i2]; \
            { const v32f_t rv = __builtin_amdgcn_cvt_scalef32_pk32_f32_fp6(p, 1.0f); \
                const f32x2_t w2_ = {wv, wv}; _Pragma("unroll") for (int j = 0; j < 32; j += 2) { const f32x2_t r2_ = {rv[j], rv[j + 1]}; f32x2_t a2_ = {ACC[j], ACC[j + 1]}; a2_ = __builtin_elementwise_fma(r2_, w2_, a2_); ACC[j] = a2_[0]; ACC[j + 1] = a2_[1]; } } \
            const int ri = sid[npos + 2 * i2]; LDROW(buf[i2], ntab, ri); \
            asm volatile("" : "+v"(ACC[0]), "+v"(ACC[1]), "+v"(ACC[2]), "+v"(ACC[3]), "+v"(ACC[4]), "+v"(ACC[5]), "+v"(ACC[6]), "+v"(ACC[7]), "+v"(ACC[8]), "+v"(ACC[9]), "+v"(ACC[10]), "+v"(ACC[11]), "+v"(ACC[12]), "+v"(ACC[13]), "+v"(ACC[14]), "+v"(ACC[15])); \
            asm volatile("" : "+v"(ACC[16]), "+v"(ACC[17]), "+v"(ACC[18]), "+v"(ACC[19]), "+v"(ACC[20]), "+v"(ACC[21]), "+v"(ACC[22]), "+v"(ACC[23]), "+v"(ACC[24]), "+v"(ACC[25]), "+v"(ACC[26]), "+v"(ACC[27]), "+v"(ACC[28]), "+v"(ACC[29]), "+v"(ACC[30]), "+v"(ACC[31])); \
            __builtin_amdgcn_sched_barrier(0); } } while (0)
#define V_FINISH(ACC, KT, RA, RB) do { const int t = t0 + (KT) * tstep; \
        float fin[16]; \
        _Pragma("unroll") for (int j = 0; j < 16; ++j) { const float lo = ACC[j], hi = ACC[16 + j]; const float send = hsel ? lo : hi, keep = hsel ? hi : lo; fin[j] = keep + __shfl_xor(send, 32); } \
        float* orow = (float*)((char*)(out + (size_t)t * D) + eoff); float ss = 0.f; \
        _Pragma("unroll") for (int q = 0; q < 4; ++q) { fin[2 * q] += __builtin_bit_cast(float, RA[q] << 16); fin[2 * q + 1] += __builtin_bit_cast(float, RA[q] & 0xffff0000u); fin[8 + 2 * q] += __builtin_bit_cast(float, RB[q] << 16); fin[8 + 2 * q + 1] += __builtin_bit_cast(float, RB[q] & 0xffff0000u); } \
        _Pragma("unroll") for (int j = 0; j < 16; ++j) ss += fin[j] * fin[j]; \
        const float rr = rsqrtf(wave_sum(ss) * (1.f / D) + EPS); \
        _Pragma("unroll") for (int q = 0; q < 4; ++q) { const float4 g = fgq[q]; \
            *(float4*)(orow + q * 4) = make_float4(fin[4 * q] * rr * g.x, fin[4 * q + 1] * rr * g.y, fin[4 * q + 2] * rr * g.z, fin[4 * q + 3] * rr * g.w); } } while (0)
    const unsigned eoff = (g32 * 32u + hsel * 16u) * 4u;
    float4 fgq[4];
#pragma unroll
    for (int q = 0; q < 4; ++q) fgq[q] = *(const float4*)((const char*)(fg + q * 4) + eoff);
#pragma unroll 1
    for (int kp = 0; kp < ntok / 2; ++kp) { const int k0_ = 2 * kp, k1_ = 2 * kp + 1;
        const char* h0p = (const char*)(H2B + (size_t)(t0 + k0_ * tstep) * D) + eoff / 2; const char* h1p = (const char*)(H2B + (size_t)(t0 + k1_ * tstep) * D) + eoff / 2;
        const pg8::u32x4 ra0 = *(const pg8::u32x4*)h0p, rb0 = *(const pg8::u32x4*)(h0p + 16), ra1 = *(const pg8::u32x4*)h1p, rb1 = *(const pg8::u32x4*)(h1p + 16);
        __builtin_amdgcn_sched_barrier(0);
        float acc0[32], acc1[32];
#pragma unroll
        for (int j = 0; j < 32; ++j) { acc0[j] = 0.f; acc1[j] = 0.f; }
#pragma unroll 1
        for (int bb = 0; bb < 8; ++bb) { const int q = nsteps + 16 * kp + 2 * bb; V_STEP(q, acc0, k0_); V_STEP(q + 1, acc1, k1_); }
        V_FINISH(acc0, k0_, ra0, rb0);
        V_FINISH(acc1, k1_, ra1, rb1);
        __builtin_amdgcn_sched_barrier(0);
    }
#undef V_FINISH
#undef V_STEP
#undef STEP_DESC
#undef LDI
#undef LDF
#undef LDROW
}

typedef short v4i16_t __attribute__((ext_vector_type(4)));
typedef int v2i32_t __attribute__((ext_vector_type(2)));
typedef int v4i32_t __attribute__((ext_vector_type(4)));
DEVI bf16x8_t join_tr(v4i16_t lo, v4i16_t hh) { const v2i32_t a = __builtin_bit_cast(v2i32_t, lo), b = __builtin_bit_cast(v2i32_t, hh); const v4i32_t w = {a[0], a[1], b[0], b[1]}; return __builtin_bit_cast(bf16x8_t, w); }
DEVI float max3f(float a, float b, float c) { float r; asm("v_max3_f32 %0, %1, %2, %3" : "=v"(r) : "v"(a), "v"(b), "v"(c)); return r; }
DEVI float max2f(float a, float b) { float r; asm("v_max_f32_e32 %0, %1, %2" : "=v"(r) : "v"(a), "v"(b)); return r; }
DEVI void glds16(const void* gsrc, unsigned lds_dst) { unsigned keep;
    asm volatile("s_mov_b32 %0, m0\n\ts_mov_b32 m0, %2\n\ts_nop 0\n\tglobal_load_lds_dwordx4 %1, off\n\ts_mov_b32 m0, %0" : "=&s"(keep) : "v"(gsrc), "s"(lds_dst) : "memory"); }
#define LDSADDR(p) ((unsigned)__builtin_amdgcn_readfirstlane((int)(unsigned)(uintptr_t)(p)))
#define ATT_BAR(N) asm volatile("s_waitcnt vmcnt(" #N ") lgkmcnt(0)\n\ts_barrier" ::: "memory")
template <int DQK, int DV, int DSPLIT, int NSLOT, int PD, bool CAUSAL, bool STAG, int VAR = 0>
DEVI void attn_unit(LAS unsigned char* S, const bf16* Qu, int qpitch, const bf16* Ku, int kpitch, const bf16* Vu, int vpitch, bf16* Ou, int opitch, int NT, int qcb) {
    constexpr int NCH = DQK / 8, KSLOT = NCH * 1024, NVG = DV / 32, VSLOT = NVG * 4096, NRG = 8 / DSPLIT, DVW = DV / DSPLIT, NOD = DVW / 32, NKS = DQK / 16;
    constexpr int KOFF = 0, VOFF = NSLOT * KSLOT, WSF = VOFF + NSLOT * VSLOT;
    static_assert(NRG * 32 * DVW * 2 * DSPLIT <= NSLOT * KSLOT, "O staging reuses the K ring");
    static_assert(NSLOT >= PD + (STAG ? 2 : 1), "ring depth");
    int tid_ = threadIdx.x; asm volatile("" : "+v"(tid_));
    const int lane = tid_ & 63, wid = __builtin_amdgcn_readfirstlane(tid_ >> 6), r32 = lane & 31, hi = lane >> 5, rg = wid % NRG, dp = wid / NRG;
    const bool late = STAG && wid >= 4;
    LAS float* wsf = (LAS float*)(S + WSF) + wid * 64;
    const int nld = (NCH - wid + 7) / 8 + (NVG * 4 - wid + 7) / 8;
    const bf16* ksrc = Ku + (size_t)lane * kpitch;
    const bf16* vsrc = Vu + (size_t)(lane >> 2) * vpitch + (lane & 3) * 8;
#define ATT_DMA(t, slot) do { \
        _Pragma("unroll") for (int pc_ = 0; pc_ < (NCH + 7) / 8; ++pc_) { const int pc = wid + 8 * pc_; if (pc < NCH) \
            glds16(ksrc + (size_t)(t) * 64 * kpitch + pc * 8, LDSADDR(S + KOFF + (slot) * KSLOT + pc * 1024)); } \
        _Pragma("unroll") for (int pv_ = 0; pv_ < (NVG * 4 + 7) / 8; ++pv_) { const int pv = wid + 8 * pv_; if (pv < NVG * 4) \
            glds16(vsrc + (size_t)((t) * 64 + (pv & 3) * 16) * vpitch + (pv >> 2) * 32, LDSADDR(S + VOFF + (slot) * VSLOT + pv * 1024)); } } while (0)
    bf16x8_t qr[NKS];
#pragma unroll
    for (int ks = 0; ks < NKS; ++ks) qr[ks] = *(const bf16x8_t*)(Qu + (size_t)(32 * rg + r32) * qpitch + ks * 16 + hi * 8);
#pragma unroll
    for (int ks = 0; ks < NKS; ++ks) asm volatile("" : "+v"(qr[ks]));
#pragma unroll
    for (int t = 0; t < PD; ++t) if (t < NT) ATT_DMA(t, t);
    f32x16_t o[NOD];
#pragma unroll
    for (int dd = 0; dd < NOD; ++dd) o[dd] = f32x16_t{};
    float m = 0.f, l = 0.f; f32x16_t negm = f32x16_t{};
    const int tlast = CAUSAL ? qcb + (rg >> 1) : NT - 1;
    const LAS unsigned char* kbase = S + KOFF + hi * 1024 + r32 * 16;
    const LAS unsigned char* vbase = S + VOFF + ((lane >> 4) & 1) * 32 + (lane & 3) * 8 + (4 * hi + ((lane & 15) >> 2)) * 64 + dp * NOD * 4096;
    bf16x8_t pa[4];
#define ATT_QKSM(sl) do { const LAS unsigned char* kp = kbase + (sl) * KSLOT; \
            f32x16_t p0 = negm, p1 = negm; \
            _Pragma("unroll") for (int ks = 0; ks < NKS; ++ks) { const bf16x8_t a0 = *(const LAS bf16x8_t*)(kp + ks * 2048), a1 = *(const LAS bf16x8_t*)(kp + ks * 2048 + 512); \
                if (VAR != 2) { p0 = __builtin_amdgcn_mfma_f32_32x32x16_bf16(a0, qr[ks], p0, 0, 0, 0); p1 = __builtin_amdgcn_mfma_f32_32x32x16_bf16(a1, qr[ks], p1, 0, 0, 0); } else { p0[ks] += __builtin_bit_cast(float, (int)a0[0]); p1[ks] += __builtin_bit_cast(float, (int)a1[0]); } } \
            asm volatile("s_nop 15\n\ts_nop 7" : "+v"(p0), "+v"(p1)); \
            float rm = 0.f; \
            if (VAR != 1) { float a = max3f(p0[0], p0[1], p1[0]), b = max3f(p0[2], p0[3], p1[1]); a = max3f(a, p1[2], p1[3]); \
              _Pragma("unroll") for (int r = 4; r < 16; r += 4) { a = max3f(a, p0[r], p0[r + 1]); b = max3f(b, p0[r + 2], p0[r + 3]); a = max3f(a, p1[r], p1[r + 1]); b = max3f(b, p1[r + 2], p1[r + 3]); } \
              rm = max2f(a, b); rm = max2f(rm, __shfl_xor(rm, 32)); } \
            if (__any(rm > 0.f)) { \
                const float dl = fmaxf(rm, 0.f), alpha = __builtin_amdgcn_exp2f(-dl); m += dl; l *= alpha; \
                _Pragma("unroll") for (int r = 0; r < 16; ++r) { p0[r] -= dl; p1[r] -= dl; negm[r] = -m; } \
                if (hi == 0) wsf[r32] = alpha; \
                LDS_WAIT(); asm volatile("" ::: "memory"); \
                _Pragma("unroll") for (int r = 0; r < 16; ++r) { const float f = wsf[crow16(r, hi)]; \
                    _Pragma("unroll") for (int dd = 0; dd < NOD; ++dd) o[dd][r] *= f; } \
                LDS_WAIT(); asm volatile("" ::: "memory"); \
            } \
            float ls = 0.f; \
            if (VAR != 1) { _Pragma("unroll") for (int r = 0; r < 16; ++r) { p0[r] = __builtin_amdgcn_exp2f(p0[r]); p1[r] = __builtin_amdgcn_exp2f(p1[r]); ls += p0[r] + p1[r]; } } \
            l += ls; \
            _Pragma("unroll") for (int ks = 0; ks < 4; ++ks) { pg8::u32x4 w; \
                if (ks < 2) { w.x = pg8::cvt_pk_bf16(p0[8 * ks], p0[8 * ks + 1]); w.y = pg8::cvt_pk_bf16(p0[8 * ks + 2], p0[8 * ks + 3]); w.z = pg8::cvt_pk_bf16(p0[8 * ks + 4], p0[8 * ks + 5]); w.w = pg8::cvt_pk_bf16(p0[8 * ks + 6], p0[8 * ks + 7]); } \
                else { const int k2 = ks - 2; w.x = pg8::cvt_pk_bf16(p1[8 * k2], p1[8 * k2 + 1]); w.y = pg8::cvt_pk_bf16(p1[8 * k2 + 2], p1[8 * k2 + 3]); w.z = pg8::cvt_pk_bf16(p1[8 * k2 + 4], p1[8 * k2 + 5]); w.w = pg8::cvt_pk_bf16(p1[8 * k2 + 6], p1[8 * k2 + 7]); } \
                pa[ks] = __builtin_bit_cast(bf16x8_t, w); } } while (0)
#define ATT_PV(sl) do { const LAS unsigned char* vp = vbase + (sl) * VSLOT; \
            _Pragma("unroll") for (int dd = 0; dd < NOD; ++dd) \
                _Pragma("unroll") for (int ks = 0; ks < 4; ++ks) { \
                    const v4i16_t lo = __builtin_amdgcn_ds_read_tr16_b64_v4i16((LAS v4i16_t*)(vp + dd * 4096 + ks * 1024)); \
                    const v4i16_t hh = __builtin_amdgcn_ds_read_tr16_b64_v4i16((LAS v4i16_t*)(vp + dd * 4096 + ks * 1024 + 512)); \
                    const bf16x8_t vf = join_tr(lo, hh); \
                    if (VAR != 2) o[dd] = __builtin_amdgcn_mfma_f32_32x32x16_bf16(pa[ks], vf, o[dd], 0, 0, 0); else o[dd][ks] += __builtin_bit_cast(float, (int)vf[0] + (int)pa[ks][0]); } } while (0)
    int slot = 0, slot_prev = NSLOT - 1, slot_issue = PD % NSLOT;
    for (int t = 0; t < NT; ++t) {
        const int ahead = (t + PD - 1 < NT - 1 ? t + PD - 1 : NT - 1) - t;
        const int nwait = ahead * nld;
        if (nwait <= 0) ATT_BAR(0); else if (nwait == 2) ATT_BAR(2); else if (nwait == 3) ATT_BAR(3); else if (nwait == 4) ATT_BAR(4); else if (nwait == 6) ATT_BAR(6); else if (nwait == 8) ATT_BAR(8); else ATT_BAR(0);
        if (t + PD < NT) ATT_DMA(t + PD, slot_issue);
        if (!late) { if (t <= tlast) { ATT_QKSM(slot); ATT_PV(slot); } }
        else { if (t >= 1 && t - 1 <= tlast) ATT_PV(slot_prev); if (t <= tlast) ATT_QKSM(slot); }
        slot_prev = slot; slot = slot + 1 == NSLOT ? 0 : slot + 1; slot_issue = slot_issue + 1 == NSLOT ? 0 : slot_issue + 1;
    }
    if (late && tlast >= NT - 1) ATT_PV(slot_prev);
    l += __shfl_xor(l, 32);
    if (hi == 0) wsf[32 + r32] = l;
    ATT_BAR(0);
    LAS bf16* stg = (LAS bf16*)(S + KOFF) + wid * 32 * DVW;
#pragma unroll
    for (int r = 0; r < 16; ++r) { const int orow = crow16(r, hi); const float rl = __builtin_amdgcn_rcpf(wsf[32 + orow]);
#pragma unroll
        for (int dd = 0; dd < NOD; ++dd) stg[orow * DVW + dd * 32 + r32] = f2bf(o[dd][r] * rl); }
    LDS_WAIT(); asm volatile("" ::: "memory");
#pragma unroll
    for (int i = 0; i < DVW / 16; ++i) { const int idx = i * 64 + lane, row = idx / (DVW / 8), ch = idx % (DVW / 8);
        *(pg8::u32x4*)(Ou + (size_t)(32 * rg + row) * opitch + dp * DVW + ch * 8) = *(const LAS pg8::u32x4*)(stg + row * DVW + ch * 8); }
    ATT_BAR(0);
#undef ATT_DMA
#undef ATT_QKSM
#undef ATT_PV
}

typedef float f32x2_t __attribute__((ext_vector_type(2)));
DEVI unsigned cvtpk(float lo, float hi) { const f32x2_t v = {lo, hi}; const bf16x2_t b = __builtin_convertvector(v, bf16x2_t); return __builtin_bit_cast(unsigned, b); }
DEVI void attn_mla_unit(LAS unsigned char* S, const bf16* Qu, const bf16* Ku, const bf16* Vu, bf16* Ou, int NT, int qcb) {
    constexpr int NCH = 12, KSLOT = NCH * 1024, VSLOT = 8192, NSLOT = 4, NKS = 6, qpitch = 768, kpitch = 768, vpitch = 512, opitch = D;
    constexpr int KOFF = 0, VOFF = NSLOT * KSLOT, WSF = VOFF + NSLOT * VSLOT;
    int tid_ = threadIdx.x; asm volatile("" : "+v"(tid_));
    const int lane = tid_ & 63, wid = __builtin_amdgcn_readfirstlane(tid_ >> 6), r32 = lane & 31, hi = lane >> 5;
    LAS float* wsf = (LAS float*)(S + WSF) + wid * 64;
    const int nld = wid < 4 ? 3 : 2;
    const bf16* ksrc = Ku + (size_t)lane * kpitch;
    const bf16* vsrc = Vu + (size_t)(lane >> 2) * vpitch + (lane & 3) * 8;
#define MLA_DMA(t, slot) do { \
        glds16(ksrc + (size_t)(t) * 64 * kpitch + wid * 8, LDSADDR(S + KOFF + (slot) * KSLOT + wid * 1024)); \
        if (wid < 4) glds16(ksrc + (size_t)(t) * 64 * kpitch + (wid + 8) * 8, LDSADDR(S + KOFF + (slot) * KSLOT + (wid + 8) * 1024)); \
        glds16(vsrc + (size_t)((t) * 64 + (wid & 3) * 16) * vpitch + (wid >> 2) * 32, LDSADDR(S + VOFF + (slot) * VSLOT + wid * 1024)); } while (0)
#define MLA_BAR(nw) do { if ((nw) <= 0) ATT_BAR(0); else if ((nw) == 2) ATT_BAR(2); else if ((nw) == 3) ATT_BAR(3); else if ((nw) == 4) ATT_BAR(4); else ATT_BAR(6); } while (0)
#define SGB(mask, n) __builtin_amdgcn_sched_group_barrier(mask, n, 0)
    bf16x8_t qr[NKS];
#pragma unroll
    for (int ks = 0; ks < NKS; ++ks) qr[ks] = *(const bf16x8_t*)(Qu + (size_t)(32 * wid + r32) * qpitch + ks * 16 + hi * 8);
#pragma unroll
    for (int ks = 0; ks < NKS; ++ks) asm volatile("" : "+v"(qr[ks]));
    MLA_DMA(0, 0); MLA_DMA(1, 1); MLA_DMA(2, 2);
    f32x16_t o0 = f32x16_t{}, o1 = f32x16_t{};
    float m = 0.f, l = 0.f; f32x16_t negm = f32x16_t{};
    const int tlast = qcb + (wid >> 1);
    const LAS unsigned char* kbase = S + KOFF + hi * 1024 + r32 * 16;
    const LAS unsigned char* vbase = S + VOFF + ((lane >> 4) & 1) * 32 + (lane & 3) * 8 + (4 * hi + ((lane & 15) >> 2)) * 64;
    f32x16_t p0, p1;
#define MLA_ROWMAX(rm, q0, q1) do { float a_ = __builtin_fmaxf(__builtin_fmaxf(q0[0], q0[1]), q1[0]), b_ = __builtin_fmaxf(__builtin_fmaxf(q0[2], q0[3]), q1[1]); a_ = __builtin_fmaxf(__builtin_fmaxf(a_, q1[2]), q1[3]); \
        _Pragma("unroll") for (int r = 4; r < 16; r += 4) { a_ = __builtin_fmaxf(__builtin_fmaxf(a_, q0[r]), q0[r + 1]); b_ = __builtin_fmaxf(__builtin_fmaxf(b_, q0[r + 2]), q0[r + 3]); a_ = __builtin_fmaxf(__builtin_fmaxf(a_, q1[r]), q1[r + 1]); b_ = __builtin_fmaxf(__builtin_fmaxf(b_, q1[r + 2]), q1[r + 3]); } \
        rm = __builtin_fmaxf(a_, b_); rm = __builtin_fmaxf(rm, __shfl_xor(rm, 32)); } while (0)
#define MLA_MOVE(rm, q0, q1) do { if (__any(rm > 0.f)) { \
            const float dl = fmaxf(rm, 0.f), alpha = __builtin_amdgcn_exp2f(-dl); m += dl; l *= alpha; \
            _Pragma("unroll") for (int r = 0; r < 16; ++r) { q0[r] -= dl; q1[r] -= dl; negm[r] = -m; } \
            if (hi == 0) wsf[r32] = alpha; \
            LDS_WAIT(); asm volatile("" ::: "memory"); \
            _Pragma("unroll") for (int r = 0; r < 16; ++r) { const float f = wsf[crow16(r, hi)]; o0[r] *= f; o1[r] *= f; } \
            LDS_WAIT(); asm volatile("" ::: "memory"); } } while (0)
    MLA_BAR(2 * nld);
    MLA_DMA(3, 3);
    { const LAS unsigned char* kp = kbase; p0 = negm; p1 = negm;
#pragma unroll
      for (int ks = 0; ks < NKS; ++ks) { const bf16x8_t a0 = *(const LAS bf16x8_t*)(kp + ks * 2048), a1 = *(const LAS bf16x8_t*)(kp + ks * 2048 + 512);
          p0 = __builtin_amdgcn_mfma_f32_32x32x16_bf16(a0, qr[ks], p0, 0, 0, 0); p1 = __builtin_amdgcn_mfma_f32_32x32x16_bf16(a1, qr[ks], p1, 0, 0, 0); }
      float rm; MLA_ROWMAX(rm, p0, p1); MLA_MOVE(rm, p0, p1); }
    int kslot = 1, vslot = 0, islot = 3;
    for (int t = 0; t < NT; ++t) {
        if (t + 1 < NT) { const int young = (t + 2 < NT) ? 1 : 0; MLA_BAR(young * nld); } else ATT_BAR(0);
        if (t >= 1 && t + 3 < NT) MLA_DMA(t + 3, islot);
        if (t < tlast) {
            const LAS unsigned char* kp = kbase + kslot * KSLOT; const LAS unsigned char* vp = vbase + vslot * VSLOT;
            bf16x8_t kf[12];
#pragma unroll
            for (int ks = 0; ks < NKS; ++ks) { kf[2 * ks] = *(const LAS bf16x8_t*)(kp + ks * 2048); kf[2 * ks + 1] = *(const LAS bf16x8_t*)(kp + ks * 2048 + 512); }
            f32x16_t n0 = negm, n1 = negm; float ls = 0.f; pg8::u32x4 pw[4];
#pragma unroll
            for (int ks = 0; ks < NKS; ++ks) { n0 = __builtin_amdgcn_mfma_f32_32x32x16_bf16(kf[2 * ks], qr[ks], n0, 0, 0, 0); n1 = __builtin_amdgcn_mfma_f32_32x32x16_bf16(kf[2 * ks + 1], qr[ks], n1, 0, 0, 0); }
#pragma unroll
            for (int r = 0; r < 16; ++r) { p0[r] = __builtin_amdgcn_exp2f(p0[r]); p1[r] = __builtin_amdgcn_exp2f(p1[r]); }
#pragma unroll
            for (int r = 0; r < 16; r += 2) { ls += (p0[r] + p0[r + 1]) + (p1[r] + p1[r + 1]); }
#pragma unroll
            for (int ks = 0; ks < 2; ++ks) { pw[ks] = (pg8::u32x4){cvtpk(p0[8 * ks], p0[8 * ks + 1]), cvtpk(p0[8 * ks + 2], p0[8 * ks + 3]), cvtpk(p0[8 * ks + 4], p0[8 * ks + 5]), cvtpk(p0[8 * ks + 6], p0[8 * ks + 7])};
                pw[2 + ks] = (pg8::u32x4){cvtpk(p1[8 * ks], p1[8 * ks + 1]), cvtpk(p1[8 * ks + 2], p1[8 * ks + 3]), cvtpk(p1[8 * ks + 4], p1[8 * ks + 5]), cvtpk(p1[8 * ks + 6], p1[8 * ks + 7])}; }
            l += ls;
            SGB(0x100, 4);
#pragma unroll
            for (int i = 0; i < 12; ++i) { SGB(0x008, 1); SGB(0x002, 7); if (i < 8) SGB(0x100, 1); }
            __builtin_amdgcn_sched_barrier(0);
            v4i16_t vlo[8], vhi[8];
#pragma unroll
            for (int i = 0; i < 8; ++i) { vlo[i] = __builtin_amdgcn_ds_read_tr16_b64_v4i16((LAS v4i16_t*)(vp + (i >> 2) * 4096 + (i & 3) * 1024)); vhi[i] = __builtin_amdgcn_ds_read_tr16_b64_v4i16((LAS v4i16_t*)(vp + (i >> 2) * 4096 + (i & 3) * 1024 + 512)); }
#pragma unroll
            for (int i = 0; i < 8; ++i) { const bf16x8_t vf = join_tr(vlo[i], vhi[i]); const bf16x8_t pa_ = __builtin_bit_cast(bf16x8_t, pw[i & 3]);
                if (i < 4) o0 = __builtin_amdgcn_mfma_f32_32x32x16_bf16(pa_, vf, o0, 0, 0, 0); else o1 = __builtin_amdgcn_mfma_f32_32x32x16_bf16(pa_, vf, o1, 0, 0, 0); }
            float rm; MLA_ROWMAX(rm, n0, n1);
            SGB(0x100, 6);
#pragma unroll
            for (int i = 0; i < 8; ++i) { SGB(0x008, 1); SGB(0x002, 3); if (i < 5) SGB(0x100, 2); }
            __builtin_amdgcn_sched_barrier(0);
            MLA_MOVE(rm, n0, n1);
            p0 = n0; p1 = n1;
        } else if (t == tlast) {
            asm volatile("" : "+v"(p0), "+v"(p1));
            const LAS unsigned char* vp = vbase + vslot * VSLOT; float ls = 0.f; pg8::u32x4 pw[4];
#pragma unroll
            for (int r = 0; r < 16; ++r) { p0[r] = __builtin_amdgcn_exp2f(p0[r]); p1[r] = __builtin_amdgcn_exp2f(p1[r]); ls += p0[r] + p1[r]; }
            l += ls;
#pragma unroll
            for (int ks = 0; ks < 2; ++ks) { pw[ks] = (pg8::u32x4){cvtpk(p0[8 * ks], p0[8 * ks + 1]), cvtpk(p0[8 * ks + 2], p0[8 * ks + 3]), cvtpk(p0[8 * ks + 4], p0[8 * ks + 5]), cvtpk(p0[8 * ks + 6], p0[8 * ks + 7])};
                pw[2 + ks] = (pg8::u32x4){cvtpk(p1[8 * ks], p1[8 * ks + 1]), cvtpk(p1[8 * ks + 2], p1[8 * ks + 3]), cvtpk(p1[8 * ks + 4], p1[8 * ks + 5]), cvtpk(p1[8 * ks + 6], p1[8 * ks + 7])}; }
#pragma unroll
            for (int i = 0; i < 8; ++i) { const v4i16_t lo = __builtin_amdgcn_ds_read_tr16_b64_v4i16((LAS v4i16_t*)(vp + (i >> 2) * 4096 + (i & 3) * 1024)), hh = __builtin_amdgcn_ds_read_tr16_b64_v4i16((LAS v4i16_t*)(vp + (i >> 2) * 4096 + (i & 3) * 1024 + 512));
                const bf16x8_t vf = join_tr(lo, hh); const bf16x8_t pa_ = __builtin_bit_cast(bf16x8_t, pw[i & 3]);
                if (i < 4) o0 = __builtin_amdgcn_mfma_f32_32x32x16_bf16(pa_, vf, o0, 0, 0, 0); else o1 = __builtin_amdgcn_mfma_f32_32x32x16_bf16(pa_, vf, o1, 0, 0, 0); }
        }
        kslot = (kslot + 1) & 3; vslot = (vslot + 1) & 3; islot = (islot + 1) & 3;
    }
    l += __shfl_xor(l, 32);
    if (hi == 0) wsf[32 + r32] = l;
    ATT_BAR(0);
    LAS bf16* stg = (LAS bf16*)(S + KOFF) + wid * 32 * 64;
#pragma unroll
    for (int r = 0; r < 16; ++r) { const int orow = crow16(r, hi); const float rl = __builtin_amdgcn_rcpf(wsf[32 + orow]);
        stg[orow * 64 + r32] = f2bf(o0[r] * rl); stg[orow * 64 + 32 + r32] = f2bf(o1[r] * rl); }
    LDS_WAIT(); asm volatile("" ::: "memory");
#pragma unroll
    for (int i = 0; i < 4; ++i) { const int idx = i * 64 + lane, row = idx >> 3, ch = idx & 7;
        *(pg8::u32x4*)(Ou + (size_t)(32 * wid + row) * opitch + ch * 8) = *(const LAS pg8::u32x4*)(stg + row * 64 + ch * 8); }
    ATT_BAR(0);
#undef MLA_DMA
#undef MLA_BAR
#undef MLA_ROWMAX
#undef MLA_MOVE
#undef SGB
}

DEVI bool unit_of(int Mrows, int Ncols, int G, int c, int i, int& pm, int& pn) {
    const int nM = Mrows / 256, nN = Ncols / 256, nwg = nM * nN; const long Lq = (long)i * G + c; if (Lq >= nwg) return false;
    int wgid = (int)Lq; { const int q = nwg / 8, r = nwg % 8, xcd = wgid % 8, off = wgid / 8; wgid = (xcd < r ? xcd * (q + 1) : r * (q + 1) + (xcd - r) * q) + off; }
    const int nig = 8 * nN, gid = wgid / nig, fm = gid * 8, gsz = (nM - fm) < 8 ? (nM - fm) : 8;
    pm = fm + ((wgid % nig) % gsz); pn = (wgid % nig) / gsz; return true;
}
DEVI void own_writes_visible() {
    asm volatile("s_waitcnt vmcnt(0)" ::: "memory"); __syncthreads();
    if (threadIdx.x == 0) { __builtin_amdgcn_fence(__ATOMIC_ACQUIRE, "agent"); asm volatile("s_waitcnt vmcnt(0)" ::: "memory"); }
    __syncthreads();
}

__global__ void __launch_bounds__(NTHR, 2) mega(Args args) {
    extern __shared__ __attribute__((aligned(16))) unsigned char lds[];
    const int tid = threadIdx.x, lane = tid & 63, wave = __builtin_amdgcn_readfirstlane(tid >> 6);
    const int G = gridDim.x, bx = blockIdx.x; const int vcu = (G % 8 == 0) ? (bx % 8) * (G / 8) + bx / 8 : bx;
    LAS unsigned char* L = (LAS unsigned char*)lds + PH_BASE;
    volatile LAS unsigned* MISC = (volatile LAS unsigned*)((LAS unsigned char*)lds + LDSCTL_OFF + 320);
    unsigned char* ws = args.ws; gu32* ctl = (gu32*)(ws + WS_CTL);
    if (tid < PH_BASE / 4) ((LAS unsigned*)(lds))[tid] = 0u;
    __syncthreads();
    XcdBarrier bar = xcd_barrier_post((unsigned*)(ctl + CW_BAR) + args.li * XCD_BAR_WORDS, MISC + 8);
    const unsigned mask = args.mask;
#define IN(k) ((mask >> (k)) & 1u)
#ifndef PROBE_ATTVAR
#define PROBE_ATTVAR 0
#endif
#ifndef PROBE_EXPVAR
#define PROBE_EXPVAR 0
#endif
#ifndef V_IN_PROJ
#define V_IN_PROJ 1
#endif
#ifndef PROBE_REP
#define PROBE_REP 0u
#endif
#define NREP(k) (1 + (int)((PROBE_REP >> (k)) & 1u))
#define SEAM(k) do { if ((mask & ((1u << PH_N) - 1u)) >> ((k) + 1)) xcd_barrier(bar); } while (0)
    const float* x = args.in[0]; float* out = args.out;
    bf16 *Wt_in = (bf16*)(ws + WS_WIN), *Wt_qup = (bf16*)(ws + WS_WQUP), *Wt_kv = (bf16*)(ws + WS_WKV), *Wt_mix = (bf16*)(ws + WS_WMIX), *Wt_mq = (bf16*)(ws + WS_WMQ), *Wt_mkv = (bf16*)(ws + WS_WMKV),
         *Wt_mo = (bf16*)(ws + WS_WMO), *Wt_pq = (bf16*)(ws + WS_WPQ), *SK = (bf16*)(ws + WS_SK), *MEMN = (bf16*)(ws + WS_MEMN), *MEMKV = (bf16*)(ws + WS_MEMKV), *PU = (bf16*)(ws + WS_PU), *PV = (bf16*)(ws + WS_PV);
    float *partq = (float*)(ws + WS_PARTQ), *partkv = (float*)(ws + WS_PARTKV), *part1 = (float*)(ws + WS_PART1), *part2 = (float*)(ws + WS_PART2), *trig = (float*)(ws + WS_TRIG);
    bf16 *XN = (bf16*)(ws + WS_R1), *CONCAT = XN, *QM = XN, *H2B = XN;
    bf16 *CQ = (bf16*)(ws + WS_R2 + R2_CQ), *CKV = (bf16*)(ws + WS_R2 + R2_CKV), *U = (bf16*)(ws + WS_R2 + R2_U), *H1B = (bf16*)(ws + WS_R2), *OM = (bf16*)(ws + WS_R3);
    bf16 *QB = (bf16*)(ws + WS_R3 + R3_QB), *KB = (bf16*)(ws + WS_R3 + R3_KB), *VB = (bf16*)(ws + WS_R3 + R3_VB), *QP = (bf16*)(ws + WS_R3);


    if (IN(PH_PRO)) {
        for (int rep_ = 0; rep_ < NREP(PH_PRO); ++rep_) { if (rep_) xcd_barrier(bar);
        LAS float* scr = (LAS float*)(L + wave * 16384);
        const int gw = vcu * NWAVES + wave, NGW = G * NWAVES;
        constexpr int I_IN = (D / 64) * (INP / 32), I_QUP = (256 / 64) * (768 / 32), I_KV = (128 / 64) * (1024 / 32), I_SQ = (D / 64) * (D / 32), I_W2 = (D / 64) * (2048 / 32);
        constexpr int NITEMS = I_IN + I_QUP + I_KV + 2 * I_SQ + 2 * I_W2;
        for (int rp_ = 0; rp_ < 1 + (int)((PROBE_REP >> 20) & 1u); ++rp_)
        for (int it = gw; it < NITEMS; it += NGW) {
            int r = it;
            if (r < I_IN) { p0_transpose_item<1, false>(args.in[3], D, INC, Wt_in, INP, nullptr, scr, r, lane); continue; } r -= I_IN;
            if (r < I_QUP) { p0_transpose_item<0, true>(args.in[5], 256, 768, Wt_qup, 768, args.in[4], scr, r, lane); continue; } r -= I_QUP;
            if (r < I_KV) { p0_transpose_item<2, true>(args.in[7], 128, 1024, Wt_kv, 1024, args.in[6], scr, r, lane); continue; } r -= I_KV;
            if (r < I_SQ) { p0_transpose_item<0, false>(args.in[12], D, D, Wt_mix, D, nullptr, scr, r, lane); continue; } r -= I_SQ;
            if (r < I_SQ) { p0_transpose_item<0, false>(args.in[17], D, D, Wt_mo, D, nullptr, scr, r, lane); continue; } r -= I_SQ;
            if (r < I_W2) { p0_transpose_item<0, false>(args.in[16], D, 2048, Wt_mkv, 2048, nullptr, scr, r, lane); continue; } r -= I_W2;
            p0_transpose_item<0, true>(args.in[19], D, 2048, Wt_pq, 2048, args.in[18], scr, r, lane);
        }
        for (int rp_ = 0; rp_ < 1 + (int)((PROBE_REP >> 21) & 1u); ++rp_)
        for (int m = gw; m < M; m += 4 * NGW) rms_rows4_to_bf16(x, args.in[2], XN, m, NGW, M, lane);
        for (int m = gw; m < BATCH * NMEM; m += NGW) rms_row_to_bf16(args.in[1] + (size_t)m * D, args.in[14], MEMN + (size_t)m * D, lane);
        const size_t gtid = (size_t)vcu * NTHR + tid, gn = (size_t)G * NTHR;
        cvt_stream(args.in[20], SK, (size_t)PH * 2 * PNK * PHALF / 8, nullptr, gtid, gn);
        for (size_t i = gtid; i < (size_t)D * D / 8; i += gn) {
            const float4 a = *(const float4*)(args.in[15] + i * 8), b = *(const float4*)(args.in[15] + i * 8 + 4); const float gk = args.in[13][(i * 8) >> 10];
            pg8::u32x4 o; o.x = pg8::cvt_pk_bf16(a.x * gk, a.y * gk); o.y = pg8::cvt_pk_bf16(a.z * gk, a.w * gk); o.z = pg8::cvt_pk_bf16(b.x * gk, b.y * gk); o.w = pg8::cvt_pk_bf16(b.z * gk, b.w * gk);
            *(pg8::u32x4*)(Wt_mq + i * 8) = o; }
        for (int rp_ = 0; rp_ < 1 + (int)((PROBE_REP >> 22) & 1u); ++rp_) {
        cvt_rows_fp6<true>(args.in[21], (unsigned char*)PU, args.in[18], PU_SCALE, gtid, gn);
        if (!V_IN_PROJ) cvt_rows_fp6<false>(args.in[22], (unsigned char*)PV, nullptr, PV_SCALE, gtid, gn); }
        for (size_t i = gtid; i < (size_t)SEQ * 16; i += gn) { float c, s; rope_cs((int)(i >> 4), (int)(i & 15), c, s); *(float2*)(trig + i * 2) = make_float2(c, s); }
        }
        SEAM(PH_PRO);
    }
    if (IN(PH_PROJ)) {
        for (int rep_ = 0; rep_ < NREP(PH_PROJ); ++rep_) { if (rep_) xcd_barrier(bar);
        { pg8::Gemm g{XN, Wt_in, M, INP, D, 0, 0, 0, 0}; pg8::StaticOrder S; S.init(M, INP, G, bx); pg8::EpiProj E{CQ, CKV, KB, U, partq, partkv, trig};
          pg8::gemm_phase<pg8::EpiProj, pg8::StaticOrder, true, true>(L, g, S, E); }
        { pg8::Gemm g{MEMN, Wt_mkv, BATCH * NMEM, 2048, D, 0, 0, 0, 0}; pg8::StaticOrder S; S.init(BATCH * NMEM, 2048, G, (bx + 128) % G); pg8::EpiPlain E{MEMKV, 2048};
          pg8::gemm_phase<pg8::EpiPlain, pg8::StaticOrder, true, true>(L, g, S, E); }
        if (V_IN_PROJ && bx >= 144) { asm volatile("" ::: "memory"); cvt_rows_fp6<false>(args.in[22], (unsigned char*)PV, nullptr, PV_SCALE, (size_t)(bx - 144) * NTHR + threadIdx.x, (size_t)(G - 144) * NTHR); asm volatile("" ::: "memory"); }
        }
        SEAM(PH_PROJ);
    }
    if (IN(PH_UP)) {
        for (int rep_ = 0; rep_ < NREP(PH_UP); ++rep_) { if (rep_) xcd_barrier(bar);
        if (IN(PHB_UPG)) {
        { pg8::Gemm g{CQ, Wt_qup, M, 768, 256, 0, 0, 0, 0}; pg8::StaticOrder S; S.init(M, 768, G, bx); pg8::EpiQ E{QB, partq, trig, LOG2E * 0.10206207261596577f};
          pg8::gemm_phase<pg8::EpiQ, pg8::StaticOrder, true, true>(L, g, S, E); }
        { pg8::Gemm g{CKV, Wt_kv, M, 1024, 128, 0, 0, 0, 0}; pg8::StaticOrder S; S.init(M, 1024, G, (bx + 192) % G); pg8::EpiKV E{KB, VB, partkv};
          pg8::gemm_phase<pg8::EpiKV, pg8::StaticOrder, true, true>(L, g, S, E); }
        }
        if (IN(PHB_CONV)) { __syncthreads(); for (int c = vcu; c < M / 64; c += G) conv_chunk(c, U, args.in[8], args.in[9], args.in[10], args.in[11], CONCAT, L); }
        }
        SEAM(PH_UP);
    }
    if (IN(PH_ATTN)) {
        for (int rep_ = 0; rep_ < NREP(PH_ATTN); ++rep_) { if (rep_) xcd_barrier(bar);
        for (int u = vcu; u < 512; u += G) { const int bh = (u & 255) >> 4, sidx = u & 15, qb = u < 256 ? 31 - sidx : sidx, b = bh >> 3, h = bh & 7;
            const size_t r0 = (size_t)b * SEQ;
            if (NREP(PH_ATTN) > 1 && rep_ == 0) attn_unit<96, 64, 1, 4, 3, true, false, PROBE_ATTVAR>(L, QB + (r0 + qb * 256) * 768 + h * 96, 768, KB + r0 * 768 + h * 96, 768, VB + r0 * 512 + h * 64, 512, CONCAT + (r0 + qb * 256) * D + h * 64, D, 4 * qb + 4, 4 * qb);
            else attn_mla_unit(L, QB + (r0 + qb * 256) * 768 + h * 96, KB + r0 * 768 + h * 96, VB + r0 * 512 + h * 64, CONCAT + (r0 + qb * 256) * D + h * 64, 4 * qb + 4, 4 * qb); }
        }
        { bf16* KQT = (bf16*)(ws + WS_KQT); bf16* VOT = (bf16*)(ws + WS_VOT);
#pragma unroll 1
          for (int bh = 0; bh < BATCH * XH; ++bh) { const int b = bh >> 2, h = bh & 3;
            { pg8::Gemm g{MEMKV + (size_t)b * NMEM * 2048 + h * XD, Wt_mq + h * XD, NMEM, D, XD, 2048, D, 0, 0}; pg8::StaticOrder S; S.init(NMEM, D, G, (bx + 8 * bh) % G);
              pg8::EpiPlain E{KQT + (size_t)b * D * D + (size_t)h * XD * D, D}; pg8::gemm_phase<pg8::EpiPlain, pg8::StaticOrder, true, true>(L, g, S, E); }
            { pg8::Gemm g{Wt_mo + h * XD, MEMKV + (size_t)b * NMEM * 2048 + 1024 + h * XD, D, NMEM, XD, D, 2048, 0, 0}; pg8::StaticOrder S; S.init(D, NMEM, G, (bx + 8 * bh + 4) % G);
              pg8::EpiPlain E{VOT + (size_t)b * D * D + h * XD, D}; pg8::gemm_phase<pg8::EpiPlain, pg8::StaticOrder, true, true>(L, g, S, E); } } }
        SEAM(PH_ATTN);
    }
    if (IN(PH_MIX)) {
        for (int rep_ = 0; rep_ < NREP(PH_MIX); ++rep_) { if (rep_) xcd_barrier(bar);
        pg8::Gemm g{CONCAT, Wt_mix, M, D, D, 0, 0, 0, 0}; pg8::StaticOrder S; S.init(M, D, G, bx); pg8::EpiRes<false> E{x, nullptr, H1B, part1};
        pg8::gemm_phase<pg8::EpiRes<false>, pg8::StaticOrder, true, true>(L, g, S, E);
        }
        SEAM(PH_MIX);
    }
    if (IN(PH_MEMQ)) {
        for (int rep_ = 0; rep_ < NREP(PH_MEMQ); ++rep_) { if (rep_) xcd_barrier(bar);
        pg8::Gemm g{H1B, (const bf16*)(ws + WS_KQT), M, D, D, 0, 0, SEQ / 256, (size_t)D * D * 2}; pg8::StaticOrder S; S.init(M, D, G, bx);
        pg8::EpiSoftmaxP E{OM, D, part1, LOG2E / 16.0f, (LAS float*)(L + 131072)};
        pg8::gemm_phase<pg8::EpiSoftmaxP, pg8::StaticOrder, true, true>(L, g, S, E);
        }
        SEAM(PH_MEMQ);
    }
    if (IN(PH_MEMO)) {
        pg8::Gemm g{OM, (const bf16*)(ws + WS_VOT), M, D, D, 0, 0, SEQ / 256, (size_t)D * D * 2};   pg8::StaticOrder S; S.init(M, D, G, bx); pg8::EpiRes<true> E{nullptr, H1B, H2B, part2};
        pg8::gemm_phase<pg8::EpiRes<true>, pg8::StaticOrder, true, true>(L, g, S, E);
        SEAM(PH_MEMO);
    }
    if (IN(PH_PQ)) {
        for (int rep_ = 0; rep_ < NREP(PH_PQ); ++rep_) { if (rep_) xcd_barrier(bar);
        pg8::Gemm g{H2B, Wt_pq, M, 2048, D, 0, 0, 0, 0}; pg8::StaticOrder S; S.init(M, 2048, G, bx); pg8::EpiScaled E{QP, 2048, part2, 1.0f};
        pg8::gemm_phase<pg8::EpiScaled, pg8::StaticOrder, true, true>(L, g, S, E);
        own_writes_visible();
        int* EIDX = (int*)(ws + WS_R2 + R2_EIDX); float* EGATE = (float*)(ws + WS_R2 + R2_EGATE);
        LAS unsigned* scr = (LAS unsigned*)(L + 65536 + wave * 64 * 9 * 4);
        int hl = -1, upm, upn;
        for (int i = 0; unit_of(M, 2048, G, bx, i, upm, upn); ++i) { const int tb = upm, h = upn;
            if (h != hl) {
                __syncthreads();
                for (int pc = tid; pc < 4096; pc += NTHR) { const int p = pc >> 11, n = (pc >> 4) & 127, c = pc & 15;
                    *(LAS pg8::u32x4*)(L + p * 32768 + c * 2048 + n * 16) = *(const pg8::u32x4*)(SK + ((size_t)(h * 2 + p) * 128 + n) * 128 + c * 8); }
                __syncthreads(); hl = h; }
            const int token = tb * 256 + wave * 32 + (lane & 31);
            topk_wave(QP + (size_t)token * 2048 + h * 256, L, scr, EIDX + (size_t)token * 128 + h * 16, EGATE + (size_t)token * 128 + h * 16, lane); }
        __syncthreads();
        }
        SEAM(PH_PQ);
    }
    if (IN(PH_EXP)) {
        const int* EIDX = (const int*)(ws + WS_R2 + R2_EIDX); const float* EGATE = (const float*)(ws + WS_R2 + R2_EGATE);
#ifndef EXP_PREWARM
#define EXP_PREWARM 0
#endif
        if (EXP_PREWARM) {
            const pg8::u32x4* tb = (const pg8::u32x4*)PU; pg8::u32x4 x = {0u, 0u, 0u, 0u};
            for (size_t i = (size_t)vcu * NTHR + tid; i < (size_t)2 * PE * D / 16; i += (size_t)G * NTHR) { const pg8::u32x4 v = __builtin_nontemporal_load(tb + i); x ^= v; }
            if ((x[0] ^ x[1] ^ x[2] ^ x[3]) == 0x9e3779b9u && tid == 999) out[0] = 0.f;
        }
        for (int rep_ = NREP(PH_EXP) - 1; rep_ >= 0; --rep_) { float* dst = rep_ ? (float*)(ws + WS_R3) : out;
            if (rep_) { if (PROBE_EXPVAR != 5 || wave < 4) experts_wave<PROBE_EXPVAR == 5 ? 0 : PROBE_EXPVAR>(L + wave * EXP_LDS_WAVE, vcu * NWAVES + wave, G * NWAVES, H2B, part2, (const unsigned char*)PU, (const unsigned char*)PV, EIDX, EGATE, args.in[23], dst, lane); } else
            experts_wave<0>(L + wave * EXP_LDS_WAVE, vcu * NWAVES + wave, G * NWAVES, H2B, part2, (const unsigned char*)PU, (const unsigned char*)PV, EIDX, EGATE, args.in[23], dst, lane);
            if (rep_) xcd_barrier(bar); }
    }
#undef IN
#undef SEAM
}

#define FAST_MASK ((1u << PH_PRO) | (1u << PH_PROJ) | (1u << PH_UP) | (1u << PHB_UPG) | (1u << PHB_CONV) | (1u << PH_ATTN) | (1u << PH_MIX) | (1u << PH_MEMQ) | (1u << PH_MEMO) | (1u << PH_PQ) | (1u << PH_EXP))
extern "C" void kernel_launch(void* const* d_in, const int* in_sizes, int n_in, void* d_out, int out_size, void* d_ws, size_t ws_size, hipStream_t stream) {
    if (n_in != 24 || out_size != M * D || ws_size < WS_END) { fprintf(stderr, "kernel_launch: unexpected problem (n_in %d out %d ws %zu)\n", n_in, out_size, ws_size); return; }
    static int grid = 0;
    if (grid == 0) {
        int dev = 0, cus = 0, per_cu = 0;
        if (hipGetDevice(&dev) != hipSuccess || hipDeviceGetAttribute(&cus, hipDeviceAttributeMultiprocessorCount, dev) != hipSuccess) { grid = -1; return; }
        if (hipFuncSetAttribute((const void*)mega, hipFuncAttributeMaxDynamicSharedMemorySize, LDS_BYTES) != hipSuccess) { fprintf(stderr, "kernel_launch: hipFuncSetAttribute failed\n"); grid = -1; return; }
        if (hipOccupancyMaxActiveBlocksPerMultiprocessor(&per_cu, (const void*)mega, NTHR, LDS_BYTES) != hipSuccess || per_cu < 1) { fprintf(stderr, "kernel_launch: occupancy query says %d blocks per CU\n", per_cu); grid = -1; (void)hipGetLastError(); return; }
        grid = cus;
    }
    if (grid < 0) return;
    (void)hipMemsetAsync((char*)d_ws + WS_CTL, 0, CTL_ZERO_BYTES, stream);
    Args a{}; for (int i = 0; i < 24; ++i) a.in[i] = (const float*)d_in[i]; a.out = (float*)d_out; a.ws = (unsigned char*)d_ws; a.mask = FAST_MASK; a.li = 0;
    hipLaunchKernelGGL(mega, dim3(grid), dim3(NTHR), LDS_BYTES, stream, a);
}
```

```cpp
#include <hip/hip_runtime.h>
#include <cstdio>
#include <cstdint>

typedef unsigned short bf16;
#define DEVI __device__ __forceinline__

constexpr int D = 1024, BATCH = 2, SEQ = 8192, M = BATCH * SEQ;
constexpr int NMEM = 256;
constexpr int MH = 8, QRANK = 256, KVRANK = 128, NOPE = 64, ROPE = 32, VD = 64, QK = NOPE + ROPE;
constexpr int CW = 512, CK = 31;
constexpr int INC = QRANK + KVRANK + ROPE + 2 * CW;
constexpr int INP = 1536;
constexpr int XH = 4, XD = 256;
constexpr int PH = 8, PNK = 128, PHALF = 128, PTOP = 16, PE = PNK * PNK;
constexpr float EPS = 1e-6f;
constexpr float LOG2E = 1.4426950408889634f;
constexpr float PU_SCALE = 64.0f, PV_SCALE = 4.0f;

constexpr size_t MiB = 1u << 20;
constexpr size_t WS_CTL = 0;
constexpr size_t WS_WIN = 1 * MiB;
constexpr size_t WS_WQUP = 4 * MiB;
constexpr size_t WS_WKV = 5 * MiB;
constexpr size_t WS_WMIX = 6 * MiB;
constexpr size_t WS_WMQ = 8 * MiB;
constexpr size_t WS_WMKV = 10 * MiB;
constexpr size_t WS_WMO = 14 * MiB;
constexpr size_t WS_WPQ = 16 * MiB;
constexpr size_t WS_SK = 20 * MiB;
constexpr size_t WS_MEMN = 21 * MiB;
constexpr size_t WS_MEMKV = 22 * MiB;
constexpr size_t WS_PARTQ = 24 * MiB;
constexpr size_t WS_PARTKV = 24 * MiB + 512 * 1024;
constexpr size_t WS_PART1 = 25 * MiB;
constexpr size_t WS_PART2 = 26 * MiB;
constexpr size_t WS_PU = 28 * MiB;
constexpr size_t WS_PV = 60 * MiB;
constexpr size_t WS_R1 = 92 * MiB;
constexpr size_t WS_R2 = 124 * MiB;
constexpr size_t WS_R3 = 156 * MiB;
constexpr size_t WS_KQT = 220 * MiB;
constexpr size_t WS_VOT = 224 * MiB;
constexpr size_t WS_END = 228 * MiB;
constexpr size_t R2_CQ = 0, R2_CKV = 8 * MiB, R2_U = 12 * MiB;
constexpr size_t R2_EIDX = 0, R2_EGATE = 8 * MiB;
constexpr size_t R3_QB = 0, R3_KB = 24 * MiB, R3_VB = 48 * MiB;

DEVI bf16 f2bf(float f) { unsigned u = __builtin_bit_cast(unsigned, f); return (bf16)((u + 0x7fffu + ((u >> 16) & 1u)) >> 16); }
DEVI float bf2f(bf16 b) { return __builtin_bit_cast(float, (unsigned)b << 16); }
DEVI float dotbf(const bf16* a, const bf16* b, int K) {
    float s = 0.f;
    for (int k = 0; k < K; k += 8) {
        uint4 x = *(const uint4*)(a + k), y = *(const uint4*)(b + k);
        const unsigned xs[4] = {x.x, x.y, x.z, x.w}, ys[4] = {y.x, y.y, y.z, y.w};
#pragma unroll
        for (int i = 0; i < 4; ++i) {
            s += __builtin_bit_cast(float, xs[i] << 16) * __builtin_bit_cast(float, ys[i] << 16);
            s += __builtin_bit_cast(float, xs[i] & 0xffff0000u) * __builtin_bit_cast(float, ys[i] & 0xffff0000u);
        }
    }
    return s;
}
DEVI float wave_sum(float v) {
#pragma unroll
    for (int o = 1; o < 64; o <<= 1) v += __shfl_xor(v, o);
    return v;
}
DEVI float wave_max(float v) {
#pragma unroll
    for (int o = 1; o < 64; o <<= 1) v = fmaxf(v, __shfl_xor(v, o));
    return v;
}
DEVI void rope_cs(int pos, int i, float& c, float& s) {
    const float inv = exp2f(-(float)i * (13.287712379549449f / 16.0f));
    const float ang = (float)pos * inv;
    const double a = (double)ang; const double k = rint(a * 0.15915494309189535); const float r = (float)(a - k * 6.283185307179586);
    s = sinf(r); c = cosf(r);
}
DEVI int win_src(int r) {
    if (r < 416) return r;
    if (r < 512) return -1;
    const int t = (r - 512) >> 8, w = (r - 512) & 255, bj = w >> 7, j = w & 127, ch = 128 * t + j;
    return 416 + (bj ? CW : 0) + ch;
}
DEVI int wkv_src(int r) { return r < 512 ? (r >> 6) * 128 + (r & 63) : ((r - 512) >> 6) * 128 + 64 + ((r - 512) & 63); }

namespace pg8 {
#define PG8_LAS __attribute__((address_space(3)))
typedef unsigned short bf16_t;
typedef short bf16x8 __attribute__((ext_vector_type(8)));
typedef float f32x4 __attribute__((ext_vector_type(4)));
typedef unsigned u32x4 __attribute__((ext_vector_type(4)));
constexpr int BM = 256, BK = 64, HALF = 128, HTB = HALF * BK * 2  , STAGE_BYTES = 8 * HTB, NXCD = 8, WGM = 8;

__host__ __device__ __forceinline__ int lds_byte(int r, int c) { const int st = (r >> 4) * 2 + (c >> 5), rr = r & 15, cc = c & 31, ob = rr * 64 + cc * 2; return st * 1024 + (ob ^ (((ob >> 9) & 1) << 5)); }
__host__ __device__ __forceinline__ void stage_rc(int b, int& R, int& C) { const int st = b / 1024, sb = b % 1024, swz = sb ^ (((sb >> 9) & 1) << 5); R = (st >> 1) * 16 + swz / 64; C = (st & 1) * 32 + (swz % 64) / 2; }
__host__ __device__ __forceinline__ int perm32(int rho) { const int n = rho >> 4, i = rho & 15; return 8 * (i >> 2) + 4 * n + (i & 3); }

struct Unit { int pm, pn; };
struct Gemm { const bf16_t* A; const bf16_t* Bt; int M, N, K; int lda, ldb; int mb; size_t bstride; };

struct StaticOrder {
    int nM, nN, nwg, G, c;
    __host__ __device__ void init(int M, int N, int G_, int c_) { nM = M / BM; nN = N / BM; nwg = nM * nN; G = G_; c = c_; }
    __host__ __device__ bool next(int i, Unit& u) const {
        const long L = (long)i * G + c; if (L >= nwg) return false;
        int wgid = (int)L; { const int q = nwg / NXCD, r = nwg % NXCD, xcd = wgid % NXCD, off = wgid / NXCD; wgid = (xcd < r ? xcd * (q + 1) : r * (q + 1) + (xcd - r) * q) + off; }
        const int nig = WGM * nN, gid = wgid / nig, fm = gid * WGM, gsz = (nM - fm) < WGM ? (nM - fm) : WGM;
        u.pm = fm + ((wgid % nig) % gsz); u.pn = (wgid % nig) / gsz; return true;
    }
    __device__ __forceinline__ void a_ready(const Unit&) const {}
    __device__ __forceinline__ void done(const Unit&) const {}
};


typedef float f32x2 __attribute__((ext_vector_type(2)));
typedef unsigned u32x2 __attribute__((ext_vector_type(2)));
__device__ __forceinline__ unsigned cvt_pk_bf16(float lo, float hi) { unsigned r; asm volatile("v_cvt_pk_bf16_f32 %0, %1, %2" : "=v"(r) : "v"(lo), "v"(hi)); return r; }
__device__ __forceinline__ void st_bf4(bf16_t* p, f32x4 v) { u32x2 w; w.x = cvt_pk_bf16(v[0], v[1]); w.y = cvt_pk_bf16(v[2], v[3]); *(u32x2*)p = w; }
__device__ __forceinline__ float sq4(f32x4 v) { return (v[0] * v[0] + v[1] * v[1]) + (v[2] * v[2] + v[3] * v[3]); }
__device__ __forceinline__ float red_fq(float s) { s += __shfl_xor(s, 16); s += __shfl_xor(s, 32); return s; }

struct EpiProj {
    static constexpr bool PERM = false, AFTER_DRAIN = false;
    bf16_t *CQ, *CKV, *KB, *U; float *partq, *partkv; const float* trig;
    __device__ __forceinline__ void operator()(const f32x4 (&acc)[2][2][4][2], const Unit& u, int wr, int wc, int fr, int fq) const {
        const int row0 = u.pm * BM + wr * 64 + fr;
        if (u.pn == 0) {
#pragma unroll
            for (int ai = 0; ai < 2; ++ai)
#pragma unroll
                for (int m = 0; m < 4; ++m) { const int row = row0 + ai * HALF + m * 16; float s = 0.f;
#pragma unroll
                    for (int bj = 0; bj < 2; ++bj)
#pragma unroll
                        for (int n = 0; n < 2; ++n) { const f32x4 v = acc[ai][bj][m][n]; s += sq4(v); st_bf4(CQ + (size_t)row * 256 + bj * HALF + wc * 32 + n * 16 + fq * 4, v); }
                    s = red_fq(s); if (fq == 0) partq[(size_t)row * 4 + wc] = s; }
        } else if (u.pn == 1) {
            f32x4 tc0 = {0.f, 0.f, 0.f, 0.f}, tc1 = tc0, tn0 = tc0, tn1 = tc0;
            if (wc == 0) { const float* tp = trig + ((size_t)(row0 % SEQ) * 16 + fq * 4) * 2; tc0 = *(const f32x4*)tp; tc1 = *(const f32x4*)(tp + 4); }
#pragma unroll
            for (int i8 = 0; i8 < 8; ++i8) { const int ai = i8 >> 2, m = i8 & 3; const int row = row0 + ai * HALF + m * 16; float s = 0.f;
                if (wc == 0 && i8 < 7) { const int rown = row0 + ((i8 + 1) >> 2) * HALF + ((i8 + 1) & 3) * 16; const float* tp = trig + ((size_t)(rown % SEQ) * 16 + fq * 4) * 2; tn0 = *(const f32x4*)tp; tn1 = *(const f32x4*)(tp + 4); }
#pragma unroll
                for (int n = 0; n < 2; ++n) { const f32x4 v = acc[ai][0][m][n]; s += sq4(v); st_bf4(CKV + (size_t)row * 128 + wc * 32 + n * 16 + fq * 4, v); }
                s = red_fq(s); if (fq == 0) partkv[(size_t)row * 4 + wc] = s;
                if (wc == 0) { const f32x4 x1 = acc[ai][1][m][0], x2 = acc[ai][1][m][1]; const f32x4 t0 = tc0, t1 = tc1;
                    f32x4 o1, o2; o1[0] = x1[0] * t0[0] - x2[0] * t0[1]; o2[0] = x1[0] * t0[1] + x2[0] * t0[0]; o1[1] = x1[1] * t0[2] - x2[1] * t0[3]; o2[1] = x1[1] * t0[3] + x2[1] * t0[2];
                    o1[2] = x1[2] * t1[0] - x2[2] * t1[1]; o2[2] = x1[2] * t1[1] + x2[2] * t1[0]; o1[3] = x1[3] * t1[2] - x2[3] * t1[3]; o2[3] = x1[3] * t1[3] + x2[3] * t1[2];
                    u32x2 w1, w2; w1.x = cvt_pk_bf16(o1[0], o1[1]); w1.y = cvt_pk_bf16(o1[2], o1[3]); w2.x = cvt_pk_bf16(o2[0], o2[1]); w2.y = cvt_pk_bf16(o2[2], o2[3]);
#pragma unroll
                    for (int h = 0; h < 8; ++h) { *(u32x2*)(KB + (size_t)row * 768 + h * 96 + 64 + fq * 4) = w1; *(u32x2*)(KB + (size_t)row * 768 + h * 96 + 80 + fq * 4) = w2; } }
                tc0 = tn0; tc1 = tn1; asm volatile("" ::: "memory"); }
        } else {
            const int t = u.pn - 2;
#pragma unroll
            for (int ai = 0; ai < 2; ++ai)
#pragma unroll
                for (int m = 0; m < 4; ++m) { const int row = row0 + ai * HALF + m * 16;
#pragma unroll
                    for (int n = 0; n < 2; ++n) { const f32x4 val = acc[ai][0][m][n], gate = acc[ai][1][m][n]; f32x4 o;
#pragma unroll
                        for (int i = 0; i < 4; ++i) o[i] = val[i] * __builtin_amdgcn_rcpf(1.f + __expf(-gate[i]));
                        st_bf4(U + (size_t)row * 512 + t * 128 + wc * 32 + n * 16 + fq * 4, o); } }
        }
    }
};
struct EpiQ {
    static constexpr bool PERM = false, AFTER_DRAIN = false;
    bf16_t* QB; const float* partq; const float* trig; float c2;
    __device__ __forceinline__ void operator()(const f32x4 (&acc)[2][2][4][2], const Unit& u, int wr, int wc, int fr, int fq) const {
        const int row0 = u.pm * BM + wr * 64 + fr;
        const bool rope = ((u.pn * 8 + wc) % 3 == 2) || ((u.pn * 8 + 4 + wc) % 3 == 2);
        f32x4 ppc = *(const f32x4*)(partq + (size_t)row0 * 4), ppn = ppc;
        f32x4 tc0 = {0.f, 0.f, 0.f, 0.f}, tc1 = tc0, tn0 = tc0, tn1 = tc0;
        if (rope) { const float* tp = trig + ((size_t)(row0 % SEQ) * 16 + fq * 4) * 2; tc0 = *(const f32x4*)tp; tc1 = *(const f32x4*)(tp + 4); }
#pragma unroll
        for (int i8 = 0; i8 < 8; ++i8) { const int ai = i8 >> 2, m = i8 & 3; const int row = row0 + ai * HALF + m * 16;
            if (i8 < 7) { const int rown = row0 + ((i8 + 1) >> 2) * HALF + ((i8 + 1) & 3) * 16; ppn = *(const f32x4*)(partq + (size_t)rown * 4);
                if (rope) { const float* tp = trig + ((size_t)(rown % SEQ) * 16 + fq * 4) * 2; tn0 = *(const f32x4*)tp; tn1 = *(const f32x4*)(tp + 4); } }
            const float rs = rsqrtf(((ppc[0] + ppc[1]) + (ppc[2] + ppc[3])) * (1.f / 256.f) + EPS) * c2;
#pragma unroll
            for (int bj = 0; bj < 2; ++bj) { const int g = u.pn * 8 + bj * 4 + wc; bf16_t* dst = QB + (size_t)row * 768 + g * 32 + fq * 4;
                if (g % 3 != 2) { st_bf4(dst, acc[ai][bj][m][0] * rs); st_bf4(dst + 16, acc[ai][bj][m][1] * rs); }
                else { const f32x4 x1 = acc[ai][bj][m][0] * rs, x2 = acc[ai][bj][m][1] * rs; const f32x4 t0 = tc0, t1 = tc1;
                    f32x4 o1, o2; o1[0] = x1[0] * t0[0] - x2[0] * t0[1]; o2[0] = x1[0] * t0[1] + x2[0] * t0[0]; o1[1] = x1[1] * t0[2] - x2[1] * t0[3]; o2[1] = x1[1] * t0[3] + x2[1] * t0[2];
                    o1[2] = x1[2] * t1[0] - x2[2] * t1[1]; o2[2] = x1[2] * t1[1] + x2[2] * t1[0]; o1[3] = x1[3] * t1[2] - x2[3] * t1[3]; o2[3] = x1[3] * t1[3] + x2[3] * t1[2];
                    st_bf4(dst, o1); st_bf4(dst + 16, o2); } }
            ppc = ppn; tc0 = tn0; tc1 = tn1; asm volatile("" ::: "memory"); }
    }
};
struct EpiKV {
    static constexpr bool PERM = false, AFTER_DRAIN = false;
    bf16_t *KB, *VB; const float* partkv;
    __device__ __forceinline__ void operator()(const f32x4 (&acc)[2][2][4][2], const Unit& u, int wr, int wc, int fr, int fq) const {
        const int row0 = u.pm * BM + wr * 64 + fr;
        f32x4 ppc = *(const f32x4*)(partkv + (size_t)row0 * 4), ppn = ppc;
#pragma unroll
        for (int i8 = 0; i8 < 8; ++i8) { const int ai = i8 >> 2, m = i8 & 3; const int row = row0 + ai * HALF + m * 16;
            if (i8 < 7) { const int rown = row0 + ((i8 + 1) >> 2) * HALF + ((i8 + 1) & 3) * 16; ppn = *(const f32x4*)(partkv + (size_t)rown * 4); }
            const float rs = rsqrtf(((ppc[0] + ppc[1]) + (ppc[2] + ppc[3])) * (1.f / 128.f) + EPS);
#pragma unroll
            for (int bj = 0; bj < 2; ++bj)
#pragma unroll
                for (int n = 0; n < 2; ++n) { const int c = u.pn * BM + bj * HALF + wc * 32 + n * 16 + fq * 4; const f32x4 v = acc[ai][bj][m][n] * rs;
                    if (u.pn < 2) st_bf4(KB + (size_t)row * 768 + (c >> 6) * 96 + (c & 63), v); else st_bf4(VB + (size_t)row * 512 + (c - 512), v); }
            ppc = ppn; asm volatile("" ::: "memory"); }
    }
};
template <bool BF16RES> struct EpiRes {
    static constexpr bool PERM = false, AFTER_DRAIN = false;
    const float* res; const bf16_t* resb; bf16_t* outb; float* part;
    __device__ __forceinline__ f32x4 ldres(size_t off) const {
        if (BF16RES) { const u32x2 rb = *(const u32x2*)(resb + off); f32x4 r; r[0] = __builtin_bit_cast(float, rb.x << 16); r[1] = __builtin_bit_cast(float, rb.x & 0xffff0000u); r[2] = __builtin_bit_cast(float, rb.y << 16); r[3] = __builtin_bit_cast(float, rb.y & 0xffff0000u); return r; }
        return *(const f32x4*)(res + off); }
    __device__ __forceinline__ void operator()(const f32x4 (&acc)[2][2][4][2], const Unit& u, int wr, int wc, int fr, int fq) const {
        const int row0 = u.pm * BM + wr * 64 + fr; const int cb = u.pn * BM + wc * 32 + fq * 4;
        f32x4 rc[4], rn[4];
#pragma unroll
        for (int j = 0; j < 4; ++j) { rc[j] = ldres((size_t)row0 * 1024 + cb + (j >> 1) * HALF + (j & 1) * 16); rn[j] = rc[j]; }
#pragma unroll
        for (int i8 = 0; i8 < 8; ++i8) { const int ai = i8 >> 2, m = i8 & 3; const int row = row0 + ai * HALF + m * 16; float s = 0.f;
            if (i8 < 7) { const int rown = row0 + ((i8 + 1) >> 2) * HALF + ((i8 + 1) & 3) * 16;
#pragma unroll
                for (int j = 0; j < 4; ++j) rn[j] = ldres((size_t)rown * 1024 + cb + (j >> 1) * HALF + (j & 1) * 16); }
#pragma unroll
            for (int bj = 0; bj < 2; ++bj)
#pragma unroll
                for (int n = 0; n < 2; ++n) { const size_t off = (size_t)row * 1024 + cb + bj * HALF + n * 16;
                    const f32x4 v = acc[ai][bj][m][n] + rc[bj * 2 + n]; st_bf4(outb + off, v); s += sq4(v); }
            s = red_fq(s); if (fq == 0) part[(size_t)row * 16 + u.pn * 4 + wc] = s;
#pragma unroll
            for (int j = 0; j < 4; ++j) rc[j] = rn[j];
            asm volatile("" ::: "memory"); }
    }
};
struct EpiScaled {
    static constexpr bool PERM = false, AFTER_DRAIN = false;
    bf16_t* out; int ldc; const float* part; float mul;
    __device__ __forceinline__ void operator()(const f32x4 (&acc)[2][2][4][2], const Unit& u, int wr, int wc, int fr, int fq) const {
        const int row0 = u.pm * BM + wr * 64 + fr;
        float rs8[8];
#pragma unroll
        for (int hb = 0; hb < 2; ++hb) { f32x4 q[4][4];
#pragma unroll
            for (int k = 0; k < 4; ++k) { const int row = row0 + hb * HALF + k * 16; const f32x4* pp = (const f32x4*)(part + (size_t)row * 16);
#pragma unroll
                for (int j = 0; j < 4; ++j) q[k][j] = pp[j]; }
#pragma unroll
            for (int k = 0; k < 4; ++k) { const f32x4 a = q[k][0], b = q[k][1], c = q[k][2], d = q[k][3];
                const float ss = (((a[0] + a[1]) + (a[2] + a[3])) + ((b[0] + b[1]) + (b[2] + b[3]))) + (((c[0] + c[1]) + (c[2] + c[3])) + ((d[0] + d[1]) + (d[2] + d[3])));
                rs8[hb * 4 + k] = rsqrtf(ss * (1.f / 1024.f) + EPS) * mul; } }
#pragma unroll
        for (int i8 = 0; i8 < 8; ++i8) { const int ai = i8 >> 2, m = i8 & 3; const int row = row0 + ai * HALF + m * 16; const float rs = rs8[i8];
#pragma unroll
            for (int bj = 0; bj < 2; ++bj)
#pragma unroll
                for (int n = 0; n < 2; ++n) st_bf4(out + (size_t)row * ldc + u.pn * BM + bj * HALF + wc * 32 + n * 16 + fq * 4, acc[ai][bj][m][n] * rs);
            asm volatile("" ::: "memory"); }
    }
};
struct EpiSoftmaxP {
    static constexpr bool PERM = false, AFTER_DRAIN = false;
    bf16_t* out; int ldc; const float* part; float mul; PG8_LAS float* scr;
    __device__ __forceinline__ float rscale(int row) const { const f32x4* pp = (const f32x4*)(part + (size_t)row * 16); const f32x4 a = pp[0], b = pp[1], c = pp[2], d = pp[3];
        const float ss = (((a[0] + a[1]) + (a[2] + a[3])) + ((b[0] + b[1]) + (b[2] + b[3]))) + (((c[0] + c[1]) + (c[2] + c[3])) + ((d[0] + d[1]) + (d[2] + d[3]))); return rsqrtf(ss * (1.f / 1024.f) + EPS) * mul; }
    __device__ __forceinline__ void operator()(const f32x4 (&acc)[2][2][4][2], const Unit& u, int wr, int wc, int fr, int fq) const {
        PG8_LAS float* P1 = scr; PG8_LAS float* P2 = scr + 1024; float rs8[8];
#define EPS_BAR() do { asm volatile("s_waitcnt lgkmcnt(0)" ::: "memory"); __builtin_amdgcn_s_barrier(); asm volatile("" ::: "memory"); } while (0)
#pragma unroll
        for (int ai = 0; ai < 2; ++ai)
#pragma unroll
            for (int m = 0; m < 4; ++m) { float mx = -3.0e38f;
#pragma unroll
                for (int bj = 0; bj < 2; ++bj)
#pragma unroll
                    for (int n = 0; n < 2; ++n) { const f32x4 v = acc[ai][bj][m][n]; mx = fmaxf(mx, fmaxf(fmaxf(v[0], v[1]), fmaxf(v[2], v[3]))); }
                mx = fmaxf(mx, __shfl_xor(mx, 16)); mx = fmaxf(mx, __shfl_xor(mx, 32));
                if (fq == 0) P1[(ai * HALF + wr * 64 + m * 16 + fr) * 4 + wc] = mx; }
        EPS_BAR();
#pragma unroll
        for (int ai = 0; ai < 2; ++ai)
#pragma unroll
            for (int m = 0; m < 4; ++m) { const int rl = ai * HALF + wr * 64 + m * 16 + fr; const f32x4 q = *(const PG8_LAS f32x4*)(P1 + rl * 4);
                const float mx = fmaxf(fmaxf(q[0], q[1]), fmaxf(q[2], q[3])), rs = rscale(u.pm * BM + rl); float sm = 0.f; rs8[ai * 4 + m] = rs;
#pragma unroll
                for (int bj = 0; bj < 2; ++bj)
#pragma unroll
                    for (int n = 0; n < 2; ++n) { const f32x4 v = acc[ai][bj][m][n];
#pragma unroll
                        for (int i = 0; i < 4; ++i) sm += __builtin_amdgcn_exp2f((v[i] - mx) * rs); }
                sm += __shfl_xor(sm, 16); sm += __shfl_xor(sm, 32);
                if (fq == 0) P2[rl * 4 + wc] = sm; asm volatile("" ::: "memory"); }
        EPS_BAR();
#pragma unroll
        for (int ai = 0; ai < 2; ++ai)
#pragma unroll
            for (int m = 0; m < 4; ++m) { const int rl = ai * HALF + wr * 64 + m * 16 + fr; const f32x4 q = *(const PG8_LAS f32x4*)(P1 + rl * 4), w = *(const PG8_LAS f32x4*)(P2 + rl * 4);
                const float mx = fmaxf(fmaxf(q[0], q[1]), fmaxf(q[2], q[3])), rs = rs8[ai * 4 + m], inv = 1.0f / ((w[0] + w[1]) + (w[2] + w[3]));
#pragma unroll
                for (int bj = 0; bj < 2; ++bj)
#pragma unroll
                    for (int n = 0; n < 2; ++n) { const f32x4 v = acc[ai][bj][m][n]; f32x4 o;
#pragma unroll
                        for (int i = 0; i < 4; ++i) o[i] = __builtin_amdgcn_exp2f((v[i] - mx) * rs) * inv;
                        st_bf4(out + (size_t)(u.pm * BM + rl) * ldc + u.pn * BM + bj * HALF + wc * 32 + n * 16 + fq * 4, o); }
                asm volatile("" ::: "memory"); }
        EPS_BAR();
#undef EPS_BAR
    }
};
struct EpiPlain {
    static constexpr bool PERM = false, AFTER_DRAIN = false;
    bf16_t* out; int ldc;
    __device__ __forceinline__ void operator()(const f32x4 (&acc)[2][2][4][2], const Unit& u, int wr, int wc, int fr, int fq) const {
        const int row0 = u.pm * BM + wr * 64 + fr;
#pragma unroll
        for (int ai = 0; ai < 2; ++ai)
#pragma unroll
            for (int m = 0; m < 4; ++m) { const int row = row0 + ai * HALF + m * 16;
#pragma unroll
                for (int bj = 0; bj < 2; ++bj)
#pragma unroll
                    for (int n = 0; n < 2; ++n) st_bf4(out + (size_t)row * ldc + u.pn * BM + bj * HALF + wc * 32 + n * 16 + fq * 4, acc[ai][bj][m][n]); }
    }
};
template <class Epi, class Sched, bool ALIGN_EPI = false, bool SP2 = false>
__device__ __forceinline__ void gemm_phase(PG8_LAS unsigned char* lds, const Gemm g, const Sched& S, const Epi& E) {
    int tid_ = threadIdx.x; asm volatile("" : "+v"(tid_));
    const int tid = tid_, wid = __builtin_amdgcn_readfirstlane(tid >> 6), lane = tid & 63, wr = wid >> 2, wc = wid & 3, fr = lane & 15, fq = lane >> 4;
    const int K = g.K, nt = K / BK, lda = g.lda ? g.lda : K, ldb = g.ldb ? g.ldb : K;
#define PG8_BOFF(pm_) (g.mb ? (size_t)((pm_) / g.mb) * g.bstride : (size_t)0)
    unsigned voffA[2], voffB[2];
#pragma unroll
    for (int i = 0; i < 2; ++i) { int R, C; stage_rc(tid * 16 + i * 8192, R, C); const int Rb = Epi::PERM ? ((R & ~31) + perm32(R & 31)) : R;
        voffA[i] = (unsigned)(R * lda + C) * 2u; voffB[i] = (unsigned)(Rb * ldb + C) * 2u; }
    const size_t kstep = (size_t)(BK * 2);
    const size_t hstepA = (size_t)HALF * lda * 2, hstepB = (size_t)HALF * ldb * 2;
    const size_t tstepA = 2 * hstepA, tstepB = 2 * hstepB;
    const unsigned ldsw = (unsigned)wid * 1024u;
    const int aoff = lds_byte(wr * 64 + fr, fq * 8), boff = lds_byte(wc * 32 + fr, fq * 8);
#define PG8_SA(b, h) (((b) * 2 + (h)) * HTB)
#define PG8_SB(b, h) ((4 + (b) * 2 + (h)) * HTB)
#define PG8_STAGE(bufoff, gbase, voff) do { _Pragma("unroll") for (int _i = 0; _i < 2; ++_i) \
        __builtin_amdgcn_global_load_lds((const unsigned*)((const char*)(gbase) + (voff)[_i]), (PG8_LAS unsigned*)(lds + (bufoff) + ldsw + _i * 8192), 16, 0, 0); } while (0)
#define PG8_LDA(dst, b, h) do { _Pragma("unroll") for (int m = 0; m < 4; ++m) _Pragma("unroll") for (int k = 0; k < 2; ++k) dst[m][k] = *(const PG8_LAS bf16x8*)(lds + PG8_SA(b, h) + aoff + m * 2048 + k * 1024); } while (0)
#define PG8_LDB(dst, b, h) do { _Pragma("unroll") for (int n = 0; n < 2; ++n) _Pragma("unroll") for (int k = 0; k < 2; ++k) dst[n][k] = *(const PG8_LAS bf16x8*)(lds + PG8_SB(b, h) + boff + n * 2048 + k * 1024); } while (0)
#define PG8_MMA(ai, bj, At, Bt) do { __builtin_amdgcn_s_setprio(1); _Pragma("unroll") for (int m = 0; m < 4; ++m) _Pragma("unroll") for (int n = 0; n < 2; ++n) _Pragma("unroll") for (int k = 0; k < 2; ++k) \
        acc[ai][bj][m][n] = __builtin_amdgcn_mfma_f32_16x16x32_bf16(Bt[n][k], At[m][k], acc[ai][bj][m][n], 0, 0, 0); __builtin_amdgcn_s_setprio(0); } while (0)
#define PG8_WAIT_V(n) asm volatile("s_waitcnt vmcnt(" #n ")" ::: "memory")
#define PG8_WAIT_L(n) asm volatile("s_waitcnt lgkmcnt(" #n ")" ::: "memory")
#define PG8_BAR __builtin_amdgcn_s_barrier()
#define PG8_SCHED __builtin_amdgcn_sched_barrier(0)
    Unit cur, nxt; int ui = 0;
    if (!S.next(0, cur)) return;
    f32x4 acc[2][2][4][2];
#pragma unroll
    for (int a = 0; a < 2; ++a)
#pragma unroll
        for (int b = 0; b < 2; ++b)
#pragma unroll
            for (int m = 0; m < 4; ++m)
#pragma unroll
                for (int n = 0; n < 2; ++n) acc[a][b][m][n] = (f32x4){0.f, 0.f, 0.f, 0.f};
    bf16x8 At[4][2], B0[2][2], B1[2][2];
    const char* cA = (const char*)g.A + (size_t)cur.pm * tstepA; const char* cB = (const char*)g.Bt + (size_t)cur.pn * tstepB + PG8_BOFF(cur.pm);
    S.a_ready(cur);
    if constexpr (SP2) {
        PG8_STAGE(PG8_SB(0, 0), cB, voffB); PG8_STAGE(PG8_SB(0, 1), cB + hstepB, voffB); PG8_STAGE(PG8_SA(0, 0), cA, voffA); PG8_STAGE(PG8_SA(0, 1), cA + hstepA, voffA);
        if (wr == 1) PG8_BAR;
        PG8_WAIT_V(2); PG8_BAR;
        PG8_STAGE(PG8_SB(1, 0), cB + kstep, voffB); PG8_STAGE(PG8_SA(1, 0), cA + kstep, voffA); PG8_STAGE(PG8_SB(1, 1), cB + hstepB + kstep, voffB);
        PG8_WAIT_V(6); PG8_BAR;
    } else {
        PG8_STAGE(PG8_SB(0, 0), cB, voffB); PG8_STAGE(PG8_SA(0, 0), cA, voffA); PG8_STAGE(PG8_SB(0, 1), cB + hstepB, voffB); PG8_STAGE(PG8_SA(0, 1), cA + hstepA, voffA);
        if (wr == 1) PG8_BAR;
        PG8_WAIT_V(4); PG8_BAR;
        PG8_STAGE(PG8_SB(1, 0), cB + kstep, voffB); PG8_STAGE(PG8_SA(1, 0), cA + kstep, voffA); PG8_STAGE(PG8_SB(1, 1), cB + hstepB + kstep, voffB);
        PG8_WAIT_V(6); PG8_BAR;
    }
    for (;;) {
        const bool has_next = S.next(ui + 1, nxt);
        const char* nA = has_next ? (const char*)g.A + (size_t)nxt.pm * tstepA : cA; const char* nB = has_next ? (const char*)g.Bt + (size_t)nxt.pn * tstepB + PG8_BOFF(nxt.pm) : cB;
        for (int t = 0; t < nt; t += 2) {
            const bool last = (t == nt - 2);
            const char* a1 = cA + (size_t)(t + 1) * kstep;
            const char* a2 = last ? nA : cA + (size_t)(t + 2) * kstep; const char* b2 = last ? nB : cB + (size_t)(t + 2) * kstep;
            const char* a3 = a2 + kstep; const char* b3 = b2 + kstep;
            if (last && has_next) S.a_ready(nxt);
            if constexpr (SP2) {
            PG8_LDB(B0, 0, 0); PG8_LDB(B1, 0, 1); PG8_SCHED; PG8_LDA(At, 0, 0); PG8_STAGE(PG8_SA(1, 1), a1 + hstepA, voffA);
            PG8_WAIT_V(8); PG8_WAIT_L(0); PG8_BAR; PG8_MMA(0, 0, At, B0); PG8_MMA(0, 1, At, B1); PG8_BAR; PG8_SCHED;
            PG8_LDA(At, 0, 1); PG8_STAGE(PG8_SB(0, 0), b2, voffB); PG8_STAGE(PG8_SB(0, 1), b2 + hstepB, voffB); PG8_STAGE(PG8_SA(0, 0), a2, voffA);
            PG8_WAIT_V(8); PG8_WAIT_L(0); PG8_BAR; PG8_MMA(1, 0, At, B0); PG8_MMA(1, 1, At, B1); PG8_BAR; PG8_SCHED;
            PG8_LDB(B0, 1, 0); PG8_LDB(B1, 1, 1); PG8_SCHED; PG8_LDA(At, 1, 0); PG8_STAGE(PG8_SA(0, 1), a2 + hstepA, voffA);
            PG8_WAIT_V(8); PG8_WAIT_L(0); PG8_BAR; PG8_MMA(0, 0, At, B0); PG8_MMA(0, 1, At, B1); PG8_BAR; PG8_SCHED;
            PG8_LDA(At, 1, 1); PG8_STAGE(PG8_SB(1, 0), b3, voffB); PG8_STAGE(PG8_SB(1, 1), b3 + hstepB, voffB); PG8_STAGE(PG8_SA(1, 0), a3, voffA);
            PG8_WAIT_V(8); PG8_WAIT_L(0); PG8_BAR; PG8_MMA(1, 0, At, B0); PG8_MMA(1, 1, At, B1); PG8_BAR; PG8_SCHED;
            } else {
            PG8_LDB(B0, 0, 0); PG8_SCHED; PG8_LDA(At, 0, 0); PG8_STAGE(PG8_SA(1, 1), a1 + hstepA, voffA);
            PG8_WAIT_L(8); PG8_BAR; PG8_WAIT_L(0); PG8_MMA(0, 0, At, B0); PG8_BAR; PG8_SCHED;
            PG8_LDB(B1, 0, 1); PG8_STAGE(PG8_SB(0, 0), b2, voffB);
            PG8_BAR; PG8_WAIT_L(0); PG8_MMA(0, 1, At, B1); PG8_BAR;
            PG8_LDA(At, 0, 1); PG8_STAGE(PG8_SA(0, 0), a2, voffA);
            PG8_BAR; PG8_WAIT_L(0); PG8_MMA(1, 0, At, B0); PG8_BAR; PG8_SCHED;
            PG8_STAGE(PG8_SB(0, 1), b2 + hstepB, voffB);
            PG8_WAIT_V(6); PG8_BAR; PG8_MMA(1, 1, At, B1); PG8_BAR;
            PG8_LDB(B0, 1, 0); PG8_SCHED; PG8_LDA(At, 1, 0); PG8_STAGE(PG8_SA(0, 1), a2 + hstepA, voffA);
            PG8_WAIT_L(8); PG8_BAR; PG8_WAIT_L(0); PG8_MMA(0, 0, At, B0); PG8_BAR; PG8_SCHED;
            PG8_LDB(B1, 1, 1); PG8_STAGE(PG8_SB(1, 0), b3, voffB);
            PG8_BAR; PG8_WAIT_L(0); PG8_MMA(0, 1, At, B1); PG8_BAR;
            PG8_LDA(At, 1, 1); PG8_STAGE(PG8_SA(1, 0), a3, voffA);
            PG8_BAR; PG8_WAIT_L(0); PG8_MMA(1, 0, At, B0); PG8_BAR; PG8_SCHED;
            PG8_STAGE(PG8_SB(1, 1), b3 + hstepB, voffB);
            PG8_WAIT_V(6); PG8_BAR; PG8_MMA(1, 1, At, B1); PG8_BAR;
            }
        }
        if constexpr (ALIGN_EPI) { if (wr == 0) PG8_BAR; }
        if constexpr (!Epi::AFTER_DRAIN) { E(acc, cur, wr, wc, fr, fq); S.done(cur); }
        if (!has_next) break;
#pragma unroll
        for (int a = 0; a < 2; ++a)
#pragma unroll
            for (int b = 0; b < 2; ++b)
#pragma unroll
                for (int m = 0; m < 4; ++m)
#pragma unroll
                    for (int n = 0; n < 2; ++n) acc[a][b][m][n] = (f32x4){0.f, 0.f, 0.f, 0.f};
        cur = nxt; cA = nA; cB = nB; ++ui;
        if constexpr (ALIGN_EPI) { if (wr == 1) PG8_BAR; }
    }
    PG8_WAIT_V(0);
    if constexpr (!ALIGN_EPI) { if (wr == 0) PG8_BAR; }
    PG8_BAR;
    if constexpr (Epi::AFTER_DRAIN) { E.fused(acc, cur, wr, wc, fr, fq, lds, wid, lane); S.done(cur); }
#undef PG8_BOFF
#undef PG8_SA
#undef PG8_SB
#undef PG8_STAGE
#undef PG8_LDA
#undef PG8_LDB
#undef PG8_MMA
#undef PG8_WAIT_V
#undef PG8_WAIT_L
#undef PG8_BAR
#undef PG8_SCHED
}
}

#define GAS __attribute__((address_space(1)))
#define LAS __attribute__((address_space(3)))
typedef GAS unsigned gu32;
#define LDS_WAIT() asm volatile("s_waitcnt lgkmcnt(0)" ::: "memory")
#define VM_WAIT() asm volatile("s_waitcnt vmcnt(0)" ::: "memory")
constexpr int NWAVES = 8, NTHR = NWAVES * 64;
constexpr int LDSCTL_OFF = 0, PH_BASE = 512, LDS_BYTES = 147456;
constexpr int CW_BAR = 4096;
constexpr size_t CTL_ZERO_BYTES = 256 * 1024;
constexpr size_t WS_TRIG = 27 * MiB;
#define XB_TMO      128
#define XB_XCNT(j)  (256  + 64 * (j))
#define XB_XSUB(j)  (1280 + 64 * (j))
#define XB_XGEN(j)  (2304 + 64 * (j))
#define XB_TOP      3328
#define XB_TOPGEN   3392
#define XCD_BAR_WORDS 3456
#define XB_SPIN_CAP (1u << 18)

__device__ __forceinline__ unsigned xb_ld(unsigned* p)              { return __hip_atomic_load(p, __ATOMIC_RELAXED, __HIP_MEMORY_SCOPE_AGENT); }
__device__ __forceinline__ unsigned xb_add(unsigned* p, unsigned v) { return __hip_atomic_fetch_add(p, v, __ATOMIC_RELAXED, __HIP_MEMORY_SCOPE_AGENT); }
__device__ __forceinline__ unsigned xb_xcc_id() { return (unsigned)__builtin_amdgcn_s_getreg((3 << 11) | 20) & 0xFu; }
#define XB_SPIN(cond, bar) do { unsigned _sp = 0; while (cond) { __builtin_amdgcn_s_sleep(1); \
    if ((++_sp & 255u) == 0u) { if (xb_ld(&(bar)[XB_TMO])) break; if (_sp > XB_SPIN_CAP) { atomicAdd(&(bar)[XB_TMO], 1u); break; } } } } while (0)

struct XcdBarrier {
    unsigned* bar; unsigned x;
    volatile LAS unsigned* st;
};

__device__ __forceinline__ XcdBarrier xcd_barrier_post(unsigned* bar, volatile LAS unsigned* st) {
    XcdBarrier b; b.bar = bar; b.x = xb_xcc_id(); b.st = st;
    if (threadIdx.x == 0) (void)xb_add(&bar[XB_XCNT(b.x)], 1u);
    return b;
}
__device__ __forceinline__ void xcd_barrier_complete(unsigned* bar, unsigned x, unsigned& nloc, unsigned& nx) {
    const unsigned G = gridDim.x * gridDim.y * gridDim.z;
    unsigned sum, cnt, mine, sp = 0u;
    for (;;) {
        sum = 0u; cnt = 0u; mine = 0u;
#pragma unroll
        for (unsigned j = 0; j < 16; ++j) { const unsigned c = xb_ld(&bar[XB_XCNT(j)]); sum += c; cnt += (c > 0u) ? 1u : 0u; mine = (j == x) ? c : mine; }
        if (sum == G) break;
        __builtin_amdgcn_s_sleep(1);
        if ((++sp & 255u) == 0u) { if (xb_ld(&bar[XB_TMO])) break; if (sp > XB_SPIN_CAP) { atomicAdd(&bar[XB_TMO], 1u); break; } }
    }
    nloc = mine > 0u ? mine : 1u; nx = cnt > 0u ? cnt : 1u;
}

__device__ __forceinline__ void xcd_barrier(const XcdBarrier& b) {
    asm volatile("s_waitcnt vmcnt(0)" ::: "memory");
    __syncthreads();
    if (threadIdx.x == 0) {
        unsigned* bar = b.bar;
        __builtin_amdgcn_s_waitcnt(0);
        unsigned nloc = b.st[0], nx = b.st[1];
        if (nloc == 0u) { xcd_barrier_complete(bar, b.x, nloc, nx); b.st[0] = nloc; b.st[1] = nx; }
        const unsigned old = xb_add(&bar[XB_XSUB(b.x)], 1u);
        const unsigned gen = old / nloc;
        if (old + 1u == (gen + 1u) * nloc) {
            __builtin_amdgcn_fence(__ATOMIC_RELEASE, "agent");
            asm volatile("s_waitcnt vmcnt(0)" ::: "memory");
            const unsigned og = xb_add(&bar[XB_TOP], 1u);
            const unsigned tg = og / nx;
            if (og + 1u == (tg + 1u) * nx) xb_add(&bar[XB_TOPGEN], 1u);
            else XB_SPIN(xb_ld(&bar[XB_TOPGEN]) == tg, bar);
            __builtin_amdgcn_fence(__ATOMIC_ACQUIRE, "agent");
            xb_add(&bar[XB_XGEN(b.x)], 1u);
            asm volatile("s_waitcnt vmcnt(0)" ::: "memory");
        } else {
            XB_SPIN(xb_ld(&bar[XB_XGEN(b.x)]) == gen, bar);
            __builtin_amdgcn_fence(__ATOMIC_ACQUIRE, "agent");
            asm volatile("s_waitcnt vmcnt(0)" ::: "memory");
        }
    }
    __syncthreads();
}

enum { PH_PRO = 0, PH_PROJ, PH_UP, PH_ATTN, PH_MIX, PH_MEMQ, PH_XATTN, PH_MEMO, PH_PQ, PH_TOPK, PH_EXP, PH_N, PHB_CONV = 16, PHB_UPG = 17 };
struct Args { const float* in[24]; float* out; unsigned char* ws; unsigned mask; unsigned li; };

DEVI int src_col(int mode, int r) { return mode == 0 ? r : mode == 1 ? win_src(r) : wkv_src(r); }
template <int MODE, bool HASG> DEVI void p0_transpose_item(const float* W, int K, int N, bf16* WT, int NR, const float* gk, LAS float* scr, int item, int lane) {
    const int nb_ = NR / 32, kb = item / nb_, nb = item % nb_, k0 = 64 * kb, n0 = 32 * nb;
    const int sc = src_col(MODE, n0 + (lane & 31)), scc = sc < 0 ? 0 : sc; const float keep = sc < 0 ? 0.f : 1.f;
    float v[32];
#pragma unroll
    for (int i = 0; i < 32; ++i) { const int kk = 2 * i + (lane >> 5); v[i] = W[(size_t)(k0 + kk) * N + scc]; }
    if (HASG) {
#pragma unroll
        for (int i = 0; i < 32; ++i) { const int kk = 2 * i + (lane >> 5); v[i] *= gk[k0 + kk]; } }
#pragma unroll
    for (int i = 0; i < 32; ++i) { const int kk = 2 * i + (lane >> 5); scr[kk * 33 + (lane & 31)] = MODE == 0 ? v[i] : v[i] * keep; }
    LDS_WAIT(); asm volatile("" ::: "memory");
    const int c = lane & 7;
#pragma unroll
    for (int j = 0; j < 4; ++j) { const int n = (lane >> 3) + 8 * j; const LAS float* s = scr + (8 * c) * 33 + n;
        uint4 o; o.x = pg8::cvt_pk_bf16(s[0 * 33], s[1 * 33]); o.y = pg8::cvt_pk_bf16(s[2 * 33], s[3 * 33]); o.z = pg8::cvt_pk_bf16(s[4 * 33], s[5 * 33]); o.w = pg8::cvt_pk_bf16(s[6 * 33], s[7 * 33]);
        *(uint4*)(WT + (size_t)(n0 + n) * K + k0 + 8 * c) = o; }
    LDS_WAIT(); asm volatile("" ::: "memory");
}
DEVI void rms_row_to_bf16(const float* xrow, const float* g, bf16* orow, int lane) {
    const float4* xr = (const float4*)xrow + lane; const float4* gr = (const float4*)g + lane;
    float4 v[4]; float s = 0.f;
#pragma unroll
    for (int j = 0; j < 4; ++j) { v[j] = xr[64 * j]; s += (v[j].x * v[j].x + v[j].y * v[j].y) + (v[j].z * v[j].z + v[j].w * v[j].w); }
    const float r = rsqrtf(wave_sum(s) * (1.f / D) + EPS);
    uint2* o8 = (uint2*)orow + lane;
#pragma unroll
    for (int j = 0; j < 4; ++j) { const float4 gg = gr[64 * j]; uint2 o; o.x = pg8::cvt_pk_bf16(v[j].x * r * gg.x, v[j].y * r * gg.y); o.y = pg8::cvt_pk_bf16(v[j].z * r * gg.z, v[j].w * r * gg.w); o8[64 * j] = o; }
}
DEVI void rms_rows4_to_bf16(const float* x, const float* g, bf16* out, int m0, int step, int mend, int lane) {
    float4 v[4][4]; float s[4]; float4 gq[4];
#pragma unroll
    for (int j = 0; j < 4; ++j) gq[j] = ((const float4*)g + lane)[64 * j];
#pragma unroll
    for (int r = 0; r < 4; ++r) { const int m = m0 + r * step; const float4* xr = (const float4*)(x + (size_t)(m < mend ? m : m0) * D) + lane;
#pragma unroll
        for (int j = 0; j < 4; ++j) v[r][j] = xr[64 * j]; }
#pragma unroll
    for (int r = 0; r < 4; ++r) { float t = 0.f;
#pragma unroll
        for (int j = 0; j < 4; ++j) t += (v[r][j].x * v[r][j].x + v[r][j].y * v[r][j].y) + (v[r][j].z * v[r][j].z + v[r][j].w * v[r][j].w);
        s[r] = t; }
#pragma unroll
    for (int o = 1; o < 64; o <<= 1) {
#pragma unroll
        for (int r = 0; r < 4; ++r) s[r] += __shfl_xor(s[r], o); }
#pragma unroll
    for (int r = 0; r < 4; ++r) { const int m = m0 + r * step; if (m < mend) { const float rs = rsqrtf(s[r] * (1.f / D) + EPS); uint2* o8 = (uint2*)(out + (size_t)m * D) + lane;
#pragma unroll
        for (int j = 0; j < 4; ++j) { const float4 gg = gq[j]; uint2 o; o.x = pg8::cvt_pk_bf16(v[r][j].x * rs * gg.x, v[r][j].y * rs * gg.y); o.y = pg8::cvt_pk_bf16(v[r][j].z * rs * gg.z, v[r][j].w * rs * gg.w); o8[64 * j] = o; } } }
}
DEVI void cvt_stream_fp8(const float* src, unsigned char* dst, size_t n16, const float* g, float mul, size_t gtid, size_t gn) {
    for (size_t i = gtid; i < n16; i += gn) { pg8::u32x4 o;
#pragma unroll
        for (int q = 0; q < 4; ++q) { float4 a = *(const float4*)(src + i * 16 + q * 4); if (g) { const float4 gg = *(const float4*)(g + ((i * 16 + q * 4) & (D - 1))); a.x *= gg.x; a.y *= gg.y; a.z *= gg.z; a.w *= gg.w; }
            int p = __builtin_amdgcn_cvt_pk_fp8_f32(a.x * mul, a.y * mul, 0, false); p = __builtin_amdgcn_cvt_pk_fp8_f32(a.z * mul, a.w * mul, p, true); o[q] = (unsigned)p; }
        *(pg8::u32x4*)(dst + i * 16) = o; }
}
typedef unsigned v6u_t __attribute__((ext_vector_type(6)));
typedef float f32x2_t __attribute__((ext_vector_type(2)));
typedef float v16f_t __attribute__((ext_vector_type(16)));
typedef float v32f_t __attribute__((ext_vector_type(32)));
typedef __bf16 v32bf_t __attribute__((ext_vector_type(32)));
#ifndef FP6_INTERLEAVED
#define FP6_INTERLEAVED 0
#endif
template <bool HASG> DEVI void cvt_rows_fp6(const float* src, unsigned char* dst, const float* g, float mul, size_t gtid, size_t gn) {
    const int grp = (int)(gtid & 31);
    float4 gg[8];
#pragma unroll
    for (int q = 0; q < 8; ++q) { gg[q] = HASG ? *(const float4*)(g + grp * 32 + q * 4) : make_float4(1.f, 1.f, 1.f, 1.f); gg[q].x *= mul; gg[q].y *= mul; gg[q].z *= mul; gg[q].w *= mul; }
    for (size_t i0 = gtid; i0 < (size_t)PE * 32; i0 += 2 * gn) {
        float4 v[2][8];
#pragma unroll
        for (int u = 0; u < 2; ++u) { const size_t i = i0 + u * gn; if (i < (size_t)PE * 32) { const float* sp = src + (i >> 5) * D + (i & 31) * 32;
#pragma unroll
            for (int q = 0; q < 8; ++q) v[u][q] = *(const float4*)(sp + q * 4); } }
#pragma unroll
        for (int u = 0; u < 2; ++u) { const size_t i = i0 + u * gn; if (i < (size_t)PE * 32) { const size_t row = i >> 5;
            v16f_t a, b;
#pragma unroll
            for (int q = 0; q < 8; ++q) { const float4 x = v[u][q]; a[2 * q] = x.x * gg[q].x; b[2 * q] = x.y * gg[q].y; a[2 * q + 1] = x.z * gg[q].z; b[2 * q + 1] = x.w * gg[q].w; }
            const v6u_t p = __builtin_amdgcn_cvt_scalef32_2xpk16_fp6_f32(a, b, 1.0f);
            *(pg8::u32x4*)(dst + row * 768 + grp * 16) = (pg8::u32x4){p[0], p[1], p[2], p[3]};
            *(pg8::u32x2*)(dst + row * 768 + 512 + grp * 8) = (pg8::u32x2){p[4], p[5]}; } }
    }
}
DEVI void cvt_stream(const float* src, bf16* dst, size_t n8, const float* g, size_t gtid, size_t gn) {
    for (size_t i = gtid; i < n8; i += gn) { const float4 a = *(const float4*)(src + i * 8), b = *(const float4*)(src + i * 8 + 4);
        float4 ga = make_float4(1.f, 1.f, 1.f, 1.f), gb = ga; if (g) { ga = *(const float4*)(g + ((i * 8) & (D - 1))); gb = *(const float4*)(g + ((i * 8) & (D - 1)) + 4); }
        uint4 o; o.x = pg8::cvt_pk_bf16(a.x * ga.x, a.y * ga.y); o.y = pg8::cvt_pk_bf16(a.z * ga.z, a.w * ga.w); o.z = pg8::cvt_pk_bf16(b.x * gb.x, b.y * gb.y); o.w = pg8::cvt_pk_bf16(b.z * gb.z, b.w * gb.w);
        *(uint4*)(dst + i * 8) = o; }
}


DEVI void conv_token(int row, const bf16* U, const float* cw, const float* cb, const float* lg, const float* lb, bf16* CONCAT, int lane) {
    const int pos = row % SEQ; float y[8];
    { const float4 b0 = *(const float4*)(cb + lane * 8), b1 = *(const float4*)(cb + lane * 8 + 4); y[0] = b0.x; y[1] = b0.y; y[2] = b0.z; y[3] = b0.w; y[4] = b1.x; y[5] = b1.y; y[6] = b1.z; y[7] = b1.w; }
    const int k0 = pos >= CK - 1 ? 0 : CK - 1 - pos;
    for (int k = k0; k < CK; ++k) {
        const uint4 u = *(const uint4*)(U + (size_t)(row - (CK - 1) + k) * CW + lane * 8);
        const float4 w0 = *(const float4*)(cw + k * CW + lane * 8), w1 = *(const float4*)(cw + k * CW + lane * 8 + 4);
        y[0] += w0.x * __builtin_bit_cast(float, u.x << 16); y[1] += w0.y * __builtin_bit_cast(float, u.x & 0xffff0000u);
        y[2] += w0.z * __builtin_bit_cast(float, u.y << 16); y[3] += w0.w * __builtin_bit_cast(float, u.y & 0xffff0000u);
        y[4] += w1.x * __builtin_bit_cast(float, u.z << 16); y[5] += w1.y * __builtin_bit_cast(float, u.z & 0xffff0000u);
        y[6] += w1.z * __builtin_bit_cast(float, u.w << 16); y[7] += w1.w * __builtin_bit_cast(float, u.w & 0xffff0000u);
    }
    float s = 0.f;
#pragma unroll
    for (int e = 0; e < 8; ++e) s += y[e];
    const float mu = wave_sum(s) * (1.f / CW); float q = 0.f;
#pragma unroll
    for (int e = 0; e < 8; ++e) { y[e] -= mu; q += y[e] * y[e]; }
    const float rstd = rsqrtf(wave_sum(q) * (1.f / CW) + EPS);
    const float4 g0 = *(const float4*)(lg + lane * 8), g1 = *(const float4*)(lg + lane * 8 + 4), c0 = *(const float4*)(lb + lane * 8), c1 = *(const float4*)(lb + lane * 8 + 4);
    const float gg[8] = {g0.x, g0.y, g0.z, g0.w, g1.x, g1.y, g1.z, g1.w}, bb[8] = {c0.x, c0.y, c0.z, c0.w, c1.x, c1.y, c1.z, c1.w};
    float z[8];
#pragma unroll
    for (int e = 0; e < 8; ++e) { const float t = y[e] * rstd * gg[e] + bb[e]; z[e] = t * __builtin_amdgcn_rcpf(1.f + __expf(-t)); }
    uint4 o; o.x = pg8::cvt_pk_bf16(z[0], z[1]); o.y = pg8::cvt_pk_bf16(z[2], z[3]); o.z = pg8::cvt_pk_bf16(z[4], z[5]); o.w = pg8::cvt_pk_bf16(z[6], z[7]);
    *(uint4*)(CONCAT + (size_t)row * D + CW + lane * 8) = o;
}

DEVI void conv_chunk(int c, const bf16* U, const float* cw, const float* cb, const float* lg, const float* lb, bf16* CONCAT, LAS unsigned char* lds) {
    const int ch = threadIdx.x, lane = ch & 63, wv = __builtin_amdgcn_readfirstlane(ch >> 6);
    const int t0 = c * 64, pos0 = t0 % SEQ;
    float w[CK];
#pragma unroll
    for (int k = 0; k < CK; ++k) w[k] = cw[k * CW + ch];
    const float bias = cb[ch];
    float u[64 + CK - 1];
#pragma unroll
    for (int r = 0; r < 64 + CK - 1; ++r) { const int row = t0 - (CK - 1) + r;
        const unsigned raw = *(const unsigned short*)(U + (size_t)(row < 0 ? 0 : row) * CW + ch); u[r] = __builtin_bit_cast(float, raw << 16); }
#pragma unroll
    for (int r = 0; r < CK - 1; ++r) { const float keep = (pos0 - (CK - 1) + r >= 0) ? 1.f : 0.f; u[r] *= keep; }
    LAS float* yl = (LAS float*)lds;
#pragma unroll
    for (int j = 0; j < 64; ++j) { float y = bias;
#pragma unroll
        for (int k = 0; k < CK; ++k) y += w[k] * u[j + k];
        yl[j * CW + ch] = y; }
    __syncthreads();
#pragma unroll 1
    for (int i = 0; i < 8; ++i) { const int j = wv * 8 + i, row = t0 + j;
        const pg8::f32x4 a0 = *(const LAS pg8::f32x4*)(yl + j * CW + lane * 8), a1 = *(const LAS pg8::f32x4*)(yl + j * CW + lane * 8 + 4);
        float y[8] = {a0[0], a0[1], a0[2], a0[3], a1[0], a1[1], a1[2], a1[3]}; float sm = 0.f;
#pragma unroll
        for (int e = 0; e < 8; ++e) sm += y[e];
        const float mu = wave_sum(sm) * (1.f / CW); float q = 0.f;
#pragma unroll
        for (int e = 0; e < 8; ++e) { y[e] -= mu; q += y[e] * y[e]; }
        const float rstd = rsqrtf(wave_sum(q) * (1.f / CW) + EPS);
        const float4 g0 = *(const float4*)(lg + lane * 8), g1 = *(const float4*)(lg + lane * 8 + 4), c0 = *(const float4*)(lb + lane * 8), c1 = *(const float4*)(lb + lane * 8 + 4);
        const float gg[8] = {g0.x, g0.y, g0.z, g0.w, g1.x, g1.y, g1.z, g1.w}, bb[8] = {c0.x, c0.y, c0.z, c0.w, c1.x, c1.y, c1.z, c1.w};
        float z[8];
#pragma unroll
        for (int e = 0; e < 8; ++e) { const float t = y[e] * rstd * gg[e] + bb[e]; z[e] = t * __builtin_amdgcn_rcpf(1.f + __expf(-t)); }
        uint4 o; o.x = pg8::cvt_pk_bf16(z[0], z[1]); o.y = pg8::cvt_pk_bf16(z[2], z[3]); o.z = pg8::cvt_pk_bf16(z[4], z[5]); o.w = pg8::cvt_pk_bf16(z[6], z[7]);
        *(uint4*)(CONCAT + (size_t)row * D + CW + lane * 8) = o; }
    __syncthreads();
}

typedef short bf16x8_t __attribute__((ext_vector_type(8)));
typedef float f32x16_t __attribute__((ext_vector_type(16)));
typedef __bf16 bf16x2_t __attribute__((ext_vector_type(2)));
DEVI unsigned umax_(unsigned a, unsigned b) { return a > b ? a : b; }
DEVI unsigned umin_(unsigned a, unsigned b) { return a < b ? a : b; }
DEVI unsigned kmax_(unsigned a, unsigned b) { unsigned r; asm("v_max_f32 %0, %1, %2" : "=v"(r) : "v"(a), "v"(b)); return r; }
DEVI unsigned kmin_(unsigned a, unsigned b) { unsigned r; asm("v_min_f32 %0, %1, %2" : "=v"(r) : "v"(a), "v"(b)); return r; }
DEVI void ce_desc(unsigned& a, unsigned& b) { const unsigned mx = kmax_(a, b), mn = kmin_(a, b); a = mx; b = mn; }
DEVI void sort16_desc(unsigned (&v)[16]) {
    ce_desc(v[0], v[13]); ce_desc(v[1], v[12]); ce_desc(v[2], v[15]); ce_desc(v[3], v[14]); ce_desc(v[4], v[8]); ce_desc(v[5], v[6]); ce_desc(v[7], v[11]); ce_desc(v[9], v[10]);
    ce_desc(v[0], v[5]); ce_desc(v[1], v[7]); ce_desc(v[2], v[9]); ce_desc(v[3], v[4]); ce_desc(v[6], v[13]); ce_desc(v[8], v[14]); ce_desc(v[10], v[15]); ce_desc(v[11], v[12]);
    ce_desc(v[0], v[1]); ce_desc(v[2], v[3]); ce_desc(v[4], v[5]); ce_desc(v[6], v[8]); ce_desc(v[7], v[9]); ce_desc(v[10], v[11]); ce_desc(v[12], v[13]); ce_desc(v[14], v[15]);
    ce_desc(v[0], v[2]); ce_desc(v[1], v[3]); ce_desc(v[4], v[10]); ce_desc(v[5], v[11]); ce_desc(v[6], v[7]); ce_desc(v[8], v[9]); ce_desc(v[12], v[14]); ce_desc(v[13], v[15]);
    ce_desc(v[1], v[2]); ce_desc(v[3], v[12]); ce_desc(v[4], v[6]); ce_desc(v[5], v[7]); ce_desc(v[8], v[10]); ce_desc(v[9], v[11]); ce_desc(v[13], v[14]);
    ce_desc(v[1], v[4]); ce_desc(v[2], v[6]); ce_desc(v[5], v[8]); ce_desc(v[7], v[10]); ce_desc(v[9], v[13]); ce_desc(v[11], v[14]);
    ce_desc(v[2], v[4]); ce_desc(v[3], v[6]); ce_desc(v[9], v[12]); ce_desc(v[11], v[13]);
    ce_desc(v[3], v[5]); ce_desc(v[6], v[8]); ce_desc(v[7], v[9]); ce_desc(v[10], v[12]);
    ce_desc(v[3], v[4]); ce_desc(v[5], v[6]); ce_desc(v[7], v[8]); ce_desc(v[9], v[10]); ce_desc(v[11], v[12]);
    ce_desc(v[6], v[7]); ce_desc(v[8], v[9]);
}
DEVI void merge16_desc(unsigned (&v)[16]) {
#pragma unroll
    for (int j = 8; j > 0; j >>= 1)
#pragma unroll
        for (int i = 0; i < 16; ++i) { const int l = i ^ j; if (l > i) ce_desc(v[i], v[l]); }
}
DEVI void top16_merge(unsigned (&a)[16], const unsigned (&b)[16]) {
#pragma unroll
    for (int i = 0; i < 16; ++i) a[i] = kmax_(a[i], b[15 - i]);
    merge16_desc(a);
}
DEVI int crow16(int r, int hi) { return (r & 3) + 8 * (r >> 2) + 4 * hi; }

DEVI void subkey_top16(unsigned (&best)[16], const bf16* qrow  , const LAS unsigned char* kl  , int hi) {
    bf16x8_t qf[8];
#pragma unroll
    for (int ks = 0; ks < 8; ++ks) qf[ks] = *(const bf16x8_t*)(qrow + 16 * ks);
    unsigned grp[16];
#pragma unroll
    for (int nt = 0; nt < 4; ++nt) {
        f32x16_t acc = {};
#pragma unroll
        for (int ks = 0; ks < 8; ++ks) { const bf16x8_t kf = *(const LAS bf16x8_t*)(kl + ks * 4096 + nt * 512); acc = __builtin_amdgcn_mfma_f32_32x32x16_bf16(kf, qf[ks], acc, 0, 0, 0); }
#pragma unroll
        for (int r = 0; r < 16; ++r) { const float av = acc[r]; grp[r] = (__builtin_bit_cast(unsigned, av) & 0xffffff80u) | (unsigned)(127 - (32 * nt + crow16(r, hi))); }
        sort16_desc(grp);
        if (nt == 0) {
#pragma unroll
            for (int r = 0; r < 16; ++r) best[r] = grp[r];
        } else top16_merge(best, grp);
    }
    unsigned oth[16];
#pragma unroll
    for (int r = 0; r < 16; ++r) oth[r] = (unsigned)__shfl_xor((int)best[r], 32);
    top16_merge(best, oth);
}
DEVI void topk_wave(const bf16* qbase, const LAS unsigned char* keys, LAS unsigned* scr  , int* eidx, float* egate, int lane) {
    const int r32 = lane & 31, hi = lane >> 5;
    unsigned b0[16], b1[16];
    subkey_top16(b0, qbase + 8 * hi, keys + hi * 2048 + r32 * 16, hi);
    subkey_top16(b1, qbase + 128 + 8 * hi, keys + 32768 + hi * 2048 + r32 * 16, hi);
    float s0[16], s1[16];
#pragma unroll
    for (int i = 0; i < 16; ++i) { s0[i] = __builtin_bit_cast(float, b0[i] & 0xffffff80u); s1[i] = __builtin_bit_cast(float, b1[i] & 0xffffff80u); }
#pragma unroll
    for (int w = 0; w < 4; ++w) {
        scr[lane * 9 + w] = (127u - (b0[4 * w] & 127u)) | ((127u - (b0[4 * w + 1] & 127u)) << 8) | ((127u - (b0[4 * w + 2] & 127u)) << 16) | ((127u - (b0[4 * w + 3] & 127u)) << 24);
        scr[lane * 9 + 4 + w] = (127u - (b1[4 * w] & 127u)) | ((127u - (b1[4 * w + 1] & 127u)) << 8) | ((127u - (b1[4 * w + 2] & 127u)) << 16) | ((127u - (b1[4 * w + 3] & 127u)) << 24);
    }
    unsigned ca[16], cb2[16];
#define CAND(i, j) ((__builtin_bit_cast(unsigned, s0[i] + s1[j]) & 0xffffff00u) | (unsigned)(255 - ((i) * 16 + (j))))
    const unsigned lowest = 0xff800000u;
    if (hi == 0) {
#pragma unroll
        for (int j = 0; j < 16; ++j) ca[j] = CAND(0, j);
#pragma unroll
        for (int j = 0; j < 8; ++j) cb2[j] = CAND(1, j);
#pragma unroll
        for (int j = 8; j < 16; ++j) cb2[j] = lowest;
    } else {
        ca[0] = CAND(2, 0); ca[1] = CAND(2, 1); ca[2] = CAND(2, 2); ca[3] = CAND(2, 3); ca[4] = CAND(2, 4); ca[5] = CAND(3, 0); ca[6] = CAND(3, 1); ca[7] = CAND(3, 2); ca[8] = CAND(3, 3);
        ca[9] = CAND(4, 0); ca[10] = CAND(4, 1); ca[11] = CAND(4, 2); ca[12] = CAND(5, 0); ca[13] = CAND(5, 1); ca[14] = CAND(6, 0); ca[15] = CAND(6, 1);
        cb2[0] = CAND(7, 0); cb2[1] = CAND(7, 1); cb2[2] = CAND(8, 0); cb2[3] = CAND(9, 0); cb2[4] = CAND(10, 0); cb2[5] = CAND(11, 0); cb2[6] = CAND(12, 0); cb2[7] = CAND(13, 0); cb2[8] = CAND(14, 0); cb2[9] = CAND(15, 0);
#pragma unroll
        for (int j = 10; j < 16; ++j) cb2[j] = lowest;
    }
#undef CAND
    sort16_desc(ca); sort16_desc(cb2); top16_merge(ca, cb2);
    unsigned oth[16];
#pragma unroll
    for (int r = 0; r < 16; ++r) oth[r] = (unsigned)__shfl_xor((int)ca[r], 32);
    top16_merge(ca, oth);
    const float mx = __builtin_bit_cast(float, ca[0] & 0xffffff00u); float ex[16]; float l = 0.f;
#pragma unroll
    for (int k = 0; k < 16; ++k) { ex[k] = __expf(__builtin_bit_cast(float, ca[k] & 0xffffff00u) - mx); l += ex[k]; }
    const float rl = 1.f / l;
    LDS_WAIT(); asm volatile("" ::: "memory");
    int ei[8]; float eg[8];
    const unsigned mhi = (unsigned)(-hi);
#pragma unroll
    for (int k = 0; k < 8; ++k) { const unsigned key = ca[k] ^ ((ca[k] ^ ca[8 + k]) & mhi); const unsigned ij = 255u - (key & 255u), i = ij >> 4, j = ij & 15u;
        const unsigned w0 = scr[lane * 9 + (i >> 2)], w1 = scr[lane * 9 + 4 + (j >> 2)];
        ei[k] = (int)(((w0 >> (8 * (i & 3))) & 255u) * PNK + ((w1 >> (8 * (j & 3))) & 255u)); eg[k] = __builtin_bit_cast(float, __builtin_bit_cast(unsigned, ex[k]) ^ ((__builtin_bit_cast(unsigned, ex[k]) ^ __builtin_bit_cast(unsigned, ex[8 + k])) & mhi)) * rl; }
    *(int4*)(eidx + hi * 8) = make_int4(ei[0], ei[1], ei[2], ei[3]); *(int4*)(eidx + hi * 8 + 4) = make_int4(ei[4], ei[5], ei[6], ei[7]);
    *(float4*)(egate + hi * 8) = make_float4(eg[0], eg[1], eg[2], eg[3]); *(float4*)(egate + hi * 8 + 4) = make_float4(eg[4], eg[5], eg[6], eg[7]);
    LDS_WAIT(); asm volatile("" ::: "memory");
}

typedef unsigned char fp8_t;
template <int VAR = 0> DEVI float dot16_fp8(pg8::u32x4 row, pg8::u32x4 ha, pg8::u32x4 hb, float acc) {
    if (VAR == 1) return __builtin_bit_cast(float, (row[0] ^ row[1]) ^ (row[2] ^ row[3]));
#pragma unroll
    for (int i = 0; i < 4; ++i) { const unsigned hlo = i < 2 ? ha[2 * i] : hb[2 * i - 4], hhi = i < 2 ? ha[2 * i + 1] : hb[2 * i - 3];
        acc = __builtin_amdgcn_fdot2_f32_bf16(__builtin_amdgcn_cvt_scalef32_pk_bf16_fp8(row[i], 1.0f, false), __builtin_bit_cast(bf16x2_t, hlo), acc, false);
        acc = __builtin_amdgcn_fdot2_f32_bf16(__builtin_amdgcn_cvt_scalef32_pk_bf16_fp8(row[i], 1.0f, true), __builtin_bit_cast(bf16x2_t, hhi), acc, false); }
    return acc;
}
template <int VAR = 0> DEVI void fma16_fp8(float (&acc)[16], float w, pg8::u32x4 row) {
    if (VAR == 1) { acc[0] += __builtin_bit_cast(float, row[0] ^ row[1]); acc[1] += __builtin_bit_cast(float, row[2] ^ row[3]); return; }
#pragma unroll
    for (int i = 0; i < 4; ++i) { const pg8::f32x2 lo = __builtin_amdgcn_cvt_pk_f32_fp8(row[i], false), hh = __builtin_amdgcn_cvt_pk_f32_fp8(row[i], true);
        acc[4 * i] += w * lo[0]; acc[4 * i + 1] += w * lo[1]; acc[4 * i + 2] += w * hh[0]; acc[4 * i + 3] += w * hh[1]; }
}
DEVI void sort128_asc(unsigned& a, unsigned& b, int lane) {
#pragma unroll
    for (int k = 2; k <= 128; k <<= 1)
#pragma unroll
        for (int j = k >> 1; j > 0; j >>= 1) {
            if (j == 64) { const unsigned lo = umin_(a, b), hi = umax_(a, b); a = lo; b = hi; }
            else {
                const bool upper = (lane & j) != 0;
                const bool asc_a = k == 128 ? true : ((lane & k) == 0), asc_b = k == 128 ? true : (k == 64 ? false : ((lane & k) == 0));
                const unsigned pa_ = (unsigned)__shfl_xor((int)a, j), pb_ = (unsigned)__shfl_xor((int)b, j);
                a = (upper != asc_a) ? umin_(a, pa_) : umax_(a, pa_);
                b = (upper != asc_b) ? umin_(b, pb_) : umax_(b, pb_);
            }
        }
}
constexpr int EXD = 8, EXP_LDS_WAVE = 12800 + 1024;
typedef int v8i_t __attribute__((ext_vector_type(8)));
typedef float v4f_t __attribute__((ext_vector_type(4)));
struct Row6 { pg8::u32x4 a; pg8::u32x2 b; };
template <int VAR> DEVI void experts_wave(LAS unsigned char* wl_, int t0, int tstep, const bf16* H2B, const float* part2, const unsigned char* PU, const unsigned char* PV, const int* EIDX, const float* EGATE, const float* fg, float* out, int lane) {
    if (t0 >= M) return;
    const int ntok = (M - t0 + tstep - 1) / tstep < 8 ? (M - t0 + tstep - 1) / tstep : 8;
    LAS int* sid = (LAS int*)wl_; LAS float* gsl = (LAS float*)(wl_ + 4096); LAS float* wl = (LAS float*)(wl_ + 8192); LAS float* r2l = (LAS float*)(wl_ + 12288);
    const unsigned g32 = (unsigned)lane & 31u, hsel = (unsigned)lane >> 5, l4 = (unsigned)lane * 4u;
#define LDI(p) (*(const int*)((const char*)(p) + l4))
#define LDF(p) (*(const float*)((const char*)(p) + l4))
#define LDROW(dst, tab, ridx) do { const unsigned char* rp_ = (tab) + (size_t)(unsigned)(ridx) * 768u; (dst).a = *(const pg8::u32x4*)(rp_ + g32 * 16u); (dst).b = *(const pg8::u32x2*)(rp_ + 512u + g32 * 8u); } while (0)
    for (int k = 0; k < ntok; ++k) { const int t = t0 + k * tstep;
        unsigned k0 = ((unsigned)LDI(EIDX + (size_t)t * 128) << 7) | (unsigned)lane, k1 = ((unsigned)LDI(EIDX + (size_t)t * 128 + 64) << 7) | (unsigned)(64 + lane);
        const float ga = LDF(EGATE + (size_t)t * 128), gb = LDF(EGATE + (size_t)t * 128 + 64);
        sort128_asc(k0, k1, lane);
        const unsigned sl0 = k0 & 127u, sl1 = k1 & 127u;
        const float x0 = __shfl(ga, (int)(sl0 & 63u)), y0 = __shfl(gb, (int)(sl0 & 63u)), x1 = __shfl(ga, (int)(sl1 & 63u)), y1 = __shfl(gb, (int)(sl1 & 63u));
        sid[k * 128 + lane] = (int)(k0 >> 7); sid[k * 128 + 64 + lane] = (int)(k1 >> 7);
        gsl[k * 128 + lane] = sl0 < 64u ? x0 : y0; gsl[k * 128 + 64 + lane] = sl1 < 64u ? x1 : y1;
        const float r2 = rsqrtf(wave_sum(lane < 16 ? LDF(part2 + (size_t)t * 16) : 0.f) * (1.f / D) + EPS) * (1.0f / PU_SCALE);
        if (lane == 0) r2l[k] = r2; }
    LDS_WAIT(); asm volatile("" ::: "memory");
    const int nsteps = 8 * ntok;
#define STEP_DESC(q, tab, pos0) do { const int q_ = (q); if (q_ < nsteps) { (tab) = PU; (pos0) = ((q_ >> 5) * 4 + (q_ & 3)) * 128 + 16 * ((q_ >> 2) & 7); } \
        else if (q_ < 2 * nsteps) { const int qq_ = q_ - nsteps; (tab) = PV; (pos0) = ((qq_ >> 4) * 2 + (qq_ & 1)) * 128 + 16 * ((qq_ >> 1) & 7); } else { (tab) = PV; (pos0) = 0; } } while (0)
    constexpr int LOOK = 1;
    Row6 buf[8 * LOOK];
    pg8::u32x4 hhi[4];
#define CONVERT_GRP(g_) do { LAS unsigned char* img = wl_ + 12800; const int c16 = lane & 15, q4 = lane >> 4; \
      _Pragma("unroll") for (int k = 0; k < 4; ++k) { const int tt_ = t0 + (4 * (g_) + k) * tstep; \
          const pg8::u32x4 h0 = *(const pg8::u32x4*)((const char*)(H2B + (size_t)tt_ * D) + lane * 32), h1 = *(const pg8::u32x4*)((const char*)(H2B + (size_t)tt_ * D) + lane * 32 + 16); \
          float hf[16]; \
          _Pragma("unroll") for (int j = 0; j < 4; ++j) { hf[2 * j] = __builtin_bit_cast(float, h0[j] << 16); hf[2 * j + 1] = __builtin_bit_cast(float, h0[j] & 0xffff0000u); hf[8 + 2 * j] = __builtin_bit_cast(float, h1[j] << 16); hf[8 + 2 * j + 1] = __builtin_bit_cast(float, h1[j] & 0xffff0000u); } \
          pg8::u32x4 hiw; \
          _Pragma("unroll") for (int w = 0; w < 4; ++w) { int p = __builtin_amdgcn_cvt_pk_fp8_f32(hf[4 * w], hf[4 * w + 1], 0, false); p = __builtin_amdgcn_cvt_pk_fp8_f32(hf[4 * w + 2], hf[4 * w + 3], p, true); \
              hiw[w] = (unsigned)p; } \
          *(LAS pg8::u32x4*)(img + lane * 16) = hiw; \
          LDS_WAIT(); asm volatile("" ::: "memory"); \
          const int off = 32 * c16 + 512 * (q4 >> 1) + 16 * (q4 & 1); \
          hhi[k] = *(const LAS pg8::u32x4*)(img + off); \
          LDS_WAIT(); asm volatile("" ::: "memory"); } } while (0)
#pragma unroll
    for (int i = 0; i < 8; ++i) { const int ri = sid[2 * i + (int)hsel]; LDROW(buf[i], PU, ri); }
#define TR_STEP(S) _Pragma("unroll") for (int i = 0; i < S; ++i) { const bool up_ = (lane & S) != 0; const float send = up_ ? r[i] : r[i + S], keep = up_ ? r[i + S] : r[i]; r[i] = keep + __shfl_xor(send, S); }
#define U_STEP(q, B_, K_, G_) do { const int q__ = (q); const int ub_ = (B_); constexpr int uk_ = (K_); const int tk_ = 4 * (G_) + uk_; \
        const unsigned char* ntab; int npos; STEP_DESC(q__ + LOOK, ntab, npos); npos += (int)hsel; \
        const v8i_t AAh = {(int)hhi[uk_][0], (int)hhi[uk_][1], (int)hhi[uk_][2], (int)hhi[uk_][3], 0, 0, 0, 0}; \
        const v8i_t ABh = {0, 0, 0, 0, (int)hhi[uk_][0], (int)hhi[uk_][1], (int)hhi[uk_][2], (int)hhi[uk_][3]}; \
        const int c16_ = lane & 15; const bool dg_ = (lane >> 4) == (c16_ >> 2); \
        float r[16]; int riu_[8]; \
        _Pragma("unroll") for (int i2 = 0; i2 < 8; ++i2) riu_[i2] = sid[npos + 2 * i2]; \
        _Pragma("unroll") for (int i2 = 0; i2 < 8; ++i2) { \
            const v8i_t B6 = {(int)buf[i2].a[0], (int)buf[i2].a[1], (int)buf[i2].a[2], (int)buf[i2].a[3], (int)buf[i2].b[0], (int)buf[i2].b[1], 0, 0}; \
            const v4f_t z4 = {0.f, 0.f, 0.f, 0.f}; \
            v4f_t cA = __builtin_amdgcn_mfma_scale_f32_16x16x128_f8f6f4(AAh, B6, z4, 0, 2, 0, 127, 0, 127); \
            v4f_t cB = __builtin_amdgcn_mfma_scale_f32_16x16x128_f8f6f4(ABh, B6, z4, 0, 2, 0, 127, 0, 127); \
            LDROW(buf[i2], ntab, riu_[i2]); \
            const float a01 = (c16_ & 1) ? cA[1] : cA[0], a23 = (c16_ & 1) ? cA[3] : cA[2], b01 = (c16_ & 1) ? cB[1] : cB[0], b23 = (c16_ & 1) ? cB[3] : cB[2]; \
            r[2 * i2] = dg_ ? ((c16_ & 2) ? a23 : a01) : 0.f; r[2 * i2 + 1] = dg_ ? ((c16_ & 2) ? b23 : b01) : 0.f; \
            __builtin_amdgcn_sched_barrier(0); } \
        TR_STEP(8) TR_STEP(4) TR_STEP(2) TR_STEP(1) \
        float tot = r[0] + __shfl_xor(r[0], 16); tot += __shfl_xor(tot, 32); \
        const int pos = tk_ * 128 + 16 * ub_ + c16_; \
        const float a = tot * r2l[tk_]; \
        const float wf_ = 0.5f * a * (1.f + erff(a * 0.70710678118654752f)) * gsl[pos] * (1.0f / PV_SCALE); \
        const unsigned wb_ = __builtin_bit_cast(unsigned, wf_) + (1u << 19);     \
        ((LAS unsigned*)wl)[pos] = ((wb_ >> 31) << 5) | 8u | ((wb_ >> 20) & 7u) | (((wb_ >> 23) & 255u) << 8); } while (0)
    if (ntok == 8) {
#pragma unroll 1
        for (int grp = 0; grp < 2; ++grp) {
            CONVERT_GRP(grp);
#pragma unroll 1
            for (int b = 0; b < 8; ++b) { const int q = grp * 32 + b * 4;
                U_STEP(q, b, 0, grp); U_STEP(q + 1, b, 1, grp); U_STEP(q + 2, b, 2, grp); U_STEP(q + 3, b, 3, grp); }
        }
    }
#undef CONVERT_GRP
#undef U_STEP
#undef TR_STEP
    LDS_WAIT(); asm volatile("" ::: "memory");
    typedef float v16f_tt __attribute__((ext_vector_type(16)));
    const int iv = lane & 31, hv = lane >> 5, bo = 6 * iv, r0v = bo >> 5, shv = bo & 31, rshv = shv > 26 ? 32 - shv : 31;
    unsigned m0v[6], m1v[6];
#pragma unroll
    for (int d = 0; d < 6; ++d) { m0v[d] = d == r0v ? ~0u : 0u; m1v[d] = d == r0v + 1 ? ~0u : 0u; }
    const unsigned ebase = 32u * (unsigned)iv + 4u * (unsigned)hv;
    float4 fgq[4];
#pragma unroll
    for (int r4 = 0; r4 < 4; ++r4) fgq[r4] = *(const float4*)(fg + ebase + 8 * r4);
#define V_STEP(q, CACC, KT) do { const int q__ = (q); const int b = ((q__ - nsteps) >> 1) & 7; \
        const unsigned char* ntab; int npos; STEP_DESC(q__ + LOOK, ntab, npos); npos += (int)hsel; \
        const int wpos = (KT) * 128 + b * 16 + (int)hsel; \
        unsigned cwv_[8]; int riv_[8];     \
        _Pragma("unroll") for (int i2 = 0; i2 < 8; ++i2) { cwv_[i2] = ((const LAS unsigned*)wl)[wpos + 2 * i2]; riv_[i2] = sid[npos + 2 * i2]; } \
        _Pragma("unroll") for (int i2 = 0; i2 < 8; ++i2) { \
            const v8i_t B6 = {(int)buf[i2].a[0], (int)buf[i2].a[1], (int)buf[i2].a[2], (int)buf[i2].a[3], (int)buf[i2].b[0], (int)buf[i2].b[1], 0, 0}; \
            const unsigned cw_ = cwv_[i2]; const unsigned c6_ = cw_ & 63u, lo_ = c6_ << shv, hi_ = c6_ >> rshv; const int sc_ = (int)(cw_ >> 8); \
            const v8i_t A6 = {(int)((lo_ & m0v[0]) | (hi_ & m1v[0])), (int)((lo_ & m0v[1]) | (hi_ & m1v[1])), (int)((lo_ & m0v[2]) | (hi_ & m1v[2])), (int)((lo_ & m0v[3]) | (hi_ & m1v[3])), (int)((lo_ & m0v[4]) | (hi_ & m1v[4])), (int)((lo_ & m0v[5]) | (hi_ & m1v[5])), 0, 0}; \
            CACC = __builtin_amdgcn_mfma_scale_f32_32x32x64_f8f6f4(A6, B6, CACC, 2, 2, 0, sc_, 0, 127); \
            LDROW(buf[i2], ntab, riv_[i2]); \
            __builtin_amdgcn_sched_barrier(0); } } while (0)
#define V_FINISH(CACC, KT) do { const int t = t0 + (KT) * tstep; float ss = 0.f; float fin[16]; \
        _Pragma("unroll") for (int r4 = 0; r4 < 4; ++r4) { const pg8::u32x2 rr_ = *(const pg8::u32x2*)(H2B + (size_t)t * D + ebase + 8 * r4); \
            fin[4 * r4] = CACC[4 * r4] + __builtin_bit_cast(float, rr_[0] << 16); fin[4 * r4 + 1] = CACC[4 * r4 + 1] + __builtin_bit_cast(float, rr_[0] & 0xffff0000u); \
            fin[4 * r4 + 2] = CACC[4 * r4 + 2] + __builtin_bit_cast(float, rr_[1] << 16); fin[4 * r4 + 3] = CACC[4 * r4 + 3] + __builtin_bit_cast(float, rr_[1] & 0xffff0000u); } \
        _Pragma("unroll") for (int j = 0; j < 16; ++j) ss += fin[j] * fin[j]; \
        const float rr = rsqrtf(wave_sum(ss) * (1.f / D) + EPS); \
        _Pragma("unroll") for (int r4 = 0; r4 < 4; ++r4) { const float4 g = fgq[r4]; \
            *(float4*)(out + (size_t)t * D + ebase + 8 * r4) = make_float4(fin[4 * r4] * rr * g.x, fin[4 * r4 + 1] * rr * g.y, fin[4 * r4 + 2] * rr * g.z, fin[4 * r4 + 3] * rr * g.w); } } while (0)
#pragma unroll 1
    for (int grp = 0; grp < ntok / 2; ++grp) { const int kb_ = 2 * grp;
        v16f_tt ca0, ca1;
#pragma unroll
        for (int j = 0; j < 16; ++j) { ca0[j] = 0.f; ca1[j] = 0.f; }
#pragma unroll 1
        for (int bb = 0; bb < 8; ++bb) { const int q = nsteps + 16 * grp + 2 * bb; V_STEP(q, ca0, kb_); V_STEP(q + 1, ca1, kb_ + 1); }
        V_FINISH(ca0, kb_); V_FINISH(ca1, kb_ + 1);
        __builtin_amdgcn_sched_barrier(0);
    }
#undef V_FINISH
#undef V_STEP
#undef STEP_DESC
#undef LDI
#undef LDF
#undef LDROW
}

typedef short v4i16_t __attribute__((ext_vector_type(4)));
typedef int v2i32_t __attribute__((ext_vector_type(2)));
typedef int v4i32_t __attribute__((ext_vector_type(4)));
DEVI bf16x8_t join_tr(v4i16_t lo, v4i16_t hh) { const v2i32_t a = __builtin_bit_cast(v2i32_t, lo), b = __builtin_bit_cast(v2i32_t, hh); const v4i32_t w = {a[0], a[1], b[0], b[1]}; return __builtin_bit_cast(bf16x8_t, w); }
DEVI float max3f(float a, float b, float c) { float r; asm("v_max3_f32 %0, %1, %2, %3" : "=v"(r) : "v"(a), "v"(b), "v"(c)); return r; }
DEVI float max2f(float a, float b) { float r; asm("v_max_f32_e32 %0, %1, %2" : "=v"(r) : "v"(a), "v"(b)); return r; }
DEVI void glds16(const void* gsrc, unsigned lds_dst) { unsigned keep;
    asm volatile("s_mov_b32 %0, m0\n\ts_mov_b32 m0, %2\n\ts_nop 0\n\tglobal_load_lds_dwordx4 %1, off\n\ts_mov_b32 m0, %0" : "=&s"(keep) : "v"(gsrc), "s"(lds_dst) : "memory"); }
#define LDSADDR(p) ((unsigned)__builtin_amdgcn_readfirstlane((int)(unsigned)(uintptr_t)(p)))
#define ATT_BAR(N) asm volatile("s_waitcnt vmcnt(" #N ") lgkmcnt(0)\n\ts_barrier" ::: "memory")
template <int DQK, int DV, int DSPLIT, int NSLOT, int PD, bool CAUSAL, bool STAG, int VAR = 0>
DEVI void attn_unit(LAS unsigned char* S, const bf16* Qu, int qpitch, const bf16* Ku, int kpitch, const bf16* Vu, int vpitch, bf16* Ou, int opitch, int NT, int qcb) {
    constexpr int NCH = DQK / 8, KSLOT = NCH * 1024, NVG = DV / 32, VSLOT = NVG * 4096, NRG = 8 / DSPLIT, DVW = DV / DSPLIT, NOD = DVW / 32, NKS = DQK / 16;
    constexpr int KOFF = 0, VOFF = NSLOT * KSLOT, WSF = VOFF + NSLOT * VSLOT;
    static_assert(NRG * 32 * DVW * 2 * DSPLIT <= NSLOT * KSLOT, "O staging reuses the K ring");
    static_assert(NSLOT >= PD + (STAG ? 2 : 1), "ring depth");
    int tid_ = threadIdx.x; asm volatile("" : "+v"(tid_));
    const int lane = tid_ & 63, wid = __builtin_amdgcn_readfirstlane(tid_ >> 6), r32 = lane & 31, hi = lane >> 5, rg = wid % NRG, dp = wid / NRG;
    const bool late = STAG && wid >= 4;
    LAS float* wsf = (LAS float*)(S + WSF) + wid * 64;
    const int nld = (NCH - wid + 7) / 8 + (NVG * 4 - wid + 7) / 8;
    const bf16* ksrc = Ku + (size_t)lane * kpitch;
    const bf16* vsrc = Vu + (size_t)(lane >> 2) * vpitch + (lane & 3) * 8;
#define ATT_DMA(t, slot) do { \
        _Pragma("unroll") for (int pc_ = 0; pc_ < (NCH + 7) / 8; ++pc_) { const int pc = wid + 8 * pc_; if (pc < NCH) \
            glds16(ksrc + (size_t)(t) * 64 * kpitch + pc * 8, LDSADDR(S + KOFF + (slot) * KSLOT + pc * 1024)); } \
        _Pragma("unroll") for (int pv_ = 0; pv_ < (NVG * 4 + 7) / 8; ++pv_) { const int pv = wid + 8 * pv_; if (pv < NVG * 4) \
            glds16(vsrc + (size_t)((t) * 64 + (pv & 3) * 16) * vpitch + (pv >> 2) * 32, LDSADDR(S + VOFF + (slot) * VSLOT + pv * 1024)); } } while (0)
    bf16x8_t qr[NKS];
#pragma unroll
    for (int ks = 0; ks < NKS; ++ks) qr[ks] = *(const bf16x8_t*)(Qu + (size_t)(32 * rg + r32) * qpitch + ks * 16 + hi * 8);
#pragma unroll
    for (int ks = 0; ks < NKS; ++ks) asm volatile("" : "+v"(qr[ks]));
#pragma unroll
    for (int t = 0; t < PD; ++t) if (t < NT) ATT_DMA(t, t);
    f32x16_t o[NOD];
#pragma unroll
    for (int dd = 0; dd < NOD; ++dd) o[dd] = f32x16_t{};
    float m = 0.f, l = 0.f; f32x16_t negm = f32x16_t{};
    const int tlast = CAUSAL ? qcb + (rg >> 1) : NT - 1;
    const LAS unsigned char* kbase = S + KOFF + hi * 1024 + r32 * 16;
    const LAS unsigned char* vbase = S + VOFF + ((lane >> 4) & 1) * 32 + (lane & 3) * 8 + (4 * hi + ((lane & 15) >> 2)) * 64 + dp * NOD * 4096;
    bf16x8_t pa[4];
#define ATT_QKSM(sl) do { const LAS unsigned char* kp = kbase + (sl) * KSLOT; \
            f32x16_t p0 = negm, p1 = negm; \
            _Pragma("unroll") for (int ks = 0; ks < NKS; ++ks) { const bf16x8_t a0 = *(const LAS bf16x8_t*)(kp + ks * 2048), a1 = *(const LAS bf16x8_t*)(kp + ks * 2048 + 512); \
                if (VAR != 2) { p0 = __builtin_amdgcn_mfma_f32_32x32x16_bf16(a0, qr[ks], p0, 0, 0, 0); p1 = __builtin_amdgcn_mfma_f32_32x32x16_bf16(a1, qr[ks], p1, 0, 0, 0); } else { p0[ks] += __builtin_bit_cast(float, (int)a0[0]); p1[ks] += __builtin_bit_cast(float, (int)a1[0]); } } \
            asm volatile("s_nop 15\n\ts_nop 7" : "+v"(p0), "+v"(p1)); \
            float rm = 0.f; \
            if (VAR != 1) { float a = max3f(p0[0], p0[1], p1[0]), b = max3f(p0[2], p0[3], p1[1]); a = max3f(a, p1[2], p1[3]); \
              _Pragma("unroll") for (int r = 4; r < 16; r += 4) { a = max3f(a, p0[r], p0[r + 1]); b = max3f(b, p0[r + 2], p0[r + 3]); a = max3f(a, p1[r], p1[r + 1]); b = max3f(b, p1[r + 2], p1[r + 3]); } \
              rm = max2f(a, b); rm = max2f(rm, __shfl_xor(rm, 32)); } \
            if (__any(rm > 0.f)) { \
                const float dl = fmaxf(rm, 0.f), alpha = __builtin_amdgcn_exp2f(-dl); m += dl; l *= alpha; \
                _Pragma("unroll") for (int r = 0; r < 16; ++r) { p0[r] -= dl; p1[r] -= dl; negm[r] = -m; } \
                if (hi == 0) wsf[r32] = alpha; \
                LDS_WAIT(); asm volatile("" ::: "memory"); \
                _Pragma("unroll") for (int r = 0; r < 16; ++r) { const float f = wsf[crow16(r, hi)]; \
                    _Pragma("unroll") for (int dd = 0; dd < NOD; ++dd) o[dd][r] *= f; } \
                LDS_WAIT(); asm volatile("" ::: "memory"); \
            } \
            float ls = 0.f; \
            if (VAR != 1) { _Pragma("unroll") for (int r = 0; r < 16; ++r) { p0[r] = __builtin_amdgcn_exp2f(p0[r]); p1[r] = __builtin_amdgcn_exp2f(p1[r]); ls += p0[r] + p1[r]; } } \
            l += ls; \
            _Pragma("unroll") for (int ks = 0; ks < 4; ++ks) { pg8::u32x4 w; \
                if (ks < 2) { w.x = pg8::cvt_pk_bf16(p0[8 * ks], p0[8 * ks + 1]); w.y = pg8::cvt_pk_bf16(p0[8 * ks + 2], p0[8 * ks + 3]); w.z = pg8::cvt_pk_bf16(p0[8 * ks + 4], p0[8 * ks + 5]); w.w = pg8::cvt_pk_bf16(p0[8 * ks + 6], p0[8 * ks + 7]); } \
                else { const int k2 = ks - 2; w.x = pg8::cvt_pk_bf16(p1[8 * k2], p1[8 * k2 + 1]); w.y = pg8::cvt_pk_bf16(p1[8 * k2 + 2], p1[8 * k2 + 3]); w.z = pg8::cvt_pk_bf16(p1[8 * k2 + 4], p1[8 * k2 + 5]); w.w = pg8::cvt_pk_bf16(p1[8 * k2 + 6], p1[8 * k2 + 7]); } \
                pa[ks] = __builtin_bit_cast(bf16x8_t, w); } } while (0)
#define ATT_PV(sl) do { const LAS unsigned char* vp = vbase + (sl) * VSLOT; \
            _Pragma("unroll") for (int dd = 0; dd < NOD; ++dd) \
                _Pragma("unroll") for (int ks = 0; ks < 4; ++ks) { \
                    const v4i16_t lo = __builtin_amdgcn_ds_read_tr16_b64_v4i16((LAS v4i16_t*)(vp + dd * 4096 + ks * 1024)); \
                    const v4i16_t hh = __builtin_amdgcn_ds_read_tr16_b64_v4i16((LAS v4i16_t*)(vp + dd * 4096 + ks * 1024 + 512)); \
                    const bf16x8_t vf = join_tr(lo, hh); \
                    if (VAR != 2) o[dd] = __builtin_amdgcn_mfma_f32_32x32x16_bf16(pa[ks], vf, o[dd], 0, 0, 0); else o[dd][ks] += __builtin_bit_cast(float, (int)vf[0] + (int)pa[ks][0]); } } while (0)
    int slot = 0, slot_prev = NSLOT - 1, slot_issue = PD % NSLOT;
    for (int t = 0; t < NT; ++t) {
        const int ahead = (t + PD - 1 < NT - 1 ? t + PD - 1 : NT - 1) - t;
        const int nwait = ahead * nld;
        if (nwait <= 0) ATT_BAR(0); else if (nwait == 2) ATT_BAR(2); else if (nwait == 3) ATT_BAR(3); else if (nwait == 4) ATT_BAR(4); else if (nwait == 6) ATT_BAR(6); else if (nwait == 8) ATT_BAR(8); else ATT_BAR(0);
        if (t + PD < NT) ATT_DMA(t + PD, slot_issue);
        if (!late) { if (t <= tlast) { ATT_QKSM(slot); ATT_PV(slot); } }
        else { if (t >= 1 && t - 1 <= tlast) ATT_PV(slot_prev); if (t <= tlast) ATT_QKSM(slot); }
        slot_prev = slot; slot = slot + 1 == NSLOT ? 0 : slot + 1; slot_issue = slot_issue + 1 == NSLOT ? 0 : slot_issue + 1;
    }
    if (late && tlast >= NT - 1) ATT_PV(slot_prev);
    l += __shfl_xor(l, 32);
    if (hi == 0) wsf[32 + r32] = l;
    ATT_BAR(0);
    LAS bf16* stg = (LAS bf16*)(S + KOFF) + wid * 32 * DVW;
#pragma unroll
    for (int r = 0; r < 16; ++r) { const int orow = crow16(r, hi); const float rl = __builtin_amdgcn_rcpf(wsf[32 + orow]);
#pragma unroll
        for (int dd = 0; dd < NOD; ++dd) stg[orow * DVW + dd * 32 + r32] = f2bf(o[dd][r] * rl); }
    LDS_WAIT(); asm volatile("" ::: "memory");
#pragma unroll
    for (int i = 0; i < DVW / 16; ++i) { const int idx = i * 64 + lane, row = idx / (DVW / 8), ch = idx % (DVW / 8);
        *(pg8::u32x4*)(Ou + (size_t)(32 * rg + row) * opitch + dp * DVW + ch * 8) = *(const LAS pg8::u32x4*)(stg + row * DVW + ch * 8); }
    ATT_BAR(0);
#undef ATT_DMA
#undef ATT_QKSM
#undef ATT_PV
}

typedef float f32x2_t __attribute__((ext_vector_type(2)));
DEVI unsigned cvtpk(float lo, float hi) { const f32x2_t v = {lo, hi}; const bf16x2_t b = __builtin_convertvector(v, bf16x2_t); return __builtin_bit_cast(unsigned, b); }
DEVI void attn_mla_unit(LAS unsigned char* S, const bf16* Qu, const bf16* Ku, const bf16* Vu, bf16* Ou, int NT, int qcb) {
    constexpr int NCH = 12, KSLOT = NCH * 1024, VSLOT = 8192, NSLOT = 4, NKS = 6, qpitch = 768, kpitch = 768, vpitch = 512, opitch = D;
    constexpr int KOFF = 0, VOFF = NSLOT * KSLOT, WSF = VOFF + NSLOT * VSLOT;
    int tid_ = threadIdx.x; asm volatile("" : "+v"(tid_));
    const int lane = tid_ & 63, wid = __builtin_amdgcn_readfirstlane(tid_ >> 6), r32 = lane & 31, hi = lane >> 5;
    LAS float* wsf = (LAS float*)(S + WSF) + wid * 64;
    const int nld = wid < 4 ? 3 : 2;
    const bf16* ksrc = Ku + (size_t)lane * kpitch;
    const bf16* vsrc = Vu + (size_t)(lane >> 2) * vpitch + (lane & 3) * 8;
#define MLA_DMA(t, slot) do { \
        glds16(ksrc + (size_t)(t) * 64 * kpitch + wid * 8, LDSADDR(S + KOFF + (slot) * KSLOT + wid * 1024)); \
        if (wid < 4) glds16(ksrc + (size_t)(t) * 64 * kpitch + (wid + 8) * 8, LDSADDR(S + KOFF + (slot) * KSLOT + (wid + 8) * 1024)); \
        glds16(vsrc + (size_t)((t) * 64 + (wid & 3) * 16) * vpitch + (wid >> 2) * 32, LDSADDR(S + VOFF + (slot) * VSLOT + wid * 1024)); } while (0)
#define MLA_BAR(nw) do { if ((nw) <= 0) ATT_BAR(0); else if ((nw) == 2) ATT_BAR(2); else if ((nw) == 3) ATT_BAR(3); else if ((nw) == 4) ATT_BAR(4); else ATT_BAR(6); } while (0)
#define SGB(mask, n) __builtin_amdgcn_sched_group_barrier(mask, n, 0)
    bf16x8_t qr[NKS];
#pragma unroll
    for (int ks = 0; ks < NKS; ++ks) qr[ks] = *(const bf16x8_t*)(Qu + (size_t)(32 * wid + r32) * qpitch + ks * 16 + hi * 8);
#pragma unroll
    for (int ks = 0; ks < NKS; ++ks) asm volatile("" : "+v"(qr[ks]));
    MLA_DMA(0, 0); MLA_DMA(1, 1); MLA_DMA(2, 2);
    f32x16_t o0 = f32x16_t{}, o1 = f32x16_t{};
    float m = 0.f, l = 0.f; f32x16_t negm = f32x16_t{};
    const int tlast = qcb + (wid >> 1);
    const LAS unsigned char* kbase = S + KOFF + hi * 1024 + r32 * 16;
    const LAS unsigned char* vbase = S + VOFF + ((lane >> 4) & 1) * 32 + (lane & 3) * 8 + (4 * hi + ((lane & 15) >> 2)) * 64;
    f32x16_t p0, p1;
#define MLA_ROWMAX(rm, q0, q1) do { float a_ = __builtin_fmaxf(__builtin_fmaxf(q0[0], q0[1]), q1[0]), b_ = __builtin_fmaxf(__builtin_fmaxf(q0[2], q0[3]), q1[1]); a_ = __builtin_fmaxf(__builtin_fmaxf(a_, q1[2]), q1[3]); \
        _Pragma("unroll") for (int r = 4; r < 16; r += 4) { a_ = __builtin_fmaxf(__builtin_fmaxf(a_, q0[r]), q0[r + 1]); b_ = __builtin_fmaxf(__builtin_fmaxf(b_, q0[r + 2]), q0[r + 3]); a_ = __builtin_fmaxf(__builtin_fmaxf(a_, q1[r]), q1[r + 1]); b_ = __builtin_fmaxf(__builtin_fmaxf(b_, q1[r + 2]), q1[r + 3]); } \
        rm = __builtin_fmaxf(a_, b_); rm = __builtin_fmaxf(rm, __shfl_xor(rm, 32)); } while (0)
#define MLA_MOVE(rm, q0, q1) do { if (__any(rm > 0.f)) { \
            const float dl = fmaxf(rm, 0.f), alpha = __builtin_amdgcn_exp2f(-dl); m += dl; l *= alpha; \
            _Pragma("unroll") for (int r = 0; r < 16; ++r) { q0[r] -= dl; q1[r] -= dl; negm[r] = -m; } \
            if (hi == 0) wsf[r32] = alpha; \
            LDS_WAIT(); asm volatile("" ::: "memory"); \
            _Pragma("unroll") for (int r = 0; r < 16; ++r) { const float f = wsf[crow16(r, hi)]; o0[r] *= f; o1[r] *= f; } \
            LDS_WAIT(); asm volatile("" ::: "memory"); } } while (0)
    MLA_BAR(2 * nld);
    MLA_DMA(3, 3);
    { const LAS unsigned char* kp = kbase; p0 = negm; p1 = negm;
#pragma unroll
      for (int ks = 0; ks < NKS; ++ks) { const bf16x8_t a0 = *(const LAS bf16x8_t*)(kp + ks * 2048), a1 = *(const LAS bf16x8_t*)(kp + ks * 2048 + 512);
          p0 = __builtin_amdgcn_mfma_f32_32x32x16_bf16(a0, qr[ks], p0, 0, 0, 0); p1 = __builtin_amdgcn_mfma_f32_32x32x16_bf16(a1, qr[ks], p1, 0, 0, 0); }
      float rm; MLA_ROWMAX(rm, p0, p1); MLA_MOVE(rm, p0, p1); }
    int kslot = 1, vslot = 0, islot = 3;
    for (int t = 0; t < NT; ++t) {
        if (t + 1 < NT) { const int young = (t + 2 < NT) ? 1 : 0; MLA_BAR(young * nld); } else ATT_BAR(0);
        if (t >= 1 && t + 3 < NT) MLA_DMA(t + 3, islot);
        if (t < tlast) {
            const LAS unsigned char* kp = kbase + kslot * KSLOT; const LAS unsigned char* vp = vbase + vslot * VSLOT;
            bf16x8_t kf[12];
#pragma unroll
            for (int ks = 0; ks < NKS; ++ks) { kf[2 * ks] = *(const LAS bf16x8_t*)(kp + ks * 2048); kf[2 * ks + 1] = *(const LAS bf16x8_t*)(kp + ks * 2048 + 512); }
            f32x16_t n0 = negm, n1 = negm; float ls = 0.f; pg8::u32x4 pw[4];
#pragma unroll
            for (int ks = 0; ks < NKS; ++ks) { n0 = __builtin_amdgcn_mfma_f32_32x32x16_bf16(kf[2 * ks], qr[ks], n0, 0, 0, 0); n1 = __builtin_amdgcn_mfma_f32_32x32x16_bf16(kf[2 * ks + 1], qr[ks], n1, 0, 0, 0); }
#pragma unroll
            for (int r = 0; r < 16; ++r) { p0[r] = __builtin_amdgcn_exp2f(p0[r]); p1[r] = __builtin_amdgcn_exp2f(p1[r]); }
#pragma unroll
            for (int r = 0; r < 16; r += 2) { ls += (p0[r] + p0[r + 1]) + (p1[r] + p1[r + 1]); }
#pragma unroll
            for (int ks = 0; ks < 2; ++ks) { pw[ks] = (pg8::u32x4){cvtpk(p0[8 * ks], p0[8 * ks + 1]), cvtpk(p0[8 * ks + 2], p0[8 * ks + 3]), cvtpk(p0[8 * ks + 4], p0[8 * ks + 5]), cvtpk(p0[8 * ks + 6], p0[8 * ks + 7])};
                pw[2 + ks] = (pg8::u32x4){cvtpk(p1[8 * ks], p1[8 * ks + 1]), cvtpk(p1[8 * ks + 2], p1[8 * ks + 3]), cvtpk(p1[8 * ks + 4], p1[8 * ks + 5]), cvtpk(p1[8 * ks + 6], p1[8 * ks + 7])}; }
            l += ls;
            SGB(0x100, 4);
#pragma unroll
            for (int i = 0; i < 12; ++i) { SGB(0x008, 1); SGB(0x002, 7); if (i < 8) SGB(0x100, 1); }
            __builtin_amdgcn_sched_barrier(0);
            v4i16_t vlo[8], vhi[8];
#pragma unroll
            for (int i = 0; i < 8; ++i) { vlo[i] = __builtin_amdgcn_ds_read_tr16_b64_v4i16((LAS v4i16_t*)(vp + (i >> 2) * 4096 + (i & 3) * 1024)); vhi[i] = __builtin_amdgcn_ds_read_tr16_b64_v4i16((LAS v4i16_t*)(vp + (i >> 2) * 4096 + (i & 3) * 1024 + 512)); }
#pragma unroll
            for (int i = 0; i < 8; ++i) { const bf16x8_t vf = join_tr(vlo[i], vhi[i]); const bf16x8_t pa_ = __builtin_bit_cast(bf16x8_t, pw[i & 3]);
                if (i < 4) o0 = __builtin_amdgcn_mfma_f32_32x32x16_bf16(pa_, vf, o0, 0, 0, 0); else o1 = __builtin_amdgcn_mfma_f32_32x32x16_bf16(pa_, vf, o1, 0, 0, 0); }
            float rm; MLA_ROWMAX(rm, n0, n1);
            SGB(0x100, 6);
#pragma unroll
            for (int i = 0; i < 8; ++i) { SGB(0x008, 1); SGB(0x002, 3); if (i < 5) SGB(0x100, 2); }
            __builtin_amdgcn_sched_barrier(0);
            MLA_MOVE(rm, n0, n1);
            p0 = n0; p1 = n1;
        } else if (t == tlast) {
            asm volatile("" : "+v"(p0), "+v"(p1));
            const LAS unsigned char* vp = vbase + vslot * VSLOT; float ls = 0.f; pg8::u32x4 pw[4];
#pragma unroll
            for (int r = 0; r < 16; ++r) { p0[r] = __builtin_amdgcn_exp2f(p0[r]); p1[r] = __builtin_amdgcn_exp2f(p1[r]); ls += p0[r] + p1[r]; }
            l += ls;
#pragma unroll
            for (int ks = 0; ks < 2; ++ks) { pw[ks] = (pg8::u32x4){cvtpk(p0[8 * ks], p0[8 * ks + 1]), cvtpk(p0[8 * ks + 2], p0[8 * ks + 3]), cvtpk(p0[8 * ks + 4], p0[8 * ks + 5]), cvtpk(p0[8 * ks + 6], p0[8 * ks + 7])};
                pw[2 + ks] = (pg8::u32x4){cvtpk(p1[8 * ks], p1[8 * ks + 1]), cvtpk(p1[8 * ks + 2], p1[8 * ks + 3]), cvtpk(p1[8 * ks + 4], p1[8 * ks + 5]), cvtpk(p1[8 * ks + 6], p1[8 * ks + 7])}; }
#pragma unroll
            for (int i = 0; i < 8; ++i) { const v4i16_t lo = __builtin_amdgcn_ds_read_tr16_b64_v4i16((LAS v4i16_t*)(vp + (i >> 2) * 4096 + (i & 3) * 1024)), hh = __builtin_amdgcn_ds_read_tr16_b64_v4i16((LAS v4i16_t*)(vp + (i >> 2) * 4096 + (i & 3) * 1024 + 512));
                const bf16x8_t vf = join_tr(lo, hh); const bf16x8_t pa_ = __builtin_bit_cast(bf16x8_t, pw[i & 3]);
                if (i < 4) o0 = __builtin_amdgcn_mfma_f32_32x32x16_bf16(pa_, vf, o0, 0, 0, 0); else o1 = __builtin_amdgcn_mfma_f32_32x32x16_bf16(pa_, vf, o1, 0, 0, 0); }
        }
        kslot = (kslot + 1) & 3; vslot = (vslot + 1) & 3; islot = (islot + 1) & 3;
    }
    l += __shfl_xor(l, 32);
    if (hi == 0) wsf[32 + r32] = l;
    ATT_BAR(0);
    LAS bf16* stg = (LAS bf16*)(S + KOFF) + wid * 32 * 64;
#pragma unroll
    for (int r = 0; r < 16; ++r) { const int orow = crow16(r, hi); const float rl = __builtin_amdgcn_rcpf(wsf[32 + orow]);
        stg[orow * 64 + r32] = f2bf(o0[r] * rl); stg[orow * 64 + 32 + r32] = f2bf(o1[r] * rl); }
    LDS_WAIT(); asm volatile("" ::: "memory");
#pragma unroll
    for (int i = 0; i < 4; ++i) { const int idx = i * 64 + lane, row = idx >> 3, ch = idx & 7;
        *(pg8::u32x4*)(Ou + (size_t)(32 * wid + row) * opitch + ch * 8) = *(const LAS pg8::u32x4*)(stg + row * 64 + ch * 8); }
    ATT_BAR(0);
#undef MLA_DMA
#undef MLA_BAR
#undef MLA_ROWMAX
#undef MLA_MOVE
#undef SGB
}

DEVI bool unit_of(int Mrows, int Ncols, int G, int c, int i, int& pm, int& pn) {
    const int nM = Mrows / 256, nN = Ncols / 256, nwg = nM * nN; const long Lq = (long)i * G + c; if (Lq >= nwg) return false;
    int wgid = (int)Lq; { const int q = nwg / 8, r = nwg % 8, xcd = wgid % 8, off = wgid / 8; wgid = (xcd < r ? xcd * (q + 1) : r * (q + 1) + (xcd - r) * q) + off; }
    const int nig = 8 * nN, gid = wgid / nig, fm = gid * 8, gsz = (nM - fm) < 8 ? (nM - fm) : 8;
    pm = fm + ((wgid % nig) % gsz); pn = (wgid % nig) / gsz; return true;
}
DEVI void own_writes_visible() {
    asm volatile("s_waitcnt vmcnt(0)" ::: "memory"); __syncthreads();
    if (threadIdx.x == 0) { __builtin_amdgcn_fence(__ATOMIC_ACQUIRE, "agent"); asm volatile("s_waitcnt vmcnt(0)" ::: "memory"); }
    __syncthreads();
}

__global__ void __launch_bounds__(NTHR, 2) mega(Args args) {
    extern __shared__ __attribute__((aligned(16))) unsigned char lds[];
    const int tid = threadIdx.x, lane = tid & 63, wave = __builtin_amdgcn_readfirstlane(tid >> 6);
    const int G = gridDim.x, bx = blockIdx.x; const int vcu = (G % 8 == 0) ? (bx % 8) * (G / 8) + bx / 8 : bx;
    LAS unsigned char* L = (LAS unsigned char*)lds + PH_BASE;
    volatile LAS unsigned* MISC = (volatile LAS unsigned*)((LAS unsigned char*)lds + LDSCTL_OFF + 320);
    unsigned char* ws = args.ws; gu32* ctl = (gu32*)(ws + WS_CTL);
    if (tid < PH_BASE / 4) ((LAS unsigned*)(lds))[tid] = 0u;
    __syncthreads();
    XcdBarrier bar = xcd_barrier_post((unsigned*)(ctl + CW_BAR) + args.li * XCD_BAR_WORDS, MISC + 8);
    const unsigned mask = args.mask;
#define IN(k) ((mask >> (k)) & 1u)
#ifndef PROBE_ATTVAR
#define PROBE_ATTVAR 0
#endif
#ifndef PROBE_EXPVAR
#define PROBE_EXPVAR 0
#endif
#ifndef V_IN_PROJ
#define V_IN_PROJ 1
#endif
#ifndef PROBE_REP
#define PROBE_REP 0u
#endif
#define NREP(k) (1 + (int)((PROBE_REP >> (k)) & 1u))
#define SEAM(k) do { if ((mask & ((1u << PH_N) - 1u)) >> ((k) + 1)) xcd_barrier(bar); } while (0)
    const float* x = args.in[0]; float* out = args.out;
    bf16 *Wt_in = (bf16*)(ws + WS_WIN), *Wt_qup = (bf16*)(ws + WS_WQUP), *Wt_kv = (bf16*)(ws + WS_WKV), *Wt_mix = (bf16*)(ws + WS_WMIX), *Wt_mq = (bf16*)(ws + WS_WMQ), *Wt_mkv = (bf16*)(ws + WS_WMKV),
         *Wt_mo = (bf16*)(ws + WS_WMO), *Wt_pq = (bf16*)(ws + WS_WPQ), *SK = (bf16*)(ws + WS_SK), *MEMN = (bf16*)(ws + WS_MEMN), *MEMKV = (bf16*)(ws + WS_MEMKV), *PU = (bf16*)(ws + WS_PU), *PV = (bf16*)(ws + WS_PV);
    float *partq = (float*)(ws + WS_PARTQ), *partkv = (float*)(ws + WS_PARTKV), *part1 = (float*)(ws + WS_PART1), *part2 = (float*)(ws + WS_PART2), *trig = (float*)(ws + WS_TRIG);
    bf16 *XN = (bf16*)(ws + WS_R1), *CONCAT = XN, *QM = XN, *H2B = XN;
    bf16 *CQ = (bf16*)(ws + WS_R2 + R2_CQ), *CKV = (bf16*)(ws + WS_R2 + R2_CKV), *U = (bf16*)(ws + WS_R2 + R2_U), *H1B = (bf16*)(ws + WS_R2), *OM = (bf16*)(ws + WS_R3);
    bf16 *QB = (bf16*)(ws + WS_R3 + R3_QB), *KB = (bf16*)(ws + WS_R3 + R3_KB), *VB = (bf16*)(ws + WS_R3 + R3_VB), *QP = (bf16*)(ws + WS_R3);


    if (IN(PH_PRO)) {
        for (int rep_ = 0; rep_ < NREP(PH_PRO); ++rep_) { if (rep_) xcd_barrier(bar);
        LAS float* scr = (LAS float*)(L + wave * 16384);
        const int gw = vcu * NWAVES + wave, NGW = G * NWAVES;
        constexpr int I_IN = (D / 64) * (INP / 32), I_QUP = (256 / 64) * (768 / 32), I_KV = (128 / 64) * (1024 / 32), I_SQ = (D / 64) * (D / 32), I_W2 = (D / 64) * (2048 / 32);
        constexpr int NITEMS = I_IN + I_QUP + I_KV + 2 * I_SQ + 2 * I_W2;
        for (int rp_ = 0; rp_ < 1 + (int)((PROBE_REP >> 20) & 1u); ++rp_)
        for (int it = gw; it < NITEMS; it += NGW) {
            int r = it;
            if (r < I_IN) { p0_transpose_item<1, false>(args.in[3], D, INC, Wt_in, INP, nullptr, scr, r, lane); continue; } r -= I_IN;
            if (r < I_QUP) { p0_transpose_item<0, true>(args.in[5], 256, 768, Wt_qup, 768, args.in[4], scr, r, lane); continue; } r -= I_QUP;
            if (r < I_KV) { p0_transpose_item<2, true>(args.in[7], 128, 1024, Wt_kv, 1024, args.in[6], scr, r, lane); continue; } r -= I_KV;
            if (r < I_SQ) { p0_transpose_item<0, false>(args.in[12], D, D, Wt_mix, D, nullptr, scr, r, lane); continue; } r -= I_SQ;
            if (r < I_SQ) { p0_transpose_item<0, false>(args.in[17], D, D, Wt_mo, D, nullptr, scr, r, lane); continue; } r -= I_SQ;
            if (r < I_W2) { p0_transpose_item<0, false>(args.in[16], D, 2048, Wt_mkv, 2048, nullptr, scr, r, lane); continue; } r -= I_W2;
            p0_transpose_item<0, true>(args.in[19], D, 2048, Wt_pq, 2048, args.in[18], scr, r, lane);
        }
        for (int rp_ = 0; rp_ < 1 + (int)((PROBE_REP >> 21) & 1u); ++rp_)
        for (int m = gw; m < M; m += 4 * NGW) rms_rows4_to_bf16(x, args.in[2], XN, m, NGW, M, lane);
        for (int m = gw; m < BATCH * NMEM; m += NGW) rms_row_to_bf16(args.in[1] + (size_t)m * D, args.in[14], MEMN + (size_t)m * D, lane);
        const size_t gtid = (size_t)vcu * NTHR + tid, gn = (size_t)G * NTHR;
        cvt_stream(args.in[20], SK, (size_t)PH * 2 * PNK * PHALF / 8, nullptr, gtid, gn);
        for (size_t i = gtid; i < (size_t)D * D / 8; i += gn) {
            const float4 a = *(const float4*)(args.in[15] + i * 8), b = *(const float4*)(args.in[15] + i * 8 + 4); const float gk = args.in[13][(i * 8) >> 10];
            pg8::u32x4 o; o.x = pg8::cvt_pk_bf16(a.x * gk, a.y * gk); o.y = pg8::cvt_pk_bf16(a.z * gk, a.w * gk); o.z = pg8::cvt_pk_bf16(b.x * gk, b.y * gk); o.w = pg8::cvt_pk_bf16(b.z * gk, b.w * gk);
            *(pg8::u32x4*)(Wt_mq + i * 8) = o; }
        for (int rp_ = 0; rp_ < 1 + (int)((PROBE_REP >> 22) & 1u); ++rp_) {
        cvt_rows_fp6<true>(args.in[21], (unsigned char*)PU, args.in[18], PU_SCALE, gtid, gn);
        if (!V_IN_PROJ) cvt_rows_fp6<false>(args.in[22], (unsigned char*)PV, nullptr, PV_SCALE, gtid, gn); }
        for (size_t i = gtid; i < (size_t)SEQ * 16; i += gn) { float c, s; rope_cs((int)(i >> 4), (int)(i & 15), c, s); *(float2*)(trig + i * 2) = make_float2(c, s); }
        }
        SEAM(PH_PRO);
    }
    if (IN(PH_PROJ)) {
        for (int rep_ = 0; rep_ < NREP(PH_PROJ); ++rep_) { if (rep_) xcd_barrier(bar);
        { pg8::Gemm g{XN, Wt_in, M, INP, D, 0, 0, 0, 0}; pg8::StaticOrder S; S.init(M, INP, G, bx); pg8::EpiProj E{CQ, CKV, KB, U, partq, partkv, trig};
          pg8::gemm_phase<pg8::EpiProj, pg8::StaticOrder, true, true>(L, g, S, E); }
        { pg8::Gemm g{MEMN, Wt_mkv, BATCH * NMEM, 2048, D, 0, 0, 0, 0}; pg8::StaticOrder S; S.init(BATCH * NMEM, 2048, G, (bx + 128) % G); pg8::EpiPlain E{MEMKV, 2048};
          pg8::gemm_phase<pg8::EpiPlain, pg8::StaticOrder, true, true>(L, g, S, E); }
        if (V_IN_PROJ && bx >= 144) { asm volatile("" ::: "memory"); cvt_rows_fp6<false>(args.in[22], (unsigned char*)PV, nullptr, PV_SCALE, (size_t)(bx - 144) * NTHR + threadIdx.x, (size_t)(G - 144) * NTHR); asm volatile("" ::: "memory"); }
        }
        SEAM(PH_PROJ);
    }
    if (IN(PH_UP)) {
        for (int rep_ = 0; rep_ < NREP(PH_UP); ++rep_) { if (rep_) xcd_barrier(bar);
        if (IN(PHB_UPG)) {
        { pg8::Gemm g{CQ, Wt_qup, M, 768, 256, 0, 0, 0, 0}; pg8::StaticOrder S; S.init(M, 768, G, bx); pg8::EpiQ E{QB, partq, trig, LOG2E * 0.10206207261596577f};
          pg8::gemm_phase<pg8::EpiQ, pg8::StaticOrder, true, true>(L, g, S, E); }
        { pg8::Gemm g{CKV, Wt_kv, M, 1024, 128, 0, 0, 0, 0}; pg8::StaticOrder S; S.init(M, 1024, G, (bx + 192) % G); pg8::EpiKV E{KB, VB, partkv};
          pg8::gemm_phase<pg8::EpiKV, pg8::StaticOrder, true, true>(L, g, S, E); }
        }
        if (IN(PHB_CONV)) { __syncthreads(); for (int c = vcu; c < M / 64; c += G) conv_chunk(c, U, args.in[8], args.in[9], args.in[10], args.in[11], CONCAT, L); }
        }
        SEAM(PH_UP);
    }
    if (IN(PH_ATTN)) {
        for (int rep_ = 0; rep_ < NREP(PH_ATTN); ++rep_) { if (rep_) xcd_barrier(bar);
        for (int u = vcu; u < 512; u += G) { const int bh = (u & 255) >> 4, sidx = u & 15, qb = u < 256 ? 31 - sidx : sidx, b = bh >> 3, h = bh & 7;
            const size_t r0 = (size_t)b * SEQ;
            if (NREP(PH_ATTN) > 1 && rep_ == 0) attn_unit<96, 64, 1, 4, 3, true, false, PROBE_ATTVAR>(L, QB + (r0 + qb * 256) * 768 + h * 96, 768, KB + r0 * 768 + h * 96, 768, VB + r0 * 512 + h * 64, 512, CONCAT + (r0 + qb * 256) * D + h * 64, D, 4 * qb + 4, 4 * qb);
            else attn_mla_unit(L, QB + (r0 + qb * 256) * 768 + h * 96, KB + r0 * 768 + h * 96, VB + r0 * 512 + h * 64, CONCAT + (r0 + qb * 256) * D + h * 64, 4 * qb + 4, 4 * qb); }
        }
        { bf16* KQT = (bf16*)(ws + WS_KQT); bf16* VOT = (bf16*)(ws + WS_VOT);
#pragma unroll 1
          for (int bh = 0; bh < BATCH * XH; ++bh) { const int b = bh >> 2, h = bh & 3;
            { pg8::Gemm g{MEMKV + (size_t)b * NMEM * 2048 + h * XD, Wt_mq + h * XD, NMEM, D, XD, 2048, D, 0, 0}; pg8::StaticOrder S; S.init(NMEM, D, G, (bx + 8 * bh) % G);
              pg8::EpiPlain E{KQT + (size_t)b * D * D + (size_t)h * XD * D, D}; pg8::gemm_phase<pg8::EpiPlain, pg8::StaticOrder, true, true>(L, g, S, E); }
            { pg8::Gemm g{Wt_mo + h * XD, MEMKV + (size_t)b * NMEM * 2048 + 1024 + h * XD, D, NMEM, XD, D, 2048, 0, 0}; pg8::StaticOrder S; S.init(D, NMEM, G, (bx + 8 * bh + 4) % G);
              pg8::EpiPlain E{VOT + (size_t)b * D * D + h * XD, D}; pg8::gemm_phase<pg8::EpiPlain, pg8::StaticOrder, true, true>(L, g, S, E); } } }
        SEAM(PH_ATTN);
    }
    if (IN(PH_MIX)) {
        for (int rep_ = 0; rep_ < NREP(PH_MIX); ++rep_) { if (rep_) xcd_barrier(bar);
        pg8::Gemm g{CONCAT, Wt_mix, M, D, D, 0, 0, 0, 0}; pg8::StaticOrder S; S.init(M, D, G, bx); pg8::EpiRes<false> E{x, nullptr, H1B, part1};
        pg8::gemm_phase<pg8::EpiRes<false>, pg8::StaticOrder, true, true>(L, g, S, E);
        }
        SEAM(PH_MIX);
    }
    if (IN(PH_MEMQ)) {
        for (int rep_ = 0; rep_ < NREP(PH_MEMQ); ++rep_) { if (rep_) xcd_barrier(bar);
        pg8::Gemm g{H1B, (const bf16*)(ws + WS_KQT), M, D, D, 0, 0, SEQ / 256, (size_t)D * D * 2}; pg8::StaticOrder S; S.init(M, D, G, bx);
        pg8::EpiSoftmaxP E{OM, D, part1, LOG2E / 16.0f, (LAS float*)(L + 131072)};
        pg8::gemm_phase<pg8::EpiSoftmaxP, pg8::StaticOrder, true, true>(L, g, S, E);
        }
        SEAM(PH_MEMQ);
    }
    if (IN(PH_MEMO)) {
        pg8::Gemm g{OM, (const bf16*)(ws + WS_VOT), M, D, D, 0, 0, SEQ / 256, (size_t)D * D * 2};   pg8::StaticOrder S; S.init(M, D, G, bx); pg8::EpiRes<true> E{nullptr, H1B, H2B, part2};
        pg8::gemm_phase<pg8::EpiRes<true>, pg8::StaticOrder, true, true>(L, g, S, E);
        SEAM(PH_MEMO);
    }
    if (IN(PH_PQ)) {
        for (int rep_ = 0; rep_ < NREP(PH_PQ); ++rep_) { if (rep_) xcd_barrier(bar);
        pg8::Gemm g{H2B, Wt_pq, M, 2048, D, 0, 0, 0, 0}; pg8::StaticOrder S; S.init(M, 2048, G, bx); pg8::EpiScaled E{QP, 2048, part2, 1.0f};
        pg8::gemm_phase<pg8::EpiScaled, pg8::StaticOrder, true, true>(L, g, S, E);
        own_writes_visible();
        int* EIDX = (int*)(ws + WS_R2 + R2_EIDX); float* EGATE = (float*)(ws + WS_R2 + R2_EGATE);
        LAS unsigned* scr = (LAS unsigned*)(L + 65536 + wave * 64 * 9 * 4);
        int hl = -1, upm, upn;
        for (int i = 0; unit_of(M, 2048, G, bx, i, upm, upn); ++i) { const int tb = upm, h = upn;
            if (h != hl) {
                __syncthreads();
                for (int pc = tid; pc < 4096; pc += NTHR) { const int p = pc >> 11, n = (pc >> 4) & 127, c = pc & 15;
                    *(LAS pg8::u32x4*)(L + p * 32768 + c * 2048 + n * 16) = *(const pg8::u32x4*)(SK + ((size_t)(h * 2 + p) * 128 + n) * 128 + c * 8); }
                __syncthreads(); hl = h; }
            const int token = tb * 256 + wave * 32 + (lane & 31);
            topk_wave(QP + (size_t)token * 2048 + h * 256, L, scr, EIDX + (size_t)token * 128 + h * 16, EGATE + (size_t)token * 128 + h * 16, lane); }
        __syncthreads();
        }
        SEAM(PH_PQ);
    }
    if (IN(PH_EXP)) {
        const int* EIDX = (const int*)(ws + WS_R2 + R2_EIDX); const float* EGATE = (const float*)(ws + WS_R2 + R2_EGATE);
#ifndef EXP_PREWARM
#define EXP_PREWARM 0
#endif
        if (EXP_PREWARM) {
            const pg8::u32x4* tb = (const pg8::u32x4*)PU; pg8::u32x4 x = {0u, 0u, 0u, 0u};
            for (size_t i = (size_t)vcu * NTHR + tid; i < (size_t)2 * PE * D / 16; i += (size_t)G * NTHR) { const pg8::u32x4 v = __builtin_nontemporal_load(tb + i); x ^= v; }
            if ((x[0] ^ x[1] ^ x[2] ^ x[3]) == 0x9e3779b9u && tid == 999) out[0] = 0.f;
        }
        for (int rep_ = NREP(PH_EXP) - 1; rep_ >= 0; --rep_) { float* dst = rep_ ? (float*)(ws + WS_R3) : out;
            if (rep_) { if (PROBE_EXPVAR != 5 || wave < 4) experts_wave<PROBE_EXPVAR == 5 ? 0 : PROBE_EXPVAR>(L + wave * EXP_LDS_WAVE, vcu * NWAVES + wave, G * NWAVES, H2B, part2, (const unsigned char*)PU, (const unsigned char*)PV, EIDX, EGATE, args.in[23], dst, lane); } else
            experts_wave<0>(L + wave * EXP_LDS_WAVE, vcu * NWAVES + wave, G * NWAVES, H2B, part2, (const unsigned char*)PU, (const unsigned char*)PV, EIDX, EGATE, args.in[23], dst, lane);
            if (rep_) xcd_barrier(bar); }
    }
#undef IN
#undef SEAM
}

#define FAST_MASK ((1u << PH_PRO) | (1u << PH_PROJ) | (1u << PH_UP) | (1u << PHB_UPG) | (1u << PHB_CONV) | (1u << PH_ATTN) | (1u << PH_MIX) | (1u << PH_MEMQ) | (1u << PH_MEMO) | (1u << PH_PQ) | (1u << PH_EXP))
extern "C" void kernel_launch(void* const* d_in, const int* in_sizes, int n_in, void* d_out, int out_size, void* d_ws, size_t ws_size, hipStream_t stream) {
    if (n_in != 24 || out_size != M * D || ws_size < WS_END) { fprintf(stderr, "kernel_launch: unexpected problem (n_in %d out %d ws %zu)\n", n_in, out_size, ws_size); return; }
    static int grid = 0;
    if (grid == 0) {
        int dev = 0, cus = 0, per_cu = 0;
        if (hipGetDevice(&dev) != hipSuccess || hipDeviceGetAttribute(&cus, hipDeviceAttributeMultiprocessorCount, dev) != hipSuccess) { grid = -1; return; }
        if (hipFuncSetAttribute((const void*)mega, hipFuncAttributeMaxDynamicSharedMemorySize, LDS_BYTES) != hipSuccess) { fprintf(stderr, "kernel_launch: hipFuncSetAttribute failed\n"); grid = -1; return; }
        if (hipOccupancyMaxActiveBlocksPerMultiprocessor(&per_cu, (const void*)mega, NTHR, LDS_BYTES) != hipSuccess || per_cu < 1) { fprintf(stderr, "kernel_launch: occupancy query says %d blocks per CU\n", per_cu); grid = -1; (void)hipGetLastError(); return; }
        grid = cus;
    }
    if (grid < 0) return;
    (void)hipMemsetAsync((char*)d_ws + WS_CTL, 0, CTL_ZERO_BYTES, stream);
    Args a{}; for (int i = 0; i < 24; ++i) a.in[i] = (const float*)d_in[i]; a.out = (float*)d_out; a.ws = (unsigned char*)d_ws; a.mask = FAST_MASK; a.li = 0;
    hipLaunchKernelGGL(mega, dim3(grid), dim3(NTHR), LDS_BYTES, stream, a);
}
```

```cpp
#include <hip/hip_runtime.h>
#include <cstdio>
#include <cstdint>

typedef unsigned short bf16;
#define DEVI __device__ __forceinline__

constexpr int D = 1024, BATCH = 2, SEQ = 8192, M = BATCH * SEQ;
constexpr int NMEM = 256;
constexpr int MH = 8, QRANK = 256, KVRANK = 128, NOPE = 64, ROPE = 32, VD = 64, QK = NOPE + ROPE;
constexpr int CW = 512, CK = 31;
constexpr int INC = QRANK + KVRANK + ROPE + 2 * CW;
constexpr int INP = 1536;
constexpr int XH = 4, XD = 256;
constexpr int PH = 8, PNK = 128, PHALF = 128, PTOP = 16, PE = PNK * PNK;
constexpr float EPS = 1e-6f;
constexpr float LOG2E = 1.4426950408889634f;
constexpr float PU_SCALE = 64.0f, PV_SCALE = 4.0f;

constexpr size_t MiB = 1u << 20;
constexpr size_t WS_CTL = 0;
constexpr size_t WS_WIN = 1 * MiB;
constexpr size_t WS_WQUP = 4 * MiB;
constexpr size_t WS_WKV = 5 * MiB;
constexpr size_t WS_WMIX = 6 * MiB;
constexpr size_t WS_WMQ = 8 * MiB;
constexpr size_t WS_WMKV = 10 * MiB;
constexpr size_t WS_WMO = 14 * MiB;
constexpr size_t WS_WPQ = 16 * MiB;
constexpr size_t WS_SK = 20 * MiB;
constexpr size_t WS_MEMN = 21 * MiB;
constexpr size_t WS_MEMKV = 22 * MiB;
constexpr size_t WS_PARTQ = 24 * MiB;
constexpr size_t WS_PARTKV = 24 * MiB + 512 * 1024;
constexpr size_t WS_PART1 = 25 * MiB;
constexpr size_t WS_PART2 = 26 * MiB;
constexpr size_t WS_PU = 28 * MiB;
constexpr size_t WS_PV = 60 * MiB;
constexpr size_t WS_R1 = 92 * MiB;
constexpr size_t WS_R2 = 124 * MiB;
constexpr size_t WS_R3 = 156 * MiB;
constexpr size_t WS_KQT = 220 * MiB;
constexpr size_t WS_VOT = 224 * MiB;
constexpr size_t WS_KR = 228 * MiB;
constexpr size_t WS_END = 229 * MiB;
constexpr size_t R2_CQ = 0, R2_CKV = 8 * MiB, R2_U = 12 * MiB;
constexpr size_t R2_EIDX = 0, R2_EGATE = 8 * MiB;
constexpr size_t R3_QB = 0, R3_KB = 24 * MiB, R3_VB = 48 * MiB;

DEVI bf16 f2bf(float f) { unsigned u = __builtin_bit_cast(unsigned, f); return (bf16)((u + 0x7fffu + ((u >> 16) & 1u)) >> 16); }
DEVI float bf2f(bf16 b) { return __builtin_bit_cast(float, (unsigned)b << 16); }
DEVI float dotbf(const bf16* a, const bf16* b, int K) {
    float s = 0.f;
    for (int k = 0; k < K; k += 8) {
        uint4 x = *(const uint4*)(a + k), y = *(const uint4*)(b + k);
        const unsigned xs[4] = {x.x, x.y, x.z, x.w}, ys[4] = {y.x, y.y, y.z, y.w};
#pragma unroll
        for (int i = 0; i < 4; ++i) {
            s += __builtin_bit_cast(float, xs[i] << 16) * __builtin_bit_cast(float, ys[i] << 16);
            s += __builtin_bit_cast(float, xs[i] & 0xffff0000u) * __builtin_bit_cast(float, ys[i] & 0xffff0000u);
        }
    }
    return s;
}
#define DPPX_(x, CTRL) __builtin_bit_cast(float, __builtin_amdgcn_update_dpp(0, __builtin_bit_cast(int, (float)(x)), (CTRL), 0xF, 0xF, true))
DEVI float x16_sum(float v) { const unsigned b = __builtin_bit_cast(unsigned, v); const auto s = __builtin_amdgcn_permlane16_swap(b, b, false, false); return __builtin_bit_cast(float, (unsigned)s[0]) + __builtin_bit_cast(float, (unsigned)s[1]); }
DEVI float x32_sum(float v) { const unsigned b = __builtin_bit_cast(unsigned, v); const auto s = __builtin_amdgcn_permlane32_swap(b, b, false, false); return __builtin_bit_cast(float, (unsigned)s[0]) + __builtin_bit_cast(float, (unsigned)s[1]); }
DEVI float x16_max(float v) { const unsigned b = __builtin_bit_cast(unsigned, v); const auto s = __builtin_amdgcn_permlane16_swap(b, b, false, false); return fmaxf(__builtin_bit_cast(float, (unsigned)s[0]), __builtin_bit_cast(float, (unsigned)s[1])); }
DEVI float x32_max(float v) { const unsigned b = __builtin_bit_cast(unsigned, v); const auto s = __builtin_amdgcn_permlane32_swap(b, b, false, false); return fmaxf(__builtin_bit_cast(float, (unsigned)s[0]), __builtin_bit_cast(float, (unsigned)s[1])); }
DEVI unsigned x32_get(unsigned v, int lane) { const auto s = __builtin_amdgcn_permlane32_swap(v, v, false, false); return (lane & 32) ? (unsigned)s[0] : (unsigned)s[1]; }
DEVI float row16_sum(float v) { v += DPPX_(v, 0xB1); v += DPPX_(v, 0x4E); v += DPPX_(v, 0x141); v += DPPX_(v, 0x128); return v; }
DEVI float row16_max(float v) { v = fmaxf(v, DPPX_(v, 0xB1)); v = fmaxf(v, DPPX_(v, 0x4E)); v = fmaxf(v, DPPX_(v, 0x141)); v = fmaxf(v, DPPX_(v, 0x128)); return v; }
DEVI float wave_sum(float v) { return x32_sum(x16_sum(row16_sum(v))); }
DEVI float wave_max(float v) { return x32_max(x16_max(row16_max(v))); }
DEVI void rope_cs(int pos, int i, float& c, float& s) {
    const float inv = exp2f(-(float)i * (13.287712379549449f / 16.0f));
    const float ang = (float)pos * inv;
    const double a = (double)ang; const double k = rint(a * 0.15915494309189535); const float r = (float)(a - k * 6.283185307179586);
    s = sinf(r); c = cosf(r);
}
DEVI int win_src(int r) {
    if (r < 416) return r;
    if (r < 512) return -1;
    const int t = (r - 512) >> 8, w = (r - 512) & 255, bj = w >> 7, j = w & 127, ch = 128 * t + j;
    return 416 + (bj ? CW : 0) + ch;
}
DEVI int wkv_src(int r) { return r < 512 ? (r >> 6) * 128 + (r & 63) : ((r - 512) >> 6) * 128 + 64 + ((r - 512) & 63); }

namespace pg8 {
#define PG8_LAS __attribute__((address_space(3)))
typedef unsigned short bf16_t;
typedef short bf16x8 __attribute__((ext_vector_type(8)));
typedef float f32x4 __attribute__((ext_vector_type(4)));
typedef unsigned u32x4 __attribute__((ext_vector_type(4)));
constexpr int BM = 256, BK = 64, HALF = 128, HTB = HALF * BK * 2  , STAGE_BYTES = 8 * HTB, NXCD = 8, WGM = 8;

__host__ __device__ __forceinline__ int lds_byte(int r, int c) { const int st = (r >> 4) * 2 + (c >> 5), rr = r & 15, cc = c & 31, ob = rr * 64 + cc * 2; return st * 1024 + (ob ^ (((ob >> 9) & 1) << 5)); }
__host__ __device__ __forceinline__ void stage_rc(int b, int& R, int& C) { const int st = b / 1024, sb = b % 1024, swz = sb ^ (((sb >> 9) & 1) << 5); R = (st >> 1) * 16 + swz / 64; C = (st & 1) * 32 + (swz % 64) / 2; }
__host__ __device__ __forceinline__ int perm32(int rho) { const int n = rho >> 4, i = rho & 15; return 8 * (i >> 2) + 4 * n + (i & 3); }

struct Unit { int pm, pn; };
struct Gemm { const bf16_t* A; const bf16_t* Bt; int M, N, K; int lda, ldb; int mb; size_t bstride; };

struct StaticOrder {
    int nM, nN, nwg, G, c;
    __host__ __device__ void init(int M, int N, int G_, int c_) { nM = M / BM; nN = N / BM; nwg = nM * nN; G = G_; c = c_; }
    __host__ __device__ bool next(int i, Unit& u) const {
        const long L = (long)i * G + c; if (L >= nwg) return false;
        int wgid = (int)L; { const int q = nwg / NXCD, r = nwg % NXCD, xcd = wgid % NXCD, off = wgid / NXCD; wgid = (xcd < r ? xcd * (q + 1) : r * (q + 1) + (xcd - r) * q) + off; }
        const int nig = WGM * nN, gid = wgid / nig, fm = gid * WGM, gsz = (nM - fm) < WGM ? (nM - fm) : WGM;
        u.pm = fm + ((wgid % nig) % gsz); u.pn = (wgid % nig) / gsz; return true;
    }
    __device__ __forceinline__ void a_ready(const Unit&) const {}
    __device__ __forceinline__ void done(const Unit&) const {}
};


typedef float f32x2 __attribute__((ext_vector_type(2)));
typedef unsigned u32x2 __attribute__((ext_vector_type(2)));
__device__ __forceinline__ unsigned cvt_pk_bf16(float lo, float hi) { unsigned r; asm volatile("v_cvt_pk_bf16_f32 %0, %1, %2" : "=v"(r) : "v"(lo), "v"(hi)); return r; }
__device__ __forceinline__ void st_bf4(bf16_t* p, f32x4 v) { u32x2 w; w.x = cvt_pk_bf16(v[0], v[1]); w.y = cvt_pk_bf16(v[2], v[3]); *(u32x2*)p = w; }
typedef __bf16 pbf2_t __attribute__((ext_vector_type(2)));
__device__ __forceinline__ unsigned cvt2(float lo, float hi) { const f32x2 v = {lo, hi}; return __builtin_bit_cast(unsigned, __builtin_convertvector(v, pbf2_t)); }
__device__ __forceinline__ void st_bf4_pair(bf16_t* p0, f32x4 v0, f32x4 v1) {
    const auto r0 = __builtin_amdgcn_permlane16_swap(cvt2(v0[0], v0[1]), cvt2(v1[0], v1[1]), false, false), r1 = __builtin_amdgcn_permlane16_swap(cvt2(v0[2], v0[3]), cvt2(v1[2], v1[3]), false, false);
    const u32x4 w = {r0[0], r1[0], r0[1], r1[1]};
    *(u32x4*)((char*)p0 + ((threadIdx.x & 16) ? 24 : 0)) = w;
}
__device__ __forceinline__ float sq4(f32x4 v) { return (v[0] * v[0] + v[1] * v[1]) + (v[2] * v[2] + v[3] * v[3]); }
__device__ __forceinline__ float red_fq(float s) { return x32_sum(x16_sum(s)); }

struct EpiProj {
    static constexpr bool PERM = false, AFTER_DRAIN = false;
    bf16_t *CQ, *CKV, *KB, *U; float *partq, *partkv; const float* trig;
    __device__ __forceinline__ void operator()(const f32x4 (&acc)[2][2][4][2], const Unit& u, int wr, int wc, int fr, int fq) const {
        const int row0 = u.pm * BM + wr * 64 + fr;
        if (u.pn == 0) {
#pragma unroll
            for (int ai = 0; ai < 2; ++ai)
#pragma unroll
                for (int m = 0; m < 4; ++m) { const int row = row0 + ai * HALF + m * 16; float s = 0.f;
#pragma unroll
                    for (int bj = 0; bj < 2; ++bj)
                        { const f32x4 v0 = acc[ai][bj][m][0], v1 = acc[ai][bj][m][1]; s += sq4(v0) + sq4(v1); st_bf4_pair(CQ + (size_t)row * 256 + bj * HALF + wc * 32 + fq * 4, v0, v1); }
                    s = red_fq(s); if (fq == 0) partq[(size_t)row * 4 + wc] = s; }
        } else if (u.pn == 1) {
            f32x4 tc0 = {0.f, 0.f, 0.f, 0.f}, tc1 = tc0, tn0 = tc0, tn1 = tc0;
            if (wc == 0) { const float* tp = trig + ((size_t)(row0 % SEQ) * 16 + fq * 4) * 2; tc0 = *(const f32x4*)tp; tc1 = *(const f32x4*)(tp + 4); }
#pragma unroll
            for (int i8 = 0; i8 < 8; ++i8) { const int ai = i8 >> 2, m = i8 & 3; const int row = row0 + ai * HALF + m * 16; float s = 0.f;
                if (wc == 0 && i8 < 7) { const int rown = row0 + ((i8 + 1) >> 2) * HALF + ((i8 + 1) & 3) * 16; const float* tp = trig + ((size_t)(rown % SEQ) * 16 + fq * 4) * 2; tn0 = *(const f32x4*)tp; tn1 = *(const f32x4*)(tp + 4); }
                { const f32x4 v0 = acc[ai][0][m][0], v1 = acc[ai][0][m][1]; s += sq4(v0) + sq4(v1); st_bf4_pair(CKV + (size_t)row * 128 + wc * 32 + fq * 4, v0, v1); }
                s = red_fq(s); if (fq == 0) partkv[(size_t)row * 4 + wc] = s;
                if (wc == 0) { const f32x4 x1 = acc[ai][1][m][0], x2 = acc[ai][1][m][1]; const f32x4 t0 = tc0, t1 = tc1;
                    f32x4 o1, o2; o1[0] = x1[0] * t0[0] - x2[0] * t0[1]; o2[0] = x1[0] * t0[1] + x2[0] * t0[0]; o1[1] = x1[1] * t0[2] - x2[1] * t0[3]; o2[1] = x1[1] * t0[3] + x2[1] * t0[2];
                    o1[2] = x1[2] * t1[0] - x2[2] * t1[1]; o2[2] = x1[2] * t1[1] + x2[2] * t1[0]; o1[3] = x1[3] * t1[2] - x2[3] * t1[3]; o2[3] = x1[3] * t1[3] + x2[3] * t1[2];
                    st_bf4_pair(KB + (size_t)row * 32 + fq * 4, o1, o2); }
                tc0 = tn0; tc1 = tn1; asm volatile("" ::: "memory"); }
        } else {
            const int t = u.pn - 2;
#pragma unroll
            for (int ai = 0; ai < 2; ++ai)
#pragma unroll
                for (int m = 0; m < 4; ++m) { const int row = row0 + ai * HALF + m * 16; f32x4 og[2];
#pragma unroll
                    for (int n = 0; n < 2; ++n) { const f32x4 val = acc[ai][0][m][n], gate = acc[ai][1][m][n];
#pragma unroll
                        for (int i = 0; i < 4; ++i) og[n][i] = val[i] * __builtin_amdgcn_rcpf(1.f + __expf(-gate[i])); }
                    st_bf4_pair(U + (size_t)row * 512 + t * 128 + wc * 32 + fq * 4, og[0], og[1]); }
        }
    }
};
struct EpiQ {
    static constexpr bool PERM = false, AFTER_DRAIN = false;
    bf16_t* QB; const float* partq; const float* trig; float c2;
    __device__ __forceinline__ void operator()(const f32x4 (&acc)[2][2][4][2], const Unit& u, int wr, int wc, int fr, int fq) const {
        const int row0 = u.pm * BM + wr * 64 + fr;
        const bool rope = ((u.pn * 8 + wc) % 3 == 2) || ((u.pn * 8 + 4 + wc) % 3 == 2);
        f32x4 ppc = *(const f32x4*)(partq + (size_t)row0 * 4), ppn = ppc;
        f32x4 tc0 = {0.f, 0.f, 0.f, 0.f}, tc1 = tc0, tn0 = tc0, tn1 = tc0;
        if (rope) { const float* tp = trig + ((size_t)(row0 % SEQ) * 16 + fq * 4) * 2; tc0 = *(const f32x4*)tp; tc1 = *(const f32x4*)(tp + 4); }
#pragma unroll
        for (int i8 = 0; i8 < 8; ++i8) { const int ai = i8 >> 2, m = i8 & 3; const int row = row0 + ai * HALF + m * 16;
            if (i8 < 7) { const int rown = row0 + ((i8 + 1) >> 2) * HALF + ((i8 + 1) & 3) * 16; ppn = *(const f32x4*)(partq + (size_t)rown * 4);
                if (rope) { const float* tp = trig + ((size_t)(rown % SEQ) * 16 + fq * 4) * 2; tn0 = *(const f32x4*)tp; tn1 = *(const f32x4*)(tp + 4); } }
            const float rs = rsqrtf(((ppc[0] + ppc[1]) + (ppc[2] + ppc[3])) * (1.f / 256.f) + EPS) * c2;
#pragma unroll
            for (int bj = 0; bj < 2; ++bj) { const int g = u.pn * 8 + bj * 4 + wc; bf16_t* dst = QB + (size_t)row * 768 + g * 32 + fq * 4;
                if (g % 3 != 2) st_bf4_pair(dst, acc[ai][bj][m][0] * rs, acc[ai][bj][m][1] * rs);
                else { const f32x4 x1 = acc[ai][bj][m][0] * rs, x2 = acc[ai][bj][m][1] * rs; const f32x4 t0 = tc0, t1 = tc1;
                    f32x4 o1, o2; o1[0] = x1[0] * t0[0] - x2[0] * t0[1]; o2[0] = x1[0] * t0[1] + x2[0] * t0[0]; o1[1] = x1[1] * t0[2] - x2[1] * t0[3]; o2[1] = x1[1] * t0[3] + x2[1] * t0[2];
                    o1[2] = x1[2] * t1[0] - x2[2] * t1[1]; o2[2] = x1[2] * t1[1] + x2[2] * t1[0]; o1[3] = x1[3] * t1[2] - x2[3] * t1[3]; o2[3] = x1[3] * t1[3] + x2[3] * t1[2];
                    st_bf4_pair(dst, o1, o2); } }
            ppc = ppn; tc0 = tn0; tc1 = tn1; asm volatile("" ::: "memory"); }
    }
};
struct EpiKV {
    static constexpr bool PERM = false, AFTER_DRAIN = false;
    bf16_t *KB, *VB; const float* partkv;
    __device__ __forceinline__ void operator()(const f32x4 (&acc)[2][2][4][2], const Unit& u, int wr, int wc, int fr, int fq) const {
        const int row0 = u.pm * BM + wr * 64 + fr;
        f32x4 ppc = *(const f32x4*)(partkv + (size_t)row0 * 4), ppn = ppc;
#pragma unroll
        for (int i8 = 0; i8 < 8; ++i8) { const int ai = i8 >> 2, m = i8 & 3; const int row = row0 + ai * HALF + m * 16;
            if (i8 < 7) { const int rown = row0 + ((i8 + 1) >> 2) * HALF + ((i8 + 1) & 3) * 16; ppn = *(const f32x4*)(partkv + (size_t)rown * 4); }
            const float rs = rsqrtf(((ppc[0] + ppc[1]) + (ppc[2] + ppc[3])) * (1.f / 128.f) + EPS);
#pragma unroll
            for (int bj = 0; bj < 2; ++bj)
                { const int c = u.pn * BM + bj * HALF + wc * 32 + fq * 4; const f32x4 v0 = acc[ai][bj][m][0] * rs, v1 = acc[ai][bj][m][1] * rs;
                    if (u.pn < 2) st_bf4_pair(KB + (size_t)row * 768 + (c >> 6) * 96 + (c & 63), v0, v1); else st_bf4_pair(VB + (size_t)row * 512 + (c - 512), v0, v1); }
            ppc = ppn; asm volatile("" ::: "memory"); }
    }
};
template <bool BF16RES> struct EpiRes {
    static constexpr bool PERM = false, AFTER_DRAIN = false;
    const float* res; const bf16_t* resb; bf16_t* outb; float* part;
    __device__ __forceinline__ f32x4 ldres(size_t off) const {
        if (BF16RES) { const u32x2 rb = *(const u32x2*)(resb + off); f32x4 r; r[0] = __builtin_bit_cast(float, rb.x << 16); r[1] = __builtin_bit_cast(float, rb.x & 0xffff0000u); r[2] = __builtin_bit_cast(float, rb.y << 16); r[3] = __builtin_bit_cast(float, rb.y & 0xffff0000u); return r; }
        return *(const f32x4*)(res + off); }
    __device__ __forceinline__ void operator()(const f32x4 (&acc)[2][2][4][2], const Unit& u, int wr, int wc, int fr, int fq) const {
        const int row0 = u.pm * BM + wr * 64 + fr; const int cb = u.pn * BM + wc * 32 + fq * 4;
        f32x4 rc[4], rn[4];
#pragma unroll
        for (int j = 0; j < 4; ++j) { rc[j] = ldres((size_t)row0 * 1024 + cb + (j >> 1) * HALF + (j & 1) * 16); rn[j] = rc[j]; }
#pragma unroll
        for (int i8 = 0; i8 < 8; ++i8) { const int ai = i8 >> 2, m = i8 & 3; const int row = row0 + ai * HALF + m * 16; float s = 0.f;
            if (i8 < 7) { const int rown = row0 + ((i8 + 1) >> 2) * HALF + ((i8 + 1) & 3) * 16;
#pragma unroll
                for (int j = 0; j < 4; ++j) rn[j] = ldres((size_t)rown * 1024 + cb + (j >> 1) * HALF + (j & 1) * 16); }
#pragma unroll
            for (int bj = 0; bj < 2; ++bj)
                { const size_t off = (size_t)row * 1024 + cb + bj * HALF;
                    const f32x4 v0 = acc[ai][bj][m][0] + rc[bj * 2], v1 = acc[ai][bj][m][1] + rc[bj * 2 + 1]; st_bf4_pair(outb + off, v0, v1); s += sq4(v0) + sq4(v1); }
            s = red_fq(s); if (fq == 0) part[(size_t)row * 16 + u.pn * 4 + wc] = s;
#pragma unroll
            for (int j = 0; j < 4; ++j) rc[j] = rn[j];
            asm volatile("" ::: "memory"); }
    }
};
struct EpiScaled {
    static constexpr bool PERM = false, AFTER_DRAIN = false;
    bf16_t* out; int ldc; const float* part; float mul;
    __device__ __forceinline__ void operator()(const f32x4 (&acc)[2][2][4][2], const Unit& u, int wr, int wc, int fr, int fq) const {
        const int row0 = u.pm * BM + wr * 64 + fr;
        float rs8[8];
#pragma unroll
        for (int hb = 0; hb < 2; ++hb) { f32x4 q[4][4];
#pragma unroll
            for (int k = 0; k < 4; ++k) { const int row = row0 + hb * HALF + k * 16; const f32x4* pp = (const f32x4*)(part + (size_t)row * 16);
#pragma unroll
                for (int j = 0; j < 4; ++j) q[k][j] = pp[j]; }
#pragma unroll
            for (int k = 0; k < 4; ++k) { const f32x4 a = q[k][0], b = q[k][1], c = q[k][2], d = q[k][3];
                const float ss = (((a[0] + a[1]) + (a[2] + a[3])) + ((b[0] + b[1]) + (b[2] + b[3]))) + (((c[0] + c[1]) + (c[2] + c[3])) + ((d[0] + d[1]) + (d[2] + d[3])));
                rs8[hb * 4 + k] = rsqrtf(ss * (1.f / 1024.f) + EPS) * mul; } }
#pragma unroll
        for (int i8 = 0; i8 < 8; ++i8) { const int ai = i8 >> 2, m = i8 & 3; const int row = row0 + ai * HALF + m * 16; const float rs = rs8[i8];
#pragma unroll
            for (int bj = 0; bj < 2; ++bj)
                st_bf4_pair(out + (size_t)row * ldc + u.pn * BM + bj * HALF + wc * 32 + fq * 4, acc[ai][bj][m][0] * rs, acc[ai][bj][m][1] * rs);
            asm volatile("" ::: "memory"); }
    }
};
struct EpiSoftmaxP {
    static constexpr bool PERM = false, AFTER_DRAIN = false;
    bf16_t* out; int ldc; const float* part; float mul; PG8_LAS float* scr;
    __device__ __forceinline__ float rscale(int row) const { const f32x4* pp = (const f32x4*)(part + (size_t)row * 16); const f32x4 a = pp[0], b = pp[1], c = pp[2], d = pp[3];
        const float ss = (((a[0] + a[1]) + (a[2] + a[3])) + ((b[0] + b[1]) + (b[2] + b[3]))) + (((c[0] + c[1]) + (c[2] + c[3])) + ((d[0] + d[1]) + (d[2] + d[3]))); return rsqrtf(ss * (1.f / 1024.f) + EPS) * mul; }
    __device__ __forceinline__ void operator()(const f32x4 (&acc)[2][2][4][2], const Unit& u, int wr, int wc, int fr, int fq) const {
        PG8_LAS float* P1 = scr; PG8_LAS float* P2 = scr + 1024;
#define EPS_BAR() do { asm volatile("s_waitcnt lgkmcnt(0)" ::: "memory"); __builtin_amdgcn_s_barrier(); asm volatile("" ::: "memory"); } while (0)
#pragma unroll
        for (int ai = 0; ai < 2; ++ai)
#pragma unroll
            for (int m = 0; m < 4; ++m) { float mx = -3.0e38f;
#pragma unroll
                for (int bj = 0; bj < 2; ++bj)
#pragma unroll
                    for (int n = 0; n < 2; ++n) { const f32x4 v = acc[ai][bj][m][n]; mx = fmaxf(mx, fmaxf(fmaxf(v[0], v[1]), fmaxf(v[2], v[3]))); }
                mx = x32_max(x16_max(mx));
                if (fq == 0) P1[(ai * HALF + wr * 64 + m * 16 + fr) * 4 + wc] = mx; }
        EPS_BAR();
#pragma unroll
        for (int ai = 0; ai < 2; ++ai)
#pragma unroll
            for (int m = 0; m < 4; ++m) { const int rl = ai * HALF + wr * 64 + m * 16 + fr; const f32x4 q = *(const PG8_LAS f32x4*)(P1 + rl * 4);
                const float mx = fmaxf(fmaxf(q[0], q[1]), fmaxf(q[2], q[3])), rs = rscale(u.pm * BM + rl); float sm = 0.f;
#pragma unroll
                for (int bj = 0; bj < 2; ++bj)
#pragma unroll
                    for (int n = 0; n < 2; ++n) { f32x4& v = const_cast<f32x4&>(acc[ai][bj][m][n]);
#pragma unroll
                        for (int i = 0; i < 4; ++i) { v[i] = __builtin_amdgcn_exp2f((v[i] - mx) * rs); sm += v[i]; } }
                sm = x32_sum(x16_sum(sm));
                if (fq == 0) P2[rl * 4 + wc] = sm; asm volatile("" ::: "memory"); }
        EPS_BAR();
#pragma unroll
        for (int ai = 0; ai < 2; ++ai)
#pragma unroll
            for (int m = 0; m < 4; ++m) { const int rl = ai * HALF + wr * 64 + m * 16 + fr; const f32x4 w = *(const PG8_LAS f32x4*)(P2 + rl * 4);
                const float inv = 1.0f / ((w[0] + w[1]) + (w[2] + w[3]));
#pragma unroll
                for (int bj = 0; bj < 2; ++bj)
                    st_bf4_pair(out + (size_t)(u.pm * BM + rl) * ldc + u.pn * BM + bj * HALF + wc * 32 + fq * 4, acc[ai][bj][m][0] * inv, acc[ai][bj][m][1] * inv);
                asm volatile("" ::: "memory"); }
        EPS_BAR();
#undef EPS_BAR
    }
};
struct EpiPlain {
    static constexpr bool PERM = false, AFTER_DRAIN = false;
    bf16_t* out; int ldc;
    __device__ __forceinline__ void operator()(const f32x4 (&acc)[2][2][4][2], const Unit& u, int wr, int wc, int fr, int fq) const {
        const int row0 = u.pm * BM + wr * 64 + fr;
#pragma unroll
        for (int ai = 0; ai < 2; ++ai)
#pragma unroll
            for (int m = 0; m < 4; ++m) { const int row = row0 + ai * HALF + m * 16;
#pragma unroll
                for (int bj = 0; bj < 2; ++bj)
                    st_bf4_pair(out + (size_t)row * ldc + u.pn * BM + bj * HALF + wc * 32 + fq * 4, acc[ai][bj][m][0], acc[ai][bj][m][1]); }
    }
};
template <class Epi, class Sched, bool ALIGN_EPI = false, bool SP2 = false>
__device__ __forceinline__ void gemm_phase(PG8_LAS unsigned char* lds, const Gemm g, const Sched& S, const Epi& E) {
    int tid_ = threadIdx.x; asm volatile("" : "+v"(tid_));
    const int tid = tid_, wid = __builtin_amdgcn_readfirstlane(tid >> 6), lane = tid & 63, wr = wid >> 2, wc = wid & 3, fr = lane & 15, fq = lane >> 4;
    const int K = g.K, nt = K / BK, lda = g.lda ? g.lda : K, ldb = g.ldb ? g.ldb : K;
#define PG8_BOFF(pm_) (g.mb ? (size_t)((pm_) / g.mb) * g.bstride : (size_t)0)
    unsigned voffA[2], voffB[2];
#pragma unroll
    for (int i = 0; i < 2; ++i) { int R, C; stage_rc(tid * 16 + i * 8192, R, C); const int Rb = Epi::PERM ? ((R & ~31) + perm32(R & 31)) : R;
        voffA[i] = (unsigned)(R * lda + C) * 2u; voffB[i] = (unsigned)(Rb * ldb + C) * 2u; }
    const size_t kstep = (size_t)(BK * 2);
    const size_t hstepA = (size_t)HALF * lda * 2, hstepB = (size_t)HALF * ldb * 2;
    const size_t tstepA = 2 * hstepA, tstepB = 2 * hstepB;
    const unsigned ldsw = (unsigned)wid * 1024u;
    const int aoff = lds_byte(wr * 64 + fr, fq * 8), boff = lds_byte(wc * 32 + fr, fq * 8);
#define PG8_SA(b, h) (((b) * 2 + (h)) * HTB)
#define PG8_SB(b, h) ((4 + (b) * 2 + (h)) * HTB)
#define PG8_STAGE(bufoff, gbase, voff) do { _Pragma("unroll") for (int _i = 0; _i < 2; ++_i) \
        __builtin_amdgcn_global_load_lds((const unsigned*)((const char*)(gbase) + (voff)[_i]), (PG8_LAS unsigned*)(lds + (bufoff) + ldsw + _i * 8192), 16, 0, 0); } while (0)
#define PG8_LDA(dst, b, h) do { _Pragma("unroll") for (int m = 0; m < 4; ++m) _Pragma("unroll") for (int k = 0; k < 2; ++k) dst[m][k] = *(const PG8_LAS bf16x8*)(lds + PG8_SA(b, h) + aoff + m * 2048 + k * 1024); } while (0)
#define PG8_LDB(dst, b, h) do { _Pragma("unroll") for (int n = 0; n < 2; ++n) _Pragma("unroll") for (int k = 0; k < 2; ++k) dst[n][k] = *(const PG8_LAS bf16x8*)(lds + PG8_SB(b, h) + boff + n * 2048 + k * 1024); } while (0)
#define PG8_MMA(ai, bj, At, Bt) do { __builtin_amdgcn_s_setprio(1); _Pragma("unroll") for (int m = 0; m < 4; ++m) _Pragma("unroll") for (int n = 0; n < 2; ++n) _Pragma("unroll") for (int k = 0; k < 2; ++k) \
        acc[ai][bj][m][n] = __builtin_amdgcn_mfma_f32_16x16x32_bf16(Bt[n][k], At[m][k], acc[ai][bj][m][n], 0, 0, 0); __builtin_amdgcn_s_setprio(0); } while (0)
#define PG8_WAIT_V(n) asm volatile("s_waitcnt vmcnt(" #n ")" ::: "memory")
#define PG8_WAIT_L(n) asm volatile("s_waitcnt lgkmcnt(" #n ")" ::: "memory")
#define PG8_BAR __builtin_amdgcn_s_barrier()
#define PG8_SCHED __builtin_amdgcn_sched_barrier(0)
    Unit cur, nxt; int ui = 0;
    if (!S.next(0, cur)) return;
    f32x4 acc[2][2][4][2];
#pragma unroll
    for (int a = 0; a < 2; ++a)
#pragma unroll
        for (int b = 0; b < 2; ++b)
#pragma unroll
            for (int m = 0; m < 4; ++m)
#pragma unroll
                for (int n = 0; n < 2; ++n) acc[a][b][m][n] = (f32x4){0.f, 0.f, 0.f, 0.f};
    bf16x8 At[4][2], B0[2][2], B1[2][2];
    const char* cA = (const char*)g.A + (size_t)cur.pm * tstepA; const char* cB = (const char*)g.Bt + (size_t)cur.pn * tstepB + PG8_BOFF(cur.pm);
    S.a_ready(cur);
    if constexpr (SP2) {
        PG8_STAGE(PG8_SB(0, 0), cB, voffB); PG8_STAGE(PG8_SB(0, 1), cB + hstepB, voffB); PG8_STAGE(PG8_SA(0, 0), cA, voffA); PG8_STAGE(PG8_SA(0, 1), cA + hstepA, voffA);
        if (wr == 1) PG8_BAR;
        PG8_WAIT_V(2); PG8_BAR;
        PG8_STAGE(PG8_SB(1, 0), cB + kstep, voffB); PG8_STAGE(PG8_SA(1, 0), cA + kstep, voffA); PG8_STAGE(PG8_SB(1, 1), cB + hstepB + kstep, voffB);
        PG8_WAIT_V(6); PG8_BAR;
    } else {
        PG8_STAGE(PG8_SB(0, 0), cB, voffB); PG8_STAGE(PG8_SA(0, 0), cA, voffA); PG8_STAGE(PG8_SB(0, 1), cB + hstepB, voffB); PG8_STAGE(PG8_SA(0, 1), cA + hstepA, voffA);
        if (wr == 1) PG8_BAR;
        PG8_WAIT_V(4); PG8_BAR;
        PG8_STAGE(PG8_SB(1, 0), cB + kstep, voffB); PG8_STAGE(PG8_SA(1, 0), cA + kstep, voffA); PG8_STAGE(PG8_SB(1, 1), cB + hstepB + kstep, voffB);
        PG8_WAIT_V(6); PG8_BAR;
    }
    for (;;) {
        const bool has_next = S.next(ui + 1, nxt);
        const char* nA = has_next ? (const char*)g.A + (size_t)nxt.pm * tstepA : cA; const char* nB = has_next ? (const char*)g.Bt + (size_t)nxt.pn * tstepB + PG8_BOFF(nxt.pm) : cB;
        for (int t = 0; t < nt; t += 2) {
            const bool last = (t == nt - 2);
            const char* a1 = cA + (size_t)(t + 1) * kstep;
            const char* a2 = last ? nA : cA + (size_t)(t + 2) * kstep; const char* b2 = last ? nB : cB + (size_t)(t + 2) * kstep;
            const char* a3 = a2 + kstep; const char* b3 = b2 + kstep;
            if (last && has_next) S.a_ready(nxt);
            if constexpr (SP2) {
            PG8_LDB(B0, 0, 0); PG8_LDB(B1, 0, 1); PG8_SCHED; PG8_LDA(At, 0, 0); PG8_STAGE(PG8_SA(1, 1), a1 + hstepA, voffA);
            PG8_WAIT_V(8); PG8_WAIT_L(0); PG8_BAR; PG8_MMA(0, 0, At, B0); PG8_MMA(0, 1, At, B1); PG8_BAR; PG8_SCHED;
            PG8_LDA(At, 0, 1); PG8_STAGE(PG8_SB(0, 0), b2, voffB); PG8_STAGE(PG8_SB(0, 1), b2 + hstepB, voffB); PG8_STAGE(PG8_SA(0, 0), a2, voffA);
            PG8_WAIT_V(8); PG8_WAIT_L(0); PG8_BAR; PG8_MMA(1, 0, At, B0); PG8_MMA(1, 1, At, B1); PG8_BAR; PG8_SCHED;
            PG8_LDB(B0, 1, 0); PG8_LDB(B1, 1, 1); PG8_SCHED; PG8_LDA(At, 1, 0); PG8_STAGE(PG8_SA(0, 1), a2 + hstepA, voffA);
            PG8_WAIT_V(8); PG8_WAIT_L(0); PG8_BAR; PG8_MMA(0, 0, At, B0); PG8_MMA(0, 1, At, B1); PG8_BAR; PG8_SCHED;
            PG8_LDA(At, 1, 1); PG8_STAGE(PG8_SB(1, 0), b3, voffB); PG8_STAGE(PG8_SB(1, 1), b3 + hstepB, voffB); PG8_STAGE(PG8_SA(1, 0), a3, voffA);
            PG8_WAIT_V(8); PG8_WAIT_L(0); PG8_BAR; PG8_MMA(1, 0, At, B0); PG8_MMA(1, 1, At, B1); PG8_BAR; PG8_SCHED;
            } else {
            PG8_LDB(B0, 0, 0); PG8_SCHED; PG8_LDA(At, 0, 0); PG8_STAGE(PG8_SA(1, 1), a1 + hstepA, voffA);
            PG8_WAIT_L(8); PG8_BAR; PG8_WAIT_L(0); PG8_MMA(0, 0, At, B0); PG8_BAR; PG8_SCHED;
            PG8_LDB(B1, 0, 1); PG8_STAGE(PG8_SB(0, 0), b2, voffB);
            PG8_BAR; PG8_WAIT_L(0); PG8_MMA(0, 1, At, B1); PG8_BAR;
            PG8_LDA(At, 0, 1); PG8_STAGE(PG8_SA(0, 0), a2, voffA);
            PG8_BAR; PG8_WAIT_L(0); PG8_MMA(1, 0, At, B0); PG8_BAR; PG8_SCHED;
            PG8_STAGE(PG8_SB(0, 1), b2 + hstepB, voffB);
            PG8_WAIT_V(6); PG8_BAR; PG8_MMA(1, 1, At, B1); PG8_BAR;
            PG8_LDB(B0, 1, 0); PG8_SCHED; PG8_LDA(At, 1, 0); PG8_STAGE(PG8_SA(0, 1), a2 + hstepA, voffA);
            PG8_WAIT_L(8); PG8_BAR; PG8_WAIT_L(0); PG8_MMA(0, 0, At, B0); PG8_BAR; PG8_SCHED;
            PG8_LDB(B1, 1, 1); PG8_STAGE(PG8_SB(1, 0), b3, voffB);
            PG8_BAR; PG8_WAIT_L(0); PG8_MMA(0, 1, At, B1); PG8_BAR;
            PG8_LDA(At, 1, 1); PG8_STAGE(PG8_SA(1, 0), a3, voffA);
            PG8_BAR; PG8_WAIT_L(0); PG8_MMA(1, 0, At, B0); PG8_BAR; PG8_SCHED;
            PG8_STAGE(PG8_SB(1, 1), b3 + hstepB, voffB);
            PG8_WAIT_V(6); PG8_BAR; PG8_MMA(1, 1, At, B1); PG8_BAR;
            }
        }
        if constexpr (ALIGN_EPI) { if (wr == 0) PG8_BAR; }
        if constexpr (!Epi::AFTER_DRAIN) { E(acc, cur, wr, wc, fr, fq); S.done(cur); }
        if (!has_next) break;
#pragma unroll
        for (int a = 0; a < 2; ++a)
#pragma unroll
            for (int b = 0; b < 2; ++b)
#pragma unroll
                for (int m = 0; m < 4; ++m)
#pragma unroll
                    for (int n = 0; n < 2; ++n) acc[a][b][m][n] = (f32x4){0.f, 0.f, 0.f, 0.f};
        cur = nxt; cA = nA; cB = nB; ++ui;
        if constexpr (ALIGN_EPI) { if (wr == 1) PG8_BAR; }
    }
    PG8_WAIT_V(0);
    if constexpr (!ALIGN_EPI) { if (wr == 0) PG8_BAR; }
    PG8_BAR;
    if constexpr (Epi::AFTER_DRAIN) { E.fused(acc, cur, wr, wc, fr, fq, lds, wid, lane); S.done(cur); }
#undef PG8_BOFF
#undef PG8_SA
#undef PG8_SB
#undef PG8_STAGE
#undef PG8_LDA
#undef PG8_LDB
#undef PG8_MMA
#undef PG8_WAIT_V
#undef PG8_WAIT_L
#undef PG8_BAR
#undef PG8_SCHED
}
}

#define GAS __attribute__((address_space(1)))
#define LAS __attribute__((address_space(3)))
typedef GAS unsigned gu32;
#define LDS_WAIT() asm volatile("s_waitcnt lgkmcnt(0)" ::: "memory")
#define VM_WAIT() asm volatile("s_waitcnt vmcnt(0)" ::: "memory")
constexpr int NWAVES = 8, NTHR = NWAVES * 64;
constexpr int LDSCTL_OFF = 0, PH_BASE = 512, LDS_BYTES = 147456;
constexpr int CW_BAR = 4096;
constexpr size_t CTL_ZERO_BYTES = 256 * 1024;
constexpr size_t WS_TRIG = 27 * MiB;
#define XB_TMO      128
#define XB_XCNT(j)  (256  + 64 * (j))
#define XB_XSUB(j)  (1280 + 64 * (j))
#define XB_XGEN(j)  (2304 + 64 * (j))
#define XB_TOP      3328
#define XB_TOPGEN   3392
#define XCD_BAR_WORDS 3456
#define XB_SPIN_CAP (1u << 18)

__device__ __forceinline__ unsigned xb_ld(unsigned* p)              { return __hip_atomic_load(p, __ATOMIC_RELAXED, __HIP_MEMORY_SCOPE_AGENT); }
__device__ __forceinline__ unsigned xb_add(unsigned* p, unsigned v) { return __hip_atomic_fetch_add(p, v, __ATOMIC_RELAXED, __HIP_MEMORY_SCOPE_AGENT); }
__device__ __forceinline__ unsigned xb_xcc_id() { return (unsigned)__builtin_amdgcn_s_getreg((3 << 11) | 20) & 0xFu; }
#define XB_SPIN(cond, bar) do { unsigned _sp = 0; while (cond) { __builtin_amdgcn_s_sleep(1); \
    if ((++_sp & 255u) == 0u) { if (xb_ld(&(bar)[XB_TMO])) break; if (_sp > XB_SPIN_CAP) { atomicAdd(&(bar)[XB_TMO], 1u); break; } } } } while (0)

struct XcdBarrier {
    unsigned* bar; unsigned x;
    volatile LAS unsigned* st;
};

__device__ __forceinline__ XcdBarrier xcd_barrier_post(unsigned* bar, volatile LAS unsigned* st) {
    XcdBarrier b; b.bar = bar; b.x = xb_xcc_id(); b.st = st;
    if (threadIdx.x == 0) (void)xb_add(&bar[XB_XCNT(b.x)], 1u);
    return b;
}
__device__ __forceinline__ void xcd_barrier_complete(unsigned* bar, unsigned x, unsigned& nloc, unsigned& nx) {
    const unsigned G = gridDim.x * gridDim.y * gridDim.z;
    unsigned sum, cnt, mine, sp = 0u;
    for (;;) {
        sum = 0u; cnt = 0u; mine = 0u;
#pragma unroll
        for (unsigned j = 0; j < 16; ++j) { const unsigned c = xb_ld(&bar[XB_XCNT(j)]); sum += c; cnt += (c > 0u) ? 1u : 0u; mine = (j == x) ? c : mine; }
        if (sum == G) break;
        __builtin_amdgcn_s_sleep(1);
        if ((++sp & 255u) == 0u) { if (xb_ld(&bar[XB_TMO])) break; if (sp > XB_SPIN_CAP) { atomicAdd(&bar[XB_TMO], 1u); break; } }
    }
    nloc = mine > 0u ? mine : 1u; nx = cnt > 0u ? cnt : 1u;
}

__device__ __forceinline__ void xcd_barrier(const XcdBarrier& b) {
    asm volatile("s_waitcnt vmcnt(0)" ::: "memory");
    __syncthreads();
    if (threadIdx.x == 0) {
        unsigned* bar = b.bar;
        __builtin_amdgcn_s_waitcnt(0);
        unsigned nloc = b.st[0], nx = b.st[1];
        if (nloc == 0u) { xcd_barrier_complete(bar, b.x, nloc, nx); b.st[0] = nloc; b.st[1] = nx; }
        const unsigned old = xb_add(&bar[XB_XSUB(b.x)], 1u);
        const unsigned gen = old / nloc;
        if (old + 1u == (gen + 1u) * nloc) {
            __builtin_amdgcn_fence(__ATOMIC_RELEASE, "agent");
            asm volatile("s_waitcnt vmcnt(0)" ::: "memory");
            (void)xb_add(&bar[XB_TOP], 1u);
            XB_SPIN(xb_ld(&bar[XB_TOP]) < (gen + 1u) * nx, bar);
            __builtin_amdgcn_fence(__ATOMIC_ACQUIRE, "agent");
            asm volatile("s_waitcnt vmcnt(0)" ::: "memory");
        } else {
            XB_SPIN(xb_ld(&bar[XB_TOP]) < (gen + 1u) * nx, bar);
            __builtin_amdgcn_fence(__ATOMIC_ACQUIRE, "agent");
            asm volatile("s_waitcnt vmcnt(0)" ::: "memory");
        }
    }
    __syncthreads();
}

enum { PH_PRO = 0, PH_PROJ, PH_UP, PH_ATTN, PH_MIX, PH_MEMQ, PH_XATTN, PH_MEMO, PH_PQ, PH_TOPK, PH_EXP, PH_N, PHB_CONV = 16, PHB_UPG = 17 };
struct Args { const float* in[24]; float* out; unsigned char* ws; unsigned mask; unsigned li; };

DEVI int src_col(int mode, int r) { return mode == 0 ? r : mode == 1 ? win_src(r) : wkv_src(r); }
template <int MODE, bool HASG> DEVI void p0_transpose_item(const float* W, int K, int N, bf16* WT, int NR, const float* gk, LAS float* scr, int item, int lane) {
    const int nb_ = NR / 32, kb = item / nb_, nb = item % nb_, k0 = 64 * kb, n0 = 32 * nb;
    const int sc = src_col(MODE, n0 + (lane & 31)), scc = sc < 0 ? 0 : sc; const float keep = sc < 0 ? 0.f : 1.f;
    float v[32];
#pragma unroll
    for (int i = 0; i < 32; ++i) { const int kk = 2 * i + (lane >> 5); v[i] = W[(size_t)(k0 + kk) * N + scc]; }
    if (HASG) {
#pragma unroll
        for (int i = 0; i < 32; ++i) { const int kk = 2 * i + (lane >> 5); v[i] *= gk[k0 + kk]; } }
#pragma unroll
    for (int i = 0; i < 32; ++i) { const int kk = 2 * i + (lane >> 5); scr[kk * 33 + (lane & 31)] = MODE == 0 ? v[i] : v[i] * keep; }
    LDS_WAIT(); asm volatile("" ::: "memory");
    const int c = lane & 7;
#pragma unroll
    for (int j = 0; j < 4; ++j) { const int n = (lane >> 3) + 8 * j; const LAS float* s = scr + (8 * c) * 33 + n;
        uint4 o; o.x = pg8::cvt_pk_bf16(s[0 * 33], s[1 * 33]); o.y = pg8::cvt_pk_bf16(s[2 * 33], s[3 * 33]); o.z = pg8::cvt_pk_bf16(s[4 * 33], s[5 * 33]); o.w = pg8::cvt_pk_bf16(s[6 * 33], s[7 * 33]);
        *(uint4*)(WT + (size_t)(n0 + n) * K + k0 + 8 * c) = o; }
    LDS_WAIT(); asm volatile("" ::: "memory");
}
DEVI void rms_row_to_bf16(const float* xrow, const float* g, bf16* orow, int lane) {
    const float4* xr = (const float4*)xrow + lane; const float4* gr = (const float4*)g + lane;
    float4 v[4]; float s = 0.f;
#pragma unroll
    for (int j = 0; j < 4; ++j) { v[j] = xr[64 * j]; s += (v[j].x * v[j].x + v[j].y * v[j].y) + (v[j].z * v[j].z + v[j].w * v[j].w); }
    const float r = rsqrtf(wave_sum(s) * (1.f / D) + EPS);
    uint2* o8 = (uint2*)orow + lane;
#pragma unroll
    for (int j = 0; j < 4; ++j) { const float4 gg = gr[64 * j]; uint2 o; o.x = pg8::cvt_pk_bf16(v[j].x * r * gg.x, v[j].y * r * gg.y); o.y = pg8::cvt_pk_bf16(v[j].z * r * gg.z, v[j].w * r * gg.w); o8[64 * j] = o; }
}
DEVI void rms_rows4_to_bf16(const float* x, const float* g, bf16* out, int m0, int step, int mend, int lane) {
    float4 v[4][4]; float s[4]; float4 gq[4];
#pragma unroll
    for (int j = 0; j < 4; ++j) gq[j] = ((const float4*)g + lane)[64 * j];
#pragma unroll
    for (int r = 0; r < 4; ++r) { const int m = m0 + r * step; const float4* xr = (const float4*)(x + (size_t)(m < mend ? m : m0) * D) + lane;
#pragma unroll
        for (int j = 0; j < 4; ++j) v[r][j] = xr[64 * j]; }
#pragma unroll
    for (int r = 0; r < 4; ++r) { float t = 0.f;
#pragma unroll
        for (int j = 0; j < 4; ++j) t += (v[r][j].x * v[r][j].x + v[r][j].y * v[r][j].y) + (v[r][j].z * v[r][j].z + v[r][j].w * v[r][j].w);
        s[r] = t; }
#pragma unroll
    for (int r = 0; r < 4; ++r) s[r] = wave_sum(s[r]);
#pragma unroll
    for (int r = 0; r < 4; ++r) { const int m = m0 + r * step; if (m < mend) { const float rs = rsqrtf(s[r] * (1.f / D) + EPS); uint2* o8 = (uint2*)(out + (size_t)m * D) + lane;
#pragma unroll
        for (int j = 0; j < 4; ++j) { const float4 gg = gq[j]; uint2 o; o.x = pg8::cvt_pk_bf16(v[r][j].x * rs * gg.x, v[r][j].y * rs * gg.y); o.y = pg8::cvt_pk_bf16(v[r][j].z * rs * gg.z, v[r][j].w * rs * gg.w); o8[64 * j] = o; } } }
}
DEVI void cvt_stream_fp8(const float* src, unsigned char* dst, size_t n16, const float* g, float mul, size_t gtid, size_t gn) {
    for (size_t i = gtid; i < n16; i += gn) { pg8::u32x4 o;
#pragma unroll
        for (int q = 0; q < 4; ++q) { float4 a = *(const float4*)(src + i * 16 + q * 4); if (g) { const float4 gg = *(const float4*)(g + ((i * 16 + q * 4) & (D - 1))); a.x *= gg.x; a.y *= gg.y; a.z *= gg.z; a.w *= gg.w; }
            int p = __builtin_amdgcn_cvt_pk_fp8_f32(a.x * mul, a.y * mul, 0, false); p = __builtin_amdgcn_cvt_pk_fp8_f32(a.z * mul, a.w * mul, p, true); o[q] = (unsigned)p; }
        *(pg8::u32x4*)(dst + i * 16) = o; }
}
typedef unsigned v6u_t __attribute__((ext_vector_type(6)));
typedef float f32x2_t __attribute__((ext_vector_type(2)));
typedef float v16f_t __attribute__((ext_vector_type(16)));
typedef float v32f_t __attribute__((ext_vector_type(32)));
typedef __bf16 v32bf_t __attribute__((ext_vector_type(32)));
#ifndef FP6_INTERLEAVED
#define FP6_INTERLEAVED 0
#endif
template <bool HASG> DEVI void cvt_rows_fp6(const float* src, unsigned char* dst, const float* g, float mul, size_t gtid, size_t gn) {
    const int grp = (int)(gtid & 31);
    float4 gg[8];
#pragma unroll
    for (int q = 0; q < 8; ++q) { gg[q] = HASG ? *(const float4*)(g + grp * 32 + q * 4) : make_float4(1.f, 1.f, 1.f, 1.f); gg[q].x *= mul; gg[q].y *= mul; gg[q].z *= mul; gg[q].w *= mul; }
    for (size_t i0 = gtid; i0 < (size_t)PE * 32; i0 += 2 * gn) {
        float4 v[2][8];
#pragma unroll
        for (int u = 0; u < 2; ++u) { const size_t i = i0 + u * gn; if (i < (size_t)PE * 32) { const float* sp = src + (i >> 5) * D + (i & 31) * 32;
#pragma unroll
            for (int q = 0; q < 8; ++q) v[u][q] = *(const float4*)(sp + q * 4); } }
#pragma unroll
        for (int u = 0; u < 2; ++u) { const size_t i = i0 + u * gn; if (i < (size_t)PE * 32) { const size_t row = i >> 5;
            v16f_t a, b;
#pragma unroll
            for (int q = 0; q < 8; ++q) { const float4 x = v[u][q]; a[2 * q] = x.x * gg[q].x; b[2 * q] = x.y * gg[q].y; a[2 * q + 1] = x.z * gg[q].z; b[2 * q + 1] = x.w * gg[q].w; }
            const v6u_t p = __builtin_amdgcn_cvt_scalef32_2xpk16_fp6_f32(a, b, 1.0f);
            *(pg8::u32x4*)(dst + row * 768 + grp * 16) = (pg8::u32x4){p[0], p[1], p[2], p[3]};
            *(pg8::u32x2*)(dst + row * 768 + 512 + grp * 8) = (pg8::u32x2){p[4], p[5]}; } }
    }
}
DEVI void cvt_stream(const float* src, bf16* dst, size_t n8, const float* g, size_t gtid, size_t gn) {
    for (size_t i = gtid; i < n8; i += gn) { const float4 a = *(const float4*)(src + i * 8), b = *(const float4*)(src + i * 8 + 4);
        float4 ga = make_float4(1.f, 1.f, 1.f, 1.f), gb = ga; if (g) { ga = *(const float4*)(g + ((i * 8) & (D - 1))); gb = *(const float4*)(g + ((i * 8) & (D - 1)) + 4); }
        uint4 o; o.x = pg8::cvt_pk_bf16(a.x * ga.x, a.y * ga.y); o.y = pg8::cvt_pk_bf16(a.z * ga.z, a.w * ga.w); o.z = pg8::cvt_pk_bf16(b.x * gb.x, b.y * gb.y); o.w = pg8::cvt_pk_bf16(b.z * gb.z, b.w * gb.w);
        *(uint4*)(dst + i * 8) = o; }
}


DEVI void conv_token(int row, const bf16* U, const float* cw, const float* cb, const float* lg, const float* lb, bf16* CONCAT, int lane) {
    const int pos = row % SEQ; float y[8];
    { const float4 b0 = *(const float4*)(cb + lane * 8), b1 = *(const float4*)(cb + lane * 8 + 4); y[0] = b0.x; y[1] = b0.y; y[2] = b0.z; y[3] = b0.w; y[4] = b1.x; y[5] = b1.y; y[6] = b1.z; y[7] = b1.w; }
    const int k0 = pos >= CK - 1 ? 0 : CK - 1 - pos;
    for (int k = k0; k < CK; ++k) {
        const uint4 u = *(const uint4*)(U + (size_t)(row - (CK - 1) + k) * CW + lane * 8);
        const float4 w0 = *(const float4*)(cw + k * CW + lane * 8), w1 = *(const float4*)(cw + k * CW + lane * 8 + 4);
        y[0] += w0.x * __builtin_bit_cast(float, u.x << 16); y[1] += w0.y * __builtin_bit_cast(float, u.x & 0xffff0000u);
        y[2] += w0.z * __builtin_bit_cast(float, u.y << 16); y[3] += w0.w * __builtin_bit_cast(float, u.y & 0xffff0000u);
        y[4] += w1.x * __builtin_bit_cast(float, u.z << 16); y[5] += w1.y * __builtin_bit_cast(float, u.z & 0xffff0000u);
        y[6] += w1.z * __builtin_bit_cast(float, u.w << 16); y[7] += w1.w * __builtin_bit_cast(float, u.w & 0xffff0000u);
    }
    float s = 0.f;
#pragma unroll
    for (int e = 0; e < 8; ++e) s += y[e];
    const float mu = wave_sum(s) * (1.f / CW); float q = 0.f;
#pragma unroll
    for (int e = 0; e < 8; ++e) { y[e] -= mu; q += y[e] * y[e]; }
    const float rstd = rsqrtf(wave_sum(q) * (1.f / CW) + EPS);
    const float4 g0 = *(const float4*)(lg + lane * 8), g1 = *(const float4*)(lg + lane * 8 + 4), c0 = *(const float4*)(lb + lane * 8), c1 = *(const float4*)(lb + lane * 8 + 4);
    const float gg[8] = {g0.x, g0.y, g0.z, g0.w, g1.x, g1.y, g1.z, g1.w}, bb[8] = {c0.x, c0.y, c0.z, c0.w, c1.x, c1.y, c1.z, c1.w};
    float z[8];
#pragma unroll
    for (int e = 0; e < 8; ++e) { const float t = y[e] * rstd * gg[e] + bb[e]; z[e] = t * __builtin_amdgcn_rcpf(1.f + __expf(-t)); }
    uint4 o; o.x = pg8::cvt_pk_bf16(z[0], z[1]); o.y = pg8::cvt_pk_bf16(z[2], z[3]); o.z = pg8::cvt_pk_bf16(z[4], z[5]); o.w = pg8::cvt_pk_bf16(z[6], z[7]);
    *(uint4*)(CONCAT + (size_t)row * D + CW + lane * 8) = o;
}

DEVI void conv_chunk(int c, const bf16* U, const float* cw, const float* cb, const float* lg, const float* lb, bf16* CONCAT, LAS unsigned char* lds) {
    const int ch = threadIdx.x, lane = ch & 63, wv = __builtin_amdgcn_readfirstlane(ch >> 6);
    const int t0 = c * 64, pos0 = t0 % SEQ;
    float w[CK];
#pragma unroll
    for (int k = 0; k < CK; ++k) w[k] = cw[k * CW + ch];
    const float bias = cb[ch];
    float u[64 + CK - 1];
#pragma unroll
    for (int r = 0; r < 64 + CK - 1; ++r) { const int row = t0 - (CK - 1) + r;
        const unsigned raw = *(const unsigned short*)(U + (size_t)(row < 0 ? 0 : row) * CW + ch); u[r] = __builtin_bit_cast(float, raw << 16); }
#pragma unroll
    for (int r = 0; r < CK - 1; ++r) { const float keep = (pos0 - (CK - 1) + r >= 0) ? 1.f : 0.f; u[r] *= keep; }
    LAS float* yl = (LAS float*)lds;
#pragma unroll
    for (int j = 0; j < 64; ++j) { float y = bias;
#pragma unroll
        for (int k = 0; k < CK; ++k) y += w[k] * u[j + k];
        yl[j * CW + ch] = y; }
    __syncthreads();
#pragma unroll 1
    for (int i = 0; i < 8; ++i) { const int j = wv * 8 + i, row = t0 + j;
        const pg8::f32x4 a0 = *(const LAS pg8::f32x4*)(yl + j * CW + lane * 8), a1 = *(const LAS pg8::f32x4*)(yl + j * CW + lane * 8 + 4);
        float y[8] = {a0[0], a0[1], a0[2], a0[3], a1[0], a1[1], a1[2], a1[3]}; float sm = 0.f;
#pragma unroll
        for (int e = 0; e < 8; ++e) sm += y[e];
        const float mu = wave_sum(sm) * (1.f / CW); float q = 0.f;
#pragma unroll
        for (int e = 0; e < 8; ++e) { y[e] -= mu; q += y[e] * y[e]; }
        const float rstd = rsqrtf(wave_sum(q) * (1.f / CW) + EPS);
        const float4 g0 = *(const float4*)(lg + lane * 8), g1 = *(const float4*)(lg + lane * 8 + 4), c0 = *(const float4*)(lb + lane * 8), c1 = *(const float4*)(lb + lane * 8 + 4);
        const float gg[8] = {g0.x, g0.y, g0.z, g0.w, g1.x, g1.y, g1.z, g1.w}, bb[8] = {c0.x, c0.y, c0.z, c0.w, c1.x, c1.y, c1.z, c1.w};
        float z[8];
#pragma unroll
        for (int e = 0; e < 8; ++e) { const float t = y[e] * rstd * gg[e] + bb[e]; z[e] = t * __builtin_amdgcn_rcpf(1.f + __expf(-t)); }
        uint4 o; o.x = pg8::cvt_pk_bf16(z[0], z[1]); o.y = pg8::cvt_pk_bf16(z[2], z[3]); o.z = pg8::cvt_pk_bf16(z[4], z[5]); o.w = pg8::cvt_pk_bf16(z[6], z[7]);
        *(uint4*)(CONCAT + (size_t)row * D + CW + lane * 8) = o; }
    __syncthreads();
}

typedef short bf16x8_t __attribute__((ext_vector_type(8)));
typedef float f32x16_t __attribute__((ext_vector_type(16)));
typedef __bf16 bf16x2_t __attribute__((ext_vector_type(2)));
DEVI unsigned umax_(unsigned a, unsigned b) { return a > b ? a : b; }
DEVI unsigned umin_(unsigned a, unsigned b) { return a < b ? a : b; }
DEVI unsigned kmax_(unsigned a, unsigned b) { unsigned r; asm("v_max_f32 %0, %1, %2" : "=v"(r) : "v"(a), "v"(b)); return r; }
DEVI unsigned kmin_(unsigned a, unsigned b) { unsigned r; asm("v_min_f32 %0, %1, %2" : "=v"(r) : "v"(a), "v"(b)); return r; }
DEVI void ce_desc(unsigned& a, unsigned& b) { const unsigned mx = kmax_(a, b), mn = kmin_(a, b); a = mx; b = mn; }
DEVI void sort16_desc(unsigned (&v)[16]) {
    ce_desc(v[0], v[13]); ce_desc(v[1], v[12]); ce_desc(v[2], v[15]); ce_desc(v[3], v[14]); ce_desc(v[4], v[8]); ce_desc(v[5], v[6]); ce_desc(v[7], v[11]); ce_desc(v[9], v[10]);
    ce_desc(v[0], v[5]); ce_desc(v[1], v[7]); ce_desc(v[2], v[9]); ce_desc(v[3], v[4]); ce_desc(v[6], v[13]); ce_desc(v[8], v[14]); ce_desc(v[10], v[15]); ce_desc(v[11], v[12]);
    ce_desc(v[0], v[1]); ce_desc(v[2], v[3]); ce_desc(v[4], v[5]); ce_desc(v[6], v[8]); ce_desc(v[7], v[9]); ce_desc(v[10], v[11]); ce_desc(v[12], v[13]); ce_desc(v[14], v[15]);
    ce_desc(v[0], v[2]); ce_desc(v[1], v[3]); ce_desc(v[4], v[10]); ce_desc(v[5], v[11]); ce_desc(v[6], v[7]); ce_desc(v[8], v[9]); ce_desc(v[12], v[14]); ce_desc(v[13], v[15]);
    ce_desc(v[1], v[2]); ce_desc(v[3], v[12]); ce_desc(v[4], v[6]); ce_desc(v[5], v[7]); ce_desc(v[8], v[10]); ce_desc(v[9], v[11]); ce_desc(v[13], v[14]);
    ce_desc(v[1], v[4]); ce_desc(v[2], v[6]); ce_desc(v[5], v[8]); ce_desc(v[7], v[10]); ce_desc(v[9], v[13]); ce_desc(v[11], v[14]);
    ce_desc(v[2], v[4]); ce_desc(v[3], v[6]); ce_desc(v[9], v[12]); ce_desc(v[11], v[13]);
    ce_desc(v[3], v[5]); ce_desc(v[6], v[8]); ce_desc(v[7], v[9]); ce_desc(v[10], v[12]);
    ce_desc(v[3], v[4]); ce_desc(v[5], v[6]); ce_desc(v[7], v[8]); ce_desc(v[9], v[10]); ce_desc(v[11], v[12]);
    ce_desc(v[6], v[7]); ce_desc(v[8], v[9]);
}
DEVI void merge16_desc(unsigned (&v)[16]) {
#pragma unroll
    for (int j = 8; j > 0; j >>= 1)
#pragma unroll
        for (int i = 0; i < 16; ++i) { const int l = i ^ j; if (l > i) ce_desc(v[i], v[l]); }
}
DEVI void top16_merge(unsigned (&a)[16], const unsigned (&b)[16]) {
#pragma unroll
    for (int i = 0; i < 16; ++i) a[i] = kmax_(a[i], b[15 - i]);
    merge16_desc(a);
}
DEVI int crow16(int r, int hi) { return (r & 3) + 8 * (r >> 2) + 4 * hi; }

DEVI void subkey_top16(unsigned (&best)[16], const bf16* qrow  , const LAS unsigned char* kl  , int hi) {
    bf16x8_t qf[8];
#pragma unroll
    for (int ks = 0; ks < 8; ++ks) qf[ks] = *(const bf16x8_t*)(qrow + 16 * ks);
    unsigned grp[16];
#pragma unroll
    for (int nt = 0; nt < 4; ++nt) {
        f32x16_t acc = {};
#pragma unroll
        for (int ks = 0; ks < 8; ++ks) { const bf16x8_t kf = *(const LAS bf16x8_t*)(kl + ks * 4096 + nt * 512); acc = __builtin_amdgcn_mfma_f32_32x32x16_bf16(kf, qf[ks], acc, 0, 0, 0); }
#pragma unroll
        for (int r = 0; r < 16; ++r) { const float av = acc[r]; grp[r] = (__builtin_bit_cast(unsigned, av) & 0xffffff80u) | (unsigned)(127 - (32 * nt + crow16(r, hi))); }
        sort16_desc(grp);
        if (nt == 0) {
#pragma unroll
            for (int r = 0; r < 16; ++r) best[r] = grp[r];
        } else top16_merge(best, grp);
    }
    unsigned oth[16];
#pragma unroll
    for (int r = 0; r < 16; ++r) oth[r] = x32_get(best[r], hi << 5);
    top16_merge(best, oth);
}
DEVI void topk_wave(const bf16* qbase, const LAS unsigned char* keys, LAS unsigned* scr  , int* eidx, float* egate, int lane) {
    const int r32 = lane & 31, hi = lane >> 5;
    unsigned b0[16], b1[16];
    subkey_top16(b0, qbase + 8 * hi, keys + hi * 2048 + r32 * 16, hi);
    subkey_top16(b1, qbase + 128 + 8 * hi, keys + 32768 + hi * 2048 + r32 * 16, hi);
    float s0[16], s1[16];
#pragma unroll
    for (int i = 0; i < 16; ++i) { s0[i] = __builtin_bit_cast(float, b0[i] & 0xffffff80u); s1[i] = __builtin_bit_cast(float, b1[i] & 0xffffff80u); }
#pragma unroll
    for (int w = 0; w < 4; ++w) {
        scr[lane * 9 + w] = (127u - (b0[4 * w] & 127u)) | ((127u - (b0[4 * w + 1] & 127u)) << 8) | ((127u - (b0[4 * w + 2] & 127u)) << 16) | ((127u - (b0[4 * w + 3] & 127u)) << 24);
        scr[lane * 9 + 4 + w] = (127u - (b1[4 * w] & 127u)) | ((127u - (b1[4 * w + 1] & 127u)) << 8) | ((127u - (b1[4 * w + 2] & 127u)) << 16) | ((127u - (b1[4 * w + 3] & 127u)) << 24);
    }
    unsigned ca[16], cb2[16];
#define CAND(i, j) ((__builtin_bit_cast(unsigned, s0[i] + s1[j]) & 0xffffff00u) | (unsigned)(255 - ((i) * 16 + (j))))
    const unsigned lowest = 0xff800000u;
    if (hi == 0) {
#pragma unroll
        for (int j = 0; j < 16; ++j) ca[j] = CAND(0, j);
#pragma unroll
        for (int j = 0; j < 8; ++j) cb2[j] = CAND(1, j);
#pragma unroll
        for (int j = 8; j < 16; ++j) cb2[j] = lowest;
    } else {
        ca[0] = CAND(2, 0); ca[1] = CAND(2, 1); ca[2] = CAND(2, 2); ca[3] = CAND(2, 3); ca[4] = CAND(2, 4); ca[5] = CAND(3, 0); ca[6] = CAND(3, 1); ca[7] = CAND(3, 2); ca[8] = CAND(3, 3);
        ca[9] = CAND(4, 0); ca[10] = CAND(4, 1); ca[11] = CAND(4, 2); ca[12] = CAND(5, 0); ca[13] = CAND(5, 1); ca[14] = CAND(6, 0); ca[15] = CAND(6, 1);
        cb2[0] = CAND(7, 0); cb2[1] = CAND(7, 1); cb2[2] = CAND(8, 0); cb2[3] = CAND(9, 0); cb2[4] = CAND(10, 0); cb2[5] = CAND(11, 0); cb2[6] = CAND(12, 0); cb2[7] = CAND(13, 0); cb2[8] = CAND(14, 0); cb2[9] = CAND(15, 0);
#pragma unroll
        for (int j = 10; j < 16; ++j) cb2[j] = lowest;
    }
#undef CAND
    sort16_desc(ca); sort16_desc(cb2); top16_merge(ca, cb2);
    unsigned oth[16];
#pragma unroll
    for (int r = 0; r < 16; ++r) oth[r] = x32_get(ca[r], lane);
    top16_merge(ca, oth);
    const float mx = __builtin_bit_cast(float, ca[0] & 0xffffff00u); float ex[16]; float l = 0.f;
#pragma unroll
    for (int k = 0; k < 16; ++k) { ex[k] = __expf(__builtin_bit_cast(float, ca[k] & 0xffffff00u) - mx); l += ex[k]; }
    const float rl = 1.f / l;
    LDS_WAIT(); asm volatile("" ::: "memory");
    int ei[8]; float eg[8];
    const unsigned mhi = (unsigned)(-hi);
#pragma unroll
    for (int k = 0; k < 8; ++k) { const unsigned key = ca[k] ^ ((ca[k] ^ ca[8 + k]) & mhi); const unsigned ij = 255u - (key & 255u), i = ij >> 4, j = ij & 15u;
        const unsigned w0 = scr[lane * 9 + (i >> 2)], w1 = scr[lane * 9 + 4 + (j >> 2)];
        ei[k] = (int)(((w0 >> (8 * (i & 3))) & 255u) * PNK + ((w1 >> (8 * (j & 3))) & 255u)); eg[k] = __builtin_bit_cast(float, __builtin_bit_cast(unsigned, ex[k]) ^ ((__builtin_bit_cast(unsigned, ex[k]) ^ __builtin_bit_cast(unsigned, ex[8 + k])) & mhi)) * rl; }
    *(int4*)(eidx + hi * 8) = make_int4(ei[0], ei[1], ei[2], ei[3]); *(int4*)(eidx + hi * 8 + 4) = make_int4(ei[4], ei[5], ei[6], ei[7]);
    *(float4*)(egate + hi * 8) = make_float4(eg[0], eg[1], eg[2], eg[3]); *(float4*)(egate + hi * 8 + 4) = make_float4(eg[4], eg[5], eg[6], eg[7]);
    LDS_WAIT(); asm volatile("" ::: "memory");
}

typedef unsigned char fp8_t;
template <int VAR = 0> DEVI float dot16_fp8(pg8::u32x4 row, pg8::u32x4 ha, pg8::u32x4 hb, float acc) {
    if (VAR == 1) return __builtin_bit_cast(float, (row[0] ^ row[1]) ^ (row[2] ^ row[3]));
#pragma unroll
    for (int i = 0; i < 4; ++i) { const unsigned hlo = i < 2 ? ha[2 * i] : hb[2 * i - 4], hhi = i < 2 ? ha[2 * i + 1] : hb[2 * i - 3];
        acc = __builtin_amdgcn_fdot2_f32_bf16(__builtin_amdgcn_cvt_scalef32_pk_bf16_fp8(row[i], 1.0f, false), __builtin_bit_cast(bf16x2_t, hlo), acc, false);
        acc = __builtin_amdgcn_fdot2_f32_bf16(__builtin_amdgcn_cvt_scalef32_pk_bf16_fp8(row[i], 1.0f, true), __builtin_bit_cast(bf16x2_t, hhi), acc, false); }
    return acc;
}
template <int VAR = 0> DEVI void fma16_fp8(float (&acc)[16], float w, pg8::u32x4 row) {
    if (VAR == 1) { acc[0] += __builtin_bit_cast(float, row[0] ^ row[1]); acc[1] += __builtin_bit_cast(float, row[2] ^ row[3]); return; }
#pragma unroll
    for (int i = 0; i < 4; ++i) { const pg8::f32x2 lo = __builtin_amdgcn_cvt_pk_f32_fp8(row[i], false), hh = __builtin_amdgcn_cvt_pk_f32_fp8(row[i], true);
        acc[4 * i] += w * lo[0]; acc[4 * i + 1] += w * lo[1]; acc[4 * i + 2] += w * hh[0]; acc[4 * i + 3] += w * hh[1]; }
}
DEVI unsigned lane_xor_(unsigned v, int j, int lane) {
    if (j == 1) return (unsigned)__builtin_amdgcn_update_dpp(0, (int)v, 0xB1, 0xF, 0xF, true);
    if (j == 2) return (unsigned)__builtin_amdgcn_update_dpp(0, (int)v, 0x4E, 0xF, 0xF, true);
    if (j == 4) { const unsigned dn = (unsigned)__builtin_amdgcn_update_dpp(0, (int)v, 0x114, 0xF, 0xF, true), up = (unsigned)__builtin_amdgcn_update_dpp(0, (int)v, 0x104, 0xF, 0xF, true);
        return (lane & 4) ? dn : up; }
    if (j == 8) return (unsigned)__builtin_amdgcn_update_dpp(0, (int)v, 0x128, 0xF, 0xF, true);
    if (j == 16) { const auto s_ = __builtin_amdgcn_permlane16_swap(v, v, false, false); return (lane & 16) ? (unsigned)s_[0] : (unsigned)s_[1]; }
    const auto s_ = __builtin_amdgcn_permlane32_swap(v, v, false, false); return (lane & 32) ? (unsigned)s_[0] : (unsigned)s_[1];
}
DEVI void sort128_asc(unsigned& a, unsigned& b, int lane) {
#pragma unroll
    for (int k = 2; k <= 128; k <<= 1)
#pragma unroll
        for (int j = k >> 1; j > 0; j >>= 1) {
            if (j == 64) { const unsigned lo = umin_(a, b), hi = umax_(a, b); a = lo; b = hi; }
            else {
                const bool upper = (lane & j) != 0;
                const bool asc_a = k == 128 ? true : ((lane & k) == 0), asc_b = k == 128 ? true : (k == 64 ? false : ((lane & k) == 0));
                const unsigned pa_ = lane_xor_(a, j, lane), pb_ = lane_xor_(b, j, lane);
                a = (upper != asc_a) ? umin_(a, pa_) : umax_(a, pa_);
                b = (upper != asc_b) ? umin_(b, pb_) : umax_(b, pb_);
            }
        }
}
constexpr int EXD = 8, EXP_LDS_WAVE = 12800 + 1024;
typedef int v8i_t __attribute__((ext_vector_type(8)));
typedef float v4f_t __attribute__((ext_vector_type(4)));
struct Row6 { pg8::u32x4 a; pg8::u32x2 b; };
template <int VAR> DEVI void experts_wave(LAS unsigned char* wl_, int t0, int tstep, const bf16* H2B, const float* part2, const unsigned char* PU, const unsigned char* PV, const int* EIDX, const float* EGATE, const float* fg, float* out, int lane) {
    if (t0 >= M) return;
    const int ntok = (M - t0 + tstep - 1) / tstep < 8 ? (M - t0 + tstep - 1) / tstep : 8;
    LAS int* sid = (LAS int*)wl_; LAS float* gsl = (LAS float*)(wl_ + 4096); LAS float* wl = (LAS float*)(wl_ + 8192); LAS float* r2l = (LAS float*)(wl_ + 12288);
    const unsigned g32 = (unsigned)lane & 31u, hsel = (unsigned)lane >> 5, l4 = (unsigned)lane * 4u;
#define LDI(p) (*(const int*)((const char*)(p) + l4))
#define LDF(p) (*(const float*)((const char*)(p) + l4))
#define LDROW(dst, tab, ridx) do { const unsigned char* rp_ = (tab) + (size_t)(unsigned)(ridx) * 768u; (dst).a = *(const pg8::u32x4*)(rp_ + g32 * 16u); (dst).b = *(const pg8::u32x2*)(rp_ + 512u + g32 * 8u); } while (0)
    for (int k = 0; k < ntok; ++k) { const int t = t0 + k * tstep;
        unsigned k0 = ((unsigned)LDI(EIDX + (size_t)t * 128) << 7) | (unsigned)lane, k1 = ((unsigned)LDI(EIDX + (size_t)t * 128 + 64) << 7) | (unsigned)(64 + lane);
        const float ga = LDF(EGATE + (size_t)t * 128), gb = LDF(EGATE + (size_t)t * 128 + 64);
        sort128_asc(k0, k1, lane);
        const unsigned sl0 = k0 & 127u, sl1 = k1 & 127u;
        const float x0 = __shfl(ga, (int)(sl0 & 63u)), y0 = __shfl(gb, (int)(sl0 & 63u)), x1 = __shfl(ga, (int)(sl1 & 63u)), y1 = __shfl(gb, (int)(sl1 & 63u));
        sid[k * 128 + lane] = (int)(k0 >> 7); sid[k * 128 + 64 + lane] = (int)(k1 >> 7);
        gsl[k * 128 + lane] = sl0 < 64u ? x0 : y0; gsl[k * 128 + 64 + lane] = sl1 < 64u ? x1 : y1;
        const float r2 = rsqrtf(wave_sum(lane < 16 ? LDF(part2 + (size_t)t * 16) : 0.f) * (1.f / D) + EPS) * (1.0f / PU_SCALE);
        if (lane == 0) r2l[k] = r2; }
    LDS_WAIT(); asm volatile("" ::: "memory");
    const int nsteps = 8 * ntok;
#define STEP_DESC(q, tab, pos0) do { const int q_ = (q); if (q_ < nsteps) { (tab) = PU; (pos0) = ((q_ >> 5) * 4 + (q_ & 3)) * 128 + 16 * ((q_ >> 2) & 7); } \
        else if (q_ < 2 * nsteps) { const int qq_ = q_ - nsteps; (tab) = PV; (pos0) = ((qq_ >> 4) * 2 + (qq_ & 1)) * 128 + 16 * ((qq_ >> 1) & 7); } else { (tab) = PV; (pos0) = 0; } } while (0)
    constexpr int LOOK = 1;
    Row6 buf[8 * LOOK];
    pg8::u32x4 hhi[4];
#define CONVERT_GRP(g_) do { LAS unsigned char* img = wl_ + 12800; const int c16 = lane & 15, q4 = lane >> 4; \
      _Pragma("unroll") for (int k = 0; k < 4; ++k) { const int tt_ = t0 + (4 * (g_) + k) * tstep; \
          const pg8::u32x4 h0 = *(const pg8::u32x4*)((const char*)(H2B + (size_t)tt_ * D) + lane * 32), h1 = *(const pg8::u32x4*)((const char*)(H2B + (size_t)tt_ * D) + lane * 32 + 16); \
          float hf[16]; \
          _Pragma("unroll") for (int j = 0; j < 4; ++j) { hf[2 * j] = __builtin_bit_cast(float, h0[j] << 16); hf[2 * j + 1] = __builtin_bit_cast(float, h0[j] & 0xffff0000u); hf[8 + 2 * j] = __builtin_bit_cast(float, h1[j] << 16); hf[8 + 2 * j + 1] = __builtin_bit_cast(float, h1[j] & 0xffff0000u); } \
          pg8::u32x4 hiw; \
          _Pragma("unroll") for (int j = 0; j < 16; ++j) hf[j] = __builtin_amdgcn_fmed3f(hf[j], -448.f, 448.f);     \
          _Pragma("unroll") for (int w = 0; w < 4; ++w) { int p = __builtin_amdgcn_cvt_pk_fp8_f32(hf[4 * w], hf[4 * w + 1], 0, false); p = __builtin_amdgcn_cvt_pk_fp8_f32(hf[4 * w + 2], hf[4 * w + 3], p, true); \
              hiw[w] = (unsigned)p; } \
          *(LAS pg8::u32x4*)(img + lane * 16) = hiw; \
          LDS_WAIT(); asm volatile("" ::: "memory"); \
          const int off = 32 * c16 + 512 * (q4 >> 1) + 16 * (q4 & 1); \
          hhi[k] = *(const LAS pg8::u32x4*)(img + off); \
          LDS_WAIT(); asm volatile("" ::: "memory"); } } while (0)
#pragma unroll
    for (int i = 0; i < 8; ++i) { const int ri = sid[2 * i + (int)hsel]; LDROW(buf[i], PU, ri); }
#define DPPF_(x, CTRL) __builtin_bit_cast(float, __builtin_amdgcn_update_dpp(0, __builtin_bit_cast(int, (x)), (CTRL), 0xF, 0xF, true))
#define TR_STEP(S, CTRL) _Pragma("unroll") for (int i = 0; i < S; ++i) { const bool up_ = (lane & S) != 0; const float send = up_ ? r[i] : r[i + S], keep = up_ ? r[i + S] : r[i]; r[i] = keep + DPPF_(send, CTRL); }
#define U_STEP(q, B_, K_, G_) do { const int q__ = (q); const int ub_ = (B_); constexpr int uk_ = (K_); const int tk_ = 4 * (G_) + uk_; \
        const unsigned char* ntab; int npos; STEP_DESC(q__ + LOOK, ntab, npos); npos += (int)hsel; \
        const v8i_t AAh = {(int)hhi[uk_][0], (int)hhi[uk_][1], (int)hhi[uk_][2], (int)hhi[uk_][3], 0, 0, 0, 0}; \
        const v8i_t ABh = {0, 0, 0, 0, (int)hhi[uk_][0], (int)hhi[uk_][1], (int)hhi[uk_][2], (int)hhi[uk_][3]}; \
        const int c16_ = lane & 15; const bool dg_ = (lane >> 4) == (c16_ >> 2); \
        float r[16]; int riu_[8]; \
        _Pragma("unroll") for (int i2 = 0; i2 < 8; ++i2) riu_[i2] = sid[npos + 2 * i2]; \
        _Pragma("unroll") for (int i2 = 0; i2 < 8; ++i2) { \
            const v8i_t B6 = {(int)buf[i2].a[0], (int)buf[i2].a[1], (int)buf[i2].a[2], (int)buf[i2].a[3], (int)buf[i2].b[0], (int)buf[i2].b[1], 0, 0}; \
            const v4f_t z4 = {0.f, 0.f, 0.f, 0.f}; \
            v4f_t cA = __builtin_amdgcn_mfma_scale_f32_16x16x128_f8f6f4(AAh, B6, z4, 0, 2, 0, 127, 0, 127); \
            v4f_t cB = __builtin_amdgcn_mfma_scale_f32_16x16x128_f8f6f4(ABh, B6, z4, 0, 2, 0, 127, 0, 127); \
            LDROW(buf[i2], ntab, riu_[i2]); \
            const float a01 = (c16_ & 1) ? cA[1] : cA[0], a23 = (c16_ & 1) ? cA[3] : cA[2], b01 = (c16_ & 1) ? cB[1] : cB[0], b23 = (c16_ & 1) ? cB[3] : cB[2]; \
            r[2 * i2] = dg_ ? ((c16_ & 2) ? a23 : a01) : 0.f; r[2 * i2 + 1] = dg_ ? ((c16_ & 2) ? b23 : b01) : 0.f; \
            __builtin_amdgcn_sched_barrier(0); } \
        TR_STEP(8, 0x128) TR_STEP(4, 0x141) TR_STEP(2, 0x4E) TR_STEP(1, 0xB1) \
        const unsigned t0b_ = __builtin_bit_cast(unsigned, r[0]); const auto s16_ = __builtin_amdgcn_permlane16_swap(t0b_, t0b_, false, false);     \
        const float t1_ = __builtin_bit_cast(float, (unsigned)s16_[0]) + __builtin_bit_cast(float, (unsigned)s16_[1]); \
        const unsigned t1b_ = __builtin_bit_cast(unsigned, t1_); const auto s32_ = __builtin_amdgcn_permlane32_swap(t1b_, t1b_, false, false); \
        const float tot = __builtin_bit_cast(float, (unsigned)s32_[0]) + __builtin_bit_cast(float, (unsigned)s32_[1]); \
        const int pos = tk_ * 128 + 16 * ub_ + c16_; \
        wl[pos] = tot; } while (0)
    if (ntok == 8) {
#pragma unroll 1
        for (int grp = 0; grp < 2; ++grp) {
            CONVERT_GRP(grp);
#pragma unroll 1
            for (int b = 0; b < 8; ++b) { const int q = grp * 32 + b * 4;
                __builtin_amdgcn_s_barrier();
                U_STEP(q, b, 0, grp); U_STEP(q + 1, b, 1, grp); U_STEP(q + 2, b, 2, grp); U_STEP(q + 3, b, 3, grp); }
            LDS_WAIT(); asm volatile("" ::: "memory");
#pragma unroll
            for (int kk = 0; kk < 4; ++kk) { const int tk = 4 * grp + kk; const float rsk = r2l[tk];
#pragma unroll
                for (int hh = 0; hh < 2; ++hh) { const int pos = tk * 128 + 64 * hh + lane; const float a = wl[pos] * rsk;
                    const float wf_ = 0.5f * a * (1.f + erff(a * 0.70710678118654752f)) * gsl[pos] * (1.0f / PV_SCALE);
                    const unsigned wb_ = __builtin_bit_cast(unsigned, wf_) + (1u << 19);
                    ((LAS unsigned*)wl)[pos] = ((wb_ >> 31) << 5) | 8u | ((wb_ >> 20) & 7u) | (((wb_ >> 23) & 255u) << 8); } }
            LDS_WAIT(); asm volatile("" ::: "memory");
        }
    }
#undef CONVERT_GRP
#undef U_STEP
#undef TR_STEP
#undef DPPF_
    LDS_WAIT(); asm volatile("" ::: "memory");
    typedef float v16f_tt __attribute__((ext_vector_type(16)));
    const int iv = lane & 31, hv = lane >> 5, bo = 6 * iv, r0v = bo >> 5, shv = bo & 31, rshv = shv > 26 ? 32 - shv : 31;
    unsigned m0v[6], m1v[6];
#pragma unroll
    for (int d = 0; d < 6; ++d) { m0v[d] = d == r0v ? ~0u : 0u; m1v[d] = d == r0v + 1 ? ~0u : 0u; }
    const unsigned ebase = 32u * (unsigned)iv + 4u * (unsigned)hv;
    float4 fgq[4];
#pragma unroll
    for (int r4 = 0; r4 < 4; ++r4) fgq[r4] = *(const float4*)(fg + ebase + 8 * r4);
#define V_STEP(q, CACC, KT) do { const int q__ = (q); const int b = ((q__ - nsteps) >> 1) & 7; \
        const unsigned char* ntab; int npos; STEP_DESC(q__ + LOOK, ntab, npos); npos += (int)hsel; \
        const int wpos = (KT) * 128 + b * 16 + (int)hsel; \
        unsigned cwv_[8]; int riv_[8];     \
        _Pragma("unroll") for (int i2 = 0; i2 < 8; ++i2) { cwv_[i2] = ((const LAS unsigned*)wl)[wpos + 2 * i2]; riv_[i2] = sid[npos + 2 * i2]; } \
        _Pragma("unroll") for (int i2 = 0; i2 < 8; ++i2) { \
            const v8i_t B6 = {(int)buf[i2].a[0], (int)buf[i2].a[1], (int)buf[i2].a[2], (int)buf[i2].a[3], (int)buf[i2].b[0], (int)buf[i2].b[1], 0, 0}; \
            const unsigned cw_ = cwv_[i2]; const unsigned c6_ = cw_ & 63u, lo_ = c6_ << shv, hi_ = c6_ >> rshv; const int sc_ = (int)(cw_ >> 8); \
            const v8i_t A6 = {(int)((lo_ & m0v[0]) | (hi_ & m1v[0])), (int)((lo_ & m0v[1]) | (hi_ & m1v[1])), (int)((lo_ & m0v[2]) | (hi_ & m1v[2])), (int)((lo_ & m0v[3]) | (hi_ & m1v[3])), (int)((lo_ & m0v[4]) | (hi_ & m1v[4])), (int)((lo_ & m0v[5]) | (hi_ & m1v[5])), 0, 0}; \
            CACC = __builtin_amdgcn_mfma_scale_f32_32x32x64_f8f6f4(A6, B6, CACC, 2, 2, 0, sc_, 0, 127); \
            LDROW(buf[i2], ntab, riv_[i2]); \
            __builtin_amdgcn_sched_barrier(0); } } while (0)
#define V_FINISH(CACC, KT) do { const int t = t0 + (KT) * tstep; float ss = 0.f; float fin[16]; \
        _Pragma("unroll") for (int r4 = 0; r4 < 4; ++r4) { const pg8::u32x2 rr_ = *(const pg8::u32x2*)(H2B + (size_t)t * D + ebase + 8 * r4); \
            fin[4 * r4] = CACC[4 * r4] + __builtin_bit_cast(float, rr_[0] << 16); fin[4 * r4 + 1] = CACC[4 * r4 + 1] + __builtin_bit_cast(float, rr_[0] & 0xffff0000u); \
            fin[4 * r4 + 2] = CACC[4 * r4 + 2] + __builtin_bit_cast(float, rr_[1] << 16); fin[4 * r4 + 3] = CACC[4 * r4 + 3] + __builtin_bit_cast(float, rr_[1] & 0xffff0000u); } \
        _Pragma("unroll") for (int j = 0; j < 16; ++j) ss += fin[j] * fin[j]; \
        const float rr = rsqrtf(wave_sum(ss) * (1.f / D) + EPS); \
        _Pragma("unroll") for (int r4 = 0; r4 < 4; ++r4) { const float4 g = fgq[r4]; \
            typedef float nt4_t __attribute__((ext_vector_type(4))); const nt4_t o4_ = {fin[4 * r4] * rr * g.x, fin[4 * r4 + 1] * rr * g.y, fin[4 * r4 + 2] * rr * g.z, fin[4 * r4 + 3] * rr * g.w}; \
            __builtin_nontemporal_store(o4_, (nt4_t*)(out + (size_t)t * D + ebase + 8 * r4)); } } while (0)
#pragma unroll 1
    for (int grp = 0; grp < ntok / 2; ++grp) { const int kb_ = 2 * grp;
        v16f_tt ca0, ca1;
#pragma unroll
        for (int j = 0; j < 16; ++j) { ca0[j] = 0.f; ca1[j] = 0.f; }
#pragma unroll 1
        for (int bb = 0; bb < 8; ++bb) { const int q = nsteps + 16 * grp + 2 * bb; if (ntok == 8) __builtin_amdgcn_s_barrier(); V_STEP(q, ca0, kb_); V_STEP(q + 1, ca1, kb_ + 1); }
        V_FINISH(ca0, kb_); V_FINISH(ca1, kb_ + 1);
        __builtin_amdgcn_sched_barrier(0);
    }
#undef V_FINISH
#undef V_STEP
#undef STEP_DESC
#undef LDI
#undef LDF
#undef LDROW
}

typedef short v4i16_t __attribute__((ext_vector_type(4)));
typedef int v2i32_t __attribute__((ext_vector_type(2)));
typedef int v4i32_t __attribute__((ext_vector_type(4)));
DEVI bf16x8_t join_tr(v4i16_t lo, v4i16_t hh) { const v2i32_t a = __builtin_bit_cast(v2i32_t, lo), b = __builtin_bit_cast(v2i32_t, hh); const v4i32_t w = {a[0], a[1], b[0], b[1]}; return __builtin_bit_cast(bf16x8_t, w); }
DEVI float max3f(float a, float b, float c) { float r; asm("v_max3_f32 %0, %1, %2, %3" : "=v"(r) : "v"(a), "v"(b), "v"(c)); return r; }
DEVI float max2f(float a, float b) { float r; asm("v_max_f32_e32 %0, %1, %2" : "=v"(r) : "v"(a), "v"(b)); return r; }
DEVI void glds16(const void* gsrc, unsigned lds_dst) { unsigned keep;
    asm volatile("s_mov_b32 %0, m0\n\ts_mov_b32 m0, %2\n\ts_nop 0\n\tglobal_load_lds_dwordx4 %1, off\n\ts_mov_b32 m0, %0" : "=&s"(keep) : "v"(gsrc), "s"(lds_dst) : "memory"); }
#define LDSADDR(p) ((unsigned)__builtin_amdgcn_readfirstlane((int)(unsigned)(uintptr_t)(p)))
#define ATT_BAR(N) asm volatile("s_waitcnt vmcnt(" #N ") lgkmcnt(0)\n\ts_barrier" ::: "memory")
template <int DQK, int DV, int DSPLIT, int NSLOT, int PD, bool CAUSAL, bool STAG, int VAR = 0>
DEVI void attn_unit(LAS unsigned char* S, const bf16* Qu, int qpitch, const bf16* Ku, int kpitch, const bf16* Vu, int vpitch, bf16* Ou, int opitch, int NT, int qcb) {
    constexpr int NCH = DQK / 8, KSLOT = NCH * 1024, NVG = DV / 32, VSLOT = NVG * 4096, NRG = 8 / DSPLIT, DVW = DV / DSPLIT, NOD = DVW / 32, NKS = DQK / 16;
    constexpr int KOFF = 0, VOFF = NSLOT * KSLOT, WSF = VOFF + NSLOT * VSLOT;
    static_assert(NRG * 32 * DVW * 2 * DSPLIT <= NSLOT * KSLOT, "O staging reuses the K ring");
    static_assert(NSLOT >= PD + (STAG ? 2 : 1), "ring depth");
    int tid_ = threadIdx.x; asm volatile("" : "+v"(tid_));
    const int lane = tid_ & 63, wid = __builtin_amdgcn_readfirstlane(tid_ >> 6), r32 = lane & 31, hi = lane >> 5, rg = wid % NRG, dp = wid / NRG;
    const bool late = STAG && wid >= 4;
    LAS float* wsf = (LAS float*)(S + WSF) + wid * 64;
    const int nld = (NCH - wid + 7) / 8 + (NVG * 4 - wid + 7) / 8;
    const bf16* ksrc = Ku + (size_t)lane * kpitch;
    const bf16* vsrc = Vu + (size_t)(lane >> 2) * vpitch + (lane & 3) * 8;
#define ATT_DMA(t, slot) do { \
        _Pragma("unroll") for (int pc_ = 0; pc_ < (NCH + 7) / 8; ++pc_) { const int pc = wid + 8 * pc_; if (pc < NCH) \
            glds16(ksrc + (size_t)(t) * 64 * kpitch + pc * 8, LDSADDR(S + KOFF + (slot) * KSLOT + pc * 1024)); } \
        _Pragma("unroll") for (int pv_ = 0; pv_ < (NVG * 4 + 7) / 8; ++pv_) { const int pv = wid + 8 * pv_; if (pv < NVG * 4) \
            glds16(vsrc + (size_t)((t) * 64 + (pv & 3) * 16) * vpitch + (pv >> 2) * 32, LDSADDR(S + VOFF + (slot) * VSLOT + pv * 1024)); } } while (0)
    bf16x8_t qr[NKS];
#pragma unroll
    for (int ks = 0; ks < NKS; ++ks) qr[ks] = *(const bf16x8_t*)(Qu + (size_t)(32 * rg + r32) * qpitch + ks * 16 + hi * 8);
#pragma unroll
    for (int ks = 0; ks < NKS; ++ks) asm volatile("" : "+v"(qr[ks]));
#pragma unroll
    for (int t = 0; t < PD; ++t) if (t < NT) ATT_DMA(t, t);
    f32x16_t o[NOD];
#pragma unroll
    for (int dd = 0; dd < NOD; ++dd) o[dd] = f32x16_t{};
    float m = 0.f, l = 0.f; f32x16_t negm = f32x16_t{};
    const int tlast = CAUSAL ? qcb + (rg >> 1) : NT - 1;
    const LAS unsigned char* kbase = S + KOFF + hi * 1024 + r32 * 16;
    const LAS unsigned char* vbase = S + VOFF + ((lane >> 4) & 1) * 32 + (lane & 3) * 8 + (4 * hi + ((lane & 15) >> 2)) * 64 + dp * NOD * 4096;
    bf16x8_t pa[4];
#define ATT_QKSM(sl) do { const LAS unsigned char* kp = kbase + (sl) * KSLOT; \
            f32x16_t p0 = negm, p1 = negm; \
            _Pragma("unroll") for (int ks = 0; ks < NKS; ++ks) { const bf16x8_t a0 = *(const LAS bf16x8_t*)(kp + ks * 2048), a1 = *(const LAS bf16x8_t*)(kp + ks * 2048 + 512); \
                if (VAR != 2) { p0 = __builtin_amdgcn_mfma_f32_32x32x16_bf16(a0, qr[ks], p0, 0, 0, 0); p1 = __builtin_amdgcn_mfma_f32_32x32x16_bf16(a1, qr[ks], p1, 0, 0, 0); } else { p0[ks] += __builtin_bit_cast(float, (int)a0[0]); p1[ks] += __builtin_bit_cast(float, (int)a1[0]); } } \
            asm volatile("s_nop 15\n\ts_nop 7" : "+v"(p0), "+v"(p1)); \
            float rm = 0.f; \
            if (VAR != 1) { float a = max3f(p0[0], p0[1], p1[0]), b = max3f(p0[2], p0[3], p1[1]); a = max3f(a, p1[2], p1[3]); \
              _Pragma("unroll") for (int r = 4; r < 16; r += 4) { a = max3f(a, p0[r], p0[r + 1]); b = max3f(b, p0[r + 2], p0[r + 3]); a = max3f(a, p1[r], p1[r + 1]); b = max3f(b, p1[r + 2], p1[r + 3]); } \
              rm = max2f(a, b); rm = x32_max(rm); } \
            if (__any(rm > 0.f)) { \
                const float dl = fmaxf(rm, 0.f), alpha = __builtin_amdgcn_exp2f(-dl); m += dl; l *= alpha; \
                _Pragma("unroll") for (int r = 0; r < 16; ++r) { p0[r] -= dl; p1[r] -= dl; negm[r] = -m; } \
                if (hi == 0) wsf[r32] = alpha; \
                LDS_WAIT(); asm volatile("" ::: "memory"); \
                _Pragma("unroll") for (int r = 0; r < 16; ++r) { const float f = wsf[crow16(r, hi)]; \
                    _Pragma("unroll") for (int dd = 0; dd < NOD; ++dd) o[dd][r] *= f; } \
                LDS_WAIT(); asm volatile("" ::: "memory"); \
            } \
            float ls = 0.f; \
            if (VAR != 1) { _Pragma("unroll") for (int r = 0; r < 16; ++r) { p0[r] = __builtin_amdgcn_exp2f(p0[r]); p1[r] = __builtin_amdgcn_exp2f(p1[r]); ls += p0[r] + p1[r]; } } \
            l += ls; \
            _Pragma("unroll") for (int ks = 0; ks < 4; ++ks) { pg8::u32x4 w; \
                if (ks < 2) { w.x = pg8::cvt_pk_bf16(p0[8 * ks], p0[8 * ks + 1]); w.y = pg8::cvt_pk_bf16(p0[8 * ks + 2], p0[8 * ks + 3]); w.z = pg8::cvt_pk_bf16(p0[8 * ks + 4], p0[8 * ks + 5]); w.w = pg8::cvt_pk_bf16(p0[8 * ks + 6], p0[8 * ks + 7]); } \
                else { const int k2 = ks - 2; w.x = pg8::cvt_pk_bf16(p1[8 * k2], p1[8 * k2 + 1]); w.y = pg8::cvt_pk_bf16(p1[8 * k2 + 2], p1[8 * k2 + 3]); w.z = pg8::cvt_pk_bf16(p1[8 * k2 + 4], p1[8 * k2 + 5]); w.w = pg8::cvt_pk_bf16(p1[8 * k2 + 6], p1[8 * k2 + 7]); } \
                pa[ks] = __builtin_bit_cast(bf16x8_t, w); } } while (0)
#define ATT_PV(sl) do { const LAS unsigned char* vp = vbase + (sl) * VSLOT; \
            _Pragma("unroll") for (int dd = 0; dd < NOD; ++dd) \
                _Pragma("unroll") for (int ks = 0; ks < 4; ++ks) { \
                    const v4i16_t lo = __builtin_amdgcn_ds_read_tr16_b64_v4i16((LAS v4i16_t*)(vp + dd * 4096 + ks * 1024)); \
                    const v4i16_t hh = __builtin_amdgcn_ds_read_tr16_b64_v4i16((LAS v4i16_t*)(vp + dd * 4096 + ks * 1024 + 512)); \
                    const bf16x8_t vf = join_tr(lo, hh); \
                    if (VAR != 2) o[dd] = __builtin_amdgcn_mfma_f32_32x32x16_bf16(pa[ks], vf, o[dd], 0, 0, 0); else o[dd][ks] += __builtin_bit_cast(float, (int)vf[0] + (int)pa[ks][0]); } } while (0)
    int slot = 0, slot_prev = NSLOT - 1, slot_issue = PD % NSLOT;
    for (int t = 0; t < NT; ++t) {
        const int ahead = (t + PD - 1 < NT - 1 ? t + PD - 1 : NT - 1) - t;
        const int nwait = ahead * nld;
        if (nwait <= 0) ATT_BAR(0); else if (nwait == 2) ATT_BAR(2); else if (nwait == 3) ATT_BAR(3); else if (nwait == 4) ATT_BAR(4); else if (nwait == 6) ATT_BAR(6); else if (nwait == 8) ATT_BAR(8); else ATT_BAR(0);
        if (t + PD < NT) ATT_DMA(t + PD, slot_issue);
        if (!late) { if (t <= tlast) { ATT_QKSM(slot); ATT_PV(slot); } }
        else { if (t >= 1 && t - 1 <= tlast) ATT_PV(slot_prev); if (t <= tlast) ATT_QKSM(slot); }
        slot_prev = slot; slot = slot + 1 == NSLOT ? 0 : slot + 1; slot_issue = slot_issue + 1 == NSLOT ? 0 : slot_issue + 1;
    }
    if (late && tlast >= NT - 1) ATT_PV(slot_prev);
    l = x32_sum(l);
    if (hi == 0) wsf[32 + r32] = l;
    ATT_BAR(0);
    LAS bf16* stg = (LAS bf16*)(S + KOFF) + wid * 32 * DVW;
#pragma unroll
    for (int r = 0; r < 16; ++r) { const int orow = crow16(r, hi); const float rl = __builtin_amdgcn_rcpf(wsf[32 + orow]);
#pragma unroll
        for (int dd = 0; dd < NOD; ++dd) stg[orow * DVW + dd * 32 + r32] = f2bf(o[dd][r] * rl); }
    LDS_WAIT(); asm volatile("" ::: "memory");
#pragma unroll
    for (int i = 0; i < DVW / 16; ++i) { const int idx = i * 64 + lane, row = idx / (DVW / 8), ch = idx % (DVW / 8);
        *(pg8::u32x4*)(Ou + (size_t)(32 * rg + row) * opitch + dp * DVW + ch * 8) = *(const LAS pg8::u32x4*)(stg + row * DVW + ch * 8); }
    ATT_BAR(0);
#undef ATT_DMA
#undef ATT_QKSM
#undef ATT_PV
}

typedef float f32x2_t __attribute__((ext_vector_type(2)));
constexpr float MLA_MOVE_THR = 8.0f;
DEVI unsigned cvtpk(float lo, float hi) { const f32x2_t v = {lo, hi}; const bf16x2_t b = __builtin_convertvector(v, bf16x2_t); return __builtin_bit_cast(unsigned, b); }
DEVI void attn_mla_unit(LAS unsigned char* S, const bf16* Qu, const bf16* Ku, const bf16* KRu, const bf16* Vu, bf16* Ou, int NT, int qcb) {
    constexpr int NCH = 12, KSLOT = NCH * 1024, VSLOT = 8192, NSLOT = 4, NKS = 6, qpitch = 768, kpitch = 768, vpitch = 512, opitch = D;
    constexpr int KOFF = 0, VOFF = NSLOT * KSLOT, WSF = VOFF + NSLOT * VSLOT;
    int tid_ = threadIdx.x; asm volatile("" : "+v"(tid_));
    const int lane = tid_ & 63, wid = __builtin_amdgcn_readfirstlane(tid_ >> 6), r32 = lane & 31, hi = lane >> 5;
    LAS float* wsf = (LAS float*)(S + WSF) + wid * 64;
    const int nld = wid < 4 ? 3 : 2;
    const bf16* ksrc = Ku + (size_t)lane * kpitch;
    const bf16* krsrc = KRu + (size_t)lane * 32;
    const bf16* vsrc = Vu + (size_t)(lane >> 2) * vpitch + (lane & 3) * 8;
#define MLA_DMA_K(t, slot) do { \
        glds16(ksrc + (size_t)(t) * 64 * kpitch + wid * 8, LDSADDR(S + KOFF + (slot) * KSLOT + wid * 1024)); \
        if (wid < 4) glds16(krsrc + (size_t)(t) * 64 * 32 + wid * 8, LDSADDR(S + KOFF + (slot) * KSLOT + (wid + 8) * 1024)); } while (0)
#define MLA_DMA_V(t, slot) do { \
        glds16(vsrc + (size_t)((t) * 64 + (wid & 3) * 16) * vpitch + (wid >> 2) * 32, LDSADDR(S + VOFF + (slot) * VSLOT + wid * 1024)); } while (0)
#define MLA_BAR(nw) do { if ((nw) <= 0) ATT_BAR(0); else if ((nw) == 2) ATT_BAR(2); else if ((nw) == 3) ATT_BAR(3); else if ((nw) == 4) ATT_BAR(4); else ATT_BAR(6); } while (0)
#define SGB(mask, n) __builtin_amdgcn_sched_group_barrier(mask, n, 0)
    bf16x8_t qr[NKS];
#pragma unroll
    for (int ks = 0; ks < NKS; ++ks) qr[ks] = *(const bf16x8_t*)(Qu + (size_t)(32 * wid + r32) * qpitch + ks * 16 + hi * 8);
#pragma unroll
    for (int ks = 0; ks < NKS; ++ks) asm volatile("" : "+v"(qr[ks]));
    MLA_DMA_K(0, 0); MLA_DMA_K(1, 1); MLA_DMA_K(2, 2); MLA_DMA_V(0, 0); MLA_DMA_V(1, 1);
    f32x16_t o0 = f32x16_t{}, o1 = f32x16_t{};
    float m = 0.f, l = 0.f; f32x16_t negm = f32x16_t{};
    const int tlast = qcb + (wid >> 1);
    const LAS unsigned char* kbase = S + KOFF + hi * 1024 + r32 * 16;
    const LAS unsigned char* vbase = S + VOFF + ((lane >> 4) & 1) * 32 + (lane & 3) * 8 + (4 * hi + ((lane & 15) >> 2)) * 64;
    f32x16_t p0, p1;
#define MLA_ROWMAX(rm, q0, q1) do { float a_ = __builtin_fmaxf(__builtin_fmaxf(q0[0], q0[1]), q1[0]), b_ = __builtin_fmaxf(__builtin_fmaxf(q0[2], q0[3]), q1[1]); a_ = __builtin_fmaxf(__builtin_fmaxf(a_, q1[2]), q1[3]); \
        _Pragma("unroll") for (int r = 4; r < 16; r += 4) { a_ = __builtin_fmaxf(__builtin_fmaxf(a_, q0[r]), q0[r + 1]); b_ = __builtin_fmaxf(__builtin_fmaxf(b_, q0[r + 2]), q0[r + 3]); a_ = __builtin_fmaxf(__builtin_fmaxf(a_, q1[r]), q1[r + 1]); b_ = __builtin_fmaxf(__builtin_fmaxf(b_, q1[r + 2]), q1[r + 3]); } \
        rm = __builtin_fmaxf(a_, b_); rm = x32_max(rm); } while (0)
#define MLA_MOVE(rm, q0, q1) do { if (__any(rm > MLA_MOVE_THR)) {     \
            const float dl = fmaxf(rm, 0.f), alpha = __builtin_amdgcn_exp2f(-dl); m += dl; l *= alpha; \
            _Pragma("unroll") for (int r = 0; r < 16; ++r) { q0[r] -= dl; q1[r] -= dl; negm[r] = -m; } \
            if (hi == 0) wsf[r32] = alpha; \
            LDS_WAIT(); asm volatile("" ::: "memory"); \
            _Pragma("unroll") for (int r = 0; r < 16; ++r) { const float f = wsf[crow16(r, hi)]; o0[r] *= f; o1[r] *= f; } \
            LDS_WAIT(); asm volatile("" ::: "memory"); } } while (0)
    ATT_BAR(0);
    if (3 < NT) MLA_DMA_K(3, 3);
    if (2 < NT) MLA_DMA_V(2, 2);
    { const LAS unsigned char* kp = kbase; p0 = negm; p1 = negm;
#pragma unroll
      for (int ks = 0; ks < NKS; ++ks) { const bf16x8_t a0 = *(const LAS bf16x8_t*)(kp + ks * 2048), a1 = *(const LAS bf16x8_t*)(kp + ks * 2048 + 512);
          p0 = __builtin_amdgcn_mfma_f32_32x32x16_bf16(a0, qr[ks], p0, 0, 0, 0); p1 = __builtin_amdgcn_mfma_f32_32x32x16_bf16(a1, qr[ks], p1, 0, 0, 0); }
      float rm; MLA_ROWMAX(rm, p0, p1); MLA_MOVE(rm, p0, p1); }
    asm volatile("s_waitcnt lgkmcnt(0)\n\ts_barrier" ::: "memory");
    int kslot = 1, vslot = 0;
    for (int t = 0; t < NT; ++t) {
        if (t >= 2 && (t & 1) == 0) { ATT_BAR(0); if (wid >= 4) __builtin_amdgcn_s_sleep(4); }
        if (t >= 1) { if (t + 3 < NT) MLA_DMA_K(t + 3, (kslot + 2) & 3); if (t + 2 < NT) MLA_DMA_V(t + 2, (vslot + 2) & 3); }
        if (t < tlast) {
            const LAS unsigned char* kp = kbase + kslot * KSLOT; const LAS unsigned char* vp = vbase + vslot * VSLOT;
            bf16x8_t kf[12];
#pragma unroll
            for (int ks = 0; ks < NKS; ++ks) { kf[2 * ks] = *(const LAS bf16x8_t*)(kp + ks * 2048); kf[2 * ks + 1] = *(const LAS bf16x8_t*)(kp + ks * 2048 + 512); }
            f32x16_t n0 = negm, n1 = negm; float ls = 0.f; pg8::u32x4 pw[4];
#pragma unroll
            for (int ks = 0; ks < NKS; ++ks) { n0 = __builtin_amdgcn_mfma_f32_32x32x16_bf16(kf[2 * ks], qr[ks], n0, 0, 0, 0); n1 = __builtin_amdgcn_mfma_f32_32x32x16_bf16(kf[2 * ks + 1], qr[ks], n1, 0, 0, 0); }
#pragma unroll
            for (int r = 0; r < 16; ++r) { p0[r] = __builtin_amdgcn_exp2f(p0[r]); p1[r] = __builtin_amdgcn_exp2f(p1[r]); }
#pragma unroll
            for (int r = 0; r < 16; r += 2) { ls += (p0[r] + p0[r + 1]) + (p1[r] + p1[r + 1]); }
#pragma unroll
            for (int ks = 0; ks < 2; ++ks) { pw[ks] = (pg8::u32x4){cvtpk(p0[8 * ks], p0[8 * ks + 1]), cvtpk(p0[8 * ks + 2], p0[8 * ks + 3]), cvtpk(p0[8 * ks + 4], p0[8 * ks + 5]), cvtpk(p0[8 * ks + 6], p0[8 * ks + 7])};
                pw[2 + ks] = (pg8::u32x4){cvtpk(p1[8 * ks], p1[8 * ks + 1]), cvtpk(p1[8 * ks + 2], p1[8 * ks + 3]), cvtpk(p1[8 * ks + 4], p1[8 * ks + 5]), cvtpk(p1[8 * ks + 6], p1[8 * ks + 7])}; }
            l += ls;
            v4i16_t vlo[8], vhi[8];
#pragma unroll
            for (int i = 0; i < 4; ++i) { vlo[i] = __builtin_amdgcn_ds_read_tr16_b64_v4i16((LAS v4i16_t*)(vp + (i >> 2) * 4096 + (i & 3) * 1024)); vhi[i] = __builtin_amdgcn_ds_read_tr16_b64_v4i16((LAS v4i16_t*)(vp + (i >> 2) * 4096 + (i & 3) * 1024 + 512)); }
            SGB(0x100, 4);
#pragma unroll
            for (int i = 0; i < 12; ++i) { SGB(0x008, 1); SGB(0x002, 7); if (i < 8) SGB(0x100, 1); else SGB(0x100, 2); }
            __builtin_amdgcn_sched_barrier(0);
#pragma unroll
            for (int i = 4; i < 8; ++i) { vlo[i] = __builtin_amdgcn_ds_read_tr16_b64_v4i16((LAS v4i16_t*)(vp + (i >> 2) * 4096 + (i & 3) * 1024)); vhi[i] = __builtin_amdgcn_ds_read_tr16_b64_v4i16((LAS v4i16_t*)(vp + (i >> 2) * 4096 + (i & 3) * 1024 + 512)); }
#pragma unroll
            for (int i = 0; i < 8; ++i) { const bf16x8_t vf = join_tr(vlo[i], vhi[i]); const bf16x8_t pa_ = __builtin_bit_cast(bf16x8_t, pw[i & 3]);
                if (i < 4) o0 = __builtin_amdgcn_mfma_f32_32x32x16_bf16(pa_, vf, o0, 0, 0, 0); else o1 = __builtin_amdgcn_mfma_f32_32x32x16_bf16(pa_, vf, o1, 0, 0, 0); }
            float rm; MLA_ROWMAX(rm, n0, n1);
#pragma unroll
            for (int i = 0; i < 8; ++i) { SGB(0x008, 1); SGB(0x002, 3); if (i < 4) SGB(0x100, 2); }
            __builtin_amdgcn_sched_barrier(0);
            MLA_MOVE(rm, n0, n1);
            p0 = n0; p1 = n1;
        } else if (t == tlast) {
            asm volatile("" : "+v"(p0), "+v"(p1));
            const LAS unsigned char* vp = vbase + vslot * VSLOT; float ls = 0.f; pg8::u32x4 pw[4];
#pragma unroll
            for (int r = 0; r < 16; ++r) { p0[r] = __builtin_amdgcn_exp2f(p0[r]); p1[r] = __builtin_amdgcn_exp2f(p1[r]); ls += p0[r] + p1[r]; }
            l += ls;
#pragma unroll
            for (int ks = 0; ks < 2; ++ks) { pw[ks] = (pg8::u32x4){cvtpk(p0[8 * ks], p0[8 * ks + 1]), cvtpk(p0[8 * ks + 2], p0[8 * ks + 3]), cvtpk(p0[8 * ks + 4], p0[8 * ks + 5]), cvtpk(p0[8 * ks + 6], p0[8 * ks + 7])};
                pw[2 + ks] = (pg8::u32x4){cvtpk(p1[8 * ks], p1[8 * ks + 1]), cvtpk(p1[8 * ks + 2], p1[8 * ks + 3]), cvtpk(p1[8 * ks + 4], p1[8 * ks + 5]), cvtpk(p1[8 * ks + 6], p1[8 * ks + 7])}; }
#pragma unroll
            for (int i = 0; i < 8; ++i) { const v4i16_t lo = __builtin_amdgcn_ds_read_tr16_b64_v4i16((LAS v4i16_t*)(vp + (i >> 2) * 4096 + (i & 3) * 1024)), hh = __builtin_amdgcn_ds_read_tr16_b64_v4i16((LAS v4i16_t*)(vp + (i >> 2) * 4096 + (i & 3) * 1024 + 512));
                const bf16x8_t vf = join_tr(lo, hh); const bf16x8_t pa_ = __builtin_bit_cast(bf16x8_t, pw[i & 3]);
                if (i < 4) o0 = __builtin_amdgcn_mfma_f32_32x32x16_bf16(pa_, vf, o0, 0, 0, 0); else o1 = __builtin_amdgcn_mfma_f32_32x32x16_bf16(pa_, vf, o1, 0, 0, 0); }
        }
        kslot = (kslot + 1) & 3; vslot = (vslot + 1) & 3;
    }
    l = x32_sum(l);
    if (hi == 0) wsf[32 + r32] = l;
    ATT_BAR(0);
    LAS bf16* stg = (LAS bf16*)(S + KOFF) + wid * 32 * 64;
#pragma unroll
    for (int r = 0; r < 16; ++r) { const int orow = crow16(r, hi); const float rl = __builtin_amdgcn_rcpf(wsf[32 + orow]);
        stg[orow * 64 + r32] = f2bf(o0[r] * rl); stg[orow * 64 + 32 + r32] = f2bf(o1[r] * rl); }
    LDS_WAIT(); asm volatile("" ::: "memory");
#pragma unroll
    for (int i = 0; i < 4; ++i) { const int idx = i * 64 + lane, row = idx >> 3, ch = idx & 7;
        *(pg8::u32x4*)(Ou + (size_t)(32 * wid + row) * opitch + ch * 8) = *(const LAS pg8::u32x4*)(stg + row * 64 + ch * 8); }
    ATT_BAR(0);
#undef MLA_DMA_K
#undef MLA_DMA_V
#undef MLA_BAR
#undef MLA_ROWMAX
#undef MLA_MOVE
#undef SGB
}

DEVI bool unit_of(int Mrows, int Ncols, int G, int c, int i, int& pm, int& pn) {
    const int nM = Mrows / 256, nN = Ncols / 256, nwg = nM * nN; const long Lq = (long)i * G + c; if (Lq >= nwg) return false;
    int wgid = (int)Lq; { const int q = nwg / 8, r = nwg % 8, xcd = wgid % 8, off = wgid / 8; wgid = (xcd < r ? xcd * (q + 1) : r * (q + 1) + (xcd - r) * q) + off; }
    const int nig = 8 * nN, gid = wgid / nig, fm = gid * 8, gsz = (nM - fm) < 8 ? (nM - fm) : 8;
    pm = fm + ((wgid % nig) % gsz); pn = (wgid % nig) / gsz; return true;
}
DEVI void own_writes_visible() {
    asm volatile("s_waitcnt vmcnt(0)" ::: "memory"); __syncthreads();
    if (threadIdx.x == 0) { __builtin_amdgcn_fence(__ATOMIC_ACQUIRE, "agent"); asm volatile("s_waitcnt vmcnt(0)" ::: "memory"); }
    __syncthreads();
}

__global__ void __launch_bounds__(NTHR, 2) mega(Args args) {
    extern __shared__ __attribute__((aligned(16))) unsigned char lds[];
    const int tid = threadIdx.x, lane = tid & 63, wave = __builtin_amdgcn_readfirstlane(tid >> 6);
    const int G = gridDim.x, bx = blockIdx.x; const int vcu = (G % 8 == 0) ? (bx % 8) * (G / 8) + bx / 8 : bx;
    LAS unsigned char* L = (LAS unsigned char*)lds + PH_BASE;
    volatile LAS unsigned* MISC = (volatile LAS unsigned*)((LAS unsigned char*)lds + LDSCTL_OFF + 320);
    unsigned char* ws = args.ws; gu32* ctl = (gu32*)(ws + WS_CTL);
    if (tid < PH_BASE / 4) ((LAS unsigned*)(lds))[tid] = 0u;
    __syncthreads();
    XcdBarrier bar = xcd_barrier_post((unsigned*)(ctl + CW_BAR) + args.li * XCD_BAR_WORDS, MISC + 8);
    const unsigned mask = args.mask;
#define IN(k) ((mask >> (k)) & 1u)
#ifndef PROBE_ATTVAR
#define PROBE_ATTVAR 0
#endif
#ifndef PROBE_EXPVAR
#define PROBE_EXPVAR 0
#endif
#ifndef V_IN_PROJ
#define V_IN_PROJ 1
#endif
#ifndef LATE_W_IN_PROJ
#define LATE_W_IN_PROJ 1
#endif
#ifndef PROBE_REP
#define PROBE_REP 0u
#endif
#define NREP(k) (1 + (int)((PROBE_REP >> (k)) & 1u))
#define SEAM(k) do { if ((mask & ((1u << PH_N) - 1u)) >> ((k) + 1)) xcd_barrier(bar); } while (0)
    const float* x = args.in[0]; float* out = args.out;
    bf16 *Wt_in = (bf16*)(ws + WS_WIN), *Wt_qup = (bf16*)(ws + WS_WQUP), *Wt_kv = (bf16*)(ws + WS_WKV), *Wt_mix = (bf16*)(ws + WS_WMIX), *Wt_mq = (bf16*)(ws + WS_WMQ), *Wt_mkv = (bf16*)(ws + WS_WMKV),
         *Wt_mo = (bf16*)(ws + WS_WMO), *Wt_pq = (bf16*)(ws + WS_WPQ), *SK = (bf16*)(ws + WS_SK), *MEMN = (bf16*)(ws + WS_MEMN), *MEMKV = (bf16*)(ws + WS_MEMKV), *PU = (bf16*)(ws + WS_PU), *PV = (bf16*)(ws + WS_PV);
    float *partq = (float*)(ws + WS_PARTQ), *partkv = (float*)(ws + WS_PARTKV), *part1 = (float*)(ws + WS_PART1), *part2 = (float*)(ws + WS_PART2), *trig = (float*)(ws + WS_TRIG);
    bf16 *XN = (bf16*)(ws + WS_R1), *CONCAT = XN, *QM = XN, *H2B = XN;
    bf16 *CQ = (bf16*)(ws + WS_R2 + R2_CQ), *CKV = (bf16*)(ws + WS_R2 + R2_CKV), *U = (bf16*)(ws + WS_R2 + R2_U), *H1B = (bf16*)(ws + WS_R2), *OM = (bf16*)(ws + WS_R3);
    bf16 *QB = (bf16*)(ws + WS_R3 + R3_QB), *KB = (bf16*)(ws + WS_R3 + R3_KB), *VB = (bf16*)(ws + WS_R3 + R3_VB), *QP = (bf16*)(ws + WS_R3);


    if (IN(PH_PRO)) {
        for (int rep_ = 0; rep_ < NREP(PH_PRO); ++rep_) { if (rep_) xcd_barrier(bar);
        LAS float* scr = (LAS float*)(L + wave * 16384);
        const int gw = vcu * NWAVES + wave, NGW = G * NWAVES;
        constexpr int I_IN = (D / 64) * (INP / 32), I_QUP = (256 / 64) * (768 / 32), I_KV = (128 / 64) * (1024 / 32), I_SQ = (D / 64) * (D / 32), I_W2 = (D / 64) * (2048 / 32);
        constexpr int NITEMS = I_IN + I_QUP + I_KV + 2 * I_SQ + 2 * I_W2;
        for (int rp_ = 0; rp_ < 1 + (int)((PROBE_REP >> 20) & 1u); ++rp_)
        for (int it = gw; it < NITEMS; it += NGW) {
            int r = it;
            if (r < I_IN) { p0_transpose_item<1, false>(args.in[3], D, INC, Wt_in, INP, nullptr, scr, r, lane); continue; } r -= I_IN;
            if (r < I_QUP) { p0_transpose_item<0, true>(args.in[5], 256, 768, Wt_qup, 768, args.in[4], scr, r, lane); continue; } r -= I_QUP;
            if (r < I_KV) { p0_transpose_item<2, true>(args.in[7], 128, 1024, Wt_kv, 1024, args.in[6], scr, r, lane); continue; } r -= I_KV;
            if (r < I_SQ) { if (!LATE_W_IN_PROJ) p0_transpose_item<0, false>(args.in[12], D, D, Wt_mix, D, nullptr, scr, r, lane); continue; } r -= I_SQ;
            if (r < I_SQ) { p0_transpose_item<0, false>(args.in[17], D, D, Wt_mo, D, nullptr, scr, r, lane); continue; } r -= I_SQ;
            if (r < I_W2) { p0_transpose_item<0, false>(args.in[16], D, 2048, Wt_mkv, 2048, nullptr, scr, r, lane); continue; } r -= I_W2;
            if (!LATE_W_IN_PROJ) p0_transpose_item<0, true>(args.in[19], D, 2048, Wt_pq, 2048, args.in[18], scr, r, lane);
        }
        for (int rp_ = 0; rp_ < 1 + (int)((PROBE_REP >> 21) & 1u); ++rp_)
        for (int m = gw; m < M; m += 4 * NGW) rms_rows4_to_bf16(x, args.in[2], XN, m, NGW, M, lane);
        for (int m = gw; m < BATCH * NMEM; m += NGW) rms_row_to_bf16(args.in[1] + (size_t)m * D, args.in[14], MEMN + (size_t)m * D, lane);
        const size_t gtid = (size_t)vcu * NTHR + tid, gn = (size_t)G * NTHR;
        cvt_stream(args.in[20], SK, (size_t)PH * 2 * PNK * PHALF / 8, nullptr, gtid, gn);
        for (size_t i = gtid; i < (size_t)D * D / 8; i += gn) {
            const float4 a = *(const float4*)(args.in[15] + i * 8), b = *(const float4*)(args.in[15] + i * 8 + 4); const float gk = args.in[13][(i * 8) >> 10];
            pg8::u32x4 o; o.x = pg8::cvt_pk_bf16(a.x * gk, a.y * gk); o.y = pg8::cvt_pk_bf16(a.z * gk, a.w * gk); o.z = pg8::cvt_pk_bf16(b.x * gk, b.y * gk); o.w = pg8::cvt_pk_bf16(b.z * gk, b.w * gk);
            *(pg8::u32x4*)(Wt_mq + i * 8) = o; }
        for (int rp_ = 0; rp_ < 1 + (int)((PROBE_REP >> 22) & 1u); ++rp_) {
        cvt_rows_fp6<true>(args.in[21], (unsigned char*)PU, args.in[18], PU_SCALE, gtid, gn);
        if (!V_IN_PROJ) cvt_rows_fp6<false>(args.in[22], (unsigned char*)PV, nullptr, PV_SCALE, gtid, gn); }
        for (size_t i = gtid; i < (size_t)SEQ * 16; i += gn) { float c, s; rope_cs((int)(i >> 4), (int)(i & 15), c, s); *(float2*)(trig + i * 2) = make_float2(c, s); }
        }
        SEAM(PH_PRO);
    }
    if (IN(PH_PROJ)) {
        for (int rep_ = 0; rep_ < NREP(PH_PROJ); ++rep_) { if (rep_) xcd_barrier(bar);
        { pg8::Gemm g{XN, Wt_in, M, INP, D, 0, 0, 0, 0}; pg8::StaticOrder S; S.init(M, INP, G, bx); pg8::EpiProj E{CQ, CKV, (bf16*)(ws + WS_KR), U, partq, partkv, trig};
          pg8::gemm_phase<pg8::EpiProj, pg8::StaticOrder, true, true>(L, g, S, E); }
        { pg8::Gemm g{MEMN, Wt_mkv, BATCH * NMEM, 2048, D, 0, 0, 0, 0}; pg8::StaticOrder S; S.init(BATCH * NMEM, 2048, G, (bx + 128) % G); pg8::EpiPlain E{MEMKV, 2048};
          pg8::gemm_phase<pg8::EpiPlain, pg8::StaticOrder, true, true>(L, g, S, E); }
        if (V_IN_PROJ && bx >= 144) { asm volatile("" ::: "memory"); cvt_rows_fp6<false>(args.in[22], (unsigned char*)PV, nullptr, PV_SCALE, (size_t)(bx - 144) * NTHR + threadIdx.x, (size_t)(G - 144) * NTHR); asm volatile("" ::: "memory");
            if (LATE_W_IN_PROJ) {
                LAS float* scr2 = (LAS float*)(L + wave * 16384); constexpr int J_SQ = (D / 64) * (D / 32), J_W2 = (D / 64) * (2048 / 32);
                for (int it = (bx - 144) * NWAVES + wave; it < J_SQ + J_W2; it += (G - 144) * NWAVES) {
                    if (it < J_SQ) p0_transpose_item<0, false>(args.in[12], D, D, Wt_mix, D, nullptr, scr2, it, lane);
                    else p0_transpose_item<0, true>(args.in[19], D, 2048, Wt_pq, 2048, args.in[18], scr2, it - J_SQ, lane); } } }
        }
        SEAM(PH_PROJ);
    }
    if (IN(PH_UP)) {
        for (int rep_ = 0; rep_ < NREP(PH_UP); ++rep_) { if (rep_) xcd_barrier(bar);
        if (IN(PHB_UPG)) {
        { pg8::Gemm g{CQ, Wt_qup, M, 768, 256, 0, 0, 0, 0}; pg8::StaticOrder S; S.init(M, 768, G, bx); pg8::EpiQ E{QB, partq, trig, LOG2E * 0.10206207261596577f};
          pg8::gemm_phase<pg8::EpiQ, pg8::StaticOrder, true, true>(L, g, S, E); }
        { pg8::Gemm g{CKV, Wt_kv, M, 1024, 128, 0, 0, 0, 0}; pg8::StaticOrder S; S.init(M, 1024, G, (bx + 192) % G); pg8::EpiKV E{KB, VB, partkv};
          pg8::gemm_phase<pg8::EpiKV, pg8::StaticOrder, true, true>(L, g, S, E); }
        }
        { bf16* KQT = (bf16*)(ws + WS_KQT); bf16* VOT = (bf16*)(ws + WS_VOT);
#pragma unroll 1
          for (int bh = 0; bh < BATCH * XH; ++bh) { const int b = bh >> 2, h = bh & 3;
            { pg8::Gemm g{MEMKV + (size_t)b * NMEM * 2048 + h * XD, Wt_mq + h * XD, NMEM, D, XD, 2048, D, 0, 0}; pg8::StaticOrder S; S.init(NMEM, D, G, (bx + G - 192 - 8 * bh) % G);
              pg8::EpiPlain E{KQT + (size_t)b * D * D + (size_t)h * XD * D, D}; pg8::gemm_phase<pg8::EpiPlain, pg8::StaticOrder, true, true>(L, g, S, E); }
            { pg8::Gemm g{Wt_mo + h * XD, MEMKV + (size_t)b * NMEM * 2048 + 1024 + h * XD, D, NMEM, XD, D, 2048, 0, 0}; pg8::StaticOrder S; S.init(D, NMEM, G, (bx + G - 192 - 8 * bh - 4) % G);
              pg8::EpiPlain E{VOT + (size_t)b * D * D + h * XD, D}; pg8::gemm_phase<pg8::EpiPlain, pg8::StaticOrder, true, true>(L, g, S, E); } } }
        if (IN(PHB_CONV)) { __syncthreads(); for (int c = vcu; c < M / 64; c += G) conv_chunk(c, U, args.in[8], args.in[9], args.in[10], args.in[11], CONCAT, L); }
        }
        SEAM(PH_UP);
    }
    if (IN(PH_ATTN)) {
        for (int rep_ = 0; rep_ < NREP(PH_ATTN); ++rep_) { if (rep_) xcd_barrier(bar);
        for (int u = vcu; u < 512; u += G) { const int bh = (u & 255) >> 4, sidx = u & 15, qb = u < 256 ? 31 - sidx : sidx, b = bh >> 3, h = bh & 7;
            const size_t r0 = (size_t)b * SEQ;
            if (NREP(PH_ATTN) > 1 && rep_ == 0) attn_unit<96, 64, 1, 4, 3, true, false, PROBE_ATTVAR>(L, QB + (r0 + qb * 256) * 768 + h * 96, 768, KB + r0 * 768 + h * 96, 768, VB + r0 * 512 + h * 64, 512, CONCAT + (r0 + qb * 256) * D + h * 64, D, 4 * qb + 4, 4 * qb);
            else attn_mla_unit(L, QB + (r0 + qb * 256) * 768 + h * 96, KB + r0 * 768 + h * 96, (const bf16*)(ws + WS_KR) + r0 * 32, VB + r0 * 512 + h * 64, CONCAT + (r0 + qb * 256) * D + h * 64, 4 * qb + 4, 4 * qb); }
        }
        SEAM(PH_ATTN);
    }
    if (IN(PH_MIX)) {
        for (int rep_ = 0; rep_ < NREP(PH_MIX); ++rep_) { if (rep_) xcd_barrier(bar);
        pg8::Gemm g{CONCAT, Wt_mix, M, D, D, 0, 0, 0, 0}; pg8::StaticOrder S; S.init(M, D, G, bx); pg8::EpiRes<false> E{x, nullptr, H1B, part1};
        pg8::gemm_phase<pg8::EpiRes<false>, pg8::StaticOrder, true, true>(L, g, S, E);
        }
        SEAM(PH_MIX);
    }
    if (IN(PH_MEMQ)) {
        for (int rep_ = 0; rep_ < NREP(PH_MEMQ); ++rep_) { if (rep_) xcd_barrier(bar);
        pg8::Gemm g{H1B, (const bf16*)(ws + WS_KQT), M, D, D, 0, 0, SEQ / 256, (size_t)D * D * 2}; pg8::StaticOrder S; S.init(M, D, G, bx);
        pg8::EpiSoftmaxP E{OM, D, part1, LOG2E / 16.0f, (LAS float*)(L + 131072)};
        pg8::gemm_phase<pg8::EpiSoftmaxP, pg8::StaticOrder, true, true>(L, g, S, E);
        }
        SEAM(PH_MEMQ);
    }
    if (IN(PH_MEMO)) {
        pg8::Gemm g{OM, (const bf16*)(ws + WS_VOT), M, D, D, 0, 0, SEQ / 256, (size_t)D * D * 2};   pg8::StaticOrder S; S.init(M, D, G, bx); pg8::EpiRes<true> E{nullptr, H1B, H2B, part2};
        pg8::gemm_phase<pg8::EpiRes<true>, pg8::StaticOrder, true, true>(L, g, S, E);
        SEAM(PH_MEMO);
    }
    if (IN(PH_PQ)) {
        for (int rep_ = 0; rep_ < NREP(PH_PQ); ++rep_) { if (rep_) xcd_barrier(bar);
        pg8::Gemm g{H2B, Wt_pq, M, 2048, D, 0, 0, 0, 0}; pg8::StaticOrder S; S.init(M, 2048, G, bx); pg8::EpiScaled E{QP, 2048, part2, 1.0f};
        pg8::gemm_phase<pg8::EpiScaled, pg8::StaticOrder, true, true>(L, g, S, E);
        own_writes_visible();
        int* EIDX = (int*)(ws + WS_R2 + R2_EIDX); float* EGATE = (float*)(ws + WS_R2 + R2_EGATE);
        LAS unsigned* scr = (LAS unsigned*)(L + 65536 + wave * 64 * 9 * 4);
        int hl = -1, upm, upn;
        for (int i = 0; unit_of(M, 2048, G, bx, i, upm, upn); ++i) { const int tb = upm, h = upn;
            if (h != hl) {
                __syncthreads();
                for (int pc = tid; pc < 4096; pc += NTHR) { const int p = pc >> 11, n = (pc >> 4) & 127, c = pc & 15;
                    *(LAS pg8::u32x4*)(L + p * 32768 + c * 2048 + n * 16) = *(const pg8::u32x4*)(SK + ((size_t)(h * 2 + p) * 128 + n) * 128 + c * 8); }
                __syncthreads(); hl = h; }
            const int token = tb * 256 + wave * 32 + (lane & 31);
            topk_wave(QP + (size_t)token * 2048 + h * 256, L, scr, EIDX + (size_t)token * 128 + h * 16, EGATE + (size_t)token * 128 + h * 16, lane); }
        __syncthreads();
        }
        SEAM(PH_PQ);
    }
    if (IN(PH_EXP)) {
        const int* EIDX = (const int*)(ws + WS_R2 + R2_EIDX); const float* EGATE = (const float*)(ws + WS_R2 + R2_EGATE);
#ifndef EXP_PREWARM
#define EXP_PREWARM 0
#endif
        if (EXP_PREWARM) {
            const pg8::u32x4* tb = (const pg8::u32x4*)PU; pg8::u32x4 x = {0u, 0u, 0u, 0u};
            for (size_t i = (size_t)vcu * NTHR + tid; i < (size_t)2 * PE * D / 16; i += (size_t)G * NTHR) { const pg8::u32x4 v = __builtin_nontemporal_load(tb + i); x ^= v; }
            if ((x[0] ^ x[1] ^ x[2] ^ x[3]) == 0x9e3779b9u && tid == 999) out[0] = 0.f;
        }
        for (int rep_ = NREP(PH_EXP) - 1; rep_ >= 0; --rep_) { float* dst = rep_ ? (float*)(ws + WS_R3) : out;
            if (rep_) { if (PROBE_EXPVAR != 5 || wave < 4) experts_wave<PROBE_EXPVAR == 5 ? 0 : PROBE_EXPVAR>(L + wave * EXP_LDS_WAVE, vcu * NWAVES + wave, G * NWAVES, H2B, part2, (const unsigned char*)PU, (const unsigned char*)PV, EIDX, EGATE, args.in[23], dst, lane); } else
            experts_wave<0>(L + wave * EXP_LDS_WAVE, vcu * NWAVES + wave, G * NWAVES, H2B, part2, (const unsigned char*)PU, (const unsigned char*)PV, EIDX, EGATE, args.in[23], dst, lane);
            if (rep_) xcd_barrier(bar); }
    }
#undef IN
#undef SEAM
}

#define FAST_MASK ((1u << PH_PRO) | (1u << PH_PROJ) | (1u << PH_UP) | (1u << PHB_UPG) | (1u << PHB_CONV) | (1u << PH_ATTN) | (1u << PH_MIX) | (1u << PH_MEMQ) | (1u << PH_MEMO) | (1u << PH_PQ) | (1u << PH_EXP))
extern "C" void kernel_launch(void* const* d_in, const int* in_sizes, int n_in, void* d_out, int out_size, void* d_ws, size_t ws_size, hipStream_t stream) {
    if (n_in != 24 || out_size != M * D || ws_size < WS_END) { fprintf(stderr, "kernel_launch: unexpected problem (n_in %d out %d ws %zu)\n", n_in, out_size, ws_size); return; }
    static int grid = 0;
    if (grid == 0) {
        int dev = 0, cus = 0, per_cu = 0;
        if (hipGetDevice(&dev) != hipSuccess || hipDeviceGetAttribute(&cus, hipDeviceAttributeMultiprocessorCount, dev) != hipSuccess) { grid = -1; return; }
        if (hipFuncSetAttribute((const void*)mega, hipFuncAttributeMaxDynamicSharedMemorySize, LDS_BYTES) != hipSuccess) { fprintf(stderr, "kernel_launch: hipFuncSetAttribute failed\n"); grid = -1; return; }
        if (hipOccupancyMaxActiveBlocksPerMultiprocessor(&per_cu, (const void*)mega, NTHR, LDS_BYTES) != hipSuccess || per_cu < 1) { fprintf(stderr, "kernel_launch: occupancy query says %d blocks per CU\n", per_cu); grid = -1; (void)hipGetLastError(); return; }
        grid = cus;
    }
    if (grid < 0) return;
    (void)hipMemsetAsync((char*)d_ws + WS_CTL, 0, CTL_ZERO_BYTES, stream);
    Args a{}; for (int i = 0; i < 24; ++i) a.in[i] = (const float*)d_in[i]; a.out = (float*)d_out; a.ws = (unsigned char*)d_ws; a.mask = FAST_MASK; a.li = 0;
    hipLaunchKernelGGL(mega, dim3(grid), dim3(NTHR), LDS_BYTES, stream, a);
}
```
